# Optimizing an MI355X kernel written in HIP

```python
import jax
import jax.numpy as jnp
from jax import lax
import numpy as np

D_MODEL = 1024
BATCH = 8
SEQ = 2048
DEPTH = 2

D_MIX = 2 * D_MODEL
EPS = 1e-6
NEG_INF = -1e30

ATT_WIDTH = D_MIX // 4
ATT_HEAD_DIM = 64
ATT_HEADS = ATT_WIDTH // ATT_HEAD_DIM
MOBA_BLOCK = 256
MOBA_TOPK = 3
MOBA_Q_CHUNK = 32

SSM_WIDTH = D_MIX // 2
SSM_HEAD_DIM = 64
SSM_HEADS = SSM_WIDTH // SSM_HEAD_DIM
SSM_GROUPS = 2
SSM_STATE = 128
SSM_CONV = 4
SSM_CHUNK = 128
SSM_CONV_DIM = SSM_WIDTH + 2 * SSM_GROUPS * SSM_STATE

MLSTM_WIDTH = D_MIX // 4
MLSTM_HEAD_DIM = 128
MLSTM_HEADS = MLSTM_WIDTH // MLSTM_HEAD_DIM
MLSTM_CONV = 4
MLSTM_CHUNK = 128

FFN_HIDDEN = 11 * D_MODEL // 4
FFN_CONV = 3

PROJ_SIZES = (ATT_WIDTH, ATT_WIDTH, ATT_WIDTH,
              SSM_WIDTH, SSM_CONV_DIM, SSM_HEADS,
              2 * MLSTM_WIDTH, MLSTM_WIDTH, MLSTM_WIDTH,
              MLSTM_HEADS, MLSTM_HEADS)
P_IN = sum(PROJ_SIZES)

kernel_name = "hybrid_moba_ssd_mlstm_convglu"


def rmsnorm(x, w):
    xf = x.astype(jnp.float32)
    y = xf * lax.rsqrt(jnp.mean(xf * xf, axis=-1, keepdims=True) + EPS)
    return (y * w.astype(jnp.float32)).astype(x.dtype)


def causal_dwconv(x, w, b):
    k_width, chans = w.shape
    y = lax.conv_general_dilated(x, w[:, None, :].astype(x.dtype), window_strides=(1,),
                                 padding=[(k_width - 1, 0)],
                                 dimension_numbers=('NWC', 'WIO', 'NWC'),
                                 feature_group_count=chans)
    return y + b.astype(x.dtype)


def split_columns(t, sizes):
    offs = np.cumsum(np.array(sizes))[:-1]
    return jnp.split(t, [int(o) for o in offs], axis=-1)


def moba_attention(q, k, v):
    bsz, seq, heads, dh = q.shape
    n_blocks = -(-seq // MOBA_BLOCK)
    n_gate = max(n_blocks, MOBA_TOPK)
    pad = n_blocks * MOBA_BLOCK - seq
    q = q.transpose(0, 2, 1, 3)
    k = jnp.pad(k.transpose(0, 2, 1, 3), ((0, 0), (0, 0), (0, pad), (0, 0)))
    v = jnp.pad(v.transpose(0, 2, 1, 3), ((0, 0), (0, 0), (0, pad), (0, 0)))
    k_blocks = k.reshape(bsz, heads, n_blocks, MOBA_BLOCK, dh)
    v_blocks = v.reshape(bsz, heads, n_blocks, MOBA_BLOCK, dh)
    k_mean = jnp.mean(k_blocks.astype(jnp.float32), axis=3)
    k_mean = jnp.pad(k_mean, ((0, 0), (0, 0), (0, n_gate - n_blocks), (0, 0)))
    n_chunks = seq // MOBA_Q_CHUNK
    q_chunks = jnp.moveaxis(q.reshape(bsz, heads, n_chunks, MOBA_Q_CHUNK, dh), 2, 0)
    b_idx = jnp.arange(bsz)[:, None, None, None]
    h_idx = jnp.arange(heads)[None, :, None, None]
    slot = jnp.arange(MOBA_TOPK + 1)
    is_routed = slot < MOBA_TOPK
    key_off = jnp.arange(MOBA_BLOCK)
    block_ids = jnp.arange(n_gate)
    scale = dh ** -0.5

    def attend_chunk(args):
        qc, c = args
        start = c * MOBA_Q_CHUNK
        own = start // MOBA_BLOCK
        q_pos = start + jnp.arange(MOBA_Q_CHUNK)
        gate = jnp.einsum('bhqd,bhnd->bhqn', qc.astype(jnp.float32), k_mean)
        gate = jnp.where(block_ids < own, gate, NEG_INF)
        _, top_idx = lax.top_k(gate, MOBA_TOPK)
        top_idx = jnp.minimum(top_idx, n_blocks - 1)
        own_idx = jnp.full(top_idx.shape[:-1] + (1,), own, dtype=top_idx.dtype)
        sel = jnp.concatenate([top_idx, own_idx], axis=-1)
        k_sel = k_blocks[b_idx, h_idx, sel]
        v_sel = v_blocks[b_idx, h_idx, sel]
        s = jnp.einsum('bhqd,bhqrkd->bhqrk', qc, k_sel,
                       preferred_element_type=jnp.float32) * scale
        causal = (own * MOBA_BLOCK + key_off)[None, :] <= q_pos[:, None]
        valid = jnp.where(is_routed[None, :, None], (slot < own)[None, :, None],
                          causal[:, None, :])
        p = jax.nn.softmax(jnp.where(valid, s, NEG_INF), axis=(-2, -1))
        return jnp.einsum('bhqrk,bhqrkd->bhqd', p.astype(v_sel.dtype), v_sel)

    out = lax.map(attend_chunk, (q_chunks, jnp.arange(n_chunks)))
    return out.transpose(1, 0, 3, 2, 4).reshape(bsz, seq, heads * dh)


def mamba2_ssd(z, xbc, dt_raw, conv_w, conv_b, dt_bias, a_log, d_skip, norm_w):
    bsz, seq, _ = z.shape
    hpg = SSM_HEADS // SSM_GROUPS
    n_chunks = seq // SSM_CHUNK
    xbc = jax.nn.silu(causal_dwconv(xbc, conv_w, conv_b)).astype(jnp.float32)
    xs, b_in, c_in = jnp.split(xbc, [SSM_WIDTH, SSM_WIDTH + SSM_GROUPS * SSM_STATE], axis=-1)
    xs = xs.reshape(bsz, n_chunks, SSM_CHUNK, SSM_GROUPS, hpg, SSM_HEAD_DIM)
    b_in = b_in.reshape(bsz, n_chunks, SSM_CHUNK, SSM_GROUPS, SSM_STATE)
    c_in = c_in.reshape(bsz, n_chunks, SSM_CHUNK, SSM_GROUPS, SSM_STATE)
    dt = jax.nn.softplus(dt_raw.astype(jnp.float32) + dt_bias.astype(jnp.float32))
    dt = dt.reshape(bsz, n_chunks, SSM_CHUNK, SSM_GROUPS, hpg)
    a = -jnp.exp(a_log.astype(jnp.float32)).reshape(SSM_GROUPS, hpg)
    log_decay = jnp.cumsum(dt * a, axis=2)
    x_dt = xs * dt[..., None]
    causal = jnp.tril(jnp.ones((SSM_CHUNK, SSM_CHUNK), dtype=bool))[:, :, None, None]
    seg = log_decay[:, :, :, None] - log_decay[:, :, None, :]
    decay = jnp.exp(jnp.where(causal, seg, -jnp.inf))
    cb = jnp.einsum('bclgn,bcsgn->bclsg', c_in, b_in)
    y = jnp.einsum('bclsg,bclsge,bcsgep->bclgep', cb, decay, x_dt)
    to_end = jnp.exp(log_decay[:, :, -1:] - log_decay)
    chunk_states = jnp.einsum('bclgn,bclge,bclgep->bcgepn', b_in, to_end, x_dt)
    chunk_decay = jnp.exp(log_decay[:, :, -1])

    def carry_state(state, inp):
        s_chunk, d_chunk = inp
        return state * d_chunk[..., None, None] + s_chunk, state

    init = jnp.zeros((bsz, SSM_GROUPS, hpg, SSM_HEAD_DIM, SSM_STATE), jnp.float32)
    _, start = lax.scan(carry_state, init,
                        (jnp.moveaxis(chunk_states, 1, 0), jnp.moveaxis(chunk_decay, 1, 0)))
    start = jnp.moveaxis(start, 0, 1)
    y = y + jnp.einsum('bclgn,bcgepn,bclge->bclgep', c_in, start, jnp.exp(log_decay))
    y = y + xs * d_skip.astype(jnp.float32).reshape(SSM_GROUPS, hpg)[:, :, None]
    y = y.reshape(bsz, seq, SSM_WIDTH) * jax.nn.silu(z.astype(jnp.float32))
    y = rmsnorm(y.reshape(bsz, seq, SSM_GROUPS, SSM_WIDTH // SSM_GROUPS),
                norm_w.reshape(SSM_GROUPS, SSM_WIDTH // SSM_GROUPS))
    return y.reshape(bsz, seq, SSM_WIDTH).astype(z.dtype)


def mlstm_chunkwise(qk_pre, v, o_pre, i_pre, f_pre, conv_w, conv_b, i_bias, f_bias, norm_w):
    out_dtype = o_pre.dtype
    bsz, seq, _ = v.shape
    n_chunks = seq // MLSTM_CHUNK
    shp = (bsz, n_chunks, MLSTM_CHUNK, MLSTM_HEADS, MLSTM_HEAD_DIM)
    gshp = shp[:-1]
    qk = jax.nn.silu(causal_dwconv(qk_pre, conv_w, conv_b)).astype(jnp.float32)
    q, k = jnp.split(qk, 2, axis=-1)
    q = q.reshape(shp)
    k = k.reshape(shp) * (MLSTM_HEAD_DIM ** -0.5)
    v = v.astype(jnp.float32).reshape(shp)
    log_i = (i_pre.astype(jnp.float32) + i_bias.astype(jnp.float32)).reshape(gshp)
    log_f = jax.nn.log_sigmoid(f_pre.astype(jnp.float32) + f_bias.astype(jnp.float32)).reshape(gshp)
    cum_f = jnp.cumsum(log_f, axis=2)
    tot_f = cum_f[:, :, -1]
    a = tot_f[:, :, None] - cum_f + log_i
    m_loc = jnp.max(a, axis=2)
    w_loc = jnp.exp(a - m_loc[:, :, None])
    c_loc = jnp.einsum('bclh,bclhd,bclhe->bchde', w_loc, v, k)
    n_loc = jnp.einsum('bclh,bclhe->bche', w_loc, k)

    def carry_state(carry, inp):
        c_st, n_st, m_st = carry
        cl, nl, ml, gc = inp
        m_new = jnp.maximum(gc + m_st, ml)
        s_old = jnp.exp(gc + m_st - m_new)
        s_new = jnp.exp(ml - m_new)
        new = (c_st * s_old[..., None, None] + cl * s_new[..., None, None],
               n_st * s_old[..., None] + nl * s_new[..., None],
               m_new)
        return new, carry

    init = (jnp.zeros((bsz, MLSTM_HEADS, MLSTM_HEAD_DIM, MLSTM_HEAD_DIM), jnp.float32),
            jnp.zeros((bsz, MLSTM_HEADS, MLSTM_HEAD_DIM), jnp.float32),
            jnp.zeros((bsz, MLSTM_HEADS), jnp.float32))
    _, (c_start, n_start, m_start) = lax.scan(
        carry_state, init,
        (jnp.moveaxis(c_loc, 1, 0), jnp.moveaxis(n_loc, 1, 0),
         jnp.moveaxis(m_loc, 1, 0), jnp.moveaxis(tot_f, 1, 0)))
    c_start = jnp.moveaxis(c_start, 0, 1)
    n_start = jnp.moveaxis(n_start, 0, 1)
    m_start = jnp.moveaxis(m_start, 0, 1)
    causal = jnp.tril(jnp.ones((MLSTM_CHUNK, MLSTM_CHUNK), dtype=bool))[:, :, None]
    d = cum_f[:, :, :, None] - cum_f[:, :, None, :] + log_i[:, :, None, :]
    d = jnp.where(causal, d, -jnp.inf)
    inter = cum_f + m_start[:, :, None]
    m_row = jnp.maximum(jnp.max(d, axis=3), inter)
    w_intra = jnp.exp(d - m_row[:, :, :, None])
    w_inter = jnp.exp(inter - m_row)
    scores = jnp.einsum('bcthd,bcshd->bctsh', q, k) * w_intra
    num = (jnp.einsum('bctsh,bcshd->bcthd', scores, v)
           + w_inter[..., None] * jnp.einsum('bchde,bcthe->bcthd', c_start, q))
    den = jnp.sum(scores, axis=3) + w_inter * jnp.einsum('bche,bcthe->bcth', n_start, q)
    h = num / jnp.maximum(jnp.abs(den), jnp.exp(-m_row))[..., None]
    h = rmsnorm(h, norm_w.reshape(MLSTM_HEADS, MLSTM_HEAD_DIM))
    h = jax.nn.sigmoid(o_pre.astype(jnp.float32)).reshape(shp) * h
    return h.reshape(bsz, seq, MLSTM_WIDTH).astype(out_dtype)


def conv_glu(h, w_up, conv_w, conv_b, w_down):
    gate, val = jnp.split(jnp.einsum('bsd,df->bsf', h, w_up), 2, axis=-1)
    gate = causal_dwconv(gate, conv_w, conv_b)
    return jnp.einsum('bsf,fd->bsd', jax.nn.gelu(gate, approximate=False) * val, w_down)


def setup_inputs(seed: int = 0) -> dict:
    key = jax.random.key(seed)
    ks = jax.random.split(key, 24)
    f32 = jnp.float32

    def nrm(k, shape, scale):
        return jax.random.normal(k, shape, f32) * scale

    def gain(k, shape):
        return 1.0 + 0.02 * jax.random.normal(k, shape, f32)

    dt0 = jnp.exp(jax.random.uniform(ks[7], (DEPTH, SSM_HEADS), f32,
                                     minval=float(np.log(1e-3)), maxval=float(np.log(1e-1))))
    return {
        "x": jax.random.normal(ks[0], (BATCH, SEQ, D_MODEL), f32),
        "norm1_w": gain(ks[1], (DEPTH, D_MODEL)),
        "w_in": nrm(ks[2], (DEPTH, D_MODEL, P_IN), D_MODEL ** -0.5),
        "q_norm_w": gain(ks[3], (DEPTH, ATT_HEAD_DIM)),
        "k_norm_w": gain(ks[4], (DEPTH, ATT_HEAD_DIM)),
        "ssm_conv_w": nrm(ks[5], (DEPTH, SSM_CONV, SSM_CONV_DIM), SSM_CONV ** -0.5),
        "ssm_conv_b": nrm(ks[6], (DEPTH, SSM_CONV_DIM), 0.02),
        "ssm_dt_bias": dt0 + jnp.log(-jnp.expm1(-dt0)),
        "ssm_a_log": jnp.log(jax.random.uniform(ks[8], (DEPTH, SSM_HEADS), f32, minval=1.0, maxval=16.0)),
        "ssm_d": gain(ks[9], (DEPTH, SSM_HEADS)),
        "ssm_norm_w": gain(ks[10], (DEPTH, SSM_WIDTH)),
        "mlstm_conv_w": nrm(ks[11], (DEPTH, MLSTM_CONV, 2 * MLSTM_WIDTH), MLSTM_CONV ** -0.5),
        "mlstm_conv_b": nrm(ks[12], (DEPTH, 2 * MLSTM_WIDTH), 0.02),
        "mlstm_i_bias": nrm(ks[13], (DEPTH, MLSTM_HEADS), 0.1),
        "mlstm_f_bias": jnp.linspace(3.0, 6.0, MLSTM_HEADS, dtype=f32)[None, :]
                        + nrm(ks[14], (DEPTH, MLSTM_HEADS), 0.02),
        "mlstm_norm_w": gain(ks[15], (DEPTH, MLSTM_WIDTH)),
        "w_out": nrm(ks[16], (DEPTH, D_MIX, D_MODEL), D_MIX ** -0.5),
        "norm2_w": gain(ks[17], (DEPTH, D_MODEL)),
        "ffn_w_up": nrm(ks[18], (DEPTH, D_MODEL, 2 * FFN_HIDDEN), D_MODEL ** -0.5),
        "ffn_conv_w": nrm(ks[19], (DEPTH, FFN_CONV, FFN_HIDDEN), FFN_CONV ** -0.5),
        "ffn_conv_b": nrm(ks[20], (DEPTH, FFN_HIDDEN), 0.02),
        "ffn_w_down": nrm(ks[21], (DEPTH, FFN_HIDDEN, D_MODEL), FFN_HIDDEN ** -0.5),
    }


def reference(x, norm1_w, w_in, q_norm_w, k_norm_w, ssm_conv_w, ssm_conv_b, ssm_dt_bias,
              ssm_a_log, ssm_d, ssm_norm_w, mlstm_conv_w, mlstm_conv_b, mlstm_i_bias,
              mlstm_f_bias, mlstm_norm_w, w_out, norm2_w, ffn_w_up, ffn_conv_w, ffn_conv_b,
              ffn_w_down):
    bsz, seq, _ = x.shape
    for l in range(DEPTH):
        h = rmsnorm(x, norm1_w[l])
        proj = jnp.einsum('bsd,dp->bsp', h, w_in[l])
        (aq, ak, av, z, xbc, dt_raw, m_qk, m_v, m_o, m_i, m_f) = split_columns(proj, PROJ_SIZES)
        head_shape = (bsz, seq, ATT_HEADS, ATT_HEAD_DIM)
        aq = rmsnorm(aq.reshape(head_shape), q_norm_w[l])
        ak = rmsnorm(ak.reshape(head_shape), k_norm_w[l])
        y_att = moba_attention(aq, ak, av.reshape(head_shape))
        y_ssm = mamba2_ssd(z, xbc, dt_raw, ssm_conv_w[l], ssm_conv_b[l], ssm_dt_bias[l],
                           ssm_a_log[l], ssm_d[l], ssm_norm_w[l])
        y_mlstm = mlstm_chunkwise(m_qk, m_v, m_o, m_i, m_f, mlstm_conv_w[l], mlstm_conv_b[l],
                                  mlstm_i_bias[l], mlstm_f_bias[l], mlstm_norm_w[l])
        mix = jnp.concatenate([y_att, y_ssm, y_mlstm], axis=-1)
        x = x + jnp.einsum('bsm,md->bsd', mix, w_out[l])
        h = rmsnorm(x, norm2_w[l])
        x = x + conv_glu(h, ffn_w_up[l], ffn_conv_w[l], ffn_conv_b[l], ffn_w_down[l])
    return x
```

```cpp
#include <hip/hip_runtime.h>
#include <cstdio>
#include <cstdint>
#include <cmath>

#ifndef MK_MULTI
#define MK_MULTI 1
#endif

constexpr int BATCH = 8, SEQ = 2048, DM = 1024, DEPTH = 2;
constexpr int M = BATCH * SEQ;
constexpr int P_IN = 6168;
constexpr int PLD = 6144;
constexpr int PC_Q = 0, PC_Z = 512, PC_MO = 1536, PC_K = 2048, PC_V = 2560, PC_XBC = 3072, PC_MQK = 4608, PC_MV = 5632;
constexpr int SC_Q = 0, SC_K = 512, SC_V = 1024, SC_Z = 1536, SC_XBC = 2560, SC_DT = 4096, SC_MQK = 4112, SC_MV = 5136, SC_MO = 5648, SC_MI = 6160, SC_MF = 6164;
constexpr int FFN = 2816, ULD = 5632;
constexpr int DMIX = 2048;
constexpr float EPS = 1e-6f;
constexpr float C2 = 0.125f * 1.4426950408889634f;

constexpr size_t MiB = 1u << 20;
constexpr size_t WS_CTL = 0, CTL_ZERO_BYTES = 1 * MiB;
constexpr size_t WS_SMALLP = 1 * MiB;
constexpr size_t WS_SSQ = 3 * MiB - 512 * 1024;
constexpr size_t WS_BUFA = 4 * MiB;
constexpr size_t WS_BUFB = 16 * MiB;
constexpr size_t WS_XB = 22 * MiB;
constexpr size_t WS_PROJ = 64 * MiB;
constexpr size_t WS_END = 256 * MiB;

namespace pg8 {
#define PG8_LAS __attribute__((address_space(3)))
typedef unsigned short bf16_t;
typedef short bf16x8 __attribute__((ext_vector_type(8)));
typedef float f32x4 __attribute__((ext_vector_type(4)));
typedef unsigned u32x4 __attribute__((ext_vector_type(4)));
constexpr int BM = 256, BK = 64, HALF = 128, HTB = HALF * BK * 2, STAGE_BYTES = 8 * HTB, NXCD = 8, WGM = 8;

__host__ __device__ __forceinline__ int lds_byte(int r, int c) { const int st = (r >> 4) * 2 + (c >> 5), rr = r & 15, cc = c & 31, ob = rr * 64 + cc * 2; return st * 1024 + (ob ^ (((ob >> 9) & 1) << 5)); }
__host__ __device__ __forceinline__ void stage_rc(int b, int& R, int& C) { const int st = b / 1024, sb = b % 1024, swz = sb ^ (((sb >> 9) & 1) << 5); R = (st >> 1) * 16 + swz / 64; C = (st & 1) * 32 + (swz % 64) / 2; }
__host__ __device__ __forceinline__ int perm32(int rho) { const int n = rho >> 4, i = rho & 15; return 8 * (i >> 2) + 4 * n + (i & 3); }

struct Unit { int pm, pn; };
struct Gemm { const bf16_t* A; const bf16_t* Bt; int M, N, K, lda; };

struct StaticOrder {
    int nM, nN, nwg, G, c;
    __host__ __device__ void init(int M_, int N_, int G_, int c_) { nM = M_ / BM; nN = N_ / BM; nwg = nM * nN; G = G_; c = c_; }
    __host__ __device__ bool next(int i, Unit& u) const {
        const long L = (long)i * G + c; if (L >= nwg) return false;
        int wgid = (int)L; { const int q = nwg / NXCD, r = nwg % NXCD, xcd = wgid % NXCD, off = wgid / NXCD; wgid = (xcd < r ? xcd * (q + 1) : r * (q + 1) + (xcd - r) * q) + off; }
        const int nig = WGM * nN, gid = wgid / nig, fm = gid * WGM, gsz = (nM - fm) < WGM ? (nM - fm) : WGM;
        u.pm = fm + ((wgid % nig) % gsz); u.pn = (wgid % nig) / gsz; return true;
    }
};

__device__ __forceinline__ unsigned cvt_pk_bf16(float lo, float hi) { unsigned r; asm volatile("v_cvt_pk_bf16_f32 %0, %1, %2" : "=v"(r) : "v"(lo), "v"(hi)); return r; }

struct EpiBf16 {
    static constexpr bool PERM = true;
    bf16_t* O; int ldc;
    __device__ __forceinline__ void operator()(const f32x4 (&acc)[2][2][4][2], const Unit& u, int wr, int wc, int fr, int fq) const {
        const int row0 = u.pm * BM + wr * 64 + fr; const int col0 = u.pn * BM + wc * 32 + 8 * fq;
#pragma unroll
        for (int ai = 0; ai < 2; ++ai)
#pragma unroll
            for (int m = 0; m < 4; ++m) { bf16_t* rowp = O + (size_t)(row0 + ai * HALF + m * 16) * ldc + col0;
#pragma unroll
                for (int bj = 0; bj < 2; ++bj) { const f32x4 v0 = acc[ai][bj][m][0], v1 = acc[ai][bj][m][1];
                    u32x4 w; w.x = cvt_pk_bf16(v0[0], v0[1]); w.y = cvt_pk_bf16(v0[2], v0[3]); w.z = cvt_pk_bf16(v1[0], v1[1]); w.w = cvt_pk_bf16(v1[2], v1[3]);
                    *(u32x4*)(rowp + bj * HALF) = w; } }
    }
};
struct EpiProj {
    static constexpr bool PERM = true;
    bf16_t* P; const float* qw; const float* kw;
    __device__ __forceinline__ void operator()(const f32x4 (&acc)[2][2][4][2], const Unit& u, int wr, int wc, int fr, int fq) const {
        const int pn = u.pn; const bool isq = pn < 2, isk = (pn == 8 || pn == 9);
        const int row0 = u.pm * BM + wr * 64 + fr;
        if (!(isq || isk)) {
            const int col0 = pn * BM + wc * 32 + 8 * fq;
#pragma unroll
            for (int ai = 0; ai < 2; ++ai)
#pragma unroll
                for (int m = 0; m < 4; ++m) { bf16_t* rowp = P + (size_t)(row0 + ai * HALF + m * 16) * PLD + col0;
#pragma unroll
                    for (int bj = 0; bj < 2; ++bj) { const f32x4 v0 = acc[ai][bj][m][0], v1 = acc[ai][bj][m][1];
                        u32x4 w; w.x = cvt_pk_bf16(v0[0], v0[1]); w.y = cvt_pk_bf16(v0[2], v0[3]); w.z = cvt_pk_bf16(v1[0], v1[1]); w.w = cvt_pk_bf16(v1[2], v1[3]);
                        *(u32x4*)(rowp + bj * HALF) = w; } }
        } else {
            const float* w = isq ? qw : kw; const float post = isq ? C2 : 1.0f;
            const int colb = pn * BM + 64 * wc + 8 * fq;
#pragma unroll
            for (int ai = 0; ai < 2; ++ai)
#pragma unroll
                for (int m = 0; m < 4; ++m) {
                    float ss = 0.f;
#pragma unroll
                    for (int bj = 0; bj < 2; ++bj)
#pragma unroll
                        for (int n = 0; n < 2; ++n) { const f32x4 x = acc[ai][bj][m][n]; ss += (x[0] * x[0] + x[1] * x[1]) + (x[2] * x[2] + x[3] * x[3]); }
                    ss += __shfl_xor(ss, 16); ss += __shfl_xor(ss, 32);
                    const float r = (1.0f / sqrtf(ss * (1.0f / 64.0f) + EPS)) * post;
                    bf16_t* rowp = P + (size_t)(row0 + ai * HALF + m * 16) * PLD + colb;
#pragma unroll
                    for (int bj = 0; bj < 2; ++bj) { const f32x4 w0 = *(const f32x4*)(w + 32 * bj + 8 * fq), w1 = *(const f32x4*)(w + 32 * bj + 8 * fq + 4);
                        const f32x4 v0 = acc[ai][bj][m][0] * r * w0, v1 = acc[ai][bj][m][1] * r * w1;
                        u32x4 o; o.x = cvt_pk_bf16(v0[0], v0[1]); o.y = cvt_pk_bf16(v0[2], v0[3]); o.z = cvt_pk_bf16(v1[0], v1[1]); o.w = cvt_pk_bf16(v1[2], v1[3]);
                        *(u32x4*)(rowp + 32 * bj) = o; }
                    asm volatile("" ::: "memory");
                }
        }
    }
};
struct EpiRes {
    static constexpr bool PERM = false;
    const float* base; float* out; int ldc;
    __device__ __forceinline__ void operator()(const f32x4 (&acc)[2][2][4][2], const Unit& u, int wr, int wc, int fr, int fq) const {
        const int row0 = u.pm * BM + wr * 64 + fr, col0 = u.pn * BM + wc * 32 + 4 * fq;
#pragma unroll
        for (int ai = 0; ai < 2; ++ai)
#pragma unroll
            for (int m = 0; m < 4; ++m) { const size_t off = (size_t)(row0 + ai * HALF + m * 16) * ldc + col0;
#pragma unroll
                for (int bj = 0; bj < 2; ++bj)
#pragma unroll
                    for (int n = 0; n < 2; ++n) { const f32x4 b = *(const f32x4*)(base + off + bj * HALF + n * 16); *(f32x4*)(out + off + bj * HALF + n * 16) = b + acc[ai][bj][m][n]; } }
    }
};

template <class Epi>
__device__ __forceinline__ void gemm_phase(PG8_LAS unsigned char* lds, const Gemm g, const StaticOrder& S, const Epi& E) {
    int tid_ = threadIdx.x; asm volatile("" : "+v"(tid_));
    const int tid = tid_, wid = __builtin_amdgcn_readfirstlane(tid >> 6), lane = tid & 63, wr = wid >> 2, wc = wid & 3, fr = lane & 15, fq = lane >> 4;
    const int K = g.K, nt = K / BK, lda = g.lda;
    unsigned voffA[2], voffB[2];
#pragma unroll
    for (int i = 0; i < 2; ++i) { int R, C; stage_rc(tid * 16 + i * 8192, R, C); const int Rb = Epi::PERM ? ((R & ~31) + perm32(R & 31)) : R;
        voffA[i] = (unsigned)(R * lda + C) * 2u; voffB[i] = (unsigned)(Rb * K + C) * 2u; }
    const size_t kstep = (size_t)(BK * 2);
    const size_t hstepA = (size_t)HALF * lda * 2, hstepB = (size_t)HALF * K * 2;
    const size_t tstepA = 2 * hstepA, tstepB = 2 * hstepB;
    const unsigned ldsw = (unsigned)wid * 1024u;
    const int aoff = lds_byte(wr * 64 + fr, fq * 8), boff = lds_byte(wc * 32 + fr, fq * 8);
#define PG8_SA(b, h) (((b) * 2 + (h)) * HTB)
#define PG8_SB(b, h) ((4 + (b) * 2 + (h)) * HTB)
#define PG8_STAGE(bufoff, gbase, voff) do { _Pragma("unroll") for (int _i = 0; _i < 2; ++_i) \
        __builtin_amdgcn_global_load_lds((const unsigned*)((const char*)(gbase) + (voff)[_i]), (PG8_LAS unsigned*)(lds + (bufoff) + ldsw + _i * 8192), 16, 0, 0); } while (0)
#define PG8_LDA(dst, b, h) do { _Pragma("unroll") for (int m = 0; m < 4; ++m) _Pragma("unroll") for (int k = 0; k < 2; ++k) dst[m][k] = *(const PG8_LAS bf16x8*)(lds + PG8_SA(b, h) + aoff + m * 2048 + k * 1024); } while (0)
#define PG8_LDB(dst, b, h) do { _Pragma("unroll") for (int n = 0; n < 2; ++n) _Pragma("unroll") for (int k = 0; k < 2; ++k) dst[n][k] = *(const PG8_LAS bf16x8*)(lds + PG8_SB(b, h) + boff + n * 2048 + k * 1024); } while (0)
#define PG8_MMA(ai, bj, At, Bt) do { __builtin_amdgcn_s_setprio(1); _Pragma("unroll") for (int m = 0; m < 4; ++m) _Pragma("unroll") for (int n = 0; n < 2; ++n) _Pragma("unroll") for (int k = 0; k < 2; ++k) \
        acc[ai][bj][m][n] = __builtin_amdgcn_mfma_f32_16x16x32_bf16(Bt[n][k], At[m][k], acc[ai][bj][m][n], 0, 0, 0); __builtin_amdgcn_s_setprio(0); } while (0)
#define PG8_WAIT_V(n) asm volatile("s_waitcnt vmcnt(" #n ")" ::: "memory")
#define PG8_WAIT_L(n) asm volatile("s_waitcnt lgkmcnt(" #n ")" ::: "memory")
#define PG8_BAR __builtin_amdgcn_s_barrier()
#define PG8_SCHED __builtin_amdgcn_sched_barrier(0)
    Unit cur, nxt; int ui = 0;
    if (!S.next(0, cur)) return;
    f32x4 acc[2][2][4][2];
#pragma unroll
    for (int a = 0; a < 2; ++a)
#pragma unroll
        for (int b = 0; b < 2; ++b)
#pragma unroll
            for (int m = 0; m < 4; ++m)
#pragma unroll
                for (int n = 0; n < 2; ++n) acc[a][b][m][n] = (f32x4){0.f, 0.f, 0.f, 0.f};
    bf16x8 At[4][2], B0[2][2], B1[2][2];
    const char* cA = (const char*)g.A + (size_t)cur.pm * tstepA; const char* cB = (const char*)g.Bt + (size_t)cur.pn * tstepB;
    PG8_STAGE(PG8_SB(0, 0), cB, voffB); PG8_STAGE(PG8_SB(0, 1), cB + hstepB, voffB); PG8_STAGE(PG8_SA(0, 0), cA, voffA); PG8_STAGE(PG8_SA(0, 1), cA + hstepA, voffA);
    if (wr == 1) PG8_BAR;
    PG8_WAIT_V(2); PG8_BAR;
    PG8_STAGE(PG8_SB(1, 0), cB + kstep, voffB); PG8_STAGE(PG8_SA(1, 0), cA + kstep, voffA); PG8_STAGE(PG8_SB(1, 1), cB + hstepB + kstep, voffB);
    PG8_WAIT_V(6); PG8_BAR;
    for (;;) {
        const bool has_next = S.next(ui + 1, nxt);
        const char* nA = has_next ? (const char*)g.A + (size_t)nxt.pm * tstepA : cA; const char* nB = has_next ? (const char*)g.Bt + (size_t)nxt.pn * tstepB : cB;
        for (int t = 0; t < nt; t += 2) {
            const bool last = (t == nt - 2);
            const char* a1 = cA + (size_t)(t + 1) * kstep;
            const char* a2 = last ? nA : cA + (size_t)(t + 2) * kstep; const char* b2 = last ? nB : cB + (size_t)(t + 2) * kstep;
            const char* a3 = a2 + kstep; const char* b3 = b2 + kstep;
            PG8_LDB(B0, 0, 0); PG8_LDB(B1, 0, 1); PG8_SCHED; PG8_LDA(At, 0, 0); PG8_STAGE(PG8_SA(1, 1), a1 + hstepA, voffA);
            PG8_WAIT_V(8); PG8_WAIT_L(0); PG8_BAR; PG8_MMA(0, 0, At, B0); PG8_MMA(0, 1, At, B1); PG8_BAR; PG8_SCHED;
            PG8_LDA(At, 0, 1); PG8_STAGE(PG8_SB(0, 0), b2, voffB); PG8_STAGE(PG8_SB(0, 1), b2 + hstepB, voffB); PG8_STAGE(PG8_SA(0, 0), a2, voffA);
            PG8_WAIT_V(8); PG8_WAIT_L(0); PG8_BAR; PG8_MMA(1, 0, At, B0); PG8_MMA(1, 1, At, B1); PG8_BAR; PG8_SCHED;
            PG8_LDB(B0, 1, 0); PG8_LDB(B1, 1, 1); PG8_SCHED; PG8_LDA(At, 1, 0); PG8_STAGE(PG8_SA(0, 1), a2 + hstepA, voffA);
            PG8_WAIT_V(8); PG8_WAIT_L(0); PG8_BAR; PG8_MMA(0, 0, At, B0); PG8_MMA(0, 1, At, B1); PG8_BAR; PG8_SCHED;
            PG8_LDA(At, 1, 1); PG8_STAGE(PG8_SB(1, 0), b3, voffB); PG8_STAGE(PG8_SB(1, 1), b3 + hstepB, voffB); PG8_STAGE(PG8_SA(1, 0), a3, voffA);
            PG8_WAIT_V(8); PG8_WAIT_L(0); PG8_BAR; PG8_MMA(1, 0, At, B0); PG8_MMA(1, 1, At, B1); PG8_BAR; PG8_SCHED;
        }
        if (wr == 0) PG8_BAR;
        E(acc, cur, wr, wc, fr, fq);
        if (!has_next) break;
#pragma unroll
        for (int a = 0; a < 2; ++a)
#pragma unroll
            for (int b = 0; b < 2; ++b)
#pragma unroll
                for (int m = 0; m < 4; ++m)
#pragma unroll
                    for (int n = 0; n < 2; ++n) acc[a][b][m][n] = (f32x4){0.f, 0.f, 0.f, 0.f};
        cur = nxt; cA = nA; cB = nB; ++ui;
        if (wr == 1) PG8_BAR;
    }
    PG8_WAIT_V(0);
    PG8_BAR;
#undef PG8_SA
#undef PG8_SB
#undef PG8_STAGE
#undef PG8_LDA
#undef PG8_LDB
#undef PG8_MMA
#undef PG8_WAIT_V
#undef PG8_WAIT_L
#undef PG8_BAR
#undef PG8_SCHED
}
}

constexpr int NWAVES = 8;
constexpr int RING_OFF = 0, RING_BYTES = 131072;
constexpr int LDSCTL_OFF = RING_BYTES, MISC_OFF = LDSCTL_OFF + 320;
constexpr int LDS_BYTES = 147456;
constexpr int CW_BAR = 4096;

#define GAS __attribute__((address_space(1)))
#define LAS __attribute__((address_space(3)))
typedef unsigned short bf16;
typedef unsigned v4u __attribute__((ext_vector_type(4)));
typedef float f32x4 __attribute__((ext_vector_type(4)));
typedef GAS unsigned gu32;
#define RLX_AGENT __ATOMIC_RELAXED, __HIP_MEMORY_SCOPE_AGENT
#define LDS_WAIT() asm volatile("s_waitcnt lgkmcnt(0)" ::: "memory")
#define VM_WAIT() asm volatile("s_waitcnt vmcnt(0)" ::: "memory")
__device__ __forceinline__ unsigned f2bf(float f) { unsigned u = __builtin_bit_cast(unsigned, f); return (u + 0x7fffu + ((u >> 16) & 1u)) >> 16; }
__device__ __forceinline__ unsigned pk2(float lo, float hi) { return f2bf(lo) | (f2bf(hi) << 16); }
__device__ __forceinline__ float bf2f(unsigned short b) { return __uint_as_float(((unsigned)b) << 16); }

#define XB_TMO      128
#define XB_XCNT(j)  (256  + 64 * (j))
#define XB_XSUB(j)  (1280 + 64 * (j))
#define XB_XGEN(j)  (2304 + 64 * (j))
#define XB_TOP      3328
#define XB_TOPGEN   3392
#define XCD_BAR_WORDS 3456
#define XB_SPIN_CAP (1u << 18)
__device__ __forceinline__ unsigned xb_ld(unsigned* p)              { return __hip_atomic_load(p, __ATOMIC_RELAXED, __HIP_MEMORY_SCOPE_AGENT); }
__device__ __forceinline__ unsigned xb_add(unsigned* p, unsigned v) { return __hip_atomic_fetch_add(p, v, __ATOMIC_RELAXED, __HIP_MEMORY_SCOPE_AGENT); }
__device__ __forceinline__ unsigned xb_xcc_id() { return (unsigned)__builtin_amdgcn_s_getreg((3 << 11) | 20) & 0xFu; }
#define XB_SPIN(cond, bar) do { unsigned _sp = 0; while (cond) { __builtin_amdgcn_s_sleep(1); \
    if ((++_sp & 255u) == 0u) { if (xb_ld(&(bar)[XB_TMO])) break; if (_sp > XB_SPIN_CAP) { atomicAdd(&(bar)[XB_TMO], 1u); break; } } } } while (0)
struct XcdBarrier { unsigned* bar; unsigned x; volatile LAS unsigned* st; };
__device__ __forceinline__ XcdBarrier xcd_barrier_post(unsigned* bar, volatile LAS unsigned* st) {
    XcdBarrier b; b.bar = bar; b.x = xb_xcc_id(); b.st = st;
    if (threadIdx.x == 0) (void)xb_add(&bar[XB_XCNT(b.x)], 1u);
    return b;
}
__device__ __forceinline__ void xcd_barrier_complete(unsigned* bar, unsigned x, unsigned& nloc, unsigned& nx) {
    const unsigned G = gridDim.x * gridDim.y * gridDim.z;
    unsigned sum, cnt, mine, sp = 0u;
    for (;;) {
        sum = 0u; cnt = 0u; mine = 0u;
#pragma unroll
        for (unsigned j = 0; j < 16; ++j) { const unsigned c = xb_ld(&bar[XB_XCNT(j)]); sum += c; cnt += (c > 0u) ? 1u : 0u; mine = (j == x) ? c : mine; }
        if (sum == G) break;
        __builtin_amdgcn_s_sleep(1);
        if ((++sp & 255u) == 0u) { if (xb_ld(&bar[XB_TMO])) break; if (sp > XB_SPIN_CAP) { atomicAdd(&bar[XB_TMO], 1u); break; } }
    }
    nloc = mine > 0u ? mine : 1u; nx = cnt > 0u ? cnt : 1u;
}
__device__ __forceinline__ void xcd_barrier(const XcdBarrier& b) {
    asm volatile("s_waitcnt vmcnt(0)" ::: "memory");
    __syncthreads();
    if (threadIdx.x == 0) {
        unsigned* bar = b.bar;
        __builtin_amdgcn_s_waitcnt(0);
        unsigned nloc = b.st[0], nx = b.st[1];
        if (nloc == 0u) { xcd_barrier_complete(bar, b.x, nloc, nx); b.st[0] = nloc; b.st[1] = nx; }
        const unsigned old = xb_add(&bar[XB_XSUB(b.x)], 1u);
        const unsigned gen = old / nloc;
        if (old + 1u == (gen + 1u) * nloc) {
            __builtin_amdgcn_fence(__ATOMIC_RELEASE, "agent");
            asm volatile("s_waitcnt vmcnt(0)" ::: "memory");
            const unsigned og = xb_add(&bar[XB_TOP], 1u);
            const unsigned tg = og / nx;
            if (og + 1u == (tg + 1u) * nx) xb_add(&bar[XB_TOPGEN], 1u);
            else XB_SPIN(xb_ld(&bar[XB_TOPGEN]) == tg, bar);
            __builtin_amdgcn_fence(__ATOMIC_ACQUIRE, "agent");
            xb_add(&bar[XB_XGEN(b.x)], 1u);
            asm volatile("s_waitcnt vmcnt(0)" ::: "memory");
        } else {
            XB_SPIN(xb_ld(&bar[XB_XGEN(b.x)]) == gen, bar);
            __builtin_amdgcn_fence(__ATOMIC_ACQUIRE, "agent");
            asm volatile("s_waitcnt vmcnt(0)" ::: "memory");
        }
    }
    __syncthreads();
}

struct Args { const float* in[22]; float* out; unsigned char* ws; int ph_lo, ph_hi; };

struct Frame {
    LAS unsigned char* lds;
    gu32* ctl;
    int tid, lane, wave;
    int vcu, G;
};

__device__ __forceinline__ float wave_sum(float v) {
#pragma unroll
    for (int o = 1; o < 64; o <<= 1) v += __shfl_xor(v, o);
    return v;
}

__device__ __forceinline__ void conv_item(const float* W, int ldw, int srccol0, bf16* WT, int K, int dstrow0, int k0, LAS float* scr, int lane) {
#pragma unroll 8
    for (int i = 0; i < 32; ++i) { const int kk = 2 * i + (lane >> 5); scr[kk * 33 + (lane & 31)] = W[(size_t)(k0 + kk) * ldw + srccol0 + (lane & 31)]; }
    LDS_WAIT(); asm volatile("" ::: "memory");
    const int c = lane & 7;
#pragma unroll
    for (int j = 0; j < 4; ++j) { const int n = (lane >> 3) + 8 * j; const LAS float* s = scr + (8 * c) * 33 + n;
        v4u o; o.x = pk2(s[0 * 33], s[1 * 33]); o.y = pk2(s[2 * 33], s[3 * 33]); o.z = pk2(s[4 * 33], s[5 * 33]); o.w = pk2(s[6 * 33], s[7 * 33]);
        *(GAS v4u*)(WT + (size_t)(dstrow0 + n) * K + k0 + 8 * c) = o; }
    LDS_WAIT(); asm volatile("" ::: "memory");
}
__device__ __forceinline__ int in_src_col(int n0) {
    const int tile = n0 >> 8, p = n0 & 255; int dest;
    if (tile < 2 || tile == 8 || tile == 9) { const int bj = p >> 7, wc = (p >> 5) & 3; dest = (tile << 8) + 64 * wc + 32 * bj; } else dest = n0;
    if (dest < PC_Z) return SC_Q + dest;
    if (dest < PC_MO) return SC_Z + dest - PC_Z;
    if (dest < PC_K) return SC_MO + dest - PC_MO;
    if (dest < PC_V) return SC_K + dest - PC_K;
    if (dest < PC_XBC) return SC_V + dest - PC_V;
    if (dest < PC_MQK) return SC_XBC + dest - PC_XBC;
    if (dest < PC_MV) return SC_MQK + dest - PC_MQK;
    return SC_MV + dest - PC_MV;
}
__device__ __forceinline__ void convert_weights(Frame& F, int which, const float* Wa, const float* Wb, bf16* bufa, bf16* bufb, LAS float* scr) {
    const int gw = F.vcu * NWAVES + F.wave, NGW = F.G * NWAVES;
    if (which == 0) {
        constexpr int IA = (DM / 64) * (PLD / 32), IB = (DMIX / 64) * (DM / 32);
        for (int it = gw; it < IA + IB; it += NGW) {
            if (it < IA) { const int nblk = PLD / 32, kb = it / nblk, nb = it % nblk; conv_item(Wa, P_IN, in_src_col(32 * nb), bufa, DM, 32 * nb, 64 * kb, scr, F.lane); }
            else { const int r = it - IA, nblk = DM / 32, kb = r / nblk, nb = r % nblk; conv_item(Wb, DM, 32 * nb, bufb, DMIX, 32 * nb, 64 * kb, scr, F.lane); }
        }
    } else {
        constexpr int IA = (DM / 64) * (ULD / 32), IB = (FFN / 64) * (DM / 32);
        for (int it = gw; it < IA + IB; it += NGW) {
            if (it < IA) { const int nblk = ULD / 32, kb = it / nblk, nb = it % nblk; conv_item(Wa, ULD, 32 * nb, bufa, DM, 32 * nb, 64 * kb, scr, F.lane); }
            else { const int r = it - IA, nblk = DM / 32, kb = r / nblk, nb = r % nblk; conv_item(Wb, DM, 32 * nb, bufb, FFN, 32 * nb, 64 * kb, scr, F.lane); }
        }
    }
}
__device__ __forceinline__ void row_pass(Frame& F, const float* x, const float* nw, bf16* xb, const float* w_in  , float* smallp, LAS float* wsm  ) {
    if (w_in) {
        for (int k = F.tid; k < DM; k += NWAVES * 64) {
            const float* src = w_in + (size_t)k * P_IN;
#pragma unroll
            for (int c = 0; c < 16; ++c) wsm[c * DM + k] = src[SC_DT + c];
#pragma unroll
            for (int c = 0; c < 8; ++c) wsm[(16 + c) * DM + k] = src[SC_MI + c];
        }
        LDS_WAIT(); __syncthreads();
    }
    const int gw = F.vcu * NWAVES + F.wave, NGW = F.G * NWAVES;
    f32x4 wv[4];
#pragma unroll
    for (int j = 0; j < 4; ++j) wv[j] = ((const GAS f32x4*)nw)[64 * j + F.lane];
    for (int m = gw; m < M; m += NGW) {
        const GAS f32x4* xr = (const GAS f32x4*)(x + (size_t)m * DM) + F.lane;
        f32x4 v[4]; float s = 0.f;
#pragma unroll
        for (int j = 0; j < 4; ++j) { v[j] = xr[64 * j]; s += (v[j].x * v[j].x + v[j].y * v[j].y) + (v[j].z * v[j].z + v[j].w * v[j].w); }
        const float r = 1.0f / sqrtf(wave_sum(s) * (1.0f / DM) + EPS);
#pragma unroll
        for (int j = 0; j < 4; ++j) v[j] = v[j] * r * wv[j];
        GAS unsigned long long* o8 = (GAS unsigned long long*)(xb + (size_t)m * DM) + F.lane;
#pragma unroll
        for (int j = 0; j < 4; ++j) o8[64 * j] = (unsigned long long)pk2(v[j].x, v[j].y) | ((unsigned long long)pk2(v[j].z, v[j].w) << 32);
        if (w_in) {
            float mine = 0.f;
            for (int c = 0; c < 24; ++c) {
                float d = 0.f;
#pragma unroll
                for (int j = 0; j < 4; ++j) { const f32x4 w4 = *(const LAS f32x4*)(wsm + c * DM + 4 * (64 * j + F.lane)); d += (v[j].x * w4.x + v[j].y * w4.y) + (v[j].z * w4.z + v[j].w * w4.w); }
                d = wave_sum(d);
                if (F.lane == c) mine = d;
            }
            if (F.lane < 24) smallp[(size_t)m * 24 + F.lane] = mine;
        }
    }
}
__device__ __forceinline__ void ssd_finalize(Frame& F, bf16* proj, const float* ssq, const float* nw) {
    const int gt = F.vcu * (NWAVES * 64) + F.tid, NT = F.G * NWAVES * 64;
    for (int it = gt; it < M * 128; it += NT) {
        const int row = it >> 7, c0 = (it & 127) * 8, g = c0 >> 9;
        float s = 0.f;
#pragma unroll
        for (int h = 0; h < 8; ++h) s += ssq[(size_t)row * 16 + g * 8 + h];
        const float r = 1.0f / sqrtf(s * (1.0f / 512.0f) + EPS);
        v4u* p = (v4u*)(proj + (size_t)row * PLD + PC_Z + c0);
        v4u v = *p; const f32x4 w0 = *(const f32x4*)(nw + c0), w1 = *(const f32x4*)(nw + c0 + 4);
        v4u o;
        o.x = pk2(bf2f(v.x & 0xffff) * r * w0.x, bf2f(v.x >> 16) * r * w0.y); o.y = pk2(bf2f(v.y & 0xffff) * r * w0.z, bf2f(v.y >> 16) * r * w0.w);
        o.z = pk2(bf2f(v.z & 0xffff) * r * w1.x, bf2f(v.z >> 16) * r * w1.y); o.w = pk2(bf2f(v.w & 0xffff) * r * w1.z, bf2f(v.w >> 16) * r * w1.w);
        *p = o;
    }
}
__device__ __forceinline__ void ffn_ew(Frame& F, bf16* u, const float* cw  , const float* cb) {
    const int gt = F.vcu * (NWAVES * 64) + F.tid, NT = F.G * NWAVES * 64;
    constexpr int CPR = FFN / 8;
    for (int it = gt; it < M * CPR; it += NT) {
        const int row = it / CPR, c0 = (it % CPR) * 8, t = row & (SEQ - 1);
        const bf16* g0 = u + (size_t)row * ULD + c0;
        v4u a2 = *(const v4u*)g0, a1 = (v4u){0, 0, 0, 0}, a0 = (v4u){0, 0, 0, 0};
        if (t >= 1) a1 = *(const v4u*)(g0 - ULD);
        if (t >= 2) a0 = *(const v4u*)(g0 - 2 * ULD);
        const v4u vv = *(const v4u*)(g0 + FFN);
        float o[8];
#pragma unroll
        for (int i = 0; i < 8; ++i) {
            const unsigned w2 = a2[i >> 1], w1 = a1[i >> 1], w0 = a0[i >> 1], wv = vv[i >> 1];
            const float x2 = (i & 1) ? bf2f(w2 >> 16) : bf2f(w2 & 0xffff), x1 = (i & 1) ? bf2f(w1 >> 16) : bf2f(w1 & 0xffff), x0 = (i & 1) ? bf2f(w0 >> 16) : bf2f(w0 & 0xffff);
            const float val = (i & 1) ? bf2f(wv >> 16) : bf2f(wv & 0xffff);
            const float gt_ = cw[c0 + i] * x0 + cw[FFN + c0 + i] * x1 + cw[2 * FFN + c0 + i] * x2 + cb[c0 + i];
            o[i] = 0.5f * gt_ * (1.0f + erff(gt_ * 0.70710678118654752f)) * val;
        }
        v4u ov; ov.x = pk2(o[0], o[1]); ov.y = pk2(o[2], o[3]); ov.z = pk2(o[4], o[5]); ov.w = pk2(o[6], o[7]);
        *(v4u*)(u + (size_t)row * ULD + FFN + c0) = ov;
    }
}

constexpr int PH_PER_LAYER = 9, N_PHASES = PH_PER_LAYER * DEPTH;

__global__ void __launch_bounds__(NWAVES * 64, 2) fwd(Args args) {
    extern __shared__ __attribute__((aligned(16))) unsigned char lds[];
    Frame F;
    F.lds = (LAS unsigned char*)lds;
    F.tid = threadIdx.x; F.lane = F.tid & 63; F.wave = __builtin_amdgcn_readfirstlane(F.tid >> 6);
    F.G = gridDim.x; { const int bx = blockIdx.x; F.vcu = (F.G % 8 == 0) ? (bx % 8) * (F.G / 8) + bx / 8 : bx; }
    unsigned char* ws = args.ws;
    F.ctl = (gu32*)(ws + WS_CTL);
    for (int u = F.tid; u < (LDS_BYTES - LDSCTL_OFF) / 4; u += NWAVES * 64) ((LAS unsigned*)(F.lds + LDSCTL_OFF))[u] = 0u;
    __syncthreads();
    volatile LAS unsigned* MISC = (volatile LAS unsigned*)(F.lds + MISC_OFF);
    XcdBarrier bar; bar.bar = (unsigned*)(F.ctl + CW_BAR); bar.x = 0; bar.st = nullptr;
    const bool multi = (args.ph_hi - args.ph_lo) > 1;
    if (multi) bar = xcd_barrier_post((unsigned*)(F.ctl + CW_BAR), MISC + 8);

    bf16* bufa = (bf16*)(ws + WS_BUFA); bf16* bufb = (bf16*)(ws + WS_BUFB); bf16* xb = (bf16*)(ws + WS_XB); bf16* proj = (bf16*)(ws + WS_PROJ);
    float* smallp = (float*)(ws + WS_SMALLP); float* ssq = (float*)(ws + WS_SSQ);
    float* out = args.out;

    for (int ph = args.ph_lo; ph < args.ph_hi; ++ph) {
        const int l = ph / PH_PER_LAYER, p = ph % PH_PER_LAYER;
        { int t_ = threadIdx.x; asm volatile("" : "+v"(t_)); F.tid = t_; F.lane = t_ & 63; F.wave = __builtin_amdgcn_readfirstlane(t_ >> 6); }
        const float* xin = (l == 0) ? args.in[0] : out;
        switch (p) {
        case 0: {
            convert_weights(F, 0, args.in[2] + (size_t)l * DM * P_IN, args.in[16] + (size_t)l * DMIX * DM, bufa, bufb, (LAS float*)(F.lds + F.wave * 16384));
            __syncthreads();
            row_pass(F, xin, args.in[1] + l * DM, xb, args.in[2] + (size_t)l * DM * P_IN, smallp, (LAS float*)(F.lds));
        } break;
        case 1: {
            pg8::Gemm g{xb, bufa, M, PLD, DM, DM}; pg8::StaticOrder S; S.init(M, PLD, F.G, (int)blockIdx.x);
            pg8::EpiProj E{proj, args.in[3] + l * 64, args.in[4] + l * 64};
            pg8::gemm_phase<pg8::EpiProj>(F.lds + RING_OFF, g, S, E);
        } break;
        case 2: break;
        case 3: ssd_finalize(F, proj, ssq, args.in[10] + l * 1024); break;
        case 4: {
            pg8::Gemm g{proj, bufb, M, DM, DMIX, PLD}; pg8::StaticOrder S; S.init(M, DM, F.G, (int)blockIdx.x);
            pg8::EpiRes E{xin, out, DM};
            pg8::gemm_phase<pg8::EpiRes>(F.lds + RING_OFF, g, S, E);
        } break;
        case 5: {
            convert_weights(F, 1, args.in[18] + (size_t)l * DM * ULD, args.in[21] + (size_t)l * FFN * DM, bufa, bufb, (LAS float*)(F.lds + F.wave * 16384));
            __syncthreads();
            row_pass(F, out, args.in[17] + l * DM, xb, nullptr, nullptr, nullptr);
        } break;
        case 6: {
            pg8::Gemm g{xb, bufa, M, ULD, DM, DM}; pg8::StaticOrder S; S.init(M, ULD, F.G, (int)blockIdx.x);
            pg8::EpiBf16 E{proj, ULD};
            pg8::gemm_phase<pg8::EpiBf16>(F.lds + RING_OFF, g, S, E);
        } break;
        case 7: ffn_ew(F, proj, args.in[19] + (size_t)l * 3 * FFN, args.in[20] + l * FFN); break;
        case 8: {
            pg8::Gemm g{proj + FFN, bufb, M, DM, FFN, ULD}; pg8::StaticOrder S; S.init(M, DM, F.G, (int)blockIdx.x);
            pg8::EpiRes E{out, out, DM};
            pg8::gemm_phase<pg8::EpiRes>(F.lds + RING_OFF, g, S, E);
        } break;
        }
        if (ph + 1 < args.ph_hi) xcd_barrier(bar);
    }
}

__device__ __forceinline__ float silu_f(float x) { return x / (1.0f + __expf(-x)); }

__global__ void __launch_bounds__(256) naive_attn(bf16* proj) {
    __shared__ float sK[128][64];
    __shared__ float sV[128][64];
    const int tid = threadIdx.x, qb = blockIdx.x & 7, h = (blockIdx.x >> 3) & 7, b = blockIdx.x >> 6;
    const int t = qb * 256 + tid; const size_t rowq = (size_t)b * SEQ + t;
    float q[64];
    { const v4u* qp = (const v4u*)(proj + rowq * PLD + PC_Q + h * 64);
#pragma unroll
      for (int i = 0; i < 8; ++i) { const v4u v = qp[i];
#pragma unroll
          for (int j = 0; j < 4; ++j) { q[i * 8 + 2 * j] = bf2f(v[j] & 0xffff); q[i * 8 + 2 * j + 1] = bf2f(v[j] >> 16); } } }
    unsigned sel = (1u << qb) - 1u;
    if (qb >= 4) {
        float g[8];
        float* part = &sV[0][0];
        float* km = &sV[8][0];
#pragma unroll
        for (int n = 0; n < 8; ++n) { if (n < qb) {
            const int d = tid & 63, pt = tid >> 6; float s = 0.f;
            for (int r = 0; r < 64; ++r) s += bf2f(proj[((size_t)b * SEQ + n * 256 + pt * 64 + r) * PLD + PC_K + h * 64 + d]);
            __syncthreads();
            part[pt * 64 + d] = s;
            __syncthreads();
            if (tid < 64) km[tid] = (part[tid] + part[64 + tid] + part[128 + tid] + part[192 + tid]) * (1.0f / 256.0f);
            __syncthreads();
            float gg = 0.f;
#pragma unroll
            for (int dd = 0; dd < 64; ++dd) gg += q[dd] * km[dd];
            g[n] = gg;
        } else g[n] = 0.f; }
        __syncthreads();
        sel = 0u;
#pragma unroll
        for (int k = 0; k < 3; ++k) { int best = -1; float bv = 0.f;
#pragma unroll
            for (int n = 0; n < 8; ++n) if (n < qb && !((sel >> n) & 1u)) { if (best < 0 || g[n] > bv) { best = n; bv = g[n]; } }
            sel |= 1u << best; }
    }
    float acc[64];
#pragma unroll
    for (int i = 0; i < 64; ++i) acc[i] = 0.f;
    float mx = -INFINITY, l = 0.f;
    for (int n = 0; n <= qb; ++n) {
        for (int hf = 0; hf < 2; ++hf) {
            __syncthreads();
            for (int i = tid; i < 128 * 8; i += 256) { const int r = i >> 3, c = i & 7; const size_t row = (size_t)b * SEQ + n * 256 + hf * 128 + r;
                const v4u kv = *(const v4u*)(proj + row * PLD + PC_K + h * 64 + c * 8), vv = *(const v4u*)(proj + row * PLD + PC_V + h * 64 + c * 8);
#pragma unroll
                for (int j = 0; j < 4; ++j) { sK[r][c * 8 + 2 * j] = bf2f(kv[j] & 0xffff); sK[r][c * 8 + 2 * j + 1] = bf2f(kv[j] >> 16); sV[r][c * 8 + 2 * j] = bf2f(vv[j] & 0xffff); sV[r][c * 8 + 2 * j + 1] = bf2f(vv[j] >> 16); } }
            __syncthreads();
            const bool blk_ok = (n == qb) || ((sel >> n) & 1u);
            for (int j = 0; j < 128; ++j) {
                const int kp = n * 256 + hf * 128 + j;
                const bool valid = blk_ok && (n < qb || kp <= t);
                if (valid) {
                    float s = 0.f;
#pragma unroll
                    for (int d = 0; d < 64; ++d) s += q[d] * sK[j][d];
                    if (s > mx) { const float sc = exp2f(mx - s); l *= sc;
#pragma unroll
                        for (int d = 0; d < 64; ++d) acc[d] *= sc;
                        mx = s; }
                    const float pw = exp2f(s - mx); l += pw;
#pragma unroll
                    for (int d = 0; d < 64; ++d) acc[d] += pw * sV[j][d];
                }
            }
        }
    }
    const float inv = 1.0f / l;
    v4u* op = (v4u*)(proj + rowq * PLD + PC_Q + h * 64);
#pragma unroll
    for (int i = 0; i < 8; ++i) { v4u o; o.x = pk2(acc[i * 8] * inv, acc[i * 8 + 1] * inv); o.y = pk2(acc[i * 8 + 2] * inv, acc[i * 8 + 3] * inv); o.z = pk2(acc[i * 8 + 4] * inv, acc[i * 8 + 5] * inv); o.w = pk2(acc[i * 8 + 6] * inv, acc[i * 8 + 7] * inv); op[i] = o; }
}

__global__ void __launch_bounds__(256) naive_ssd(bf16* proj, const float* smallp, float* ssq, const float* conv_w  , const float* conv_b, const float* dt_bias, const float* a_log, const float* dskip) {
    constexpr int TB = 32;
    __shared__ float xa[TB][64];
    __shared__ float Ba[TB][128];
    __shared__ float Ca[TB][128];
    __shared__ float ys[TB][64];
    __shared__ float dta[TB];
    const int tid = threadIdx.x, h = blockIdx.x & 15, b = blockIdx.x >> 4, g = h >> 3;
    const int p = tid >> 2, nq = tid & 3;
    const float a = -__expf(a_log[h]), dsk = dskip[h], dtb = dt_bias[h];
    float st[32];
#pragma unroll
    for (int i = 0; i < 32; ++i) st[i] = 0.f;
    for (int t0 = 0; t0 < SEQ; t0 += TB) {
        __syncthreads();
        for (int i = tid; i < TB * 320; i += 256) {
            const int tt = i / 320, cc = i % 320; const int t = t0 + tt;
            int ch; if (cc < 64) ch = h * 64 + cc; else if (cc < 192) ch = 1024 + g * 128 + (cc - 64); else ch = 1280 + g * 128 + (cc - 192);
            float s = conv_b[ch];
#pragma unroll
            for (int j = 0; j < 4; ++j) { const int ts = t - 3 + j; if (ts >= 0) s += conv_w[j * 1536 + ch] * bf2f(proj[((size_t)b * SEQ + ts) * PLD + PC_XBC + ch]); }
            s = silu_f(s);
            if (cc < 64) xa[tt][cc] = s; else if (cc < 192) Ba[tt][cc - 64] = s; else Ca[tt][cc - 192] = s;
        }
        if (tid < TB) { const float v = smallp[((size_t)b * SEQ + t0 + tid) * 24 + h] + dtb; dta[tid] = (v > 20.f) ? v : log1pf(__expf(v)); }
        __syncthreads();
        for (int tt = 0; tt < TB; ++tt) {
            const float dt = dta[tt], dA = __expf(dt * a), xv = xa[tt][p], dtx = dt * xv;
            float y = 0.f;
#pragma unroll
            for (int i = 0; i < 32; ++i) { st[i] = st[i] * dA + dtx * Ba[tt][nq * 32 + i]; y += Ca[tt][nq * 32 + i] * st[i]; }
            y += __shfl_xor(y, 1); y += __shfl_xor(y, 2);
            if (nq == 0) ys[tt][p] = y + dsk * xv;
        }
        __syncthreads();
        {
            const int tt = tid >> 3, pq = tid & 7; const size_t row = (size_t)b * SEQ + t0 + tt;
            bf16* zp = proj + row * PLD + PC_Z + h * 64 + pq * 8;
            const v4u zv = *(const v4u*)zp; float o[8]; float ss = 0.f;
#pragma unroll
            for (int i = 0; i < 8; ++i) { const unsigned w = zv[i >> 1]; const float z = (i & 1) ? bf2f(w >> 16) : bf2f(w & 0xffff); o[i] = ys[tt][pq * 8 + i] * silu_f(z); ss += o[i] * o[i]; }
            ss += __shfl_xor(ss, 1); ss += __shfl_xor(ss, 2); ss += __shfl_xor(ss, 4);
            v4u ov; ov.x = pk2(o[0], o[1]); ov.y = pk2(o[2], o[3]); ov.z = pk2(o[4], o[5]); ov.w = pk2(o[6], o[7]);
            *(v4u*)zp = ov;
            if (pq == 0) ssq[row * 16 + h] = ss;
        }
    }
}

__global__ void __launch_bounds__(512) naive_mlstm(bf16* proj, const float* smallp, const float* conv_w  , const float* conv_b, const float* i_bias, const float* f_bias, const float* norm_w) {
    constexpr int TB = 16;
    __shared__ float qa[TB][128];
    __shared__ float ka[TB][128];
    __shared__ float va[TB][128];
    __shared__ float hs[TB][128];
    __shared__ float lia[TB], lfa[TB];
    const int tid = threadIdx.x, hd = blockIdx.x & 3, b = blockIdx.x >> 2;
    const int d = tid >> 2, eq = tid & 3;
    const float ib = i_bias[hd], fb = f_bias[hd];
    float C[32], nn[32];
#pragma unroll
    for (int i = 0; i < 32; ++i) { C[i] = 0.f; nn[i] = 0.f; }
    float mst = 0.f;
    for (int t0 = 0; t0 < SEQ; t0 += TB) {
        __syncthreads();
        for (int i = tid; i < TB * 256; i += 512) {
            const int tt = i >> 8, cc = i & 255; const int t = t0 + tt;
            const int ch = (cc < 128) ? (hd * 128 + cc) : (512 + hd * 128 + (cc - 128));
            float s = conv_b[ch];
#pragma unroll
            for (int j = 0; j < 4; ++j) { const int ts = t - 3 + j; if (ts >= 0) s += conv_w[j * 1024 + ch] * bf2f(proj[((size_t)b * SEQ + ts) * PLD + PC_MQK + ch]); }
            s = silu_f(s);
            if (cc < 128) qa[tt][cc] = s; else ka[tt][cc - 128] = s * 0.08838834764831845f;
        }
        for (int i = tid; i < TB * 128; i += 512) { const int tt = i >> 7, cc = i & 127; va[tt][cc] = bf2f(proj[((size_t)b * SEQ + t0 + tt) * PLD + PC_MV + hd * 128 + cc]); }
        if (tid < TB) { const size_t row = (size_t)b * SEQ + t0 + tid; lia[tid] = smallp[row * 24 + 16 + hd] + ib; const float fv = smallp[row * 24 + 20 + hd] + fb;
            lfa[tid] = (fv >= 0.f) ? -log1pf(__expf(-fv)) : (fv - log1pf(__expf(fv))); }
        __syncthreads();
        for (int tt = 0; tt < TB; ++tt) {
            const float li = lia[tt], lf = lfa[tt];
            const float mn = fmaxf(lf + mst, li), fi = __expf(li - mn), ff = __expf(lf + mst - mn); mst = mn;
            const float iv = fi * va[tt][d];
            float num = 0.f, den = 0.f;
#pragma unroll
            for (int i = 0; i < 32; ++i) { const float kk = ka[tt][eq * 32 + i], qq = qa[tt][eq * 32 + i];
                C[i] = ff * C[i] + iv * kk; nn[i] = ff * nn[i] + fi * kk; num += C[i] * qq; den += nn[i] * qq; }
            num += __shfl_xor(num, 1); num += __shfl_xor(num, 2); den += __shfl_xor(den, 1); den += __shfl_xor(den, 2);
            if (eq == 0) hs[tt][d] = num / fmaxf(fabsf(den), __expf(-mn));
        }
        __syncthreads();
        if (tid < TB * 16) {
            const int tt = tid >> 4, dq = tid & 15; const size_t row = (size_t)b * SEQ + t0 + tt;
            float hv[8]; float ss = 0.f;
#pragma unroll
            for (int i = 0; i < 8; ++i) { hv[i] = hs[tt][dq * 8 + i]; ss += hv[i] * hv[i]; }
            ss += __shfl_xor(ss, 1); ss += __shfl_xor(ss, 2); ss += __shfl_xor(ss, 4); ss += __shfl_xor(ss, 8);
            const float r = 1.0f / sqrtf(ss * (1.0f / 128.0f) + EPS);
            bf16* op = proj + row * PLD + PC_MO + hd * 128 + dq * 8;
            const v4u ov_ = *(const v4u*)op; float o[8];
#pragma unroll
            for (int i = 0; i < 8; ++i) { const unsigned w = ov_[i >> 1]; const float og = (i & 1) ? bf2f(w >> 16) : bf2f(w & 0xffff);
                o[i] = hv[i] * r * norm_w[hd * 128 + dq * 8 + i] * (1.0f / (1.0f + __expf(-og))); }
            v4u ov; ov.x = pk2(o[0], o[1]); ov.y = pk2(o[2], o[3]); ov.z = pk2(o[4], o[5]); ov.w = pk2(o[6], o[7]);
            *(v4u*)op = ov;
        }
    }
}

extern "C" void kernel_launch(void* const* d_in, const int* in_sizes, int n_in, void* d_out, int out_size, void* d_ws, size_t ws_size, hipStream_t stream) {
    static int grid = 0;
    if (grid == 0) {
        if (n_in != 22 || in_sizes[0] != M * DM || out_size != M * DM || ws_size < WS_END) { fprintf(stderr, "kernel_launch: unexpected shapes (n_in %d, in0 %d, out %d, ws %zu); nothing launched\n", n_in, n_in > 0 ? in_sizes[0] : -1, out_size, ws_size); grid = -1; return; }
        int dev = 0, cus = 0, per_cu = 0;
        if (hipGetDevice(&dev) != hipSuccess || hipDeviceGetAttribute(&cus, hipDeviceAttributeMultiprocessorCount, dev) != hipSuccess) { grid = -1; return; }
        if (hipFuncSetAttribute((const void*)fwd, hipFuncAttributeMaxDynamicSharedMemorySize, LDS_BYTES) != hipSuccess) { fprintf(stderr, "kernel_launch: hipFuncSetAttribute failed\n"); grid = -1; return; }
        if (hipOccupancyMaxActiveBlocksPerMultiprocessor(&per_cu, (const void*)fwd, NWAVES * 64, LDS_BYTES) != hipSuccess || per_cu < 1) { fprintf(stderr, "kernel_launch: occupancy query reports %d blocks per CU\n", per_cu); per_cu = 1; }
        (void)hipGetLastError();
        grid = cus;
    }
    if (grid < 0) return;
    (void)hipMemsetAsync((char*)d_ws + WS_CTL, 0, CTL_ZERO_BYTES, stream);
    Args a{};
    for (int i = 0; i < 22; ++i) a.in[i] = (const float*)d_in[i];
    a.out = (float*)d_out; a.ws = (unsigned char*)d_ws;
    bf16* proj = (bf16*)((char*)d_ws + WS_PROJ); float* smallp = (float*)((char*)d_ws + WS_SMALLP); float* ssq = (float*)((char*)d_ws + WS_SSQ);
#if MK_MULTI
    for (int ph = 0; ph < N_PHASES; ++ph) {
        const int l = ph / PH_PER_LAYER, p = ph % PH_PER_LAYER;
        if (p == 2) {
            naive_attn<<<BATCH * 64, 256, 0, stream>>>(proj);
            naive_ssd<<<BATCH * 16, 256, 0, stream>>>(proj, smallp, ssq, a.in[5] + (size_t)l * 4 * 1536, a.in[6] + l * 1536, a.in[7] + l * 16, a.in[8] + l * 16, a.in[9] + l * 16);
            naive_mlstm<<<BATCH * 4, 512, 0, stream>>>(proj, smallp, a.in[11] + (size_t)l * 4 * 1024, a.in[12] + l * 1024, a.in[13] + l * 4, a.in[14] + l * 4, a.in[15] + l * 512);
            continue;
        }
        a.ph_lo = ph; a.ph_hi = ph + 1;
        hipLaunchKernelGGL(fwd, dim3(grid), dim3(NWAVES * 64), LDS_BYTES, stream, a);
    }
#else
    a.ph_lo = 0; a.ph_hi = N_PHASES;
    hipLaunchKernelGGL(fwd, dim3(grid), dim3(NWAVES * 64), LDS_BYTES, stream, a);
#endif
}
```

```cpp
#include <hip/hip_runtime.h>
#include <cstdio>
#include <cstdint>
#include <cmath>

#ifndef MK_MULTI
#define MK_MULTI 0
#endif

constexpr int BATCH = 8, SEQ = 2048, DM = 1024, DEPTH = 2;
constexpr int M = BATCH * SEQ;
constexpr int P_IN = 6168;
constexpr int PLD = 6144;
constexpr int PC_Q = 0, PC_Z = 512, PC_MO = 1536, PC_K = 2048, PC_V = 2560, PC_XBC = 3072, PC_MQK = 4608, PC_MV = 5632;
constexpr int SC_Q = 0, SC_K = 512, SC_V = 1024, SC_Z = 1536, SC_XBC = 2560, SC_DT = 4096, SC_MQK = 4112, SC_MV = 5136, SC_MO = 5648, SC_MI = 6160, SC_MF = 6164;
constexpr int FFN = 2816, ULD = 5632;
constexpr int DMIX = 2048;
constexpr float EPS = 1e-6f;
constexpr float C2 = 0.125f * 1.4426950408889634f;

constexpr size_t MiB = 1u << 20;
constexpr size_t WS_CTL = 0, CTL_ZERO_BYTES = 1 * MiB;
constexpr size_t WS_SMALLP = 1 * MiB;
constexpr size_t WS_SSQ = 3 * MiB - 512 * 1024;
constexpr size_t WS_BUFA = 4 * MiB;
constexpr size_t WS_BUFB = 16 * MiB;
constexpr size_t WS_XB = 22 * MiB;
constexpr size_t WS_PROJ = 64 * MiB;
constexpr size_t WS_END = 256 * MiB;

namespace pg8 {
#define PG8_LAS __attribute__((address_space(3)))
typedef unsigned short bf16_t;
typedef short bf16x8 __attribute__((ext_vector_type(8)));
typedef float f32x4 __attribute__((ext_vector_type(4)));
typedef unsigned u32x4 __attribute__((ext_vector_type(4)));
constexpr int BM = 256, BK = 64, HALF = 128, HTB = HALF * BK * 2, STAGE_BYTES = 8 * HTB, NXCD = 8, WGM = 8;

__host__ __device__ __forceinline__ int lds_byte(int r, int c) { const int st = (r >> 4) * 2 + (c >> 5), rr = r & 15, cc = c & 31, ob = rr * 64 + cc * 2; return st * 1024 + (ob ^ (((ob >> 9) & 1) << 5)); }
__host__ __device__ __forceinline__ void stage_rc(int b, int& R, int& C) { const int st = b / 1024, sb = b % 1024, swz = sb ^ (((sb >> 9) & 1) << 5); R = (st >> 1) * 16 + swz / 64; C = (st & 1) * 32 + (swz % 64) / 2; }
__host__ __device__ __forceinline__ int perm32(int rho) { const int n = rho >> 4, i = rho & 15; return 8 * (i >> 2) + 4 * n + (i & 3); }

struct Unit { int pm, pn; };
struct Gemm { const bf16_t* A; const bf16_t* Bt; int M, N, K, lda; };

struct StaticOrder {
    int nM, nN, nwg, G, c;
    __host__ __device__ void init(int M_, int N_, int G_, int c_) { nM = M_ / BM; nN = N_ / BM; nwg = nM * nN; G = G_; c = c_; }
    __host__ __device__ bool next(int i, Unit& u) const {
        const long L = (long)i * G + c; if (L >= nwg) return false;
        int wgid = (int)L; { const int q = nwg / NXCD, r = nwg % NXCD, xcd = wgid % NXCD, off = wgid / NXCD; wgid = (xcd < r ? xcd * (q + 1) : r * (q + 1) + (xcd - r) * q) + off; }
        const int nig = WGM * nN, gid = wgid / nig, fm = gid * WGM, gsz = (nM - fm) < WGM ? (nM - fm) : WGM;
        u.pm = fm + ((wgid % nig) % gsz); u.pn = (wgid % nig) / gsz; return true;
    }
};

__device__ __forceinline__ unsigned cvt_pk_bf16(float lo, float hi) { unsigned r; asm volatile("v_cvt_pk_bf16_f32 %0, %1, %2" : "=v"(r) : "v"(lo), "v"(hi)); return r; }

struct EpiBf16 {
    static constexpr bool PERM = true;
    bf16_t* O; int ldc;
    __device__ __forceinline__ void operator()(const f32x4 (&acc)[2][2][4][2], const Unit& u, int wr, int wc, int fr, int fq) const {
        const int row0 = u.pm * BM + wr * 64 + fr; const int col0 = u.pn * BM + wc * 32 + 8 * fq;
#pragma unroll
        for (int ai = 0; ai < 2; ++ai)
#pragma unroll
            for (int m = 0; m < 4; ++m) { bf16_t* rowp = O + (size_t)(row0 + ai * HALF + m * 16) * ldc + col0;
#pragma unroll
                for (int bj = 0; bj < 2; ++bj) { const f32x4 v0 = acc[ai][bj][m][0], v1 = acc[ai][bj][m][1];
                    u32x4 w; w.x = cvt_pk_bf16(v0[0], v0[1]); w.y = cvt_pk_bf16(v0[2], v0[3]); w.z = cvt_pk_bf16(v1[0], v1[1]); w.w = cvt_pk_bf16(v1[2], v1[3]);
                    *(u32x4*)(rowp + bj * HALF) = w; } }
    }
};
struct EpiProj {
    static constexpr bool PERM = true;
    bf16_t* P; const float* qw; const float* kw;
    __device__ __forceinline__ void operator()(const f32x4 (&acc)[2][2][4][2], const Unit& u, int wr, int wc, int fr, int fq) const {
        const int pn = u.pn; const bool isq = pn < 2, isk = (pn == 8 || pn == 9);
        const int row0 = u.pm * BM + wr * 64 + fr;
        if (!(isq || isk)) {
            const int col0 = pn * BM + wc * 32 + 8 * fq;
#pragma unroll
            for (int ai = 0; ai < 2; ++ai)
#pragma unroll
                for (int m = 0; m < 4; ++m) { bf16_t* rowp = P + (size_t)(row0 + ai * HALF + m * 16) * PLD + col0;
#pragma unroll
                    for (int bj = 0; bj < 2; ++bj) { const f32x4 v0 = acc[ai][bj][m][0], v1 = acc[ai][bj][m][1];
                        u32x4 w; w.x = cvt_pk_bf16(v0[0], v0[1]); w.y = cvt_pk_bf16(v0[2], v0[3]); w.z = cvt_pk_bf16(v1[0], v1[1]); w.w = cvt_pk_bf16(v1[2], v1[3]);
                        *(u32x4*)(rowp + bj * HALF) = w; } }
        } else {
            const float* w = isq ? qw : kw; const float post = isq ? C2 : 1.0f;
            const int colb = pn * BM + 64 * wc + 8 * fq;
#pragma unroll
            for (int ai = 0; ai < 2; ++ai)
#pragma unroll
                for (int m = 0; m < 4; ++m) {
                    float ss = 0.f;
#pragma unroll
                    for (int bj = 0; bj < 2; ++bj)
#pragma unroll
                        for (int n = 0; n < 2; ++n) { const f32x4 x = acc[ai][bj][m][n]; ss += (x[0] * x[0] + x[1] * x[1]) + (x[2] * x[2] + x[3] * x[3]); }
                    ss += __shfl_xor(ss, 16); ss += __shfl_xor(ss, 32);
                    const float r = (1.0f / sqrtf(ss * (1.0f / 64.0f) + EPS)) * post;
                    bf16_t* rowp = P + (size_t)(row0 + ai * HALF + m * 16) * PLD + colb;
#pragma unroll
                    for (int bj = 0; bj < 2; ++bj) { const f32x4 w0 = *(const f32x4*)(w + 32 * bj + 8 * fq), w1 = *(const f32x4*)(w + 32 * bj + 8 * fq + 4);
                        const f32x4 v0 = acc[ai][bj][m][0] * r * w0, v1 = acc[ai][bj][m][1] * r * w1;
                        u32x4 o; o.x = cvt_pk_bf16(v0[0], v0[1]); o.y = cvt_pk_bf16(v0[2], v0[3]); o.z = cvt_pk_bf16(v1[0], v1[1]); o.w = cvt_pk_bf16(v1[2], v1[3]);
                        *(u32x4*)(rowp + 32 * bj) = o; }
                    asm volatile("" ::: "memory");
                }
        }
    }
};
struct EpiRes {
    static constexpr bool PERM = false;
    const float* base; float* out; int ldc;
    __device__ __forceinline__ void operator()(const f32x4 (&acc)[2][2][4][2], const Unit& u, int wr, int wc, int fr, int fq) const {
        const int row0 = u.pm * BM + wr * 64 + fr, col0 = u.pn * BM + wc * 32 + 4 * fq;
#pragma unroll
        for (int ai = 0; ai < 2; ++ai)
#pragma unroll
            for (int m = 0; m < 4; ++m) { const size_t off = (size_t)(row0 + ai * HALF + m * 16) * ldc + col0;
#pragma unroll
                for (int bj = 0; bj < 2; ++bj)
#pragma unroll
                    for (int n = 0; n < 2; ++n) { const f32x4 b = *(const f32x4*)(base + off + bj * HALF + n * 16); *(f32x4*)(out + off + bj * HALF + n * 16) = b + acc[ai][bj][m][n]; } }
    }
};

template <class Epi>
__device__ __forceinline__ void gemm_phase(PG8_LAS unsigned char* lds, const Gemm g, const StaticOrder& S, const Epi& E) {
    int tid_ = threadIdx.x; asm volatile("" : "+v"(tid_));
    const int tid = tid_, wid = __builtin_amdgcn_readfirstlane(tid >> 6), lane = tid & 63, wr = wid >> 2, wc = wid & 3, fr = lane & 15, fq = lane >> 4;
    const int K = g.K, nt = K / BK, lda = g.lda;
    unsigned voffA[2], voffB[2];
#pragma unroll
    for (int i = 0; i < 2; ++i) { int R, C; stage_rc(tid * 16 + i * 8192, R, C); const int Rb = Epi::PERM ? ((R & ~31) + perm32(R & 31)) : R;
        voffA[i] = (unsigned)(R * lda + C) * 2u; voffB[i] = (unsigned)(Rb * K + C) * 2u; }
    const size_t kstep = (size_t)(BK * 2);
    const size_t hstepA = (size_t)HALF * lda * 2, hstepB = (size_t)HALF * K * 2;
    const size_t tstepA = 2 * hstepA, tstepB = 2 * hstepB;
    const unsigned ldsw = (unsigned)wid * 1024u;
    const int aoff = lds_byte(wr * 64 + fr, fq * 8), boff = lds_byte(wc * 32 + fr, fq * 8);
#define PG8_SA(b, h) (((b) * 2 + (h)) * HTB)
#define PG8_SB(b, h) ((4 + (b) * 2 + (h)) * HTB)
#define PG8_STAGE(bufoff, gbase, voff) do { _Pragma("unroll") for (int _i = 0; _i < 2; ++_i) \
        __builtin_amdgcn_global_load_lds((const unsigned*)((const char*)(gbase) + (voff)[_i]), (PG8_LAS unsigned*)(lds + (bufoff) + ldsw + _i * 8192), 16, 0, 0); } while (0)
#define PG8_LDA(dst, b, h) do { _Pragma("unroll") for (int m = 0; m < 4; ++m) _Pragma("unroll") for (int k = 0; k < 2; ++k) dst[m][k] = *(const PG8_LAS bf16x8*)(lds + PG8_SA(b, h) + aoff + m * 2048 + k * 1024); } while (0)
#define PG8_LDB(dst, b, h) do { _Pragma("unroll") for (int n = 0; n < 2; ++n) _Pragma("unroll") for (int k = 0; k < 2; ++k) dst[n][k] = *(const PG8_LAS bf16x8*)(lds + PG8_SB(b, h) + boff + n * 2048 + k * 1024); } while (0)
#define PG8_MMA(ai, bj, At, Bt) do { __builtin_amdgcn_s_setprio(1); _Pragma("unroll") for (int m = 0; m < 4; ++m) _Pragma("unroll") for (int n = 0; n < 2; ++n) _Pragma("unroll") for (int k = 0; k < 2; ++k) \
        acc[ai][bj][m][n] = __builtin_amdgcn_mfma_f32_16x16x32_bf16(Bt[n][k], At[m][k], acc[ai][bj][m][n], 0, 0, 0); __builtin_amdgcn_s_setprio(0); } while (0)
#define PG8_WAIT_V(n) asm volatile("s_waitcnt vmcnt(" #n ")" ::: "memory")
#define PG8_WAIT_L(n) asm volatile("s_waitcnt lgkmcnt(" #n ")" ::: "memory")
#define PG8_BAR __builtin_amdgcn_s_barrier()
#define PG8_SCHED __builtin_amdgcn_sched_barrier(0)
    Unit cur, nxt; int ui = 0;
    if (!S.next(0, cur)) return;
    f32x4 acc[2][2][4][2];
#pragma unroll
    for (int a = 0; a < 2; ++a)
#pragma unroll
        for (int b = 0; b < 2; ++b)
#pragma unroll
            for (int m = 0; m < 4; ++m)
#pragma unroll
                for (int n = 0; n < 2; ++n) acc[a][b][m][n] = (f32x4){0.f, 0.f, 0.f, 0.f};
    bf16x8 At[4][2], B0[2][2], B1[2][2];
    const char* cA = (const char*)g.A + (size_t)cur.pm * tstepA; const char* cB = (const char*)g.Bt + (size_t)cur.pn * tstepB;
    PG8_STAGE(PG8_SB(0, 0), cB, voffB); PG8_STAGE(PG8_SB(0, 1), cB + hstepB, voffB); PG8_STAGE(PG8_SA(0, 0), cA, voffA); PG8_STAGE(PG8_SA(0, 1), cA + hstepA, voffA);
    if (wr == 1) PG8_BAR;
    PG8_WAIT_V(2); PG8_BAR;
    PG8_STAGE(PG8_SB(1, 0), cB + kstep, voffB); PG8_STAGE(PG8_SA(1, 0), cA + kstep, voffA); PG8_STAGE(PG8_SB(1, 1), cB + hstepB + kstep, voffB);
    PG8_WAIT_V(6); PG8_BAR;
    for (;;) {
        const bool has_next = S.next(ui + 1, nxt);
        const char* nA = has_next ? (const char*)g.A + (size_t)nxt.pm * tstepA : cA; const char* nB = has_next ? (const char*)g.Bt + (size_t)nxt.pn * tstepB : cB;
        for (int t = 0; t < nt; t += 2) {
            const bool last = (t == nt - 2);
            const char* a1 = cA + (size_t)(t + 1) * kstep;
            const char* a2 = last ? nA : cA + (size_t)(t + 2) * kstep; const char* b2 = last ? nB : cB + (size_t)(t + 2) * kstep;
            const char* a3 = a2 + kstep; const char* b3 = b2 + kstep;
            PG8_LDB(B0, 0, 0); PG8_LDB(B1, 0, 1); PG8_SCHED; PG8_LDA(At, 0, 0); PG8_STAGE(PG8_SA(1, 1), a1 + hstepA, voffA);
            PG8_WAIT_V(8); PG8_WAIT_L(0); PG8_BAR; PG8_MMA(0, 0, At, B0); PG8_MMA(0, 1, At, B1); PG8_BAR; PG8_SCHED;
            PG8_LDA(At, 0, 1); PG8_STAGE(PG8_SB(0, 0), b2, voffB); PG8_STAGE(PG8_SB(0, 1), b2 + hstepB, voffB); PG8_STAGE(PG8_SA(0, 0), a2, voffA);
            PG8_WAIT_V(8); PG8_WAIT_L(0); PG8_BAR; PG8_MMA(1, 0, At, B0); PG8_MMA(1, 1, At, B1); PG8_BAR; PG8_SCHED;
            PG8_LDB(B0, 1, 0); PG8_LDB(B1, 1, 1); PG8_SCHED; PG8_LDA(At, 1, 0); PG8_STAGE(PG8_SA(0, 1), a2 + hstepA, voffA);
            PG8_WAIT_V(8); PG8_WAIT_L(0); PG8_BAR; PG8_MMA(0, 0, At, B0); PG8_MMA(0, 1, At, B1); PG8_BAR; PG8_SCHED;
            PG8_LDA(At, 1, 1); PG8_STAGE(PG8_SB(1, 0), b3, voffB); PG8_STAGE(PG8_SB(1, 1), b3 + hstepB, voffB); PG8_STAGE(PG8_SA(1, 0), a3, voffA);
            PG8_WAIT_V(8); PG8_WAIT_L(0); PG8_BAR; PG8_MMA(1, 0, At, B0); PG8_MMA(1, 1, At, B1); PG8_BAR; PG8_SCHED;
        }
        if (wr == 0) PG8_BAR;
        E(acc, cur, wr, wc, fr, fq);
        if (!has_next) break;
#pragma unroll
        for (int a = 0; a < 2; ++a)
#pragma unroll
            for (int b = 0; b < 2; ++b)
#pragma unroll
                for (int m = 0; m < 4; ++m)
#pragma unroll
                    for (int n = 0; n < 2; ++n) acc[a][b][m][n] = (f32x4){0.f, 0.f, 0.f, 0.f};
        cur = nxt; cA = nA; cB = nB; ++ui;
        if (wr == 1) PG8_BAR;
    }
    PG8_WAIT_V(0);
    PG8_BAR;
#undef PG8_SA
#undef PG8_SB
#undef PG8_STAGE
#undef PG8_LDA
#undef PG8_LDB
#undef PG8_MMA
#undef PG8_WAIT_V
#undef PG8_WAIT_L
#undef PG8_BAR
#undef PG8_SCHED
}
}

constexpr int NWAVES = 8;
constexpr int RING_OFF = 0, RING_BYTES = 131072;
constexpr int LDSCTL_OFF = RING_BYTES, MISC_OFF = LDSCTL_OFF + 320;
constexpr int LDS_BYTES = 147456;
constexpr int CW_BAR = 4096;

#define GAS __attribute__((address_space(1)))
#define LAS __attribute__((address_space(3)))
typedef unsigned short bf16;
typedef unsigned v4u __attribute__((ext_vector_type(4)));
typedef float f32x4 __attribute__((ext_vector_type(4)));
typedef GAS unsigned gu32;
#define RLX_AGENT __ATOMIC_RELAXED, __HIP_MEMORY_SCOPE_AGENT
#define LDS_WAIT() asm volatile("s_waitcnt lgkmcnt(0)" ::: "memory")
#define VM_WAIT() asm volatile("s_waitcnt vmcnt(0)" ::: "memory")
__device__ __forceinline__ unsigned f2bf(float f) { unsigned u = __builtin_bit_cast(unsigned, f); return (u + 0x7fffu + ((u >> 16) & 1u)) >> 16; }
__device__ __forceinline__ unsigned pk2(float lo, float hi) { return f2bf(lo) | (f2bf(hi) << 16); }
__device__ __forceinline__ float bf2f(unsigned short b) { return __uint_as_float(((unsigned)b) << 16); }

#define XB_TMO      128
#define XB_XCNT(j)  (256  + 64 * (j))
#define XB_XSUB(j)  (1280 + 64 * (j))
#define XB_XGEN(j)  (2304 + 64 * (j))
#define XB_TOP      3328
#define XB_TOPGEN   3392
#define XCD_BAR_WORDS 3456
#define XB_SPIN_CAP (1u << 18)
__device__ __forceinline__ unsigned xb_ld(unsigned* p)              { return __hip_atomic_load(p, __ATOMIC_RELAXED, __HIP_MEMORY_SCOPE_AGENT); }
__device__ __forceinline__ unsigned xb_add(unsigned* p, unsigned v) { return __hip_atomic_fetch_add(p, v, __ATOMIC_RELAXED, __HIP_MEMORY_SCOPE_AGENT); }
__device__ __forceinline__ unsigned xb_xcc_id() { return (unsigned)__builtin_amdgcn_s_getreg((3 << 11) | 20) & 0xFu; }
#define XB_SPIN(cond, bar) do { unsigned _sp = 0; while (cond) { __builtin_amdgcn_s_sleep(1); \
    if ((++_sp & 255u) == 0u) { if (xb_ld(&(bar)[XB_TMO])) break; if (_sp > XB_SPIN_CAP) { atomicAdd(&(bar)[XB_TMO], 1u); break; } } } } while (0)
struct XcdBarrier { unsigned* bar; unsigned x; volatile LAS unsigned* st; };
__device__ __forceinline__ XcdBarrier xcd_barrier_post(unsigned* bar, volatile LAS unsigned* st) {
    XcdBarrier b; b.bar = bar; b.x = xb_xcc_id(); b.st = st;
    if (threadIdx.x == 0) (void)xb_add(&bar[XB_XCNT(b.x)], 1u);
    return b;
}
__device__ __forceinline__ void xcd_barrier_complete(unsigned* bar, unsigned x, unsigned& nloc, unsigned& nx) {
    const unsigned G = gridDim.x * gridDim.y * gridDim.z;
    unsigned sum, cnt, mine, sp = 0u;
    for (;;) {
        sum = 0u; cnt = 0u; mine = 0u;
#pragma unroll
        for (unsigned j = 0; j < 16; ++j) { const unsigned c = xb_ld(&bar[XB_XCNT(j)]); sum += c; cnt += (c > 0u) ? 1u : 0u; mine = (j == x) ? c : mine; }
        if (sum == G) break;
        __builtin_amdgcn_s_sleep(1);
        if ((++sp & 255u) == 0u) { if (xb_ld(&bar[XB_TMO])) break; if (sp > XB_SPIN_CAP) { atomicAdd(&bar[XB_TMO], 1u); break; } }
    }
    nloc = mine > 0u ? mine : 1u; nx = cnt > 0u ? cnt : 1u;
}
__device__ __forceinline__ void xcd_barrier(const XcdBarrier& b) {
    asm volatile("s_waitcnt vmcnt(0)" ::: "memory");
    __syncthreads();
    if (threadIdx.x == 0) {
        unsigned* bar = b.bar;
        __builtin_amdgcn_s_waitcnt(0);
        unsigned nloc = b.st[0], nx = b.st[1];
        if (nloc == 0u) { xcd_barrier_complete(bar, b.x, nloc, nx); b.st[0] = nloc; b.st[1] = nx; }
        const unsigned old = xb_add(&bar[XB_XSUB(b.x)], 1u);
        const unsigned gen = old / nloc;
        if (old + 1u == (gen + 1u) * nloc) {
            __builtin_amdgcn_fence(__ATOMIC_RELEASE, "agent");
            asm volatile("s_waitcnt vmcnt(0)" ::: "memory");
            const unsigned og = xb_add(&bar[XB_TOP], 1u);
            const unsigned tg = og / nx;
            if (og + 1u == (tg + 1u) * nx) xb_add(&bar[XB_TOPGEN], 1u);
            else XB_SPIN(xb_ld(&bar[XB_TOPGEN]) == tg, bar);
            __builtin_amdgcn_fence(__ATOMIC_ACQUIRE, "agent");
            xb_add(&bar[XB_XGEN(b.x)], 1u);
            asm volatile("s_waitcnt vmcnt(0)" ::: "memory");
        } else {
            XB_SPIN(xb_ld(&bar[XB_XGEN(b.x)]) == gen, bar);
            __builtin_amdgcn_fence(__ATOMIC_ACQUIRE, "agent");
            asm volatile("s_waitcnt vmcnt(0)" ::: "memory");
        }
    }
    __syncthreads();
}

struct Args { const float* in[22]; float* out; unsigned char* ws; int ph_lo, ph_hi; };

struct Frame {
    LAS unsigned char* lds;
    gu32* ctl;
    int tid, lane, wave;
    int vcu, G;
};

__device__ __forceinline__ float wave_sum(float v) {
#pragma unroll
    for (int o = 1; o < 64; o <<= 1) v += __shfl_xor(v, o);
    return v;
}

__device__ __forceinline__ void conv_item(const float* W, int ldw, int srccol0, bf16* WT, int K, int dstrow0, int k0, LAS float* scr, int lane) {
#pragma unroll 8
    for (int i = 0; i < 32; ++i) { const int kk = 2 * i + (lane >> 5); scr[kk * 33 + (lane & 31)] = W[(size_t)(k0 + kk) * ldw + srccol0 + (lane & 31)]; }
    LDS_WAIT(); asm volatile("" ::: "memory");
    const int c = lane & 7;
#pragma unroll
    for (int j = 0; j < 4; ++j) { const int n = (lane >> 3) + 8 * j; const LAS float* s = scr + (8 * c) * 33 + n;
        v4u o; o.x = pk2(s[0 * 33], s[1 * 33]); o.y = pk2(s[2 * 33], s[3 * 33]); o.z = pk2(s[4 * 33], s[5 * 33]); o.w = pk2(s[6 * 33], s[7 * 33]);
        *(GAS v4u*)(WT + (size_t)(dstrow0 + n) * K + k0 + 8 * c) = o; }
    LDS_WAIT(); asm volatile("" ::: "memory");
}
__device__ __forceinline__ int in_src_col(int n0) {
    const int tile = n0 >> 8, p = n0 & 255; int dest;
    if (tile < 2 || tile == 8 || tile == 9) { const int bj = p >> 7, wc = (p >> 5) & 3; dest = (tile << 8) + 64 * wc + 32 * bj; } else dest = n0;
    if (dest < PC_Z) return SC_Q + dest;
    if (dest < PC_MO) return SC_Z + dest - PC_Z;
    if (dest < PC_K) return SC_MO + dest - PC_MO;
    if (dest < PC_V) return SC_K + dest - PC_K;
    if (dest < PC_XBC) return SC_V + dest - PC_V;
    if (dest < PC_MQK) return SC_XBC + dest - PC_XBC;
    if (dest < PC_MV) return SC_MQK + dest - PC_MQK;
    return SC_MV + dest - PC_MV;
}
__device__ __forceinline__ void convert_weights(Frame& F, int which, const float* Wa, const float* Wb, bf16* bufa, bf16* bufb, LAS float* scr) {
    const int gw = F.vcu * NWAVES + F.wave, NGW = F.G * NWAVES;
    if (which == 0) {
        constexpr int IA = (DM / 64) * (PLD / 32), IB = (DMIX / 64) * (DM / 32);
        for (int it = gw; it < IA + IB; it += NGW) {
            if (it < IA) { const int nblk = PLD / 32, kb = it / nblk, nb = it % nblk; conv_item(Wa, P_IN, in_src_col(32 * nb), bufa, DM, 32 * nb, 64 * kb, scr, F.lane); }
            else { const int r = it - IA, nblk = DM / 32, kb = r / nblk, nb = r % nblk; conv_item(Wb, DM, 32 * nb, bufb, DMIX, 32 * nb, 64 * kb, scr, F.lane); }
        }
    } else {
        constexpr int IA = (DM / 64) * (ULD / 32), IB = (FFN / 64) * (DM / 32);
        for (int it = gw; it < IA + IB; it += NGW) {
            if (it < IA) { const int nblk = ULD / 32, kb = it / nblk, nb = it % nblk; conv_item(Wa, ULD, 32 * nb, bufa, DM, 32 * nb, 64 * kb, scr, F.lane); }
            else { const int r = it - IA, nblk = DM / 32, kb = r / nblk, nb = r % nblk; conv_item(Wb, DM, 32 * nb, bufb, FFN, 32 * nb, 64 * kb, scr, F.lane); }
        }
    }
}
__device__ __forceinline__ void row_pass(Frame& F, const float* x, const float* nw, bf16* xb, const float* w_in  , float* smallp, LAS float* wsm  ) {
    if (w_in) {
        for (int k = F.tid; k < DM; k += NWAVES * 64) {
            const float* src = w_in + (size_t)k * P_IN;
#pragma unroll
            for (int c = 0; c < 16; ++c) wsm[c * DM + k] = src[SC_DT + c];
#pragma unroll
            for (int c = 0; c < 8; ++c) wsm[(16 + c) * DM + k] = src[SC_MI + c];
        }
        LDS_WAIT(); __syncthreads();
    }
    const int gw = F.vcu * NWAVES + F.wave, NGW = F.G * NWAVES;
    f32x4 wv[4];
#pragma unroll
    for (int j = 0; j < 4; ++j) wv[j] = ((const GAS f32x4*)nw)[64 * j + F.lane];
    for (int m = gw; m < M; m += NGW) {
        const GAS f32x4* xr = (const GAS f32x4*)(x + (size_t)m * DM) + F.lane;
        f32x4 v[4]; float s = 0.f;
#pragma unroll
        for (int j = 0; j < 4; ++j) { v[j] = xr[64 * j]; s += (v[j].x * v[j].x + v[j].y * v[j].y) + (v[j].z * v[j].z + v[j].w * v[j].w); }
        const float r = 1.0f / sqrtf(wave_sum(s) * (1.0f / DM) + EPS);
#pragma unroll
        for (int j = 0; j < 4; ++j) v[j] = v[j] * r * wv[j];
        GAS unsigned long long* o8 = (GAS unsigned long long*)(xb + (size_t)m * DM) + F.lane;
#pragma unroll
        for (int j = 0; j < 4; ++j) o8[64 * j] = (unsigned long long)pk2(v[j].x, v[j].y) | ((unsigned long long)pk2(v[j].z, v[j].w) << 32);
        if (w_in) {
            float mine = 0.f;
            for (int c = 0; c < 24; ++c) {
                float d = 0.f;
#pragma unroll
                for (int j = 0; j < 4; ++j) { const f32x4 w4 = *(const LAS f32x4*)(wsm + c * DM + 4 * (64 * j + F.lane)); d += (v[j].x * w4.x + v[j].y * w4.y) + (v[j].z * w4.z + v[j].w * w4.w); }
                d = wave_sum(d);
                if (F.lane == c) mine = d;
            }
            if (F.lane < 24) smallp[(size_t)m * 24 + F.lane] = mine;
        }
    }
}
__device__ __forceinline__ void ssd_finalize(Frame& F, bf16* proj, const float* ssq, const float* nw) {
    const int gt = F.vcu * (NWAVES * 64) + F.tid, NT = F.G * NWAVES * 64;
    for (int it = gt; it < M * 128; it += NT) {
        const int row = it >> 7, c0 = (it & 127) * 8, g = c0 >> 9;
        float s = 0.f;
#pragma unroll
        for (int h = 0; h < 8; ++h) s += ssq[(size_t)row * 16 + g * 8 + h];
        const float r = 1.0f / sqrtf(s * (1.0f / 512.0f) + EPS);
        v4u* p = (v4u*)(proj + (size_t)row * PLD + PC_Z + c0);
        v4u v = *p; const f32x4 w0 = *(const f32x4*)(nw + c0), w1 = *(const f32x4*)(nw + c0 + 4);
        v4u o;
        o.x = pk2(bf2f(v.x & 0xffff) * r * w0.x, bf2f(v.x >> 16) * r * w0.y); o.y = pk2(bf2f(v.y & 0xffff) * r * w0.z, bf2f(v.y >> 16) * r * w0.w);
        o.z = pk2(bf2f(v.z & 0xffff) * r * w1.x, bf2f(v.z >> 16) * r * w1.y); o.w = pk2(bf2f(v.w & 0xffff) * r * w1.z, bf2f(v.w >> 16) * r * w1.w);
        *p = o;
    }
}
__device__ __forceinline__ void ffn_ew(Frame& F, bf16* u, const float* cw  , const float* cb) {
    const int gt = F.vcu * (NWAVES * 64) + F.tid, NT = F.G * NWAVES * 64;
    constexpr int CPR = FFN / 8;
    for (int it = gt; it < M * CPR; it += NT) {
        const int row = it / CPR, c0 = (it % CPR) * 8, t = row & (SEQ - 1);
        const bf16* g0 = u + (size_t)row * ULD + c0;
        v4u a2 = *(const v4u*)g0, a1 = (v4u){0, 0, 0, 0}, a0 = (v4u){0, 0, 0, 0};
        if (t >= 1) a1 = *(const v4u*)(g0 - ULD);
        if (t >= 2) a0 = *(const v4u*)(g0 - 2 * ULD);
        const v4u vv = *(const v4u*)(g0 + FFN);
        float o[8];
#pragma unroll
        for (int i = 0; i < 8; ++i) {
            const unsigned w2 = a2[i >> 1], w1 = a1[i >> 1], w0 = a0[i >> 1], wv = vv[i >> 1];
            const float x2 = (i & 1) ? bf2f(w2 >> 16) : bf2f(w2 & 0xffff), x1 = (i & 1) ? bf2f(w1 >> 16) : bf2f(w1 & 0xffff), x0 = (i & 1) ? bf2f(w0 >> 16) : bf2f(w0 & 0xffff);
            const float val = (i & 1) ? bf2f(wv >> 16) : bf2f(wv & 0xffff);
            const float gt_ = cw[c0 + i] * x0 + cw[FFN + c0 + i] * x1 + cw[2 * FFN + c0 + i] * x2 + cb[c0 + i];
            o[i] = 0.5f * gt_ * (1.0f + erff(gt_ * 0.70710678118654752f)) * val;
        }
        v4u ov; ov.x = pk2(o[0], o[1]); ov.y = pk2(o[2], o[3]); ov.z = pk2(o[4], o[5]); ov.w = pk2(o[6], o[7]);
        *(v4u*)(u + (size_t)row * ULD + FFN + c0) = ov;
    }
}

__device__ __forceinline__ float silu_f(float x) { return x / (1.0f + __expf(-x)); }

__device__ __forceinline__ void naive_attn_unit(int tidx, bf16* proj, int b, int h, int qb, LAS unsigned char* lds) {
    const int tid = tidx, qi = tid >> 1, dh = tid & 1;
    LAS float* sK = (LAS float*)lds;
    LAS float* sV = sK + 128 * 64;
    const int t = qb * 256 + qi; const size_t rowq = (size_t)b * SEQ + t;
    float q[32];
    { const v4u* qp = (const v4u*)(proj + rowq * PLD + PC_Q + h * 64 + dh * 32);
#pragma unroll
      for (int i = 0; i < 4; ++i) { const v4u v = qp[i];
#pragma unroll
          for (int j = 0; j < 4; ++j) { q[i * 8 + 2 * j] = bf2f(v[j] & 0xffff); q[i * 8 + 2 * j + 1] = bf2f(v[j] >> 16); } } }
    unsigned sel = (1u << qb) - 1u;
    if (qb >= 4) {
        float g[8];
        LAS float* part = sV;
        LAS float* km = sV + 8 * 64;
#pragma unroll
        for (int n = 0; n < 8; ++n) { if (n < qb) {
            const int d = tid & 63, pt = tid >> 6; float s = 0.f;
            for (int r = 0; r < 32; ++r) s += bf2f(proj[((size_t)b * SEQ + n * 256 + pt * 32 + r) * PLD + PC_K + h * 64 + d]);
            __syncthreads();
            part[pt * 64 + d] = s;
            __syncthreads();
            if (tid < 64) { float a = 0.f;
#pragma unroll
                for (int k = 0; k < 8; ++k) a += part[k * 64 + tid];
                km[tid] = a * (1.0f / 256.0f); }
            __syncthreads();
            float gg = 0.f;
#pragma unroll
            for (int dd = 0; dd < 32; ++dd) gg += q[dd] * km[dh * 32 + dd];
            gg += __shfl_xor(gg, 1);
            g[n] = gg;
        } else g[n] = 0.f; }
        __syncthreads();
        sel = 0u;
#pragma unroll
        for (int k = 0; k < 3; ++k) { int best = -1; float bv = 0.f;
#pragma unroll
            for (int n = 0; n < 8; ++n) if (n < qb && !((sel >> n) & 1u)) { if (best < 0 || g[n] > bv) { best = n; bv = g[n]; } }
            sel |= 1u << best; }
    }
    float acc[32];
#pragma unroll
    for (int i = 0; i < 32; ++i) acc[i] = 0.f;
    float mx = -INFINITY, l = 0.f;
    for (int n = 0; n <= qb; ++n) {
        for (int hf = 0; hf < 2; ++hf) {
            __syncthreads();
            for (int i = tid; i < 128 * 8; i += 512) { const int r = i >> 3, c = i & 7; const size_t row = (size_t)b * SEQ + n * 256 + hf * 128 + r;
                const v4u kv = *(const v4u*)(proj + row * PLD + PC_K + h * 64 + c * 8), vv = *(const v4u*)(proj + row * PLD + PC_V + h * 64 + c * 8);
#pragma unroll
                for (int j = 0; j < 4; ++j) { sK[r * 64 + c * 8 + 2 * j] = bf2f(kv[j] & 0xffff); sK[r * 64 + c * 8 + 2 * j + 1] = bf2f(kv[j] >> 16); sV[r * 64 + c * 8 + 2 * j] = bf2f(vv[j] & 0xffff); sV[r * 64 + c * 8 + 2 * j + 1] = bf2f(vv[j] >> 16); } }
            __syncthreads();
            const bool blk_ok = (n == qb) || ((sel >> n) & 1u);
#pragma unroll 1
            for (int j = 0; j < 128; ++j) {
                const int kp = n * 256 + hf * 128 + j;
                const bool valid = blk_ok && (n < qb || kp <= t);
                float s = 0.f;
#pragma unroll
                for (int d = 0; d < 32; ++d) s += q[d] * sK[j * 64 + dh * 32 + d];
                s += __shfl_xor(s, 1);
                if (valid) {
                    if (s > mx) { const float sc = exp2f(mx - s); l *= sc;
#pragma unroll
                        for (int d = 0; d < 32; ++d) acc[d] *= sc;
                        mx = s; }
                    const float pw = exp2f(s - mx); l += pw;
#pragma unroll
                    for (int d = 0; d < 32; ++d) acc[d] += pw * sV[j * 64 + dh * 32 + d];
                }
            }
        }
    }
    const float inv = 1.0f / l;
    v4u* op = (v4u*)(proj + rowq * PLD + PC_Q + h * 64 + dh * 32);
    __syncthreads();
#pragma unroll
    for (int i = 0; i < 4; ++i) { v4u o; o.x = pk2(acc[i * 8] * inv, acc[i * 8 + 1] * inv); o.y = pk2(acc[i * 8 + 2] * inv, acc[i * 8 + 3] * inv); o.z = pk2(acc[i * 8 + 4] * inv, acc[i * 8 + 5] * inv); o.w = pk2(acc[i * 8 + 6] * inv, acc[i * 8 + 7] * inv); op[i] = o; }
}

__device__ __forceinline__ void naive_ssd_pair(bf16* proj, const float* smallp, float* ssq, const float* conv_w  , const float* conv_b, const float* dt_bias, const float* a_log, const float* dskip, int b, int hp, LAS unsigned char* lds, int tidx) {
    constexpr int TB = 32;
    const int tid = tidx & 255, half = tidx >> 8, h = hp * 2 + half, g = h >> 3;
    LAS float* xa = (LAS float*)(lds + half * 65536);
    LAS float* Ba = xa + TB * 64;
    LAS float* Ca = Ba + TB * 128;
    LAS float* ys = Ca + TB * 128;
    LAS float* dta = ys + TB * 64;
    const int p = tid >> 2, nq = tid & 3;
    const float a = -__expf(a_log[h]), dsk = dskip[h], dtb = dt_bias[h];
    float st[32];
#pragma unroll
    for (int i = 0; i < 32; ++i) st[i] = 0.f;
    for (int t0 = 0; t0 < SEQ; t0 += TB) {
        __syncthreads();
        for (int i = tid; i < TB * 320; i += 256) {
            const int tt = i / 320, cc = i % 320; const int t = t0 + tt;
            int ch; if (cc < 64) ch = h * 64 + cc; else if (cc < 192) ch = 1024 + g * 128 + (cc - 64); else ch = 1280 + g * 128 + (cc - 192);
            float s = conv_b[ch];
#pragma unroll
            for (int j = 0; j < 4; ++j) { const int ts = t - 3 + j; if (ts >= 0) s += conv_w[j * 1536 + ch] * bf2f(proj[((size_t)b * SEQ + ts) * PLD + PC_XBC + ch]); }
            s = silu_f(s);
            if (cc < 64) xa[tt * 64 + cc] = s; else if (cc < 192) Ba[tt * 128 + cc - 64] = s; else Ca[tt * 128 + cc - 192] = s;
        }
        if (tid < TB) { const float v = smallp[((size_t)b * SEQ + t0 + tid) * 24 + h] + dtb; dta[tid] = (v > 20.f) ? v : log1pf(__expf(v)); }
        __syncthreads();
        for (int tt = 0; tt < TB; ++tt) {
            const float dt = dta[tt], dA = __expf(dt * a), xv = xa[tt * 64 + p], dtx = dt * xv;
            float y = 0.f;
#pragma unroll
            for (int i = 0; i < 32; ++i) { st[i] = st[i] * dA + dtx * Ba[tt * 128 + nq * 32 + i]; y += Ca[tt * 128 + nq * 32 + i] * st[i]; }
            y += __shfl_xor(y, 1); y += __shfl_xor(y, 2);
            if (nq == 0) ys[tt * 64 + p] = y + dsk * xv;
        }
        __syncthreads();
        {
            const int tt = tid >> 3, pq = tid & 7; const size_t row = (size_t)b * SEQ + t0 + tt;
            bf16* zp = proj + row * PLD + PC_Z + h * 64 + pq * 8;
            const v4u zv = *(const v4u*)zp; float o[8]; float ss = 0.f;
#pragma unroll
            for (int i = 0; i < 8; ++i) { const unsigned w = zv[i >> 1]; const float z = (i & 1) ? bf2f(w >> 16) : bf2f(w & 0xffff); o[i] = ys[tt * 64 + pq * 8 + i] * silu_f(z); ss += o[i] * o[i]; }
            ss += __shfl_xor(ss, 1); ss += __shfl_xor(ss, 2); ss += __shfl_xor(ss, 4);
            v4u ov; ov.x = pk2(o[0], o[1]); ov.y = pk2(o[2], o[3]); ov.z = pk2(o[4], o[5]); ov.w = pk2(o[6], o[7]);
            *(v4u*)zp = ov;
            if (pq == 0) ssq[row * 16 + h] = ss;
        }
    }
    __syncthreads();
}

__device__ __forceinline__ void naive_mlstm_unit(bf16* proj, const float* smallp, const float* conv_w  , const float* conv_b, const float* i_bias, const float* f_bias, const float* norm_w, int b, int hd, LAS unsigned char* lds, int tidx) {
    constexpr int TB = 16;
    LAS float* qa = (LAS float*)lds;
    LAS float* ka = qa + TB * 128;
    LAS float* va = ka + TB * 128;
    LAS float* hs = va + TB * 128;
    LAS float* lia = hs + TB * 128;
    LAS float* lfa = lia + TB;
    const int tid = tidx;
    const int d = tid >> 2, eq = tid & 3;
    const float ib = i_bias[hd], fb = f_bias[hd];
    float C[32], nn[32];
#pragma unroll
    for (int i = 0; i < 32; ++i) { C[i] = 0.f; nn[i] = 0.f; }
    float mst = 0.f;
    for (int t0 = 0; t0 < SEQ; t0 += TB) {
        __syncthreads();
        for (int i = tid; i < TB * 256; i += 512) {
            const int tt = i >> 8, cc = i & 255; const int t = t0 + tt;
            const int ch = (cc < 128) ? (hd * 128 + cc) : (512 + hd * 128 + (cc - 128));
            float s = conv_b[ch];
#pragma unroll
            for (int j = 0; j < 4; ++j) { const int ts = t - 3 + j; if (ts >= 0) s += conv_w[j * 1024 + ch] * bf2f(proj[((size_t)b * SEQ + ts) * PLD + PC_MQK + ch]); }
            s = silu_f(s);
            if (cc < 128) qa[tt * 128 + cc] = s; else ka[tt * 128 + cc - 128] = s * 0.08838834764831845f;
        }
        for (int i = tid; i < TB * 128; i += 512) { const int tt = i >> 7, cc = i & 127; va[tt * 128 + cc] = bf2f(proj[((size_t)b * SEQ + t0 + tt) * PLD + PC_MV + hd * 128 + cc]); }
        if (tid < TB) { const size_t row = (size_t)b * SEQ + t0 + tid; lia[tid] = smallp[row * 24 + 16 + hd] + ib; const float fv = smallp[row * 24 + 20 + hd] + fb;
            lfa[tid] = (fv >= 0.f) ? -log1pf(__expf(-fv)) : (fv - log1pf(__expf(fv))); }
        __syncthreads();
        for (int tt = 0; tt < TB; ++tt) {
            const float li = lia[tt], lf = lfa[tt];
            const float mn = fmaxf(lf + mst, li), fi = __expf(li - mn), ff = __expf(lf + mst - mn); mst = mn;
            const float iv = fi * va[tt * 128 + d];
            float num = 0.f, den = 0.f;
#pragma unroll
            for (int i = 0; i < 32; ++i) { const float kk = ka[tt * 128 + eq * 32 + i], qq = qa[tt * 128 + eq * 32 + i];
                C[i] = ff * C[i] + iv * kk; nn[i] = ff * nn[i] + fi * kk; num += C[i] * qq; den += nn[i] * qq; }
            num += __shfl_xor(num, 1); num += __shfl_xor(num, 2); den += __shfl_xor(den, 1); den += __shfl_xor(den, 2);
            if (eq == 0) hs[tt * 128 + d] = num / fmaxf(fabsf(den), __expf(-mn));
        }
        __syncthreads();
        if (tid < TB * 16) {
            const int tt = tid >> 4, dq = tid & 15; const size_t row = (size_t)b * SEQ + t0 + tt;
            float hv[8]; float ss = 0.f;
#pragma unroll
            for (int i = 0; i < 8; ++i) { hv[i] = hs[tt * 128 + dq * 8 + i]; ss += hv[i] * hv[i]; }
            ss += __shfl_xor(ss, 1); ss += __shfl_xor(ss, 2); ss += __shfl_xor(ss, 4); ss += __shfl_xor(ss, 8);
            const float r = 1.0f / sqrtf(ss * (1.0f / 128.0f) + EPS);
            bf16* op = proj + row * PLD + PC_MO + hd * 128 + dq * 8;
            const v4u ov_ = *(const v4u*)op; float o[8];
#pragma unroll
            for (int i = 0; i < 8; ++i) { const unsigned w = ov_[i >> 1]; const float og = (i & 1) ? bf2f(w >> 16) : bf2f(w & 0xffff);
                o[i] = hv[i] * r * norm_w[hd * 128 + dq * 8 + i] * (1.0f / (1.0f + __expf(-og))); }
            v4u ov; ov.x = pk2(o[0], o[1]); ov.y = pk2(o[2], o[3]); ov.z = pk2(o[4], o[5]); ov.w = pk2(o[6], o[7]);
            *(v4u*)op = ov;
        }
    }
    __syncthreads();
}

constexpr int PH_PER_LAYER = 9, N_PHASES = PH_PER_LAYER * DEPTH;

__global__ void __launch_bounds__(NWAVES * 64, 2) fwd(Args args) {
    extern __shared__ __attribute__((aligned(16))) unsigned char lds[];
    Frame F;
    F.lds = (LAS unsigned char*)lds;
    F.tid = threadIdx.x; F.lane = F.tid & 63; F.wave = __builtin_amdgcn_readfirstlane(F.tid >> 6);
    F.G = gridDim.x; { const int bx = blockIdx.x; F.vcu = (F.G % 8 == 0) ? (bx % 8) * (F.G / 8) + bx / 8 : bx; }
    unsigned char* ws = args.ws;
    F.ctl = (gu32*)(ws + WS_CTL);
    for (int u = F.tid; u < (LDS_BYTES - LDSCTL_OFF) / 4; u += NWAVES * 64) ((LAS unsigned*)(F.lds + LDSCTL_OFF))[u] = 0u;
    __syncthreads();
    volatile LAS unsigned* MISC = (volatile LAS unsigned*)(F.lds + MISC_OFF);
    XcdBarrier bar; bar.bar = (unsigned*)(F.ctl + CW_BAR); bar.x = 0; bar.st = nullptr;
    const bool multi = (args.ph_hi - args.ph_lo) > 1;
    if (multi) bar = xcd_barrier_post((unsigned*)(F.ctl + CW_BAR), MISC + 8);

    bf16* bufa = (bf16*)(ws + WS_BUFA); bf16* bufb = (bf16*)(ws + WS_BUFB); bf16* xb = (bf16*)(ws + WS_XB); bf16* proj = (bf16*)(ws + WS_PROJ);
    float* smallp = (float*)(ws + WS_SMALLP); float* ssq = (float*)(ws + WS_SSQ);
    float* out = args.out;

    for (int ph = args.ph_lo; ph < args.ph_hi; ++ph) {
        const int l = ph / PH_PER_LAYER, p = ph % PH_PER_LAYER;
        { int t_ = threadIdx.x; asm volatile("" : "+v"(t_)); F.tid = t_; F.lane = t_ & 63; F.wave = __builtin_amdgcn_readfirstlane(t_ >> 6); }
        const float* xin = (l == 0) ? args.in[0] : out;
        switch (p) {
        case 0: {
            convert_weights(F, 0, args.in[2] + (size_t)l * DM * P_IN, args.in[16] + (size_t)l * DMIX * DM, bufa, bufb, (LAS float*)(F.lds + F.wave * 16384));
            __syncthreads();
            row_pass(F, xin, args.in[1] + l * DM, xb, args.in[2] + (size_t)l * DM * P_IN, smallp, (LAS float*)(F.lds));
        } break;
        case 1: {
            pg8::Gemm g{xb, bufa, M, PLD, DM, DM}; pg8::StaticOrder S; S.init(M, PLD, F.G, (int)blockIdx.x);
            pg8::EpiProj E{proj, args.in[3] + l * 64, args.in[4] + l * 64};
            pg8::gemm_phase<pg8::EpiProj>(F.lds + RING_OFF, g, S, E);
        } break;
        case 2: {
            for (int pi = F.vcu; pi < 256; pi += F.G) {
                const int bh = pi >> 2, s4 = pi & 3;
                naive_attn_unit(F.tid, proj, bh >> 3, bh & 7, s4, F.lds);
                naive_attn_unit(F.tid, proj, bh >> 3, bh & 7, 7 - s4, F.lds);
                __syncthreads();
                if (pi < 64) naive_ssd_pair(proj, smallp, ssq, args.in[5] + (size_t)l * 4 * 1536, args.in[6] + l * 1536, args.in[7] + l * 16, args.in[8] + l * 16, args.in[9] + l * 16, pi >> 3, pi & 7, F.lds, F.tid);
                else if (pi < 96) naive_mlstm_unit(proj, smallp, args.in[11] + (size_t)l * 4 * 1024, args.in[12] + l * 1024, args.in[13] + l * 4, args.in[14] + l * 4, args.in[15] + l * 512, (pi - 64) >> 2, (pi - 64) & 3, F.lds, F.tid);
            }
        } break;
        case 3: ssd_finalize(F, proj, ssq, args.in[10] + l * 1024); break;
        case 4: {
            pg8::Gemm g{proj, bufb, M, DM, DMIX, PLD}; pg8::StaticOrder S; S.init(M, DM, F.G, (int)blockIdx.x);
            pg8::EpiRes E{xin, out, DM};
            pg8::gemm_phase<pg8::EpiRes>(F.lds + RING_OFF, g, S, E);
        } break;
        case 5: {
            convert_weights(F, 1, args.in[18] + (size_t)l * DM * ULD, args.in[21] + (size_t)l * FFN * DM, bufa, bufb, (LAS float*)(F.lds + F.wave * 16384));
            __syncthreads();
            row_pass(F, out, args.in[17] + l * DM, xb, nullptr, nullptr, nullptr);
        } break;
        case 6: {
            pg8::Gemm g{xb, bufa, M, ULD, DM, DM}; pg8::StaticOrder S; S.init(M, ULD, F.G, (int)blockIdx.x);
            pg8::EpiBf16 E{proj, ULD};
            pg8::gemm_phase<pg8::EpiBf16>(F.lds + RING_OFF, g, S, E);
        } break;
        case 7: ffn_ew(F, proj, args.in[19] + (size_t)l * 3 * FFN, args.in[20] + l * FFN); break;
        case 8: {
            pg8::Gemm g{proj + FFN, bufb, M, DM, FFN, ULD}; pg8::StaticOrder S; S.init(M, DM, F.G, (int)blockIdx.x);
            pg8::EpiRes E{out, out, DM};
            pg8::gemm_phase<pg8::EpiRes>(F.lds + RING_OFF, g, S, E);
        } break;
        }
        if (ph + 1 < args.ph_hi) xcd_barrier(bar);
    }
}

extern "C" void kernel_launch(void* const* d_in, const int* in_sizes, int n_in, void* d_out, int out_size, void* d_ws, size_t ws_size, hipStream_t stream) {
    static int grid = 0;
    if (grid == 0) {
        if (n_in != 22 || in_sizes[0] != M * DM || out_size != M * DM || ws_size < WS_END) { fprintf(stderr, "kernel_launch: unexpected shapes (n_in %d, in0 %d, out %d, ws %zu); nothing launched\n", n_in, n_in > 0 ? in_sizes[0] : -1, out_size, ws_size); grid = -1; return; }
        int dev = 0, cus = 0, per_cu = 0;
        if (hipGetDevice(&dev) != hipSuccess || hipDeviceGetAttribute(&cus, hipDeviceAttributeMultiprocessorCount, dev) != hipSuccess) { grid = -1; return; }
        if (hipFuncSetAttribute((const void*)fwd, hipFuncAttributeMaxDynamicSharedMemorySize, LDS_BYTES) != hipSuccess) { fprintf(stderr, "kernel_launch: hipFuncSetAttribute failed\n"); grid = -1; return; }
        if (hipOccupancyMaxActiveBlocksPerMultiprocessor(&per_cu, (const void*)fwd, NWAVES * 64, LDS_BYTES) != hipSuccess || per_cu < 1) { fprintf(stderr, "kernel_launch: occupancy query reports %d blocks per CU\n", per_cu); per_cu = 1; }
        (void)hipGetLastError();
        grid = cus;
    }
    if (grid < 0) return;
    (void)hipMemsetAsync((char*)d_ws + WS_CTL, 0, CTL_ZERO_BYTES, stream);
    Args a{};
    for (int i = 0; i < 22; ++i) a.in[i] = (const float*)d_in[i];
    a.out = (float*)d_out; a.ws = (unsigned char*)d_ws;
#if MK_MULTI
    for (int ph = 0; ph < N_PHASES; ++ph) {
        a.ph_lo = ph; a.ph_hi = ph + 1;
        hipLaunchKernelGGL(fwd, dim3(grid), dim3(NWAVES * 64), LDS_BYTES, stream, a);
    }
#else
    a.ph_lo = 0; a.ph_hi = N_PHASES;
    hipLaunchKernelGGL(fwd, dim3(grid), dim3(NWAVES * 64), LDS_BYTES, stream, a);
#endif
}
```

```cpp
#include <hip/hip_runtime.h>
#include <cstdio>
#include <cstdint>
#include <cmath>

#ifndef MK_MULTI
#define MK_MULTI 0
#endif

constexpr int BATCH = 8, SEQ = 2048, DM = 1024, DEPTH = 2;
constexpr int M = BATCH * SEQ;
constexpr int P_IN = 6168;
constexpr int PLD = 6144;
constexpr int PC_Q = 0, PC_Z = 512, PC_MO = 1536, PC_K = 2048, PC_V = 2560, PC_XBC = 3072, PC_MQK = 4608, PC_MV = 5632;
constexpr int SC_Q = 0, SC_K = 512, SC_V = 1024, SC_Z = 1536, SC_XBC = 2560, SC_DT = 4096, SC_MQK = 4112, SC_MV = 5136, SC_MO = 5648, SC_MI = 6160, SC_MF = 6164;
constexpr int FFN = 2816, ULD = 5632;
constexpr int DMIX = 2048;
constexpr float EPS = 1e-6f;
constexpr float C2 = 0.125f * 1.4426950408889634f;

constexpr size_t MiB = 1u << 20;
constexpr size_t WS_CTL = 0, CTL_ZERO_BYTES = 1 * MiB;
constexpr size_t WS_SMALLP = 1 * MiB;
constexpr size_t WS_SSQ = 3 * MiB - 512 * 1024;
constexpr size_t WS_BUFA = 4 * MiB;
constexpr size_t WS_BUFB = 16 * MiB;
constexpr size_t WS_XB = 22 * MiB;
constexpr size_t WS_PROJ = 64 * MiB;
constexpr size_t WS_END = 256 * MiB;

namespace pg8 {
#define PG8_LAS __attribute__((address_space(3)))
typedef unsigned short bf16_t;
typedef short bf16x8 __attribute__((ext_vector_type(8)));
typedef float f32x4 __attribute__((ext_vector_type(4)));
typedef unsigned u32x4 __attribute__((ext_vector_type(4)));
constexpr int BM = 256, BK = 64, HALF = 128, HTB = HALF * BK * 2, STAGE_BYTES = 8 * HTB, NXCD = 8, WGM = 8;

__host__ __device__ __forceinline__ int lds_byte(int r, int c) { const int st = (r >> 4) * 2 + (c >> 5), rr = r & 15, cc = c & 31, ob = rr * 64 + cc * 2; return st * 1024 + (ob ^ (((ob >> 9) & 1) << 5)); }
__host__ __device__ __forceinline__ void stage_rc(int b, int& R, int& C) { const int st = b / 1024, sb = b % 1024, swz = sb ^ (((sb >> 9) & 1) << 5); R = (st >> 1) * 16 + swz / 64; C = (st & 1) * 32 + (swz % 64) / 2; }
__host__ __device__ __forceinline__ int perm32(int rho) { const int n = rho >> 4, i = rho & 15; return 8 * (i >> 2) + 4 * n + (i & 3); }

struct Unit { int pm, pn; };
struct Gemm { const bf16_t* A; const bf16_t* Bt; int M, N, K, lda; };

struct StaticOrder {
    int nM, nN, nwg, G, c;
    __host__ __device__ void init(int M_, int N_, int G_, int c_) { nM = M_ / BM; nN = N_ / BM; nwg = nM * nN; G = G_; c = c_; }
    __host__ __device__ bool next(int i, Unit& u) const {
        const long L = (long)i * G + c; if (L >= nwg) return false;
        int wgid = (int)L; { const int q = nwg / NXCD, r = nwg % NXCD, xcd = wgid % NXCD, off = wgid / NXCD; wgid = (xcd < r ? xcd * (q + 1) : r * (q + 1) + (xcd - r) * q) + off; }
        const int nig = WGM * nN, gid = wgid / nig, fm = gid * WGM, gsz = (nM - fm) < WGM ? (nM - fm) : WGM;
        u.pm = fm + ((wgid % nig) % gsz); u.pn = (wgid % nig) / gsz; return true;
    }
};

__device__ __forceinline__ unsigned cvt_pk_bf16(float lo, float hi) { unsigned r; asm volatile("v_cvt_pk_bf16_f32 %0, %1, %2" : "=v"(r) : "v"(lo), "v"(hi)); return r; }

struct EpiBf16 {
    static constexpr bool PERM = true;
    bf16_t* O; int ldc;
    __device__ __forceinline__ void operator()(const f32x4 (&acc)[2][2][4][2], const Unit& u, int wr, int wc, int fr, int fq) const {
        const int row0 = u.pm * BM + wr * 64 + fr; const int col0 = u.pn * BM + wc * 32 + 8 * fq;
#pragma unroll
        for (int ai = 0; ai < 2; ++ai)
#pragma unroll
            for (int m = 0; m < 4; ++m) { bf16_t* rowp = O + (size_t)(row0 + ai * HALF + m * 16) * ldc + col0;
#pragma unroll
                for (int bj = 0; bj < 2; ++bj) { const f32x4 v0 = acc[ai][bj][m][0], v1 = acc[ai][bj][m][1];
                    u32x4 w; w.x = cvt_pk_bf16(v0[0], v0[1]); w.y = cvt_pk_bf16(v0[2], v0[3]); w.z = cvt_pk_bf16(v1[0], v1[1]); w.w = cvt_pk_bf16(v1[2], v1[3]);
                    *(u32x4*)(rowp + bj * HALF) = w; } }
    }
};
struct EpiProj {
    static constexpr bool PERM = true;
    bf16_t* P; const float* qw; const float* kw;
    __device__ __forceinline__ void operator()(const f32x4 (&acc)[2][2][4][2], const Unit& u, int wr, int wc, int fr, int fq) const {
        const int pn = u.pn; const bool isq = pn < 2, isk = (pn == 8 || pn == 9);
        const int row0 = u.pm * BM + wr * 64 + fr;
        if (!(isq || isk)) {
            const int col0 = pn * BM + wc * 32 + 8 * fq;
#pragma unroll
            for (int ai = 0; ai < 2; ++ai)
#pragma unroll
                for (int m = 0; m < 4; ++m) { bf16_t* rowp = P + (size_t)(row0 + ai * HALF + m * 16) * PLD + col0;
#pragma unroll
                    for (int bj = 0; bj < 2; ++bj) { const f32x4 v0 = acc[ai][bj][m][0], v1 = acc[ai][bj][m][1];
                        u32x4 w; w.x = cvt_pk_bf16(v0[0], v0[1]); w.y = cvt_pk_bf16(v0[2], v0[3]); w.z = cvt_pk_bf16(v1[0], v1[1]); w.w = cvt_pk_bf16(v1[2], v1[3]);
                        *(u32x4*)(rowp + bj * HALF) = w; } }
        } else {
            const float* w = isq ? qw : kw; const float post = isq ? C2 : 1.0f;
            const int colb = pn * BM + 64 * wc + 8 * fq;
#pragma unroll
            for (int ai = 0; ai < 2; ++ai)
#pragma unroll
                for (int m = 0; m < 4; ++m) {
                    float ss = 0.f;
#pragma unroll
                    for (int bj = 0; bj < 2; ++bj)
#pragma unroll
                        for (int n = 0; n < 2; ++n) { const f32x4 x = acc[ai][bj][m][n]; ss += (x[0] * x[0] + x[1] * x[1]) + (x[2] * x[2] + x[3] * x[3]); }
                    ss += __shfl_xor(ss, 16); ss += __shfl_xor(ss, 32);
                    const float r = (1.0f / sqrtf(ss * (1.0f / 64.0f) + EPS)) * post;
                    bf16_t* rowp = P + (size_t)(row0 + ai * HALF + m * 16) * PLD + colb;
#pragma unroll
                    for (int bj = 0; bj < 2; ++bj) { const f32x4 w0 = *(const f32x4*)(w + 32 * bj + 8 * fq), w1 = *(const f32x4*)(w + 32 * bj + 8 * fq + 4);
                        const f32x4 v0 = acc[ai][bj][m][0] * r * w0, v1 = acc[ai][bj][m][1] * r * w1;
                        u32x4 o; o.x = cvt_pk_bf16(v0[0], v0[1]); o.y = cvt_pk_bf16(v0[2], v0[3]); o.z = cvt_pk_bf16(v1[0], v1[1]); o.w = cvt_pk_bf16(v1[2], v1[3]);
                        *(u32x4*)(rowp + 32 * bj) = o; }
                    asm volatile("" ::: "memory");
                }
        }
    }
};
struct EpiRes {
    static constexpr bool PERM = false;
    const float* base; float* out; int ldc;
    __device__ __forceinline__ void operator()(const f32x4 (&acc)[2][2][4][2], const Unit& u, int wr, int wc, int fr, int fq) const {
        const int row0 = u.pm * BM + wr * 64 + fr, col0 = u.pn * BM + wc * 32 + 4 * fq;
#pragma unroll
        for (int ai = 0; ai < 2; ++ai)
#pragma unroll
            for (int m = 0; m < 4; ++m) { const size_t off = (size_t)(row0 + ai * HALF + m * 16) * ldc + col0;
#pragma unroll
                for (int bj = 0; bj < 2; ++bj)
#pragma unroll
                    for (int n = 0; n < 2; ++n) { const f32x4 b = *(const f32x4*)(base + off + bj * HALF + n * 16); *(f32x4*)(out + off + bj * HALF + n * 16) = b + acc[ai][bj][m][n]; } }
    }
};

template <class Epi>
__device__ __forceinline__ void gemm_phase(PG8_LAS unsigned char* lds, const Gemm g, const StaticOrder& S, const Epi& E, int tid_) {
    asm volatile("" : "+v"(tid_));
    const int tid = tid_, wid = __builtin_amdgcn_readfirstlane(tid >> 6), lane = tid & 63, wr = wid >> 2, wc = wid & 3, fr = lane & 15, fq = lane >> 4;
    const int K = g.K, nt = K / BK, lda = g.lda;
    unsigned voffA[2], voffB[2];
#pragma unroll
    for (int i = 0; i < 2; ++i) { int R, C; stage_rc(tid * 16 + i * 8192, R, C); const int Rb = Epi::PERM ? ((R & ~31) + perm32(R & 31)) : R;
        voffA[i] = (unsigned)(R * lda + C) * 2u; voffB[i] = (unsigned)(Rb * K + C) * 2u; }
    const size_t kstep = (size_t)(BK * 2);
    const size_t hstepA = (size_t)HALF * lda * 2, hstepB = (size_t)HALF * K * 2;
    const size_t tstepA = 2 * hstepA, tstepB = 2 * hstepB;
    const unsigned ldsw = (unsigned)wid * 1024u;
    const int aoff = lds_byte(wr * 64 + fr, fq * 8), boff = lds_byte(wc * 32 + fr, fq * 8);
#define PG8_SA(b, h) (((b) * 2 + (h)) * HTB)
#define PG8_SB(b, h) ((4 + (b) * 2 + (h)) * HTB)
#define PG8_STAGE(bufoff, gbase, voff) do { _Pragma("unroll") for (int _i = 0; _i < 2; ++_i) \
        __builtin_amdgcn_global_load_lds((const unsigned*)((const char*)(gbase) + (voff)[_i]), (PG8_LAS unsigned*)(lds + (bufoff) + ldsw + _i * 8192), 16, 0, 0); } while (0)
#define PG8_LDA(dst, b, h) do { _Pragma("unroll") for (int m = 0; m < 4; ++m) _Pragma("unroll") for (int k = 0; k < 2; ++k) dst[m][k] = *(const PG8_LAS bf16x8*)(lds + PG8_SA(b, h) + aoff + m * 2048 + k * 1024); } while (0)
#define PG8_LDB(dst, b, h) do { _Pragma("unroll") for (int n = 0; n < 2; ++n) _Pragma("unroll") for (int k = 0; k < 2; ++k) dst[n][k] = *(const PG8_LAS bf16x8*)(lds + PG8_SB(b, h) + boff + n * 2048 + k * 1024); } while (0)
#define PG8_MMA(ai, bj, At, Bt) do { __builtin_amdgcn_s_setprio(1); _Pragma("unroll") for (int m = 0; m < 4; ++m) _Pragma("unroll") for (int n = 0; n < 2; ++n) _Pragma("unroll") for (int k = 0; k < 2; ++k) \
        acc[ai][bj][m][n] = __builtin_amdgcn_mfma_f32_16x16x32_bf16(Bt[n][k], At[m][k], acc[ai][bj][m][n], 0, 0, 0); __builtin_amdgcn_s_setprio(0); } while (0)
#define PG8_WAIT_V(n) asm volatile("s_waitcnt vmcnt(" #n ")" ::: "memory")
#define PG8_WAIT_L(n) asm volatile("s_waitcnt lgkmcnt(" #n ")" ::: "memory")
#define PG8_BAR __builtin_amdgcn_s_barrier()
#define PG8_SCHED __builtin_amdgcn_sched_barrier(0)
    Unit cur, nxt; int ui = 0;
    if (!S.next(0, cur)) return;
    f32x4 acc[2][2][4][2];
#pragma unroll
    for (int a = 0; a < 2; ++a)
#pragma unroll
        for (int b = 0; b < 2; ++b)
#pragma unroll
            for (int m = 0; m < 4; ++m)
#pragma unroll
                for (int n = 0; n < 2; ++n) acc[a][b][m][n] = (f32x4){0.f, 0.f, 0.f, 0.f};
    bf16x8 At[4][2], B0[2][2], B1[2][2];
    const char* cA = (const char*)g.A + (size_t)cur.pm * tstepA; const char* cB = (const char*)g.Bt + (size_t)cur.pn * tstepB;
    PG8_STAGE(PG8_SB(0, 0), cB, voffB); PG8_STAGE(PG8_SB(0, 1), cB + hstepB, voffB); PG8_STAGE(PG8_SA(0, 0), cA, voffA); PG8_STAGE(PG8_SA(0, 1), cA + hstepA, voffA);
    if (wr == 1) PG8_BAR;
    PG8_WAIT_V(2); PG8_BAR;
    PG8_STAGE(PG8_SB(1, 0), cB + kstep, voffB); PG8_STAGE(PG8_SA(1, 0), cA + kstep, voffA); PG8_STAGE(PG8_SB(1, 1), cB + hstepB + kstep, voffB);
    PG8_WAIT_V(6); PG8_BAR;
    for (;;) {
        const bool has_next = S.next(ui + 1, nxt);
        const char* nA = has_next ? (const char*)g.A + (size_t)nxt.pm * tstepA : cA; const char* nB = has_next ? (const char*)g.Bt + (size_t)nxt.pn * tstepB : cB;
        for (int t = 0; t < nt; t += 2) {
            const bool last = (t == nt - 2);
            const char* a1 = cA + (size_t)(t + 1) * kstep;
            const char* a2 = last ? nA : cA + (size_t)(t + 2) * kstep; const char* b2 = last ? nB : cB + (size_t)(t + 2) * kstep;
            const char* a3 = a2 + kstep; const char* b3 = b2 + kstep;
            PG8_LDB(B0, 0, 0); PG8_LDB(B1, 0, 1); PG8_SCHED; PG8_LDA(At, 0, 0); PG8_STAGE(PG8_SA(1, 1), a1 + hstepA, voffA);
            PG8_WAIT_V(8); PG8_WAIT_L(0); PG8_BAR; PG8_MMA(0, 0, At, B0); PG8_MMA(0, 1, At, B1); PG8_BAR; PG8_SCHED;
            PG8_LDA(At, 0, 1); PG8_STAGE(PG8_SB(0, 0), b2, voffB); PG8_STAGE(PG8_SB(0, 1), b2 + hstepB, voffB); PG8_STAGE(PG8_SA(0, 0), a2, voffA);
            PG8_WAIT_V(8); PG8_WAIT_L(0); PG8_BAR; PG8_MMA(1, 0, At, B0); PG8_MMA(1, 1, At, B1); PG8_BAR; PG8_SCHED;
            PG8_LDB(B0, 1, 0); PG8_LDB(B1, 1, 1); PG8_SCHED; PG8_LDA(At, 1, 0); PG8_STAGE(PG8_SA(0, 1), a2 + hstepA, voffA);
            PG8_WAIT_V(8); PG8_WAIT_L(0); PG8_BAR; PG8_MMA(0, 0, At, B0); PG8_MMA(0, 1, At, B1); PG8_BAR; PG8_SCHED;
            PG8_LDA(At, 1, 1); PG8_STAGE(PG8_SB(1, 0), b3, voffB); PG8_STAGE(PG8_SB(1, 1), b3 + hstepB, voffB); PG8_STAGE(PG8_SA(1, 0), a3, voffA);
            PG8_WAIT_V(8); PG8_WAIT_L(0); PG8_BAR; PG8_MMA(1, 0, At, B0); PG8_MMA(1, 1, At, B1); PG8_BAR; PG8_SCHED;
        }
        if (wr == 0) PG8_BAR;
        E(acc, cur, wr, wc, fr, fq);
        if (!has_next) break;
#pragma unroll
        for (int a = 0; a < 2; ++a)
#pragma unroll
            for (int b = 0; b < 2; ++b)
#pragma unroll
                for (int m = 0; m < 4; ++m)
#pragma unroll
                    for (int n = 0; n < 2; ++n) acc[a][b][m][n] = (f32x4){0.f, 0.f, 0.f, 0.f};
        cur = nxt; cA = nA; cB = nB; ++ui;
        if (wr == 1) PG8_BAR;
    }
    PG8_WAIT_V(0);
    PG8_BAR;
#undef PG8_SA
#undef PG8_SB
#undef PG8_STAGE
#undef PG8_LDA
#undef PG8_LDB
#undef PG8_MMA
#undef PG8_WAIT_V
#undef PG8_WAIT_L
#undef PG8_BAR
#undef PG8_SCHED
}
}

constexpr int NWAVES = 8;
constexpr int RING_OFF = 0, RING_BYTES = 131072;
constexpr int LDS_BYTES = 147456;
constexpr int LDSCTL_OFF = LDS_BYTES - 512, MISC_OFF = LDSCTL_OFF + 320;
constexpr int CW_BAR = 4096;

#define GAS __attribute__((address_space(1)))
#define LAS __attribute__((address_space(3)))
typedef unsigned short bf16;
typedef unsigned v4u __attribute__((ext_vector_type(4)));
typedef float f32x4 __attribute__((ext_vector_type(4)));
typedef GAS unsigned gu32;
#define RLX_AGENT __ATOMIC_RELAXED, __HIP_MEMORY_SCOPE_AGENT
#define LDS_WAIT() asm volatile("s_waitcnt lgkmcnt(0)" ::: "memory")
#define VM_WAIT() asm volatile("s_waitcnt vmcnt(0)" ::: "memory")
__device__ __forceinline__ unsigned f2bf(float f) { unsigned u = __builtin_bit_cast(unsigned, f); return (u + 0x7fffu + ((u >> 16) & 1u)) >> 16; }
__device__ __forceinline__ unsigned pk2(float lo, float hi) { return f2bf(lo) | (f2bf(hi) << 16); }
__device__ __forceinline__ float bf2f(unsigned short b) { return __uint_as_float(((unsigned)b) << 16); }

#define XB_TMO      128
#define XB_XCNT(j)  (256  + 64 * (j))
#define XB_XSUB(j)  (1280 + 64 * (j))
#define XB_XGEN(j)  (2304 + 64 * (j))
#define XB_TOP      3328
#define XB_TOPGEN   3392
#define XCD_BAR_WORDS 3456
#define XB_SPIN_CAP (1u << 18)
__device__ __forceinline__ unsigned xb_ld(unsigned* p)              { return __hip_atomic_load(p, __ATOMIC_RELAXED, __HIP_MEMORY_SCOPE_AGENT); }
__device__ __forceinline__ unsigned xb_add(unsigned* p, unsigned v) { return __hip_atomic_fetch_add(p, v, __ATOMIC_RELAXED, __HIP_MEMORY_SCOPE_AGENT); }
__device__ __forceinline__ unsigned xb_xcc_id() { return (unsigned)__builtin_amdgcn_s_getreg((3 << 11) | 20) & 0xFu; }
#define XB_SPIN(cond, bar) do { unsigned _sp = 0; while (cond) { __builtin_amdgcn_s_sleep(1); \
    if ((++_sp & 255u) == 0u) { if (xb_ld(&(bar)[XB_TMO])) break; if (_sp > XB_SPIN_CAP) { atomicAdd(&(bar)[XB_TMO], 1u); break; } } } } while (0)
struct XcdBarrier { unsigned* bar; unsigned x; volatile LAS unsigned* st; };
__device__ __forceinline__ XcdBarrier xcd_barrier_post(unsigned* bar, volatile LAS unsigned* st) {
    XcdBarrier b; b.bar = bar; b.x = xb_xcc_id(); b.st = st;
    if (threadIdx.x == 0) (void)xb_add(&bar[XB_XCNT(b.x)], 1u);
    return b;
}
__device__ __forceinline__ void xcd_barrier_complete(unsigned* bar, unsigned x, unsigned& nloc, unsigned& nx) {
    const unsigned G = gridDim.x * gridDim.y * gridDim.z;
    unsigned sum, cnt, mine, sp = 0u;
    for (;;) {
        sum = 0u; cnt = 0u; mine = 0u;
#pragma unroll
        for (unsigned j = 0; j < 16; ++j) { const unsigned c = xb_ld(&bar[XB_XCNT(j)]); sum += c; cnt += (c > 0u) ? 1u : 0u; mine = (j == x) ? c : mine; }
        if (sum == G) break;
        __builtin_amdgcn_s_sleep(1);
        if ((++sp & 255u) == 0u) { if (xb_ld(&bar[XB_TMO])) break; if (sp > XB_SPIN_CAP) { atomicAdd(&bar[XB_TMO], 1u); break; } }
    }
    nloc = mine > 0u ? mine : 1u; nx = cnt > 0u ? cnt : 1u;
}
__device__ __forceinline__ void xcd_barrier(const XcdBarrier& b, int tid) {
    asm volatile("s_waitcnt vmcnt(0)" ::: "memory");
    __syncthreads();
    if (tid == 0) {
        unsigned* bar = b.bar;
        __builtin_amdgcn_s_waitcnt(0);
        unsigned nloc = b.st[0], nx = b.st[1];
        if (nloc == 0u) { xcd_barrier_complete(bar, b.x, nloc, nx); b.st[0] = nloc; b.st[1] = nx; }
        const unsigned old = xb_add(&bar[XB_XSUB(b.x)], 1u);
        const unsigned gen = old / nloc;
        if (old + 1u == (gen + 1u) * nloc) {
            __builtin_amdgcn_fence(__ATOMIC_RELEASE, "agent");
            asm volatile("s_waitcnt vmcnt(0)" ::: "memory");
            const unsigned og = xb_add(&bar[XB_TOP], 1u);
            const unsigned tg = og / nx;
            if (og + 1u == (tg + 1u) * nx) xb_add(&bar[XB_TOPGEN], 1u);
            else XB_SPIN(xb_ld(&bar[XB_TOPGEN]) == tg, bar);
            __builtin_amdgcn_fence(__ATOMIC_ACQUIRE, "agent");
            xb_add(&bar[XB_XGEN(b.x)], 1u);
            asm volatile("s_waitcnt vmcnt(0)" ::: "memory");
        } else {
            XB_SPIN(xb_ld(&bar[XB_XGEN(b.x)]) == gen, bar);
            __builtin_amdgcn_fence(__ATOMIC_ACQUIRE, "agent");
            asm volatile("s_waitcnt vmcnt(0)" ::: "memory");
        }
    }
    __syncthreads();
}

struct Args { const float* in[22]; float* out; unsigned char* ws; int ph_lo, ph_hi; };

struct Frame {
    LAS unsigned char* lds;
    int tid, lane, wave;
    int vcu, G;
};

__device__ __forceinline__ float wave_sum(float v) {
#pragma unroll
    for (int o = 1; o < 64; o <<= 1) v += __shfl_xor(v, o);
    return v;
}

__device__ __forceinline__ void conv_item(const float* W, int ldw, int srccol0, bf16* WT, int K, int dstrow0, int k0, LAS float* scr, int lane) {
#pragma unroll 8
    for (int i = 0; i < 32; ++i) { const int kk = 2 * i + (lane >> 5); scr[kk * 33 + (lane & 31)] = W[(size_t)(k0 + kk) * ldw + srccol0 + (lane & 31)]; }
    LDS_WAIT(); asm volatile("" ::: "memory");
    const int c = lane & 7;
#pragma unroll
    for (int j = 0; j < 4; ++j) { const int n = (lane >> 3) + 8 * j; const LAS float* s = scr + (8 * c) * 33 + n;
        v4u o; o.x = pk2(s[0 * 33], s[1 * 33]); o.y = pk2(s[2 * 33], s[3 * 33]); o.z = pk2(s[4 * 33], s[5 * 33]); o.w = pk2(s[6 * 33], s[7 * 33]);
        *(GAS v4u*)(WT + (size_t)(dstrow0 + n) * K + k0 + 8 * c) = o; }
    LDS_WAIT(); asm volatile("" ::: "memory");
}
__device__ __forceinline__ int in_src_col(int n0) {
    const int tile = n0 >> 8, p = n0 & 255; int dest;
    if (tile < 2 || tile == 8 || tile == 9) { const int bj = p >> 7, wc = (p >> 5) & 3; dest = (tile << 8) + 64 * wc + 32 * bj; } else dest = n0;
    if (dest < PC_Z) return SC_Q + dest;
    if (dest < PC_MO) return SC_Z + dest - PC_Z;
    if (dest < PC_K) return SC_MO + dest - PC_MO;
    if (dest < PC_V) return SC_K + dest - PC_K;
    if (dest < PC_XBC) return SC_V + dest - PC_V;
    if (dest < PC_MQK) return SC_XBC + dest - PC_XBC;
    if (dest < PC_MV) return SC_MQK + dest - PC_MQK;
    return SC_MV + dest - PC_MV;
}
__device__ __forceinline__ void convert_weights(Frame& F, int which, const float* Wa, const float* Wb, bf16* bufa, bf16* bufb, LAS float* scr) {
    const int gw = F.vcu * NWAVES + F.wave, NGW = F.G * NWAVES;
    if (which == 0) {
        constexpr int IA = (DM / 64) * (PLD / 32), IB = (DMIX / 64) * (DM / 32);
        for (int it = gw; it < IA + IB; it += NGW) {
            if (it < IA) { const int nblk = PLD / 32, kb = it / nblk, nb = it % nblk; conv_item(Wa, P_IN, in_src_col(32 * nb), bufa, DM, 32 * nb, 64 * kb, scr, F.lane); }
            else { const int r = it - IA, nblk = DM / 32, kb = r / nblk, nb = r % nblk; conv_item(Wb, DM, 32 * nb, bufb, DMIX, 32 * nb, 64 * kb, scr, F.lane); }
        }
    } else {
        constexpr int IA = (DM / 64) * (ULD / 32), IB = (FFN / 64) * (DM / 32);
        for (int it = gw; it < IA + IB; it += NGW) {
            if (it < IA) { const int nblk = ULD / 32, kb = it / nblk, nb = it % nblk; conv_item(Wa, ULD, 32 * nb, bufa, DM, 32 * nb, 64 * kb, scr, F.lane); }
            else { const int r = it - IA, nblk = DM / 32, kb = r / nblk, nb = r % nblk; conv_item(Wb, DM, 32 * nb, bufb, FFN, 32 * nb, 64 * kb, scr, F.lane); }
        }
    }
}
__device__ __forceinline__ void row_pass(Frame& F, const float* x, const float* nw, bf16* xb, const float* w_in  , float* smallp, LAS float* wsm  ) {
    if (w_in) {
        for (int k = F.tid; k < DM; k += NWAVES * 64) {
            const float* src = w_in + (size_t)k * P_IN;
#pragma unroll
            for (int c = 0; c < 16; ++c) wsm[c * DM + k] = src[SC_DT + c];
#pragma unroll
            for (int c = 0; c < 8; ++c) wsm[(16 + c) * DM + k] = src[SC_MI + c];
        }
        LDS_WAIT(); __syncthreads();
    }
    const int gw = F.vcu * NWAVES + F.wave, NGW = F.G * NWAVES;
    f32x4 wv[4];
#pragma unroll
    for (int j = 0; j < 4; ++j) wv[j] = ((const GAS f32x4*)nw)[64 * j + F.lane];
    for (int m = gw; m < M; m += NGW) {
        const GAS f32x4* xr = (const GAS f32x4*)(x + (size_t)m * DM) + F.lane;
        f32x4 v[4]; float s = 0.f;
#pragma unroll
        for (int j = 0; j < 4; ++j) { v[j] = xr[64 * j]; s += (v[j].x * v[j].x + v[j].y * v[j].y) + (v[j].z * v[j].z + v[j].w * v[j].w); }
        const float r = 1.0f / sqrtf(wave_sum(s) * (1.0f / DM) + EPS);
#pragma unroll
        for (int j = 0; j < 4; ++j) v[j] = v[j] * r * wv[j];
        GAS unsigned long long* o8 = (GAS unsigned long long*)(xb + (size_t)m * DM) + F.lane;
#pragma unroll
        for (int j = 0; j < 4; ++j) o8[64 * j] = (unsigned long long)pk2(v[j].x, v[j].y) | ((unsigned long long)pk2(v[j].z, v[j].w) << 32);
        if (w_in) {
            float mine = 0.f;
            for (int c = 0; c < 24; ++c) {
                float d = 0.f;
#pragma unroll
                for (int j = 0; j < 4; ++j) { const f32x4 w4 = *(const LAS f32x4*)(wsm + c * DM + 4 * (64 * j + F.lane)); d += (v[j].x * w4.x + v[j].y * w4.y) + (v[j].z * w4.z + v[j].w * w4.w); }
                d = wave_sum(d);
                if (F.lane == c) mine = d;
            }
            if (F.lane < 24) smallp[(size_t)m * 24 + F.lane] = mine;
        }
    }
}
__device__ __forceinline__ void ssd_finalize(Frame& F, bf16* proj, const float* ssq, const float* nw) {
    const int gt = F.vcu * (NWAVES * 64) + F.tid, NT = F.G * NWAVES * 64;
    for (int it = gt; it < M * 128; it += NT) {
        const int row = it >> 7, c0 = (it & 127) * 8, g = c0 >> 9;
        float s = 0.f;
#pragma unroll
        for (int h = 0; h < 8; ++h) s += ssq[(size_t)row * 16 + g * 8 + h];
        const float r = 1.0f / sqrtf(s * (1.0f / 512.0f) + EPS);
        v4u* p = (v4u*)(proj + (size_t)row * PLD + PC_Z + c0);
        v4u v = *p; const f32x4 w0 = *(const f32x4*)(nw + c0), w1 = *(const f32x4*)(nw + c0 + 4);
        v4u o;
        o.x = pk2(bf2f(v.x & 0xffff) * r * w0.x, bf2f(v.x >> 16) * r * w0.y); o.y = pk2(bf2f(v.y & 0xffff) * r * w0.z, bf2f(v.y >> 16) * r * w0.w);
        o.z = pk2(bf2f(v.z & 0xffff) * r * w1.x, bf2f(v.z >> 16) * r * w1.y); o.w = pk2(bf2f(v.w & 0xffff) * r * w1.z, bf2f(v.w >> 16) * r * w1.w);
        *p = o;
    }
}
__device__ __forceinline__ void ffn_ew(Frame& F, bf16* u, const float* cw  , const float* cb) {
    const int gt = F.vcu * (NWAVES * 64) + F.tid, NT = F.G * NWAVES * 64;
    constexpr int CPR = FFN / 8;
    for (int it = gt; it < M * CPR; it += NT) {
        const int row = it / CPR, c0 = (it % CPR) * 8, t = row & (SEQ - 1);
        const bf16* g0 = u + (size_t)row * ULD + c0;
        v4u a2 = *(const v4u*)g0, a1 = (v4u){0, 0, 0, 0}, a0 = (v4u){0, 0, 0, 0};
        if (t >= 1) a1 = *(const v4u*)(g0 - ULD);
        if (t >= 2) a0 = *(const v4u*)(g0 - 2 * ULD);
        const v4u vv = *(const v4u*)(g0 + FFN);
        float o[8];
#pragma unroll
        for (int i = 0; i < 8; ++i) {
            const unsigned w2 = a2[i >> 1], w1 = a1[i >> 1], w0 = a0[i >> 1], wv = vv[i >> 1];
            const float x2 = (i & 1) ? bf2f(w2 >> 16) : bf2f(w2 & 0xffff), x1 = (i & 1) ? bf2f(w1 >> 16) : bf2f(w1 & 0xffff), x0 = (i & 1) ? bf2f(w0 >> 16) : bf2f(w0 & 0xffff);
            const float val = (i & 1) ? bf2f(wv >> 16) : bf2f(wv & 0xffff);
            const float gt_ = cw[c0 + i] * x0 + cw[FFN + c0 + i] * x1 + cw[2 * FFN + c0 + i] * x2 + cb[c0 + i];
            o[i] = 0.5f * gt_ * (1.0f + erff(gt_ * 0.70710678118654752f)) * val;
        }
        v4u ov; ov.x = pk2(o[0], o[1]); ov.y = pk2(o[2], o[3]); ov.z = pk2(o[4], o[5]); ov.w = pk2(o[6], o[7]);
        *(v4u*)(u + (size_t)row * ULD + FFN + c0) = ov;
    }
}

__device__ __forceinline__ float silu_f(float x) { return x / (1.0f + __expf(-x)); }

__device__ __forceinline__ void naive_attn_unit(int tidx, bf16* proj, int b, int h, int qb, LAS unsigned char* lds) {
    asm volatile("" : "+v"(tidx));
    const int tid = tidx, qi = tid >> 1, dh = tid & 1;
    LAS float* sK = (LAS float*)lds;
    LAS float* sV = sK + 128 * 64;
    const int t = qb * 256 + qi; const size_t rowq = (size_t)b * SEQ + t;
    float q[32];
    { const v4u* qp = (const v4u*)(proj + rowq * PLD + PC_Q + h * 64 + dh * 32);
#pragma unroll
      for (int i = 0; i < 4; ++i) { const v4u v = qp[i];
#pragma unroll
          for (int j = 0; j < 4; ++j) { q[i * 8 + 2 * j] = bf2f(v[j] & 0xffff); q[i * 8 + 2 * j + 1] = bf2f(v[j] >> 16); } } }
    unsigned sel = (1u << qb) - 1u;
    if (qb >= 4) {
        float g[8];
        LAS float* part = sV;
        LAS float* km = sV + 8 * 64;
#pragma unroll
        for (int n = 0; n < 8; ++n) { if (n < qb) {
            const int d = tid & 63, pt = tid >> 6; float s = 0.f;
            for (int r = 0; r < 32; ++r) s += bf2f(proj[((size_t)b * SEQ + n * 256 + pt * 32 + r) * PLD + PC_K + h * 64 + d]);
            __syncthreads();
            part[pt * 64 + d] = s;
            __syncthreads();
            if (tid < 64) { float a = 0.f;
#pragma unroll
                for (int k = 0; k < 8; ++k) a += part[k * 64 + tid];
                km[tid] = a * (1.0f / 256.0f); }
            __syncthreads();
            float gg = 0.f;
#pragma unroll
            for (int dd = 0; dd < 32; ++dd) gg += q[dd] * km[dh * 32 + dd];
            gg += __shfl_xor(gg, 1);
            g[n] = gg;
        } else g[n] = 0.f; }
        __syncthreads();
        sel = 0u;
#pragma unroll
        for (int k = 0; k < 3; ++k) { int best = -1; float bv = 0.f;
#pragma unroll
            for (int n = 0; n < 8; ++n) if (n < qb && !((sel >> n) & 1u)) { if (best < 0 || g[n] > bv) { best = n; bv = g[n]; } }
            sel |= 1u << best; }
    }
    float acc[32];
#pragma unroll
    for (int i = 0; i < 32; ++i) acc[i] = 0.f;
    float mx = -INFINITY, l = 0.f;
    for (int n = 0; n <= qb; ++n) {
        for (int hf = 0; hf < 2; ++hf) {
            __syncthreads();
            for (int i = tid; i < 128 * 8; i += 512) { const int r = i >> 3, c = i & 7; const size_t row = (size_t)b * SEQ + n * 256 + hf * 128 + r;
                const v4u kv = *(const v4u*)(proj + row * PLD + PC_K + h * 64 + c * 8), vv = *(const v4u*)(proj + row * PLD + PC_V + h * 64 + c * 8);
#pragma unroll
                for (int j = 0; j < 4; ++j) { sK[r * 64 + c * 8 + 2 * j] = bf2f(kv[j] & 0xffff); sK[r * 64 + c * 8 + 2 * j + 1] = bf2f(kv[j] >> 16); sV[r * 64 + c * 8 + 2 * j] = bf2f(vv[j] & 0xffff); sV[r * 64 + c * 8 + 2 * j + 1] = bf2f(vv[j] >> 16); } }
            __syncthreads();
            const bool blk_ok = (n == qb) || ((sel >> n) & 1u);
#pragma unroll 1
            for (int j = 0; j < 128; ++j) {
                const int kp = n * 256 + hf * 128 + j;
                const bool valid = blk_ok && (n < qb || kp <= t);
                float s = 0.f;
#pragma unroll
                for (int d = 0; d < 32; ++d) s += q[d] * sK[j * 64 + dh * 32 + d];
                s += __shfl_xor(s, 1);
                if (valid) {
                    if (s > mx) { const float sc = exp2f(mx - s); l *= sc;
#pragma unroll
                        for (int d = 0; d < 32; ++d) acc[d] *= sc;
                        mx = s; }
                    const float pw = exp2f(s - mx); l += pw;
#pragma unroll
                    for (int d = 0; d < 32; ++d) acc[d] += pw * sV[j * 64 + dh * 32 + d];
                }
            }
        }
    }
    const float inv = 1.0f / l;
    v4u* op = (v4u*)(proj + rowq * PLD + PC_Q + h * 64 + dh * 32);
    __syncthreads();
#pragma unroll
    for (int i = 0; i < 4; ++i) { v4u o; o.x = pk2(acc[i * 8] * inv, acc[i * 8 + 1] * inv); o.y = pk2(acc[i * 8 + 2] * inv, acc[i * 8 + 3] * inv); o.z = pk2(acc[i * 8 + 4] * inv, acc[i * 8 + 5] * inv); o.w = pk2(acc[i * 8 + 6] * inv, acc[i * 8 + 7] * inv); op[i] = o; }
}

__device__ __forceinline__ void naive_ssd_pair(bf16* proj, const float* smallp, float* ssq, const float* conv_w  , const float* conv_b, const float* dt_bias, const float* a_log, const float* dskip, int b, int hp, LAS unsigned char* lds, int tidx) {
    constexpr int TB = 32;
    const int tid = tidx & 255, half = tidx >> 8, h = hp * 2 + half, g = h >> 3;
    LAS float* xa = (LAS float*)(lds + half * 65536);
    LAS float* Ba = xa + TB * 64;
    LAS float* Ca = Ba + TB * 128;
    LAS float* ys = Ca + TB * 128;
    LAS float* dta = ys + TB * 64;
    const int p = tid >> 2, nq = tid & 3;
    const float a = -__expf(a_log[h]), dsk = dskip[h], dtb = dt_bias[h];
    float st[32];
#pragma unroll
    for (int i = 0; i < 32; ++i) st[i] = 0.f;
    for (int t0 = 0; t0 < SEQ; t0 += TB) {
        __syncthreads();
        for (int i = tid; i < TB * 320; i += 256) {
            const int tt = i / 320, cc = i % 320; const int t = t0 + tt;
            int ch; if (cc < 64) ch = h * 64 + cc; else if (cc < 192) ch = 1024 + g * 128 + (cc - 64); else ch = 1280 + g * 128 + (cc - 192);
            float s = conv_b[ch];
#pragma unroll
            for (int j = 0; j < 4; ++j) { const int ts = t - 3 + j; if (ts >= 0) s += conv_w[j * 1536 + ch] * bf2f(proj[((size_t)b * SEQ + ts) * PLD + PC_XBC + ch]); }
            s = silu_f(s);
            if (cc < 64) xa[tt * 64 + cc] = s; else if (cc < 192) Ba[tt * 128 + cc - 64] = s; else Ca[tt * 128 + cc - 192] = s;
        }
        if (tid < TB) { const float v = smallp[((size_t)b * SEQ + t0 + tid) * 24 + h] + dtb; dta[tid] = (v > 20.f) ? v : log1pf(__expf(v)); }
        __syncthreads();
        for (int tt = 0; tt < TB; ++tt) {
            const float dt = dta[tt], dA = __expf(dt * a), xv = xa[tt * 64 + p], dtx = dt * xv;
            float y = 0.f;
#pragma unroll
            for (int i = 0; i < 32; ++i) { st[i] = st[i] * dA + dtx * Ba[tt * 128 + nq * 32 + i]; y += Ca[tt * 128 + nq * 32 + i] * st[i]; }
            y += __shfl_xor(y, 1); y += __shfl_xor(y, 2);
            if (nq == 0) ys[tt * 64 + p] = y + dsk * xv;
        }
        __syncthreads();
        {
            const int tt = tid >> 3, pq = tid & 7; const size_t row = (size_t)b * SEQ + t0 + tt;
            bf16* zp = proj + row * PLD + PC_Z + h * 64 + pq * 8;
            const v4u zv = *(const v4u*)zp; float o[8]; float ss = 0.f;
#pragma unroll
            for (int i = 0; i < 8; ++i) { const unsigned w = zv[i >> 1]; const float z = (i & 1) ? bf2f(w >> 16) : bf2f(w & 0xffff); o[i] = ys[tt * 64 + pq * 8 + i] * silu_f(z); ss += o[i] * o[i]; }
            ss += __shfl_xor(ss, 1); ss += __shfl_xor(ss, 2); ss += __shfl_xor(ss, 4);
            v4u ov; ov.x = pk2(o[0], o[1]); ov.y = pk2(o[2], o[3]); ov.z = pk2(o[4], o[5]); ov.w = pk2(o[6], o[7]);
            *(v4u*)zp = ov;
            if (pq == 0) ssq[row * 16 + h] = ss;
        }
    }
    __syncthreads();
}

__device__ __forceinline__ void naive_mlstm_unit(bf16* proj, const float* smallp, const float* conv_w  , const float* conv_b, const float* i_bias, const float* f_bias, const float* norm_w, int b, int hd, LAS unsigned char* lds, int tidx) {
    constexpr int TB = 16;
    LAS float* qa = (LAS float*)lds;
    LAS float* ka = qa + TB * 128;
    LAS float* va = ka + TB * 128;
    LAS float* hs = va + TB * 128;
    LAS float* lia = hs + TB * 128;
    LAS float* lfa = lia + TB;
    asm volatile("" : "+v"(tidx));
    const int tid = tidx;
    const int d = tid >> 2, eq = tid & 3;
    const float ib = i_bias[hd], fb = f_bias[hd];
    float C[32], nn[32];
#pragma unroll
    for (int i = 0; i < 32; ++i) { C[i] = 0.f; nn[i] = 0.f; }
    float mst = 0.f;
    for (int t0 = 0; t0 < SEQ; t0 += TB) {
        __syncthreads();
        for (int i = tid; i < TB * 256; i += 512) {
            const int tt = i >> 8, cc = i & 255; const int t = t0 + tt;
            const int ch = (cc < 128) ? (hd * 128 + cc) : (512 + hd * 128 + (cc - 128));
            float s = conv_b[ch];
#pragma unroll
            for (int j = 0; j < 4; ++j) { const int ts = t - 3 + j; if (ts >= 0) s += conv_w[j * 1024 + ch] * bf2f(proj[((size_t)b * SEQ + ts) * PLD + PC_MQK + ch]); }
            s = silu_f(s);
            if (cc < 128) qa[tt * 128 + cc] = s; else ka[tt * 128 + cc - 128] = s * 0.08838834764831845f;
        }
        for (int i = tid; i < TB * 128; i += 512) { const int tt = i >> 7, cc = i & 127; va[tt * 128 + cc] = bf2f(proj[((size_t)b * SEQ + t0 + tt) * PLD + PC_MV + hd * 128 + cc]); }
        if (tid < TB) { const size_t row = (size_t)b * SEQ + t0 + tid; lia[tid] = smallp[row * 24 + 16 + hd] + ib; const float fv = smallp[row * 24 + 20 + hd] + fb;
            lfa[tid] = (fv >= 0.f) ? -log1pf(__expf(-fv)) : (fv - log1pf(__expf(fv))); }
        __syncthreads();
        for (int tt = 0; tt < TB; ++tt) {
            const float li = lia[tt], lf = lfa[tt];
            const float mn = fmaxf(lf + mst, li), fi = __expf(li - mn), ff = __expf(lf + mst - mn); mst = mn;
            const float iv = fi * va[tt * 128 + d];
            float num = 0.f, den = 0.f;
#pragma unroll
            for (int i = 0; i < 32; ++i) { const float kk = ka[tt * 128 + eq * 32 + i], qq = qa[tt * 128 + eq * 32 + i];
                C[i] = ff * C[i] + iv * kk; nn[i] = ff * nn[i] + fi * kk; num += C[i] * qq; den += nn[i] * qq; }
            num += __shfl_xor(num, 1); num += __shfl_xor(num, 2); den += __shfl_xor(den, 1); den += __shfl_xor(den, 2);
            if (eq == 0) hs[tt * 128 + d] = num / fmaxf(fabsf(den), __expf(-mn));
        }
        __syncthreads();
        if (tid < TB * 16) {
            const int tt = tid >> 4, dq = tid & 15; const size_t row = (size_t)b * SEQ + t0 + tt;
            float hv[8]; float ss = 0.f;
#pragma unroll
            for (int i = 0; i < 8; ++i) { hv[i] = hs[tt * 128 + dq * 8 + i]; ss += hv[i] * hv[i]; }
            ss += __shfl_xor(ss, 1); ss += __shfl_xor(ss, 2); ss += __shfl_xor(ss, 4); ss += __shfl_xor(ss, 8);
            const float r = 1.0f / sqrtf(ss * (1.0f / 128.0f) + EPS);
            bf16* op = proj + row * PLD + PC_MO + hd * 128 + dq * 8;
            const v4u ov_ = *(const v4u*)op; float o[8];
#pragma unroll
            for (int i = 0; i < 8; ++i) { const unsigned w = ov_[i >> 1]; const float og = (i & 1) ? bf2f(w >> 16) : bf2f(w & 0xffff);
                o[i] = hv[i] * r * norm_w[hd * 128 + dq * 8 + i] * (1.0f / (1.0f + __expf(-og))); }
            v4u ov; ov.x = pk2(o[0], o[1]); ov.y = pk2(o[2], o[3]); ov.z = pk2(o[4], o[5]); ov.w = pk2(o[6], o[7]);
            *(v4u*)op = ov;
        }
    }
    __syncthreads();
}

typedef short bf16x8v __attribute__((ext_vector_type(8)));
typedef float f32x16 __attribute__((ext_vector_type(16)));
typedef short v4i16_t __attribute__((ext_vector_type(4)));
__device__ __forceinline__ bf16x8v frag_row(LAS const unsigned char* base, int pitch, int row, int kel) { return *(const LAS bf16x8v*)(base + row * pitch + kel * 2); }
__device__ __forceinline__ bf16x8v frag_tr(LAS const unsigned char* base, int pitch, int krow, int col) {
    LAS const unsigned char* p = base + krow * pitch + col * 2;
    const v4i16_t lo = __builtin_amdgcn_ds_read_tr16_b64_v4i16((LAS v4i16_t*)p);
    const v4i16_t hi = __builtin_amdgcn_ds_read_tr16_b64_v4i16((LAS v4i16_t*)(p + 4 * pitch));
    return (bf16x8v){lo[0], lo[1], lo[2], lo[3], hi[0], hi[1], hi[2], hi[3]};
}
#define MFMA32(a, b, c) __builtin_amdgcn_mfma_f32_32x32x16_bf16((a), (b), (c), 0, 0, 0)

__device__ __forceinline__ void ssd_unit(int tid, bf16* proj, const float* smallp, float* ssq, const float* conv_w  , const float* conv_b, const float* dt_bias, const float* a_log, const float* dskip, int b, int h, LAS unsigned char* lds) {
    constexpr int PB = 272, PX = 144;
    asm volatile("" : "+v"(tid));
    LAS unsigned char* CG = lds;
    LAS unsigned char* BB = lds + 34816;
    LAS unsigned char* XX = lds + 69632;
    LAS unsigned char* XW = lds + 88064;
    LAS unsigned char* ST = lds + 106496;
    LAS float* ldv = (LAS float*)(lds + 123904);
    LAS float* dtv = ldv + 128;
    const int lane0 = tid & 63, w = __builtin_amdgcn_readfirstlane(tid >> 6);
    const int g = h >> 3, pt = w & 1, lt = w >> 1;
    const float a = -__expf(a_log[h]), dsk = dskip[h], dtb = dt_bias[h];
    const int cg = tid % 40, rp = tid / 40;
    int ch; LAS unsigned char* sdst; int spitch;
    if (cg < 8) { ch = h * 64 + cg * 8; sdst = XX + cg * 16; spitch = PX; }
    else if (cg < 24) { ch = 1024 + g * 128 + (cg - 8) * 8; sdst = BB + (cg - 8) * 16; spitch = PB; }
    else { ch = 1280 + g * 128 + (cg - 24) * 8; sdst = CG + (cg - 24) * 16; spitch = PB; }
    float cw[4][8], cbv[8];
#pragma unroll
    for (int j = 0; j < 4; ++j)
#pragma unroll
        for (int i = 0; i < 8; ++i) cw[j][i] = conv_w[j * 1536 + ch + i];
#pragma unroll
    for (int i = 0; i < 8; ++i) cbv[i] = conv_b[ch + i];
    f32x16 sacc;
#pragma unroll
    for (int i = 0; i < 16; ++i) sacc[i] = 0.f;
    for (int i = tid; i < 17408 / 4; i += 512) ((LAS unsigned*)ST)[i] = 0u;
    for (int c = 0; c < 16; ++c) {
        const size_t row0 = (size_t)b * SEQ + c * 128;
        int lane = lane0; asm volatile("" : "+v"(lane));
        const int r = lane & 31, hh = lane >> 5, trq = (lane & 15) >> 2, trc = 16 * ((lane >> 4) & 1) + 4 * (lane & 3);
        __syncthreads();
        if (w == 0) {
            float v0 = smallp[(row0 + lane) * 24 + h] + dtb, v1 = smallp[(row0 + 64 + lane) * 24 + h] + dtb;
            v0 = (v0 > 20.f) ? v0 : log1pf(__expf(v0)); v1 = (v1 > 20.f) ? v1 : log1pf(__expf(v1));
            float s0 = v0 * a, s1 = v1 * a;
#pragma unroll
            for (int o = 1; o < 64; o <<= 1) { const float t0 = __shfl_up(s0, o), t1 = __shfl_up(s1, o); if (lane >= o) { s0 += t0; s1 += t1; } }
            s1 += __shfl(s0, 63);
            ldv[lane] = s0; ldv[64 + lane] = s1; dtv[lane] = v0; dtv[64 + lane] = v1;
        }
        if (rp < 12) {
            for (int row = rp; row < 128; row += 12) {
                const int t = c * 128 + row;
                float acc[8];
#pragma unroll
                for (int i = 0; i < 8; ++i) acc[i] = cbv[i];
#pragma unroll
                for (int j = 0; j < 4; ++j) { const int ts = t - 3 + j;
                    if (ts >= 0) { const v4u raw = *(const v4u*)(proj + ((size_t)b * SEQ + ts) * PLD + PC_XBC + ch);
#pragma unroll
                        for (int i = 0; i < 4; ++i) { acc[2 * i] += cw[j][2 * i] * bf2f(raw[i] & 0xffff); acc[2 * i + 1] += cw[j][2 * i + 1] * bf2f(raw[i] >> 16); } } }
#pragma unroll
                for (int i = 0; i < 8; ++i) acc[i] = silu_f(acc[i]);
                v4u o; o.x = pk2(acc[0], acc[1]); o.y = pk2(acc[2], acc[3]); o.z = pk2(acc[4], acc[5]); o.w = pk2(acc[6], acc[7]);
                *(LAS v4u*)(sdst + row * spitch) = o;
            }
        }
        __syncthreads();
        {
            const int row = tid >> 2, q4 = tid & 3; const float wl = dtv[row] * __expf(ldv[127] - ldv[row]);
#pragma unroll
            for (int k = 0; k < 2; ++k) { const v4u xv = *(const LAS v4u*)(XX + row * PX + q4 * 32 + k * 16); v4u o;
#pragma unroll
                for (int i = 0; i < 4; ++i) o[i] = pk2(bf2f(xv[i] & 0xffff) * wl, bf2f(xv[i] >> 16) * wl);
                *(LAS v4u*)(XW + row * PX + q4 * 32 + k * 16) = o; }
        }
        __syncthreads();
        f32x16 yacc;
#pragma unroll
        for (int i = 0; i < 16; ++i) yacc[i] = 0.f;
#pragma unroll
        for (int ks = 0; ks < 8; ++ks) yacc = MFMA32(frag_row(ST, PB, 32 * pt + r, 16 * ks + 8 * hh), frag_row(CG, PB, 32 * lt + r, 16 * ks + 8 * hh), yacc);
        { const float e = __expf(ldv[32 * lt + r]);
#pragma unroll
          for (int i = 0; i < 16; ++i) yacc[i] *= e; }
        f32x16 tA, tB;
        const int ltA = (w >= 6) ? 3 : (w >= 3) ? 2 : (w >= 1) ? 1 : 0, stA = w - ltA * (ltA + 1) / 2;
        const int ltB = 3, stB = w + 2;
#pragma unroll
        for (int i = 0; i < 16; ++i) { tA[i] = 0.f; tB[i] = 0.f; }
#pragma unroll
        for (int ks = 0; ks < 8; ++ks) tA = MFMA32(frag_row(BB, PB, 32 * stA + r, 16 * ks + 8 * hh), frag_row(CG, PB, 32 * ltA + r, 16 * ks + 8 * hh), tA);
        if (w < 2) {
#pragma unroll
            for (int ks = 0; ks < 8; ++ks) tB = MFMA32(frag_row(BB, PB, 32 * stB + r, 16 * ks + 8 * hh), frag_row(CG, PB, 32 * ltB + r, 16 * ks + 8 * hh), tB);
        }
        __syncthreads();
        { const int l = 32 * ltA + r; const float ldl = ldv[l];
#pragma unroll
          for (int g4 = 0; g4 < 4; ++g4) { const int s0 = 32 * stA + 8 * g4 + 4 * hh; float v[4];
#pragma unroll
              for (int j = 0; j < 4; ++j) { const int s_ = s0 + j; v[j] = (s_ <= l) ? tA[4 * g4 + j] * __expf(ldl - ldv[s_]) * dtv[s_] : 0.f; }
              *(LAS unsigned long long*)(CG + l * PB + s0 * 2) = (unsigned long long)pk2(v[0], v[1]) | ((unsigned long long)pk2(v[2], v[3]) << 32); } }
        if (w < 2) { const int l = 32 * ltB + r; const float ldl = ldv[l];
#pragma unroll
          for (int g4 = 0; g4 < 4; ++g4) { const int s0 = 32 * stB + 8 * g4 + 4 * hh; float v[4];
#pragma unroll
              for (int j = 0; j < 4; ++j) { const int s_ = s0 + j; v[j] = (s_ <= l) ? tB[4 * g4 + j] * __expf(ldl - ldv[s_]) * dtv[s_] : 0.f; }
              *(LAS unsigned long long*)(CG + l * PB + s0 * 2) = (unsigned long long)pk2(v[0], v[1]) | ((unsigned long long)pk2(v[2], v[3]) << 32); } }
        __syncthreads();
        for (int ks = 0; ks < 2 * (lt + 1); ++ks) yacc = MFMA32(frag_tr(XX, PX, 16 * ks + 8 * hh + trq, 32 * pt + trc), frag_row(CG, PB, 32 * lt + r, 16 * ks + 8 * hh), yacc);
        { const float e = __expf(ldv[127]);
#pragma unroll
          for (int i = 0; i < 16; ++i) sacc[i] *= e; }
#pragma unroll
        for (int ks = 0; ks < 8; ++ks) sacc = MFMA32(frag_tr(BB, PB, 16 * ks + 8 * hh + trq, 32 * lt + trc), frag_tr(XW, PX, 16 * ks + 8 * hh + trq, 32 * pt + trc), sacc);
        __syncthreads();
        {
            const int p = 32 * pt + r, l = 32 * lt + r;
#pragma unroll
            for (int g4 = 0; g4 < 4; ++g4) { const int n0 = 32 * lt + 8 * g4 + 4 * hh;
                *(LAS unsigned long long*)(ST + p * PB + n0 * 2) = (unsigned long long)pk2(sacc[4 * g4], sacc[4 * g4 + 1]) | ((unsigned long long)pk2(sacc[4 * g4 + 2], sacc[4 * g4 + 3]) << 32);
                const int p0 = 32 * pt + 8 * g4 + 4 * hh;
                *(LAS f32x4*)(CG + l * 272 + p0 * 4) = (f32x4){yacc[4 * g4], yacc[4 * g4 + 1], yacc[4 * g4 + 2], yacc[4 * g4 + 3]}; }
        }
        __syncthreads();
        {
            const int row = tid >> 2, q4 = tid & 3;
            bf16* zp = proj + (row0 + row) * PLD + PC_Z + h * 64 + q4 * 16;
            float o[16]; float ss = 0.f;
#pragma unroll
            for (int k = 0; k < 2; ++k) { const v4u zv = *(const v4u*)(zp + 8 * k); const v4u xv = *(const LAS v4u*)(XX + row * PX + q4 * 32 + k * 16);
                const f32x4 y0 = *(const LAS f32x4*)(CG + row * 272 + (q4 * 16 + 8 * k) * 4), y1 = *(const LAS f32x4*)(CG + row * 272 + (q4 * 16 + 8 * k + 4) * 4);
#pragma unroll
                for (int i = 0; i < 4; ++i) { const float ya = (i < 2 ? y0[2 * i] : y1[2 * i - 4]), yb = (i < 2 ? y0[2 * i + 1] : y1[2 * i - 3]);
                    const float oa = (ya + dsk * bf2f(xv[i] & 0xffff)) * silu_f(bf2f(zv[i] & 0xffff)), ob = (yb + dsk * bf2f(xv[i] >> 16)) * silu_f(bf2f(zv[i] >> 16));
                    o[8 * k + 2 * i] = oa; o[8 * k + 2 * i + 1] = ob; ss += oa * oa + ob * ob; } }
            ss += __shfl_xor(ss, 1); ss += __shfl_xor(ss, 2);
#pragma unroll
            for (int k = 0; k < 2; ++k) { v4u ov; ov.x = pk2(o[8 * k], o[8 * k + 1]); ov.y = pk2(o[8 * k + 2], o[8 * k + 3]); ov.z = pk2(o[8 * k + 4], o[8 * k + 5]); ov.w = pk2(o[8 * k + 6], o[8 * k + 7]); *(v4u*)(zp + 8 * k) = ov; }
            if (q4 == 0) ssq[(row0 + row) * 16 + h] = ss;
        }
    }
    __syncthreads();
}

__device__ __forceinline__ void mlstm_unit(int tid, bf16* proj, const float* smallp, const float* conv_w  , const float* conv_b, const float* i_bias, const float* f_bias, const float* norm_w, int b, int hd, LAS unsigned char* lds) {
    constexpr int PB = 272;
    asm volatile("" : "+v"(tid));
    LAS unsigned char* QP = lds;
    LAS unsigned char* KK = lds + 34816;
    LAS unsigned char* VV = lds + 69632;
    LAS unsigned char* CS = lds + 104448;
    LAS float* uu = (LAS float*)(lds + 139264);
    LAS float* mmv = uu + 128;
    LAS float* wint = mmv + 128;
    LAS float* dnv = wint + 128;
    LAS float* wlv = dnv + 128;
    LAS float* den = wlv + 128;
    LAS float* nst = den + 128;
    LAS float* nacc = nst + 128;
    LAS float* scal = nacc + 128;
    const int lane0 = tid & 63, w = __builtin_amdgcn_readfirstlane(tid >> 6);
    const int tt = w >> 1, dp = w & 1;
    const float ib = i_bias[hd], fb = f_bias[hd];
    const int cg = tid & 31, rp = tid >> 5;
    const int ch = (cg < 16) ? (hd * 128 + cg * 8) : (512 + hd * 128 + (cg - 16) * 8);
    LAS unsigned char* sdst = (cg < 16) ? (QP + cg * 16) : (KK + (cg - 16) * 16);
    const float post = (cg < 16) ? 1.0f : 0.08838834764831845f;
    float cw[4][8], cbv[8];
#pragma unroll
    for (int j = 0; j < 4; ++j)
#pragma unroll
        for (int i = 0; i < 8; ++i) cw[j][i] = conv_w[j * 1024 + ch + i];
#pragma unroll
    for (int i = 0; i < 8; ++i) cbv[i] = conv_b[ch + i];
    f32x16 cacc0, cacc1;
#pragma unroll
    for (int i = 0; i < 16; ++i) { cacc0[i] = 0.f; cacc1[i] = 0.f; }
    for (int i = tid; i < 34816 / 4; i += 512) ((LAS unsigned*)CS)[i] = 0u;
    if (tid < 128) nst[tid] = 0.f;
    float mst = 0.f;
    for (int c = 0; c < 16; ++c) {
        const size_t row0 = (size_t)b * SEQ + c * 128;
        int lane = lane0; asm volatile("" : "+v"(lane));
        const int r = lane & 31, hh = lane >> 5, trq = (lane & 15) >> 2, trc = 16 * ((lane >> 4) & 1) + 4 * (lane & 3);
        __syncthreads();
        if (w == 0) {
            const float li0 = smallp[(row0 + lane) * 24 + 16 + hd] + ib, li1 = smallp[(row0 + 64 + lane) * 24 + 16 + hd] + ib;
            const float f0 = smallp[(row0 + lane) * 24 + 20 + hd] + fb, f1 = smallp[(row0 + 64 + lane) * 24 + 20 + hd] + fb;
            float c0 = (f0 >= 0.f) ? -log1pf(__expf(-f0)) : (f0 - log1pf(__expf(f0))), c1 = (f1 >= 0.f) ? -log1pf(__expf(-f1)) : (f1 - log1pf(__expf(f1)));
#pragma unroll
            for (int o = 1; o < 64; o <<= 1) { const float t0 = __shfl_up(c0, o), t1 = __shfl_up(c1, o); if (lane >= o) { c0 += t0; c1 += t1; } }
            c1 += __shfl(c0, 63);
            const float totf = __shfl(c1, 63);
            const float u0 = li0 - c0, u1 = li1 - c1;
            float p0 = u0, p1 = u1;
#pragma unroll
            for (int o = 1; o < 64; o <<= 1) { const float t0 = __shfl_up(p0, o), t1 = __shfl_up(p1, o); if (lane >= o) { p0 = fmaxf(p0, t0); p1 = fmaxf(p1, t1); } }
            p1 = fmaxf(p1, __shfl(p0, 63));
            const float mloc = totf + __shfl(p1, 63), mnew = fmaxf(totf + mst, mloc);
            const float m0 = fmaxf(p0, mst), m1 = fmaxf(p1, mst);
            uu[lane] = u0; uu[64 + lane] = u1; mmv[lane] = m0; mmv[64 + lane] = m1;
            wint[lane] = __expf(mst - m0); wint[64 + lane] = __expf(mst - m1);
            dnv[lane] = __expf(-(c0 + m0)); dnv[64 + lane] = __expf(-(c1 + m1));
            wlv[lane] = __expf(totf + u0 - mnew); wlv[64 + lane] = __expf(totf + u1 - mnew);
            if (lane == 0) scal[0] = __expf(totf + mst - mnew);
            mst = mnew;
        }
        if (tid < 128) nacc[tid] = 0.f;
        for (int row = rp; row < 128; row += 16) {
            const int t = c * 128 + row;
            float acc[8];
#pragma unroll
            for (int i = 0; i < 8; ++i) acc[i] = cbv[i];
#pragma unroll
            for (int j = 0; j < 4; ++j) { const int ts = t - 3 + j;
                if (ts >= 0) { const v4u raw = *(const v4u*)(proj + ((size_t)b * SEQ + ts) * PLD + PC_MQK + ch);
#pragma unroll
                    for (int i = 0; i < 4; ++i) { acc[2 * i] += cw[j][2 * i] * bf2f(raw[i] & 0xffff); acc[2 * i + 1] += cw[j][2 * i + 1] * bf2f(raw[i] >> 16); } } }
#pragma unroll
            for (int i = 0; i < 8; ++i) acc[i] = silu_f(acc[i]) * post;
            v4u o; o.x = pk2(acc[0], acc[1]); o.y = pk2(acc[2], acc[3]); o.z = pk2(acc[4], acc[5]); o.w = pk2(acc[6], acc[7]);
            *(LAS v4u*)(sdst + row * PB) = o;
        }
        for (int it = tid; it < 2048; it += 512) { const int row = it >> 4, cc = it & 15;
            *(LAS v4u*)(VV + row * PB + cc * 16) = *(const v4u*)(proj + (row0 + row) * PLD + PC_MV + hd * 128 + cc * 8); }
        __syncthreads();
        f32x16 na0, na1;
#pragma unroll
        for (int i = 0; i < 16; ++i) { na0[i] = 0.f; na1[i] = 0.f; }
#pragma unroll
        for (int ks = 0; ks < 8; ++ks) { const bf16x8v qf = frag_row(QP, PB, 32 * tt + r, 16 * ks + 8 * hh);
            na0 = MFMA32(frag_row(CS, PB, 32 * (2 * dp) + r, 16 * ks + 8 * hh), qf, na0);
            na1 = MFMA32(frag_row(CS, PB, 32 * (2 * dp + 1) + r, 16 * ks + 8 * hh), qf, na1); }
        { const float e = wint[32 * tt + r];
#pragma unroll
          for (int i = 0; i < 16; ++i) { na0[i] *= e; na1[i] *= e; } }
        {
            const int t = tid >> 2, q4 = tid & 3; float d = 0.f;
#pragma unroll
            for (int k = 0; k < 4; ++k) { const v4u qv = *(const LAS v4u*)(QP + t * PB + q4 * 64 + k * 16);
#pragma unroll
                for (int i = 0; i < 4; ++i) d += bf2f(qv[i] & 0xffff) * nst[q4 * 32 + k * 8 + 2 * i] + bf2f(qv[i] >> 16) * nst[q4 * 32 + k * 8 + 2 * i + 1]; }
            d += __shfl_xor(d, 1); d += __shfl_xor(d, 2);
            if (q4 == 0) den[t] = d * wint[t];
        }
        f32x16 tA, tB;
        const int ttA = (w >= 6) ? 3 : (w >= 3) ? 2 : (w >= 1) ? 1 : 0, stA = w - ttA * (ttA + 1) / 2;
        const int ttB = 3, stB = w + 2;
#pragma unroll
        for (int i = 0; i < 16; ++i) { tA[i] = 0.f; tB[i] = 0.f; }
#pragma unroll
        for (int ks = 0; ks < 8; ++ks) tA = MFMA32(frag_row(KK, PB, 32 * stA + r, 16 * ks + 8 * hh), frag_row(QP, PB, 32 * ttA + r, 16 * ks + 8 * hh), tA);
        if (w < 2) {
#pragma unroll
            for (int ks = 0; ks < 8; ++ks) tB = MFMA32(frag_row(KK, PB, 32 * stB + r, 16 * ks + 8 * hh), frag_row(QP, PB, 32 * ttB + r, 16 * ks + 8 * hh), tB);
        }
        __syncthreads();
        { const int t = 32 * ttA + r; const float mt = mmv[t]; float ds = 0.f;
#pragma unroll
          for (int g4 = 0; g4 < 4; ++g4) { const int s0 = 32 * stA + 8 * g4 + 4 * hh; float v[4];
#pragma unroll
              for (int j = 0; j < 4; ++j) { const int s_ = s0 + j; v[j] = (s_ <= t) ? tA[4 * g4 + j] * __expf(uu[s_] - mt) : 0.f; ds += v[j]; }
              *(LAS unsigned long long*)(QP + t * PB + s0 * 2) = (unsigned long long)pk2(v[0], v[1]) | ((unsigned long long)pk2(v[2], v[3]) << 32); }
          ds += __shfl_xor(ds, 32);
          if (hh == 0) __hip_atomic_fetch_add(den + t, ds, __ATOMIC_RELAXED, __HIP_MEMORY_SCOPE_WORKGROUP); }
        if (w < 2) { const int t = 32 * ttB + r; const float mt = mmv[t]; float ds = 0.f;
#pragma unroll
          for (int g4 = 0; g4 < 4; ++g4) { const int s0 = 32 * stB + 8 * g4 + 4 * hh; float v[4];
#pragma unroll
              for (int j = 0; j < 4; ++j) { const int s_ = s0 + j; v[j] = (s_ <= t) ? tB[4 * g4 + j] * __expf(uu[s_] - mt) : 0.f; ds += v[j]; }
              *(LAS unsigned long long*)(QP + t * PB + s0 * 2) = (unsigned long long)pk2(v[0], v[1]) | ((unsigned long long)pk2(v[2], v[3]) << 32); }
          ds += __shfl_xor(ds, 32);
          if (hh == 0) __hip_atomic_fetch_add(den + t, ds, __ATOMIC_RELAXED, __HIP_MEMORY_SCOPE_WORKGROUP); }
        {
            const int rg = tid >> 4, ec = tid & 15; float cs[8];
#pragma unroll
            for (int i = 0; i < 8; ++i) cs[i] = 0.f;
#pragma unroll
            for (int k = 0; k < 4; ++k) { const int row = 4 * rg + k; const float wl = wlv[row]; LAS v4u* p = (LAS v4u*)(KK + row * PB + ec * 16); const v4u kv = *p; v4u o;
#pragma unroll
                for (int i = 0; i < 4; ++i) { const float a0 = bf2f(kv[i] & 0xffff) * wl, a1 = bf2f(kv[i] >> 16) * wl; o[i] = pk2(a0, a1); cs[2 * i] += a0; cs[2 * i + 1] += a1; }
                *p = o; }
#pragma unroll
            for (int i = 0; i < 8; ++i) { cs[i] += __shfl_xor(cs[i], 16); cs[i] += __shfl_xor(cs[i], 32); }
            if (lane < 16) {
#pragma unroll
                for (int i = 0; i < 8; ++i) __hip_atomic_fetch_add(nacc + ec * 8 + i, cs[i], __ATOMIC_RELAXED, __HIP_MEMORY_SCOPE_WORKGROUP); }
        }
        __syncthreads();
        for (int ks = 0; ks < 2 * (tt + 1); ++ks) { const bf16x8v pf = frag_row(QP, PB, 32 * tt + r, 16 * ks + 8 * hh);
            na0 = MFMA32(frag_tr(VV, PB, 16 * ks + 8 * hh + trq, 32 * (2 * dp) + trc), pf, na0);
            na1 = MFMA32(frag_tr(VV, PB, 16 * ks + 8 * hh + trq, 32 * (2 * dp + 1) + trc), pf, na1); }
        { const float e = scal[0];
#pragma unroll
          for (int i = 0; i < 16; ++i) { cacc0[i] *= e; cacc1[i] *= e; } }
#pragma unroll
        for (int ks = 0; ks < 8; ++ks) { const bf16x8v kf = frag_tr(KK, PB, 16 * ks + 8 * hh + trq, 32 * tt + trc);
            cacc0 = MFMA32(kf, frag_tr(VV, PB, 16 * ks + 8 * hh + trq, 32 * (2 * dp) + trc), cacc0);
            cacc1 = MFMA32(kf, frag_tr(VV, PB, 16 * ks + 8 * hh + trq, 32 * (2 * dp + 1) + trc), cacc1); }
        __syncthreads();
        {
            const int t = 32 * tt + r; const float dv = 1.0f / fmaxf(fabsf(den[t]), dnv[t]);
#pragma unroll
            for (int g4 = 0; g4 < 4; ++g4) {
                const int e0 = 32 * tt + 8 * g4 + 4 * hh, d0 = 32 * (2 * dp) + r, d1 = 32 * (2 * dp + 1) + r;
                *(LAS unsigned long long*)(CS + d0 * PB + e0 * 2) = (unsigned long long)pk2(cacc0[4 * g4], cacc0[4 * g4 + 1]) | ((unsigned long long)pk2(cacc0[4 * g4 + 2], cacc0[4 * g4 + 3]) << 32);
                *(LAS unsigned long long*)(CS + d1 * PB + e0 * 2) = (unsigned long long)pk2(cacc1[4 * g4], cacc1[4 * g4 + 1]) | ((unsigned long long)pk2(cacc1[4 * g4 + 2], cacc1[4 * g4 + 3]) << 32);
                const int dd0 = 32 * (2 * dp) + 8 * g4 + 4 * hh, dd1 = dd0 + 32;
                *(LAS unsigned long long*)(QP + t * PB + dd0 * 2) = (unsigned long long)pk2(na0[4 * g4] * dv, na0[4 * g4 + 1] * dv) | ((unsigned long long)pk2(na0[4 * g4 + 2] * dv, na0[4 * g4 + 3] * dv) << 32);
                *(LAS unsigned long long*)(QP + t * PB + dd1 * 2) = (unsigned long long)pk2(na1[4 * g4] * dv, na1[4 * g4 + 1] * dv) | ((unsigned long long)pk2(na1[4 * g4 + 2] * dv, na1[4 * g4 + 3] * dv) << 32);
            }
            if (tid < 128) nst[tid] = nst[tid] * scal[0] + nacc[tid];
        }
        __syncthreads();
        {
            const int t = tid >> 2, q4 = tid & 3; float hv[32]; float ss = 0.f;
#pragma unroll
            for (int k = 0; k < 4; ++k) { const v4u x = *(const LAS v4u*)(QP + t * PB + q4 * 64 + k * 16);
#pragma unroll
                for (int i = 0; i < 4; ++i) { hv[8 * k + 2 * i] = bf2f(x[i] & 0xffff); hv[8 * k + 2 * i + 1] = bf2f(x[i] >> 16); ss += hv[8 * k + 2 * i] * hv[8 * k + 2 * i] + hv[8 * k + 2 * i + 1] * hv[8 * k + 2 * i + 1]; } }
            ss += __shfl_xor(ss, 1); ss += __shfl_xor(ss, 2);
            const float rr = 1.0f / sqrtf(ss * (1.0f / 128.0f) + EPS);
            bf16* op = proj + (row0 + t) * PLD + PC_MO + hd * 128 + q4 * 32;
            const float* nw = norm_w + hd * 128 + q4 * 32;
#pragma unroll
            for (int k = 0; k < 4; ++k) { const v4u og = *(const v4u*)(op + 8 * k); v4u o;
#pragma unroll
                for (int i = 0; i < 4; ++i) { const float g0 = 1.0f / (1.0f + __expf(-bf2f(og[i] & 0xffff))), g1 = 1.0f / (1.0f + __expf(-bf2f(og[i] >> 16)));
                    o[i] = pk2(hv[8 * k + 2 * i] * rr * nw[8 * k + 2 * i] * g0, hv[8 * k + 2 * i + 1] * rr * nw[8 * k + 2 * i + 1] * g1); }
                *(v4u*)(op + 8 * k) = o; }
        }
    }
    __syncthreads();
}

constexpr int PH_PER_LAYER = 9, N_PHASES = PH_PER_LAYER * DEPTH;

__global__ void __launch_bounds__(NWAVES * 64, 2) fwd(Args args) {
    extern __shared__ __attribute__((aligned(16))) unsigned char lds[];
    Frame F;
    F.lds = (LAS unsigned char*)lds;
    F.tid = threadIdx.x; F.lane = F.tid & 63; F.wave = __builtin_amdgcn_readfirstlane(F.tid >> 6);
    const int wave0 = F.wave;
    for (int u = F.tid; u < (LDS_BYTES - LDSCTL_OFF) / 4; u += NWAVES * 64) ((LAS unsigned*)(F.lds + LDSCTL_OFF))[u] = 0u;
    __syncthreads();
    const int ph_lo = args.ph_lo, ph_hi = args.ph_hi;
    if (ph_hi - ph_lo > 1) (void)xcd_barrier_post((unsigned*)(args.ws + WS_CTL) + CW_BAR, (volatile LAS unsigned*)(F.lds + MISC_OFF) + 8);

    for (int ph = ph_lo; ph < ph_hi; ++ph) {
        const int l = ph / PH_PER_LAYER, p = ph % PH_PER_LAYER;
        const __attribute__((address_space(4))) Args* ap = (const __attribute__((address_space(4))) Args*)__builtin_amdgcn_kernarg_segment_ptr();
        asm volatile("" : "+s"(ap));
        { int t_ = wave0 * 64 + (int)__builtin_amdgcn_mbcnt_hi(~0u, __builtin_amdgcn_mbcnt_lo(~0u, 0u)); asm volatile("" : "+v"(t_)); F.tid = t_; F.lane = t_ & 63; F.wave = __builtin_amdgcn_readfirstlane(t_ >> 6); }
        F.G = gridDim.x; { const int bx = blockIdx.x; F.vcu = (F.G % 8 == 0) ? (bx % 8) * (F.G / 8) + bx / 8 : bx; }
        unsigned char* ws = ap->ws; float* out = ap->out;
        bf16* bufa = (bf16*)(ws + WS_BUFA); bf16* bufb = (bf16*)(ws + WS_BUFB); bf16* xb = (bf16*)(ws + WS_XB); bf16* proj = (bf16*)(ws + WS_PROJ);
        float* smallp = (float*)(ws + WS_SMALLP); float* ssq = (float*)(ws + WS_SSQ);
        const float* xin = (l == 0) ? ap->in[0] : out;
        switch (p) {
        case 0: {
            convert_weights(F, 0, ap->in[2] + (size_t)l * DM * P_IN, ap->in[16] + (size_t)l * DMIX * DM, bufa, bufb, (LAS float*)(F.lds + F.wave * 16384));
            __syncthreads();
            row_pass(F, xin, ap->in[1] + l * DM, xb, ap->in[2] + (size_t)l * DM * P_IN, smallp, (LAS float*)(F.lds));
        } break;
        case 1: {
            pg8::Gemm g{xb, bufa, M, PLD, DM, DM}; pg8::StaticOrder S; S.init(M, PLD, F.G, (int)blockIdx.x);
            pg8::EpiProj E{proj, ap->in[3] + l * 64, ap->in[4] + l * 64};
            pg8::gemm_phase<pg8::EpiProj>(F.lds + RING_OFF, g, S, E, F.tid);
        } break;
        case 2: {
            for (int pi = F.vcu; pi < 256; pi += F.G) {
                const int bh = pi >> 2, s4 = pi & 3;
                naive_attn_unit(F.tid, proj, bh >> 3, bh & 7, s4, F.lds);
                naive_attn_unit(F.tid, proj, bh >> 3, bh & 7, 7 - s4, F.lds);
                __syncthreads();
                if (pi < 128) ssd_unit(F.tid, proj, smallp, ssq, ap->in[5] + (size_t)l * 4 * 1536, ap->in[6] + l * 1536, ap->in[7] + l * 16, ap->in[8] + l * 16, ap->in[9] + l * 16, pi >> 4, pi & 15, F.lds);
                else if (pi < 160) mlstm_unit(F.tid, proj, smallp, ap->in[11] + (size_t)l * 4 * 1024, ap->in[12] + l * 1024, ap->in[13] + l * 4, ap->in[14] + l * 4, ap->in[15] + l * 512, (pi - 128) >> 2, (pi - 128) & 3, F.lds);
            }
        } break;
        case 3: ssd_finalize(F, proj, ssq, ap->in[10] + l * 1024); break;
        case 4: {
            pg8::Gemm g{proj, bufb, M, DM, DMIX, PLD}; pg8::StaticOrder S; S.init(M, DM, F.G, (int)blockIdx.x);
            pg8::EpiRes E{xin, out, DM};
            pg8::gemm_phase<pg8::EpiRes>(F.lds + RING_OFF, g, S, E, F.tid);
        } break;
        case 5: {
            convert_weights(F, 1, ap->in[18] + (size_t)l * DM * ULD, ap->in[21] + (size_t)l * FFN * DM, bufa, bufb, (LAS float*)(F.lds + F.wave * 16384));
            __syncthreads();
            row_pass(F, out, ap->in[17] + l * DM, xb, nullptr, nullptr, nullptr);
        } break;
        case 6: {
            pg8::Gemm g{xb, bufa, M, ULD, DM, DM}; pg8::StaticOrder S; S.init(M, ULD, F.G, (int)blockIdx.x);
            pg8::EpiBf16 E{proj, ULD};
            pg8::gemm_phase<pg8::EpiBf16>(F.lds + RING_OFF, g, S, E, F.tid);
        } break;
        case 7: ffn_ew(F, proj, ap->in[19] + (size_t)l * 3 * FFN, ap->in[20] + l * FFN); break;
        case 8: {
            pg8::Gemm g{proj + FFN, bufb, M, DM, FFN, ULD}; pg8::StaticOrder S; S.init(M, DM, F.G, (int)blockIdx.x);
            pg8::EpiRes E{out, out, DM};
            pg8::gemm_phase<pg8::EpiRes>(F.lds + RING_OFF, g, S, E, F.tid);
        } break;
        }
        if (ph + 1 < ph_hi) { XcdBarrier bar; bar.bar = (unsigned*)(ap->ws + WS_CTL) + CW_BAR; bar.x = xb_xcc_id(); bar.st = (volatile LAS unsigned*)(F.lds + MISC_OFF) + 8; xcd_barrier(bar, F.tid); }
    }
}

extern "C" void kernel_launch(void* const* d_in, const int* in_sizes, int n_in, void* d_out, int out_size, void* d_ws, size_t ws_size, hipStream_t stream) {
    static int grid = 0;
    if (grid == 0) {
        if (n_in != 22 || in_sizes[0] != M * DM || out_size != M * DM || ws_size < WS_END) { fprintf(stderr, "kernel_launch: unexpected shapes (n_in %d, in0 %d, out %d, ws %zu); nothing launched\n", n_in, n_in > 0 ? in_sizes[0] : -1, out_size, ws_size); grid = -1; return; }
        int dev = 0, cus = 0, per_cu = 0;
        if (hipGetDevice(&dev) != hipSuccess || hipDeviceGetAttribute(&cus, hipDeviceAttributeMultiprocessorCount, dev) != hipSuccess) { grid = -1; return; }
        if (hipFuncSetAttribute((const void*)fwd, hipFuncAttributeMaxDynamicSharedMemorySize, LDS_BYTES) != hipSuccess) { fprintf(stderr, "kernel_launch: hipFuncSetAttribute failed\n"); grid = -1; return; }
        if (hipOccupancyMaxActiveBlocksPerMultiprocessor(&per_cu, (const void*)fwd, NWAVES * 64, LDS_BYTES) != hipSuccess || per_cu < 1) { fprintf(stderr, "kernel_launch: occupancy query reports %d blocks per CU\n", per_cu); per_cu = 1; }
        (void)hipGetLastError();
        grid = cus;
    }
    if (grid < 0) return;
    (void)hipMemsetAsync((char*)d_ws + WS_CTL, 0, CTL_ZERO_BYTES, stream);
    Args a{};
    for (int i = 0; i < 22; ++i) a.in[i] = (const float*)d_in[i];
    a.out = (float*)d_out; a.ws = (unsigned char*)d_ws;
#if MK_MULTI
    for (int ph = 0; ph < N_PHASES; ++ph) {
        a.ph_lo = ph; a.ph_hi = ph + 1;
        hipLaunchKernelGGL(fwd, dim3(grid), dim3(NWAVES * 64), LDS_BYTES, stream, a);
    }
#else
    a.ph_lo = 0; a.ph_hi = N_PHASES;
    hipLaunchKernelGGL(fwd, dim3(grid), dim3(NWAVES * 64), LDS_BYTES, stream, a);
#endif
}
```

```cpp
#include <hip/hip_runtime.h>
#include <hip/hip_bf16.h>
#include <cstdio>
#include <cstdint>
#include <cmath>

#ifndef MK_MULTI
#define MK_MULTI 0
#endif

constexpr int BATCH = 8, SEQ = 2048, DM = 1024, DEPTH = 2;
constexpr int M = BATCH * SEQ;
constexpr int P_IN = 6168;
constexpr int PLD = 6144;
constexpr int PC_Q = 0, PC_Z = 512, PC_MO = 1536, PC_K = 2048, PC_V = 2560, PC_XBC = 3072, PC_MQK = 4608, PC_MV = 5632;
constexpr int SC_Q = 0, SC_K = 512, SC_V = 1024, SC_Z = 1536, SC_XBC = 2560, SC_DT = 4096, SC_MQK = 4112, SC_MV = 5136, SC_MO = 5648, SC_MI = 6160, SC_MF = 6164;
constexpr int FFN = 2816, ULD = 5632;
constexpr int DMIX = 2048;
constexpr float EPS = 1e-6f;
constexpr float C2 = 0.125f * 1.4426950408889634f;

constexpr size_t MiB = 1u << 20;
constexpr size_t WS_CTL = 0, CTL_ZERO_BYTES = 1 * MiB;
constexpr size_t WS_KSUM = 256 * 1024;
constexpr size_t WS_SMALLP = 1 * MiB;
constexpr size_t WS_SSQ = 3 * MiB - 512 * 1024;
constexpr size_t WS_BUFA = 4 * MiB;
constexpr size_t WS_BUFB = 16 * MiB;
constexpr size_t WS_XB = 22 * MiB;
constexpr size_t WS_PROJ = 64 * MiB;
constexpr size_t WS_END = 256 * MiB;

namespace pg8 {
#define PG8_LAS __attribute__((address_space(3)))
typedef unsigned short bf16_t;
typedef short bf16x8 __attribute__((ext_vector_type(8)));
typedef float f32x4 __attribute__((ext_vector_type(4)));
typedef unsigned u32x4 __attribute__((ext_vector_type(4)));
constexpr int BM = 256, BK = 64, HALF = 128, HTB = HALF * BK * 2, STAGE_BYTES = 8 * HTB, NXCD = 8, WGM = 8;

__host__ __device__ __forceinline__ int lds_byte(int r, int c) { const int st = (r >> 4) * 2 + (c >> 5), rr = r & 15, cc = c & 31, ob = rr * 64 + cc * 2; return st * 1024 + (ob ^ (((ob >> 9) & 1) << 5)); }
__host__ __device__ __forceinline__ void stage_rc(int b, int& R, int& C) { const int st = b / 1024, sb = b % 1024, swz = sb ^ (((sb >> 9) & 1) << 5); R = (st >> 1) * 16 + swz / 64; C = (st & 1) * 32 + (swz % 64) / 2; }
__host__ __device__ __forceinline__ int perm32(int rho) { const int n = rho >> 4, i = rho & 15; return 8 * (i >> 2) + 4 * n + (i & 3); }

struct Unit { int pm, pn; };
struct Gemm { const bf16_t* A; const bf16_t* Bt; int M, N, K, lda; };

struct StaticOrder {
    int nM, nN, nwg, G, c;
    __host__ __device__ void init(int M_, int N_, int G_, int c_) { nM = M_ / BM; nN = N_ / BM; nwg = nM * nN; G = G_; c = c_; }
    __host__ __device__ bool next(int i, Unit& u) const {
        const long L = (long)i * G + c; if (L >= nwg) return false;
        int wgid = (int)L; { const int q = nwg / NXCD, r = nwg % NXCD, xcd = wgid % NXCD, off = wgid / NXCD; wgid = (xcd < r ? xcd * (q + 1) : r * (q + 1) + (xcd - r) * q) + off; }
        const int nig = WGM * nN, gid = wgid / nig, fm = gid * WGM, gsz = (nM - fm) < WGM ? (nM - fm) : WGM;
        u.pm = fm + ((wgid % nig) % gsz); u.pn = (wgid % nig) / gsz; return true;
    }
};

__device__ __forceinline__ unsigned cvt_pk_bf16(float lo, float hi) { unsigned r; asm volatile("v_cvt_pk_bf16_f32 %0, %1, %2" : "=v"(r) : "v"(lo), "v"(hi)); return r; }

struct EpiBf16 {
    static constexpr bool PERM = true;
    bf16_t* O; int ldc;
    __device__ __forceinline__ void operator()(const f32x4 (&acc)[2][2][4][2], const Unit& u, int wr, int wc, int fr, int fq) const {
        const int row0 = u.pm * BM + wr * 64 + fr; const int col0 = u.pn * BM + wc * 32 + 8 * fq;
#pragma unroll
        for (int ai = 0; ai < 2; ++ai)
#pragma unroll
            for (int m = 0; m < 4; ++m) { bf16_t* rowp = O + (size_t)(row0 + ai * HALF + m * 16) * ldc + col0;
#pragma unroll
                for (int bj = 0; bj < 2; ++bj) { const f32x4 v0 = acc[ai][bj][m][0], v1 = acc[ai][bj][m][1];
                    u32x4 w; w.x = cvt_pk_bf16(v0[0], v0[1]); w.y = cvt_pk_bf16(v0[2], v0[3]); w.z = cvt_pk_bf16(v1[0], v1[1]); w.w = cvt_pk_bf16(v1[2], v1[3]);
                    *(u32x4*)(rowp + bj * HALF) = w; } }
    }
};
struct EpiProj {
    static constexpr bool PERM = true;
    bf16_t* P; const float* qw; const float* kw; float* ksum;
    __device__ __forceinline__ void operator()(const f32x4 (&acc)[2][2][4][2], const Unit& u, int wr, int wc, int fr, int fq) const {
        const int pn = u.pn; const bool isq = pn < 2, isk = (pn == 8 || pn == 9);
        const int row0 = u.pm * BM + wr * 64 + fr;
        if (!(isq || isk)) {
            const int col0 = pn * BM + wc * 32 + 8 * fq;
#pragma unroll
            for (int ai = 0; ai < 2; ++ai)
#pragma unroll
                for (int m = 0; m < 4; ++m) { bf16_t* rowp = P + (size_t)(row0 + ai * HALF + m * 16) * PLD + col0;
#pragma unroll
                    for (int bj = 0; bj < 2; ++bj) { const f32x4 v0 = acc[ai][bj][m][0], v1 = acc[ai][bj][m][1];
                        u32x4 w; w.x = cvt_pk_bf16(v0[0], v0[1]); w.y = cvt_pk_bf16(v0[2], v0[3]); w.z = cvt_pk_bf16(v1[0], v1[1]); w.w = cvt_pk_bf16(v1[2], v1[3]);
                        *(u32x4*)(rowp + bj * HALF) = w; } }
        } else {
            const float* w = isq ? qw : kw; const float post = isq ? C2 : 1.0f;
            const int colb = pn * BM + 64 * wc + 8 * fq;
            f32x4 cs[2][2];
#pragma unroll
            for (int bj = 0; bj < 2; ++bj)
#pragma unroll
                for (int n = 0; n < 2; ++n) cs[bj][n] = (f32x4){0.f, 0.f, 0.f, 0.f};
#pragma unroll
            for (int ai = 0; ai < 2; ++ai)
#pragma unroll
                for (int m = 0; m < 4; ++m) {
                    float ss = 0.f;
#pragma unroll
                    for (int bj = 0; bj < 2; ++bj)
#pragma unroll
                        for (int n = 0; n < 2; ++n) { const f32x4 x = acc[ai][bj][m][n]; ss += (x[0] * x[0] + x[1] * x[1]) + (x[2] * x[2] + x[3] * x[3]); }
                    ss += __shfl_xor(ss, 16); ss += __shfl_xor(ss, 32);
                    const float r = (1.0f / sqrtf(ss * (1.0f / 64.0f) + EPS)) * post;
                    bf16_t* rowp = P + (size_t)(row0 + ai * HALF + m * 16) * PLD + colb;
#pragma unroll
                    for (int bj = 0; bj < 2; ++bj) { const f32x4 w0 = *(const f32x4*)(w + 32 * bj + 8 * fq), w1 = *(const f32x4*)(w + 32 * bj + 8 * fq + 4);
                        const f32x4 v0 = acc[ai][bj][m][0] * r * w0, v1 = acc[ai][bj][m][1] * r * w1;
                        cs[bj][0] += v0; cs[bj][1] += v1;
                        u32x4 o; o.x = cvt_pk_bf16(v0[0], v0[1]); o.y = cvt_pk_bf16(v0[2], v0[3]); o.z = cvt_pk_bf16(v1[0], v1[1]); o.w = cvt_pk_bf16(v1[2], v1[3]);
                        *(u32x4*)(rowp + 32 * bj) = o; }
                    asm volatile("" ::: "memory");
                }
            if (isk) {
                float* kd = ksum + ((size_t)(u.pm * 8 + (pn - 8) * 4 + wc) * 64) + 8 * fq;
#pragma unroll
                for (int bj = 0; bj < 2; ++bj)
#pragma unroll
                    for (int n = 0; n < 2; ++n)
#pragma unroll
                        for (int i = 0; i < 4; ++i) { float x = cs[bj][n][i]; x += __shfl_xor(x, 1); x += __shfl_xor(x, 2); x += __shfl_xor(x, 4); x += __shfl_xor(x, 8);
                            if (fr == 0) atomicAdd(kd + 32 * bj + 4 * n + i, x); }
            }
        }
    }
};
struct EpiRes {
    static constexpr bool PERM = false;
    const float* base; float* out; int ldc;
    __device__ __forceinline__ void operator()(const f32x4 (&acc)[2][2][4][2], const Unit& u, int wr, int wc, int fr, int fq) const {
        const int row0 = u.pm * BM + wr * 64 + fr, col0 = u.pn * BM + wc * 32 + 4 * fq;
#pragma unroll
        for (int ai = 0; ai < 2; ++ai)
#pragma unroll
            for (int m = 0; m < 4; ++m) { const size_t off = (size_t)(row0 + ai * HALF + m * 16) * ldc + col0;
#pragma unroll
                for (int bj = 0; bj < 2; ++bj)
#pragma unroll
                    for (int n = 0; n < 2; ++n) { const f32x4 b = *(const f32x4*)(base + off + bj * HALF + n * 16); *(f32x4*)(out + off + bj * HALF + n * 16) = b + acc[ai][bj][m][n]; } }
    }
};

template <class Epi>
__device__ __forceinline__ void gemm_phase(PG8_LAS unsigned char* lds, const Gemm g, const StaticOrder& S, const Epi& E, int tid_) {
    asm volatile("" : "+v"(tid_));
    const int tid = tid_, wid = __builtin_amdgcn_readfirstlane(tid >> 6), lane = tid & 63, wr = wid >> 2, wc = wid & 3, fr = lane & 15, fq = lane >> 4;
    const int K = g.K, nt = K / BK, lda = g.lda;
    unsigned voffA[2], voffB[2];
#pragma unroll
    for (int i = 0; i < 2; ++i) { int R, C; stage_rc(tid * 16 + i * 8192, R, C); const int Rb = Epi::PERM ? ((R & ~31) + perm32(R & 31)) : R;
        voffA[i] = (unsigned)(R * lda + C) * 2u; voffB[i] = (unsigned)(Rb * K + C) * 2u; }
    const size_t kstep = (size_t)(BK * 2);
    const size_t hstepA = (size_t)HALF * lda * 2, hstepB = (size_t)HALF * K * 2;
    const size_t tstepA = 2 * hstepA, tstepB = 2 * hstepB;
    const unsigned ldsw = (unsigned)wid * 1024u;
    const int aoff = lds_byte(wr * 64 + fr, fq * 8), boff = lds_byte(wc * 32 + fr, fq * 8);
#define PG8_SA(b, h) (((b) * 2 + (h)) * HTB)
#define PG8_SB(b, h) ((4 + (b) * 2 + (h)) * HTB)
#define PG8_STAGE(bufoff, gbase, voff) do { _Pragma("unroll") for (int _i = 0; _i < 2; ++_i) \
        __builtin_amdgcn_global_load_lds((const unsigned*)((const char*)(gbase) + (voff)[_i]), (PG8_LAS unsigned*)(lds + (bufoff) + ldsw + _i * 8192), 16, 0, 0); } while (0)
#define PG8_LDA(dst, b, h) do { _Pragma("unroll") for (int m = 0; m < 4; ++m) _Pragma("unroll") for (int k = 0; k < 2; ++k) dst[m][k] = *(const PG8_LAS bf16x8*)(lds + PG8_SA(b, h) + aoff + m * 2048 + k * 1024); } while (0)
#define PG8_LDB(dst, b, h) do { _Pragma("unroll") for (int n = 0; n < 2; ++n) _Pragma("unroll") for (int k = 0; k < 2; ++k) dst[n][k] = *(const PG8_LAS bf16x8*)(lds + PG8_SB(b, h) + boff + n * 2048 + k * 1024); } while (0)
#define PG8_MMA(ai, bj, At, Bt) do { __builtin_amdgcn_s_setprio(1); _Pragma("unroll") for (int m = 0; m < 4; ++m) _Pragma("unroll") for (int n = 0; n < 2; ++n) _Pragma("unroll") for (int k = 0; k < 2; ++k) \
        acc[ai][bj][m][n] = __builtin_amdgcn_mfma_f32_16x16x32_bf16(Bt[n][k], At[m][k], acc[ai][bj][m][n], 0, 0, 0); __builtin_amdgcn_s_setprio(0); } while (0)
#define PG8_WAIT_V(n) asm volatile("s_waitcnt vmcnt(" #n ")" ::: "memory")
#define PG8_WAIT_L(n) asm volatile("s_waitcnt lgkmcnt(" #n ")" ::: "memory")
#define PG8_BAR __builtin_amdgcn_s_barrier()
#define PG8_SCHED __builtin_amdgcn_sched_barrier(0)
    Unit cur, nxt; int ui = 0;
    if (!S.next(0, cur)) return;
    f32x4 acc[2][2][4][2];
#pragma unroll
    for (int a = 0; a < 2; ++a)
#pragma unroll
        for (int b = 0; b < 2; ++b)
#pragma unroll
            for (int m = 0; m < 4; ++m)
#pragma unroll
                for (int n = 0; n < 2; ++n) acc[a][b][m][n] = (f32x4){0.f, 0.f, 0.f, 0.f};
    bf16x8 At[4][2], B0[2][2], B1[2][2];
    const char* cA = (const char*)g.A + (size_t)cur.pm * tstepA; const char* cB = (const char*)g.Bt + (size_t)cur.pn * tstepB;
    PG8_STAGE(PG8_SB(0, 0), cB, voffB); PG8_STAGE(PG8_SB(0, 1), cB + hstepB, voffB); PG8_STAGE(PG8_SA(0, 0), cA, voffA); PG8_STAGE(PG8_SA(0, 1), cA + hstepA, voffA);
    if (wr == 1) PG8_BAR;
    PG8_WAIT_V(2); PG8_BAR;
    PG8_STAGE(PG8_SB(1, 0), cB + kstep, voffB); PG8_STAGE(PG8_SA(1, 0), cA + kstep, voffA); PG8_STAGE(PG8_SB(1, 1), cB + hstepB + kstep, voffB);
    PG8_WAIT_V(6); PG8_BAR;
    for (;;) {
        const bool has_next = S.next(ui + 1, nxt);
        const char* nA = has_next ? (const char*)g.A + (size_t)nxt.pm * tstepA : cA; const char* nB = has_next ? (const char*)g.Bt + (size_t)nxt.pn * tstepB : cB;
        for (int t = 0; t < nt; t += 2) {
            const bool last = (t == nt - 2);
            const char* a1 = cA + (size_t)(t + 1) * kstep;
            const char* a2 = last ? nA : cA + (size_t)(t + 2) * kstep; const char* b2 = last ? nB : cB + (size_t)(t + 2) * kstep;
            const char* a3 = a2 + kstep; const char* b3 = b2 + kstep;
            PG8_LDB(B0, 0, 0); PG8_LDB(B1, 0, 1); PG8_SCHED; PG8_LDA(At, 0, 0); PG8_STAGE(PG8_SA(1, 1), a1 + hstepA, voffA);
            PG8_WAIT_V(8); PG8_WAIT_L(0); PG8_BAR; PG8_MMA(0, 0, At, B0); PG8_MMA(0, 1, At, B1); PG8_BAR; PG8_SCHED;
            PG8_LDA(At, 0, 1); PG8_STAGE(PG8_SB(0, 0), b2, voffB); PG8_STAGE(PG8_SB(0, 1), b2 + hstepB, voffB); PG8_STAGE(PG8_SA(0, 0), a2, voffA);
            PG8_WAIT_V(8); PG8_WAIT_L(0); PG8_BAR; PG8_MMA(1, 0, At, B0); PG8_MMA(1, 1, At, B1); PG8_BAR; PG8_SCHED;
            PG8_LDB(B0, 1, 0); PG8_LDB(B1, 1, 1); PG8_SCHED; PG8_LDA(At, 1, 0); PG8_STAGE(PG8_SA(0, 1), a2 + hstepA, voffA);
            PG8_WAIT_V(8); PG8_WAIT_L(0); PG8_BAR; PG8_MMA(0, 0, At, B0); PG8_MMA(0, 1, At, B1); PG8_BAR; PG8_SCHED;
            PG8_LDA(At, 1, 1); PG8_STAGE(PG8_SB(1, 0), b3, voffB); PG8_STAGE(PG8_SB(1, 1), b3 + hstepB, voffB); PG8_STAGE(PG8_SA(1, 0), a3, voffA);
            PG8_WAIT_V(8); PG8_WAIT_L(0); PG8_BAR; PG8_MMA(1, 0, At, B0); PG8_MMA(1, 1, At, B1); PG8_BAR; PG8_SCHED;
        }
        if (wr == 0) PG8_BAR;
        E(acc, cur, wr, wc, fr, fq);
        if (!has_next) break;
#pragma unroll
        for (int a = 0; a < 2; ++a)
#pragma unroll
            for (int b = 0; b < 2; ++b)
#pragma unroll
                for (int m = 0; m < 4; ++m)
#pragma unroll
                    for (int n = 0; n < 2; ++n) acc[a][b][m][n] = (f32x4){0.f, 0.f, 0.f, 0.f};
        cur = nxt; cA = nA; cB = nB; ++ui;
        if (wr == 1) PG8_BAR;
    }
    PG8_WAIT_V(0);
    PG8_BAR;
#undef PG8_SA
#undef PG8_SB
#undef PG8_STAGE
#undef PG8_LDA
#undef PG8_LDB
#undef PG8_MMA
#undef PG8_WAIT_V
#undef PG8_WAIT_L
#undef PG8_BAR
#undef PG8_SCHED
}
}

constexpr int NWAVES = 8;
constexpr int RING_OFF = 0, RING_BYTES = 131072;
constexpr int LDS_BYTES = 147456;
constexpr int LDSCTL_OFF = LDS_BYTES - 512, MISC_OFF = LDSCTL_OFF + 320;
constexpr int CW_BAR = 4096;

#define GAS __attribute__((address_space(1)))
#define LAS __attribute__((address_space(3)))
typedef unsigned short bf16;
typedef unsigned v4u __attribute__((ext_vector_type(4)));
typedef float f32x4 __attribute__((ext_vector_type(4)));
typedef GAS unsigned gu32;
#define RLX_AGENT __ATOMIC_RELAXED, __HIP_MEMORY_SCOPE_AGENT
#define LDS_WAIT() asm volatile("s_waitcnt lgkmcnt(0)" ::: "memory")
#define VM_WAIT() asm volatile("s_waitcnt vmcnt(0)" ::: "memory")
__device__ __forceinline__ unsigned f2bf(float f) { unsigned u = __builtin_bit_cast(unsigned, f); return (u + 0x7fffu + ((u >> 16) & 1u)) >> 16; }
__device__ __forceinline__ unsigned pk2(float lo, float hi) { return f2bf(lo) | (f2bf(hi) << 16); }
__device__ __forceinline__ float bf2f(unsigned short b) { return __uint_as_float(((unsigned)b) << 16); }

#define XB_TMO      128
#define XB_XCNT(j)  (256  + 64 * (j))
#define XB_XSUB(j)  (1280 + 64 * (j))
#define XB_XGEN(j)  (2304 + 64 * (j))
#define XB_TOP      3328
#define XB_TOPGEN   3392
#define XCD_BAR_WORDS 3456
#define XB_SPIN_CAP (1u << 18)
__device__ __forceinline__ unsigned xb_ld(unsigned* p)              { return __hip_atomic_load(p, __ATOMIC_RELAXED, __HIP_MEMORY_SCOPE_AGENT); }
__device__ __forceinline__ unsigned xb_add(unsigned* p, unsigned v) { return __hip_atomic_fetch_add(p, v, __ATOMIC_RELAXED, __HIP_MEMORY_SCOPE_AGENT); }
__device__ __forceinline__ unsigned xb_xcc_id() { return (unsigned)__builtin_amdgcn_s_getreg((3 << 11) | 20) & 0xFu; }
#define XB_SPIN(cond, bar) do { unsigned _sp = 0; while (cond) { __builtin_amdgcn_s_sleep(1); \
    if ((++_sp & 255u) == 0u) { if (xb_ld(&(bar)[XB_TMO])) break; if (_sp > XB_SPIN_CAP) { atomicAdd(&(bar)[XB_TMO], 1u); break; } } } } while (0)
struct XcdBarrier { unsigned* bar; unsigned x; volatile LAS unsigned* st; };
__device__ __forceinline__ XcdBarrier xcd_barrier_post(unsigned* bar, volatile LAS unsigned* st) {
    XcdBarrier b; b.bar = bar; b.x = xb_xcc_id(); b.st = st;
    if (threadIdx.x == 0) (void)xb_add(&bar[XB_XCNT(b.x)], 1u);
    return b;
}
__device__ __forceinline__ void xcd_barrier_complete(unsigned* bar, unsigned x, unsigned& nloc, unsigned& nx) {
    const unsigned G = gridDim.x * gridDim.y * gridDim.z;
    unsigned sum, cnt, mine, sp = 0u;
    for (;;) {
        sum = 0u; cnt = 0u; mine = 0u;
#pragma unroll
        for (unsigned j = 0; j < 16; ++j) { const unsigned c = xb_ld(&bar[XB_XCNT(j)]); sum += c; cnt += (c > 0u) ? 1u : 0u; mine = (j == x) ? c : mine; }
        if (sum == G) break;
        __builtin_amdgcn_s_sleep(1);
        if ((++sp & 255u) == 0u) { if (xb_ld(&bar[XB_TMO])) break; if (sp > XB_SPIN_CAP) { atomicAdd(&bar[XB_TMO], 1u); break; } }
    }
    nloc = mine > 0u ? mine : 1u; nx = cnt > 0u ? cnt : 1u;
}
__device__ __forceinline__ void xcd_barrier(const XcdBarrier& b, int tid) {
    asm volatile("s_waitcnt vmcnt(0)" ::: "memory");
    __syncthreads();
    if (tid == 0) {
        unsigned* bar = b.bar;
        __builtin_amdgcn_s_waitcnt(0);
        unsigned nloc = b.st[0], nx = b.st[1];
        if (nloc == 0u) { xcd_barrier_complete(bar, b.x, nloc, nx); b.st[0] = nloc; b.st[1] = nx; }
        const unsigned old = xb_add(&bar[XB_XSUB(b.x)], 1u);
        const unsigned gen = old / nloc;
        if (old + 1u == (gen + 1u) * nloc) {
            __builtin_amdgcn_fence(__ATOMIC_RELEASE, "agent");
            asm volatile("s_waitcnt vmcnt(0)" ::: "memory");
            const unsigned og = xb_add(&bar[XB_TOP], 1u);
            const unsigned tg = og / nx;
            if (og + 1u == (tg + 1u) * nx) xb_add(&bar[XB_TOPGEN], 1u);
            else XB_SPIN(xb_ld(&bar[XB_TOPGEN]) == tg, bar);
            __builtin_amdgcn_fence(__ATOMIC_ACQUIRE, "agent");
            xb_add(&bar[XB_XGEN(b.x)], 1u);
            asm volatile("s_waitcnt vmcnt(0)" ::: "memory");
        } else {
            XB_SPIN(xb_ld(&bar[XB_XGEN(b.x)]) == gen, bar);
            __builtin_amdgcn_fence(__ATOMIC_ACQUIRE, "agent");
            asm volatile("s_waitcnt vmcnt(0)" ::: "memory");
        }
    }
    __syncthreads();
}

struct Args { const float* in[22]; float* out; unsigned char* ws; int ph_lo, ph_hi; };

struct Frame {
    LAS unsigned char* lds;
    int tid, lane, wave;
    int vcu, G;
};

__device__ __forceinline__ float wave_sum(float v) {
#pragma unroll
    for (int o = 1; o < 64; o <<= 1) v += __shfl_xor(v, o);
    return v;
}

__device__ __forceinline__ void conv_item(const float* W, int ldw, int srccol0, bf16* WT, int K, int dstrow0, int k0, LAS float* scr, int lane) {
#pragma unroll 8
    for (int i = 0; i < 32; ++i) { const int kk = 2 * i + (lane >> 5); scr[kk * 33 + (lane & 31)] = W[(size_t)(k0 + kk) * ldw + srccol0 + (lane & 31)]; }
    LDS_WAIT(); asm volatile("" ::: "memory");
    const int c = lane & 7;
#pragma unroll
    for (int j = 0; j < 4; ++j) { const int n = (lane >> 3) + 8 * j; const LAS float* s = scr + (8 * c) * 33 + n;
        v4u o; o.x = pk2(s[0 * 33], s[1 * 33]); o.y = pk2(s[2 * 33], s[3 * 33]); o.z = pk2(s[4 * 33], s[5 * 33]); o.w = pk2(s[6 * 33], s[7 * 33]);
        *(GAS v4u*)(WT + (size_t)(dstrow0 + n) * K + k0 + 8 * c) = o; }
    LDS_WAIT(); asm volatile("" ::: "memory");
}
__device__ __forceinline__ int in_src_col(int n0) {
    const int tile = n0 >> 8, p = n0 & 255; int dest;
    if (tile < 2 || tile == 8 || tile == 9) { const int bj = p >> 7, wc = (p >> 5) & 3; dest = (tile << 8) + 64 * wc + 32 * bj; } else dest = n0;
    if (dest < PC_Z) return SC_Q + dest;
    if (dest < PC_MO) return SC_Z + dest - PC_Z;
    if (dest < PC_K) return SC_MO + dest - PC_MO;
    if (dest < PC_V) return SC_K + dest - PC_K;
    if (dest < PC_XBC) return SC_V + dest - PC_V;
    if (dest < PC_MQK) return SC_XBC + dest - PC_XBC;
    if (dest < PC_MV) return SC_MQK + dest - PC_MQK;
    return SC_MV + dest - PC_MV;
}
__device__ __forceinline__ void convert_weights(Frame& F, int which, const float* Wa, const float* Wb, bf16* bufa, bf16* bufb, LAS float* scr) {
    const int gw = F.vcu * NWAVES + F.wave, NGW = F.G * NWAVES;
    if (which == 0) {
        constexpr int IA = (DM / 64) * (PLD / 32), IB = (DMIX / 64) * (DM / 32);
        for (int it = gw; it < IA + IB; it += NGW) {
            if (it < IA) { const int nblk = PLD / 32, kb = it / nblk, nb = it % nblk; conv_item(Wa, P_IN, in_src_col(32 * nb), bufa, DM, 32 * nb, 64 * kb, scr, F.lane); }
            else { const int r = it - IA, nblk = DM / 32, kb = r / nblk, nb = r % nblk; conv_item(Wb, DM, 32 * nb, bufb, DMIX, 32 * nb, 64 * kb, scr, F.lane); }
        }
    } else {
        constexpr int IA = (DM / 64) * (ULD / 32), IB = (FFN / 64) * (DM / 32);
        for (int it = gw; it < IA + IB; it += NGW) {
            if (it < IA) { const int nblk = ULD / 32, kb = it / nblk, nb = it % nblk; conv_item(Wa, ULD, 32 * nb, bufa, DM, 32 * nb, 64 * kb, scr, F.lane); }
            else { const int r = it - IA, nblk = DM / 32, kb = r / nblk, nb = r % nblk; conv_item(Wb, DM, 32 * nb, bufb, FFN, 32 * nb, 64 * kb, scr, F.lane); }
        }
    }
}
__device__ __forceinline__ void row_pass(Frame& F, const float* x, const float* nw, bf16* xb, const float* w_in  , float* smallp, LAS float* wsm  ) {
    if (w_in) {
        for (int k = F.tid; k < DM; k += NWAVES * 64) {
            const float* src = w_in + (size_t)k * P_IN;
#pragma unroll
            for (int c = 0; c < 16; ++c) wsm[c * DM + k] = src[SC_DT + c];
#pragma unroll
            for (int c = 0; c < 8; ++c) wsm[(16 + c) * DM + k] = src[SC_MI + c];
        }
        LDS_WAIT(); __syncthreads();
    }
    const int gw = F.vcu * NWAVES + F.wave, NGW = F.G * NWAVES;
    f32x4 wv[4];
#pragma unroll
    for (int j = 0; j < 4; ++j) wv[j] = ((const GAS f32x4*)nw)[64 * j + F.lane];
    for (int m = gw; m < M; m += NGW) {
        const GAS f32x4* xr = (const GAS f32x4*)(x + (size_t)m * DM) + F.lane;
        f32x4 v[4]; float s = 0.f;
#pragma unroll
        for (int j = 0; j < 4; ++j) { v[j] = xr[64 * j]; s += (v[j].x * v[j].x + v[j].y * v[j].y) + (v[j].z * v[j].z + v[j].w * v[j].w); }
        const float r = 1.0f / sqrtf(wave_sum(s) * (1.0f / DM) + EPS);
#pragma unroll
        for (int j = 0; j < 4; ++j) v[j] = v[j] * r * wv[j];
        GAS unsigned long long* o8 = (GAS unsigned long long*)(xb + (size_t)m * DM) + F.lane;
#pragma unroll
        for (int j = 0; j < 4; ++j) o8[64 * j] = (unsigned long long)pk2(v[j].x, v[j].y) | ((unsigned long long)pk2(v[j].z, v[j].w) << 32);
        if (w_in) {
            float mine = 0.f;
            for (int c = 0; c < 24; ++c) {
                float d = 0.f;
#pragma unroll
                for (int j = 0; j < 4; ++j) { const f32x4 w4 = *(const LAS f32x4*)(wsm + c * DM + 4 * (64 * j + F.lane)); d += (v[j].x * w4.x + v[j].y * w4.y) + (v[j].z * w4.z + v[j].w * w4.w); }
                d = wave_sum(d);
                if (F.lane == c) mine = d;
            }
            if (F.lane < 24) smallp[(size_t)m * 24 + F.lane] = mine;
        }
    }
}
__device__ __forceinline__ void ssd_finalize(Frame& F, bf16* proj, const float* ssq, const float* nw) {
    const int gt = F.vcu * (NWAVES * 64) + F.tid, NT = F.G * NWAVES * 64;
    for (int it = gt; it < M * 128; it += NT) {
        const int row = it >> 7, c0 = (it & 127) * 8, g = c0 >> 9;
        float s = 0.f;
#pragma unroll
        for (int h = 0; h < 8; ++h) s += ssq[(size_t)row * 16 + g * 8 + h];
        const float r = 1.0f / sqrtf(s * (1.0f / 512.0f) + EPS);
        v4u* p = (v4u*)(proj + (size_t)row * PLD + PC_Z + c0);
        v4u v = *p; const f32x4 w0 = *(const f32x4*)(nw + c0), w1 = *(const f32x4*)(nw + c0 + 4);
        v4u o;
        o.x = pk2(bf2f(v.x & 0xffff) * r * w0.x, bf2f(v.x >> 16) * r * w0.y); o.y = pk2(bf2f(v.y & 0xffff) * r * w0.z, bf2f(v.y >> 16) * r * w0.w);
        o.z = pk2(bf2f(v.z & 0xffff) * r * w1.x, bf2f(v.z >> 16) * r * w1.y); o.w = pk2(bf2f(v.w & 0xffff) * r * w1.z, bf2f(v.w >> 16) * r * w1.w);
        *p = o;
    }
}
__device__ __forceinline__ void ffn_ew(Frame& F, bf16* u, const float* cw  , const float* cb) {
    const int gt = F.vcu * (NWAVES * 64) + F.tid, NT = F.G * NWAVES * 64;
    constexpr int CPR = FFN / 8;
    for (int it = gt; it < M * CPR; it += NT) {
        const int row = it / CPR, c0 = (it % CPR) * 8, t = row & (SEQ - 1);
        const bf16* g0 = u + (size_t)row * ULD + c0;
        v4u a2 = *(const v4u*)g0, a1 = (v4u){0, 0, 0, 0}, a0 = (v4u){0, 0, 0, 0};
        if (t >= 1) a1 = *(const v4u*)(g0 - ULD);
        if (t >= 2) a0 = *(const v4u*)(g0 - 2 * ULD);
        const v4u vv = *(const v4u*)(g0 + FFN);
        float o[8];
#pragma unroll
        for (int i = 0; i < 8; ++i) {
            const unsigned w2 = a2[i >> 1], w1 = a1[i >> 1], w0 = a0[i >> 1], wv = vv[i >> 1];
            const float x2 = (i & 1) ? bf2f(w2 >> 16) : bf2f(w2 & 0xffff), x1 = (i & 1) ? bf2f(w1 >> 16) : bf2f(w1 & 0xffff), x0 = (i & 1) ? bf2f(w0 >> 16) : bf2f(w0 & 0xffff);
            const float val = (i & 1) ? bf2f(wv >> 16) : bf2f(wv & 0xffff);
            const float gt_ = cw[c0 + i] * x0 + cw[FFN + c0 + i] * x1 + cw[2 * FFN + c0 + i] * x2 + cb[c0 + i];
            o[i] = 0.5f * gt_ * (1.0f + erff(gt_ * 0.70710678118654752f)) * val;
        }
        v4u ov; ov.x = pk2(o[0], o[1]); ov.y = pk2(o[2], o[3]); ov.z = pk2(o[4], o[5]); ov.w = pk2(o[6], o[7]);
        *(v4u*)(u + (size_t)row * ULD + FFN + c0) = ov;
    }
}

__device__ __forceinline__ float silu_f(float x) { return x / (1.0f + __expf(-x)); }

__device__ __forceinline__ void naive_attn_unit(int tidx, bf16* proj, int b, int h, int qb, LAS unsigned char* lds) {
    asm volatile("" : "+v"(tidx));
    const int tid = tidx, qi = tid >> 1, dh = tid & 1;
    LAS float* sK = (LAS float*)lds;
    LAS float* sV = sK + 128 * 64;
    const int t = qb * 256 + qi; const size_t rowq = (size_t)b * SEQ + t;
    float q[32];
    { const v4u* qp = (const v4u*)(proj + rowq * PLD + PC_Q + h * 64 + dh * 32);
#pragma unroll
      for (int i = 0; i < 4; ++i) { const v4u v = qp[i];
#pragma unroll
          for (int j = 0; j < 4; ++j) { q[i * 8 + 2 * j] = bf2f(v[j] & 0xffff); q[i * 8 + 2 * j + 1] = bf2f(v[j] >> 16); } } }
    unsigned sel = (1u << qb) - 1u;
    if (qb >= 4) {
        float g[8];
        LAS float* part = sV;
        LAS float* km = sV + 8 * 64;
#pragma unroll
        for (int n = 0; n < 8; ++n) { if (n < qb) {
            const int d = tid & 63, pt = tid >> 6; float s = 0.f;
            for (int r = 0; r < 32; ++r) s += bf2f(proj[((size_t)b * SEQ + n * 256 + pt * 32 + r) * PLD + PC_K + h * 64 + d]);
            __syncthreads();
            part[pt * 64 + d] = s;
            __syncthreads();
            if (tid < 64) { float a = 0.f;
#pragma unroll
                for (int k = 0; k < 8; ++k) a += part[k * 64 + tid];
                km[tid] = a * (1.0f / 256.0f); }
            __syncthreads();
            float gg = 0.f;
#pragma unroll
            for (int dd = 0; dd < 32; ++dd) gg += q[dd] * km[dh * 32 + dd];
            gg += __shfl_xor(gg, 1);
            g[n] = gg;
        } else g[n] = 0.f; }
        __syncthreads();
        sel = 0u;
#pragma unroll
        for (int k = 0; k < 3; ++k) { int best = -1; float bv = 0.f;
#pragma unroll
            for (int n = 0; n < 8; ++n) if (n < qb && !((sel >> n) & 1u)) { if (best < 0 || g[n] > bv) { best = n; bv = g[n]; } }
            sel |= 1u << best; }
    }
    float acc[32];
#pragma unroll
    for (int i = 0; i < 32; ++i) acc[i] = 0.f;
    float mx = -INFINITY, l = 0.f;
    for (int n = 0; n <= qb; ++n) {
        for (int hf = 0; hf < 2; ++hf) {
            __syncthreads();
            for (int i = tid; i < 128 * 8; i += 512) { const int r = i >> 3, c = i & 7; const size_t row = (size_t)b * SEQ + n * 256 + hf * 128 + r;
                const v4u kv = *(const v4u*)(proj + row * PLD + PC_K + h * 64 + c * 8), vv = *(const v4u*)(proj + row * PLD + PC_V + h * 64 + c * 8);
#pragma unroll
                for (int j = 0; j < 4; ++j) { sK[r * 64 + c * 8 + 2 * j] = bf2f(kv[j] & 0xffff); sK[r * 64 + c * 8 + 2 * j + 1] = bf2f(kv[j] >> 16); sV[r * 64 + c * 8 + 2 * j] = bf2f(vv[j] & 0xffff); sV[r * 64 + c * 8 + 2 * j + 1] = bf2f(vv[j] >> 16); } }
            __syncthreads();
            const bool blk_ok = (n == qb) || ((sel >> n) & 1u);
#pragma unroll 1
            for (int j = 0; j < 128; ++j) {
                const int kp = n * 256 + hf * 128 + j;
                const bool valid = blk_ok && (n < qb || kp <= t);
                float s = 0.f;
#pragma unroll
                for (int d = 0; d < 32; ++d) s += q[d] * sK[j * 64 + dh * 32 + d];
                s += __shfl_xor(s, 1);
                if (valid) {
                    if (s > mx) { const float sc = exp2f(mx - s); l *= sc;
#pragma unroll
                        for (int d = 0; d < 32; ++d) acc[d] *= sc;
                        mx = s; }
                    const float pw = exp2f(s - mx); l += pw;
#pragma unroll
                    for (int d = 0; d < 32; ++d) acc[d] += pw * sV[j * 64 + dh * 32 + d];
                }
            }
        }
    }
    const float inv = 1.0f / l;
    v4u* op = (v4u*)(proj + rowq * PLD + PC_Q + h * 64 + dh * 32);
    __syncthreads();
#pragma unroll
    for (int i = 0; i < 4; ++i) { v4u o; o.x = pk2(acc[i * 8] * inv, acc[i * 8 + 1] * inv); o.y = pk2(acc[i * 8 + 2] * inv, acc[i * 8 + 3] * inv); o.z = pk2(acc[i * 8 + 4] * inv, acc[i * 8 + 5] * inv); o.w = pk2(acc[i * 8 + 6] * inv, acc[i * 8 + 7] * inv); op[i] = o; }
}

__device__ __forceinline__ void naive_ssd_pair(bf16* proj, const float* smallp, float* ssq, const float* conv_w  , const float* conv_b, const float* dt_bias, const float* a_log, const float* dskip, int b, int hp, LAS unsigned char* lds, int tidx) {
    constexpr int TB = 32;
    const int tid = tidx & 255, half = tidx >> 8, h = hp * 2 + half, g = h >> 3;
    LAS float* xa = (LAS float*)(lds + half * 65536);
    LAS float* Ba = xa + TB * 64;
    LAS float* Ca = Ba + TB * 128;
    LAS float* ys = Ca + TB * 128;
    LAS float* dta = ys + TB * 64;
    const int p = tid >> 2, nq = tid & 3;
    const float a = -__expf(a_log[h]), dsk = dskip[h], dtb = dt_bias[h];
    float st[32];
#pragma unroll
    for (int i = 0; i < 32; ++i) st[i] = 0.f;
    for (int t0 = 0; t0 < SEQ; t0 += TB) {
        __syncthreads();
        for (int i = tid; i < TB * 320; i += 256) {
            const int tt = i / 320, cc = i % 320; const int t = t0 + tt;
            int ch; if (cc < 64) ch = h * 64 + cc; else if (cc < 192) ch = 1024 + g * 128 + (cc - 64); else ch = 1280 + g * 128 + (cc - 192);
            float s = conv_b[ch];
#pragma unroll
            for (int j = 0; j < 4; ++j) { const int ts = t - 3 + j; if (ts >= 0) s += conv_w[j * 1536 + ch] * bf2f(proj[((size_t)b * SEQ + ts) * PLD + PC_XBC + ch]); }
            s = silu_f(s);
            if (cc < 64) xa[tt * 64 + cc] = s; else if (cc < 192) Ba[tt * 128 + cc - 64] = s; else Ca[tt * 128 + cc - 192] = s;
        }
        if (tid < TB) { const float v = smallp[((size_t)b * SEQ + t0 + tid) * 24 + h] + dtb; dta[tid] = (v > 20.f) ? v : log1pf(__expf(v)); }
        __syncthreads();
        for (int tt = 0; tt < TB; ++tt) {
            const float dt = dta[tt], dA = __expf(dt * a), xv = xa[tt * 64 + p], dtx = dt * xv;
            float y = 0.f;
#pragma unroll
            for (int i = 0; i < 32; ++i) { st[i] = st[i] * dA + dtx * Ba[tt * 128 + nq * 32 + i]; y += Ca[tt * 128 + nq * 32 + i] * st[i]; }
            y += __shfl_xor(y, 1); y += __shfl_xor(y, 2);
            if (nq == 0) ys[tt * 64 + p] = y + dsk * xv;
        }
        __syncthreads();
        {
            const int tt = tid >> 3, pq = tid & 7; const size_t row = (size_t)b * SEQ + t0 + tt;
            bf16* zp = proj + row * PLD + PC_Z + h * 64 + pq * 8;
            const v4u zv = *(const v4u*)zp; float o[8]; float ss = 0.f;
#pragma unroll
            for (int i = 0; i < 8; ++i) { const unsigned w = zv[i >> 1]; const float z = (i & 1) ? bf2f(w >> 16) : bf2f(w & 0xffff); o[i] = ys[tt * 64 + pq * 8 + i] * silu_f(z); ss += o[i] * o[i]; }
            ss += __shfl_xor(ss, 1); ss += __shfl_xor(ss, 2); ss += __shfl_xor(ss, 4);
            v4u ov; ov.x = pk2(o[0], o[1]); ov.y = pk2(o[2], o[3]); ov.z = pk2(o[4], o[5]); ov.w = pk2(o[6], o[7]);
            *(v4u*)zp = ov;
            if (pq == 0) ssq[row * 16 + h] = ss;
        }
    }
    __syncthreads();
}

__device__ __forceinline__ void naive_mlstm_unit(bf16* proj, const float* smallp, const float* conv_w  , const float* conv_b, const float* i_bias, const float* f_bias, const float* norm_w, int b, int hd, LAS unsigned char* lds, int tidx) {
    constexpr int TB = 16;
    LAS float* qa = (LAS float*)lds;
    LAS float* ka = qa + TB * 128;
    LAS float* va = ka + TB * 128;
    LAS float* hs = va + TB * 128;
    LAS float* lia = hs + TB * 128;
    LAS float* lfa = lia + TB;
    asm volatile("" : "+v"(tidx));
    const int tid = tidx;
    const int d = tid >> 2, eq = tid & 3;
    const float ib = i_bias[hd], fb = f_bias[hd];
    float C[32], nn[32];
#pragma unroll
    for (int i = 0; i < 32; ++i) { C[i] = 0.f; nn[i] = 0.f; }
    float mst = 0.f;
    for (int t0 = 0; t0 < SEQ; t0 += TB) {
        __syncthreads();
        for (int i = tid; i < TB * 256; i += 512) {
            const int tt = i >> 8, cc = i & 255; const int t = t0 + tt;
            const int ch = (cc < 128) ? (hd * 128 + cc) : (512 + hd * 128 + (cc - 128));
            float s = conv_b[ch];
#pragma unroll
            for (int j = 0; j < 4; ++j) { const int ts = t - 3 + j; if (ts >= 0) s += conv_w[j * 1024 + ch] * bf2f(proj[((size_t)b * SEQ + ts) * PLD + PC_MQK + ch]); }
            s = silu_f(s);
            if (cc < 128) qa[tt * 128 + cc] = s; else ka[tt * 128 + cc - 128] = s * 0.08838834764831845f;
        }
        for (int i = tid; i < TB * 128; i += 512) { const int tt = i >> 7, cc = i & 127; va[tt * 128 + cc] = bf2f(proj[((size_t)b * SEQ + t0 + tt) * PLD + PC_MV + hd * 128 + cc]); }
        if (tid < TB) { const size_t row = (size_t)b * SEQ + t0 + tid; lia[tid] = smallp[row * 24 + 16 + hd] + ib; const float fv = smallp[row * 24 + 20 + hd] + fb;
            lfa[tid] = (fv >= 0.f) ? -log1pf(__expf(-fv)) : (fv - log1pf(__expf(fv))); }
        __syncthreads();
        for (int tt = 0; tt < TB; ++tt) {
            const float li = lia[tt], lf = lfa[tt];
            const float mn = fmaxf(lf + mst, li), fi = __expf(li - mn), ff = __expf(lf + mst - mn); mst = mn;
            const float iv = fi * va[tt * 128 + d];
            float num = 0.f, den = 0.f;
#pragma unroll
            for (int i = 0; i < 32; ++i) { const float kk = ka[tt * 128 + eq * 32 + i], qq = qa[tt * 128 + eq * 32 + i];
                C[i] = ff * C[i] + iv * kk; nn[i] = ff * nn[i] + fi * kk; num += C[i] * qq; den += nn[i] * qq; }
            num += __shfl_xor(num, 1); num += __shfl_xor(num, 2); den += __shfl_xor(den, 1); den += __shfl_xor(den, 2);
            if (eq == 0) hs[tt * 128 + d] = num / fmaxf(fabsf(den), __expf(-mn));
        }
        __syncthreads();
        if (tid < TB * 16) {
            const int tt = tid >> 4, dq = tid & 15; const size_t row = (size_t)b * SEQ + t0 + tt;
            float hv[8]; float ss = 0.f;
#pragma unroll
            for (int i = 0; i < 8; ++i) { hv[i] = hs[tt * 128 + dq * 8 + i]; ss += hv[i] * hv[i]; }
            ss += __shfl_xor(ss, 1); ss += __shfl_xor(ss, 2); ss += __shfl_xor(ss, 4); ss += __shfl_xor(ss, 8);
            const float r = 1.0f / sqrtf(ss * (1.0f / 128.0f) + EPS);
            bf16* op = proj + row * PLD + PC_MO + hd * 128 + dq * 8;
            const v4u ov_ = *(const v4u*)op; float o[8];
#pragma unroll
            for (int i = 0; i < 8; ++i) { const unsigned w = ov_[i >> 1]; const float og = (i & 1) ? bf2f(w >> 16) : bf2f(w & 0xffff);
                o[i] = hv[i] * r * norm_w[hd * 128 + dq * 8 + i] * (1.0f / (1.0f + __expf(-og))); }
            v4u ov; ov.x = pk2(o[0], o[1]); ov.y = pk2(o[2], o[3]); ov.z = pk2(o[4], o[5]); ov.w = pk2(o[6], o[7]);
            *(v4u*)op = ov;
        }
    }
    __syncthreads();
}

typedef short bf16x8v __attribute__((ext_vector_type(8)));
typedef float f32x16 __attribute__((ext_vector_type(16)));
typedef short v4i16_t __attribute__((ext_vector_type(4)));
__device__ __forceinline__ bf16x8v frag_row(LAS const unsigned char* base, int pitch, int row, int kel) { return *(const LAS bf16x8v*)(base + row * pitch + kel * 2); }
__device__ __forceinline__ bf16x8v frag_tr(LAS const unsigned char* base, int pitch, int krow, int col) {
    LAS const unsigned char* p = base + krow * pitch + col * 2;
    const v4i16_t lo = __builtin_amdgcn_ds_read_tr16_b64_v4i16((LAS v4i16_t*)p);
    const v4i16_t hi = __builtin_amdgcn_ds_read_tr16_b64_v4i16((LAS v4i16_t*)(p + 4 * pitch));
    return (bf16x8v){lo[0], lo[1], lo[2], lo[3], hi[0], hi[1], hi[2], hi[3]};
}
#define MFMA32(a, b, c) __builtin_amdgcn_mfma_f32_32x32x16_bf16((a), (b), (c), 0, 0, 0)

__device__ __forceinline__ void ssd_unit(int tid, bf16* proj, const float* smallp, float* ssq, const float* conv_w  , const float* conv_b, const float* dt_bias, const float* a_log, const float* dskip, int b, int h, LAS unsigned char* lds) {
    constexpr int PB = 272, PX = 144;
    asm volatile("" : "+v"(tid));
    LAS unsigned char* CG = lds;
    LAS unsigned char* BB = lds + 34816;
    LAS unsigned char* XX = lds + 69632;
    LAS unsigned char* XW = lds + 88064;
    LAS unsigned char* ST = lds + 106496;
    LAS float* ldv = (LAS float*)(lds + 123904);
    LAS float* dtv = ldv + 128;
    const int lane0 = tid & 63, w = __builtin_amdgcn_readfirstlane(tid >> 6);
    const int g = h >> 3, pt = w & 1, lt = w >> 1;
    const float a = -__expf(a_log[h]), dsk = dskip[h], dtb = dt_bias[h];
    const int cg = tid % 40, rp = tid / 40;
    int ch; LAS unsigned char* sdst; int spitch;
    if (cg < 8) { ch = h * 64 + cg * 8; sdst = XX + cg * 16; spitch = PX; }
    else if (cg < 24) { ch = 1024 + g * 128 + (cg - 8) * 8; sdst = BB + (cg - 8) * 16; spitch = PB; }
    else { ch = 1280 + g * 128 + (cg - 24) * 8; sdst = CG + (cg - 24) * 16; spitch = PB; }
    float cw[4][8], cbv[8];
#pragma unroll
    for (int j = 0; j < 4; ++j)
#pragma unroll
        for (int i = 0; i < 8; ++i) cw[j][i] = conv_w[j * 1536 + ch + i];
#pragma unroll
    for (int i = 0; i < 8; ++i) cbv[i] = conv_b[ch + i];
    f32x16 sacc;
#pragma unroll
    for (int i = 0; i < 16; ++i) sacc[i] = 0.f;
    for (int i = tid; i < 17408 / 4; i += 512) ((LAS unsigned*)ST)[i] = 0u;
    for (int c = 0; c < 16; ++c) {
        const size_t row0 = (size_t)b * SEQ + c * 128;
        int lane = lane0; asm volatile("" : "+v"(lane));
        const int r = lane & 31, hh = lane >> 5, trq = (lane & 15) >> 2, trc = 16 * ((lane >> 4) & 1) + 4 * (lane & 3);
        __syncthreads();
        if (w == 0) {
            float v0 = smallp[(row0 + lane) * 24 + h] + dtb, v1 = smallp[(row0 + 64 + lane) * 24 + h] + dtb;
            v0 = (v0 > 20.f) ? v0 : log1pf(__expf(v0)); v1 = (v1 > 20.f) ? v1 : log1pf(__expf(v1));
            float s0 = v0 * a, s1 = v1 * a;
#pragma unroll
            for (int o = 1; o < 64; o <<= 1) { const float t0 = __shfl_up(s0, o), t1 = __shfl_up(s1, o); if (lane >= o) { s0 += t0; s1 += t1; } }
            s1 += __shfl(s0, 63);
            ldv[lane] = s0; ldv[64 + lane] = s1; dtv[lane] = v0; dtv[64 + lane] = v1;
        }
        if (rp < 12) {
            for (int row = rp; row < 128; row += 12) {
                const int t = c * 128 + row;
                float acc[8];
#pragma unroll
                for (int i = 0; i < 8; ++i) acc[i] = cbv[i];
#pragma unroll
                for (int j = 0; j < 4; ++j) { const int ts = t - 3 + j;
                    if (ts >= 0) { const v4u raw = *(const v4u*)(proj + ((size_t)b * SEQ + ts) * PLD + PC_XBC + ch);
#pragma unroll
                        for (int i = 0; i < 4; ++i) { acc[2 * i] += cw[j][2 * i] * bf2f(raw[i] & 0xffff); acc[2 * i + 1] += cw[j][2 * i + 1] * bf2f(raw[i] >> 16); } } }
#pragma unroll
                for (int i = 0; i < 8; ++i) acc[i] = silu_f(acc[i]);
                v4u o; o.x = pk2(acc[0], acc[1]); o.y = pk2(acc[2], acc[3]); o.z = pk2(acc[4], acc[5]); o.w = pk2(acc[6], acc[7]);
                *(LAS v4u*)(sdst + row * spitch) = o;
            }
        }
        __syncthreads();
        {
            const int row = tid >> 2, q4 = tid & 3; const float wl = dtv[row] * __expf(ldv[127] - ldv[row]);
#pragma unroll
            for (int k = 0; k < 2; ++k) { const v4u xv = *(const LAS v4u*)(XX + row * PX + q4 * 32 + k * 16); v4u o;
#pragma unroll
                for (int i = 0; i < 4; ++i) o[i] = pk2(bf2f(xv[i] & 0xffff) * wl, bf2f(xv[i] >> 16) * wl);
                *(LAS v4u*)(XW + row * PX + q4 * 32 + k * 16) = o; }
        }
        __syncthreads();
        f32x16 yacc;
#pragma unroll
        for (int i = 0; i < 16; ++i) yacc[i] = 0.f;
#pragma unroll
        for (int ks = 0; ks < 8; ++ks) yacc = MFMA32(frag_row(ST, PB, 32 * pt + r, 16 * ks + 8 * hh), frag_row(CG, PB, 32 * lt + r, 16 * ks + 8 * hh), yacc);
        { const float e = __expf(ldv[32 * lt + r]);
#pragma unroll
          for (int i = 0; i < 16; ++i) yacc[i] *= e; }
        f32x16 tA, tB;
        const int ltA = (w >= 6) ? 3 : (w >= 3) ? 2 : (w >= 1) ? 1 : 0, stA = w - ltA * (ltA + 1) / 2;
        const int ltB = 3, stB = w + 2;
#pragma unroll
        for (int i = 0; i < 16; ++i) { tA[i] = 0.f; tB[i] = 0.f; }
#pragma unroll
        for (int ks = 0; ks < 8; ++ks) tA = MFMA32(frag_row(BB, PB, 32 * stA + r, 16 * ks + 8 * hh), frag_row(CG, PB, 32 * ltA + r, 16 * ks + 8 * hh), tA);
        if (w < 2) {
#pragma unroll
            for (int ks = 0; ks < 8; ++ks) tB = MFMA32(frag_row(BB, PB, 32 * stB + r, 16 * ks + 8 * hh), frag_row(CG, PB, 32 * ltB + r, 16 * ks + 8 * hh), tB);
        }
        __syncthreads();
        { const int l = 32 * ltA + r; const float ldl = ldv[l];
#pragma unroll
          for (int g4 = 0; g4 < 4; ++g4) { const int s0 = 32 * stA + 8 * g4 + 4 * hh; float v[4];
#pragma unroll
              for (int j = 0; j < 4; ++j) { const int s_ = s0 + j; v[j] = (s_ <= l) ? tA[4 * g4 + j] * __expf(ldl - ldv[s_]) * dtv[s_] : 0.f; }
              *(LAS unsigned long long*)(CG + l * PB + s0 * 2) = (unsigned long long)pk2(v[0], v[1]) | ((unsigned long long)pk2(v[2], v[3]) << 32); } }
        if (w < 2) { const int l = 32 * ltB + r; const float ldl = ldv[l];
#pragma unroll
          for (int g4 = 0; g4 < 4; ++g4) { const int s0 = 32 * stB + 8 * g4 + 4 * hh; float v[4];
#pragma unroll
              for (int j = 0; j < 4; ++j) { const int s_ = s0 + j; v[j] = (s_ <= l) ? tB[4 * g4 + j] * __expf(ldl - ldv[s_]) * dtv[s_] : 0.f; }
              *(LAS unsigned long long*)(CG + l * PB + s0 * 2) = (unsigned long long)pk2(v[0], v[1]) | ((unsigned long long)pk2(v[2], v[3]) << 32); } }
        __syncthreads();
        for (int ks = 0; ks < 2 * (lt + 1); ++ks) yacc = MFMA32(frag_tr(XX, PX, 16 * ks + 8 * hh + trq, 32 * pt + trc), frag_row(CG, PB, 32 * lt + r, 16 * ks + 8 * hh), yacc);
        { const float e = __expf(ldv[127]);
#pragma unroll
          for (int i = 0; i < 16; ++i) sacc[i] *= e; }
#pragma unroll
        for (int ks = 0; ks < 8; ++ks) sacc = MFMA32(frag_tr(BB, PB, 16 * ks + 8 * hh + trq, 32 * lt + trc), frag_tr(XW, PX, 16 * ks + 8 * hh + trq, 32 * pt + trc), sacc);
        __syncthreads();
        {
            const int p = 32 * pt + r, l = 32 * lt + r;
#pragma unroll
            for (int g4 = 0; g4 < 4; ++g4) { const int n0 = 32 * lt + 8 * g4 + 4 * hh;
                *(LAS unsigned long long*)(ST + p * PB + n0 * 2) = (unsigned long long)pk2(sacc[4 * g4], sacc[4 * g4 + 1]) | ((unsigned long long)pk2(sacc[4 * g4 + 2], sacc[4 * g4 + 3]) << 32);
                const int p0 = 32 * pt + 8 * g4 + 4 * hh;
                *(LAS f32x4*)(CG + l * 272 + p0 * 4) = (f32x4){yacc[4 * g4], yacc[4 * g4 + 1], yacc[4 * g4 + 2], yacc[4 * g4 + 3]}; }
        }
        __syncthreads();
        {
            const int row = tid >> 2, q4 = tid & 3;
            bf16* zp = proj + (row0 + row) * PLD + PC_Z + h * 64 + q4 * 16;
            float o[16]; float ss = 0.f;
#pragma unroll
            for (int k = 0; k < 2; ++k) { const v4u zv = *(const v4u*)(zp + 8 * k); const v4u xv = *(const LAS v4u*)(XX + row * PX + q4 * 32 + k * 16);
                const f32x4 y0 = *(const LAS f32x4*)(CG + row * 272 + (q4 * 16 + 8 * k) * 4), y1 = *(const LAS f32x4*)(CG + row * 272 + (q4 * 16 + 8 * k + 4) * 4);
#pragma unroll
                for (int i = 0; i < 4; ++i) { const float ya = (i < 2 ? y0[2 * i] : y1[2 * i - 4]), yb = (i < 2 ? y0[2 * i + 1] : y1[2 * i - 3]);
                    const float oa = (ya + dsk * bf2f(xv[i] & 0xffff)) * silu_f(bf2f(zv[i] & 0xffff)), ob = (yb + dsk * bf2f(xv[i] >> 16)) * silu_f(bf2f(zv[i] >> 16));
                    o[8 * k + 2 * i] = oa; o[8 * k + 2 * i + 1] = ob; ss += oa * oa + ob * ob; } }
            ss += __shfl_xor(ss, 1); ss += __shfl_xor(ss, 2);
#pragma unroll
            for (int k = 0; k < 2; ++k) { v4u ov; ov.x = pk2(o[8 * k], o[8 * k + 1]); ov.y = pk2(o[8 * k + 2], o[8 * k + 3]); ov.z = pk2(o[8 * k + 4], o[8 * k + 5]); ov.w = pk2(o[8 * k + 6], o[8 * k + 7]); *(v4u*)(zp + 8 * k) = ov; }
            if (q4 == 0) ssq[(row0 + row) * 16 + h] = ss;
        }
    }
    __syncthreads();
}

__device__ __forceinline__ void mlstm_unit(int tid, bf16* proj, const float* smallp, const float* conv_w  , const float* conv_b, const float* i_bias, const float* f_bias, const float* norm_w, int b, int hd, LAS unsigned char* lds) {
    constexpr int PB = 272;
    asm volatile("" : "+v"(tid));
    LAS unsigned char* QP = lds;
    LAS unsigned char* KK = lds + 34816;
    LAS unsigned char* VV = lds + 69632;
    LAS unsigned char* CS = lds + 104448;
    LAS float* uu = (LAS float*)(lds + 139264);
    LAS float* mmv = uu + 128;
    LAS float* wint = mmv + 128;
    LAS float* dnv = wint + 128;
    LAS float* wlv = dnv + 128;
    LAS float* den = wlv + 128;
    LAS float* nst = den + 128;
    LAS float* nacc = nst + 128;
    LAS float* scal = nacc + 128;
    const int lane0 = tid & 63, w = __builtin_amdgcn_readfirstlane(tid >> 6);
    const int tt = w >> 1, dp = w & 1;
    const float ib = i_bias[hd], fb = f_bias[hd];
    const int cg = tid & 31, rp = tid >> 5;
    const int ch = (cg < 16) ? (hd * 128 + cg * 8) : (512 + hd * 128 + (cg - 16) * 8);
    LAS unsigned char* sdst = (cg < 16) ? (QP + cg * 16) : (KK + (cg - 16) * 16);
    const float post = (cg < 16) ? 1.0f : 0.08838834764831845f;
    float cw[4][8], cbv[8];
#pragma unroll
    for (int j = 0; j < 4; ++j)
#pragma unroll
        for (int i = 0; i < 8; ++i) cw[j][i] = conv_w[j * 1024 + ch + i];
#pragma unroll
    for (int i = 0; i < 8; ++i) cbv[i] = conv_b[ch + i];
    f32x16 cacc0, cacc1;
#pragma unroll
    for (int i = 0; i < 16; ++i) { cacc0[i] = 0.f; cacc1[i] = 0.f; }
    for (int i = tid; i < 34816 / 4; i += 512) ((LAS unsigned*)CS)[i] = 0u;
    if (tid < 128) nst[tid] = 0.f;
    float mst = 0.f;
    for (int c = 0; c < 16; ++c) {
        const size_t row0 = (size_t)b * SEQ + c * 128;
        int lane = lane0; asm volatile("" : "+v"(lane));
        const int r = lane & 31, hh = lane >> 5, trq = (lane & 15) >> 2, trc = 16 * ((lane >> 4) & 1) + 4 * (lane & 3);
        __syncthreads();
        if (w == 0) {
            const float li0 = smallp[(row0 + lane) * 24 + 16 + hd] + ib, li1 = smallp[(row0 + 64 + lane) * 24 + 16 + hd] + ib;
            const float f0 = smallp[(row0 + lane) * 24 + 20 + hd] + fb, f1 = smallp[(row0 + 64 + lane) * 24 + 20 + hd] + fb;
            float c0 = (f0 >= 0.f) ? -log1pf(__expf(-f0)) : (f0 - log1pf(__expf(f0))), c1 = (f1 >= 0.f) ? -log1pf(__expf(-f1)) : (f1 - log1pf(__expf(f1)));
#pragma unroll
            for (int o = 1; o < 64; o <<= 1) { const float t0 = __shfl_up(c0, o), t1 = __shfl_up(c1, o); if (lane >= o) { c0 += t0; c1 += t1; } }
            c1 += __shfl(c0, 63);
            const float totf = __shfl(c1, 63);
            const float u0 = li0 - c0, u1 = li1 - c1;
            float p0 = u0, p1 = u1;
#pragma unroll
            for (int o = 1; o < 64; o <<= 1) { const float t0 = __shfl_up(p0, o), t1 = __shfl_up(p1, o); if (lane >= o) { p0 = fmaxf(p0, t0); p1 = fmaxf(p1, t1); } }
            p1 = fmaxf(p1, __shfl(p0, 63));
            const float mloc = totf + __shfl(p1, 63), mnew = fmaxf(totf + mst, mloc);
            const float m0 = fmaxf(p0, mst), m1 = fmaxf(p1, mst);
            uu[lane] = u0; uu[64 + lane] = u1; mmv[lane] = m0; mmv[64 + lane] = m1;
            wint[lane] = __expf(mst - m0); wint[64 + lane] = __expf(mst - m1);
            dnv[lane] = __expf(-(c0 + m0)); dnv[64 + lane] = __expf(-(c1 + m1));
            wlv[lane] = __expf(totf + u0 - mnew); wlv[64 + lane] = __expf(totf + u1 - mnew);
            if (lane == 0) scal[0] = __expf(totf + mst - mnew);
            mst = mnew;
        }
        if (tid < 128) nacc[tid] = 0.f;
        for (int row = rp; row < 128; row += 16) {
            const int t = c * 128 + row;
            float acc[8];
#pragma unroll
            for (int i = 0; i < 8; ++i) acc[i] = cbv[i];
#pragma unroll
            for (int j = 0; j < 4; ++j) { const int ts = t - 3 + j;
                if (ts >= 0) { const v4u raw = *(const v4u*)(proj + ((size_t)b * SEQ + ts) * PLD + PC_MQK + ch);
#pragma unroll
                    for (int i = 0; i < 4; ++i) { acc[2 * i] += cw[j][2 * i] * bf2f(raw[i] & 0xffff); acc[2 * i + 1] += cw[j][2 * i + 1] * bf2f(raw[i] >> 16); } } }
#pragma unroll
            for (int i = 0; i < 8; ++i) acc[i] = silu_f(acc[i]) * post;
            v4u o; o.x = pk2(acc[0], acc[1]); o.y = pk2(acc[2], acc[3]); o.z = pk2(acc[4], acc[5]); o.w = pk2(acc[6], acc[7]);
            *(LAS v4u*)(sdst + row * PB) = o;
        }
        for (int it = tid; it < 2048; it += 512) { const int row = it >> 4, cc = it & 15;
            *(LAS v4u*)(VV + row * PB + cc * 16) = *(const v4u*)(proj + (row0 + row) * PLD + PC_MV + hd * 128 + cc * 8); }
        __syncthreads();
        f32x16 na0, na1;
#pragma unroll
        for (int i = 0; i < 16; ++i) { na0[i] = 0.f; na1[i] = 0.f; }
#pragma unroll
        for (int ks = 0; ks < 8; ++ks) { const bf16x8v qf = frag_row(QP, PB, 32 * tt + r, 16 * ks + 8 * hh);
            na0 = MFMA32(frag_row(CS, PB, 32 * (2 * dp) + r, 16 * ks + 8 * hh), qf, na0);
            na1 = MFMA32(frag_row(CS, PB, 32 * (2 * dp + 1) + r, 16 * ks + 8 * hh), qf, na1); }
        { const float e = wint[32 * tt + r];
#pragma unroll
          for (int i = 0; i < 16; ++i) { na0[i] *= e; na1[i] *= e; } }
        {
            const int t = tid >> 2, q4 = tid & 3; float d = 0.f;
#pragma unroll
            for (int k = 0; k < 4; ++k) { const v4u qv = *(const LAS v4u*)(QP + t * PB + q4 * 64 + k * 16);
#pragma unroll
                for (int i = 0; i < 4; ++i) d += bf2f(qv[i] & 0xffff) * nst[q4 * 32 + k * 8 + 2 * i] + bf2f(qv[i] >> 16) * nst[q4 * 32 + k * 8 + 2 * i + 1]; }
            d += __shfl_xor(d, 1); d += __shfl_xor(d, 2);
            if (q4 == 0) den[t] = d * wint[t];
        }
        f32x16 tA, tB;
        const int ttA = (w >= 6) ? 3 : (w >= 3) ? 2 : (w >= 1) ? 1 : 0, stA = w - ttA * (ttA + 1) / 2;
        const int ttB = 3, stB = w + 2;
#pragma unroll
        for (int i = 0; i < 16; ++i) { tA[i] = 0.f; tB[i] = 0.f; }
#pragma unroll
        for (int ks = 0; ks < 8; ++ks) tA = MFMA32(frag_row(KK, PB, 32 * stA + r, 16 * ks + 8 * hh), frag_row(QP, PB, 32 * ttA + r, 16 * ks + 8 * hh), tA);
        if (w < 2) {
#pragma unroll
            for (int ks = 0; ks < 8; ++ks) tB = MFMA32(frag_row(KK, PB, 32 * stB + r, 16 * ks + 8 * hh), frag_row(QP, PB, 32 * ttB + r, 16 * ks + 8 * hh), tB);
        }
        __syncthreads();
        { const int t = 32 * ttA + r; const float mt = mmv[t]; float ds = 0.f;
#pragma unroll
          for (int g4 = 0; g4 < 4; ++g4) { const int s0 = 32 * stA + 8 * g4 + 4 * hh; float v[4];
#pragma unroll
              for (int j = 0; j < 4; ++j) { const int s_ = s0 + j; v[j] = (s_ <= t) ? tA[4 * g4 + j] * __expf(uu[s_] - mt) : 0.f; ds += v[j]; }
              *(LAS unsigned long long*)(QP + t * PB + s0 * 2) = (unsigned long long)pk2(v[0], v[1]) | ((unsigned long long)pk2(v[2], v[3]) << 32); }
          ds += __shfl_xor(ds, 32);
          if (hh == 0) __hip_atomic_fetch_add(den + t, ds, __ATOMIC_RELAXED, __HIP_MEMORY_SCOPE_WORKGROUP); }
        if (w < 2) { const int t = 32 * ttB + r; const float mt = mmv[t]; float ds = 0.f;
#pragma unroll
          for (int g4 = 0; g4 < 4; ++g4) { const int s0 = 32 * stB + 8 * g4 + 4 * hh; float v[4];
#pragma unroll
              for (int j = 0; j < 4; ++j) { const int s_ = s0 + j; v[j] = (s_ <= t) ? tB[4 * g4 + j] * __expf(uu[s_] - mt) : 0.f; ds += v[j]; }
              *(LAS unsigned long long*)(QP + t * PB + s0 * 2) = (unsigned long long)pk2(v[0], v[1]) | ((unsigned long long)pk2(v[2], v[3]) << 32); }
          ds += __shfl_xor(ds, 32);
          if (hh == 0) __hip_atomic_fetch_add(den + t, ds, __ATOMIC_RELAXED, __HIP_MEMORY_SCOPE_WORKGROUP); }
        {
            const int rg = tid >> 4, ec = tid & 15; float cs[8];
#pragma unroll
            for (int i = 0; i < 8; ++i) cs[i] = 0.f;
#pragma unroll
            for (int k = 0; k < 4; ++k) { const int row = 4 * rg + k; const float wl = wlv[row]; LAS v4u* p = (LAS v4u*)(KK + row * PB + ec * 16); const v4u kv = *p; v4u o;
#pragma unroll
                for (int i = 0; i < 4; ++i) { const float a0 = bf2f(kv[i] & 0xffff) * wl, a1 = bf2f(kv[i] >> 16) * wl; o[i] = pk2(a0, a1); cs[2 * i] += a0; cs[2 * i + 1] += a1; }
                *p = o; }
#pragma unroll
            for (int i = 0; i < 8; ++i) { cs[i] += __shfl_xor(cs[i], 16); cs[i] += __shfl_xor(cs[i], 32); }
            if (lane < 16) {
#pragma unroll
                for (int i = 0; i < 8; ++i) __hip_atomic_fetch_add(nacc + ec * 8 + i, cs[i], __ATOMIC_RELAXED, __HIP_MEMORY_SCOPE_WORKGROUP); }
        }
        __syncthreads();
        for (int ks = 0; ks < 2 * (tt + 1); ++ks) { const bf16x8v pf = frag_row(QP, PB, 32 * tt + r, 16 * ks + 8 * hh);
            na0 = MFMA32(frag_tr(VV, PB, 16 * ks + 8 * hh + trq, 32 * (2 * dp) + trc), pf, na0);
            na1 = MFMA32(frag_tr(VV, PB, 16 * ks + 8 * hh + trq, 32 * (2 * dp + 1) + trc), pf, na1); }
        { const float e = scal[0];
#pragma unroll
          for (int i = 0; i < 16; ++i) { cacc0[i] *= e; cacc1[i] *= e; } }
#pragma unroll
        for (int ks = 0; ks < 8; ++ks) { const bf16x8v kf = frag_tr(KK, PB, 16 * ks + 8 * hh + trq, 32 * tt + trc);
            cacc0 = MFMA32(kf, frag_tr(VV, PB, 16 * ks + 8 * hh + trq, 32 * (2 * dp) + trc), cacc0);
            cacc1 = MFMA32(kf, frag_tr(VV, PB, 16 * ks + 8 * hh + trq, 32 * (2 * dp + 1) + trc), cacc1); }
        __syncthreads();
        {
            const int t = 32 * tt + r; const float dv = 1.0f / fmaxf(fabsf(den[t]), dnv[t]);
#pragma unroll
            for (int g4 = 0; g4 < 4; ++g4) {
                const int e0 = 32 * tt + 8 * g4 + 4 * hh, d0 = 32 * (2 * dp) + r, d1 = 32 * (2 * dp + 1) + r;
                *(LAS unsigned long long*)(CS + d0 * PB + e0 * 2) = (unsigned long long)pk2(cacc0[4 * g4], cacc0[4 * g4 + 1]) | ((unsigned long long)pk2(cacc0[4 * g4 + 2], cacc0[4 * g4 + 3]) << 32);
                *(LAS unsigned long long*)(CS + d1 * PB + e0 * 2) = (unsigned long long)pk2(cacc1[4 * g4], cacc1[4 * g4 + 1]) | ((unsigned long long)pk2(cacc1[4 * g4 + 2], cacc1[4 * g4 + 3]) << 32);
                const int dd0 = 32 * (2 * dp) + 8 * g4 + 4 * hh, dd1 = dd0 + 32;
                *(LAS unsigned long long*)(QP + t * PB + dd0 * 2) = (unsigned long long)pk2(na0[4 * g4] * dv, na0[4 * g4 + 1] * dv) | ((unsigned long long)pk2(na0[4 * g4 + 2] * dv, na0[4 * g4 + 3] * dv) << 32);
                *(LAS unsigned long long*)(QP + t * PB + dd1 * 2) = (unsigned long long)pk2(na1[4 * g4] * dv, na1[4 * g4 + 1] * dv) | ((unsigned long long)pk2(na1[4 * g4 + 2] * dv, na1[4 * g4 + 3] * dv) << 32);
            }
            if (tid < 128) nst[tid] = nst[tid] * scal[0] + nacc[tid];
        }
        __syncthreads();
        {
            const int t = tid >> 2, q4 = tid & 3; float hv[32]; float ss = 0.f;
#pragma unroll
            for (int k = 0; k < 4; ++k) { const v4u x = *(const LAS v4u*)(QP + t * PB + q4 * 64 + k * 16);
#pragma unroll
                for (int i = 0; i < 4; ++i) { hv[8 * k + 2 * i] = bf2f(x[i] & 0xffff); hv[8 * k + 2 * i + 1] = bf2f(x[i] >> 16); ss += hv[8 * k + 2 * i] * hv[8 * k + 2 * i] + hv[8 * k + 2 * i + 1] * hv[8 * k + 2 * i + 1]; } }
            ss += __shfl_xor(ss, 1); ss += __shfl_xor(ss, 2);
            const float rr = 1.0f / sqrtf(ss * (1.0f / 128.0f) + EPS);
            bf16* op = proj + (row0 + t) * PLD + PC_MO + hd * 128 + q4 * 32;
            const float* nw = norm_w + hd * 128 + q4 * 32;
#pragma unroll
            for (int k = 0; k < 4; ++k) { const v4u og = *(const v4u*)(op + 8 * k); v4u o;
#pragma unroll
                for (int i = 0; i < 4; ++i) { const float g0 = 1.0f / (1.0f + __expf(-bf2f(og[i] & 0xffff))), g1 = 1.0f / (1.0f + __expf(-bf2f(og[i] >> 16)));
                    o[i] = pk2(hv[8 * k + 2 * i] * rr * nw[8 * k + 2 * i] * g0, hv[8 * k + 2 * i + 1] * rr * nw[8 * k + 2 * i + 1] * g1); }
                *(v4u*)(op + 8 * k) = o; }
        }
    }
    __syncthreads();
}

namespace attn_body {
using bf16=__hip_bfloat16;
using bf16x8=__attribute__((ext_vector_type(8)))short;
using s16x4=__attribute__((ext_vector_type(4)))short;
using f32x16=__attribute__((ext_vector_type(16)))float;
using u32x4=__attribute__((ext_vector_type(4)))unsigned;
constexpr int BATCH=8,NHEAD=8,SEQ=2048,D=64,DM=6144;
constexpr int NW=8,QBLK=32,QB=QBLK*NW,KVBLK=64,NQB=SEQ/QB;
constexpr int ATTN_PITCH=DM, ATTN_UNIT_ROWS=QB;
__device__ __forceinline__ int crow(int r,int hi){return (r&3)+8*(r>>2)+4*hi;}
#define SBAR() __builtin_amdgcn_sched_barrier(0)
__device__ __forceinline__ void cmask(f32x16&p0,f32x16&p1,int jb,int qrel,int hi){
  const float NEG=-INFINITY; int kb=64*jb+4*hi;
  #pragma unroll
  for(int r=0;r<16;++r){int kv=kb+(r&3)+8*(r>>2); if(kv>qrel)p0[r]=NEG; if(kv+32>qrel)p1[r]=NEG;}
}

typedef float f32x4_t __attribute__((ext_vector_type(4)));
__device__ __forceinline__ float bfu(short v){return __uint_as_float(((unsigned)(unsigned short)v)<<16);}
constexpr int NSLOT=3, SLOTB=8192;
constexpr int LDS_K=0, LDS_V=NSLOT*SLOTB, LDS_WS=2*NSLOT*SLOTB, LDS_OST=LDS_WS+NW*64*4, LDS_BYTES=LDS_OST+NW*4096;
constexpr float C2=0.125f*1.4426950408889634f;
__device__ __forceinline__ void glds16(const void*gsrc,unsigned lds_dst){unsigned keep;
  asm volatile("s_mov_b32 %0, m0\n\ts_mov_b32 m0, %2\n\ts_nop 0\n\tglobal_load_lds_dwordx4 %1, off\n\ts_mov_b32 m0, %0":"=&s"(keep):"v"(gsrc),"s"(lds_dst):"memory");}
__device__ __forceinline__ float max3f(float a,float b,float c){float r;asm("v_max3_f32 %0, %1, %2, %3":"=v"(r):"v"(a),"v"(b),"v"(c));return r;}
__device__ __forceinline__ float max2f(float a,float b){float r;asm("v_max_f32_e32 %0, %1, %2":"=v"(r):"v"(a),"v"(b));return r;}
__device__ __forceinline__ float fadd_s(float a,float b){float r;asm("v_add_f32_e32 %0, %1, %2":"=v"(r):"v"(a),"v"(b));return r;}
__device__ __forceinline__ float fsub_s(float a,float b){float r;asm("v_sub_f32_e32 %0, %1, %2":"=v"(r):"v"(a),"v"(b));return r;}
typedef float f32x2_t __attribute__((ext_vector_type(2))); typedef __bf16 bf16x2_t __attribute__((ext_vector_type(2)));
__device__ __forceinline__ unsigned cvtpk_s(float lo,float hi){f32x2_t v={lo,hi};bf16x2_t b=__builtin_convertvector(v,bf16x2_t);return __builtin_bit_cast(unsigned,b);}
#define WAIT_BAR(N) asm volatile("s_waitcnt vmcnt(" #N ") lgkmcnt(0)\n\ts_barrier":::"memory")

__device__ __forceinline__ void qkt(f32x16&p0,f32x16&p1,const char*Kslot,const bf16x8*qr,const f32x16&negm,int r32,int hi){
  const char*kb=Kslot+hi*1024+r32*16;
  #pragma unroll
  for(int d0=0;d0<4;++d0){
    const bf16x8 b0=*reinterpret_cast<const bf16x8*>(kb+d0*2048);
    const bf16x8 b1=*reinterpret_cast<const bf16x8*>(kb+d0*2048+512);
    if(d0==0){p0=__builtin_amdgcn_mfma_f32_32x32x16_bf16(b0,qr[0],negm,0,0,0);p1=__builtin_amdgcn_mfma_f32_32x32x16_bf16(b1,qr[0],negm,0,0,0);}
    else{p0=__builtin_amdgcn_mfma_f32_32x32x16_bf16(b0,qr[d0],p0,0,0,0);p1=__builtin_amdgcn_mfma_f32_32x32x16_bf16(b1,qr[d0],p1,0,0,0);}}
}
typedef __attribute__((address_space(3))) const char* lds_cptr;
typedef short v4i16_t __attribute__((ext_vector_type(4)));
__device__ __forceinline__ void kload8(bf16x8*kf,lds_cptr kp){
  kf[0]=*(const __attribute__((address_space(3))) bf16x8*)(kp);      kf[1]=*(const __attribute__((address_space(3))) bf16x8*)(kp+512);
  kf[2]=*(const __attribute__((address_space(3))) bf16x8*)(kp+2048); kf[3]=*(const __attribute__((address_space(3))) bf16x8*)(kp+2560);
  kf[4]=*(const __attribute__((address_space(3))) bf16x8*)(kp+4096); kf[5]=*(const __attribute__((address_space(3))) bf16x8*)(kp+4608);
  kf[6]=*(const __attribute__((address_space(3))) bf16x8*)(kp+6144); kf[7]=*(const __attribute__((address_space(3))) bf16x8*)(kp+6656);
}
__device__ __forceinline__ void kload2(bf16x8*kf,lds_cptr kp,int j){ kf[2*j]=*(const __attribute__((address_space(3))) bf16x8*)(kp+j*2048); kf[2*j+1]=*(const __attribute__((address_space(3))) bf16x8*)(kp+j*2048+512); }
__device__ __forceinline__ s16x4 vtr(lds_cptr p){ return __builtin_bit_cast(s16x4,__builtin_amdgcn_ds_read_tr16_b64_v4i16((__attribute__((address_space(3))) v4i16_t*)p)); }
__device__ __forceinline__ float rowmax(const f32x16&p0,const f32x16&p1){
  float a=max3f(p0[0],p0[1],p1[0]),b=max3f(p0[2],p0[3],p1[1]);a=max3f(a,p1[2],p1[3]);
  #pragma unroll
  for(int r=4;r<16;r+=4){a=max3f(a,p0[r],p0[r+1]);b=max3f(b,p0[r+2],p0[r+3]);a=max3f(a,p1[r],p1[r+1]);b=max3f(b,p1[r+2],p1[r+3]);}
  const float m=max2f(a,b);
  auto rr=__builtin_amdgcn_permlane32_swap(__float_as_uint(m),__float_as_uint(m),false,false);
  return max2f(__uint_as_float(rr[0]),__uint_as_float(rr[1]));
}
__device__ __forceinline__ void pv(f32x16*o,int vb,bf16x8 pa0,bf16x8 pa1,bf16x8 pa2,bf16x8 pa3){
  #pragma unroll
  for(int d0=0;d0<2;++d0){s16x4 lo[4],hi[4];
    #pragma unroll
    for(int ks=0;ks<4;++ks){
      asm volatile("ds_read_b64_tr_b16 %0,%1 offset:%c2":"=&v"(lo[ks]):"v"(vb),"i"(d0*4096+ks*1024):"memory");
      asm volatile("ds_read_b64_tr_b16 %0,%1 offset:%c2":"=&v"(hi[ks]):"v"(vb),"i"(d0*4096+ks*1024+512):"memory");}
    asm volatile("s_waitcnt lgkmcnt(0)":::"memory");SBAR();
    #define PK(k) (bf16x8){lo[k][0],lo[k][1],lo[k][2],lo[k][3],hi[k][0],hi[k][1],hi[k][2],hi[k][3]}
    o[d0]=__builtin_amdgcn_mfma_f32_32x32x16_bf16(pa0,PK(0),o[d0],0,0,0);
    o[d0]=__builtin_amdgcn_mfma_f32_32x32x16_bf16(pa1,PK(1),o[d0],0,0,0);
    o[d0]=__builtin_amdgcn_mfma_f32_32x32x16_bf16(pa2,PK(2),o[d0],0,0,0);
    o[d0]=__builtin_amdgcn_mfma_f32_32x32x16_bf16(pa3,PK(3),o[d0],0,0,0);
    #undef PK
  }
}

#ifndef ATTN_STORE16
#define ATTN_STORE16(p,v) (*(u32x4*)(p)=(v))
#endif
template<int THRL> __device__ __forceinline__ void attn_unit(int tid,int b,int h,int qb,const bf16*Q,const bf16*__restrict__ K,const bf16*__restrict__ V,bf16*O,const float*__restrict__ ksum,char*shm){
  asm volatile("":"+v"(tid));
  const int lane=tid&63,r32=lane&31,hi=lane>>5; const int wid=__builtin_amdgcn_readfirstlane(tid>>6);
  const long rowbase=(long)b*SEQ; const int q0=qb*QB;
  const bf16*Qw=Q+(rowbase+q0+wid*QBLK)*DM+h*D;
  const bf16*Kh=K+rowbase*DM+h*D,*Vh=V+rowbase*DM+h*D;
  const unsigned lds0=(unsigned)(uintptr_t)shm;
  float*wsf=(float*)(shm+LDS_WS)+wid*64;
  const bf16*ksrc=Kh+(long)lane*DM+wid*8;
  const bf16*vsrc=Vh+(long)(16*(wid&3)+(lane>>2))*DM+(wid>>2)*32+(lane&3)*8;
  const unsigned kdst=lds0+LDS_K+wid*1024, vdst=lds0+LDS_V+wid*1024;
  #define DMA_K(t,slot) glds16(ksrc+(long)(t)*KVBLK*DM,(unsigned)__builtin_amdgcn_readfirstlane(kdst+(slot)))
  #define DMA_V(t,slot) glds16(vsrc+(long)(t)*KVBLK*DM,(unsigned)__builtin_amdgcn_readfirstlane(vdst+(slot)))
  const int vb0=(int)(lds0+LDS_V)+((lane>>4)&1)*32+(lane&3)*8+(4*hi+((lane&15)>>2))*64;
  const char*Kbase=shm+LDS_K; bf16x8 kf[8];
  const lds_cptr shm3=(lds_cptr)shm; const lds_cptr kp0=shm3+LDS_K+hi*1024+r32*16; const lds_cptr vp0=shm3+LDS_V+((lane>>4)&1)*32+(lane&3)*8+(4*hi+((lane&15)>>2))*64;
  const int NT=(q0+QB)/KVBLK;
  DMA_K(0,0);DMA_V(0,0);DMA_K(1,SLOTB);
  bf16x8 qr[4];
  #pragma unroll
  for(int d0=0;d0<4;++d0)qr[d0]=*reinterpret_cast<const bf16x8*>(&Qw[(long)r32*DM+d0*16+hi*8]);
  unsigned sel=(1u<<qb)-1u;
  if(qb>=4){
    float g[8];
    #pragma unroll
    for(int n=0;n<8;++n){ g[n]=0.f;
      if(n<qb){ const float*kp=ksum+(((long)(b*8+n)*NHEAD+h)*64)+hi*8; float a=0.f;
        #pragma unroll
        for(int d0=0;d0<4;++d0){ const f32x4_t k0=*(const f32x4_t*)(kp+d0*16),k1=*(const f32x4_t*)(kp+d0*16+4);
          #pragma unroll
          for(int j=0;j<4;++j){ a+=bfu(qr[d0][j])*k0[j]; a+=bfu(qr[d0][4+j])*k1[j]; } }
        a+=__shfl_xor(a,32); g[n]=a; } }
    sel=0u;
    #pragma unroll
    for(int k=0;k<3;++k){ int best=-1; float bv=0.f;
      #pragma unroll
      for(int n=0;n<8;++n) if(n<qb&&!((sel>>n)&1u)){ if(best<0||g[n]>bv){best=n;bv=g[n];} }
      sel|=1u<<best; }
  }
  const f32x16 ninf={-INFINITY,-INFINITY,-INFINITY,-INFINITY,-INFINITY,-INFINITY,-INFINITY,-INFINITY,-INFINITY,-INFINITY,-INFINITY,-INFINITY,-INFINITY,-INFINITY,-INFINITY,-INFINITY};
  #define CINIT(t) ({ const bool mk_=((t)<NT-4)&&!((sel>>((t)>>2))&1u); f32x16 c_; _Pragma("unroll") for(int r_=0;r_<16;++r_)c_[r_]=mk_?ninf[r_]:negm[r_]; c_; })
  float mhat=0.f,l_reg=0.f;f32x16 o[2];o[0]=f32x16{};o[1]=f32x16{};f32x16 negm=f32x16{};asm volatile("":"+v"(negm));
  const int qrel=wid*QBLK+r32;
  #define CMASK(P0,P1,t) do{int jb_=(t)-(NT-4); if(jb_>=0)cmask(P0,P1,jb_,qrel,hi);}while(0)
  bool resc=false;
  #define START(P0,P1) do{ const float rm=rowmax(P0,P1); resc=false; \
    { const float dl=max2f(rm,-64.f); mhat=fadd_s(mhat,dl); \
      _Pragma("unroll") for(int r=0;r<16;++r){P0[r]=fsub_s(P0[r],dl);P1[r]=fsub_s(P1[r],dl);} \
      _Pragma("unroll") for(int r=0;r<16;++r)negm[r]=-mhat; asm volatile("":"+v"(negm)); } \
    _Pragma("unroll") for(int r=0;r<16;++r)P0[r]=__builtin_amdgcn_exp2f(P0[r]); }while(0)
  #define RESC() do{ if(resc){ asm volatile("s_waitcnt lgkmcnt(0)":::"memory"); \
      _Pragma("unroll") for(int d_=0;d_<2;++d_) _Pragma("unroll") for(int r=0;r<16;++r)o[d_][r]*=wsf[crow(r,hi)]; } }while(0)
  f32x16 pA0,pA1,pB0,pB1;
  int sl_prev=0,sl_cur=0,sl_next=SLOTB;
  #define ROT() do{sl_prev=sl_cur;sl_cur=sl_next;sl_next=(sl_next==(NSLOT-1)*SLOTB)?0:sl_next+SLOTB;}while(0)
  DMA_K(2,2*SLOTB);
  WAIT_BAR(3);
  { const f32x16 c0_=CINIT(0); qkt(pA0,pA1,Kbase,qr,c0_,r32,hi); }asm volatile("s_nop 15\n\ts_nop 7":"+v"(pA0),"+v"(pA1));CMASK(pA0,pA1,0);
  START(pA0,pA1);
  _Pragma("unroll") for(int r=0;r<16;++r)pA1[r]=__builtin_amdgcn_exp2f(pA1[r]);
  WAIT_BAR(0);
  DMA_K(3,0);DMA_V(1,SLOTB);
  ROT();
  kload8(kf,kp0+sl_cur);
  WAIT_BAR(2);
  s16x4 vlo[8],vhi[8]; u32x4 pw0,pw1,pw2,pw3;
  #define PKW(P,B) cvtpk_s(P[B],P[B+1])
  #define PAF(k) __builtin_bit_cast(bf16x8,pw##k)
  #define VFR(i) (bf16x8){vlo[i][0],vlo[i][1],vlo[i][2],vlo[i][3],vhi[i][0],vhi[i][1],vhi[i][2],vhi[i][3]}
  #define PIN(x) asm volatile("":"+v"(x))
  #define MX3(a,b,c) __builtin_fmaxf(__builtin_fmaxf((a),(b)),(c))
  #define GAPA(MF,A0,A1,A2,A3,W0,W1,PW) do{ MF; sacc+=A0; sacc+=A1; sacc+=A2; sacc+=A3; PIN(sacc); W0; W1; PIN(PW); SBAR(); }while(0)
  #define EX(v) __builtin_amdgcn_exp2f(v)
  #define GAPB(MF,X,B) do{ MF; X[B]=EX(X[B]); X[B+1]=EX(X[B+1]); X[B+2]=EX(X[B+2]); X[B+3]=EX(X[B+3]); PIN(X); SBAR(); }while(0)
  #define VRD(i) do{ vlo[i]=vtr(vp_+(((i)>>2)*4096+((i)&3)*1024)); vhi[i]=vtr(vp_+(((i)>>2)*4096+((i)&3)*1024+512)); }while(0)
  #define KRD(G,j) do{ if(G){ kload2(kf,kp0+sl_next,j); SBAR(); } }while(0)
  #define STEP(C0,C1,P0,P1,t,GK,GV,GL) do{ SBAR(); \
    const lds_cptr vp_=vp0+sl_prev; const f32x16 cin_=CINIT(t); \
    VRD(0); SBAR(); float sacc=(P0[0]+P0[1]); \
    GAPA(C0=__builtin_amdgcn_mfma_f32_32x32x16_bf16(kf[0],qr[0],cin_,0,0,0), P0[2],P0[3],P0[4],P0[5],     pw0[0]=PKW(P0,0), pw0[1]=PKW(P0,2), pw0); \
    VRD(4); SBAR(); GAPA(C1=__builtin_amdgcn_mfma_f32_32x32x16_bf16(kf[1],qr[0],cin_,0,0,0), P0[6],P0[7],P0[8],P0[9],     pw0[2]=PKW(P0,4), pw0[3]=PKW(P0,6), pw0); \
    VRD(1); SBAR(); GAPA(C0=__builtin_amdgcn_mfma_f32_32x32x16_bf16(kf[2],qr[1],C0,0,0,0),   P0[10],P0[11],P0[12],P0[13], pw1[0]=PKW(P0,8), pw1[1]=PKW(P0,10), pw1); \
    VRD(5); SBAR(); GAPA(C1=__builtin_amdgcn_mfma_f32_32x32x16_bf16(kf[3],qr[1],C1,0,0,0),   P0[14],P0[15],P1[0],P1[1],   pw1[2]=PKW(P0,12),pw1[3]=PKW(P0,14), pw1); \
    VRD(2); SBAR(); GAPA(C0=__builtin_amdgcn_mfma_f32_32x32x16_bf16(kf[4],qr[2],C0,0,0,0),   P1[2],P1[3],P1[4],P1[5],     pw2[0]=PKW(P1,0), pw2[1]=PKW(P1,2), pw2); \
    VRD(6); SBAR(); GAPA(C1=__builtin_amdgcn_mfma_f32_32x32x16_bf16(kf[5],qr[2],C1,0,0,0),   P1[6],P1[7],P1[8],P1[9],     pw2[2]=PKW(P1,4), pw2[3]=PKW(P1,6), pw2); \
    VRD(3); SBAR(); GAPA(C0=__builtin_amdgcn_mfma_f32_32x32x16_bf16(kf[6],qr[3],C0,0,0,0),   P1[10],P1[11],P1[12],P1[13], pw3[0]=PKW(P1,8), pw3[1]=PKW(P1,10), pw3); \
    VRD(7); SBAR(); GAPA(C1=__builtin_amdgcn_mfma_f32_32x32x16_bf16(kf[7],qr[3],C1,0,0,0),   P1[14],P1[15],0.f,0.f,       pw3[2]=PKW(P1,12),pw3[3]=PKW(P1,14), pw3); \
    l_reg+=sacc; \
    if(GK){DMA_K((t)+3,sl_cur);} if(GV){DMA_V((t)+1,sl_next);} \
    CMASK(C0,C1,t); \
    { float a=MX3(C0[0],C0[1],C1[0]),b=MX3(C0[2],C0[3],C1[1]); a=MX3(a,C1[2],C1[3]); \
      _Pragma("unroll") for(int r=4;r<16;r+=4){a=MX3(a,C0[r],C0[r+1]);b=MX3(b,C0[r+2],C0[r+3]);a=MX3(a,C1[r],C1[r+1]);b=MX3(b,C1[r+2],C1[r+3]);} \
      float rm=__builtin_fmaxf(a,b); { auto rr=__builtin_amdgcn_permlane32_swap(__float_as_uint(rm),__float_as_uint(rm),false,false); rm=__builtin_fmaxf(__uint_as_float(rr[0]),__uint_as_float(rr[1])); } \
      resc=false; \
      if(__builtin_expect(__any(rm>(float)THRL),0)){ const float dl=__builtin_fmaxf(rm,0.f); mhat+=dl; \
        _Pragma("unroll") for(int r=0;r<16;++r){C0[r]-=dl;C1[r]-=dl;} \
        _Pragma("unroll") for(int r=0;r<16;++r)negm[r]=-mhat; asm volatile("":"+v"(negm)); \
        const float f=__builtin_amdgcn_exp2f(-dl); l_reg*=f; if(hi==0)wsf[r32]=f; resc=true; } } \
    SBAR(); \
    GAPB(o[0]=__builtin_amdgcn_mfma_f32_32x32x16_bf16(PAF(0),VFR(0),o[0],0,0,0), C0,0); \
    GAPB(o[1]=__builtin_amdgcn_mfma_f32_32x32x16_bf16(PAF(0),VFR(4),o[1],0,0,0), C0,4); \
    KRD(GL,0); GAPB(o[0]=__builtin_amdgcn_mfma_f32_32x32x16_bf16(PAF(1),VFR(1),o[0],0,0,0), C0,8); \
    KRD(GL,1); GAPB(o[1]=__builtin_amdgcn_mfma_f32_32x32x16_bf16(PAF(1),VFR(5),o[1],0,0,0), C0,12); \
    KRD(GL,2); GAPB(o[0]=__builtin_amdgcn_mfma_f32_32x32x16_bf16(PAF(2),VFR(2),o[0],0,0,0), C1,0); \
    KRD(GL,3); GAPB(o[1]=__builtin_amdgcn_mfma_f32_32x32x16_bf16(PAF(2),VFR(6),o[1],0,0,0), C1,4); \
    GAPB(o[0]=__builtin_amdgcn_mfma_f32_32x32x16_bf16(PAF(3),VFR(3),o[0],0,0,0), C1,8); \
    GAPB(o[1]=__builtin_amdgcn_mfma_f32_32x32x16_bf16(PAF(3),VFR(7),o[1],0,0,0), C1,12); \
    }while(0)
  int t=1;
  #undef CMASK
  #define CMASK(P0,P1,t) do{}while(0)
  for(;t+5<NT;t+=2){
    STEP(pB0,pB1,pA0,pA1,t,true,true,true);     WAIT_BAR(2); RESC(); ROT();
    STEP(pA0,pA1,pB0,pB1,t+1,true,true,true);   WAIT_BAR(2); RESC(); ROT();
  }
  #undef CMASK
  #define CMASK(P0,P1,t) do{int jb_=(t)-(NT-4); if(jb_>=0)cmask(P0,P1,jb_,qrel,hi);}while(0)
  #define ENDW(tt) do{ if((tt)+3<NT){WAIT_BAR(2);} else if((tt)+2<NT){WAIT_BAR(1);} else {WAIT_BAR(0);} }while(0)
  for(;t+1<NT;t+=2){
    STEP(pB0,pB1,pA0,pA1,t,(t+3<NT),(t+1<NT),(t+1<NT));       ENDW(t);   RESC(); ROT();
    STEP(pA0,pA1,pB0,pB1,t+1,(t+4<NT),(t+2<NT),(t+2<NT));     ENDW(t+1); RESC(); ROT();
  }
  STEP(pB0,pB1,pA0,pA1,NT-1,false,false,false); RESC();
  { float sacc=pB0[0]+pB0[1]; _Pragma("unroll") for(int r=2;r<16;++r)sacc+=pB0[r]; _Pragma("unroll") for(int r=0;r<16;++r)sacc+=pB1[r]; l_reg+=sacc;
    pw0=(u32x4){PKW(pB0,0),PKW(pB0,2),PKW(pB0,4),PKW(pB0,6)};pw1=(u32x4){PKW(pB0,8),PKW(pB0,10),PKW(pB0,12),PKW(pB0,14)};pw2=(u32x4){PKW(pB1,0),PKW(pB1,2),PKW(pB1,4),PKW(pB1,6)};pw3=(u32x4){PKW(pB1,8),PKW(pB1,10),PKW(pB1,12),PKW(pB1,14)};
    SBAR(); pv(o,vb0+sl_cur,PAF(0),PAF(1),PAF(2),PAF(3)); }
  #undef PKW
  #undef PAF
  #undef VFR
  #undef PIN
  #undef MX3
  #undef GAPA
  #undef GAPB
  #undef EX
  #undef VRD
  #undef KRD
  #undef STEP
  #undef ENDW
  {auto rr=__builtin_amdgcn_permlane32_swap(__float_as_uint(l_reg),__float_as_uint(l_reg),false,false);l_reg=__uint_as_float(rr[0])+__uint_as_float(rr[1]);}
  if(hi==0)wsf[32+r32]=l_reg;asm volatile("s_waitcnt lgkmcnt(0)":::"memory");
  float rli[16];
  #pragma unroll
  for(int r=0;r<16;++r)rli[r]=__builtin_amdgcn_rcpf(wsf[32+crow(r,hi)]);
  bf16*Ow=O+(rowbase+q0+wid*QBLK)*DM+h*D;
  { bf16*stg=(bf16*)(shm+LDS_OST)+wid*2048;
    #pragma unroll
    for(int r=0;r<16;++r){const int orow=crow(r,hi);
      #pragma unroll
      for(int d0=0;d0<2;++d0)stg[orow*64+d0*32+r32]=__float2bfloat16(o[d0][r]*rli[r]);}
    asm volatile("s_waitcnt lgkmcnt(0)":::"memory");
    #pragma unroll
    for(int i=0;i<4;++i){const int row=i*8+(lane>>3),ch=lane&7; const u32x4 v=*(const u32x4*)(stg+row*64+ch*8); ATTN_STORE16(Ow+(long)row*DM+ch*8,v);} }
  asm volatile("s_waitcnt lgkmcnt(0)\n\ts_barrier":::"memory");
  #undef CINIT
  #undef DMA_K
  #undef DMA_V
  #undef CMASK
  #undef START
  #undef RESC
  #undef ROT
}
constexpr int ATTN_LDS_BYTES=LDS_BYTES;
#undef SBAR
#undef WAIT_BAR
}

constexpr int PH_PER_LAYER = 9, N_PHASES = PH_PER_LAYER * DEPTH;

__global__ void __launch_bounds__(NWAVES * 64, 2) fwd(Args args) {
    extern __shared__ __attribute__((aligned(16))) unsigned char lds[];
    Frame F;
    F.lds = (LAS unsigned char*)lds;
    F.tid = threadIdx.x; F.lane = F.tid & 63; F.wave = __builtin_amdgcn_readfirstlane(F.tid >> 6);
    const int wave0 = F.wave;
    for (int u = F.tid; u < (LDS_BYTES - LDSCTL_OFF) / 4; u += NWAVES * 64) ((LAS unsigned*)(F.lds + LDSCTL_OFF))[u] = 0u;
    __syncthreads();
    const int ph_lo = args.ph_lo, ph_hi = args.ph_hi;
    if (ph_hi - ph_lo > 1) (void)xcd_barrier_post((unsigned*)(args.ws + WS_CTL) + CW_BAR, (volatile LAS unsigned*)(F.lds + MISC_OFF) + 8);

    for (int ph = ph_lo; ph < ph_hi; ++ph) {
        const int l = ph / PH_PER_LAYER, p = ph % PH_PER_LAYER;
        const __attribute__((address_space(4))) Args* ap = (const __attribute__((address_space(4))) Args*)__builtin_amdgcn_kernarg_segment_ptr();
        asm volatile("" : "+s"(ap));
        { int t_ = wave0 * 64 + (int)__builtin_amdgcn_mbcnt_hi(~0u, __builtin_amdgcn_mbcnt_lo(~0u, 0u)); asm volatile("" : "+v"(t_)); F.tid = t_; F.lane = t_ & 63; F.wave = __builtin_amdgcn_readfirstlane(t_ >> 6); }
        F.G = gridDim.x; { const int bx = blockIdx.x; F.vcu = (F.G % 8 == 0) ? (bx % 8) * (F.G / 8) + bx / 8 : bx; }
        unsigned char* ws = ap->ws; float* out = ap->out;
        bf16* bufa = (bf16*)(ws + WS_BUFA); bf16* bufb = (bf16*)(ws + WS_BUFB); bf16* xb = (bf16*)(ws + WS_XB); bf16* proj = (bf16*)(ws + WS_PROJ);
        float* smallp = (float*)(ws + WS_SMALLP); float* ssq = (float*)(ws + WS_SSQ);
        const float* xin = (l == 0) ? ap->in[0] : out;
        switch (p) {
        case 0: {
            convert_weights(F, 0, ap->in[2] + (size_t)l * DM * P_IN, ap->in[16] + (size_t)l * DMIX * DM, bufa, bufb, (LAS float*)(F.lds + F.wave * 16384));
            __syncthreads();
            row_pass(F, xin, ap->in[1] + l * DM, xb, ap->in[2] + (size_t)l * DM * P_IN, smallp, (LAS float*)(F.lds));
        } break;
        case 1: {
            pg8::Gemm g{xb, bufa, M, PLD, DM, DM}; pg8::StaticOrder S; S.init(M, PLD, F.G, (int)blockIdx.x);
            pg8::EpiProj E{proj, ap->in[3] + l * 64, ap->in[4] + l * 64, (float*)(ws + WS_KSUM + (size_t)l * 131072)};
            pg8::gemm_phase<pg8::EpiProj>(F.lds + RING_OFF, g, S, E, F.tid);
        } break;
        case 2: {
            for (int pi = F.vcu; pi < 256; pi += F.G) {
                const int bh = pi >> 2, s4 = pi & 3;
                {   const attn_body::bf16* pq = (const attn_body::bf16*)proj; const float* ks = (const float*)(ws + WS_KSUM + (size_t)l * 131072);
                    attn_body::attn_unit<8>(F.tid, bh >> 3, bh & 7, s4, pq + PC_Q, pq + PC_K, pq + PC_V, (attn_body::bf16*)proj + PC_Q, ks, (char*)F.lds);
                    attn_body::attn_unit<8>(F.tid, bh >> 3, bh & 7, 7 - s4, pq + PC_Q, pq + PC_K, pq + PC_V, (attn_body::bf16*)proj + PC_Q, ks, (char*)F.lds); }
                __syncthreads();
                if (pi < 128) ssd_unit(F.tid, proj, smallp, ssq, ap->in[5] + (size_t)l * 4 * 1536, ap->in[6] + l * 1536, ap->in[7] + l * 16, ap->in[8] + l * 16, ap->in[9] + l * 16, pi >> 4, pi & 15, F.lds);
                else if (pi < 160) mlstm_unit(F.tid, proj, smallp, ap->in[11] + (size_t)l * 4 * 1024, ap->in[12] + l * 1024, ap->in[13] + l * 4, ap->in[14] + l * 4, ap->in[15] + l * 512, (pi - 128) >> 2, (pi - 128) & 3, F.lds);
            }
        } break;
        case 3: ssd_finalize(F, proj, ssq, ap->in[10] + l * 1024); break;
        case 4: {
            pg8::Gemm g{proj, bufb, M, DM, DMIX, PLD}; pg8::StaticOrder S; S.init(M, DM, F.G, (int)blockIdx.x);
            pg8::EpiRes E{xin, out, DM};
            pg8::gemm_phase<pg8::EpiRes>(F.lds + RING_OFF, g, S, E, F.tid);
        } break;
        case 5: {
            convert_weights(F, 1, ap->in[18] + (size_t)l * DM * ULD, ap->in[21] + (size_t)l * FFN * DM, bufa, bufb, (LAS float*)(F.lds + F.wave * 16384));
            __syncthreads();
            row_pass(F, out, ap->in[17] + l * DM, xb, nullptr, nullptr, nullptr);
        } break;
        case 6: {
            pg8::Gemm g{xb, bufa, M, ULD, DM, DM}; pg8::StaticOrder S; S.init(M, ULD, F.G, (int)blockIdx.x);
            pg8::EpiBf16 E{proj, ULD};
            pg8::gemm_phase<pg8::EpiBf16>(F.lds + RING_OFF, g, S, E, F.tid);
        } break;
        case 7: ffn_ew(F, proj, ap->in[19] + (size_t)l * 3 * FFN, ap->in[20] + l * FFN); break;
        case 8: {
            pg8::Gemm g{proj + FFN, bufb, M, DM, FFN, ULD}; pg8::StaticOrder S; S.init(M, DM, F.G, (int)blockIdx.x);
            pg8::EpiRes E{out, out, DM};
            pg8::gemm_phase<pg8::EpiRes>(F.lds + RING_OFF, g, S, E, F.tid);
        } break;
        }
        if (ph + 1 < ph_hi) { XcdBarrier bar; bar.bar = (unsigned*)(ap->ws + WS_CTL) + CW_BAR; bar.x = xb_xcc_id(); bar.st = (volatile LAS unsigned*)(F.lds + MISC_OFF) + 8; xcd_barrier(bar, F.tid); }
    }
}

extern "C" void kernel_launch(void* const* d_in, const int* in_sizes, int n_in, void* d_out, int out_size, void* d_ws, size_t ws_size, hipStream_t stream) {
    static int grid = 0;
    if (grid == 0) {
        if (n_in != 22 || in_sizes[0] != M * DM || out_size != M * DM || ws_size < WS_END) { fprintf(stderr, "kernel_launch: unexpected shapes (n_in %d, in0 %d, out %d, ws %zu); nothing launched\n", n_in, n_in > 0 ? in_sizes[0] : -1, out_size, ws_size); grid = -1; return; }
        int dev = 0, cus = 0, per_cu = 0;
        if (hipGetDevice(&dev) != hipSuccess || hipDeviceGetAttribute(&cus, hipDeviceAttributeMultiprocessorCount, dev) != hipSuccess) { grid = -1; return; }
        if (hipFuncSetAttribute((const void*)fwd, hipFuncAttributeMaxDynamicSharedMemorySize, LDS_BYTES) != hipSuccess) { fprintf(stderr, "kernel_launch: hipFuncSetAttribute failed\n"); grid = -1; return; }
        if (hipOccupancyMaxActiveBlocksPerMultiprocessor(&per_cu, (const void*)fwd, NWAVES * 64, LDS_BYTES) != hipSuccess || per_cu < 1) { fprintf(stderr, "kernel_launch: occupancy query reports %d blocks per CU\n", per_cu); per_cu = 1; }
        (void)hipGetLastError();
        grid = cus;
    }
    if (grid < 0) return;
    (void)hipMemsetAsync((char*)d_ws + WS_CTL, 0, CTL_ZERO_BYTES, stream);
    Args a{};
    for (int i = 0; i < 22; ++i) a.in[i] = (const float*)d_in[i];
    a.out = (float*)d_out; a.ws = (unsigned char*)d_ws;
#if MK_MULTI
    for (int ph = 0; ph < N_PHASES; ++ph) {
        a.ph_lo = ph; a.ph_hi = ph + 1;
        hipLaunchKernelGGL(fwd, dim3(grid), dim3(NWAVES * 64), LDS_BYTES, stream, a);
    }
#else
    a.ph_lo = 0; a.ph_hi = N_PHASES;
    hipLaunchKernelGGL(fwd, dim3(grid), dim3(NWAVES * 64), LDS_BYTES, stream, a);
#endif
}
```

```cpp
#include <hip/hip_runtime.h>
#include <hip/hip_bf16.h>
#include <cstdio>
#include <cstdint>
#include <cmath>

#ifndef MK_MULTI
#define MK_MULTI 0
#endif

constexpr int BATCH = 8, SEQ = 2048, DM = 1024, DEPTH = 2;
constexpr int M = BATCH * SEQ;
constexpr int P_IN = 6168;
constexpr int PLD = 6144;
constexpr int PC_Q = 0, PC_Z = 512, PC_MO = 1536, PC_K = 2048, PC_V = 2560, PC_XBC = 3072, PC_MQK = 4608, PC_MV = 5632;
constexpr int SC_Q = 0, SC_K = 512, SC_V = 1024, SC_Z = 1536, SC_XBC = 2560, SC_DT = 4096, SC_MQK = 4112, SC_MV = 5136, SC_MO = 5648, SC_MI = 6160, SC_MF = 6164;
constexpr int FFN = 2816, ULD = 5632;
constexpr int DMIX = 2048;
constexpr float EPS = 1e-6f;
constexpr float C2 = 0.125f * 1.4426950408889634f;

constexpr size_t MiB = 1u << 20;
constexpr size_t WS_CTL = 0, CTL_ZERO_BYTES = 1 * MiB;
constexpr size_t WS_KSUM = 256 * 1024;
constexpr size_t WS_QUEUE = 768 * 1024;
constexpr size_t WS_SMALLP = 1 * MiB;
constexpr size_t WS_SSQ = 3 * MiB - 512 * 1024;
constexpr size_t WS_BUFA = 4 * MiB;
constexpr size_t WS_BUFB = 16 * MiB;
constexpr size_t WS_XB = 22 * MiB;
constexpr size_t WS_HALO = 54 * MiB;
constexpr size_t WS_PROJ = 64 * MiB;
constexpr size_t WS_END = 256 * MiB;

namespace pg8 {
#define PG8_LAS __attribute__((address_space(3)))
typedef unsigned short bf16_t;
typedef short bf16x8 __attribute__((ext_vector_type(8)));
typedef float f32x4 __attribute__((ext_vector_type(4)));
typedef unsigned u32x4 __attribute__((ext_vector_type(4)));
constexpr int BM = 256, BK = 64, HALF = 128, HTB = HALF * BK * 2, STAGE_BYTES = 8 * HTB, NXCD = 8, WGM = 8;

__host__ __device__ __forceinline__ int lds_byte(int r, int c) { const int st = (r >> 4) * 2 + (c >> 5), rr = r & 15, cc = c & 31, ob = rr * 64 + cc * 2; return st * 1024 + (ob ^ (((ob >> 9) & 1) << 5)); }
__host__ __device__ __forceinline__ void stage_rc(int b, int& R, int& C) { const int st = b / 1024, sb = b % 1024, swz = sb ^ (((sb >> 9) & 1) << 5); R = (st >> 1) * 16 + swz / 64; C = (st & 1) * 32 + (swz % 64) / 2; }
__host__ __device__ __forceinline__ int perm32(int rho) { const int n = rho >> 4, i = rho & 15; return 8 * (i >> 2) + 4 * n + (i & 3); }

struct Unit { int pm, pn; };
struct Gemm { const bf16_t* A; const bf16_t* Bt; int M, N, K, lda; };

struct StaticOrder {
    int nM, nN, nwg, G, c;
    __host__ __device__ void init(int M_, int N_, int G_, int c_) { nM = M_ / BM; nN = N_ / BM; nwg = nM * nN; G = G_; c = c_; }
    __host__ __device__ bool next(int i, Unit& u) const {
        const long L = (long)i * G + c; if (L >= nwg) return false;
        int wgid = (int)L; { const int q = nwg / NXCD, r = nwg % NXCD, xcd = wgid % NXCD, off = wgid / NXCD; wgid = (xcd < r ? xcd * (q + 1) : r * (q + 1) + (xcd - r) * q) + off; }
        const int nig = WGM * nN, gid = wgid / nig, fm = gid * WGM, gsz = (nM - fm) < WGM ? (nM - fm) : WGM;
        u.pm = fm + ((wgid % nig) % gsz); u.pn = (wgid % nig) / gsz; return true;
    }
};

__device__ __forceinline__ unsigned cvt_pk_bf16(float lo, float hi) { unsigned r; asm volatile("v_cvt_pk_bf16_f32 %0, %1, %2" : "=v"(r) : "v"(lo), "v"(hi)); return r; }

struct EpiBf16 {
    static constexpr bool PERM = true;
    bf16_t* O; int ldc;
    __device__ __forceinline__ void operator()(const f32x4 (&acc)[2][2][4][2], const Unit& u, int wr, int wc, int fr, int fq) const {
        const int row0 = u.pm * BM + wr * 64 + fr; const int col0 = u.pn * BM + wc * 32 + 8 * fq;
#pragma unroll
        for (int ai = 0; ai < 2; ++ai)
#pragma unroll
            for (int m = 0; m < 4; ++m) { bf16_t* rowp = O + (size_t)(row0 + ai * HALF + m * 16) * ldc + col0;
#pragma unroll
                for (int bj = 0; bj < 2; ++bj) { const f32x4 v0 = acc[ai][bj][m][0], v1 = acc[ai][bj][m][1];
                    u32x4 w; w.x = cvt_pk_bf16(v0[0], v0[1]); w.y = cvt_pk_bf16(v0[2], v0[3]); w.z = cvt_pk_bf16(v1[0], v1[1]); w.w = cvt_pk_bf16(v1[2], v1[3]);
                    *(u32x4*)(rowp + bj * HALF) = w; } }
    }
};
struct EpiProj {
    static constexpr bool PERM = true;
    bf16_t* P; const float* qw; const float* kw; float* ksum; bf16_t* halo;
    __device__ __forceinline__ void operator()(const f32x4 (&acc)[2][2][4][2], const Unit& u, int wr, int wc, int fr, int fq) const {
        const int pn = u.pn; const bool isq = pn < 2, isk = (pn == 8 || pn == 9);
        const int row0 = u.pm * BM + wr * 64 + fr;
        if (!(isq || isk)) {
            const int col0 = pn * BM + wc * 32 + 8 * fq;
#pragma unroll
            for (int ai = 0; ai < 2; ++ai)
#pragma unroll
                for (int m = 0; m < 4; ++m) { bf16_t* rowp = P + (size_t)(row0 + ai * HALF + m * 16) * PLD + col0;
#pragma unroll
                    for (int bj = 0; bj < 2; ++bj) { const f32x4 v0 = acc[ai][bj][m][0], v1 = acc[ai][bj][m][1];
                        u32x4 w; w.x = cvt_pk_bf16(v0[0], v0[1]); w.y = cvt_pk_bf16(v0[2], v0[3]); w.z = cvt_pk_bf16(v1[0], v1[1]); w.w = cvt_pk_bf16(v1[2], v1[3]);
                        *(u32x4*)(rowp + bj * HALF) = w;
                        if (m == 3 && fr >= 13 && pn >= 12 && pn < 22) *(u32x4*)(halo + ((size_t)(((row0 + ai * HALF) >> 6) * 3 + fr - 13) * 2560 + (col0 + bj * HALF - PC_XBC))) = w; } }
        } else {
            const float* w = isq ? qw : kw; const float post = isq ? C2 : 1.0f;
            const int colb = pn * BM + 64 * wc + 8 * fq;
            f32x4 cs[2][2];
#pragma unroll
            for (int bj = 0; bj < 2; ++bj)
#pragma unroll
                for (int n = 0; n < 2; ++n) cs[bj][n] = (f32x4){0.f, 0.f, 0.f, 0.f};
#pragma unroll
            for (int ai = 0; ai < 2; ++ai)
#pragma unroll
                for (int m = 0; m < 4; ++m) {
                    float ss = 0.f;
#pragma unroll
                    for (int bj = 0; bj < 2; ++bj)
#pragma unroll
                        for (int n = 0; n < 2; ++n) { const f32x4 x = acc[ai][bj][m][n]; ss += (x[0] * x[0] + x[1] * x[1]) + (x[2] * x[2] + x[3] * x[3]); }
                    ss += __shfl_xor(ss, 16); ss += __shfl_xor(ss, 32);
                    const float r = (1.0f / sqrtf(ss * (1.0f / 64.0f) + EPS)) * post;
                    bf16_t* rowp = P + (size_t)(row0 + ai * HALF + m * 16) * PLD + colb;
#pragma unroll
                    for (int bj = 0; bj < 2; ++bj) { const f32x4 w0 = *(const f32x4*)(w + 32 * bj + 8 * fq), w1 = *(const f32x4*)(w + 32 * bj + 8 * fq + 4);
                        const f32x4 v0 = acc[ai][bj][m][0] * r * w0, v1 = acc[ai][bj][m][1] * r * w1;
                        cs[bj][0] += v0; cs[bj][1] += v1;
                        u32x4 o; o.x = cvt_pk_bf16(v0[0], v0[1]); o.y = cvt_pk_bf16(v0[2], v0[3]); o.z = cvt_pk_bf16(v1[0], v1[1]); o.w = cvt_pk_bf16(v1[2], v1[3]);
                        *(u32x4*)(rowp + 32 * bj) = o; }
                    asm volatile("" ::: "memory");
                }
            if (isk) {
                float* kd = ksum + ((size_t)(u.pm * 8 + (pn - 8) * 4 + wc) * 64) + 8 * fq;
#pragma unroll
                for (int bj = 0; bj < 2; ++bj)
#pragma unroll
                    for (int n = 0; n < 2; ++n)
#pragma unroll
                        for (int i = 0; i < 4; ++i) { float x = cs[bj][n][i]; x += __shfl_xor(x, 1); x += __shfl_xor(x, 2); x += __shfl_xor(x, 4); x += __shfl_xor(x, 8);
                            if (fr == 0) atomicAdd(kd + 32 * bj + 4 * n + i, x); }
            }
        }
    }
};
struct EpiRes {
    static constexpr bool PERM = false;
    const float* base; float* out; int ldc;
    __device__ __forceinline__ void operator()(const f32x4 (&acc)[2][2][4][2], const Unit& u, int wr, int wc, int fr, int fq) const {
        const int row0 = u.pm * BM + wr * 64 + fr, col0 = u.pn * BM + wc * 32 + 4 * fq;
#pragma unroll
        for (int ai = 0; ai < 2; ++ai)
#pragma unroll
            for (int m = 0; m < 4; ++m) { const size_t off = (size_t)(row0 + ai * HALF + m * 16) * ldc + col0;
#pragma unroll
                for (int bj = 0; bj < 2; ++bj)
#pragma unroll
                    for (int n = 0; n < 2; ++n) { const f32x4 b = *(const f32x4*)(base + off + bj * HALF + n * 16); *(f32x4*)(out + off + bj * HALF + n * 16) = b + acc[ai][bj][m][n]; } }
    }
};

template <class Epi>
__device__ __forceinline__ void gemm_phase(PG8_LAS unsigned char* lds, const Gemm g, const StaticOrder& S, const Epi& E, int tid_) {
    asm volatile("" : "+v"(tid_));
    const int tid = tid_, wid = __builtin_amdgcn_readfirstlane(tid >> 6), lane = tid & 63, wr = wid >> 2, wc = wid & 3, fr = lane & 15, fq = lane >> 4;
    const int K = g.K, nt = K / BK, lda = g.lda;
    unsigned voffA[2], voffB[2];
#pragma unroll
    for (int i = 0; i < 2; ++i) { int R, C; stage_rc(tid * 16 + i * 8192, R, C); const int Rb = Epi::PERM ? ((R & ~31) + perm32(R & 31)) : R;
        voffA[i] = (unsigned)(R * lda + C) * 2u; voffB[i] = (unsigned)(Rb * K + C) * 2u; }
    const size_t kstep = (size_t)(BK * 2);
    const size_t hstepA = (size_t)HALF * lda * 2, hstepB = (size_t)HALF * K * 2;
    const size_t tstepA = 2 * hstepA, tstepB = 2 * hstepB;
    const unsigned ldsw = (unsigned)wid * 1024u;
    const int aoff = lds_byte(wr * 64 + fr, fq * 8), boff = lds_byte(wc * 32 + fr, fq * 8);
#define PG8_SA(b, h) (((b) * 2 + (h)) * HTB)
#define PG8_SB(b, h) ((4 + (b) * 2 + (h)) * HTB)
#define PG8_STAGE(bufoff, gbase, voff) do { _Pragma("unroll") for (int _i = 0; _i < 2; ++_i) \
        __builtin_amdgcn_global_load_lds((const unsigned*)((const char*)(gbase) + (voff)[_i]), (PG8_LAS unsigned*)(lds + (bufoff) + ldsw + _i * 8192), 16, 0, 0); } while (0)
#define PG8_LDA(dst, b, h) do { _Pragma("unroll") for (int m = 0; m < 4; ++m) _Pragma("unroll") for (int k = 0; k < 2; ++k) dst[m][k] = *(const PG8_LAS bf16x8*)(lds + PG8_SA(b, h) + aoff + m * 2048 + k * 1024); } while (0)
#define PG8_LDB(dst, b, h) do { _Pragma("unroll") for (int n = 0; n < 2; ++n) _Pragma("unroll") for (int k = 0; k < 2; ++k) dst[n][k] = *(const PG8_LAS bf16x8*)(lds + PG8_SB(b, h) + boff + n * 2048 + k * 1024); } while (0)
#define PG8_MMA(ai, bj, At, Bt) do { __builtin_amdgcn_s_setprio(1); _Pragma("unroll") for (int m = 0; m < 4; ++m) _Pragma("unroll") for (int n = 0; n < 2; ++n) _Pragma("unroll") for (int k = 0; k < 2; ++k) \
        acc[ai][bj][m][n] = __builtin_amdgcn_mfma_f32_16x16x32_bf16(Bt[n][k], At[m][k], acc[ai][bj][m][n], 0, 0, 0); __builtin_amdgcn_s_setprio(0); } while (0)
#define PG8_WAIT_V(n) asm volatile("s_waitcnt vmcnt(" #n ")" ::: "memory")
#define PG8_WAIT_L(n) asm volatile("s_waitcnt lgkmcnt(" #n ")" ::: "memory")
#define PG8_BAR __builtin_amdgcn_s_barrier()
#define PG8_SCHED __builtin_amdgcn_sched_barrier(0)
    Unit cur, nxt; int ui = 0;
    if (!S.next(0, cur)) return;
    f32x4 acc[2][2][4][2];
#pragma unroll
    for (int a = 0; a < 2; ++a)
#pragma unroll
        for (int b = 0; b < 2; ++b)
#pragma unroll
            for (int m = 0; m < 4; ++m)
#pragma unroll
                for (int n = 0; n < 2; ++n) acc[a][b][m][n] = (f32x4){0.f, 0.f, 0.f, 0.f};
    bf16x8 At[4][2], B0[2][2], B1[2][2];
    const char* cA = (const char*)g.A + (size_t)cur.pm * tstepA; const char* cB = (const char*)g.Bt + (size_t)cur.pn * tstepB;
    PG8_STAGE(PG8_SB(0, 0), cB, voffB); PG8_STAGE(PG8_SB(0, 1), cB + hstepB, voffB); PG8_STAGE(PG8_SA(0, 0), cA, voffA); PG8_STAGE(PG8_SA(0, 1), cA + hstepA, voffA);
    if (wr == 1) PG8_BAR;
    PG8_WAIT_V(2); PG8_BAR;
    PG8_STAGE(PG8_SB(1, 0), cB + kstep, voffB); PG8_STAGE(PG8_SA(1, 0), cA + kstep, voffA); PG8_STAGE(PG8_SB(1, 1), cB + hstepB + kstep, voffB);
    PG8_WAIT_V(6); PG8_BAR;
    for (;;) {
        const bool has_next = S.next(ui + 1, nxt);
        const char* nA = has_next ? (const char*)g.A + (size_t)nxt.pm * tstepA : cA; const char* nB = has_next ? (const char*)g.Bt + (size_t)nxt.pn * tstepB : cB;
        for (int t = 0; t < nt; t += 2) {
            const bool last = (t == nt - 2);
            const char* a1 = cA + (size_t)(t + 1) * kstep;
            const char* a2 = last ? nA : cA + (size_t)(t + 2) * kstep; const char* b2 = last ? nB : cB + (size_t)(t + 2) * kstep;
            const char* a3 = a2 + kstep; const char* b3 = b2 + kstep;
            PG8_LDB(B0, 0, 0); PG8_LDB(B1, 0, 1); PG8_SCHED; PG8_LDA(At, 0, 0); PG8_STAGE(PG8_SA(1, 1), a1 + hstepA, voffA);
            PG8_WAIT_V(8); PG8_WAIT_L(0); PG8_BAR; PG8_MMA(0, 0, At, B0); PG8_MMA(0, 1, At, B1); PG8_BAR; PG8_SCHED;
            PG8_LDA(At, 0, 1); PG8_STAGE(PG8_SB(0, 0), b2, voffB); PG8_STAGE(PG8_SB(0, 1), b2 + hstepB, voffB); PG8_STAGE(PG8_SA(0, 0), a2, voffA);
            PG8_WAIT_V(8); PG8_WAIT_L(0); PG8_BAR; PG8_MMA(1, 0, At, B0); PG8_MMA(1, 1, At, B1); PG8_BAR; PG8_SCHED;
            PG8_LDB(B0, 1, 0); PG8_LDB(B1, 1, 1); PG8_SCHED; PG8_LDA(At, 1, 0); PG8_STAGE(PG8_SA(0, 1), a2 + hstepA, voffA);
            PG8_WAIT_V(8); PG8_WAIT_L(0); PG8_BAR; PG8_MMA(0, 0, At, B0); PG8_MMA(0, 1, At, B1); PG8_BAR; PG8_SCHED;
            PG8_LDA(At, 1, 1); PG8_STAGE(PG8_SB(1, 0), b3, voffB); PG8_STAGE(PG8_SB(1, 1), b3 + hstepB, voffB); PG8_STAGE(PG8_SA(1, 0), a3, voffA);
            PG8_WAIT_V(8); PG8_WAIT_L(0); PG8_BAR; PG8_MMA(1, 0, At, B0); PG8_MMA(1, 1, At, B1); PG8_BAR; PG8_SCHED;
        }
        if (wr == 0) PG8_BAR;
        E(acc, cur, wr, wc, fr, fq);
        if (!has_next) break;
#pragma unroll
        for (int a = 0; a < 2; ++a)
#pragma unroll
            for (int b = 0; b < 2; ++b)
#pragma unroll
                for (int m = 0; m < 4; ++m)
#pragma unroll
                    for (int n = 0; n < 2; ++n) acc[a][b][m][n] = (f32x4){0.f, 0.f, 0.f, 0.f};
        cur = nxt; cA = nA; cB = nB; ++ui;
        if (wr == 1) PG8_BAR;
    }
    PG8_WAIT_V(0);
    PG8_BAR;
#undef PG8_SA
#undef PG8_SB
#undef PG8_STAGE
#undef PG8_LDA
#undef PG8_LDB
#undef PG8_MMA
#undef PG8_WAIT_V
#undef PG8_WAIT_L
#undef PG8_BAR
#undef PG8_SCHED
}
}

constexpr int NWAVES = 8;
constexpr int RING_OFF = 0, RING_BYTES = 131072;
constexpr int LDS_BYTES = 147456;
constexpr int LDSCTL_OFF = LDS_BYTES - 512, MISC_OFF = LDSCTL_OFF + 320;
constexpr int CW_BAR = 4096;

#define GAS __attribute__((address_space(1)))
#define LAS __attribute__((address_space(3)))
typedef unsigned short bf16;
typedef unsigned v4u __attribute__((ext_vector_type(4)));
typedef float f32x4 __attribute__((ext_vector_type(4)));
typedef GAS unsigned gu32;
#define RLX_AGENT __ATOMIC_RELAXED, __HIP_MEMORY_SCOPE_AGENT
#define LDS_WAIT() asm volatile("s_waitcnt lgkmcnt(0)" ::: "memory")
#define VM_WAIT() asm volatile("s_waitcnt vmcnt(0)" ::: "memory")
__device__ __forceinline__ unsigned f2bf(float f) { unsigned u = __builtin_bit_cast(unsigned, f); return (u + 0x7fffu + ((u >> 16) & 1u)) >> 16; }
__device__ __forceinline__ unsigned pk2(float lo, float hi) { return f2bf(lo) | (f2bf(hi) << 16); }
__device__ __forceinline__ float bf2f(unsigned short b) { return __uint_as_float(((unsigned)b) << 16); }

#define XB_TMO      128
#define XB_XCNT(j)  (256  + 64 * (j))
#define XB_XSUB(j)  (1280 + 64 * (j))
#define XB_XGEN(j)  (2304 + 64 * (j))
#define XB_TOP      3328
#define XB_TOPGEN   3392
#define XCD_BAR_WORDS 3456
#define XB_SPIN_CAP (1u << 18)
__device__ __forceinline__ unsigned xb_ld(unsigned* p)              { return __hip_atomic_load(p, __ATOMIC_RELAXED, __HIP_MEMORY_SCOPE_AGENT); }
__device__ __forceinline__ unsigned xb_add(unsigned* p, unsigned v) { return __hip_atomic_fetch_add(p, v, __ATOMIC_RELAXED, __HIP_MEMORY_SCOPE_AGENT); }
__device__ __forceinline__ unsigned xb_xcc_id() { return (unsigned)__builtin_amdgcn_s_getreg((3 << 11) | 20) & 0xFu; }
#define XB_SPIN(cond, bar) do { unsigned _sp = 0; while (cond) { __builtin_amdgcn_s_sleep(1); \
    if ((++_sp & 255u) == 0u) { if (xb_ld(&(bar)[XB_TMO])) break; if (_sp > XB_SPIN_CAP) { atomicAdd(&(bar)[XB_TMO], 1u); break; } } } } while (0)
struct XcdBarrier { unsigned* bar; unsigned x; volatile LAS unsigned* st; };
__device__ __forceinline__ XcdBarrier xcd_barrier_post(unsigned* bar, volatile LAS unsigned* st) {
    XcdBarrier b; b.bar = bar; b.x = xb_xcc_id(); b.st = st;
    if (threadIdx.x == 0) (void)xb_add(&bar[XB_XCNT(b.x)], 1u);
    return b;
}
__device__ __forceinline__ void xcd_barrier_complete(unsigned* bar, unsigned x, unsigned& nloc, unsigned& nx) {
    const unsigned G = gridDim.x * gridDim.y * gridDim.z;
    unsigned sum, cnt, mine, sp = 0u;
    for (;;) {
        sum = 0u; cnt = 0u; mine = 0u;
#pragma unroll
        for (unsigned j = 0; j < 16; ++j) { const unsigned c = xb_ld(&bar[XB_XCNT(j)]); sum += c; cnt += (c > 0u) ? 1u : 0u; mine = (j == x) ? c : mine; }
        if (sum == G) break;
        __builtin_amdgcn_s_sleep(1);
        if ((++sp & 255u) == 0u) { if (xb_ld(&bar[XB_TMO])) break; if (sp > XB_SPIN_CAP) { atomicAdd(&bar[XB_TMO], 1u); break; } }
    }
    nloc = mine > 0u ? mine : 1u; nx = cnt > 0u ? cnt : 1u;
}
__device__ __forceinline__ void xcd_barrier(const XcdBarrier& b, int tid) {
    asm volatile("s_waitcnt vmcnt(0)" ::: "memory");
    __syncthreads();
    if (tid == 0) {
        unsigned* bar = b.bar;
        __builtin_amdgcn_s_waitcnt(0);
        unsigned nloc = b.st[0], nx = b.st[1];
        if (nloc == 0u) { xcd_barrier_complete(bar, b.x, nloc, nx); b.st[0] = nloc; b.st[1] = nx; }
        const unsigned old = xb_add(&bar[XB_XSUB(b.x)], 1u);
        const unsigned gen = old / nloc;
        if (old + 1u == (gen + 1u) * nloc) {
            __builtin_amdgcn_fence(__ATOMIC_RELEASE, "agent");
            asm volatile("s_waitcnt vmcnt(0)" ::: "memory");
            const unsigned og = xb_add(&bar[XB_TOP], 1u);
            const unsigned tg = og / nx;
            if (og + 1u == (tg + 1u) * nx) xb_add(&bar[XB_TOPGEN], 1u);
            else XB_SPIN(xb_ld(&bar[XB_TOPGEN]) == tg, bar);
            __builtin_amdgcn_fence(__ATOMIC_ACQUIRE, "agent");
            xb_add(&bar[XB_XGEN(b.x)], 1u);
            asm volatile("s_waitcnt vmcnt(0)" ::: "memory");
        } else {
            XB_SPIN(xb_ld(&bar[XB_XGEN(b.x)]) == gen, bar);
            __builtin_amdgcn_fence(__ATOMIC_ACQUIRE, "agent");
            asm volatile("s_waitcnt vmcnt(0)" ::: "memory");
        }
    }
    __syncthreads();
}

struct Args { const float* in[22]; float* out; unsigned char* ws; int ph_lo, ph_hi; };

struct Frame {
    LAS unsigned char* lds;
    int tid, lane, wave;
    int vcu, G;
};

__device__ __forceinline__ float wave_sum(float v) {
#pragma unroll
    for (int o = 1; o < 64; o <<= 1) v += __shfl_xor(v, o);
    return v;
}

__device__ __forceinline__ void conv_item(const float* W, int ldw, int srccol0, bf16* WT, int K, int dstrow0, int k0, LAS float* scr, int lane) {
#pragma unroll 8
    for (int i = 0; i < 32; ++i) { const int kk = 2 * i + (lane >> 5); scr[kk * 33 + (lane & 31)] = W[(size_t)(k0 + kk) * ldw + srccol0 + (lane & 31)]; }
    LDS_WAIT(); asm volatile("" ::: "memory");
    const int c = lane & 7;
#pragma unroll
    for (int j = 0; j < 4; ++j) { const int n = (lane >> 3) + 8 * j; const LAS float* s = scr + (8 * c) * 33 + n;
        v4u o; o.x = pk2(s[0 * 33], s[1 * 33]); o.y = pk2(s[2 * 33], s[3 * 33]); o.z = pk2(s[4 * 33], s[5 * 33]); o.w = pk2(s[6 * 33], s[7 * 33]);
        *(GAS v4u*)(WT + (size_t)(dstrow0 + n) * K + k0 + 8 * c) = o; }
    LDS_WAIT(); asm volatile("" ::: "memory");
}
__device__ __forceinline__ int in_src_col(int n0) {
    const int tile = n0 >> 8, p = n0 & 255; int dest;
    if (tile < 2 || tile == 8 || tile == 9) { const int bj = p >> 7, wc = (p >> 5) & 3; dest = (tile << 8) + 64 * wc + 32 * bj; } else dest = n0;
    if (dest < PC_Z) return SC_Q + dest;
    if (dest < PC_MO) return SC_Z + dest - PC_Z;
    if (dest < PC_K) return SC_MO + dest - PC_MO;
    if (dest < PC_V) return SC_K + dest - PC_K;
    if (dest < PC_XBC) return SC_V + dest - PC_V;
    if (dest < PC_MQK) return SC_XBC + dest - PC_XBC;
    if (dest < PC_MV) return SC_MQK + dest - PC_MQK;
    return SC_MV + dest - PC_MV;
}
__device__ __forceinline__ void convert_weights(Frame& F, int which, const float* Wa, const float* Wb, bf16* bufa, bf16* bufb, LAS float* scr) {
    const int gw = F.vcu * NWAVES + F.wave, NGW = F.G * NWAVES;
    if (which == 0) {
        constexpr int IA = (DM / 64) * (PLD / 32), IB = (DMIX / 64) * (DM / 32);
        for (int it = gw; it < IA + IB; it += NGW) {
            if (it < IA) { const int nblk = PLD / 32, kb = it / nblk, nb = it % nblk; conv_item(Wa, P_IN, in_src_col(32 * nb), bufa, DM, 32 * nb, 64 * kb, scr, F.lane); }
            else { const int r = it - IA, nblk = DM / 32, kb = r / nblk, nb = r % nblk; conv_item(Wb, DM, 32 * nb, bufb, DMIX, 32 * nb, 64 * kb, scr, F.lane); }
        }
    } else {
        constexpr int IA = (DM / 64) * (ULD / 32), IB = (FFN / 64) * (DM / 32);
        for (int it = gw; it < IA + IB; it += NGW) {
            if (it < IA) { const int nblk = ULD / 32, kb = it / nblk, nb = it % nblk; conv_item(Wa, ULD, 32 * nb, bufa, DM, 32 * nb, 64 * kb, scr, F.lane); }
            else { const int r = it - IA, nblk = DM / 32, kb = r / nblk, nb = r % nblk; conv_item(Wb, DM, 32 * nb, bufb, FFN, 32 * nb, 64 * kb, scr, F.lane); }
        }
    }
}
__device__ __forceinline__ void row_pass(Frame& F, const float* x, const float* nw, bf16* xb, const float* w_in  , float* smallp, LAS float* wsm  ) {
    if (w_in) {
        for (int k = F.tid; k < DM; k += NWAVES * 64) {
            const float* src = w_in + (size_t)k * P_IN;
#pragma unroll
            for (int c = 0; c < 16; ++c) wsm[c * DM + k] = src[SC_DT + c];
#pragma unroll
            for (int c = 0; c < 8; ++c) wsm[(16 + c) * DM + k] = src[SC_MI + c];
        }
        LDS_WAIT(); __syncthreads();
    }
    const int gw = F.vcu * NWAVES + F.wave, NGW = F.G * NWAVES;
    f32x4 wv[4];
#pragma unroll
    for (int j = 0; j < 4; ++j) wv[j] = ((const GAS f32x4*)nw)[64 * j + F.lane];
    for (int m = gw; m < M; m += NGW) {
        const GAS f32x4* xr = (const GAS f32x4*)(x + (size_t)m * DM) + F.lane;
        f32x4 v[4]; float s = 0.f;
#pragma unroll
        for (int j = 0; j < 4; ++j) { v[j] = xr[64 * j]; s += (v[j].x * v[j].x + v[j].y * v[j].y) + (v[j].z * v[j].z + v[j].w * v[j].w); }
        const float r = 1.0f / sqrtf(wave_sum(s) * (1.0f / DM) + EPS);
#pragma unroll
        for (int j = 0; j < 4; ++j) v[j] = v[j] * r * wv[j];
        GAS unsigned long long* o8 = (GAS unsigned long long*)(xb + (size_t)m * DM) + F.lane;
#pragma unroll
        for (int j = 0; j < 4; ++j) o8[64 * j] = (unsigned long long)pk2(v[j].x, v[j].y) | ((unsigned long long)pk2(v[j].z, v[j].w) << 32);
        if (w_in) {
            float mine = 0.f;
            for (int c = 0; c < 24; ++c) {
                float d = 0.f;
#pragma unroll
                for (int j = 0; j < 4; ++j) { const f32x4 w4 = *(const LAS f32x4*)(wsm + c * DM + 4 * (64 * j + F.lane)); d += (v[j].x * w4.x + v[j].y * w4.y) + (v[j].z * w4.z + v[j].w * w4.w); }
                d = wave_sum(d);
                if (F.lane == c) mine = d;
            }
            if (F.lane < 24) smallp[(size_t)m * 24 + F.lane] = mine;
        }
    }
}
__device__ __forceinline__ void ssd_finalize(Frame& F, bf16* proj, const float* ssq, const float* nw) {
    const int gt = F.vcu * (NWAVES * 64) + F.tid, NT = F.G * NWAVES * 64;
    for (int it = gt; it < M * 128; it += NT) {
        const int row = it >> 7, c0 = (it & 127) * 8, g = c0 >> 9;
        float s = 0.f;
#pragma unroll
        for (int h = 0; h < 8; ++h) s += ssq[(size_t)row * 16 + g * 8 + h];
        const float r = 1.0f / sqrtf(s * (1.0f / 512.0f) + EPS);
        v4u* p = (v4u*)(proj + (size_t)row * PLD + PC_Z + c0);
        v4u v = *p; const f32x4 w0 = *(const f32x4*)(nw + c0), w1 = *(const f32x4*)(nw + c0 + 4);
        v4u o;
        o.x = pk2(bf2f(v.x & 0xffff) * r * w0.x, bf2f(v.x >> 16) * r * w0.y); o.y = pk2(bf2f(v.y & 0xffff) * r * w0.z, bf2f(v.y >> 16) * r * w0.w);
        o.z = pk2(bf2f(v.z & 0xffff) * r * w1.x, bf2f(v.z >> 16) * r * w1.y); o.w = pk2(bf2f(v.w & 0xffff) * r * w1.z, bf2f(v.w >> 16) * r * w1.w);
        *p = o;
    }
}
__device__ __forceinline__ void ffn_ew(Frame& F, bf16* u, const float* cw  , const float* cb) {
    const int gt = F.vcu * (NWAVES * 64) + F.tid, NT = F.G * NWAVES * 64;
    constexpr int CPR = FFN / 8;
    for (int it = gt; it < M * CPR; it += NT) {
        const int row = it / CPR, c0 = (it % CPR) * 8, t = row & (SEQ - 1);
        const bf16* g0 = u + (size_t)row * ULD + c0;
        v4u a2 = *(const v4u*)g0, a1 = (v4u){0, 0, 0, 0}, a0 = (v4u){0, 0, 0, 0};
        if (t >= 1) a1 = *(const v4u*)(g0 - ULD);
        if (t >= 2) a0 = *(const v4u*)(g0 - 2 * ULD);
        const v4u vv = *(const v4u*)(g0 + FFN);
        float o[8];
#pragma unroll
        for (int i = 0; i < 8; ++i) {
            const unsigned w2 = a2[i >> 1], w1 = a1[i >> 1], w0 = a0[i >> 1], wv = vv[i >> 1];
            const float x2 = (i & 1) ? bf2f(w2 >> 16) : bf2f(w2 & 0xffff), x1 = (i & 1) ? bf2f(w1 >> 16) : bf2f(w1 & 0xffff), x0 = (i & 1) ? bf2f(w0 >> 16) : bf2f(w0 & 0xffff);
            const float val = (i & 1) ? bf2f(wv >> 16) : bf2f(wv & 0xffff);
            const float gt_ = cw[c0 + i] * x0 + cw[FFN + c0 + i] * x1 + cw[2 * FFN + c0 + i] * x2 + cb[c0 + i];
            o[i] = 0.5f * gt_ * (1.0f + erff(gt_ * 0.70710678118654752f)) * val;
        }
        v4u ov; ov.x = pk2(o[0], o[1]); ov.y = pk2(o[2], o[3]); ov.z = pk2(o[4], o[5]); ov.w = pk2(o[6], o[7]);
        *(v4u*)(u + (size_t)row * ULD + FFN + c0) = ov;
    }
}

__device__ __forceinline__ float silu_f(float x) { return x / (1.0f + __expf(-x)); }

typedef short bf16x8v __attribute__((ext_vector_type(8)));
typedef float f32x16 __attribute__((ext_vector_type(16)));
typedef short v4i16_t __attribute__((ext_vector_type(4)));
__device__ __forceinline__ bf16x8v frag_row(LAS const unsigned char* base, int pitch, int row, int kel) { return *(const LAS bf16x8v*)(base + row * pitch + kel * 2); }
__device__ __forceinline__ bf16x8v frag_tr(LAS const unsigned char* base, int pitch, int krow, int col) {
    LAS const unsigned char* p = base + krow * pitch + col * 2;
    const v4i16_t lo = __builtin_amdgcn_ds_read_tr16_b64_v4i16((LAS v4i16_t*)p);
    const v4i16_t hi = __builtin_amdgcn_ds_read_tr16_b64_v4i16((LAS v4i16_t*)(p + 4 * pitch));
    return (bf16x8v){lo[0], lo[1], lo[2], lo[3], hi[0], hi[1], hi[2], hi[3]};
}
#define MFMA32(a, b, c) __builtin_amdgcn_mfma_f32_32x32x16_bf16((a), (b), (c), 0, 0, 0)

__device__ __forceinline__ void ssd_unit(int tid, bf16* proj, const float* smallp, float* ssq, const float* dt_bias, const float* a_log, const float* dskip, int b, int h, LAS unsigned char* lds) {
    constexpr int PB = 272, PX = 144;
    asm volatile("" : "+v"(tid));
    LAS unsigned char* CG = lds;
    LAS unsigned char* BB = lds + 34816;
    LAS unsigned char* XX = lds + 69632;
    LAS unsigned char* XW = lds + 88064;
    LAS unsigned char* ST = lds + 106496;
    LAS float* ldv = (LAS float*)(lds + 123904);
    LAS float* dtv = ldv + 256;
    const int lane0 = tid & 63, w = __builtin_amdgcn_readfirstlane(tid >> 6);
    const int g = h >> 3, pt = w & 1, lt = w >> 1;
    const float a = -__expf(a_log[h]), dsk = dskip[h], dtb = dt_bias[h];
    const size_t rowb = (size_t)b * SEQ;
    const int xrow = tid >> 2, xq = tid & 3, brow = tid >> 4, bc = tid & 15;
    const bf16* xsrc = proj + (rowb + xrow) * PLD + PC_XBC + h * 64 + xq * 16;
    bf16* zptr = proj + (rowb + xrow) * PLD + PC_Z + h * 64 + xq * 16;
    const bf16* bsrc = proj + (rowb + brow) * PLD + PC_XBC + 1024 + g * 128 + bc * 8;
    const bf16* csrc = bsrc + 256;
    const float* dsrc = smallp + (rowb + lane0) * 24 + h;
    v4u xr[2], br[4], cr[4];
#pragma unroll
    for (int k = 0; k < 2; ++k) xr[k] = *(const v4u*)(xsrc + 8 * k);
#pragma unroll
    for (int k = 0; k < 4; ++k) { br[k] = *(const v4u*)(bsrc + (size_t)32 * k * PLD); cr[k] = *(const v4u*)(csrc + (size_t)32 * k * PLD); }
    float dtr0 = 0.f, dtr1 = 0.f;
#define SSD_GATES(v0_, v1_, buf_) do { float v0 = (v0_) + dtb, v1 = (v1_) + dtb; \
        v0 = (v0 > 20.f) ? v0 : log1pf(__expf(v0)); v1 = (v1 > 20.f) ? v1 : log1pf(__expf(v1)); \
        float s0 = v0 * a, s1 = v1 * a; \
        _Pragma("unroll") for (int o = 1; o < 64; o <<= 1) { const float t0 = __shfl_up(s0, o), t1 = __shfl_up(s1, o); if (lane0 >= o) { s0 += t0; s1 += t1; } } \
        s1 += __shfl(s0, 63); \
        ldv[(buf_) * 128 + lane0] = s0; ldv[(buf_) * 128 + 64 + lane0] = s1; dtv[(buf_) * 128 + lane0] = v0; dtv[(buf_) * 128 + 64 + lane0] = v1; } while (0)
    if (w == 0) { SSD_GATES(dsrc[0], dsrc[64 * 24], 0); dtr0 = dsrc[128 * 24]; dtr1 = dsrc[192 * 24]; }
    f32x16 sacc;
#pragma unroll
    for (int i = 0; i < 16; ++i) sacc[i] = 0.f;
    for (int i = tid; i < 17408 / 4; i += 512) ((LAS unsigned*)ST)[i] = 0u;
    for (int c = 0; c < 16; ++c) {
        const size_t row0 = rowb + c * 128;
        int lane = lane0; asm volatile("" : "+v"(lane));
        const int r = lane & 31, hh = lane >> 5, trq = (lane & 15) >> 2, trc = 16 * ((lane >> 4) & 1) + 4 * (lane & 3);
        LAS const float* ldc = ldv + (c & 1) * 128; LAS const float* dtc = dtv + (c & 1) * 128;
        __syncthreads();
        {
            const float wl = dtc[xrow] * __expf(ldc[127] - ldc[xrow]);
#pragma unroll
            for (int k = 0; k < 2; ++k) { *(LAS v4u*)(XX + xrow * PX + xq * 32 + k * 16) = xr[k]; v4u o;
#pragma unroll
                for (int i = 0; i < 4; ++i) o[i] = pk2(bf2f(xr[k][i] & 0xffff) * wl, bf2f(xr[k][i] >> 16) * wl);
                *(LAS v4u*)(XW + xrow * PX + xq * 32 + k * 16) = o; }
#pragma unroll
            for (int k = 0; k < 4; ++k) { *(LAS v4u*)(BB + (brow + 32 * k) * PB + bc * 16) = br[k]; *(LAS v4u*)(CG + (brow + 32 * k) * PB + bc * 16) = cr[k]; }
        }
        v4u zr[2];
#pragma unroll
        for (int k = 0; k < 2; ++k) zr[k] = *(const v4u*)(zptr + (size_t)c * 128 * PLD + 8 * k);
        if (c < 15) {
#pragma unroll
            for (int k = 0; k < 2; ++k) xr[k] = *(const v4u*)(xsrc + (size_t)(c + 1) * 128 * PLD + 8 * k);
#pragma unroll
            for (int k = 0; k < 4; ++k) { br[k] = *(const v4u*)(bsrc + (size_t)((c + 1) * 128 + 32 * k) * PLD); cr[k] = *(const v4u*)(csrc + (size_t)((c + 1) * 128 + 32 * k) * PLD); }
            if (w == 0) { SSD_GATES(dtr0, dtr1, (c + 1) & 1);
                if (c < 14) { dtr0 = dsrc[(size_t)(c + 2) * 128 * 24]; dtr1 = dsrc[(size_t)((c + 2) * 128 + 64) * 24]; } }
        }
        __syncthreads();
        f32x16 yacc;
#pragma unroll
        for (int i = 0; i < 16; ++i) yacc[i] = 0.f;
#pragma unroll
        for (int ks = 0; ks < 8; ++ks) yacc = MFMA32(frag_row(ST, PB, 32 * pt + r, 16 * ks + 8 * hh), frag_row(CG, PB, 32 * lt + r, 16 * ks + 8 * hh), yacc);
        { const float e = __expf(ldc[32 * lt + r]);
#pragma unroll
          for (int i = 0; i < 16; ++i) yacc[i] *= e; }
        f32x16 tA, tB;
        const int ltA = (w >= 6) ? 3 : (w >= 3) ? 2 : (w >= 1) ? 1 : 0, stA = w - ltA * (ltA + 1) / 2;
        const int ltB = 3, stB = w + 2;
#pragma unroll
        for (int i = 0; i < 16; ++i) { tA[i] = 0.f; tB[i] = 0.f; }
#pragma unroll
        for (int ks = 0; ks < 8; ++ks) tA = MFMA32(frag_row(BB, PB, 32 * stA + r, 16 * ks + 8 * hh), frag_row(CG, PB, 32 * ltA + r, 16 * ks + 8 * hh), tA);
        if (w < 2) {
#pragma unroll
            for (int ks = 0; ks < 8; ++ks) tB = MFMA32(frag_row(BB, PB, 32 * stB + r, 16 * ks + 8 * hh), frag_row(CG, PB, 32 * ltB + r, 16 * ks + 8 * hh), tB);
        }
        __syncthreads();
        { const int l = 32 * ltA + r; const float ldl = ldc[l];
#pragma unroll
          for (int g4 = 0; g4 < 4; ++g4) { const int s0 = 32 * stA + 8 * g4 + 4 * hh; float v[4];
#pragma unroll
              for (int j = 0; j < 4; ++j) { const int s_ = s0 + j; v[j] = (s_ <= l) ? tA[4 * g4 + j] * __expf(ldl - ldc[s_]) * dtc[s_] : 0.f; }
              *(LAS unsigned long long*)(CG + l * PB + s0 * 2) = (unsigned long long)pk2(v[0], v[1]) | ((unsigned long long)pk2(v[2], v[3]) << 32); } }
        if (w < 2) { const int l = 32 * ltB + r; const float ldl = ldc[l];
#pragma unroll
          for (int g4 = 0; g4 < 4; ++g4) { const int s0 = 32 * stB + 8 * g4 + 4 * hh; float v[4];
#pragma unroll
              for (int j = 0; j < 4; ++j) { const int s_ = s0 + j; v[j] = (s_ <= l) ? tB[4 * g4 + j] * __expf(ldl - ldc[s_]) * dtc[s_] : 0.f; }
              *(LAS unsigned long long*)(CG + l * PB + s0 * 2) = (unsigned long long)pk2(v[0], v[1]) | ((unsigned long long)pk2(v[2], v[3]) << 32); } }
        __syncthreads();
        for (int ks = 0; ks < 2 * (lt + 1); ++ks) yacc = MFMA32(frag_tr(XX, PX, 16 * ks + 8 * hh + trq, 32 * pt + trc), frag_row(CG, PB, 32 * lt + r, 16 * ks + 8 * hh), yacc);
        { const float e = __expf(ldc[127]);
#pragma unroll
          for (int i = 0; i < 16; ++i) sacc[i] *= e; }
#pragma unroll
        for (int ks = 0; ks < 8; ++ks) sacc = MFMA32(frag_tr(BB, PB, 16 * ks + 8 * hh + trq, 32 * lt + trc), frag_tr(XW, PX, 16 * ks + 8 * hh + trq, 32 * pt + trc), sacc);
        __syncthreads();
        {
            const int p = 32 * pt + r, l = 32 * lt + r;
#pragma unroll
            for (int g4 = 0; g4 < 4; ++g4) { const int n0 = 32 * lt + 8 * g4 + 4 * hh;
                *(LAS unsigned long long*)(ST + p * PB + n0 * 2) = (unsigned long long)pk2(sacc[4 * g4], sacc[4 * g4 + 1]) | ((unsigned long long)pk2(sacc[4 * g4 + 2], sacc[4 * g4 + 3]) << 32);
                const int p0 = 32 * pt + 8 * g4 + 4 * hh;
                *(LAS f32x4*)(CG + l * 272 + p0 * 4) = (f32x4){yacc[4 * g4], yacc[4 * g4 + 1], yacc[4 * g4 + 2], yacc[4 * g4 + 3]}; }
        }
        __syncthreads();
        {
            float o[16]; float ss = 0.f;
#pragma unroll
            for (int k = 0; k < 2; ++k) { const v4u zv = zr[k]; const v4u xv = *(const LAS v4u*)(XX + xrow * PX + xq * 32 + k * 16);
                const f32x4 y0 = *(const LAS f32x4*)(CG + xrow * 272 + (xq * 16 + 8 * k) * 4), y1 = *(const LAS f32x4*)(CG + xrow * 272 + (xq * 16 + 8 * k + 4) * 4);
#pragma unroll
                for (int i = 0; i < 4; ++i) { const float ya = (i < 2 ? y0[2 * i] : y1[2 * i - 4]), yb = (i < 2 ? y0[2 * i + 1] : y1[2 * i - 3]);
                    const float oa = (ya + dsk * bf2f(xv[i] & 0xffff)) * silu_f(bf2f(zv[i] & 0xffff)), ob = (yb + dsk * bf2f(xv[i] >> 16)) * silu_f(bf2f(zv[i] >> 16));
                    o[8 * k + 2 * i] = oa; o[8 * k + 2 * i + 1] = ob; ss += oa * oa + ob * ob; } }
            ss += __shfl_xor(ss, 1); ss += __shfl_xor(ss, 2);
            bf16* zp = zptr + (size_t)c * 128 * PLD;
#pragma unroll
            for (int k = 0; k < 2; ++k) { v4u ov; ov.x = pk2(o[8 * k], o[8 * k + 1]); ov.y = pk2(o[8 * k + 2], o[8 * k + 3]); ov.z = pk2(o[8 * k + 4], o[8 * k + 5]); ov.w = pk2(o[8 * k + 6], o[8 * k + 7]); *(v4u*)(zp + 8 * k) = ov; }
            if (xq == 0) ssq[(row0 + xrow) * 16 + h] = ss;
        }
    }
#undef SSD_GATES
    __syncthreads();
}

__device__ __forceinline__ void mlstm_unit(int tid, bf16* proj, const float* smallp, const float* i_bias, const float* f_bias, const float* norm_w, int b, int hd, LAS unsigned char* lds) {
    constexpr int PB = 272;
    asm volatile("" : "+v"(tid));
    LAS unsigned char* QP = lds;
    LAS unsigned char* KK = lds + 34816;
    LAS unsigned char* VV = lds + 69632;
    LAS unsigned char* CS = lds + 104448;
    LAS float* uu = (LAS float*)(lds + 139264);
    LAS float* mmv = uu + 256;
    LAS float* wint = mmv + 256;
    LAS float* dnv = wint + 256;
    LAS float* wlv = dnv + 256;
    LAS float* den = wlv + 256;
    LAS float* nst = den + 128;
    LAS float* nacc = nst + 128;
    LAS float* scal = nacc + 128;
    const int lane0 = tid & 63, w = __builtin_amdgcn_readfirstlane(tid >> 6);
    const int tt = w >> 1, dp = w & 1;
    const float ib = i_bias[hd], fb = f_bias[hd];
    const size_t rowb = (size_t)b * SEQ;
    const int srow = tid >> 4, sc = tid & 15, et = tid >> 2, eq = tid & 3;
    const bf16* qsrc = proj + (rowb + srow) * PLD + PC_MQK + hd * 128 + sc * 8;
    const bf16* ksrc = qsrc + 512;
    const bf16* vsrc = proj + (rowb + srow) * PLD + PC_MV + hd * 128 + sc * 8;
    bf16* optr = proj + (rowb + et) * PLD + PC_MO + hd * 128 + eq * 32;
    const float* gsrc = smallp + (rowb + lane0) * 24 + 16 + hd;
    v4u qr[4], kr[4], vr[4];
#pragma unroll
    for (int k = 0; k < 4; ++k) { qr[k] = *(const v4u*)(qsrc + (size_t)32 * k * PLD); kr[k] = *(const v4u*)(ksrc + (size_t)32 * k * PLD); vr[k] = *(const v4u*)(vsrc + (size_t)32 * k * PLD); }
    float mst = 0.f;
    float gi0 = 0.f, gi1 = 0.f, gf0 = 0.f, gf1 = 0.f;
#define ML_GATES(i0_, i1_, f0_, f1_, buf_) do { const float li0 = (i0_) + ib, li1 = (i1_) + ib; const float f0 = (f0_) + fb, f1 = (f1_) + fb; \
        float c0 = (f0 >= 0.f) ? -log1pf(__expf(-f0)) : (f0 - log1pf(__expf(f0))), c1 = (f1 >= 0.f) ? -log1pf(__expf(-f1)) : (f1 - log1pf(__expf(f1))); \
        _Pragma("unroll") for (int o = 1; o < 64; o <<= 1) { const float t0 = __shfl_up(c0, o), t1 = __shfl_up(c1, o); if (lane0 >= o) { c0 += t0; c1 += t1; } } \
        c1 += __shfl(c0, 63); \
        const float totf = __shfl(c1, 63); \
        const float u0 = li0 - c0, u1 = li1 - c1; \
        float p0 = u0, p1 = u1; \
        _Pragma("unroll") for (int o = 1; o < 64; o <<= 1) { const float t0 = __shfl_up(p0, o), t1 = __shfl_up(p1, o); if (lane0 >= o) { p0 = fmaxf(p0, t0); p1 = fmaxf(p1, t1); } } \
        p1 = fmaxf(p1, __shfl(p0, 63)); \
        const float mloc = totf + __shfl(p1, 63), mnew = fmaxf(totf + mst, mloc); \
        const float m0 = fmaxf(p0, mst), m1 = fmaxf(p1, mst); const int o_ = (buf_) * 128; \
        uu[o_ + lane0] = u0; uu[o_ + 64 + lane0] = u1; mmv[o_ + lane0] = m0; mmv[o_ + 64 + lane0] = m1; \
        wint[o_ + lane0] = __expf(mst - m0); wint[o_ + 64 + lane0] = __expf(mst - m1); \
        dnv[o_ + lane0] = __expf(-(c0 + m0)); dnv[o_ + 64 + lane0] = __expf(-(c1 + m1)); \
        wlv[o_ + lane0] = __expf(totf + u0 - mnew); wlv[o_ + 64 + lane0] = __expf(totf + u1 - mnew); \
        if (lane0 == 0) scal[(buf_)] = __expf(totf + mst - mnew); \
        mst = mnew; } while (0)
    if (w == 0) { ML_GATES(gsrc[0], gsrc[64 * 24], gsrc[4], gsrc[64 * 24 + 4], 0);
        gi0 = gsrc[128 * 24]; gi1 = gsrc[192 * 24]; gf0 = gsrc[128 * 24 + 4]; gf1 = gsrc[192 * 24 + 4]; }
    f32x16 cacc0, cacc1;
#pragma unroll
    for (int i = 0; i < 16; ++i) { cacc0[i] = 0.f; cacc1[i] = 0.f; }
    for (int i = tid; i < 34816 / 4; i += 512) ((LAS unsigned*)CS)[i] = 0u;
    if (tid < 128) nst[tid] = 0.f;
    for (int c = 0; c < 16; ++c) {
        int lane = lane0; asm volatile("" : "+v"(lane));
        const int r = lane & 31, hh = lane >> 5, trq = (lane & 15) >> 2, trc = 16 * ((lane >> 4) & 1) + 4 * (lane & 3);
        const int go = (c & 1) * 128;
        __syncthreads();
#pragma unroll
        for (int k = 0; k < 4; ++k) { *(LAS v4u*)(QP + (srow + 32 * k) * PB + sc * 16) = qr[k]; *(LAS v4u*)(KK + (srow + 32 * k) * PB + sc * 16) = kr[k]; *(LAS v4u*)(VV + (srow + 32 * k) * PB + sc * 16) = vr[k]; }
        if (tid < 128) nacc[tid] = 0.f;
        v4u og[4];
#pragma unroll
        for (int k = 0; k < 4; ++k) og[k] = *(const v4u*)(optr + (size_t)c * 128 * PLD + 8 * k);
        if (c < 15) {
#pragma unroll
            for (int k = 0; k < 4; ++k) { const size_t ro = (size_t)((c + 1) * 128 + 32 * k) * PLD; qr[k] = *(const v4u*)(qsrc + ro); kr[k] = *(const v4u*)(ksrc + ro); vr[k] = *(const v4u*)(vsrc + ro); }
            if (w == 0) { ML_GATES(gi0, gi1, gf0, gf1, (c + 1) & 1);
                if (c < 14) { const size_t ro = (size_t)(c + 2) * 128 * 24; gi0 = gsrc[ro]; gi1 = gsrc[ro + 64 * 24]; gf0 = gsrc[ro + 4]; gf1 = gsrc[ro + 64 * 24 + 4]; } }
        }
        __syncthreads();
        f32x16 na0, na1;
#pragma unroll
        for (int i = 0; i < 16; ++i) { na0[i] = 0.f; na1[i] = 0.f; }
#pragma unroll
        for (int ks = 0; ks < 8; ++ks) { const bf16x8v qf = frag_row(QP, PB, 32 * tt + r, 16 * ks + 8 * hh);
            na0 = MFMA32(frag_row(CS, PB, 32 * (2 * dp) + r, 16 * ks + 8 * hh), qf, na0);
            na1 = MFMA32(frag_row(CS, PB, 32 * (2 * dp + 1) + r, 16 * ks + 8 * hh), qf, na1); }
        { const float e = wint[go + 32 * tt + r];
#pragma unroll
          for (int i = 0; i < 16; ++i) { na0[i] *= e; na1[i] *= e; } }
        {
            float d = 0.f;
#pragma unroll
            for (int k = 0; k < 4; ++k) { const v4u qv = *(const LAS v4u*)(QP + et * PB + eq * 64 + k * 16);
#pragma unroll
                for (int i = 0; i < 4; ++i) d += bf2f(qv[i] & 0xffff) * nst[eq * 32 + k * 8 + 2 * i] + bf2f(qv[i] >> 16) * nst[eq * 32 + k * 8 + 2 * i + 1]; }
            d += __shfl_xor(d, 1); d += __shfl_xor(d, 2);
            if (eq == 0) den[et] = d * wint[go + et];
        }
        f32x16 tA, tB;
        const int ttA = (w >= 6) ? 3 : (w >= 3) ? 2 : (w >= 1) ? 1 : 0, stA = w - ttA * (ttA + 1) / 2;
        const int ttB = 3, stB = w + 2;
#pragma unroll
        for (int i = 0; i < 16; ++i) { tA[i] = 0.f; tB[i] = 0.f; }
#pragma unroll
        for (int ks = 0; ks < 8; ++ks) tA = MFMA32(frag_row(KK, PB, 32 * stA + r, 16 * ks + 8 * hh), frag_row(QP, PB, 32 * ttA + r, 16 * ks + 8 * hh), tA);
        if (w < 2) {
#pragma unroll
            for (int ks = 0; ks < 8; ++ks) tB = MFMA32(frag_row(KK, PB, 32 * stB + r, 16 * ks + 8 * hh), frag_row(QP, PB, 32 * ttB + r, 16 * ks + 8 * hh), tB);
        }
        __syncthreads();
        { const int t = 32 * ttA + r; const float mt = mmv[go + t]; float ds = 0.f;
#pragma unroll
          for (int g4 = 0; g4 < 4; ++g4) { const int s0 = 32 * stA + 8 * g4 + 4 * hh; float v[4];
#pragma unroll
              for (int j = 0; j < 4; ++j) { const int s_ = s0 + j; v[j] = (s_ <= t) ? tA[4 * g4 + j] * __expf(uu[go + s_] - mt) : 0.f; ds += v[j]; }
              *(LAS unsigned long long*)(QP + t * PB + s0 * 2) = (unsigned long long)pk2(v[0], v[1]) | ((unsigned long long)pk2(v[2], v[3]) << 32); }
          ds += __shfl_xor(ds, 32);
          if (hh == 0) __hip_atomic_fetch_add(den + t, ds, __ATOMIC_RELAXED, __HIP_MEMORY_SCOPE_WORKGROUP); }
        if (w < 2) { const int t = 32 * ttB + r; const float mt = mmv[go + t]; float ds = 0.f;
#pragma unroll
          for (int g4 = 0; g4 < 4; ++g4) { const int s0 = 32 * stB + 8 * g4 + 4 * hh; float v[4];
#pragma unroll
              for (int j = 0; j < 4; ++j) { const int s_ = s0 + j; v[j] = (s_ <= t) ? tB[4 * g4 + j] * __expf(uu[go + s_] - mt) : 0.f; ds += v[j]; }
              *(LAS unsigned long long*)(QP + t * PB + s0 * 2) = (unsigned long long)pk2(v[0], v[1]) | ((unsigned long long)pk2(v[2], v[3]) << 32); }
          ds += __shfl_xor(ds, 32);
          if (hh == 0) __hip_atomic_fetch_add(den + t, ds, __ATOMIC_RELAXED, __HIP_MEMORY_SCOPE_WORKGROUP); }
        {
            const int rg = tid >> 4, ec = tid & 15; float cs[8];
#pragma unroll
            for (int i = 0; i < 8; ++i) cs[i] = 0.f;
#pragma unroll
            for (int k = 0; k < 4; ++k) { const int row = 4 * rg + k; const float wl = wlv[go + row]; LAS v4u* p = (LAS v4u*)(KK + row * PB + ec * 16); const v4u kv = *p; v4u o;
#pragma unroll
                for (int i = 0; i < 4; ++i) { const float a0 = bf2f(kv[i] & 0xffff) * wl, a1 = bf2f(kv[i] >> 16) * wl; o[i] = pk2(a0, a1); cs[2 * i] += a0; cs[2 * i + 1] += a1; }
                *p = o; }
#pragma unroll
            for (int i = 0; i < 8; ++i) { cs[i] += __shfl_xor(cs[i], 16); cs[i] += __shfl_xor(cs[i], 32); }
            if (lane < 16) {
#pragma unroll
                for (int i = 0; i < 8; ++i) __hip_atomic_fetch_add(nacc + ec * 8 + i, cs[i], __ATOMIC_RELAXED, __HIP_MEMORY_SCOPE_WORKGROUP); }
        }
        __syncthreads();
        for (int ks = 0; ks < 2 * (tt + 1); ++ks) { const bf16x8v pf = frag_row(QP, PB, 32 * tt + r, 16 * ks + 8 * hh);
            na0 = MFMA32(frag_tr(VV, PB, 16 * ks + 8 * hh + trq, 32 * (2 * dp) + trc), pf, na0);
            na1 = MFMA32(frag_tr(VV, PB, 16 * ks + 8 * hh + trq, 32 * (2 * dp + 1) + trc), pf, na1); }
        { const float e = scal[c & 1];
#pragma unroll
          for (int i = 0; i < 16; ++i) { cacc0[i] *= e; cacc1[i] *= e; } }
#pragma unroll
        for (int ks = 0; ks < 8; ++ks) { const bf16x8v kf = frag_tr(KK, PB, 16 * ks + 8 * hh + trq, 32 * tt + trc);
            cacc0 = MFMA32(kf, frag_tr(VV, PB, 16 * ks + 8 * hh + trq, 32 * (2 * dp) + trc), cacc0);
            cacc1 = MFMA32(kf, frag_tr(VV, PB, 16 * ks + 8 * hh + trq, 32 * (2 * dp + 1) + trc), cacc1); }
        __syncthreads();
        {
            const int t = 32 * tt + r; const float dv = 1.0f / fmaxf(fabsf(den[t]), dnv[go + t]);
#pragma unroll
            for (int g4 = 0; g4 < 4; ++g4) {
                const int e0 = 32 * tt + 8 * g4 + 4 * hh, d0 = 32 * (2 * dp) + r, d1 = 32 * (2 * dp + 1) + r;
                *(LAS unsigned long long*)(CS + d0 * PB + e0 * 2) = (unsigned long long)pk2(cacc0[4 * g4], cacc0[4 * g4 + 1]) | ((unsigned long long)pk2(cacc0[4 * g4 + 2], cacc0[4 * g4 + 3]) << 32);
                *(LAS unsigned long long*)(CS + d1 * PB + e0 * 2) = (unsigned long long)pk2(cacc1[4 * g4], cacc1[4 * g4 + 1]) | ((unsigned long long)pk2(cacc1[4 * g4 + 2], cacc1[4 * g4 + 3]) << 32);
                const int dd0 = 32 * (2 * dp) + 8 * g4 + 4 * hh, dd1 = dd0 + 32;
                *(LAS unsigned long long*)(QP + t * PB + dd0 * 2) = (unsigned long long)pk2(na0[4 * g4] * dv, na0[4 * g4 + 1] * dv) | ((unsigned long long)pk2(na0[4 * g4 + 2] * dv, na0[4 * g4 + 3] * dv) << 32);
                *(LAS unsigned long long*)(QP + t * PB + dd1 * 2) = (unsigned long long)pk2(na1[4 * g4] * dv, na1[4 * g4 + 1] * dv) | ((unsigned long long)pk2(na1[4 * g4 + 2] * dv, na1[4 * g4 + 3] * dv) << 32);
            }
            if (tid < 128) nst[tid] = nst[tid] * scal[c & 1] + nacc[tid];
        }
        __syncthreads();
        {
            float hv[32]; float ss = 0.f;
#pragma unroll
            for (int k = 0; k < 4; ++k) { const v4u x = *(const LAS v4u*)(QP + et * PB + eq * 64 + k * 16);
#pragma unroll
                for (int i = 0; i < 4; ++i) { hv[8 * k + 2 * i] = bf2f(x[i] & 0xffff); hv[8 * k + 2 * i + 1] = bf2f(x[i] >> 16); ss += hv[8 * k + 2 * i] * hv[8 * k + 2 * i] + hv[8 * k + 2 * i + 1] * hv[8 * k + 2 * i + 1]; } }
            ss += __shfl_xor(ss, 1); ss += __shfl_xor(ss, 2);
            const float rr = 1.0f / sqrtf(ss * (1.0f / 128.0f) + EPS);
            bf16* op = optr + (size_t)c * 128 * PLD;
            const float* nw = norm_w + hd * 128 + eq * 32;
#pragma unroll
            for (int k = 0; k < 4; ++k) { v4u o;
#pragma unroll
                for (int i = 0; i < 4; ++i) { const float g0 = 1.0f / (1.0f + __expf(-bf2f(og[k][i] & 0xffff))), g1 = 1.0f / (1.0f + __expf(-bf2f(og[k][i] >> 16)));
                    o[i] = pk2(hv[8 * k + 2 * i] * rr * nw[8 * k + 2 * i] * g0, hv[8 * k + 2 * i + 1] * rr * nw[8 * k + 2 * i + 1] * g1); }
                *(v4u*)(op + 8 * k) = o; }
        }
    }
#undef ML_GATES
    __syncthreads();
}

__device__ __forceinline__ void conv_phase(Frame& F, bf16* proj, const bf16* halo, const float* scw, const float* scb, const float* mcw, const float* mcb) {
    const int gt = F.vcu * (NWAVES * 64) + F.tid, NT = F.G * NWAVES * 64;
    for (int it = gt; it < 256 * 320; it += NT) {
        const int strip = it % 320, rg = it / 320, hch = strip * 8;
        const float* wp; const float* bp; int wst; float post = 1.0f;
        if (hch < 1536) { wp = scw + hch; bp = scb + hch; wst = 1536; }
        else { const int c2 = hch - 1536; wp = mcw + c2; bp = mcb + c2; wst = 1024; post = (c2 >= 512) ? 0.08838834764831845f : 1.0f; }
        float cw[4][8], cb[8];
#pragma unroll
        for (int j = 0; j < 4; ++j) { const f32x4 a0 = *(const f32x4*)(wp + j * wst), a1 = *(const f32x4*)(wp + j * wst + 4);
#pragma unroll
            for (int i = 0; i < 4; ++i) { cw[j][i] = a0[i]; cw[j][4 + i] = a1[i]; } }
        { const f32x4 a0 = *(const f32x4*)bp, a1 = *(const f32x4*)(bp + 4);
#pragma unroll
          for (int i = 0; i < 4; ++i) { cb[i] = a0[i]; cb[4 + i] = a1[i]; } }
        bf16* base = proj + (size_t)rg * 64 * PLD + PC_XBC + hch;
        v4u r0 = (v4u){0, 0, 0, 0}, r1 = r0, r2 = r0;
        if ((rg & 31) != 0) { const bf16* hp = halo + ((size_t)(rg - 1) * 3) * 2560 + hch; r0 = *(const v4u*)hp; r1 = *(const v4u*)(hp + 2560); r2 = *(const v4u*)(hp + 5120); }
        for (int i0 = 0; i0 < 64; i0 += 8) {
            v4u cur[8];
#pragma unroll
            for (int j = 0; j < 8; ++j) cur[j] = *(const v4u*)(base + (size_t)(i0 + j) * PLD);
#pragma unroll
            for (int j = 0; j < 8; ++j) {
                v4u o;
#pragma unroll
                for (int i = 0; i < 4; ++i) {
                    float a0 = cb[2 * i] + cw[0][2 * i] * bf2f(r0[i] & 0xffff) + cw[1][2 * i] * bf2f(r1[i] & 0xffff) + cw[2][2 * i] * bf2f(r2[i] & 0xffff) + cw[3][2 * i] * bf2f(cur[j][i] & 0xffff);
                    float a1 = cb[2 * i + 1] + cw[0][2 * i + 1] * bf2f(r0[i] >> 16) + cw[1][2 * i + 1] * bf2f(r1[i] >> 16) + cw[2][2 * i + 1] * bf2f(r2[i] >> 16) + cw[3][2 * i + 1] * bf2f(cur[j][i] >> 16);
                    o[i] = pk2(silu_f(a0) * post, silu_f(a1) * post); }
                *(v4u*)(base + (size_t)(i0 + j) * PLD) = o;
                r0 = r1; r1 = r2; r2 = cur[j];
            }
        }
    }
}

namespace attn_body {
using bf16=__hip_bfloat16;
using bf16x8=__attribute__((ext_vector_type(8)))short;
using s16x4=__attribute__((ext_vector_type(4)))short;
using f32x16=__attribute__((ext_vector_type(16)))float;
using u32x4=__attribute__((ext_vector_type(4)))unsigned;
constexpr int BATCH=8,NHEAD=8,SEQ=2048,D=64,DM=6144;
constexpr int NW=8,QBLK=32,QB=QBLK*NW,KVBLK=64,NQB=SEQ/QB;
constexpr int ATTN_PITCH=DM, ATTN_UNIT_ROWS=QB;
__device__ __forceinline__ int crow(int r,int hi){return (r&3)+8*(r>>2)+4*hi;}
#define SBAR() __builtin_amdgcn_sched_barrier(0)
__device__ __forceinline__ void cmask(f32x16&p0,f32x16&p1,int jb,int qrel,int hi){
  const float NEG=-INFINITY; int kb=64*jb+4*hi;
  #pragma unroll
  for(int r=0;r<16;++r){int kv=kb+(r&3)+8*(r>>2); if(kv>qrel)p0[r]=NEG; if(kv+32>qrel)p1[r]=NEG;}
}

typedef float f32x4_t __attribute__((ext_vector_type(4)));
__device__ __forceinline__ float bfu(short v){return __uint_as_float(((unsigned)(unsigned short)v)<<16);}
constexpr int NSLOT=3, SLOTB=8192;
constexpr int LDS_K=0, LDS_V=NSLOT*SLOTB, LDS_WS=2*NSLOT*SLOTB, LDS_OST=LDS_WS+NW*64*4, LDS_BYTES=LDS_OST+NW*4096;
constexpr float C2=0.125f*1.4426950408889634f;
__device__ __forceinline__ void glds16(const void*gsrc,unsigned lds_dst){unsigned keep;
  asm volatile("s_mov_b32 %0, m0\n\ts_mov_b32 m0, %2\n\ts_nop 0\n\tglobal_load_lds_dwordx4 %1, off\n\ts_mov_b32 m0, %0":"=&s"(keep):"v"(gsrc),"s"(lds_dst):"memory");}
__device__ __forceinline__ float max3f(float a,float b,float c){float r;asm("v_max3_f32 %0, %1, %2, %3":"=v"(r):"v"(a),"v"(b),"v"(c));return r;}
__device__ __forceinline__ float max2f(float a,float b){float r;asm("v_max_f32_e32 %0, %1, %2":"=v"(r):"v"(a),"v"(b));return r;}
__device__ __forceinline__ float fadd_s(float a,float b){float r;asm("v_add_f32_e32 %0, %1, %2":"=v"(r):"v"(a),"v"(b));return r;}
__device__ __forceinline__ float fsub_s(float a,float b){float r;asm("v_sub_f32_e32 %0, %1, %2":"=v"(r):"v"(a),"v"(b));return r;}
typedef float f32x2_t __attribute__((ext_vector_type(2))); typedef __bf16 bf16x2_t __attribute__((ext_vector_type(2)));
__device__ __forceinline__ unsigned cvtpk_s(float lo,float hi){f32x2_t v={lo,hi};bf16x2_t b=__builtin_convertvector(v,bf16x2_t);return __builtin_bit_cast(unsigned,b);}
#define WAIT_BAR(N) asm volatile("s_waitcnt vmcnt(" #N ") lgkmcnt(0)\n\ts_barrier":::"memory")

__device__ __forceinline__ void qkt(f32x16&p0,f32x16&p1,const char*Kslot,const bf16x8*qr,const f32x16&negm,int r32,int hi){
  const char*kb=Kslot+hi*1024+r32*16;
  #pragma unroll
  for(int d0=0;d0<4;++d0){
    const bf16x8 b0=*reinterpret_cast<const bf16x8*>(kb+d0*2048);
    const bf16x8 b1=*reinterpret_cast<const bf16x8*>(kb+d0*2048+512);
    if(d0==0){p0=__builtin_amdgcn_mfma_f32_32x32x16_bf16(b0,qr[0],negm,0,0,0);p1=__builtin_amdgcn_mfma_f32_32x32x16_bf16(b1,qr[0],negm,0,0,0);}
    else{p0=__builtin_amdgcn_mfma_f32_32x32x16_bf16(b0,qr[d0],p0,0,0,0);p1=__builtin_amdgcn_mfma_f32_32x32x16_bf16(b1,qr[d0],p1,0,0,0);}}
}
typedef __attribute__((address_space(3))) const char* lds_cptr;
typedef short v4i16_t __attribute__((ext_vector_type(4)));
__device__ __forceinline__ void kload8(bf16x8*kf,lds_cptr kp){
  kf[0]=*(const __attribute__((address_space(3))) bf16x8*)(kp);      kf[1]=*(const __attribute__((address_space(3))) bf16x8*)(kp+512);
  kf[2]=*(const __attribute__((address_space(3))) bf16x8*)(kp+2048); kf[3]=*(const __attribute__((address_space(3))) bf16x8*)(kp+2560);
  kf[4]=*(const __attribute__((address_space(3))) bf16x8*)(kp+4096); kf[5]=*(const __attribute__((address_space(3))) bf16x8*)(kp+4608);
  kf[6]=*(const __attribute__((address_space(3))) bf16x8*)(kp+6144); kf[7]=*(const __attribute__((address_space(3))) bf16x8*)(kp+6656);
}
__device__ __forceinline__ void kload2(bf16x8*kf,lds_cptr kp,int j){ kf[2*j]=*(const __attribute__((address_space(3))) bf16x8*)(kp+j*2048); kf[2*j+1]=*(const __attribute__((address_space(3))) bf16x8*)(kp+j*2048+512); }
__device__ __forceinline__ s16x4 vtr(lds_cptr p){ return __builtin_bit_cast(s16x4,__builtin_amdgcn_ds_read_tr16_b64_v4i16((__attribute__((address_space(3))) v4i16_t*)p)); }
__device__ __forceinline__ float rowmax(const f32x16&p0,const f32x16&p1){
  float a=max3f(p0[0],p0[1],p1[0]),b=max3f(p0[2],p0[3],p1[1]);a=max3f(a,p1[2],p1[3]);
  #pragma unroll
  for(int r=4;r<16;r+=4){a=max3f(a,p0[r],p0[r+1]);b=max3f(b,p0[r+2],p0[r+3]);a=max3f(a,p1[r],p1[r+1]);b=max3f(b,p1[r+2],p1[r+3]);}
  const float m=max2f(a,b);
  auto rr=__builtin_amdgcn_permlane32_swap(__float_as_uint(m),__float_as_uint(m),false,false);
  return max2f(__uint_as_float(rr[0]),__uint_as_float(rr[1]));
}
__device__ __forceinline__ void pv(f32x16*o,int vb,bf16x8 pa0,bf16x8 pa1,bf16x8 pa2,bf16x8 pa3){
  #pragma unroll
  for(int d0=0;d0<2;++d0){s16x4 lo[4],hi[4];
    #pragma unroll
    for(int ks=0;ks<4;++ks){
      asm volatile("ds_read_b64_tr_b16 %0,%1 offset:%c2":"=&v"(lo[ks]):"v"(vb),"i"(d0*4096+ks*1024):"memory");
      asm volatile("ds_read_b64_tr_b16 %0,%1 offset:%c2":"=&v"(hi[ks]):"v"(vb),"i"(d0*4096+ks*1024+512):"memory");}
    asm volatile("s_waitcnt lgkmcnt(0)":::"memory");SBAR();
    #define PK(k) (bf16x8){lo[k][0],lo[k][1],lo[k][2],lo[k][3],hi[k][0],hi[k][1],hi[k][2],hi[k][3]}
    o[d0]=__builtin_amdgcn_mfma_f32_32x32x16_bf16(pa0,PK(0),o[d0],0,0,0);
    o[d0]=__builtin_amdgcn_mfma_f32_32x32x16_bf16(pa1,PK(1),o[d0],0,0,0);
    o[d0]=__builtin_amdgcn_mfma_f32_32x32x16_bf16(pa2,PK(2),o[d0],0,0,0);
    o[d0]=__builtin_amdgcn_mfma_f32_32x32x16_bf16(pa3,PK(3),o[d0],0,0,0);
    #undef PK
  }
}

#ifndef ATTN_STORE16
#define ATTN_STORE16(p,v) (*(u32x4*)(p)=(v))
#endif
template<int THRL> __device__ __forceinline__ void attn_unit(int tid,int b,int h,int qb,const bf16*Q,const bf16*__restrict__ K,const bf16*__restrict__ V,bf16*O,const float*__restrict__ ksum,char*shm){
  asm volatile("":"+v"(tid));
  const int lane=tid&63,r32=lane&31,hi=lane>>5; const int wid=__builtin_amdgcn_readfirstlane(tid>>6);
  const long rowbase=(long)b*SEQ; const int q0=qb*QB;
  const bf16*Qw=Q+(rowbase+q0+wid*QBLK)*DM+h*D;
  const bf16*Kh=K+rowbase*DM+h*D,*Vh=V+rowbase*DM+h*D;
  const unsigned lds0=(unsigned)(uintptr_t)shm;
  float*wsf=(float*)(shm+LDS_WS)+wid*64;
  const bf16*ksrc=Kh+(long)lane*DM+wid*8;
  const bf16*vsrc=Vh+(long)(16*(wid&3)+(lane>>2))*DM+(wid>>2)*32+(lane&3)*8;
  const unsigned kdst=lds0+LDS_K+wid*1024, vdst=lds0+LDS_V+wid*1024;
  #define DMA_K(t,slot) glds16(ksrc+(long)(t)*KVBLK*DM,(unsigned)__builtin_amdgcn_readfirstlane(kdst+(slot)))
  #define DMA_V(t,slot) glds16(vsrc+(long)(t)*KVBLK*DM,(unsigned)__builtin_amdgcn_readfirstlane(vdst+(slot)))
  const int vb0=(int)(lds0+LDS_V)+((lane>>4)&1)*32+(lane&3)*8+(4*hi+((lane&15)>>2))*64;
  const char*Kbase=shm+LDS_K; bf16x8 kf[8];
  const lds_cptr shm3=(lds_cptr)shm; const lds_cptr kp0=shm3+LDS_K+hi*1024+r32*16; const lds_cptr vp0=shm3+LDS_V+((lane>>4)&1)*32+(lane&3)*8+(4*hi+((lane&15)>>2))*64;
  const int NT=(q0+QB)/KVBLK;
  DMA_K(0,0);DMA_V(0,0);DMA_K(1,SLOTB);
  bf16x8 qr[4];
  #pragma unroll
  for(int d0=0;d0<4;++d0)qr[d0]=*reinterpret_cast<const bf16x8*>(&Qw[(long)r32*DM+d0*16+hi*8]);
  unsigned sel=(1u<<qb)-1u;
  if(qb>=4){
    float g[8];
    #pragma unroll
    for(int n=0;n<8;++n){ g[n]=0.f;
      if(n<qb){ const float*kp=ksum+(((long)(b*8+n)*NHEAD+h)*64)+hi*8; float a=0.f;
        #pragma unroll
        for(int d0=0;d0<4;++d0){ const f32x4_t k0=*(const f32x4_t*)(kp+d0*16),k1=*(const f32x4_t*)(kp+d0*16+4);
          #pragma unroll
          for(int j=0;j<4;++j){ a+=bfu(qr[d0][j])*k0[j]; a+=bfu(qr[d0][4+j])*k1[j]; } }
        a+=__shfl_xor(a,32); g[n]=a; } }
    sel=0u;
    #pragma unroll
    for(int k=0;k<3;++k){ int best=-1; float bv=0.f;
      #pragma unroll
      for(int n=0;n<8;++n) if(n<qb&&!((sel>>n)&1u)){ if(best<0||g[n]>bv){best=n;bv=g[n];} }
      sel|=1u<<best; }
  }
  const f32x16 ninf={-INFINITY,-INFINITY,-INFINITY,-INFINITY,-INFINITY,-INFINITY,-INFINITY,-INFINITY,-INFINITY,-INFINITY,-INFINITY,-INFINITY,-INFINITY,-INFINITY,-INFINITY,-INFINITY};
  #define CINIT(t) ({ const bool mk_=((t)<NT-4)&&!((sel>>((t)>>2))&1u); f32x16 c_; _Pragma("unroll") for(int r_=0;r_<16;++r_)c_[r_]=mk_?ninf[r_]:negm[r_]; c_; })
  float mhat=0.f,l_reg=0.f;f32x16 o[2];o[0]=f32x16{};o[1]=f32x16{};f32x16 negm=f32x16{};asm volatile("":"+v"(negm));
  const int qrel=wid*QBLK+r32;
  #define CMASK(P0,P1,t) do{int jb_=(t)-(NT-4); if(jb_>=0)cmask(P0,P1,jb_,qrel,hi);}while(0)
  bool resc=false;
  #define START(P0,P1) do{ const float rm=rowmax(P0,P1); resc=false; \
    { const float dl=max2f(rm,-64.f); mhat=fadd_s(mhat,dl); \
      _Pragma("unroll") for(int r=0;r<16;++r){P0[r]=fsub_s(P0[r],dl);P1[r]=fsub_s(P1[r],dl);} \
      _Pragma("unroll") for(int r=0;r<16;++r)negm[r]=-mhat; asm volatile("":"+v"(negm)); } \
    _Pragma("unroll") for(int r=0;r<16;++r)P0[r]=__builtin_amdgcn_exp2f(P0[r]); }while(0)
  #define RESC() do{ if(resc){ asm volatile("s_waitcnt lgkmcnt(0)":::"memory"); \
      _Pragma("unroll") for(int d_=0;d_<2;++d_) _Pragma("unroll") for(int r=0;r<16;++r)o[d_][r]*=wsf[crow(r,hi)]; } }while(0)
  f32x16 pA0,pA1,pB0,pB1;
  int sl_prev=0,sl_cur=0,sl_next=SLOTB;
  #define ROT() do{sl_prev=sl_cur;sl_cur=sl_next;sl_next=(sl_next==(NSLOT-1)*SLOTB)?0:sl_next+SLOTB;}while(0)
  DMA_K(2,2*SLOTB);
  WAIT_BAR(3);
  { const f32x16 c0_=CINIT(0); qkt(pA0,pA1,Kbase,qr,c0_,r32,hi); }asm volatile("s_nop 15\n\ts_nop 7":"+v"(pA0),"+v"(pA1));CMASK(pA0,pA1,0);
  START(pA0,pA1);
  _Pragma("unroll") for(int r=0;r<16;++r)pA1[r]=__builtin_amdgcn_exp2f(pA1[r]);
  WAIT_BAR(0);
  DMA_K(3,0);DMA_V(1,SLOTB);
  ROT();
  kload8(kf,kp0+sl_cur);
  WAIT_BAR(2);
  s16x4 vlo[8],vhi[8]; u32x4 pw0,pw1,pw2,pw3;
  #define PKW(P,B) cvtpk_s(P[B],P[B+1])
  #define PAF(k) __builtin_bit_cast(bf16x8,pw##k)
  #define VFR(i) (bf16x8){vlo[i][0],vlo[i][1],vlo[i][2],vlo[i][3],vhi[i][0],vhi[i][1],vhi[i][2],vhi[i][3]}
  #define PIN(x) asm volatile("":"+v"(x))
  #define MX3(a,b,c) __builtin_fmaxf(__builtin_fmaxf((a),(b)),(c))
  #define GAPA(MF,A0,A1,A2,A3,W0,W1,PW) do{ MF; sacc+=A0; sacc+=A1; sacc+=A2; sacc+=A3; PIN(sacc); W0; W1; PIN(PW); SBAR(); }while(0)
  #define EX(v) __builtin_amdgcn_exp2f(v)
  #define GAPB(MF,X,B) do{ MF; X[B]=EX(X[B]); X[B+1]=EX(X[B+1]); X[B+2]=EX(X[B+2]); X[B+3]=EX(X[B+3]); PIN(X); SBAR(); }while(0)
  #define VRD(i) do{ vlo[i]=vtr(vp_+(((i)>>2)*4096+((i)&3)*1024)); vhi[i]=vtr(vp_+(((i)>>2)*4096+((i)&3)*1024+512)); }while(0)
  #define KRD(G,j) do{ if(G){ kload2(kf,kp0+sl_next,j); SBAR(); } }while(0)
  #define STEP(C0,C1,P0,P1,t,GK,GV,GL) do{ SBAR(); \
    const lds_cptr vp_=vp0+sl_prev; const f32x16 cin_=CINIT(t); \
    VRD(0); SBAR(); float sacc=(P0[0]+P0[1]); \
    GAPA(C0=__builtin_amdgcn_mfma_f32_32x32x16_bf16(kf[0],qr[0],cin_,0,0,0), P0[2],P0[3],P0[4],P0[5],     pw0[0]=PKW(P0,0), pw0[1]=PKW(P0,2), pw0); \
    VRD(4); SBAR(); GAPA(C1=__builtin_amdgcn_mfma_f32_32x32x16_bf16(kf[1],qr[0],cin_,0,0,0), P0[6],P0[7],P0[8],P0[9],     pw0[2]=PKW(P0,4), pw0[3]=PKW(P0,6), pw0); \
    VRD(1); SBAR(); GAPA(C0=__builtin_amdgcn_mfma_f32_32x32x16_bf16(kf[2],qr[1],C0,0,0,0),   P0[10],P0[11],P0[12],P0[13], pw1[0]=PKW(P0,8), pw1[1]=PKW(P0,10), pw1); \
    VRD(5); SBAR(); GAPA(C1=__builtin_amdgcn_mfma_f32_32x32x16_bf16(kf[3],qr[1],C1,0,0,0),   P0[14],P0[15],P1[0],P1[1],   pw1[2]=PKW(P0,12),pw1[3]=PKW(P0,14), pw1); \
    VRD(2); SBAR(); GAPA(C0=__builtin_amdgcn_mfma_f32_32x32x16_bf16(kf[4],qr[2],C0,0,0,0),   P1[2],P1[3],P1[4],P1[5],     pw2[0]=PKW(P1,0), pw2[1]=PKW(P1,2), pw2); \
    VRD(6); SBAR(); GAPA(C1=__builtin_amdgcn_mfma_f32_32x32x16_bf16(kf[5],qr[2],C1,0,0,0),   P1[6],P1[7],P1[8],P1[9],     pw2[2]=PKW(P1,4), pw2[3]=PKW(P1,6), pw2); \
    VRD(3); SBAR(); GAPA(C0=__builtin_amdgcn_mfma_f32_32x32x16_bf16(kf[6],qr[3],C0,0,0,0),   P1[10],P1[11],P1[12],P1[13], pw3[0]=PKW(P1,8), pw3[1]=PKW(P1,10), pw3); \
    VRD(7); SBAR(); GAPA(C1=__builtin_amdgcn_mfma_f32_32x32x16_bf16(kf[7],qr[3],C1,0,0,0),   P1[14],P1[15],0.f,0.f,       pw3[2]=PKW(P1,12),pw3[3]=PKW(P1,14), pw3); \
    l_reg+=sacc; \
    if(GK){DMA_K((t)+3,sl_cur);} if(GV){DMA_V((t)+1,sl_next);} \
    CMASK(C0,C1,t); \
    { float a=MX3(C0[0],C0[1],C1[0]),b=MX3(C0[2],C0[3],C1[1]); a=MX3(a,C1[2],C1[3]); \
      _Pragma("unroll") for(int r=4;r<16;r+=4){a=MX3(a,C0[r],C0[r+1]);b=MX3(b,C0[r+2],C0[r+3]);a=MX3(a,C1[r],C1[r+1]);b=MX3(b,C1[r+2],C1[r+3]);} \
      float rm=__builtin_fmaxf(a,b); { auto rr=__builtin_amdgcn_permlane32_swap(__float_as_uint(rm),__float_as_uint(rm),false,false); rm=__builtin_fmaxf(__uint_as_float(rr[0]),__uint_as_float(rr[1])); } \
      resc=false; \
      if(__builtin_expect(__any(rm>(float)THRL),0)){ const float dl=__builtin_fmaxf(rm,0.f); mhat+=dl; \
        _Pragma("unroll") for(int r=0;r<16;++r){C0[r]-=dl;C1[r]-=dl;} \
        _Pragma("unroll") for(int r=0;r<16;++r)negm[r]=-mhat; asm volatile("":"+v"(negm)); \
        const float f=__builtin_amdgcn_exp2f(-dl); l_reg*=f; if(hi==0)wsf[r32]=f; resc=true; } } \
    SBAR(); \
    GAPB(o[0]=__builtin_amdgcn_mfma_f32_32x32x16_bf16(PAF(0),VFR(0),o[0],0,0,0), C0,0); \
    GAPB(o[1]=__builtin_amdgcn_mfma_f32_32x32x16_bf16(PAF(0),VFR(4),o[1],0,0,0), C0,4); \
    KRD(GL,0); GAPB(o[0]=__builtin_amdgcn_mfma_f32_32x32x16_bf16(PAF(1),VFR(1),o[0],0,0,0), C0,8); \
    KRD(GL,1); GAPB(o[1]=__builtin_amdgcn_mfma_f32_32x32x16_bf16(PAF(1),VFR(5),o[1],0,0,0), C0,12); \
    KRD(GL,2); GAPB(o[0]=__builtin_amdgcn_mfma_f32_32x32x16_bf16(PAF(2),VFR(2),o[0],0,0,0), C1,0); \
    KRD(GL,3); GAPB(o[1]=__builtin_amdgcn_mfma_f32_32x32x16_bf16(PAF(2),VFR(6),o[1],0,0,0), C1,4); \
    GAPB(o[0]=__builtin_amdgcn_mfma_f32_32x32x16_bf16(PAF(3),VFR(3),o[0],0,0,0), C1,8); \
    GAPB(o[1]=__builtin_amdgcn_mfma_f32_32x32x16_bf16(PAF(3),VFR(7),o[1],0,0,0), C1,12); \
    }while(0)
  int t=1;
  #undef CMASK
  #define CMASK(P0,P1,t) do{}while(0)
  for(;t+5<NT;t+=2){
    STEP(pB0,pB1,pA0,pA1,t,true,true,true);     WAIT_BAR(2); RESC(); ROT();
    STEP(pA0,pA1,pB0,pB1,t+1,true,true,true);   WAIT_BAR(2); RESC(); ROT();
  }
  #undef CMASK
  #define CMASK(P0,P1,t) do{int jb_=(t)-(NT-4); if(jb_>=0)cmask(P0,P1,jb_,qrel,hi);}while(0)
  #define ENDW(tt) do{ if((tt)+3<NT){WAIT_BAR(2);} else if((tt)+2<NT){WAIT_BAR(1);} else {WAIT_BAR(0);} }while(0)
  for(;t+1<NT;t+=2){
    STEP(pB0,pB1,pA0,pA1,t,(t+3<NT),(t+1<NT),(t+1<NT));       ENDW(t);   RESC(); ROT();
    STEP(pA0,pA1,pB0,pB1,t+1,(t+4<NT),(t+2<NT),(t+2<NT));     ENDW(t+1); RESC(); ROT();
  }
  STEP(pB0,pB1,pA0,pA1,NT-1,false,false,false); RESC();
  { float sacc=pB0[0]+pB0[1]; _Pragma("unroll") for(int r=2;r<16;++r)sacc+=pB0[r]; _Pragma("unroll") for(int r=0;r<16;++r)sacc+=pB1[r]; l_reg+=sacc;
    pw0=(u32x4){PKW(pB0,0),PKW(pB0,2),PKW(pB0,4),PKW(pB0,6)};pw1=(u32x4){PKW(pB0,8),PKW(pB0,10),PKW(pB0,12),PKW(pB0,14)};pw2=(u32x4){PKW(pB1,0),PKW(pB1,2),PKW(pB1,4),PKW(pB1,6)};pw3=(u32x4){PKW(pB1,8),PKW(pB1,10),PKW(pB1,12),PKW(pB1,14)};
    SBAR(); pv(o,vb0+sl_cur,PAF(0),PAF(1),PAF(2),PAF(3)); }
  #undef PKW
  #undef PAF
  #undef VFR
  #undef PIN
  #undef MX3
  #undef GAPA
  #undef GAPB
  #undef EX
  #undef VRD
  #undef KRD
  #undef STEP
  #undef ENDW
  {auto rr=__builtin_amdgcn_permlane32_swap(__float_as_uint(l_reg),__float_as_uint(l_reg),false,false);l_reg=__uint_as_float(rr[0])+__uint_as_float(rr[1]);}
  if(hi==0)wsf[32+r32]=l_reg;asm volatile("s_waitcnt lgkmcnt(0)":::"memory");
  float rli[16];
  #pragma unroll
  for(int r=0;r<16;++r)rli[r]=__builtin_amdgcn_rcpf(wsf[32+crow(r,hi)]);
  bf16*Ow=O+(rowbase+q0+wid*QBLK)*DM+h*D;
  { bf16*stg=(bf16*)(shm+LDS_OST)+wid*2048;
    #pragma unroll
    for(int r=0;r<16;++r){const int orow=crow(r,hi);
      #pragma unroll
      for(int d0=0;d0<2;++d0)stg[orow*64+d0*32+r32]=__float2bfloat16(o[d0][r]*rli[r]);}
    asm volatile("s_waitcnt lgkmcnt(0)":::"memory");
    #pragma unroll
    for(int i=0;i<4;++i){const int row=i*8+(lane>>3),ch=lane&7; const u32x4 v=*(const u32x4*)(stg+row*64+ch*8); ATTN_STORE16(Ow+(long)row*DM+ch*8,v);} }
  asm volatile("s_waitcnt lgkmcnt(0)\n\ts_barrier":::"memory");
  #undef CINIT
  #undef DMA_K
  #undef DMA_V
  #undef CMASK
  #undef START
  #undef RESC
  #undef ROT
}
constexpr int ATTN_LDS_BYTES=LDS_BYTES;
#undef SBAR
#undef WAIT_BAR
}

constexpr int PH_PER_LAYER = 10, N_PHASES = PH_PER_LAYER * DEPTH;

__global__ void __launch_bounds__(NWAVES * 64, 2) fwd(Args args) {
    extern __shared__ __attribute__((aligned(16))) unsigned char lds[];
    Frame F;
    F.lds = (LAS unsigned char*)lds;
    F.tid = threadIdx.x; F.lane = F.tid & 63; F.wave = __builtin_amdgcn_readfirstlane(F.tid >> 6);
    const int wave0 = F.wave;
    for (int u = F.tid; u < (LDS_BYTES - LDSCTL_OFF) / 4; u += NWAVES * 64) ((LAS unsigned*)(F.lds + LDSCTL_OFF))[u] = 0u;
    __syncthreads();
    const int ph_lo = args.ph_lo, ph_hi = args.ph_hi;
    if (ph_hi - ph_lo > 1) (void)xcd_barrier_post((unsigned*)(args.ws + WS_CTL) + CW_BAR, (volatile LAS unsigned*)(F.lds + MISC_OFF) + 8);

    for (int ph = ph_lo; ph < ph_hi; ++ph) {
        const int l = ph / PH_PER_LAYER, p = ph % PH_PER_LAYER;
        const __attribute__((address_space(4))) Args* ap = (const __attribute__((address_space(4))) Args*)__builtin_amdgcn_kernarg_segment_ptr();
        asm volatile("" : "+s"(ap));
        { int t_ = wave0 * 64 + (int)__builtin_amdgcn_mbcnt_hi(~0u, __builtin_amdgcn_mbcnt_lo(~0u, 0u)); asm volatile("" : "+v"(t_)); F.tid = t_; F.lane = t_ & 63; F.wave = __builtin_amdgcn_readfirstlane(t_ >> 6); }
        F.G = gridDim.x; { const int bx = blockIdx.x; F.vcu = (F.G % 8 == 0) ? (bx % 8) * (F.G / 8) + bx / 8 : bx; }
        unsigned char* ws = ap->ws; float* out = ap->out;
        bf16* bufa = (bf16*)(ws + WS_BUFA); bf16* bufb = (bf16*)(ws + WS_BUFB); bf16* xb = (bf16*)(ws + WS_XB); bf16* proj = (bf16*)(ws + WS_PROJ);
        float* smallp = (float*)(ws + WS_SMALLP); float* ssq = (float*)(ws + WS_SSQ);
        const float* xin = (l == 0) ? ap->in[0] : out;
        switch (p) {
        case 0: {
            convert_weights(F, 0, ap->in[2] + (size_t)l * DM * P_IN, ap->in[16] + (size_t)l * DMIX * DM, bufa, bufb, (LAS float*)(F.lds + F.wave * 16384));
            __syncthreads();
            row_pass(F, xin, ap->in[1] + l * DM, xb, ap->in[2] + (size_t)l * DM * P_IN, smallp, (LAS float*)(F.lds));
        } break;
        case 1: {
            pg8::Gemm g{xb, bufa, M, PLD, DM, DM}; pg8::StaticOrder S; S.init(M, PLD, F.G, (int)blockIdx.x);
            pg8::EpiProj E{proj, ap->in[3] + l * 64, ap->in[4] + l * 64, (float*)(ws + WS_KSUM + (size_t)l * 131072), (bf16*)(ws + WS_HALO)};
            pg8::gemm_phase<pg8::EpiProj>(F.lds + RING_OFF, g, S, E, F.tid);
        } break;
        case 2: conv_phase(F, proj, (const bf16*)(ws + WS_HALO), ap->in[5] + (size_t)l * 4 * 1536, ap->in[6] + l * 1536, ap->in[11] + (size_t)l * 4 * 1024, ap->in[12] + l * 1024); break;
        case 3: {
            gu32* qhead = (gu32*)(ws + WS_QUEUE) + l * 64;
            volatile LAS unsigned* MISC = (volatile LAS unsigned*)(F.lds + MISC_OFF);
            const attn_body::bf16* pq = (const attn_body::bf16*)proj; const float* ks = (const float*)(ws + WS_KSUM + (size_t)l * 131072);
            for (;;) {
                __syncthreads();
                if (F.tid == 0) MISC[0] = __hip_atomic_fetch_add(qhead, 1u, RLX_AGENT);
                __syncthreads();
                const int u = (int)MISC[0];
                if (u >= 672) break;
                if (u < 32) mlstm_unit(F.tid, proj, smallp, ap->in[13] + l * 4, ap->in[14] + l * 4, ap->in[15] + l * 512, u >> 2, u & 3, F.lds);
                else if (u < 160) ssd_unit(F.tid, proj, smallp, ssq, ap->in[7] + l * 16, ap->in[8] + l * 16, ap->in[9] + l * 16, (u - 32) >> 4, (u - 32) & 15, F.lds);
                else { const int idx = u - 160, bh = idx & 63, qb = 7 - (idx >> 6);
                    attn_body::attn_unit<8>(F.tid, bh >> 3, bh & 7, qb, pq + PC_Q, pq + PC_K, pq + PC_V, (attn_body::bf16*)proj + PC_Q, ks, (char*)F.lds); }
            }
        } break;
        case 4: ssd_finalize(F, proj, ssq, ap->in[10] + l * 1024); break;
        case 5: {
            pg8::Gemm g{proj, bufb, M, DM, DMIX, PLD}; pg8::StaticOrder S; S.init(M, DM, F.G, (int)blockIdx.x);
            pg8::EpiRes E{xin, out, DM};
            pg8::gemm_phase<pg8::EpiRes>(F.lds + RING_OFF, g, S, E, F.tid);
        } break;
        case 6: {
            convert_weights(F, 1, ap->in[18] + (size_t)l * DM * ULD, ap->in[21] + (size_t)l * FFN * DM, bufa, bufb, (LAS float*)(F.lds + F.wave * 16384));
            __syncthreads();
            row_pass(F, out, ap->in[17] + l * DM, xb, nullptr, nullptr, nullptr);
        } break;
        case 7: {
            pg8::Gemm g{xb, bufa, M, ULD, DM, DM}; pg8::StaticOrder S; S.init(M, ULD, F.G, (int)blockIdx.x);
            pg8::EpiBf16 E{proj, ULD};
            pg8::gemm_phase<pg8::EpiBf16>(F.lds + RING_OFF, g, S, E, F.tid);
        } break;
        case 8: ffn_ew(F, proj, ap->in[19] + (size_t)l * 3 * FFN, ap->in[20] + l * FFN); break;
        case 9: {
            pg8::Gemm g{proj + FFN, bufb, M, DM, FFN, ULD}; pg8::StaticOrder S; S.init(M, DM, F.G, (int)blockIdx.x);
            pg8::EpiRes E{out, out, DM};
            pg8::gemm_phase<pg8::EpiRes>(F.lds + RING_OFF, g, S, E, F.tid);
        } break;
        }
        if (ph + 1 < ph_hi) { XcdBarrier bar; bar.bar = (unsigned*)(ap->ws + WS_CTL) + CW_BAR; bar.x = xb_xcc_id(); bar.st = (volatile LAS unsigned*)(F.lds + MISC_OFF) + 8; xcd_barrier(bar, F.tid); }
    }
}

extern "C" void kernel_launch(void* const* d_in, const int* in_sizes, int n_in, void* d_out, int out_size, void* d_ws, size_t ws_size, hipStream_t stream) {
    static int grid = 0;
    if (grid == 0) {
        if (n_in != 22 || in_sizes[0] != M * DM || out_size != M * DM || ws_size < WS_END) { fprintf(stderr, "kernel_launch: unexpected shapes (n_in %d, in0 %d, out %d, ws %zu); nothing launched\n", n_in, n_in > 0 ? in_sizes[0] : -1, out_size, ws_size); grid = -1; return; }
        int dev = 0, cus = 0, per_cu = 0;
        if (hipGetDevice(&dev) != hipSuccess || hipDeviceGetAttribute(&cus, hipDeviceAttributeMultiprocessorCount, dev) != hipSuccess) { grid = -1; return; }
        if (hipFuncSetAttribute((const void*)fwd, hipFuncAttributeMaxDynamicSharedMemorySize, LDS_BYTES) != hipSuccess) { fprintf(stderr, "kernel_launch: hipFuncSetAttribute failed\n"); grid = -1; return; }
        if (hipOccupancyMaxActiveBlocksPerMultiprocessor(&per_cu, (const void*)fwd, NWAVES * 64, LDS_BYTES) != hipSuccess || per_cu < 1) { fprintf(stderr, "kernel_launch: occupancy query reports %d blocks per CU\n", per_cu); per_cu = 1; }
        (void)hipGetLastError();
        grid = cus;
    }
    if (grid < 0) return;
    (void)hipMemsetAsync((char*)d_ws + WS_CTL, 0, CTL_ZERO_BYTES, stream);
    Args a{};
    for (int i = 0; i < 22; ++i) a.in[i] = (const float*)d_in[i];
    a.out = (float*)d_out; a.ws = (unsigned char*)d_ws;
#if MK_MULTI
    for (int ph = 0; ph < N_PHASES; ++ph) {
        a.ph_lo = ph; a.ph_hi = ph + 1;
        hipLaunchKernelGGL(fwd, dim3(grid), dim3(NWAVES * 64), LDS_BYTES, stream, a);
    }
#else
    a.ph_lo = 0; a.ph_hi = N_PHASES;
    hipLaunchKernelGGL(fwd, dim3(grid), dim3(NWAVES * 64), LDS_BYTES, stream, a);
#endif
}
```

```cpp
#include <hip/hip_runtime.h>
#include <hip/hip_bf16.h>
#include <cstdio>
#include <cstdint>
#include <cmath>

#ifndef PROBE_PHASE
#define PROBE_PHASE -1
#endif
#ifndef PROBE_GAIN
#define PROBE_GAIN 1e-6f
#endif
#ifndef MK_MULTI
#define MK_MULTI 0
#endif

constexpr int BATCH = 8, SEQ = 2048, DM = 1024, DEPTH = 2;
constexpr int M = BATCH * SEQ;
constexpr int P_IN = 6168;
constexpr int PLD = 6144;
constexpr int PC_Q = 0, PC_Z = 512, PC_MO = 1536, PC_K = 2048, PC_V = 2560, PC_XBC = 3072, PC_MQK = 4608, PC_MV = 5632;
constexpr int SC_Q = 0, SC_K = 512, SC_V = 1024, SC_Z = 1536, SC_XBC = 2560, SC_DT = 4096, SC_MQK = 4112, SC_MV = 5136, SC_MO = 5648, SC_MI = 6160, SC_MF = 6164;
constexpr int FFN = 2816, ULD = 5632;
constexpr int DMIX = 2048;
constexpr float EPS = 1e-6f;
constexpr float C2 = 0.125f * 1.4426950408889634f;

constexpr size_t MiB = 1u << 20;
constexpr size_t WS_CTL = 0, CTL_ZERO_BYTES = 1 * MiB;
constexpr size_t WS_KSUM = 256 * 1024;
constexpr size_t WS_TS = 800 * 1024;
constexpr size_t WS_RS = 512 * 1024;
constexpr size_t WS_QUEUE = 768 * 1024;
constexpr size_t WS_SMALLP = 1 * MiB;
constexpr size_t WS_SSQ = 3 * MiB - 512 * 1024;
constexpr size_t WS_WSM = 3 * MiB + 512 * 1024;
constexpr size_t WS_BUFA = 4 * MiB;
constexpr size_t WS_BUFB = 16 * MiB;
constexpr size_t WS_XB = 22 * MiB;
constexpr size_t WS_HALO = 54 * MiB;
constexpr size_t WS_GSC = 58 * MiB;
constexpr size_t WS_SIDEA = 54 * MiB;
constexpr size_t WS_SIDEB = 57 * MiB;
static_assert(true, "EpiProj hard-codes WS_PROJ = 64 MiB, WS_HALO = 54 MiB, WS_KSUM = 256 KiB, WS_RS = 512 KiB");
constexpr size_t WS_PROJ = 64 * MiB;
constexpr size_t WS_END = 256 * MiB;

namespace pg8 {
#define PG8_LAS __attribute__((address_space(3)))
typedef unsigned short bf16_t;
typedef short bf16x8 __attribute__((ext_vector_type(8)));
typedef float f32x4 __attribute__((ext_vector_type(4)));
typedef unsigned u32x4 __attribute__((ext_vector_type(4)));
constexpr int BM = 256, BK = 64, HALF = 128, HTB = HALF * BK * 2, STAGE_BYTES = 8 * HTB, NXCD = 8, WGM = 8;

__host__ __device__ __forceinline__ int lds_byte(int r, int c) { const int st = (r >> 4) * 2 + (c >> 5), rr = r & 15, cc = c & 31, ob = rr * 64 + cc * 2; return st * 1024 + (ob ^ (((ob >> 9) & 1) << 5)); }
__host__ __device__ __forceinline__ void stage_rc(int b, int& R, int& C) { const int st = b / 1024, sb = b % 1024, swz = sb ^ (((sb >> 9) & 1) << 5); R = (st >> 1) * 16 + swz / 64; C = (st & 1) * 32 + (swz % 64) / 2; }
__host__ __device__ __forceinline__ int perm32(int rho) { const int n = rho >> 4, i = rho & 15; return 8 * (i >> 2) + 4 * n + (i & 3); }

struct Unit { int pm, pn; };
struct Gemm { const bf16_t* A; const bf16_t* Bt; int M, N, K, lda; };

struct StaticOrder {
    int nM, nN, nwg, G, c;
    __host__ __device__ void init(int M_, int N_, int G_, int c_) { nM = M_ / BM; nN = N_ / BM; nwg = nM * nN; G = G_; c = c_; }
    __host__ __device__ bool next(int i, Unit& u) const {
        const long L = (long)i * G + c; if (L >= nwg) return false;
        int wgid = (int)L; { const int q = nwg / NXCD, r = nwg % NXCD, xcd = wgid % NXCD, off = wgid / NXCD; wgid = (xcd < r ? xcd * (q + 1) : r * (q + 1) + (xcd - r) * q) + off; }
        const int nig = WGM * nN, gid = wgid / nig, fm = gid * WGM, gsz = (nM - fm) < WGM ? (nM - fm) : WGM;
        u.pm = fm + ((wgid % nig) % gsz); u.pn = (wgid % nig) / gsz; return true;
    }
};

typedef float f32x2p __attribute__((ext_vector_type(2))); typedef __bf16 bf16x2p __attribute__((ext_vector_type(2)));
__device__ __forceinline__ unsigned cvt_pk_bf16(float lo, float hi) { const f32x2p v = {lo, hi}; return __builtin_bit_cast(unsigned, __builtin_convertvector(v, bf16x2p)); }

struct EpiBf16 {
    static constexpr bool PERM = true;
    bf16_t* O; int ldc;
    __device__ __forceinline__ void operator()(const f32x4 (&acc)[2][2][4][2], const Unit& u, int wr, int wc, int fr, int fq) const {
        const int row0 = u.pm * BM + wr * 64 + fr; const int col0 = u.pn * BM + wc * 32 + 8 * fq;
#pragma unroll
        for (int ai = 0; ai < 2; ++ai)
#pragma unroll
            for (int m = 0; m < 4; ++m) { bf16_t* rowp = O + (size_t)(row0 + ai * HALF + m * 16) * ldc + col0;
#pragma unroll
                for (int bj = 0; bj < 2; ++bj) { const f32x4 v0 = acc[ai][bj][m][0], v1 = acc[ai][bj][m][1];
                    u32x4 w; w.x = cvt_pk_bf16(v0[0], v0[1]); w.y = cvt_pk_bf16(v0[2], v0[3]); w.z = cvt_pk_bf16(v1[0], v1[1]); w.w = cvt_pk_bf16(v1[2], v1[3]);
                    *(u32x4*)(rowp + bj * HALF) = w; } }
    }
};
__device__ __forceinline__ float row_prev(float prevblk, float cur, int n  ) {
    const int pb = __float_as_int(prevblk), cu = __float_as_int(cur);
    const int o = (n == 1) ? __builtin_amdgcn_update_dpp(0, pb, 0x121, 0xf, 0xf, false) : (n == 2) ? __builtin_amdgcn_update_dpp(0, pb, 0x122, 0xf, 0xf, false) : __builtin_amdgcn_update_dpp(0, pb, 0x123, 0xf, 0xf, false);
    return __int_as_float((n == 1) ? __builtin_amdgcn_update_dpp(o, cu, 0x111, 0xf, 0xf, false) : (n == 2) ? __builtin_amdgcn_update_dpp(o, cu, 0x112, 0xf, 0xf, false) : __builtin_amdgcn_update_dpp(o, cu, 0x113, 0xf, 0xf, false));
}
struct EpiProj {
    static constexpr bool PERM = true;
    unsigned char* ws; const float* const __attribute__((address_space(4)))* in; int l;
    __device__ __forceinline__ void operator()(const f32x4 (&acc)[2][2][4][2], const Unit& u, int wr, int wc, int fr, int fq) const {
        bf16_t* P = (bf16_t*)(ws + (size_t)64 * 1048576); bf16_t* halo = (bf16_t*)(ws + (size_t)54 * 1048576);
        const float* rs = (const float*)(ws + 524288) + (size_t)(2 * l) * 16384;
        const float* qw = in[3] + l * 64; const float* kw = in[4] + l * 64;
        const float* scw = in[5] + (size_t)l * 4 * 1536; const float* scb = in[6] + l * 1536; const float* mcw = in[11] + (size_t)l * 4 * 1024; const float* mcb = in[12] + l * 1024;
        const int pn = u.pn; const bool isq = pn < 2, isk = (pn == 8 || pn == 9);
        const int row0 = u.pm * BM + wr * 64 + fr;
        float rr[2][4];
#pragma unroll
        for (int ai = 0; ai < 2; ++ai)
#pragma unroll
            for (int m = 0; m < 4; ++m) rr[ai][m] = rs[row0 + ai * HALF + m * 16];
#pragma unroll
        for (int ai = 0; ai < 2; ++ai)
#pragma unroll
            for (int m = 0; m < 4; ++m) rr[ai][m] = 1.0f / sqrtf(rr[ai][m] * (1.0f / 1024.0f) + EPS);
        if (pn >= 12 && pn < 22) {
            const int col0 = pn * BM + wc * 32 + 8 * fq;
            const bool ssm = pn < 18; const float post = (pn >= 20) ? 0.08838834764831845f : 1.0f; const int wst = ssm ? 1536 : 1024;
#pragma unroll
            for (int bj = 0; bj < 2; ++bj) {
                const int hch = col0 + bj * HALF - PC_XBC; const float* wp = ssm ? (scw + hch) : (mcw + (hch - 1536)); const float* bp = ssm ? (scb + hch) : (mcb + (hch - 1536));
                f32x4 cwv[4][2], cbv[2];
#pragma unroll
                for (int j = 0; j < 4; ++j) { cwv[j][0] = *(const f32x4*)(wp + j * wst); cwv[j][1] = *(const f32x4*)(wp + j * wst + 4); }
                cbv[0] = *(const f32x4*)bp; cbv[1] = *(const f32x4*)(bp + 4);
#pragma unroll
                for (int ai = 0; ai < 2; ++ai) {
                    f32x4 gp[2] = {(f32x4){0.f, 0.f, 0.f, 0.f}, (f32x4){0.f, 0.f, 0.f, 0.f}};
#pragma unroll
                    for (int m = 0; m < 4; ++m) { const int row = row0 + ai * HALF + m * 16;
                        f32x4 g[2]; g[0] = acc[ai][bj][m][0] * rr[ai][m]; g[1] = acc[ai][bj][m][1] * rr[ai][m];
                        u32x4 raw, cv;
#pragma unroll
                        for (int n = 0; n < 2; ++n)
#pragma unroll
                            for (int i2 = 0; i2 < 2; ++i2) { float y[2];
#pragma unroll
                                for (int e = 0; e < 2; ++e) { const int i = 2 * i2 + e; const float x1 = row_prev(gp[n][i], g[n][i], 1), x2 = row_prev(gp[n][i], g[n][i], 2), x3 = row_prev(gp[n][i], g[n][i], 3);
                                    const float a = cbv[n][i] + cwv[0][n][i] * x3 + cwv[1][n][i] * x2 + cwv[2][n][i] * x1 + cwv[3][n][i] * g[n][i];
                                    y[e] = a * __builtin_amdgcn_rcpf(1.0f + __builtin_amdgcn_exp2f(-1.4426950408889634f * a)) * post; }
                                cv[2 * n + i2] = cvt_pk_bf16(y[0], y[1]); raw[2 * n + i2] = cvt_pk_bf16(g[n][2 * i2], g[n][2 * i2 + 1]); }
                        *(u32x4*)(P + (size_t)row * PLD + col0 + bj * HALF) = (m == 0 && fr < 3) ? raw : cv;
                        if (m == 3 && fr >= 13) *(u32x4*)(halo + ((size_t)((row >> 6) * 3 + fr - 13) * 2560 + hch)) = raw;
                        gp[0] = g[0]; gp[1] = g[1]; }
                }
            }
        } else if (!(isq || isk)) {
            const int col0 = pn * BM + wc * 32 + 8 * fq;
#pragma unroll
            for (int ai = 0; ai < 2; ++ai)
#pragma unroll
                for (int m = 0; m < 4; ++m) { bf16_t* rowp = P + (size_t)(row0 + ai * HALF + m * 16) * PLD + col0;
#pragma unroll
                    for (int bj = 0; bj < 2; ++bj) { const f32x4 v0 = acc[ai][bj][m][0] * rr[ai][m], v1 = acc[ai][bj][m][1] * rr[ai][m];
                        u32x4 w; w.x = cvt_pk_bf16(v0[0], v0[1]); w.y = cvt_pk_bf16(v0[2], v0[3]); w.z = cvt_pk_bf16(v1[0], v1[1]); w.w = cvt_pk_bf16(v1[2], v1[3]);
                        *(u32x4*)(rowp + bj * HALF) = w;
                    } }
        } else {
            const float* w = isq ? qw : kw; const float post = isq ? C2 : 1.0f;
            const int colb = pn * BM + 64 * wc + 8 * fq;
#pragma unroll
            for (int ai = 0; ai < 2; ++ai)
#pragma unroll
                for (int m = 0; m < 4; ++m) {
                    float ss = 0.f;
#pragma unroll
                    for (int bj = 0; bj < 2; ++bj)
#pragma unroll
                        for (int n = 0; n < 2; ++n) { const f32x4 x = acc[ai][bj][m][n] * rr[ai][m]; ss += (x[0] * x[0] + x[1] * x[1]) + (x[2] * x[2] + x[3] * x[3]); }
                    ss += __shfl_xor(ss, 16); ss += __shfl_xor(ss, 32);
                    const float r = (1.0f / sqrtf(ss * (1.0f / 64.0f) + EPS)) * post * rr[ai][m];
                    bf16_t* rowp = P + (size_t)(row0 + ai * HALF + m * 16) * PLD + colb;
#pragma unroll
                    for (int bj = 0; bj < 2; ++bj) { const f32x4 w0 = *(const f32x4*)(w + 32 * bj + 8 * fq), w1 = *(const f32x4*)(w + 32 * bj + 8 * fq + 4);
                        const f32x4 v0 = acc[ai][bj][m][0] * r * w0, v1 = acc[ai][bj][m][1] * r * w1;
                        u32x4 o; o.x = cvt_pk_bf16(v0[0], v0[1]); o.y = cvt_pk_bf16(v0[2], v0[3]); o.z = cvt_pk_bf16(v1[0], v1[1]); o.w = cvt_pk_bf16(v1[2], v1[3]);
                        *(u32x4*)(rowp + 32 * bj) = o; }
                    asm volatile("" ::: "memory");
                }
        }
    }
};
struct EpiRes {
    static constexpr bool PERM = true;
    bf16_t* xb; float* out; float* rs;
    __device__ __forceinline__ void operator()(const f32x4 (&acc)[2][2][4][2], const Unit& u, int wr, int wc, int fr, int fq) const {
        const int row0 = u.pm * BM + wr * 64 + fr, col0 = u.pn * BM + wc * 32 + 8 * fq;
#pragma unroll
        for (int ai = 0; ai < 2; ++ai)
#pragma unroll
            for (int m = 0; m < 4; ++m) { const int row = row0 + ai * HALF + m * 16; const size_t off = (size_t)row * 1024 + col0; float ss = 0.f;
#pragma unroll
                for (int bj = 0; bj < 2; ++bj) { const u32x4 bw = *(const u32x4*)(xb + off + bj * HALF);
                    f32x4 v0 = acc[ai][bj][m][0], v1 = acc[ai][bj][m][1];
                    v0[0] += __uint_as_float(bw.x << 16); v0[1] += __uint_as_float(bw.x & 0xffff0000u); v0[2] += __uint_as_float(bw.y << 16); v0[3] += __uint_as_float(bw.y & 0xffff0000u);
                    v1[0] += __uint_as_float(bw.z << 16); v1[1] += __uint_as_float(bw.z & 0xffff0000u); v1[2] += __uint_as_float(bw.w << 16); v1[3] += __uint_as_float(bw.w & 0xffff0000u);
                    if (out) { *(f32x4*)(out + off + bj * HALF) = v0; *(f32x4*)(out + off + bj * HALF + 4) = v1; }
                    else { ss += ((v0[0] * v0[0] + v0[1] * v0[1]) + (v0[2] * v0[2] + v0[3] * v0[3])) + ((v1[0] * v1[0] + v1[1] * v1[1]) + (v1[2] * v1[2] + v1[3] * v1[3]));
                        u32x4 w; w.x = cvt_pk_bf16(v0[0], v0[1]); w.y = cvt_pk_bf16(v0[2], v0[3]); w.z = cvt_pk_bf16(v1[0], v1[1]); w.w = cvt_pk_bf16(v1[2], v1[3]);
                        *(u32x4*)(xb + off + bj * HALF) = w; } }
                if (!out) { ss += __shfl_xor(ss, 16); ss += __shfl_xor(ss, 32); if (fq == 0) atomicAdd(rs + row, ss); }
                asm volatile("" ::: "memory"); }
    }
};
struct EpiScaleBf16 {
    static constexpr bool PERM = true;
    bf16_t* O; int ldc; const float* rs;
    __device__ __forceinline__ void operator()(const f32x4 (&acc)[2][2][4][2], const Unit& u, int wr, int wc, int fr, int fq) const {
        const int row0 = u.pm * BM + wr * 64 + fr; const int col0 = u.pn * BM + wc * 32 + 8 * fq;
        float rr[2][4];
#pragma unroll
        for (int ai = 0; ai < 2; ++ai)
#pragma unroll
            for (int m = 0; m < 4; ++m) rr[ai][m] = rs[row0 + ai * HALF + m * 16];
#pragma unroll
        for (int ai = 0; ai < 2; ++ai)
#pragma unroll
            for (int m = 0; m < 4; ++m) { bf16_t* rowp = O + (size_t)(row0 + ai * HALF + m * 16) * ldc + col0; const float r = 1.0f / sqrtf(rr[ai][m] * (1.0f / 1024.0f) + EPS);
#pragma unroll
                for (int bj = 0; bj < 2; ++bj) { const f32x4 v0 = acc[ai][bj][m][0] * r, v1 = acc[ai][bj][m][1] * r;
                    u32x4 w; w.x = cvt_pk_bf16(v0[0], v0[1]); w.y = cvt_pk_bf16(v0[2], v0[3]); w.z = cvt_pk_bf16(v1[0], v1[1]); w.w = cvt_pk_bf16(v1[2], v1[3]);
                    *(u32x4*)(rowp + bj * HALF) = w; } }
    }
};

typedef float f32x2q __attribute__((ext_vector_type(2)));
__device__ __forceinline__ f32x2q gelu_pk2(f32x2q v) {
    const f32x2q av = __builtin_elementwise_abs(v), d = av * 0.2316418882f + 1.0f;
    f32x2q t; t.x = __builtin_amdgcn_rcpf(d.x); t.y = __builtin_amdgcn_rcpf(d.y);
    f32x2q q = t * 0.5307027145f + (-0.7265760135f); q = q * t + 0.7107068705f; q = q * t + (-0.142248368f); q = q * t + 0.127414796f; q = q * t;
    const f32x2q s = (v * v) * (-0.72134752044f);
    f32x2q e; e.x = __builtin_amdgcn_exp2f(s.x); e.y = __builtin_amdgcn_exp2f(s.y);
    const f32x2q m = v * (q * e), r = v - m;
    f32x2q o; o.x = v.x < 0.f ? m.x : r.x; o.y = v.y < 0.f ? m.y : r.y; return o;
}
struct EpiFfn {
    static constexpr bool PERM = true;
    bf16_t* H; const float* rs; const float* cw  ; const float* cb; bf16_t* sideA  ; bf16_t* sideB  ;
    __device__ __forceinline__ void operator()(const f32x4 (&acc)[2][2][4][2], const Unit& u, int wr, int wc, int fr, int fq) const {
        constexpr int FF = 2816;
        const int row0 = u.pm * BM + wr * 64 + fr, c0 = u.pn * 128 + wc * 32 + 8 * fq;
        float rr[2][4];
#pragma unroll
        for (int ai = 0; ai < 2; ++ai)
#pragma unroll
            for (int m = 0; m < 4; ++m) rr[ai][m] = rs[row0 + ai * HALF + m * 16];
        f32x4 w0[2], w1[2], w2[2], bb[2];
#pragma unroll
        for (int n = 0; n < 2; ++n) { w0[n] = *(const f32x4*)(cw + c0 + 4 * n); w1[n] = *(const f32x4*)(cw + FF + c0 + 4 * n); w2[n] = *(const f32x4*)(cw + 2 * FF + c0 + 4 * n); bb[n] = *(const f32x4*)(cb + c0 + 4 * n); }
#pragma unroll
        for (int ai = 0; ai < 2; ++ai) {
            f32x4 gp[2] = {(f32x4){0.f, 0.f, 0.f, 0.f}, (f32x4){0.f, 0.f, 0.f, 0.f}};
#pragma unroll
            for (int m = 0; m < 4; ++m) {
                const int row = row0 + ai * HALF + m * 16; const float r = 1.0f / sqrtf(rr[ai][m] * (1.0f / 1024.0f) + EPS);
                f32x4 g[2], v[2]; u32x4 hw, gw, vw;
#pragma unroll
                for (int n = 0; n < 2; ++n) { g[n] = acc[ai][0][m][n] * r; v[n] = acc[ai][1][m][n] * r; }
#pragma unroll
                for (int n = 0; n < 2; ++n)
#pragma unroll
                    for (int i2 = 0; i2 < 2; ++i2) { f32x2q x;
#pragma unroll
                        for (int e = 0; e < 2; ++e) { const int i = 2 * i2 + e; const float x1 = row_prev(gp[n][i], g[n][i], 1), x2 = row_prev(gp[n][i], g[n][i], 2);
                            x[e] = bb[n][i] + w0[n][i] * x2 + w1[n][i] * x1 + w2[n][i] * g[n][i]; }
                        const f32x2q ge = gelu_pk2(x);
                        hw[2 * n + i2] = cvt_pk_bf16(ge.x * v[n][2 * i2], ge.y * v[n][2 * i2 + 1]);
                        gw[2 * n + i2] = cvt_pk_bf16(g[n][2 * i2], g[n][2 * i2 + 1]); vw[2 * n + i2] = cvt_pk_bf16(v[n][2 * i2], v[n][2 * i2 + 1]); }
                *(u32x4*)(H + (size_t)row * FF + c0) = hw;
                if (m == 3 && fr >= 14) *(u32x4*)(sideA + ((size_t)(row >> 6) * 2 + (fr - 14)) * FF + c0) = gw;
                if (m == 0 && fr < 2) { bf16_t* sb = sideB + ((size_t)(row >> 6) * 2 + fr) * 2 * FF + c0; *(u32x4*)sb = gw; *(u32x4*)(sb + FF) = vw; }
                gp[0] = g[0]; gp[1] = g[1];
            }
        }
    }
};

#define PG8_KT(i) (KMODE ? ((i) < 16 ? (i) + 8 : ((i) < 24 ? (i) - 16 : (i))) : (i))
template <class Epi, int KMODE = 0>
__device__ __forceinline__ void gemm_phase(PG8_LAS unsigned char* lds, const Gemm g, const StaticOrder& S, const Epi& E, int tid_, const PG8_LAS float* ftab = nullptr) {
    asm volatile("" : "+v"(tid_));
    const int tid = tid_, wid = __builtin_amdgcn_readfirstlane(tid >> 6), lane = tid & 63, wr = wid >> 2, wc = wid & 3, fr = lane & 15, fq = lane >> 4;
    const int K = g.K, nt = K / BK, lda = g.lda;
    unsigned voffA[2], voffB[2];
#pragma unroll
    for (int i = 0; i < 2; ++i) { int R, C; stage_rc(tid * 16 + i * 8192, R, C); const int Rb = Epi::PERM ? ((R & ~31) + perm32(R & 31)) : R;
        voffA[i] = (unsigned)(R * lda + C) * 2u; voffB[i] = (unsigned)(Rb * K + C) * 2u; }
    const size_t kstep = (size_t)(BK * 2);
    const size_t hstepA = (size_t)HALF * lda * 2, hstepB = (size_t)HALF * K * 2;
    const size_t tstepA = 2 * hstepA, tstepB = 2 * hstepB;
    const unsigned ldsw = (unsigned)wid * 1024u;
    const int aoff = lds_byte(wr * 64 + fr, fq * 8), boff = lds_byte(wc * 32 + fr, fq * 8);
#define PG8_SA(b, h) (((b) * 2 + (h)) * HTB)
#define PG8_SB(b, h) ((4 + (b) * 2 + (h)) * HTB)
#define PG8_STAGE(bufoff, gbase, voff) do { _Pragma("unroll") for (int _i = 0; _i < 2; ++_i) \
        __builtin_amdgcn_global_load_lds((const unsigned*)((const char*)(gbase) + (voff)[_i]), (PG8_LAS unsigned*)(lds + (bufoff) + ldsw + _i * 8192), 16, 0, 0); } while (0)
#define PG8_LDA(dst, b, h) do { _Pragma("unroll") for (int m = 0; m < 4; ++m) _Pragma("unroll") for (int k = 0; k < 2; ++k) dst[m][k] = *(const PG8_LAS bf16x8*)(lds + PG8_SA(b, h) + aoff + m * 2048 + k * 1024); } while (0)
#define PG8_LDB(dst, b, h) do { _Pragma("unroll") for (int n = 0; n < 2; ++n) _Pragma("unroll") for (int k = 0; k < 2; ++k) dst[n][k] = *(const PG8_LAS bf16x8*)(lds + PG8_SB(b, h) + boff + n * 2048 + k * 1024); } while (0)
#define PG8_MMA(ai, bj, At, Bt) do { __builtin_amdgcn_s_setprio(1); _Pragma("unroll") for (int m = 0; m < 4; ++m) _Pragma("unroll") for (int n = 0; n < 2; ++n) _Pragma("unroll") for (int k = 0; k < 2; ++k) \
        acc[ai][bj][m][n] = __builtin_amdgcn_mfma_f32_16x16x32_bf16(Bt[n][k], At[m][k], acc[ai][bj][m][n], 0, 0, 0); __builtin_amdgcn_s_setprio(0); } while (0)
#define PG8_WAIT_V(n) asm volatile("s_waitcnt vmcnt(" #n ")" ::: "memory")
#define PG8_WAIT_L(n) asm volatile("s_waitcnt lgkmcnt(" #n ")" ::: "memory")
#define PG8_BAR __builtin_amdgcn_s_barrier()
#define PG8_SCHED __builtin_amdgcn_sched_barrier(0)
    Unit cur, nxt; int ui = 0;
    if (!S.next(0, cur)) return;
    f32x4 acc[2][2][4][2];
#pragma unroll
    for (int a = 0; a < 2; ++a)
#pragma unroll
        for (int b = 0; b < 2; ++b)
#pragma unroll
            for (int m = 0; m < 4; ++m)
#pragma unroll
                for (int n = 0; n < 2; ++n) acc[a][b][m][n] = (f32x4){0.f, 0.f, 0.f, 0.f};
    bf16x8 At[4][2], B0[2][2], B1[2][2];
    const char* cA = (const char*)g.A + (size_t)cur.pm * tstepA; const char* cB = (const char*)g.Bt + (size_t)cur.pn * tstepB;
    { const char* cA0 = cA + (size_t)PG8_KT(0) * kstep; const char* cB0 = cB + (size_t)PG8_KT(0) * kstep;
    PG8_STAGE(PG8_SB(0, 0), cB0, voffB); PG8_STAGE(PG8_SB(0, 1), cB0 + hstepB, voffB); PG8_STAGE(PG8_SA(0, 0), cA0, voffA); PG8_STAGE(PG8_SA(0, 1), cA0 + hstepA, voffA);
    if (wr == 1) PG8_BAR;
    PG8_WAIT_V(2); PG8_BAR;
    PG8_STAGE(PG8_SB(1, 0), cB0 + kstep, voffB); PG8_STAGE(PG8_SA(1, 0), cA0 + kstep, voffA); PG8_STAGE(PG8_SB(1, 1), cB0 + hstepB + kstep, voffB);
    PG8_WAIT_V(6); PG8_BAR; }
    for (;;) {
        const bool has_next = S.next(ui + 1, nxt);
        const char* nA = has_next ? (const char*)g.A + (size_t)nxt.pm * tstepA : cA; const char* nB = has_next ? (const char*)g.Bt + (size_t)nxt.pn * tstepB : cB;
        for (int t = 0; t < nt; t += 2) {
            const bool last = (t == nt - 2);
            const char* a1 = cA + (size_t)PG8_KT(t + 1) * kstep;
            const char* a2 = last ? nA + (size_t)PG8_KT(0) * kstep : cA + (size_t)PG8_KT(t + 2) * kstep; const char* b2 = last ? nB + (size_t)PG8_KT(0) * kstep : cB + (size_t)PG8_KT(t + 2) * kstep;
            const char* a3 = a2 + kstep; const char* b3 = b2 + kstep;
            PG8_LDB(B0, 0, 0); PG8_LDB(B1, 0, 1); PG8_SCHED; PG8_LDA(At, 0, 0); PG8_STAGE(PG8_SA(1, 1), a1 + hstepA, voffA);
            PG8_WAIT_V(8); PG8_WAIT_L(0); PG8_BAR; PG8_MMA(0, 0, At, B0); PG8_MMA(0, 1, At, B1); PG8_BAR; PG8_SCHED;
            PG8_LDA(At, 0, 1); PG8_STAGE(PG8_SB(0, 0), b2, voffB); PG8_STAGE(PG8_SB(0, 1), b2 + hstepB, voffB); PG8_STAGE(PG8_SA(0, 0), a2, voffA);
            PG8_WAIT_V(8); PG8_WAIT_L(0); PG8_BAR; PG8_MMA(1, 0, At, B0); PG8_MMA(1, 1, At, B1); PG8_BAR; PG8_SCHED;
            PG8_LDB(B0, 1, 0); PG8_LDB(B1, 1, 1); PG8_SCHED; PG8_LDA(At, 1, 0); PG8_STAGE(PG8_SA(0, 1), a2 + hstepA, voffA);
            PG8_WAIT_V(8); PG8_WAIT_L(0); PG8_BAR; PG8_MMA(0, 0, At, B0); PG8_MMA(0, 1, At, B1); PG8_BAR; PG8_SCHED;
            PG8_LDA(At, 1, 1); PG8_STAGE(PG8_SB(1, 0), b3, voffB); PG8_STAGE(PG8_SB(1, 1), b3 + hstepB, voffB); PG8_STAGE(PG8_SA(1, 0), a3, voffA);
            PG8_WAIT_V(8); PG8_WAIT_L(0); PG8_BAR; PG8_MMA(1, 0, At, B0); PG8_MMA(1, 1, At, B1); PG8_BAR; PG8_SCHED;
            if (KMODE == 1 && (t == 6 || t == 14)) {
                const int wh = (t == 14) ? 1 : 0;
#pragma unroll
                for (int ai = 0; ai < 2; ++ai)
#pragma unroll
                    for (int m = 0; m < 4; ++m) { const float f = ftab[(ai * HALF + wr * 64 + m * 16 + fr) * 2 + wh];
#pragma unroll
                        for (int bj = 0; bj < 2; ++bj)
#pragma unroll
                            for (int n = 0; n < 2; ++n) acc[ai][bj][m][n] *= f; }
                PG8_SCHED;
            }
        }
        if (wr == 0) PG8_BAR;
        E(acc, cur, wr, wc, fr, fq);
        if (!has_next) break;
#pragma unroll
        for (int a = 0; a < 2; ++a)
#pragma unroll
            for (int b = 0; b < 2; ++b)
#pragma unroll
                for (int m = 0; m < 4; ++m)
#pragma unroll
                    for (int n = 0; n < 2; ++n) acc[a][b][m][n] = (f32x4){0.f, 0.f, 0.f, 0.f};
        cur = nxt; cA = nA; cB = nB; ++ui;
        if (wr == 1) PG8_BAR;
    }
    PG8_WAIT_V(0);
    PG8_BAR;
#undef PG8_SA
#undef PG8_SB
#undef PG8_STAGE
#undef PG8_LDA
#undef PG8_LDB
#undef PG8_MMA
#undef PG8_WAIT_V
#undef PG8_WAIT_L
#undef PG8_BAR
#undef PG8_SCHED
}
}

constexpr int NWAVES = 8;
constexpr int RING_OFF = 0, RING_BYTES = 131072;
constexpr int LDS_BYTES = 147456;
constexpr int LDSCTL_OFF = LDS_BYTES - 512, MISC_OFF = LDSCTL_OFF + 320;
constexpr int CW_BAR = 4096;

#define GAS __attribute__((address_space(1)))
#define LAS __attribute__((address_space(3)))
typedef unsigned short bf16;
typedef unsigned v4u __attribute__((ext_vector_type(4)));
typedef float f32x4 __attribute__((ext_vector_type(4)));
typedef GAS unsigned gu32;
#define RLX_AGENT __ATOMIC_RELAXED, __HIP_MEMORY_SCOPE_AGENT
#define LDS_WAIT() asm volatile("s_waitcnt lgkmcnt(0)" ::: "memory")
#define VM_WAIT() asm volatile("s_waitcnt vmcnt(0)" ::: "memory")
__device__ __forceinline__ unsigned f2bf(float f) { unsigned u = __builtin_bit_cast(unsigned, f); return (u + 0x7fffu + ((u >> 16) & 1u)) >> 16; }
typedef float f32x2_ __attribute__((ext_vector_type(2))); typedef __bf16 bf16x2_ __attribute__((ext_vector_type(2)));
__device__ __forceinline__ unsigned pk2(float lo, float hi) { const f32x2_ v = {lo, hi}; return __builtin_bit_cast(unsigned, __builtin_convertvector(v, bf16x2_)); }
__device__ __forceinline__ float bf2f(unsigned short b) { return __uint_as_float(((unsigned)b) << 16); }

#define XB_TMO      128
#define XB_XCNT(j)  (256  + 64 * (j))
#define XB_XSUB(j)  (1280 + 64 * (j))
#define XB_XGEN(j)  (2304 + 64 * (j))
#define XB_TOP      3328
#define XB_TOPGEN   3392
#define XCD_BAR_WORDS 3456
#define XB_SPIN_CAP (1u << 18)
__device__ __forceinline__ unsigned xb_ld(unsigned* p)              { return __hip_atomic_load(p, __ATOMIC_RELAXED, __HIP_MEMORY_SCOPE_AGENT); }
__device__ __forceinline__ unsigned xb_add(unsigned* p, unsigned v) { return __hip_atomic_fetch_add(p, v, __ATOMIC_RELAXED, __HIP_MEMORY_SCOPE_AGENT); }
__device__ __forceinline__ unsigned xb_xcc_id() { return (unsigned)__builtin_amdgcn_s_getreg((3 << 11) | 20) & 0xFu; }
#define XB_SPIN(cond, bar) do { unsigned _sp = 0; while (cond) { __builtin_amdgcn_s_sleep(1); \
    if ((++_sp & 255u) == 0u) { if (xb_ld(&(bar)[XB_TMO])) break; if (_sp > XB_SPIN_CAP) { atomicAdd(&(bar)[XB_TMO], 1u); break; } } } } while (0)
struct XcdBarrier { unsigned* bar; unsigned x; volatile LAS unsigned* st; };
__device__ __forceinline__ XcdBarrier xcd_barrier_post(unsigned* bar, volatile LAS unsigned* st) {
    XcdBarrier b; b.bar = bar; b.x = xb_xcc_id(); b.st = st;
    if (threadIdx.x == 0) (void)xb_add(&bar[XB_XCNT(b.x)], 1u);
    return b;
}
__device__ __forceinline__ void xcd_barrier_complete(unsigned* bar, unsigned x, unsigned& nloc, unsigned& nx) {
    const unsigned G = gridDim.x * gridDim.y * gridDim.z;
    unsigned sum, cnt, mine, sp = 0u;
    for (;;) {
        sum = 0u; cnt = 0u; mine = 0u;
#pragma unroll
        for (unsigned j = 0; j < 16; ++j) { const unsigned c = xb_ld(&bar[XB_XCNT(j)]); sum += c; cnt += (c > 0u) ? 1u : 0u; mine = (j == x) ? c : mine; }
        if (sum == G) break;
        __builtin_amdgcn_s_sleep(1);
        if ((++sp & 255u) == 0u) { if (xb_ld(&bar[XB_TMO])) break; if (sp > XB_SPIN_CAP) { atomicAdd(&bar[XB_TMO], 1u); break; } }
    }
    nloc = mine > 0u ? mine : 1u; nx = cnt > 0u ? cnt : 1u;
}
__device__ __forceinline__ void xcd_barrier(const XcdBarrier& b, int tid) {
    asm volatile("s_waitcnt vmcnt(0)" ::: "memory");
    __syncthreads();
    if (tid == 0) {
        unsigned* bar = b.bar;
        __builtin_amdgcn_s_waitcnt(0);
        unsigned nloc = b.st[0], nx = b.st[1];
        if (nloc == 0u) { xcd_barrier_complete(bar, b.x, nloc, nx); b.st[0] = nloc; b.st[1] = nx; }
        const unsigned old = xb_add(&bar[XB_XSUB(b.x)], 1u);
        const unsigned gen = old / nloc;
        if (old + 1u == (gen + 1u) * nloc) {
            __builtin_amdgcn_fence(__ATOMIC_RELEASE, "agent");
            asm volatile("s_waitcnt vmcnt(0)" ::: "memory");
            const unsigned og = xb_add(&bar[XB_TOP], 1u);
            const unsigned tg = og / nx;
            if (og + 1u == (tg + 1u) * nx) xb_add(&bar[XB_TOPGEN], 1u);
            else XB_SPIN(xb_ld(&bar[XB_TOPGEN]) == tg, bar);
            __builtin_amdgcn_fence(__ATOMIC_ACQUIRE, "agent");
            xb_add(&bar[XB_XGEN(b.x)], 1u);
            asm volatile("s_waitcnt vmcnt(0)" ::: "memory");
        } else {
            XB_SPIN(xb_ld(&bar[XB_XGEN(b.x)]) == gen, bar);
            __builtin_amdgcn_fence(__ATOMIC_ACQUIRE, "agent");
            asm volatile("s_waitcnt vmcnt(0)" ::: "memory");
        }
    }
    __syncthreads();
}

__device__ __forceinline__ int fresh_lane() { int l; asm volatile("v_mbcnt_lo_u32_b32 %0, -1, 0\n\tv_mbcnt_hi_u32_b32 %0, -1, %0" : "=v"(l)); return l; }
struct Args { const float* in[22]; float* out; unsigned char* ws; int ph_lo, ph_hi; };

struct Frame {
    LAS unsigned char* lds;
    int tid, lane, wave;
    int vcu, G;
};

__device__ __forceinline__ float wave_sum(float v) {
#pragma unroll
    for (int o = 1; o < 64; o <<= 1) v += __shfl_xor(v, o);
    return v;
}

__device__ __forceinline__ void conv_item(const float* W, int ldw, int srccol0, bf16* WT, int K, int dstrow0, int k0, LAS float* scr, int lane, const float* kscale  , int kslo = 0, int kshi = 1 << 30) {
    {
        const int lr = lane >> 3, lc = (lane & 7) * 4; f32x4 v[8];
#pragma unroll
        for (int i = 0; i < 8; ++i) { const float* p = W + (size_t)(k0 + 8 * i + lr) * ldw + srccol0 + lc;
            if ((((size_t)p) & 15) == 0) v[i] = *(const f32x4*)p; else { v[i][0] = p[0]; v[i][1] = p[1]; v[i][2] = p[2]; v[i][3] = p[3]; } }
#pragma unroll
        for (int i = 0; i < 8; ++i) { LAS float* d = scr + (8 * i + lr) * 33 + lc; d[0] = v[i][0]; d[1] = v[i][1]; d[2] = v[i][2]; d[3] = v[i][3]; }
    }
    const int c = lane & 7;
    f32x4 ks0 = (f32x4){1.f, 1.f, 1.f, 1.f}, ks1 = ks0;
    if (kscale && k0 >= kslo && k0 < kshi) { ks0 = *(const f32x4*)(kscale + k0 - kslo + 8 * c); ks1 = *(const f32x4*)(kscale + k0 - kslo + 8 * c + 4); }
    LDS_WAIT(); asm volatile("" ::: "memory");
#pragma unroll
    for (int j = 0; j < 4; ++j) { const int n = (lane >> 3) + 8 * j; const LAS float* s = scr + (8 * c) * 33 + n;
        v4u o; o.x = pk2(s[0 * 33] * ks0[0], s[1 * 33] * ks0[1]); o.y = pk2(s[2 * 33] * ks0[2], s[3 * 33] * ks0[3]); o.z = pk2(s[4 * 33] * ks1[0], s[5 * 33] * ks1[1]); o.w = pk2(s[6 * 33] * ks1[2], s[7 * 33] * ks1[3]);
        *(GAS v4u*)(WT + (size_t)(dstrow0 + n) * K + k0 + 8 * c) = o; }
    LDS_WAIT(); asm volatile("" ::: "memory");
}
__device__ __forceinline__ int in_src_col(int n0) {
    const int tile = n0 >> 8, p = n0 & 255; int dest;
    if (tile < 2 || tile == 8 || tile == 9) { const int bj = p >> 7, wc = (p >> 5) & 3; dest = (tile << 8) + 64 * wc + 32 * bj; } else dest = n0;
    if (dest < PC_Z) return SC_Q + dest;
    if (dest < PC_MO) return SC_Z + dest - PC_Z;
    if (dest < PC_K) return SC_MO + dest - PC_MO;
    if (dest < PC_V) return SC_K + dest - PC_K;
    if (dest < PC_XBC) return SC_V + dest - PC_V;
    if (dest < PC_MQK) return SC_XBC + dest - PC_XBC;
    if (dest < PC_MV) return SC_MQK + dest - PC_MQK;
    return SC_MV + dest - PC_MV;
}
__device__ __forceinline__ void conv_w_in(Frame& F, const float* w_in, const float* nw, bf16* wt, LAS float* scr) {
    const int gw = F.vcu * NWAVES + F.wave, NGW = F.G * NWAVES;
    for (int it = gw; it < (DM / 64) * (PLD / 32); it += NGW) { const int nblk = PLD / 32, kb = it / nblk, nb = it % nblk; conv_item(w_in, P_IN, in_src_col(32 * nb), wt, DM, 32 * nb, 64 * kb, scr, F.lane, nw); }
}
__device__ __forceinline__ void conv_plain(Frame& F, const float* W, int K, int N, const float* kscale, bf16* wt, LAS float* scr, int kslo = 0, int kshi = 1 << 30) {
    const int gw = F.vcu * NWAVES + F.wave, NGW = F.G * NWAVES; const int nblk = N / 32;
    for (int it = gw; it < (K / 64) * nblk; it += NGW) { const int kb = it / nblk, nb = it % nblk; conv_item(W, N, 32 * nb, wt, K, 32 * nb, 64 * kb, scr, F.lane, kscale, kslo, kshi); }
}
__device__ __forceinline__ void conv_small(Frame& F, const float* w_in, const float* nw, bf16* wst) {
    const int gt = F.vcu * (NWAVES * 64) + F.tid, NT = F.G * NWAVES * 64;
    for (int i = gt; i < 32 * DM; i += NT) { const int c = i >> 10, k = i & (DM - 1);
        float v = 0.f; if (c < 24) v = w_in[(size_t)k * P_IN + (c < 16 ? SC_DT + c : SC_MI + (c - 16))] * nw[k];
        wst[i] = (bf16)(pk2(v, 0.f) & 0xffffu); }
}
__device__ __forceinline__ void row_pass0(Frame& F, const float* x, bf16* xb, float* rs) {
    const int gw = F.vcu * NWAVES + F.wave, NGW = F.G * NWAVES;
    for (int m = gw; m < M; m += 2 * NGW) {
        const int m2 = m + NGW; const bool two = m2 < M;
        const GAS f32x4* xr = (const GAS f32x4*)(x + (size_t)m * DM) + F.lane; const GAS f32x4* xr2 = (const GAS f32x4*)(x + (size_t)(two ? m2 : m) * DM) + F.lane;
        f32x4 v[4], u[4]; float s_ = 0.f, t_ = 0.f;
#pragma unroll
        for (int j = 0; j < 4; ++j) { v[j] = xr[64 * j]; u[j] = xr2[64 * j]; }
#pragma unroll
        for (int j = 0; j < 4; ++j) { s_ += (v[j].x * v[j].x + v[j].y * v[j].y) + (v[j].z * v[j].z + v[j].w * v[j].w); t_ += (u[j].x * u[j].x + u[j].y * u[j].y) + (u[j].z * u[j].z + u[j].w * u[j].w); }
        s_ = wave_sum(s_); t_ = wave_sum(t_);
        GAS unsigned long long* o8 = (GAS unsigned long long*)(xb + (size_t)m * DM) + F.lane;
#pragma unroll
        for (int j = 0; j < 4; ++j) o8[64 * j] = (unsigned long long)pk2(v[j].x, v[j].y) | ((unsigned long long)pk2(v[j].z, v[j].w) << 32);
        if (F.lane == 0) rs[m] = s_;
        if (two) { GAS unsigned long long* p8 = (GAS unsigned long long*)(xb + (size_t)m2 * DM) + F.lane;
#pragma unroll
            for (int j = 0; j < 4; ++j) p8[64 * j] = (unsigned long long)pk2(u[j].x, u[j].y) | ((unsigned long long)pk2(u[j].z, u[j].w) << 32);
            if (F.lane == 0) rs[m2] = t_; }
    }
}
typedef short bf16x8s __attribute__((ext_vector_type(8)));
__device__ __forceinline__ void small_proj(Frame& F, const bf16* xb, const bf16* wst, const float* rs, float* smallp) {
    constexpr int SP = 1040;
    LAS unsigned char* As = F.lds; LAS unsigned char* Bs = F.lds + 64 * SP;
    const int lane = F.lane, w = F.wave, mt = w & 3, nt = w >> 2, r16 = lane & 15, kq = lane >> 4;
    for (int rb = F.vcu * 64; rb < M; rb += F.G * 64) {
        f32x4 acc = (f32x4){0.f, 0.f, 0.f, 0.f};
#pragma unroll 1
        for (int kh = 0; kh < 2; ++kh) {
            v4u av[8], bv[4];
#pragma unroll
            for (int i = 0; i < 8; ++i) { const int it = F.tid + 512 * i, row = it >> 6, c = it & 63; av[i] = *(const v4u*)(xb + (size_t)(rb + row) * DM + kh * 512 + c * 8); }
#pragma unroll
            for (int i = 0; i < 4; ++i) { const int it = F.tid + 512 * i, row = it >> 6, c = it & 63; bv[i] = *(const v4u*)(wst + (size_t)row * DM + kh * 512 + c * 8); }
            __syncthreads();
#pragma unroll
            for (int i = 0; i < 8; ++i) { const int it = F.tid + 512 * i, row = it >> 6, c = it & 63; *(LAS v4u*)(As + row * SP + c * 16) = av[i]; }
#pragma unroll
            for (int i = 0; i < 4; ++i) { const int it = F.tid + 512 * i, row = it >> 6, c = it & 63; *(LAS v4u*)(Bs + row * SP + c * 16) = bv[i]; }
            __syncthreads();
            bf16x8s a[16], b[16];
#pragma unroll
            for (int ks = 0; ks < 16; ++ks) { a[ks] = *(const LAS bf16x8s*)(As + (16 * mt + r16) * SP + (32 * ks + 8 * kq) * 2); b[ks] = *(const LAS bf16x8s*)(Bs + (16 * nt + r16) * SP + (32 * ks + 8 * kq) * 2); }
#pragma unroll
            for (int ks = 0; ks < 16; ++ks) acc = __builtin_amdgcn_mfma_f32_16x16x32_bf16(a[ks], b[ks], acc, 0, 0, 0);
        }
        const int n = 16 * nt + r16;
        if (n < 24) {
#pragma unroll
            for (int i = 0; i < 4; ++i) { const int row = rb + 16 * mt + 4 * kq + i; smallp[(size_t)row * 24 + n] = acc[i] * (1.0f / sqrtf(rs[row] * (1.0f / DM) + EPS)); } }
    }
    __syncthreads();
}
__device__ __forceinline__ unsigned cvtpk(float lo, float hi) { return pk2(lo, hi); }
__device__ __forceinline__ float bflo(unsigned w) { return __uint_as_float(w << 16); }
__device__ __forceinline__ float bfhi(unsigned w) { return __uint_as_float(w & 0xffff0000u); }
typedef float f32x2 __attribute__((ext_vector_type(2)));
__device__ __forceinline__ f32x2 gelu_pk(f32x2 v) {
    const f32x2 av = __builtin_elementwise_abs(v), d = av * 0.2316418882f + 1.0f;
    f32x2 t; t.x = __builtin_amdgcn_rcpf(d.x); t.y = __builtin_amdgcn_rcpf(d.y);
    f32x2 q = t * 0.5307027145f + (-0.7265760135f); q = q * t + 0.7107068705f; q = q * t + (-0.142248368f); q = q * t + 0.127414796f; q = q * t;
    const f32x2 s = (v * v) * (-0.72134752044f);
    f32x2 e; e.x = __builtin_amdgcn_exp2f(s.x); e.y = __builtin_amdgcn_exp2f(s.y);
    const f32x2 m = v * (q * e), r = v - m;
    f32x2 o; o.x = v.x < 0.f ? m.x : r.x; o.y = v.y < 0.f ? m.y : r.y; return o;
}

__device__ __forceinline__ void ffn_fix(Frame& F, bf16* H, const bf16* sideA, const bf16* sideB, const float* cw, const float* cb, int pm) {
    constexpr int CPR = FFN / 8;
    for (int it = F.tid; it < 4 * 2 * CPR; it += NWAVES * 64) {
        const int c0 = (it % CPR) * 8, rr_ = (it / CPR) & 1, grp = 4 * pm + it / (2 * CPR); const bool first = (grp & 31) == 0;
        const v4u z = (v4u){0, 0, 0, 0};
        const bf16* sb = sideB + ((size_t)grp * 2 + rr_) * 2 * FFN + c0;
        const v4u g2 = *(const v4u*)sb, vv = *(const v4u*)(sb + FFN);
        const v4u a1 = first ? z : *(const v4u*)(sideA + ((size_t)(grp - 1) * 2 + 1) * FFN + c0), a0 = first ? z : *(const v4u*)(sideA + ((size_t)(grp - 1) * 2) * FFN + c0);
        const v4u g1 = rr_ ? *(const v4u*)(sideB + ((size_t)grp * 2) * 2 * FFN + c0) : a1, g0 = rr_ ? a1 : a0;
        f32x4 w0[2], w1[2], w2[2], bb[2];
#pragma unroll
        for (int k = 0; k < 2; ++k) { w0[k] = *(const f32x4*)(cw + c0 + 4 * k); w1[k] = *(const f32x4*)(cw + FFN + c0 + 4 * k); w2[k] = *(const f32x4*)(cw + 2 * FFN + c0 + 4 * k); bb[k] = *(const f32x4*)(cb + c0 + 4 * k); }
        v4u ov;
#pragma unroll
        for (int i = 0; i < 4; ++i) { const int k = i >> 1, e = (i & 1) * 2; f32x2 x;
            x.x = bb[k][e] + w0[k][e] * bflo(g0[i]) + w1[k][e] * bflo(g1[i]) + w2[k][e] * bflo(g2[i]);
            x.y = bb[k][e + 1] + w0[k][e + 1] * bfhi(g0[i]) + w1[k][e + 1] * bfhi(g1[i]) + w2[k][e + 1] * bfhi(g2[i]);
            const f32x2 ge = gelu_pk(x); ov[i] = cvtpk(ge.x * bflo(vv[i]), ge.y * bfhi(vv[i])); }
        *(v4u*)(H + (size_t)(grp * 64 + rr_) * FFN + c0) = ov;
    }
}
__device__ __forceinline__ float silu_f(float x) { return x * __builtin_amdgcn_rcpf(1.0f + __builtin_amdgcn_exp2f(-1.4426950408889634f * x)); }
__device__ __forceinline__ float sigm_f(float x) { return __builtin_amdgcn_rcpf(1.0f + __builtin_amdgcn_exp2f(-1.4426950408889634f * x)); }

__device__ __forceinline__ float shx(float v, int m, int lane) { return __int_as_float(__builtin_amdgcn_ds_bpermute((lane ^ m) << 2, __float_as_int(v))); }
__device__ __forceinline__ float shup(float v, int o, int lane) { return __int_as_float(__builtin_amdgcn_ds_bpermute((lane - o) << 2, __float_as_int(v))); }
__device__ __forceinline__ float shl_(float v, int src, int lane) { (void)lane; return __int_as_float(__builtin_amdgcn_ds_bpermute(src << 2, __float_as_int(v))); }
__device__ __forceinline__ float softplus_f(float x) { return fmaxf(x, 0.f) + 0.6931471805599453f * __builtin_amdgcn_logf(1.0f + __builtin_amdgcn_exp2f(-1.4426950408889634f * fabsf(x))); }
__device__ __forceinline__ float logsig_f(float x) { return fminf(x, 0.f) - 0.6931471805599453f * __builtin_amdgcn_logf(1.0f + __builtin_amdgcn_exp2f(-1.4426950408889634f * fabsf(x))); }
typedef short bf16x8v __attribute__((ext_vector_type(8)));
typedef float f32x16 __attribute__((ext_vector_type(16)));
typedef short v4i16_t __attribute__((ext_vector_type(4)));
__device__ __forceinline__ bf16x8v frag_row(LAS const unsigned char* base, int pitch, int row, int kel) { return *(const LAS bf16x8v*)(base + row * pitch + kel * 2); }
__device__ __forceinline__ bf16x8v frag_tr(LAS const unsigned char* base, int pitch, int krow, int col) {
    LAS const unsigned char* p = base + krow * pitch + col * 2;
    const v4i16_t lo = __builtin_amdgcn_ds_read_tr16_b64_v4i16((LAS v4i16_t*)p);
    const v4i16_t hi = __builtin_amdgcn_ds_read_tr16_b64_v4i16((LAS v4i16_t*)(p + 4 * pitch));
    return (bf16x8v){lo[0], lo[1], lo[2], lo[3], hi[0], hi[1], hi[2], hi[3]};
}
#define MFMA32(a, b, c) __builtin_amdgcn_mfma_f32_32x32x16_bf16((a), (b), (c), 0, 0, 0)

__device__ __forceinline__ void ssd_unit(int tid, bf16* proj, const float* smallp, float* ssq, const float* dt_bias, const float* a_log, const float* dskip, int b, int h, LAS unsigned char* lds) {
    constexpr int PB = 272, PX = 144;
    asm volatile("" : "+v"(tid));
    LAS unsigned char* CG = lds;
    LAS unsigned char* BB = lds + 34816;
    LAS unsigned char* XX = lds + 69632;
    LAS unsigned char* XW = lds + 88064;
    LAS unsigned char* ST = lds + 106496;
    LAS float* ldv = (LAS float*)(lds + 123904);
    LAS float* dtv = ldv + 2048;
    const int lane0 = tid & 63, w = __builtin_amdgcn_readfirstlane(tid >> 6);
    const int g = h >> 3, pt = w & 1, lt = w >> 1;
    const float a = -__expf(a_log[h]), dsk = dskip[h], dtb = dt_bias[h];
    const size_t rowb = (size_t)b * SEQ;
    const int xrow = tid >> 2, xq = tid & 3, brow = tid >> 4, bc = tid & 15;
    const bf16* xsrc = proj + (rowb + xrow) * PLD + PC_XBC + h * 64 + xq * 16;
    bf16* zptr = proj + (rowb + xrow) * PLD + PC_Z + h * 64 + xq * 16;
    const bf16* bsrc = proj + (rowb + brow) * PLD + PC_XBC + 1024 + g * 128 + bc * 8;
    const bf16* csrc = bsrc + 256;
    const float* dsrc = smallp + (rowb + lane0) * 24 + h;
    v4u xr[2], br[4], cr[4];
#pragma unroll
    for (int k = 0; k < 2; ++k) xr[k] = *(const v4u*)(xsrc + 8 * k);
#pragma unroll
    for (int k = 0; k < 4; ++k) { br[k] = *(const v4u*)(bsrc + (size_t)32 * k * PLD); cr[k] = *(const v4u*)(csrc + (size_t)32 * k * PLD); }
#pragma unroll
    for (int cc = 0; cc < 2; ++cc) { const int ch_ = 2 * w + cc; const float* dp_ = dsrc + (size_t)ch_ * 128 * 24;
        float v0 = dp_[0] + dtb, v1 = dp_[64 * 24] + dtb;
        v0 = softplus_f(v0); v1 = softplus_f(v1);
        float s0 = v0 * a, s1 = v1 * a;
#pragma unroll
        for (int o = 1; o < 64; o <<= 1) { const float t0 = shup(s0, o, lane0), t1 = shup(s1, o, lane0); if (lane0 >= o) { s0 += t0; s1 += t1; } }
        s1 += shl_(s0, 63, lane0);
        ldv[ch_ * 128 + lane0] = s0; ldv[ch_ * 128 + 64 + lane0] = s1; dtv[ch_ * 128 + lane0] = v0; dtv[ch_ * 128 + 64 + lane0] = v1; }
    f32x16 sacc;
#pragma unroll
    for (int i = 0; i < 16; ++i) sacc[i] = 0.f;
    for (int i = tid; i < 17408 / 4; i += 512) ((LAS unsigned*)ST)[i] = 0u;
    for (int c = 0; c < 16; ++c) {
        const size_t row0 = rowb + c * 128;
        int lane = lane0; asm volatile("" : "+v"(lane));
        const int r = lane & 31, hh = lane >> 5, trq = (lane & 15) >> 2, trc = 16 * ((lane >> 4) & 1) + 4 * (lane & 3);
        LAS const float* ldc = ldv + c * 128; LAS const float* dtc = dtv + c * 128;
        __syncthreads();
        {
            const float wl = dtc[xrow] * __expf(ldc[127] - ldc[xrow]);
#pragma unroll
            for (int k = 0; k < 2; ++k) { *(LAS v4u*)(XX + xrow * PX + xq * 32 + k * 16) = xr[k]; v4u o;
#pragma unroll
                for (int i = 0; i < 4; ++i) o[i] = pk2(bf2f(xr[k][i] & 0xffff) * wl, bf2f(xr[k][i] >> 16) * wl);
                *(LAS v4u*)(XW + xrow * PX + xq * 32 + k * 16) = o; }
#pragma unroll
            for (int k = 0; k < 4; ++k) { *(LAS v4u*)(BB + (brow + 32 * k) * PB + bc * 16) = br[k]; *(LAS v4u*)(CG + (brow + 32 * k) * PB + bc * 16) = cr[k]; }
        }
        v4u zr[2];
#pragma unroll
        for (int k = 0; k < 2; ++k) zr[k] = *(const v4u*)(zptr + (size_t)c * 128 * PLD + 8 * k);
        if (c < 15) {
#pragma unroll
            for (int k = 0; k < 2; ++k) xr[k] = *(const v4u*)(xsrc + (size_t)(c + 1) * 128 * PLD + 8 * k);
#pragma unroll
            for (int k = 0; k < 4; ++k) { br[k] = *(const v4u*)(bsrc + (size_t)((c + 1) * 128 + 32 * k) * PLD); cr[k] = *(const v4u*)(csrc + (size_t)((c + 1) * 128 + 32 * k) * PLD); }
        }
        __syncthreads();
        f32x16 yacc;
#pragma unroll
        for (int i = 0; i < 16; ++i) yacc[i] = 0.f;
        {   bf16x8v fa[8], fb[8];
#pragma unroll
            for (int ks = 0; ks < 8; ++ks) { fa[ks] = frag_row(ST, PB, 32 * pt + r, 16 * ks + 8 * hh); fb[ks] = frag_row(CG, PB, 32 * lt + r, 16 * ks + 8 * hh); }
            __builtin_amdgcn_sched_barrier(0);
#pragma unroll
            for (int ks = 0; ks < 8; ++ks) yacc = MFMA32(fa[ks], fb[ks], yacc); }
        { const float e = __expf(ldc[32 * lt + r]);
#pragma unroll
          for (int i = 0; i < 16; ++i) yacc[i] *= e; }
        f32x16 tA, tB;
        const int ltA = (w >= 6) ? 3 : (w >= 3) ? 2 : (w >= 1) ? 1 : 0, stA = w - ltA * (ltA + 1) / 2;
        const int ltB = 3, stB = w + 2;
#pragma unroll
        for (int i = 0; i < 16; ++i) { tA[i] = 0.f; tB[i] = 0.f; }
        {   bf16x8v fa[8], fb[8];
#pragma unroll
            for (int ks = 0; ks < 8; ++ks) { fa[ks] = frag_row(BB, PB, 32 * stA + r, 16 * ks + 8 * hh); fb[ks] = frag_row(CG, PB, 32 * ltA + r, 16 * ks + 8 * hh); }
            __builtin_amdgcn_sched_barrier(0);
#pragma unroll
            for (int ks = 0; ks < 8; ++ks) tA = MFMA32(fa[ks], fb[ks], tA); }
        if (w < 2) { bf16x8v fa[8], fb[8];
#pragma unroll
            for (int ks = 0; ks < 8; ++ks) { fa[ks] = frag_row(BB, PB, 32 * stB + r, 16 * ks + 8 * hh); fb[ks] = frag_row(CG, PB, 32 * ltB + r, 16 * ks + 8 * hh); }
            __builtin_amdgcn_sched_barrier(0);
#pragma unroll
            for (int ks = 0; ks < 8; ++ks) tB = MFMA32(fa[ks], fb[ks], tB); }
        __syncthreads();
#define SSD_GWRITE(T_, st_, lt_) do { const int l = 32 * (lt_) + r; const float ldl = ldc[l]; \
          _Pragma("unroll") for (int g4 = 0; g4 < 4; ++g4) { const int s0 = 32 * (st_) + 8 * g4 + 4 * hh; \
              const f32x4 lds4 = *(LAS const f32x4*)(ldc + s0), dts4 = *(LAS const f32x4*)(dtc + s0); float v[4]; \
              _Pragma("unroll") for (int j = 0; j < 4; ++j) { const float e_ = __expf(fminf(ldl - lds4[j], 0.f)) * dts4[j] * T_[4 * g4 + j]; v[j] = (s0 + j <= l) ? e_ : 0.f; } \
              *(LAS unsigned long long*)(CG + l * PB + s0 * 2) = (unsigned long long)pk2(v[0], v[1]) | ((unsigned long long)pk2(v[2], v[3]) << 32); } } while (0)
        SSD_GWRITE(tA, stA, ltA);
        if (w < 2) SSD_GWRITE(tB, stB, ltB);
#undef SSD_GWRITE
        __syncthreads();
        for (int kb = 0; kb <= lt; ++kb) { bf16x8v fa[2], fb[2];
#pragma unroll
            for (int k2 = 0; k2 < 2; ++k2) { const int ks = 2 * kb + k2; fa[k2] = frag_tr(XX, PX, 16 * ks + 8 * hh + trq, 32 * pt + trc); fb[k2] = frag_row(CG, PB, 32 * lt + r, 16 * ks + 8 * hh); }
            __builtin_amdgcn_sched_barrier(0);
#pragma unroll
            for (int k2 = 0; k2 < 2; ++k2) yacc = MFMA32(fa[k2], fb[k2], yacc); }
        { const float e = __expf(ldc[127]);
#pragma unroll
          for (int i = 0; i < 16; ++i) sacc[i] *= e; }
        {   bf16x8v fa[8], fb[8];
#pragma unroll
            for (int ks = 0; ks < 8; ++ks) { fa[ks] = frag_tr(BB, PB, 16 * ks + 8 * hh + trq, 32 * lt + trc); fb[ks] = frag_tr(XW, PX, 16 * ks + 8 * hh + trq, 32 * pt + trc); }
            __builtin_amdgcn_sched_barrier(0);
#pragma unroll
            for (int ks = 0; ks < 8; ++ks) sacc = MFMA32(fa[ks], fb[ks], sacc); }
        __syncthreads();
        {
            const int p = 32 * pt + r, l = 32 * lt + r;
#pragma unroll
            for (int g4 = 0; g4 < 4; ++g4) { const int n0 = 32 * lt + 8 * g4 + 4 * hh;
                *(LAS unsigned long long*)(ST + p * PB + n0 * 2) = (unsigned long long)pk2(sacc[4 * g4], sacc[4 * g4 + 1]) | ((unsigned long long)pk2(sacc[4 * g4 + 2], sacc[4 * g4 + 3]) << 32);
                const int p0 = 32 * pt + 8 * g4 + 4 * hh;
                *(LAS f32x4*)(CG + l * 272 + p0 * 4) = (f32x4){yacc[4 * g4], yacc[4 * g4 + 1], yacc[4 * g4 + 2], yacc[4 * g4 + 3]}; }
        }
        __syncthreads();
        {
            float o[16]; float ss = 0.f;
#pragma unroll
            for (int k = 0; k < 2; ++k) { const v4u zv = zr[k]; const v4u xv = *(const LAS v4u*)(XX + xrow * PX + xq * 32 + k * 16);
                const f32x4 y0 = *(const LAS f32x4*)(CG + xrow * 272 + (xq * 16 + 8 * k) * 4), y1 = *(const LAS f32x4*)(CG + xrow * 272 + (xq * 16 + 8 * k + 4) * 4);
#pragma unroll
                for (int i = 0; i < 4; ++i) { const float ya = (i < 2 ? y0[2 * i] : y1[2 * i - 4]), yb = (i < 2 ? y0[2 * i + 1] : y1[2 * i - 3]);
                    const float oa = (ya + dsk * bf2f(xv[i] & 0xffff)) * silu_f(bf2f(zv[i] & 0xffff)), ob = (yb + dsk * bf2f(xv[i] >> 16)) * silu_f(bf2f(zv[i] >> 16));
                    o[8 * k + 2 * i] = oa; o[8 * k + 2 * i + 1] = ob; ss += oa * oa + ob * ob; } }
            ss += shx(ss, 1, lane); ss += shx(ss, 2, lane);
            bf16* zp = zptr + (size_t)c * 128 * PLD;
#pragma unroll
            for (int k = 0; k < 2; ++k) { v4u ov; ov.x = pk2(o[8 * k], o[8 * k + 1]); ov.y = pk2(o[8 * k + 2], o[8 * k + 3]); ov.z = pk2(o[8 * k + 4], o[8 * k + 5]); ov.w = pk2(o[8 * k + 6], o[8 * k + 7]); *(v4u*)(zp + 8 * k) = ov; }
            if (xq == 0) ssq[(row0 + xrow) * 16 + h] = ss;
        }
    }
    __syncthreads();
}

__device__ __forceinline__ void mlstm_unit(int tid, bf16* proj, const float* smallp, const float* i_bias, const float* f_bias, const float* norm_w, int b, int hd, LAS unsigned char* lds, float* gsc  , unsigned long long* pts) {
    constexpr int PB = 272, GS = 656;
    asm volatile("" : "+v"(tid));
    LAS unsigned char* QP = lds;
    LAS unsigned char* KK = lds + 34816;
    LAS unsigned char* VV = lds + 69632;
    LAS unsigned char* CS = lds + 104448;
    LAS float* uu = (LAS float*)(lds + 139264);
    LAS float* mmv = uu + 128;
    LAS float* wint = mmv + 128;
    LAS float* dnv = wint + 128;
    LAS float* wlv = dnv + 128;
    LAS float* scal = wlv + 128;
    LAS float* nwl = scal + 16;
    LAS float* ptot = nwl + 128;
    LAS float* pmlo = ptot + 16;
    LAS unsigned short* nstb = (LAS unsigned short*)(pmlo + 16);
    const int lane0 = tid & 63, w = __builtin_amdgcn_readfirstlane(tid >> 6);
    const int tt = w >> 1, dp = w & 1;
    const float ib = i_bias[hd], fb = f_bias[hd];
    const size_t rowb = (size_t)b * SEQ;
    const int srow = tid >> 4, sc = tid & 15, et = tid >> 2, eq = tid & 3;
    const bf16* qsrc = proj + (rowb + srow) * PLD + PC_MQK + hd * 128 + sc * 8;
    const bf16* ksrc = qsrc + 512;
    const bf16* vsrc = proj + (rowb + srow) * PLD + PC_MV + hd * 128 + sc * 8;
    bf16* optr = proj + (rowb + et) * PLD + PC_MO + hd * 128 + eq * 32;
    v4u qr[4], kr[4];
#pragma unroll
    for (int k = 0; k < 4; ++k) { qr[k] = *(const v4u*)(qsrc + (size_t)32 * k * PLD); kr[k] = *(const v4u*)(ksrc + (size_t)32 * k * PLD); }
    {
        float pc0[2], pc1[2], pu0[2], pu1[2], pp0[2], pp1[2];
#pragma unroll
        for (int cc = 0; cc < 2; ++cc) { const float* gp = smallp + (rowb + (size_t)(2 * w + cc) * 128 + lane0) * 24 + 16 + hd;
            const float li0 = gp[0] + ib, li1 = gp[64 * 24] + ib, f0 = gp[4] + fb, f1 = gp[64 * 24 + 4] + fb;
            float c0 = logsig_f(f0), c1 = logsig_f(f1);
#pragma unroll
            for (int o = 1; o < 64; o <<= 1) { const float t0 = shup(c0, o, lane0), t1 = shup(c1, o, lane0); if (lane0 >= o) { c0 += t0; c1 += t1; } }
            c1 += shl_(c0, 63, lane0);
            const float totf = shl_(c1, 63, lane0);
            const float u0 = li0 - c0, u1 = li1 - c1;
            float p0 = u0, p1 = u1;
#pragma unroll
            for (int o = 1; o < 64; o <<= 1) { const float t0 = shup(p0, o, lane0), t1 = shup(p1, o, lane0); if (lane0 >= o) { p0 = fmaxf(p0, t0); p1 = fmaxf(p1, t1); } }
            p1 = fmaxf(p1, shl_(p0, 63, lane0));
            pc0[cc] = c0; pc1[cc] = c1; pu0[cc] = u0; pu1[cc] = u1; pp0[cc] = p0; pp1[cc] = p1;
            const float pall = shl_(p1, 63, lane0);
            if (lane0 == 0) { ptot[2 * w + cc] = totf; pmlo[2 * w + cc] = totf + pall; }
        }
        if (tid < 128) nwl[tid] = norm_w[hd * 128 + tid];
        if (tid < 64) ((LAS unsigned*)nstb)[tid] = 0u;
        for (int i = tid; i < 34816 / 4; i += 512) ((LAS unsigned*)CS)[i] = 0u;
        __syncthreads();
        float mst = 0.f, mst_mine[2] = {0.f, 0.f}, mnew_mine[2] = {0.f, 0.f};
#pragma unroll
        for (int c = 0; c < 16; ++c) { const float tf = ptot[c], ml = pmlo[c]; const float mn = fmaxf(tf + mst, ml);
            if (tid == 0) scal[c] = __expf(tf + mst - mn);
            if (c == 2 * w) { mst_mine[0] = mst; mnew_mine[0] = mn; }
            if (c == 2 * w + 1) { mst_mine[1] = mst; mnew_mine[1] = mn; }
            mst = mn; }
#pragma unroll
        for (int cc = 0; cc < 2; ++cc) { float* go_ = gsc + (size_t)(2 * w + cc) * GS; const float ms = mst_mine[cc], mn = mnew_mine[cc], tf = ptot[2 * w + cc];
            const float m0 = fmaxf(pp0[cc], ms), m1 = fmaxf(pp1[cc], ms);
            go_[lane0] = pu0[cc]; go_[64 + lane0] = pu1[cc]; go_[128 + lane0] = m0; go_[192 + lane0] = m1;
            go_[256 + lane0] = __expf(ms - m0); go_[320 + lane0] = __expf(ms - m1);
            go_[384 + lane0] = __expf(-(pc0[cc] + m0)); go_[448 + lane0] = __expf(-(pc1[cc] + m1));
            go_[512 + lane0] = __expf(tf + pu0[cc] - mn); go_[576 + lane0] = __expf(tf + pu1[cc] - mn); }
        asm volatile("s_waitcnt vmcnt(0)" ::: "memory");
        __syncthreads();
    }
    float gr[5] = {0.f, 0.f, 0.f, 0.f, 0.f};
    if (tid < 128) {
#pragma unroll
        for (int k = 0; k < 5; ++k) gr[k] = __hip_atomic_load(gsc + k * 128 + tid, __ATOMIC_RELAXED, __HIP_MEMORY_SCOPE_AGENT); }
    f32x16 cacc0, cacc1, nacc;
#pragma unroll
    for (int i = 0; i < 16; ++i) { cacc0[i] = 0.f; cacc1[i] = 0.f; nacc[i] = 0.f; }
    const bf16x8v ones = (bf16x8v){0x3F80, 0x3F80, 0x3F80, 0x3F80, 0x3F80, 0x3F80, 0x3F80, 0x3F80};
#if PROBE_PHASE != -1 && defined(PROBE_STAGES)
    unsigned long long tacc = 0; unsigned long long tprev = __builtin_amdgcn_s_memrealtime();
#define STAMP(k) do { const unsigned long long tn_ = __builtin_amdgcn_s_memrealtime(); if ((k) == PROBE_STAGES) tacc += tn_ - tprev; tprev = tn_; } while (0)
#else
#define STAMP(k) do {} while (0)
#endif
    for (int c = 0; c < 16; ++c) {
        int lane = lane0; asm volatile("" : "+v"(lane));
        const int r = lane & 31, hh = lane >> 5, trq = (lane & 15) >> 2, trc = 16 * ((lane >> 4) & 1) + 4 * (lane & 3);
        __syncthreads();
        STAMP(0);
#pragma unroll
        for (int k = 0; k < 4; ++k) { *(LAS v4u*)(QP + (srow + 32 * k) * PB + sc * 16) = qr[k]; *(LAS v4u*)(KK + (srow + 32 * k) * PB + sc * 16) = kr[k]; }
        if (tid < 128) { uu[tid] = gr[0]; mmv[tid] = gr[1]; wint[tid] = gr[2]; dnv[tid] = gr[3]; wlv[tid] = gr[4]; }
        v4u vr[4];
#pragma unroll
        for (int k = 0; k < 4; ++k) vr[k] = *(const v4u*)(vsrc + (size_t)(c * 128 + 32 * k) * PLD);
        if (c < 15) {
#pragma unroll
            for (int k = 0; k < 4; ++k) { const size_t ro = (size_t)((c + 1) * 128 + 32 * k) * PLD; qr[k] = *(const v4u*)(qsrc + ro); kr[k] = *(const v4u*)(ksrc + ro); }
            if (tid < 128) {
#pragma unroll
                for (int k = 0; k < 5; ++k) gr[k] = __hip_atomic_load(gsc + (size_t)(c + 1) * GS + k * 128 + tid, __ATOMIC_RELAXED, __HIP_MEMORY_SCOPE_AGENT); }
        }
        __syncthreads();
        STAMP(1);
        f32x16 na0, na1, dacc;
#pragma unroll
        for (int i = 0; i < 16; ++i) { na0[i] = 0.f; na1[i] = 0.f; dacc[i] = 0.f; }
#pragma unroll
        for (int kh = 0; kh < 2; ++kh) { bf16x8v fq[4], f0[4], f1[4], fn[4];
#pragma unroll
            for (int k4 = 0; k4 < 4; ++k4) { const int ks = 4 * kh + k4; fq[k4] = frag_row(QP, PB, 32 * tt + r, 16 * ks + 8 * hh); f0[k4] = frag_row(CS, PB, 32 * (2 * dp) + r, 16 * ks + 8 * hh); f1[k4] = frag_row(CS, PB, 32 * (2 * dp + 1) + r, 16 * ks + 8 * hh);
                fn[k4] = *(const LAS bf16x8v*)((LAS const unsigned char*)nstb + (16 * ks + 8 * hh) * 2); }
            __builtin_amdgcn_sched_barrier(0);
#pragma unroll
            for (int k4 = 0; k4 < 4; ++k4) { na0 = MFMA32(f0[k4], fq[k4], na0); na1 = MFMA32(f1[k4], fq[k4], na1); dacc = MFMA32(fn[k4], fq[k4], dacc); } }
        { const float e = wint[32 * tt + r];
#pragma unroll
          for (int i = 0; i < 16; ++i) { na0[i] *= e; na1[i] *= e; dacc[i] *= e; } }
        f32x16 tA, tB;
        const int ttA = (w >= 6) ? 3 : (w >= 3) ? 2 : (w >= 1) ? 1 : 0, stA = w - ttA * (ttA + 1) / 2;
        const int ttB = 3, stB = w + 2;
#pragma unroll
        for (int i = 0; i < 16; ++i) { tA[i] = 0.f; tB[i] = 0.f; }
#pragma unroll
        for (int kh = 0; kh < 2; ++kh) { bf16x8v fa[4], fb_[4];
#pragma unroll
            for (int k4 = 0; k4 < 4; ++k4) { const int ks = 4 * kh + k4; fa[k4] = frag_row(KK, PB, 32 * stA + r, 16 * ks + 8 * hh); fb_[k4] = frag_row(QP, PB, 32 * ttA + r, 16 * ks + 8 * hh); }
            __builtin_amdgcn_sched_barrier(0);
#pragma unroll
            for (int k4 = 0; k4 < 4; ++k4) tA = MFMA32(fa[k4], fb_[k4], tA); }
        if (w < 2) {
#pragma unroll
            for (int kh = 0; kh < 2; ++kh) { bf16x8v fa[4], fb_[4];
#pragma unroll
                for (int k4 = 0; k4 < 4; ++k4) { const int ks = 4 * kh + k4; fa[k4] = frag_row(KK, PB, 32 * stB + r, 16 * ks + 8 * hh); fb_[k4] = frag_row(QP, PB, 32 * ttB + r, 16 * ks + 8 * hh); }
                __builtin_amdgcn_sched_barrier(0);
#pragma unroll
                for (int k4 = 0; k4 < 4; ++k4) tB = MFMA32(fa[k4], fb_[k4], tB); } }
        __syncthreads();
        STAMP(2);
#define ML_PWRITE(T_, st_, tt_) do { const int t = 32 * (tt_) + r; const float mt = mmv[t]; \
          _Pragma("unroll") for (int g4 = 0; g4 < 4; ++g4) { const int s0 = 32 * (st_) + 8 * g4 + 4 * hh; const f32x4 u4 = *(LAS const f32x4*)(uu + s0); float v[4]; \
              _Pragma("unroll") for (int j = 0; j < 4; ++j) { const float e_ = __expf(fminf(u4[j] - mt, 0.f)) * T_[4 * g4 + j]; v[j] = (s0 + j <= t) ? e_ : 0.f; } \
              *(LAS unsigned long long*)(QP + t * PB + s0 * 2) = (unsigned long long)pk2(v[0], v[1]) | ((unsigned long long)pk2(v[2], v[3]) << 32); } } while (0)
        ML_PWRITE(tA, stA, ttA);
        if (w < 2) ML_PWRITE(tB, stB, ttB);
#undef ML_PWRITE
        {
            const int rg = tid >> 4, ec = tid & 15;
#pragma unroll
            for (int k = 0; k < 4; ++k) { const int row = 4 * rg + k; const float wl = wlv[row]; LAS v4u* p = (LAS v4u*)(KK + row * PB + ec * 16); const v4u kv = *p; v4u o;
#pragma unroll
                for (int i = 0; i < 4; ++i) o[i] = pk2(bflo(kv[i]) * wl, bfhi(kv[i]) * wl);
                *p = o; }
#pragma unroll
            for (int k = 0; k < 4; ++k) *(LAS v4u*)(VV + (srow + 32 * k) * PB + sc * 16) = vr[k];
        }
        v4u og[4];
#pragma unroll
        for (int k = 0; k < 4; ++k) og[k] = *(const v4u*)(optr + (size_t)c * 128 * PLD + 8 * k);
        __syncthreads();
        STAMP(3);
        for (int kb = 0; kb <= tt; ++kb) { bf16x8v fp[2], f0[2], f1[2];
#pragma unroll
            for (int k2 = 0; k2 < 2; ++k2) { const int ks = 2 * kb + k2; fp[k2] = frag_row(QP, PB, 32 * tt + r, 16 * ks + 8 * hh);
                f0[k2] = frag_tr(VV, PB, 16 * ks + 8 * hh + trq, 32 * (2 * dp) + trc); f1[k2] = frag_tr(VV, PB, 16 * ks + 8 * hh + trq, 32 * (2 * dp + 1) + trc); }
            __builtin_amdgcn_sched_barrier(0);
#pragma unroll
            for (int k2 = 0; k2 < 2; ++k2) { na0 = MFMA32(f0[k2], fp[k2], na0); na1 = MFMA32(f1[k2], fp[k2], na1); dacc = MFMA32(ones, fp[k2], dacc); } }
        { const float e = scal[c];
#pragma unroll
          for (int i = 0; i < 16; ++i) { cacc0[i] *= e; cacc1[i] *= e; nacc[i] *= e; } }
#pragma unroll
        for (int kh = 0; kh < 2; ++kh) { bf16x8v fk[4], f0[4], f1[4];
#pragma unroll
            for (int k4 = 0; k4 < 4; ++k4) { const int ks = 4 * kh + k4; fk[k4] = frag_tr(KK, PB, 16 * ks + 8 * hh + trq, 32 * tt + trc);
                f0[k4] = frag_tr(VV, PB, 16 * ks + 8 * hh + trq, 32 * (2 * dp) + trc); f1[k4] = frag_tr(VV, PB, 16 * ks + 8 * hh + trq, 32 * (2 * dp + 1) + trc); }
            __builtin_amdgcn_sched_barrier(0);
#pragma unroll
            for (int k4 = 0; k4 < 4; ++k4) { cacc0 = MFMA32(fk[k4], f0[k4], cacc0); cacc1 = MFMA32(fk[k4], f1[k4], cacc1); nacc = MFMA32(fk[k4], ones, nacc); } }
        __syncthreads();
        STAMP(4);
        {
            const int t = 32 * tt + r; const float dv = __builtin_amdgcn_rcpf(fmaxf(fabsf(dacc[0]), dnv[t]));
#pragma unroll
            for (int g4 = 0; g4 < 4; ++g4) {
                const int e0 = 32 * tt + 8 * g4 + 4 * hh, d0 = 32 * (2 * dp) + r, d1 = 32 * (2 * dp + 1) + r;
                *(LAS unsigned long long*)(CS + d0 * PB + e0 * 2) = (unsigned long long)pk2(cacc0[4 * g4], cacc0[4 * g4 + 1]) | ((unsigned long long)pk2(cacc0[4 * g4 + 2], cacc0[4 * g4 + 3]) << 32);
                *(LAS unsigned long long*)(CS + d1 * PB + e0 * 2) = (unsigned long long)pk2(cacc1[4 * g4], cacc1[4 * g4 + 1]) | ((unsigned long long)pk2(cacc1[4 * g4 + 2], cacc1[4 * g4 + 3]) << 32);
                const int dd0 = 32 * (2 * dp) + 8 * g4 + 4 * hh, dd1 = dd0 + 32;
                *(LAS unsigned long long*)(QP + t * PB + dd0 * 2) = (unsigned long long)pk2(na0[4 * g4] * dv, na0[4 * g4 + 1] * dv) | ((unsigned long long)pk2(na0[4 * g4 + 2] * dv, na0[4 * g4 + 3] * dv) << 32);
                *(LAS unsigned long long*)(QP + t * PB + dd1 * 2) = (unsigned long long)pk2(na1[4 * g4] * dv, na1[4 * g4 + 1] * dv) | ((unsigned long long)pk2(na1[4 * g4 + 2] * dv, na1[4 * g4 + 3] * dv) << 32);
                if (dp == 0 && r == 0) *(LAS unsigned long long*)((LAS unsigned char*)nstb + e0 * 2) = (unsigned long long)pk2(nacc[4 * g4], nacc[4 * g4 + 1]) | ((unsigned long long)pk2(nacc[4 * g4 + 2], nacc[4 * g4 + 3]) << 32);
            }
        }
        __syncthreads();
        STAMP(5);
        {
            float hv[32]; float ss = 0.f;
#pragma unroll
            for (int k = 0; k < 4; ++k) { const v4u x = *(const LAS v4u*)(QP + et * PB + eq * 64 + k * 16);
#pragma unroll
                for (int i = 0; i < 4; ++i) { hv[8 * k + 2 * i] = bflo(x[i]); hv[8 * k + 2 * i + 1] = bfhi(x[i]); ss += hv[8 * k + 2 * i] * hv[8 * k + 2 * i] + hv[8 * k + 2 * i + 1] * hv[8 * k + 2 * i + 1]; } }
            ss += shx(ss, 1, lane); ss += shx(ss, 2, lane);
            const float rr = __builtin_amdgcn_rsqf(ss * (1.0f / 128.0f) + EPS);
            bf16* op = optr + (size_t)c * 128 * PLD;
            LAS const float* nw = nwl + eq * 32;
#pragma unroll
            for (int k = 0; k < 4; ++k) { v4u o; const f32x4 w0 = *(LAS const f32x4*)(nw + 8 * k), w1 = *(LAS const f32x4*)(nw + 8 * k + 4);
#pragma unroll
                for (int i = 0; i < 4; ++i) { const float g0 = sigm_f(bflo(og[k][i])), g1 = sigm_f(bfhi(og[k][i]));
                    const float wa = (i < 2) ? w0[2 * i] : w1[2 * i - 4], wb = (i < 2) ? w0[2 * i + 1] : w1[2 * i - 3];
                    o[i] = pk2(hv[8 * k + 2 * i] * rr * wa * g0, hv[8 * k + 2 * i + 1] * rr * wb * g1); }
                *(v4u*)(op + 8 * k) = o; }
        }
    }
#if PROBE_PHASE != -1 && defined(PROBE_STAGES)
    STAMP(6);
    if (tid == 0 && pts) pts[PROBE_STAGES] = tacc;
#endif
#undef STAMP
    __syncthreads();
}

__device__ __forceinline__ void conv_fix(Frame& F, bf16* proj, const bf16* halo, const float* scw, const float* scb, const float* mcw, const float* mcb) {
    const int gt = F.vcu * (NWAVES * 64) + F.tid, NT = F.G * NWAVES * 64;
    for (int it = gt; it < 256 * 320; it += NT) {
        const int strip = it % 320, rg = it / 320, hch = strip * 8;
        const float* wp; const float* bp; int wst; float post = 1.0f;
        if (hch < 1536) { wp = scw + hch; bp = scb + hch; wst = 1536; }
        else { const int c2 = hch - 1536; wp = mcw + c2; bp = mcb + c2; wst = 1024; post = (c2 >= 512) ? 0.08838834764831845f : 1.0f; }
        bf16* base = proj + (size_t)rg * 64 * PLD + PC_XBC + hch;
        v4u r0 = (v4u){0, 0, 0, 0}, r1 = r0, r2 = r0;
        if ((rg & 31) != 0) { const bf16* hp = halo + ((size_t)(rg - 1) * 3) * 2560 + hch; r0 = *(const v4u*)hp; r1 = *(const v4u*)(hp + 2560); r2 = *(const v4u*)(hp + 5120); }
        v4u cur[3];
#pragma unroll
        for (int j = 0; j < 3; ++j) cur[j] = *(const v4u*)(base + (size_t)j * PLD);
        float cw[4][8], cb[8];
#pragma unroll
        for (int j = 0; j < 4; ++j) { const f32x4 a0 = *(const f32x4*)(wp + j * wst), a1 = *(const f32x4*)(wp + j * wst + 4);
#pragma unroll
            for (int i = 0; i < 4; ++i) { cw[j][i] = a0[i]; cw[j][4 + i] = a1[i]; } }
        { const f32x4 a0 = *(const f32x4*)bp, a1 = *(const f32x4*)(bp + 4);
#pragma unroll
          for (int i = 0; i < 4; ++i) { cb[i] = a0[i]; cb[4 + i] = a1[i]; } }
#pragma unroll
        for (int j = 0; j < 3; ++j) { v4u o;
#pragma unroll
            for (int i = 0; i < 4; ++i) {
                const float a0 = cb[2 * i] + cw[0][2 * i] * bflo(r0[i]) + cw[1][2 * i] * bflo(r1[i]) + cw[2][2 * i] * bflo(r2[i]) + cw[3][2 * i] * bflo(cur[j][i]);
                const float a1 = cb[2 * i + 1] + cw[0][2 * i + 1] * bfhi(r0[i]) + cw[1][2 * i + 1] * bfhi(r1[i]) + cw[2][2 * i + 1] * bfhi(r2[i]) + cw[3][2 * i + 1] * bfhi(cur[j][i]);
                o[i] = pk2(silu_f(a0) * post, silu_f(a1) * post); }
            *(v4u*)(base + (size_t)j * PLD) = o; r0 = r1; r1 = r2; r2 = cur[j]; }
    }
}

__device__ __forceinline__ void ksum_pass(Frame& F, const bf16* proj, float* ksum) {
    const int gt = F.vcu * (NWAVES * 64) + F.tid, NT = F.G * NWAVES * 64;
    for (int it = gt; it < 64 * 16 * 64; it += NT) {
        const int ch = it & 63, sl = (it >> 6) & 15, tile = it >> 10;
        const bf16* base = proj + ((size_t)tile * 256 + sl * 16) * PLD + PC_K + ch * 8;
        float a[8];
#pragma unroll
        for (int i = 0; i < 8; ++i) a[i] = 0.f;
        v4u v[16];
#pragma unroll
        for (int j = 0; j < 16; ++j) v[j] = *(const v4u*)(base + (size_t)j * PLD);
#pragma unroll
        for (int j = 0; j < 16; ++j)
#pragma unroll
            for (int i = 0; i < 4; ++i) { a[2 * i] += bflo(v[j][i]); a[2 * i + 1] += bfhi(v[j][i]); }
        float* kd = ksum + (size_t)tile * 512 + ch * 8;
#pragma unroll
        for (int i = 0; i < 8; ++i) atomicAdd(kd + i, a[i]);
    }
}

namespace attn_body {
using bf16=__hip_bfloat16;
using bf16x8=__attribute__((ext_vector_type(8)))short;
using s16x4=__attribute__((ext_vector_type(4)))short;
using f32x16=__attribute__((ext_vector_type(16)))float;
using u32x4=__attribute__((ext_vector_type(4)))unsigned;
constexpr int BATCH=8,NHEAD=8,SEQ=2048,D=64,DM=6144;
constexpr int NW=8,QBLK=32,QB=QBLK*NW,KVBLK=64,NQB=SEQ/QB;
constexpr int ATTN_PITCH=DM, ATTN_UNIT_ROWS=QB;
__device__ __forceinline__ int crow(int r,int hi){return (r&3)+8*(r>>2)+4*hi;}
#define SBAR() __builtin_amdgcn_sched_barrier(0)
__device__ __forceinline__ void cmask(f32x16&p0,f32x16&p1,int jb,int qrel,int hi){
  const float NEG=-INFINITY; int kb=64*jb+4*hi;
  #pragma unroll
  for(int r=0;r<16;++r){int kv=kb+(r&3)+8*(r>>2); if(kv>qrel)p0[r]=NEG; if(kv+32>qrel)p1[r]=NEG;}
}

typedef float f32x4_t __attribute__((ext_vector_type(4)));
__device__ __forceinline__ float bfu(short v){return __uint_as_float(((unsigned)(unsigned short)v)<<16);}
constexpr int NSLOT=3, SLOTB=8192;
constexpr int LDS_K=0, LDS_V=NSLOT*SLOTB, LDS_WS=2*NSLOT*SLOTB, LDS_OST=LDS_WS+NW*64*4, LDS_BYTES=LDS_OST+NW*4096;
constexpr float C2=0.125f*1.4426950408889634f;
__device__ __forceinline__ void glds16(const void*gsrc,unsigned lds_dst){unsigned keep;
  asm volatile("s_mov_b32 %0, m0\n\ts_mov_b32 m0, %2\n\ts_nop 0\n\tglobal_load_lds_dwordx4 %1, off\n\ts_mov_b32 m0, %0":"=&s"(keep):"v"(gsrc),"s"(lds_dst):"memory");}
__device__ __forceinline__ float max3f(float a,float b,float c){float r;asm("v_max3_f32 %0, %1, %2, %3":"=v"(r):"v"(a),"v"(b),"v"(c));return r;}
__device__ __forceinline__ float max2f(float a,float b){float r;asm("v_max_f32_e32 %0, %1, %2":"=v"(r):"v"(a),"v"(b));return r;}
__device__ __forceinline__ float fadd_s(float a,float b){float r;asm("v_add_f32_e32 %0, %1, %2":"=v"(r):"v"(a),"v"(b));return r;}
__device__ __forceinline__ float fsub_s(float a,float b){float r;asm("v_sub_f32_e32 %0, %1, %2":"=v"(r):"v"(a),"v"(b));return r;}
typedef float f32x2_t __attribute__((ext_vector_type(2))); typedef __bf16 bf16x2_t __attribute__((ext_vector_type(2)));
__device__ __forceinline__ unsigned cvtpk_s(float lo,float hi){f32x2_t v={lo,hi};bf16x2_t b=__builtin_convertvector(v,bf16x2_t);return __builtin_bit_cast(unsigned,b);}
#define WAIT_BAR(N) asm volatile("s_waitcnt vmcnt(" #N ") lgkmcnt(0)\n\ts_barrier":::"memory")

__device__ __forceinline__ void qkt(f32x16&p0,f32x16&p1,const char*Kslot,const bf16x8*qr,const f32x16&negm,int r32,int hi){
  const char*kb=Kslot+hi*1024+r32*16;
  #pragma unroll
  for(int d0=0;d0<4;++d0){
    const bf16x8 b0=*reinterpret_cast<const bf16x8*>(kb+d0*2048);
    const bf16x8 b1=*reinterpret_cast<const bf16x8*>(kb+d0*2048+512);
    if(d0==0){p0=__builtin_amdgcn_mfma_f32_32x32x16_bf16(b0,qr[0],negm,0,0,0);p1=__builtin_amdgcn_mfma_f32_32x32x16_bf16(b1,qr[0],negm,0,0,0);}
    else{p0=__builtin_amdgcn_mfma_f32_32x32x16_bf16(b0,qr[d0],p0,0,0,0);p1=__builtin_amdgcn_mfma_f32_32x32x16_bf16(b1,qr[d0],p1,0,0,0);}}
}
typedef __attribute__((address_space(3))) const char* lds_cptr;
typedef short v4i16_t __attribute__((ext_vector_type(4)));
__device__ __forceinline__ void kload8(bf16x8*kf,lds_cptr kp){
  kf[0]=*(const __attribute__((address_space(3))) bf16x8*)(kp);      kf[1]=*(const __attribute__((address_space(3))) bf16x8*)(kp+512);
  kf[2]=*(const __attribute__((address_space(3))) bf16x8*)(kp+2048); kf[3]=*(const __attribute__((address_space(3))) bf16x8*)(kp+2560);
  kf[4]=*(const __attribute__((address_space(3))) bf16x8*)(kp+4096); kf[5]=*(const __attribute__((address_space(3))) bf16x8*)(kp+4608);
  kf[6]=*(const __attribute__((address_space(3))) bf16x8*)(kp+6144); kf[7]=*(const __attribute__((address_space(3))) bf16x8*)(kp+6656);
}
__device__ __forceinline__ void kload2(bf16x8*kf,lds_cptr kp,int j){ kf[2*j]=*(const __attribute__((address_space(3))) bf16x8*)(kp+j*2048); kf[2*j+1]=*(const __attribute__((address_space(3))) bf16x8*)(kp+j*2048+512); }
__device__ __forceinline__ s16x4 vtr(lds_cptr p){ return __builtin_bit_cast(s16x4,__builtin_amdgcn_ds_read_tr16_b64_v4i16((__attribute__((address_space(3))) v4i16_t*)p)); }
__device__ __forceinline__ float rowmax(const f32x16&p0,const f32x16&p1){
  float a=max3f(p0[0],p0[1],p1[0]),b=max3f(p0[2],p0[3],p1[1]);a=max3f(a,p1[2],p1[3]);
  #pragma unroll
  for(int r=4;r<16;r+=4){a=max3f(a,p0[r],p0[r+1]);b=max3f(b,p0[r+2],p0[r+3]);a=max3f(a,p1[r],p1[r+1]);b=max3f(b,p1[r+2],p1[r+3]);}
  const float m=max2f(a,b);
  auto rr=__builtin_amdgcn_permlane32_swap(__float_as_uint(m),__float_as_uint(m),false,false);
  return max2f(__uint_as_float(rr[0]),__uint_as_float(rr[1]));
}
__device__ __forceinline__ void pv(f32x16*o,int vb,bf16x8 pa0,bf16x8 pa1,bf16x8 pa2,bf16x8 pa3){
  #pragma unroll
  for(int d0=0;d0<2;++d0){s16x4 lo[4],hi[4];
    #pragma unroll
    for(int ks=0;ks<4;++ks){
      asm volatile("ds_read_b64_tr_b16 %0,%1 offset:%c2":"=&v"(lo[ks]):"v"(vb),"i"(d0*4096+ks*1024):"memory");
      asm volatile("ds_read_b64_tr_b16 %0,%1 offset:%c2":"=&v"(hi[ks]):"v"(vb),"i"(d0*4096+ks*1024+512):"memory");}
    asm volatile("s_waitcnt lgkmcnt(0)":::"memory");SBAR();
    #define PK(k) (bf16x8){lo[k][0],lo[k][1],lo[k][2],lo[k][3],hi[k][0],hi[k][1],hi[k][2],hi[k][3]}
    o[d0]=__builtin_amdgcn_mfma_f32_32x32x16_bf16(pa0,PK(0),o[d0],0,0,0);
    o[d0]=__builtin_amdgcn_mfma_f32_32x32x16_bf16(pa1,PK(1),o[d0],0,0,0);
    o[d0]=__builtin_amdgcn_mfma_f32_32x32x16_bf16(pa2,PK(2),o[d0],0,0,0);
    o[d0]=__builtin_amdgcn_mfma_f32_32x32x16_bf16(pa3,PK(3),o[d0],0,0,0);
    #undef PK
  }
}

#ifndef ATTN_STORE16
#define ATTN_STORE16(p,v) (*(u32x4*)(p)=(v))
#endif
template<int THRL> __device__ __forceinline__ void attn_unit(int tid,int b,int h,int qb,const bf16*Q,const bf16*__restrict__ K,const bf16*__restrict__ V,bf16*O,const float*__restrict__ ksum,char*shm){
  asm volatile("":"+v"(tid));
  const int lane=tid&63,r32=lane&31,hi=lane>>5; const int wid=__builtin_amdgcn_readfirstlane(tid>>6);
  const long rowbase=(long)b*SEQ; const int q0=qb*QB;
  const bf16*Qw=Q+(rowbase+q0+wid*QBLK)*DM+h*D;
  const bf16*Kh=K+rowbase*DM+h*D,*Vh=V+rowbase*DM+h*D;
  const unsigned lds0=(unsigned)(uintptr_t)shm;
  float*wsf=(float*)(shm+LDS_WS)+wid*64;
  const bf16*ksrc=Kh+(long)lane*DM+wid*8;
  const bf16*vsrc=Vh+(long)(16*(wid&3)+(lane>>2))*DM+(wid>>2)*32+(lane&3)*8;
  const unsigned kdst=lds0+LDS_K+wid*1024, vdst=lds0+LDS_V+wid*1024;
  #define DMA_K(t,slot) glds16(ksrc+(long)(t)*KVBLK*DM,(unsigned)__builtin_amdgcn_readfirstlane(kdst+(slot)))
  #define DMA_V(t,slot) glds16(vsrc+(long)(t)*KVBLK*DM,(unsigned)__builtin_amdgcn_readfirstlane(vdst+(slot)))
  const int vb0=(int)(lds0+LDS_V)+((lane>>4)&1)*32+(lane&3)*8+(4*hi+((lane&15)>>2))*64;
  const char*Kbase=shm+LDS_K; bf16x8 kf[8];
  const lds_cptr shm3=(lds_cptr)shm; const lds_cptr kp0=shm3+LDS_K+hi*1024+r32*16; const lds_cptr vp0=shm3+LDS_V+((lane>>4)&1)*32+(lane&3)*8+(4*hi+((lane&15)>>2))*64;
  const int NT=(q0+QB)/KVBLK;
  DMA_K(0,0);DMA_V(0,0);DMA_K(1,SLOTB);
  bf16x8 qr[4];
  #pragma unroll
  for(int d0=0;d0<4;++d0)qr[d0]=*reinterpret_cast<const bf16x8*>(&Qw[(long)r32*DM+d0*16+hi*8]);
  unsigned sel=(1u<<qb)-1u;
  if(qb>=4){
    float g[8];
    #pragma unroll
    for(int n=0;n<8;++n){ g[n]=0.f;
      { const float*kp=ksum+(((long)(b*8+n)*NHEAD+h)*64)+hi*8; float a=0.f;
        #pragma unroll
        for(int d0=0;d0<4;++d0){ const f32x4_t k0=*(const f32x4_t*)(kp+d0*16),k1=*(const f32x4_t*)(kp+d0*16+4);
          #pragma unroll
          for(int j=0;j<4;++j){ a+=bfu(qr[d0][j])*k0[j]; a+=bfu(qr[d0][4+j])*k1[j]; } }
        a+=shx(a,32,lane); g[n]=a; } }
    sel=0u;
    #pragma unroll
    for(int k=0;k<3;++k){ int best=-1; float bv=0.f;
      #pragma unroll
      for(int n=0;n<8;++n) if(n<qb&&!((sel>>n)&1u)){ if(best<0||g[n]>bv){best=n;bv=g[n];} }
      sel|=1u<<best; }
  }
  const f32x16 ninf={-INFINITY,-INFINITY,-INFINITY,-INFINITY,-INFINITY,-INFINITY,-INFINITY,-INFINITY,-INFINITY,-INFINITY,-INFINITY,-INFINITY,-INFINITY,-INFINITY,-INFINITY,-INFINITY};
  #define CINIT(t) ({ const bool mk_=((t)<NT-4)&&!((sel>>((t)>>2))&1u); f32x16 c_; _Pragma("unroll") for(int r_=0;r_<16;++r_)c_[r_]=mk_?ninf[r_]:negm[r_]; c_; })
  float mhat=0.f,l_reg=0.f;f32x16 o[2];o[0]=f32x16{};o[1]=f32x16{};f32x16 negm=f32x16{};asm volatile("":"+v"(negm));
  const int qrel=wid*QBLK+r32;
  #define CMASK(P0,P1,t) do{int jb_=(t)-(NT-4); if(jb_>=0)cmask(P0,P1,jb_,qrel,hi);}while(0)
  bool resc=false;
  #define START(P0,P1) do{ const float rm=rowmax(P0,P1); resc=false; \
    { const float dl=max2f(rm,-64.f); mhat=fadd_s(mhat,dl); \
      _Pragma("unroll") for(int r=0;r<16;++r){P0[r]=fsub_s(P0[r],dl);P1[r]=fsub_s(P1[r],dl);} \
      _Pragma("unroll") for(int r=0;r<16;++r)negm[r]=-mhat; asm volatile("":"+v"(negm)); } \
    _Pragma("unroll") for(int r=0;r<16;++r)P0[r]=__builtin_amdgcn_exp2f(P0[r]); }while(0)
  #define RESC() do{ if(resc){ asm volatile("s_waitcnt lgkmcnt(0)":::"memory"); \
      _Pragma("unroll") for(int d_=0;d_<2;++d_) _Pragma("unroll") for(int r=0;r<16;++r)o[d_][r]*=wsf[crow(r,hi)]; } }while(0)
  f32x16 pA0,pA1,pB0,pB1;
  int sl_prev=0,sl_cur=0,sl_next=SLOTB;
  #define ROT() do{sl_prev=sl_cur;sl_cur=sl_next;sl_next=(sl_next==(NSLOT-1)*SLOTB)?0:sl_next+SLOTB;}while(0)
  DMA_K(2,2*SLOTB);
  WAIT_BAR(3);
  { const f32x16 c0_=CINIT(0); qkt(pA0,pA1,Kbase,qr,c0_,r32,hi); }asm volatile("s_nop 15\n\ts_nop 7":"+v"(pA0),"+v"(pA1));CMASK(pA0,pA1,0);
  START(pA0,pA1);
  _Pragma("unroll") for(int r=0;r<16;++r)pA1[r]=__builtin_amdgcn_exp2f(pA1[r]);
  WAIT_BAR(0);
  DMA_K(3,0);DMA_V(1,SLOTB);
  ROT();
  kload8(kf,kp0+sl_cur);
  WAIT_BAR(2);
  s16x4 vlo[8],vhi[8]; u32x4 pw0,pw1,pw2,pw3;
  #define PKW(P,B) cvtpk_s(P[B],P[B+1])
  #define PAF(k) __builtin_bit_cast(bf16x8,pw##k)
  #define VFR(i) (bf16x8){vlo[i][0],vlo[i][1],vlo[i][2],vlo[i][3],vhi[i][0],vhi[i][1],vhi[i][2],vhi[i][3]}
  #define PIN(x) asm volatile("":"+v"(x))
  #define MX3(a,b,c) __builtin_fmaxf(__builtin_fmaxf((a),(b)),(c))
  #define GAPA(MF,A0,A1,A2,A3,W0,W1,PW) do{ MF; sacc+=A0; sacc+=A1; sacc+=A2; sacc+=A3; PIN(sacc); W0; W1; PIN(PW); SBAR(); }while(0)
  #define EX(v) __builtin_amdgcn_exp2f(v)
  #define GAPB(MF,X,B) do{ MF; X[B]=EX(X[B]); X[B+1]=EX(X[B+1]); X[B+2]=EX(X[B+2]); X[B+3]=EX(X[B+3]); PIN(X); SBAR(); }while(0)
  #define VRD(i) do{ vlo[i]=vtr(vp_+(((i)>>2)*4096+((i)&3)*1024)); vhi[i]=vtr(vp_+(((i)>>2)*4096+((i)&3)*1024+512)); }while(0)
  #define KRD(G,j) do{ if(G){ kload2(kf,kp0+sl_next,j); SBAR(); } }while(0)
  #define STEP(C0,C1,P0,P1,t,GK,GV,GL) do{ SBAR(); \
    const lds_cptr vp_=vp0+sl_prev; const f32x16 cin_=CINIT(t); \
    VRD(0); SBAR(); float sacc=(P0[0]+P0[1]); \
    GAPA(C0=__builtin_amdgcn_mfma_f32_32x32x16_bf16(kf[0],qr[0],cin_,0,0,0), P0[2],P0[3],P0[4],P0[5],     pw0[0]=PKW(P0,0), pw0[1]=PKW(P0,2), pw0); \
    VRD(4); SBAR(); GAPA(C1=__builtin_amdgcn_mfma_f32_32x32x16_bf16(kf[1],qr[0],cin_,0,0,0), P0[6],P0[7],P0[8],P0[9],     pw0[2]=PKW(P0,4), pw0[3]=PKW(P0,6), pw0); \
    VRD(1); SBAR(); GAPA(C0=__builtin_amdgcn_mfma_f32_32x32x16_bf16(kf[2],qr[1],C0,0,0,0),   P0[10],P0[11],P0[12],P0[13], pw1[0]=PKW(P0,8), pw1[1]=PKW(P0,10), pw1); \
    VRD(5); SBAR(); GAPA(C1=__builtin_amdgcn_mfma_f32_32x32x16_bf16(kf[3],qr[1],C1,0,0,0),   P0[14],P0[15],P1[0],P1[1],   pw1[2]=PKW(P0,12),pw1[3]=PKW(P0,14), pw1); \
    VRD(2); SBAR(); GAPA(C0=__builtin_amdgcn_mfma_f32_32x32x16_bf16(kf[4],qr[2],C0,0,0,0),   P1[2],P1[3],P1[4],P1[5],     pw2[0]=PKW(P1,0), pw2[1]=PKW(P1,2), pw2); \
    VRD(6); SBAR(); GAPA(C1=__builtin_amdgcn_mfma_f32_32x32x16_bf16(kf[5],qr[2],C1,0,0,0),   P1[6],P1[7],P1[8],P1[9],     pw2[2]=PKW(P1,4), pw2[3]=PKW(P1,6), pw2); \
    VRD(3); SBAR(); GAPA(C0=__builtin_amdgcn_mfma_f32_32x32x16_bf16(kf[6],qr[3],C0,0,0,0),   P1[10],P1[11],P1[12],P1[13], pw3[0]=PKW(P1,8), pw3[1]=PKW(P1,10), pw3); \
    VRD(7); SBAR(); GAPA(C1=__builtin_amdgcn_mfma_f32_32x32x16_bf16(kf[7],qr[3],C1,0,0,0),   P1[14],P1[15],0.f,0.f,       pw3[2]=PKW(P1,12),pw3[3]=PKW(P1,14), pw3); \
    l_reg+=sacc; \
    if(GK){DMA_K((t)+3,sl_cur);} if(GV){DMA_V((t)+1,sl_next);} \
    CMASK(C0,C1,t); \
    { float a=MX3(C0[0],C0[1],C1[0]),b=MX3(C0[2],C0[3],C1[1]); a=MX3(a,C1[2],C1[3]); \
      _Pragma("unroll") for(int r=4;r<16;r+=4){a=MX3(a,C0[r],C0[r+1]);b=MX3(b,C0[r+2],C0[r+3]);a=MX3(a,C1[r],C1[r+1]);b=MX3(b,C1[r+2],C1[r+3]);} \
      float rm=__builtin_fmaxf(a,b); { auto rr=__builtin_amdgcn_permlane32_swap(__float_as_uint(rm),__float_as_uint(rm),false,false); rm=__builtin_fmaxf(__uint_as_float(rr[0]),__uint_as_float(rr[1])); } \
      resc=false; \
      if(__builtin_expect(__any(rm>(float)THRL),0)){ const float dl=__builtin_fmaxf(rm,0.f); mhat+=dl; \
        _Pragma("unroll") for(int r=0;r<16;++r){C0[r]-=dl;C1[r]-=dl;} \
        _Pragma("unroll") for(int r=0;r<16;++r)negm[r]=-mhat; asm volatile("":"+v"(negm)); \
        const float f=__builtin_amdgcn_exp2f(-dl); l_reg*=f; if(hi==0)wsf[r32]=f; resc=true; } } \
    SBAR(); \
    GAPB(o[0]=__builtin_amdgcn_mfma_f32_32x32x16_bf16(PAF(0),VFR(0),o[0],0,0,0), C0,0); \
    GAPB(o[1]=__builtin_amdgcn_mfma_f32_32x32x16_bf16(PAF(0),VFR(4),o[1],0,0,0), C0,4); \
    KRD(GL,0); GAPB(o[0]=__builtin_amdgcn_mfma_f32_32x32x16_bf16(PAF(1),VFR(1),o[0],0,0,0), C0,8); \
    KRD(GL,1); GAPB(o[1]=__builtin_amdgcn_mfma_f32_32x32x16_bf16(PAF(1),VFR(5),o[1],0,0,0), C0,12); \
    KRD(GL,2); GAPB(o[0]=__builtin_amdgcn_mfma_f32_32x32x16_bf16(PAF(2),VFR(2),o[0],0,0,0), C1,0); \
    KRD(GL,3); GAPB(o[1]=__builtin_amdgcn_mfma_f32_32x32x16_bf16(PAF(2),VFR(6),o[1],0,0,0), C1,4); \
    GAPB(o[0]=__builtin_amdgcn_mfma_f32_32x32x16_bf16(PAF(3),VFR(3),o[0],0,0,0), C1,8); \
    GAPB(o[1]=__builtin_amdgcn_mfma_f32_32x32x16_bf16(PAF(3),VFR(7),o[1],0,0,0), C1,12); \
    }while(0)
  int t=1;
  #undef CMASK
  #define CMASK(P0,P1,t) do{}while(0)
  for(;t+5<NT;t+=2){
    STEP(pB0,pB1,pA0,pA1,t,true,true,true);     WAIT_BAR(2); RESC(); ROT();
    STEP(pA0,pA1,pB0,pB1,t+1,true,true,true);   WAIT_BAR(2); RESC(); ROT();
  }
  #undef CMASK
  #define CMASK(P0,P1,t) do{int jb_=(t)-(NT-4); if(jb_>=0)cmask(P0,P1,jb_,qrel,hi);}while(0)
  #define ENDW(tt) do{ if((tt)+3<NT){WAIT_BAR(2);} else if((tt)+2<NT){WAIT_BAR(1);} else {WAIT_BAR(0);} }while(0)
  for(;t+1<NT;t+=2){
    STEP(pB0,pB1,pA0,pA1,t,(t+3<NT),(t+1<NT),(t+1<NT));       ENDW(t);   RESC(); ROT();
    STEP(pA0,pA1,pB0,pB1,t+1,(t+4<NT),(t+2<NT),(t+2<NT));     ENDW(t+1); RESC(); ROT();
  }
  STEP(pB0,pB1,pA0,pA1,NT-1,false,false,false); RESC();
  { float sacc=pB0[0]+pB0[1]; _Pragma("unroll") for(int r=2;r<16;++r)sacc+=pB0[r]; _Pragma("unroll") for(int r=0;r<16;++r)sacc+=pB1[r]; l_reg+=sacc;
    pw0=(u32x4){PKW(pB0,0),PKW(pB0,2),PKW(pB0,4),PKW(pB0,6)};pw1=(u32x4){PKW(pB0,8),PKW(pB0,10),PKW(pB0,12),PKW(pB0,14)};pw2=(u32x4){PKW(pB1,0),PKW(pB1,2),PKW(pB1,4),PKW(pB1,6)};pw3=(u32x4){PKW(pB1,8),PKW(pB1,10),PKW(pB1,12),PKW(pB1,14)};
    SBAR(); pv(o,vb0+sl_cur,PAF(0),PAF(1),PAF(2),PAF(3)); }
  #undef PKW
  #undef PAF
  #undef VFR
  #undef PIN
  #undef MX3
  #undef GAPA
  #undef GAPB
  #undef EX
  #undef VRD
  #undef KRD
  #undef STEP
  #undef ENDW
  {auto rr=__builtin_amdgcn_permlane32_swap(__float_as_uint(l_reg),__float_as_uint(l_reg),false,false);l_reg=__uint_as_float(rr[0])+__uint_as_float(rr[1]);}
  if(hi==0)wsf[32+r32]=l_reg;asm volatile("s_waitcnt lgkmcnt(0)":::"memory");
  float rli[16];
  #pragma unroll
  for(int r=0;r<16;++r)rli[r]=__builtin_amdgcn_rcpf(wsf[32+crow(r,hi)]);
  bf16*Ow=O+(rowbase+q0+wid*QBLK)*DM+h*D;
  { bf16*stg=(bf16*)(shm+LDS_OST)+wid*2048;
    #pragma unroll
    for(int r=0;r<16;++r){const int orow=crow(r,hi);
      #pragma unroll
      for(int d0=0;d0<2;++d0)stg[orow*64+d0*32+r32]=__float2bfloat16(o[d0][r]*rli[r]);}
    asm volatile("s_waitcnt lgkmcnt(0)":::"memory");
    #pragma unroll
    for(int i=0;i<4;++i){const int row=i*8+(lane>>3),ch=lane&7; const u32x4 v=*(const u32x4*)(stg+row*64+ch*8); ATTN_STORE16(Ow+(long)row*DM+ch*8,v);} }
  asm volatile("s_waitcnt lgkmcnt(0)\n\ts_barrier":::"memory");
  #undef CINIT
  #undef DMA_K
  #undef DMA_V
  #undef CMASK
  #undef START
  #undef RESC
  #undef ROT
}
constexpr int ATTN_LDS_BYTES=LDS_BYTES;
#undef SBAR
#undef WAIT_BAR
}

constexpr int PH_PER_LAYER = 10, N_PHASES = PH_PER_LAYER * DEPTH;

constexpr int CONV_UNIT_ITEMS = 16, N_CONV_UNITS = (1024 + 2816) / CONV_UNIT_ITEMS;
__device__ __forceinline__ void conv_unit(int wave, int lane, int idx, const float* w_out, const float* ssm_nw, const float* w_up, const float* n2w, bf16* bufa, bf16* bufb, LAS float* scr) {
    for (int it = CONV_UNIT_ITEMS * idx + wave; it < CONV_UNIT_ITEMS * idx + CONV_UNIT_ITEMS; it += NWAVES) {
        if (it < 1024) { const int kb = it >> 5, nb = it & 31; conv_item(w_out, DM, 32 * nb, bufb, DMIX, 32 * nb, 64 * kb, scr, lane, ssm_nw, 512, 1536); }
        else { const int i2 = it - 1024, kb = i2 / (ULD / 32), nb = i2 % (ULD / 32); const int src = ((nb >> 2) & 1) * FFN + 128 * (nb >> 3) + (nb & 3) * 32;
            conv_item(w_up, ULD, src, bufa, DM, 32 * nb, 64 * kb, scr, lane, n2w); }
    }
}

template <int L, int P>
__device__ __forceinline__ void run_phase(Frame& F, const int wave0, const int ph_lo, const int ph_hi) {
    constexpr int l = L, p = P, ph = L * PH_PER_LAYER + P;
    if constexpr ((L > 0 && P == 0) || P == 4 || P == 6 || P == 8) return;
    if (!(ph_lo <= ph && ph < ph_hi)) return;
    {
        const __attribute__((address_space(4))) Args* ap = (const __attribute__((address_space(4))) Args*)__builtin_amdgcn_kernarg_segment_ptr();
        asm volatile("" : "+s"(ap));
        { int t_ = wave0 * 64 + fresh_lane(); asm volatile("" : "+v"(t_)); F.tid = t_; F.lane = t_ & 63; F.wave = __builtin_amdgcn_readfirstlane(t_ >> 6); }
        F.G = gridDim.x; { const int bx = blockIdx.x; F.vcu = (F.G % 8 == 0) ? (bx % 8) * (F.G / 8) + bx / 8 : bx; }
        unsigned char* ws = ap->ws; float* out = ap->out;
        bf16* bufa = (bf16*)(ws + WS_BUFA); bf16* bufb = (bf16*)(ws + WS_BUFB); bf16* xb = (bf16*)(ws + WS_XB); bf16* proj = (bf16*)(ws + WS_PROJ);
        float* smallp = (float*)(ws + WS_SMALLP); float* ssq = (float*)(ws + WS_SSQ);
        switch (p) {
        case 0: {
            LAS float* scr = (LAS float*)(F.lds + F.wave * 16384);
            conv_w_in(F, ap->in[2], ap->in[1], bufa, scr);
            conv_small(F, ap->in[2], ap->in[1], (bf16*)(ws + WS_WSM));
            row_pass0(F, ap->in[0], xb, (float*)(ws + WS_RS));
        } break;
        case 1: {
            const float* rs = (const float*)(ws + WS_RS) + (size_t)(2 * l) * M;
            pg8::Gemm g{xb, bufa, M, PLD, DM, DM}; pg8::StaticOrder S; S.init(M, PLD, F.G, (int)blockIdx.x);
            pg8::EpiProj E{ws, (const float* const __attribute__((address_space(4)))*)ap->in, l};
            pg8::gemm_phase<pg8::EpiProj>(F.lds + RING_OFF, g, S, E, F.tid);
            small_proj(F, xb, (const bf16*)(ws + WS_WSM) + (size_t)(l & 1) * 32 * DM, rs, smallp);
        } break;
        case 2: {
            ksum_pass(F, proj, (float*)(ws + WS_KSUM + (size_t)l * 131072));
            conv_fix(F, proj, (const bf16*)(ws + WS_HALO), ap->in[5] + (size_t)l * 4 * 1536, ap->in[6] + l * 1536, ap->in[11] + (size_t)l * 4 * 1024, ap->in[12] + l * 1024);
        } break;
        case 3: {
            gu32* qhead = (gu32*)(ws + WS_QUEUE) + l * 64;
            volatile LAS unsigned* MISC = (volatile LAS unsigned*)(F.lds + MISC_OFF);
            const attn_body::bf16* pq = (const attn_body::bf16*)proj; const float* ks = (const float*)(ws + WS_KSUM + (size_t)l * 131072);
            for (;;) {
                const int tq = wave0 * 64 + fresh_lane();
                __syncthreads();
                if (tq == 0) MISC[0] = __hip_atomic_fetch_add(qhead, 1u, RLX_AGENT);
                __syncthreads();
                const int u = (int)MISC[0];
                if (u >= 672 + N_CONV_UNITS) break;
#if PROBE_PHASE != -1
                const unsigned long long tu0 = __builtin_amdgcn_s_memrealtime();
#endif
                if (u < 32) mlstm_unit(tq, proj, smallp, ap->in[13] + l * 4, ap->in[14] + l * 4, ap->in[15] + l * 512, u >> 2, u & 3, F.lds, (float*)(ws + WS_GSC) + (size_t)u * 16 * 656, (l == 0 && u == 0) ? (unsigned long long*)(ws + WS_TS) + 1024 : nullptr);
                else if (u < 160) ssd_unit(tq, proj, smallp, ssq, ap->in[7] + l * 16, ap->in[8] + l * 16, ap->in[9] + l * 16, (u - 32) >> 4, (u - 32) & 15, F.lds);
                else if (u < 672) { const int idx = u - 160, bh = idx & 63, qb = 7 - (idx >> 6);
                    attn_body::attn_unit<8>(tq, bh >> 3, bh & 7, qb, pq + PC_Q, pq + PC_K, pq + PC_V, (attn_body::bf16*)proj + PC_Q, ks, (char*)F.lds); }
                else conv_unit(wave0, tq & 63, u - 672, ap->in[16] + (size_t)l * DMIX * DM, ap->in[10] + l * 1024, ap->in[18] + (size_t)l * DM * ULD, ap->in[17] + l * DM, bufa, bufb, (LAS float*)(F.lds + wave0 * 16384));
#if PROBE_PHASE != -1
                if (l == 0 && wave0 == 0 && fresh_lane() == 0) __hip_atomic_store((unsigned long long*)(ws + WS_TS) + 128 + u, (unsigned long long)(__builtin_amdgcn_s_memrealtime() - tu0), __ATOMIC_RELAXED, __HIP_MEMORY_SCOPE_AGENT);
#endif
            }
        } break;
        case 4: break;
        case 5: {
            pg8::Gemm g{proj, bufb, M, DM, DMIX, PLD}; pg8::StaticOrder S; S.init(M, DM, F.G, (int)blockIdx.x);
            LAS float* ftab = (LAS float*)(F.lds + RING_BYTES);
            { pg8::Unit u0; if (S.next(0, u0)) { const int row = F.tid >> 1; const float* sq = ssq + (size_t)(u0.pm * 256 + row) * 16;
                const f32x4 a0 = *(const f32x4*)sq, a1 = *(const f32x4*)(sq + 4), a2 = *(const f32x4*)(sq + 8), a3 = *(const f32x4*)(sq + 12);
                const float s0 = ((a0[0] + a0[1]) + (a0[2] + a0[3])) + ((a1[0] + a1[1]) + (a1[2] + a1[3])), s1 = ((a2[0] + a2[1]) + (a2[2] + a2[3])) + ((a3[0] + a3[1]) + (a3[2] + a3[3]));
                const float r0 = 1.0f / sqrtf(s0 * (1.0f / 512.0f) + EPS), r1 = 1.0f / sqrtf(s1 * (1.0f / 512.0f) + EPS);
                ftab[F.tid] = (F.tid & 1) ? r1 : r0 / r1; } }
            LDS_WAIT(); __syncthreads();
            pg8::EpiRes E{xb, nullptr, (float*)(ws + WS_RS) + (size_t)(2 * l + 1) * M};
            pg8::gemm_phase<pg8::EpiRes, 1>(F.lds + RING_OFF, g, S, E, F.tid, (const LAS float*)ftab);
        } break;
        case 6: break;
        case 7: {
            pg8::Gemm g{xb, bufa, M, ULD, DM, DM}; pg8::StaticOrder S; S.init(M, ULD, F.G, (int)blockIdx.x);
            pg8::EpiFfn E{proj, (const float*)(ws + WS_RS) + (size_t)(2 * l + 1) * M, ap->in[19] + (size_t)l * 3 * FFN, ap->in[20] + l * FFN, (bf16*)(ws + WS_SIDEA), (bf16*)(ws + WS_SIDEB)};
            pg8::gemm_phase<pg8::EpiFfn>(F.lds + RING_OFF, g, S, E, F.tid);
            {
                const bool half = (F.G == 256); if (!half || blockIdx.x >= 128) { Frame F2 = F; if (half) { F2.vcu = (int)blockIdx.x - 128; F2.G = 128; }
                    conv_plain(F2, ap->in[21] + (size_t)l * FFN * DM, FFN, DM, nullptr, bufb, (LAS float*)(F.lds + F.wave * 16384));
                    if (l + 1 < DEPTH) conv_small(F2, ap->in[2] + (size_t)(l + 1) * DM * P_IN, ap->in[1] + (l + 1) * DM, (bf16*)(ws + WS_WSM) + (size_t)((l + 1) & 1) * 32 * DM); } }
        } break;
        case 8: break;
        case 9: {
            pg8::Gemm g{proj, bufb, M, DM, FFN, FFN}; pg8::StaticOrder S; S.init(M, DM, F.G, (int)blockIdx.x);
            { pg8::Unit u0; for (int i = 0; S.next(i, u0); ++i) ffn_fix(F, proj, (const bf16*)(ws + WS_SIDEA), (const bf16*)(ws + WS_SIDEB), ap->in[19] + (size_t)l * 3 * FFN, ap->in[20] + l * FFN, u0.pm); }
            VM_WAIT(); __syncthreads();
            pg8::EpiRes E{xb, (l + 1 < DEPTH) ? nullptr : out, (float*)(ws + WS_RS) + (size_t)(2 * l + 2) * M};
            pg8::gemm_phase<pg8::EpiRes>(F.lds + RING_OFF, g, S, E, F.tid);
            if (l + 1 < DEPTH) conv_w_in(F, ap->in[2] + (size_t)(l + 1) * DM * P_IN, ap->in[1] + (l + 1) * DM, bufa, (LAS float*)(F.lds + F.wave * 16384));
        } break;
        }
        if (ph + 1 < ph_hi || PROBE_PHASE != -1) { XcdBarrier bar; bar.bar = (unsigned*)(ap->ws + WS_CTL) + CW_BAR; bar.x = xb_xcc_id(); bar.st = (volatile LAS unsigned*)(F.lds + MISC_OFF) + 8; xcd_barrier(bar, wave0 * 64 + fresh_lane()); }
#if PROBE_PHASE != -1
        if (blockIdx.x == 0 && wave0 == 0 && fresh_lane() == 0) { const unsigned long long tnow = __builtin_amdgcn_s_memrealtime();
            __hip_atomic_store((unsigned long long*)(ap->ws + WS_TS) + 1 + ph, tnow, __ATOMIC_RELAXED, __HIP_MEMORY_SCOPE_AGENT);
            if (P == 3 || P == 5 || P == 7 || P == 9) __hip_atomic_store((unsigned long long*)(ap->ws + WS_TS) + 2 + ph, tnow, __ATOMIC_RELAXED, __HIP_MEMORY_SCOPE_AGENT); }
#endif
    }
}

__global__ void __launch_bounds__(NWAVES * 64, 2) fwd(Args args) {
    extern __shared__ __attribute__((aligned(16))) unsigned char lds[];
    Frame F;
    F.lds = (LAS unsigned char*)lds;
    F.tid = threadIdx.x; F.lane = F.tid & 63; F.wave = __builtin_amdgcn_readfirstlane(F.tid >> 6);
    const int wave0 = F.wave;
    for (int u = F.tid; u < (LDS_BYTES - LDSCTL_OFF) / 4; u += NWAVES * 64) ((LAS unsigned*)(F.lds + LDSCTL_OFF))[u] = 0u;
    __syncthreads();
    const int ph_lo = args.ph_lo, ph_hi = args.ph_hi;
#if PROBE_PHASE != -1
    if (blockIdx.x == 0 && F.tid == 0) __hip_atomic_store((unsigned long long*)(args.ws + WS_TS), (unsigned long long)__builtin_amdgcn_s_memrealtime(), __ATOMIC_RELAXED, __HIP_MEMORY_SCOPE_AGENT);
#endif
    if (ph_hi - ph_lo > 1) (void)xcd_barrier_post((unsigned*)(args.ws + WS_CTL) + CW_BAR, (volatile LAS unsigned*)(F.lds + MISC_OFF) + 8);

    run_phase<0, 0>(F, wave0, ph_lo, ph_hi);
    run_phase<0, 1>(F, wave0, ph_lo, ph_hi);
    run_phase<0, 2>(F, wave0, ph_lo, ph_hi);
    run_phase<0, 3>(F, wave0, ph_lo, ph_hi);
    run_phase<0, 4>(F, wave0, ph_lo, ph_hi);
    run_phase<0, 5>(F, wave0, ph_lo, ph_hi);
    run_phase<0, 6>(F, wave0, ph_lo, ph_hi);
    run_phase<0, 7>(F, wave0, ph_lo, ph_hi);
    run_phase<0, 8>(F, wave0, ph_lo, ph_hi);
    run_phase<0, 9>(F, wave0, ph_lo, ph_hi);
    run_phase<1, 0>(F, wave0, ph_lo, ph_hi);
    run_phase<1, 1>(F, wave0, ph_lo, ph_hi);
    run_phase<1, 2>(F, wave0, ph_lo, ph_hi);
    run_phase<1, 3>(F, wave0, ph_lo, ph_hi);
    run_phase<1, 4>(F, wave0, ph_lo, ph_hi);
    run_phase<1, 5>(F, wave0, ph_lo, ph_hi);
    run_phase<1, 6>(F, wave0, ph_lo, ph_hi);
    run_phase<1, 7>(F, wave0, ph_lo, ph_hi);
    run_phase<1, 8>(F, wave0, ph_lo, ph_hi);
    run_phase<1, 9>(F, wave0, ph_lo, ph_hi);
#if PROBE_PHASE != -1
    {
        const __attribute__((address_space(4))) Args* ap = (const __attribute__((address_space(4))) Args*)__builtin_amdgcn_kernarg_segment_ptr();
        const unsigned long long* ts = (const unsigned long long*)(ap->ws + WS_TS);
        float us = 500.f;
#ifdef PROBE_UNIT
        if (true) { us = 0.01f * (float)__hip_atomic_load(ts + PROBE_UNIT, __ATOMIC_RELAXED, __HIP_MEMORY_SCOPE_AGENT); } else
#endif
        if (PROBE_PHASE >= 0) { us = 0.f;
            for (int l = 0; l < DEPTH; ++l) { const int ph = l * PH_PER_LAYER + PROBE_PHASE; if (ph < N_PHASES - 1) us += 0.01f * (float)(__hip_atomic_load(ts + 1 + ph, __ATOMIC_RELAXED, __HIP_MEMORY_SCOPE_AGENT) - __hip_atomic_load(ts + ph, __ATOMIC_RELAXED, __HIP_MEMORY_SCOPE_AGENT)); } }
        const float dl = sqrtf(PROBE_GAIN * us);
        float* o = ap->out;
        for (size_t i = (size_t)blockIdx.x * 512 + wave0 * 64 + fresh_lane(); i < (size_t)M * DM; i += (size_t)gridDim.x * 512) o[i] += (i & 1) ? dl : -dl;
    }
#endif
}

extern "C" void kernel_launch(void* const* d_in, const int* in_sizes, int n_in, void* d_out, int out_size, void* d_ws, size_t ws_size, hipStream_t stream) {
    static int grid = 0;
    if (grid == 0) {
        if (n_in != 22 || in_sizes[0] != M * DM || out_size != M * DM || ws_size < WS_END) { fprintf(stderr, "kernel_launch: unexpected shapes (n_in %d, in0 %d, out %d, ws %zu); nothing launched\n", n_in, n_in > 0 ? in_sizes[0] : -1, out_size, ws_size); grid = -1; return; }
        int dev = 0, cus = 0, per_cu = 0;
        if (hipGetDevice(&dev) != hipSuccess || hipDeviceGetAttribute(&cus, hipDeviceAttributeMultiprocessorCount, dev) != hipSuccess) { grid = -1; return; }
        if (hipFuncSetAttribute((const void*)fwd, hipFuncAttributeMaxDynamicSharedMemorySize, LDS_BYTES) != hipSuccess) { fprintf(stderr, "kernel_launch: hipFuncSetAttribute failed\n"); grid = -1; return; }
        if (hipOccupancyMaxActiveBlocksPerMultiprocessor(&per_cu, (const void*)fwd, NWAVES * 64, LDS_BYTES) != hipSuccess || per_cu < 1) { fprintf(stderr, "kernel_launch: occupancy query reports %d blocks per CU\n", per_cu); per_cu = 1; }
        (void)hipGetLastError();
        grid = cus;
    }
    if (grid < 0) return;
    (void)hipMemsetAsync((char*)d_ws + WS_CTL, 0, CTL_ZERO_BYTES, stream);
    Args a{};
    for (int i = 0; i < 22; ++i) a.in[i] = (const float*)d_in[i];
    a.out = (float*)d_out; a.ws = (unsigned char*)d_ws;
#if MK_MULTI
    for (int ph = 0; ph < N_PHASES; ++ph) {
        a.ph_lo = ph; a.ph_hi = ph + 1;
        hipLaunchKernelGGL(fwd, dim3(grid), dim3(NWAVES * 64), LDS_BYTES, stream, a);
    }
#else
    a.ph_lo = 0; a.ph_hi = N_PHASES;
    hipLaunchKernelGGL(fwd, dim3(grid), dim3(NWAVES * 64), LDS_BYTES, stream, a);
#endif
}
```

```cpp
#include <hip/hip_runtime.h>
#include <hip/hip_bf16.h>
#include <cstdio>
#include <cstdint>
#include <cmath>

#ifndef PROBE_PHASE
#define PROBE_PHASE -1
#endif
#ifndef PROBE_GAIN
#define PROBE_GAIN 1e-6f
#endif
#ifndef MK_MULTI
#define MK_MULTI 0
#endif

constexpr int BATCH = 8, SEQ = 2048, DM = 1024, DEPTH = 2;
constexpr int M = BATCH * SEQ;
constexpr int P_IN = 6168;
constexpr int PLD = 6144;
constexpr int PC_Q = 0, PC_Z = 512, PC_MO = 1536, PC_K = 2048, PC_V = 2560, PC_XBC = 3072, PC_MQK = 4608, PC_MV = 5632;
constexpr int SC_Q = 0, SC_K = 512, SC_V = 1024, SC_Z = 1536, SC_XBC = 2560, SC_DT = 4096, SC_MQK = 4112, SC_MV = 5136, SC_MO = 5648, SC_MI = 6160, SC_MF = 6164;
constexpr int FFN = 2816, ULD = 5632;
constexpr int DMIX = 2048;
constexpr float EPS = 1e-6f;
constexpr float C2 = 0.125f * 1.4426950408889634f;

constexpr size_t MiB = 1u << 20;
constexpr size_t WS_CTL = 0, CTL_ZERO_BYTES = 1 * MiB;
constexpr size_t WS_KSUM = 256 * 1024;
constexpr size_t WS_TS = 800 * 1024;
constexpr size_t WS_RS = 512 * 1024;
constexpr size_t WS_QUEUE = 768 * 1024;
constexpr size_t WS_SMALLP = 1 * MiB;
constexpr size_t WS_SSQ = 3 * MiB - 512 * 1024;
constexpr size_t WS_WSM = 3 * MiB + 512 * 1024;
constexpr size_t WS_BUFA = 4 * MiB;
constexpr size_t WS_BUFB = 16 * MiB;
constexpr size_t WS_XB = 22 * MiB;
constexpr size_t WS_HALO = 54 * MiB;
constexpr size_t WS_GSC = 58 * MiB;
constexpr size_t WS_SIDEA = 54 * MiB;
constexpr size_t WS_SIDEB = 57 * MiB;
static_assert(true, "EpiProj hard-codes WS_PROJ = 64 MiB, WS_HALO = 54 MiB, WS_KSUM = 256 KiB, WS_RS = 512 KiB");
constexpr size_t WS_PROJ = 64 * MiB;
constexpr size_t WS_END = 256 * MiB;

namespace pg8 {
#define PG8_LAS __attribute__((address_space(3)))
typedef unsigned short bf16_t;
typedef short bf16x8 __attribute__((ext_vector_type(8)));
typedef float f32x4 __attribute__((ext_vector_type(4)));
typedef unsigned u32x4 __attribute__((ext_vector_type(4)));
constexpr int BM = 256, BK = 64, HALF = 128, HTB = HALF * BK * 2, STAGE_BYTES = 8 * HTB, NXCD = 8, WGM = 8;

__host__ __device__ __forceinline__ int lds_byte(int r, int c) { const int st = (r >> 4) * 2 + (c >> 5), rr = r & 15, cc = c & 31, ob = rr * 64 + cc * 2; return st * 1024 + (ob ^ (((ob >> 9) & 1) << 5)); }
__host__ __device__ __forceinline__ void stage_rc(int b, int& R, int& C) { const int st = b / 1024, sb = b % 1024, swz = sb ^ (((sb >> 9) & 1) << 5); R = (st >> 1) * 16 + swz / 64; C = (st & 1) * 32 + (swz % 64) / 2; }
__host__ __device__ __forceinline__ int perm32(int rho) { const int n = rho >> 4, i = rho & 15; return 8 * (i >> 2) + 4 * n + (i & 3); }

struct Unit { int pm, pn; };
struct Gemm { const bf16_t* A; const bf16_t* Bt; int M, N, K, lda; };

struct StaticOrder {
    int nM, nN, nwg, G, c;
    __host__ __device__ void init(int M_, int N_, int G_, int c_) { nM = M_ / BM; nN = N_ / BM; nwg = nM * nN; G = G_; c = c_; }
    __host__ __device__ bool next(int i, Unit& u) const {
        const long L = (long)i * G + c; if (L >= nwg) return false;
        int wgid = (int)L; { const int q = nwg / NXCD, r = nwg % NXCD, xcd = wgid % NXCD, off = wgid / NXCD; wgid = (xcd < r ? xcd * (q + 1) : r * (q + 1) + (xcd - r) * q) + off; }
        const int nig = WGM * nN, gid = wgid / nig, fm = gid * WGM, gsz = (nM - fm) < WGM ? (nM - fm) : WGM;
        u.pm = fm + ((wgid % nig) % gsz); u.pn = (wgid % nig) / gsz; return true;
    }
};

typedef float f32x2p __attribute__((ext_vector_type(2))); typedef __bf16 bf16x2p __attribute__((ext_vector_type(2)));
__device__ __forceinline__ unsigned cvt_pk_bf16(float lo, float hi) { const f32x2p v = {lo, hi}; return __builtin_bit_cast(unsigned, __builtin_convertvector(v, bf16x2p)); }

struct EpiBf16 {
    static constexpr bool PERM = true;
    bf16_t* O; int ldc;
    __device__ __forceinline__ void operator()(const f32x4 (&acc)[2][2][4][2], const Unit& u, int wr, int wc, int fr, int fq) const {
        const int row0 = u.pm * BM + wr * 64 + fr; const int col0 = u.pn * BM + wc * 32 + 8 * fq;
#pragma unroll
        for (int ai = 0; ai < 2; ++ai)
#pragma unroll
            for (int m = 0; m < 4; ++m) { bf16_t* rowp = O + (size_t)(row0 + ai * HALF + m * 16) * ldc + col0;
#pragma unroll
                for (int bj = 0; bj < 2; ++bj) { const f32x4 v0 = acc[ai][bj][m][0], v1 = acc[ai][bj][m][1];
                    u32x4 w; w.x = cvt_pk_bf16(v0[0], v0[1]); w.y = cvt_pk_bf16(v0[2], v0[3]); w.z = cvt_pk_bf16(v1[0], v1[1]); w.w = cvt_pk_bf16(v1[2], v1[3]);
                    *(u32x4*)(rowp + bj * HALF) = w; } }
    }
};
__device__ __forceinline__ float row_prev(float prevblk, float cur, int n  ) {
    const int pb = __float_as_int(prevblk), cu = __float_as_int(cur);
    const int o = (n == 1) ? __builtin_amdgcn_update_dpp(0, pb, 0x121, 0xf, 0xf, false) : (n == 2) ? __builtin_amdgcn_update_dpp(0, pb, 0x122, 0xf, 0xf, false) : __builtin_amdgcn_update_dpp(0, pb, 0x123, 0xf, 0xf, false);
    return __int_as_float((n == 1) ? __builtin_amdgcn_update_dpp(o, cu, 0x111, 0xf, 0xf, false) : (n == 2) ? __builtin_amdgcn_update_dpp(o, cu, 0x112, 0xf, 0xf, false) : __builtin_amdgcn_update_dpp(o, cu, 0x113, 0xf, 0xf, false));
}
struct EpiProj {
    static constexpr bool PERM = true;
    unsigned char* ws; const float* const __attribute__((address_space(4)))* in; int l;
    __device__ __forceinline__ void operator()(const f32x4 (&acc)[2][2][4][2], const Unit& u, int wr, int wc, int fr, int fq) const {
        bf16_t* P = (bf16_t*)(ws + (size_t)64 * 1048576); bf16_t* halo = (bf16_t*)(ws + (size_t)54 * 1048576);
        const float* rs = (const float*)(ws + 524288) + (size_t)(2 * l) * 16384;
        const float* qw = in[3] + l * 64; const float* kw = in[4] + l * 64;
        const float* scw = in[5] + (size_t)l * 4 * 1536; const float* scb = in[6] + l * 1536; const float* mcw = in[11] + (size_t)l * 4 * 1024; const float* mcb = in[12] + l * 1024;
        const int pn = u.pn; const bool isq = pn < 2, isk = (pn == 8 || pn == 9);
        const int row0 = u.pm * BM + wr * 64 + fr;
        float rr[2][4];
#pragma unroll
        for (int ai = 0; ai < 2; ++ai)
#pragma unroll
            for (int m = 0; m < 4; ++m) rr[ai][m] = rs[row0 + ai * HALF + m * 16];
#pragma unroll
        for (int ai = 0; ai < 2; ++ai)
#pragma unroll
            for (int m = 0; m < 4; ++m) rr[ai][m] = 1.0f / sqrtf(rr[ai][m] * (1.0f / 1024.0f) + EPS);
        if (pn >= 12 && pn < 22) {
            const int col0 = pn * BM + wc * 32 + 8 * fq;
            const bool ssm = pn < 18; const float post = (pn >= 20) ? 0.08838834764831845f : 1.0f; const int wst = ssm ? 1536 : 1024;
#pragma unroll
            for (int bj = 0; bj < 2; ++bj) {
                const int hch = col0 + bj * HALF - PC_XBC; const float* wp = ssm ? (scw + hch) : (mcw + (hch - 1536)); const float* bp = ssm ? (scb + hch) : (mcb + (hch - 1536));
                f32x4 cwv[4][2], cbv[2];
#pragma unroll
                for (int j = 0; j < 4; ++j) { cwv[j][0] = *(const f32x4*)(wp + j * wst); cwv[j][1] = *(const f32x4*)(wp + j * wst + 4); }
                cbv[0] = *(const f32x4*)bp; cbv[1] = *(const f32x4*)(bp + 4);
#pragma unroll
                for (int ai = 0; ai < 2; ++ai) {
                    f32x4 gp[2] = {(f32x4){0.f, 0.f, 0.f, 0.f}, (f32x4){0.f, 0.f, 0.f, 0.f}};
#pragma unroll
                    for (int m = 0; m < 4; ++m) { const int row = row0 + ai * HALF + m * 16;
                        f32x4 g[2]; g[0] = acc[ai][bj][m][0] * rr[ai][m]; g[1] = acc[ai][bj][m][1] * rr[ai][m];
                        u32x4 raw, cv;
#pragma unroll
                        for (int n = 0; n < 2; ++n)
#pragma unroll
                            for (int i2 = 0; i2 < 2; ++i2) { float y[2];
#pragma unroll
                                for (int e = 0; e < 2; ++e) { const int i = 2 * i2 + e; const float x1 = row_prev(gp[n][i], g[n][i], 1), x2 = row_prev(gp[n][i], g[n][i], 2), x3 = row_prev(gp[n][i], g[n][i], 3);
                                    const float a = cbv[n][i] + cwv[0][n][i] * x3 + cwv[1][n][i] * x2 + cwv[2][n][i] * x1 + cwv[3][n][i] * g[n][i];
                                    y[e] = a * __builtin_amdgcn_rcpf(1.0f + __builtin_amdgcn_exp2f(-1.4426950408889634f * a)) * post; }
                                cv[2 * n + i2] = cvt_pk_bf16(y[0], y[1]); raw[2 * n + i2] = cvt_pk_bf16(g[n][2 * i2], g[n][2 * i2 + 1]); }
                        *(u32x4*)(P + (size_t)row * PLD + col0 + bj * HALF) = (m == 0 && fr < 3) ? raw : cv;
                        if (m == 3 && fr >= 13) *(u32x4*)(halo + ((size_t)((row >> 6) * 3 + fr - 13) * 2560 + hch)) = raw;
                        gp[0] = g[0]; gp[1] = g[1]; }
                }
            }
        } else if (!(isq || isk)) {
            const int col0 = pn * BM + wc * 32 + 8 * fq;
#pragma unroll
            for (int ai = 0; ai < 2; ++ai)
#pragma unroll
                for (int m = 0; m < 4; ++m) { bf16_t* rowp = P + (size_t)(row0 + ai * HALF + m * 16) * PLD + col0;
#pragma unroll
                    for (int bj = 0; bj < 2; ++bj) { const f32x4 v0 = acc[ai][bj][m][0] * rr[ai][m], v1 = acc[ai][bj][m][1] * rr[ai][m];
                        u32x4 w; w.x = cvt_pk_bf16(v0[0], v0[1]); w.y = cvt_pk_bf16(v0[2], v0[3]); w.z = cvt_pk_bf16(v1[0], v1[1]); w.w = cvt_pk_bf16(v1[2], v1[3]);
                        *(u32x4*)(rowp + bj * HALF) = w;
                    } }
        } else {
            const float* w = isq ? qw : kw; const float post = isq ? C2 : 1.0f;
            const int colb = pn * BM + 64 * wc + 8 * fq;
#pragma unroll
            for (int ai = 0; ai < 2; ++ai)
#pragma unroll
                for (int m = 0; m < 4; ++m) {
                    float ss = 0.f;
#pragma unroll
                    for (int bj = 0; bj < 2; ++bj)
#pragma unroll
                        for (int n = 0; n < 2; ++n) { const f32x4 x = acc[ai][bj][m][n] * rr[ai][m]; ss += (x[0] * x[0] + x[1] * x[1]) + (x[2] * x[2] + x[3] * x[3]); }
                    ss += __shfl_xor(ss, 16); ss += __shfl_xor(ss, 32);
                    const float r = (1.0f / sqrtf(ss * (1.0f / 64.0f) + EPS)) * post * rr[ai][m];
                    bf16_t* rowp = P + (size_t)(row0 + ai * HALF + m * 16) * PLD + colb;
#pragma unroll
                    for (int bj = 0; bj < 2; ++bj) { const f32x4 w0 = *(const f32x4*)(w + 32 * bj + 8 * fq), w1 = *(const f32x4*)(w + 32 * bj + 8 * fq + 4);
                        const f32x4 v0 = acc[ai][bj][m][0] * r * w0, v1 = acc[ai][bj][m][1] * r * w1;
                        u32x4 o; o.x = cvt_pk_bf16(v0[0], v0[1]); o.y = cvt_pk_bf16(v0[2], v0[3]); o.z = cvt_pk_bf16(v1[0], v1[1]); o.w = cvt_pk_bf16(v1[2], v1[3]);
                        *(u32x4*)(rowp + 32 * bj) = o; }
                    asm volatile("" ::: "memory");
                }
        }
    }
};
struct EpiRes {
    static constexpr bool PERM = true;
    bf16_t* xb; float* out; float* rs;
    __device__ __forceinline__ void operator()(const f32x4 (&acc)[2][2][4][2], const Unit& u, int wr, int wc, int fr, int fq) const {
        const int row0 = u.pm * BM + wr * 64 + fr, col0 = u.pn * BM + wc * 32 + 8 * fq;
#pragma unroll
        for (int ai = 0; ai < 2; ++ai)
#pragma unroll
            for (int m = 0; m < 4; ++m) { const int row = row0 + ai * HALF + m * 16; const size_t off = (size_t)row * 1024 + col0; float ss = 0.f;
#pragma unroll
                for (int bj = 0; bj < 2; ++bj) { const u32x4 bw = *(const u32x4*)(xb + off + bj * HALF);
                    f32x4 v0 = acc[ai][bj][m][0], v1 = acc[ai][bj][m][1];
                    v0[0] += __uint_as_float(bw.x << 16); v0[1] += __uint_as_float(bw.x & 0xffff0000u); v0[2] += __uint_as_float(bw.y << 16); v0[3] += __uint_as_float(bw.y & 0xffff0000u);
                    v1[0] += __uint_as_float(bw.z << 16); v1[1] += __uint_as_float(bw.z & 0xffff0000u); v1[2] += __uint_as_float(bw.w << 16); v1[3] += __uint_as_float(bw.w & 0xffff0000u);
                    if (out) { *(f32x4*)(out + off + bj * HALF) = v0; *(f32x4*)(out + off + bj * HALF + 4) = v1; }
                    else { ss += ((v0[0] * v0[0] + v0[1] * v0[1]) + (v0[2] * v0[2] + v0[3] * v0[3])) + ((v1[0] * v1[0] + v1[1] * v1[1]) + (v1[2] * v1[2] + v1[3] * v1[3]));
                        u32x4 w; w.x = cvt_pk_bf16(v0[0], v0[1]); w.y = cvt_pk_bf16(v0[2], v0[3]); w.z = cvt_pk_bf16(v1[0], v1[1]); w.w = cvt_pk_bf16(v1[2], v1[3]);
                        *(u32x4*)(xb + off + bj * HALF) = w; } }
                if (!out) { ss += __shfl_xor(ss, 16); ss += __shfl_xor(ss, 32); if (fq == 0) atomicAdd(rs + row, ss); }
                asm volatile("" ::: "memory"); }
    }
};
struct EpiScaleBf16 {
    static constexpr bool PERM = true;
    bf16_t* O; int ldc; const float* rs;
    __device__ __forceinline__ void operator()(const f32x4 (&acc)[2][2][4][2], const Unit& u, int wr, int wc, int fr, int fq) const {
        const int row0 = u.pm * BM + wr * 64 + fr; const int col0 = u.pn * BM + wc * 32 + 8 * fq;
        float rr[2][4];
#pragma unroll
        for (int ai = 0; ai < 2; ++ai)
#pragma unroll
            for (int m = 0; m < 4; ++m) rr[ai][m] = rs[row0 + ai * HALF + m * 16];
#pragma unroll
        for (int ai = 0; ai < 2; ++ai)
#pragma unroll
            for (int m = 0; m < 4; ++m) { bf16_t* rowp = O + (size_t)(row0 + ai * HALF + m * 16) * ldc + col0; const float r = 1.0f / sqrtf(rr[ai][m] * (1.0f / 1024.0f) + EPS);
#pragma unroll
                for (int bj = 0; bj < 2; ++bj) { const f32x4 v0 = acc[ai][bj][m][0] * r, v1 = acc[ai][bj][m][1] * r;
                    u32x4 w; w.x = cvt_pk_bf16(v0[0], v0[1]); w.y = cvt_pk_bf16(v0[2], v0[3]); w.z = cvt_pk_bf16(v1[0], v1[1]); w.w = cvt_pk_bf16(v1[2], v1[3]);
                    *(u32x4*)(rowp + bj * HALF) = w; } }
    }
};

typedef float f32x2q __attribute__((ext_vector_type(2)));
__device__ __forceinline__ f32x2q gelu_pk2(f32x2q v) {
    const f32x2q av = __builtin_elementwise_abs(v), d = av * 0.2316418882f + 1.0f;
    f32x2q t; t.x = __builtin_amdgcn_rcpf(d.x); t.y = __builtin_amdgcn_rcpf(d.y);
    f32x2q q = t * 0.5307027145f + (-0.7265760135f); q = q * t + 0.7107068705f; q = q * t + (-0.142248368f); q = q * t + 0.127414796f; q = q * t;
    const f32x2q s = (v * v) * (-0.72134752044f);
    f32x2q e; e.x = __builtin_amdgcn_exp2f(s.x); e.y = __builtin_amdgcn_exp2f(s.y);
    const f32x2q m = v * (q * e), r = v - m;
    f32x2q o; o.x = v.x < 0.f ? m.x : r.x; o.y = v.y < 0.f ? m.y : r.y; return o;
}
struct EpiFfn {
    static constexpr bool PERM = true;
    bf16_t* H; const float* rs; const float* cw  ; const float* cb; bf16_t* sideA  ; bf16_t* sideB  ;
    __device__ __forceinline__ void operator()(const f32x4 (&acc)[2][2][4][2], const Unit& u, int wr, int wc, int fr, int fq) const {
        constexpr int FF = 2816;
        const int row0 = u.pm * BM + wr * 64 + fr, c0 = u.pn * 128 + wc * 32 + 8 * fq;
        float rr[2][4];
#pragma unroll
        for (int ai = 0; ai < 2; ++ai)
#pragma unroll
            for (int m = 0; m < 4; ++m) rr[ai][m] = rs[row0 + ai * HALF + m * 16];
        f32x4 w0[2], w1[2], w2[2], bb[2];
#pragma unroll
        for (int n = 0; n < 2; ++n) { w0[n] = *(const f32x4*)(cw + c0 + 4 * n); w1[n] = *(const f32x4*)(cw + FF + c0 + 4 * n); w2[n] = *(const f32x4*)(cw + 2 * FF + c0 + 4 * n); bb[n] = *(const f32x4*)(cb + c0 + 4 * n); }
#pragma unroll
        for (int ai = 0; ai < 2; ++ai) {
            f32x4 gp[2] = {(f32x4){0.f, 0.f, 0.f, 0.f}, (f32x4){0.f, 0.f, 0.f, 0.f}};
#pragma unroll
            for (int m = 0; m < 4; ++m) {
                const int row = row0 + ai * HALF + m * 16; const float r = 1.0f / sqrtf(rr[ai][m] * (1.0f / 1024.0f) + EPS);
                f32x4 g[2], v[2]; u32x4 hw, gw, vw;
#pragma unroll
                for (int n = 0; n < 2; ++n) { g[n] = acc[ai][0][m][n] * r; v[n] = acc[ai][1][m][n] * r; }
#pragma unroll
                for (int n = 0; n < 2; ++n)
#pragma unroll
                    for (int i2 = 0; i2 < 2; ++i2) { f32x2q x;
#pragma unroll
                        for (int e = 0; e < 2; ++e) { const int i = 2 * i2 + e; const float x1 = row_prev(gp[n][i], g[n][i], 1), x2 = row_prev(gp[n][i], g[n][i], 2);
                            x[e] = bb[n][i] + w0[n][i] * x2 + w1[n][i] * x1 + w2[n][i] * g[n][i]; }
                        const f32x2q ge = gelu_pk2(x);
                        hw[2 * n + i2] = cvt_pk_bf16(ge.x * v[n][2 * i2], ge.y * v[n][2 * i2 + 1]);
                        gw[2 * n + i2] = cvt_pk_bf16(g[n][2 * i2], g[n][2 * i2 + 1]); vw[2 * n + i2] = cvt_pk_bf16(v[n][2 * i2], v[n][2 * i2 + 1]); }
                *(u32x4*)(H + (size_t)row * FF + c0) = hw;
                if (m == 3 && fr >= 14) *(u32x4*)(sideA + ((size_t)(row >> 6) * 2 + (fr - 14)) * FF + c0) = gw;
                if (m == 0 && fr < 2) { bf16_t* sb = sideB + ((size_t)(row >> 6) * 2 + fr) * 2 * FF + c0; *(u32x4*)sb = gw; *(u32x4*)(sb + FF) = vw; }
                gp[0] = g[0]; gp[1] = g[1];
            }
        }
    }
};

#define PG8_KT(i) (KMODE ? ((i) < 16 ? (i) + 8 : ((i) < 24 ? (i) - 16 : (i))) : (i))
template <class Epi, int KMODE = 0>
__device__ __forceinline__ void gemm_phase(PG8_LAS unsigned char* lds, const Gemm g, const StaticOrder& S, const Epi& E, int tid_, const PG8_LAS float* ftab = nullptr) {
    asm volatile("" : "+v"(tid_));
    const int tid = tid_, wid = __builtin_amdgcn_readfirstlane(tid >> 6), lane = tid & 63, wr = wid >> 2, wc = wid & 3, fr = lane & 15, fq = lane >> 4;
    const int K = g.K, nt = K / BK, lda = g.lda;
    unsigned voffA[2], voffB[2];
#pragma unroll
    for (int i = 0; i < 2; ++i) { int R, C; stage_rc(tid * 16 + i * 8192, R, C); const int Rb = Epi::PERM ? ((R & ~31) + perm32(R & 31)) : R;
        voffA[i] = (unsigned)(R * lda + C) * 2u; voffB[i] = (unsigned)(Rb * K + C) * 2u; }
    const size_t kstep = (size_t)(BK * 2);
    const size_t hstepA = (size_t)HALF * lda * 2, hstepB = (size_t)HALF * K * 2;
    const size_t tstepA = 2 * hstepA, tstepB = 2 * hstepB;
    const unsigned ldsw = (unsigned)wid * 1024u;
    const int aoff = lds_byte(wr * 64 + fr, fq * 8), boff = lds_byte(wc * 32 + fr, fq * 8);
#define PG8_SA(b, h) (((b) * 2 + (h)) * HTB)
#define PG8_SB(b, h) ((4 + (b) * 2 + (h)) * HTB)
#define PG8_STAGE(bufoff, gbase, voff) do { _Pragma("unroll") for (int _i = 0; _i < 2; ++_i) \
        __builtin_amdgcn_global_load_lds((const unsigned*)((const char*)(gbase) + (voff)[_i]), (PG8_LAS unsigned*)(lds + (bufoff) + ldsw + _i * 8192), 16, 0, 0); } while (0)
#define PG8_LDA(dst, b, h) do { _Pragma("unroll") for (int m = 0; m < 4; ++m) _Pragma("unroll") for (int k = 0; k < 2; ++k) dst[m][k] = *(const PG8_LAS bf16x8*)(lds + PG8_SA(b, h) + aoff + m * 2048 + k * 1024); } while (0)
#define PG8_LDB(dst, b, h) do { _Pragma("unroll") for (int n = 0; n < 2; ++n) _Pragma("unroll") for (int k = 0; k < 2; ++k) dst[n][k] = *(const PG8_LAS bf16x8*)(lds + PG8_SB(b, h) + boff + n * 2048 + k * 1024); } while (0)
#define PG8_MMA(ai, bj, At, Bt) do { __builtin_amdgcn_s_setprio(1); _Pragma("unroll") for (int m = 0; m < 4; ++m) _Pragma("unroll") for (int n = 0; n < 2; ++n) _Pragma("unroll") for (int k = 0; k < 2; ++k) \
        acc[ai][bj][m][n] = __builtin_amdgcn_mfma_f32_16x16x32_bf16(Bt[n][k], At[m][k], acc[ai][bj][m][n], 0, 0, 0); __builtin_amdgcn_s_setprio(0); } while (0)
#define PG8_WAIT_V(n) asm volatile("s_waitcnt vmcnt(" #n ")" ::: "memory")
#define PG8_WAIT_L(n) asm volatile("s_waitcnt lgkmcnt(" #n ")" ::: "memory")
#define PG8_BAR __builtin_amdgcn_s_barrier()
#define PG8_SCHED __builtin_amdgcn_sched_barrier(0)
    Unit cur, nxt; int ui = 0;
    if (!S.next(0, cur)) return;
    f32x4 acc[2][2][4][2];
#pragma unroll
    for (int a = 0; a < 2; ++a)
#pragma unroll
        for (int b = 0; b < 2; ++b)
#pragma unroll
            for (int m = 0; m < 4; ++m)
#pragma unroll
                for (int n = 0; n < 2; ++n) acc[a][b][m][n] = (f32x4){0.f, 0.f, 0.f, 0.f};
    bf16x8 At[4][2], B0[2][2], B1[2][2];
    const char* cA = (const char*)g.A + (size_t)cur.pm * tstepA; const char* cB = (const char*)g.Bt + (size_t)cur.pn * tstepB;
    { const char* cA0 = cA + (size_t)PG8_KT(0) * kstep; const char* cB0 = cB + (size_t)PG8_KT(0) * kstep;
    PG8_STAGE(PG8_SB(0, 0), cB0, voffB); PG8_STAGE(PG8_SB(0, 1), cB0 + hstepB, voffB); PG8_STAGE(PG8_SA(0, 0), cA0, voffA); PG8_STAGE(PG8_SA(0, 1), cA0 + hstepA, voffA);
    if (wr == 1) PG8_BAR;
    PG8_WAIT_V(2); PG8_BAR;
    PG8_STAGE(PG8_SB(1, 0), cB0 + kstep, voffB); PG8_STAGE(PG8_SA(1, 0), cA0 + kstep, voffA); PG8_STAGE(PG8_SB(1, 1), cB0 + hstepB + kstep, voffB);
    PG8_WAIT_V(6); PG8_BAR; }
    for (;;) {
        const bool has_next = S.next(ui + 1, nxt);
        const char* nA = has_next ? (const char*)g.A + (size_t)nxt.pm * tstepA : cA; const char* nB = has_next ? (const char*)g.Bt + (size_t)nxt.pn * tstepB : cB;
        for (int t = 0; t < nt; t += 2) {
            const bool last = (t == nt - 2);
            const char* a1 = cA + (size_t)PG8_KT(t + 1) * kstep;
            const char* a2 = last ? nA + (size_t)PG8_KT(0) * kstep : cA + (size_t)PG8_KT(t + 2) * kstep; const char* b2 = last ? nB + (size_t)PG8_KT(0) * kstep : cB + (size_t)PG8_KT(t + 2) * kstep;
            const char* a3 = a2 + kstep; const char* b3 = b2 + kstep;
            PG8_LDB(B0, 0, 0); PG8_LDB(B1, 0, 1); PG8_SCHED; PG8_LDA(At, 0, 0); PG8_STAGE(PG8_SA(1, 1), a1 + hstepA, voffA);
            PG8_WAIT_V(8); PG8_WAIT_L(0); PG8_BAR; PG8_MMA(0, 0, At, B0); PG8_MMA(0, 1, At, B1); PG8_BAR; PG8_SCHED;
            PG8_LDA(At, 0, 1); PG8_STAGE(PG8_SB(0, 0), b2, voffB); PG8_STAGE(PG8_SB(0, 1), b2 + hstepB, voffB); PG8_STAGE(PG8_SA(0, 0), a2, voffA);
            PG8_WAIT_V(8); PG8_WAIT_L(0); PG8_BAR; PG8_MMA(1, 0, At, B0); PG8_MMA(1, 1, At, B1); PG8_BAR; PG8_SCHED;
            PG8_LDB(B0, 1, 0); PG8_LDB(B1, 1, 1); PG8_SCHED; PG8_LDA(At, 1, 0); PG8_STAGE(PG8_SA(0, 1), a2 + hstepA, voffA);
            PG8_WAIT_V(8); PG8_WAIT_L(0); PG8_BAR; PG8_MMA(0, 0, At, B0); PG8_MMA(0, 1, At, B1); PG8_BAR; PG8_SCHED;
            PG8_LDA(At, 1, 1); PG8_STAGE(PG8_SB(1, 0), b3, voffB); PG8_STAGE(PG8_SB(1, 1), b3 + hstepB, voffB); PG8_STAGE(PG8_SA(1, 0), a3, voffA);
            PG8_WAIT_V(8); PG8_WAIT_L(0); PG8_BAR; PG8_MMA(1, 0, At, B0); PG8_MMA(1, 1, At, B1); PG8_BAR; PG8_SCHED;
            if (KMODE == 1 && (t == 6 || t == 14)) {
                const int wh = (t == 14) ? 1 : 0;
#pragma unroll
                for (int ai = 0; ai < 2; ++ai)
#pragma unroll
                    for (int m = 0; m < 4; ++m) { const float f = ftab[(ai * HALF + wr * 64 + m * 16 + fr) * 2 + wh];
#pragma unroll
                        for (int bj = 0; bj < 2; ++bj)
#pragma unroll
                            for (int n = 0; n < 2; ++n) acc[ai][bj][m][n] *= f; }
                PG8_SCHED;
            }
        }
        if (wr == 0) PG8_BAR;
        E(acc, cur, wr, wc, fr, fq);
        if (!has_next) break;
#pragma unroll
        for (int a = 0; a < 2; ++a)
#pragma unroll
            for (int b = 0; b < 2; ++b)
#pragma unroll
                for (int m = 0; m < 4; ++m)
#pragma unroll
                    for (int n = 0; n < 2; ++n) acc[a][b][m][n] = (f32x4){0.f, 0.f, 0.f, 0.f};
        cur = nxt; cA = nA; cB = nB; ++ui;
        if (wr == 1) PG8_BAR;
    }
    PG8_WAIT_V(0);
    PG8_BAR;
#undef PG8_SA
#undef PG8_SB
#undef PG8_STAGE
#undef PG8_LDA
#undef PG8_LDB
#undef PG8_MMA
#undef PG8_WAIT_V
#undef PG8_WAIT_L
#undef PG8_BAR
#undef PG8_SCHED
}
}

constexpr int NWAVES = 8;
constexpr int RING_OFF = 0, RING_BYTES = 131072;
constexpr int LDS_BYTES = 147456;
constexpr int LDSCTL_OFF = LDS_BYTES - 512, MISC_OFF = LDSCTL_OFF + 320;
constexpr int CW_BAR = 4096;

#define GAS __attribute__((address_space(1)))
#define LAS __attribute__((address_space(3)))
typedef unsigned short bf16;
typedef unsigned v4u __attribute__((ext_vector_type(4)));
typedef float f32x4 __attribute__((ext_vector_type(4)));
typedef GAS unsigned gu32;
#define RLX_AGENT __ATOMIC_RELAXED, __HIP_MEMORY_SCOPE_AGENT
#define LDS_WAIT() asm volatile("s_waitcnt lgkmcnt(0)" ::: "memory")
#define VM_WAIT() asm volatile("s_waitcnt vmcnt(0)" ::: "memory")
__device__ __forceinline__ unsigned f2bf(float f) { unsigned u = __builtin_bit_cast(unsigned, f); return (u + 0x7fffu + ((u >> 16) & 1u)) >> 16; }
typedef float f32x2_ __attribute__((ext_vector_type(2))); typedef __bf16 bf16x2_ __attribute__((ext_vector_type(2)));
__device__ __forceinline__ unsigned pk2(float lo, float hi) { const f32x2_ v = {lo, hi}; return __builtin_bit_cast(unsigned, __builtin_convertvector(v, bf16x2_)); }
__device__ __forceinline__ float bf2f(unsigned short b) { return __uint_as_float(((unsigned)b) << 16); }

#define XB_TMO      128
#define XB_XCNT(j)  (256  + 64 * (j))
#define XB_XSUB(j)  (1280 + 64 * (j))
#define XB_XGEN(j)  (2304 + 64 * (j))
#define XB_TOP      3328
#define XB_TOPGEN   3392
#define XCD_BAR_WORDS 3456
#define XB_SPIN_CAP (1u << 18)
__device__ __forceinline__ unsigned xb_ld(unsigned* p)              { return __hip_atomic_load(p, __ATOMIC_RELAXED, __HIP_MEMORY_SCOPE_AGENT); }
__device__ __forceinline__ unsigned xb_add(unsigned* p, unsigned v) { return __hip_atomic_fetch_add(p, v, __ATOMIC_RELAXED, __HIP_MEMORY_SCOPE_AGENT); }
__device__ __forceinline__ unsigned xb_xcc_id() { return (unsigned)__builtin_amdgcn_s_getreg((3 << 11) | 20) & 0xFu; }
#define XB_SPIN(cond, bar) do { unsigned _sp = 0; while (cond) { __builtin_amdgcn_s_sleep(1); \
    if ((++_sp & 255u) == 0u) { if (xb_ld(&(bar)[XB_TMO])) break; if (_sp > XB_SPIN_CAP) { atomicAdd(&(bar)[XB_TMO], 1u); break; } } } } while (0)
struct XcdBarrier { unsigned* bar; unsigned x; volatile LAS unsigned* st; };
__device__ __forceinline__ XcdBarrier xcd_barrier_post(unsigned* bar, volatile LAS unsigned* st) {
    XcdBarrier b; b.bar = bar; b.x = xb_xcc_id(); b.st = st;
    if (threadIdx.x == 0) (void)xb_add(&bar[XB_XCNT(b.x)], 1u);
    return b;
}
__device__ __forceinline__ void xcd_barrier_complete(unsigned* bar, unsigned x, unsigned& nloc, unsigned& nx) {
    const unsigned G = gridDim.x * gridDim.y * gridDim.z;
    unsigned sum, cnt, mine, sp = 0u;
    for (;;) {
        sum = 0u; cnt = 0u; mine = 0u;
#pragma unroll
        for (unsigned j = 0; j < 16; ++j) { const unsigned c = xb_ld(&bar[XB_XCNT(j)]); sum += c; cnt += (c > 0u) ? 1u : 0u; mine = (j == x) ? c : mine; }
        if (sum == G) break;
        __builtin_amdgcn_s_sleep(1);
        if ((++sp & 255u) == 0u) { if (xb_ld(&bar[XB_TMO])) break; if (sp > XB_SPIN_CAP) { atomicAdd(&bar[XB_TMO], 1u); break; } }
    }
    nloc = mine > 0u ? mine : 1u; nx = cnt > 0u ? cnt : 1u;
}
__device__ __forceinline__ void xcd_barrier(const XcdBarrier& b, int tid) {
    asm volatile("s_waitcnt vmcnt(0)" ::: "memory");
    __syncthreads();
    if (tid == 0) {
        unsigned* bar = b.bar;
        __builtin_amdgcn_s_waitcnt(0);
        unsigned nloc = b.st[0], nx = b.st[1];
        if (nloc == 0u) { xcd_barrier_complete(bar, b.x, nloc, nx); b.st[0] = nloc; b.st[1] = nx; }
        const unsigned old = xb_add(&bar[XB_XSUB(b.x)], 1u);
        const unsigned gen = old / nloc;
        if (old + 1u == (gen + 1u) * nloc) {
            __builtin_amdgcn_fence(__ATOMIC_RELEASE, "agent");
            asm volatile("s_waitcnt vmcnt(0)" ::: "memory");
            const unsigned og = xb_add(&bar[XB_TOP], 1u);
            const unsigned tg = og / nx;
            if (og + 1u == (tg + 1u) * nx) xb_add(&bar[XB_TOPGEN], 1u);
            else XB_SPIN(xb_ld(&bar[XB_TOPGEN]) == tg, bar);
            __builtin_amdgcn_fence(__ATOMIC_ACQUIRE, "agent");
            xb_add(&bar[XB_XGEN(b.x)], 1u);
            asm volatile("s_waitcnt vmcnt(0)" ::: "memory");
        } else {
            XB_SPIN(xb_ld(&bar[XB_XGEN(b.x)]) == gen, bar);
            __builtin_amdgcn_fence(__ATOMIC_ACQUIRE, "agent");
            asm volatile("s_waitcnt vmcnt(0)" ::: "memory");
        }
    }
    __syncthreads();
}

__device__ __forceinline__ int fresh_lane() { int l; asm volatile("v_mbcnt_lo_u32_b32 %0, -1, 0\n\tv_mbcnt_hi_u32_b32 %0, -1, %0" : "=v"(l)); return l; }
struct Args { const float* in[22]; float* out; unsigned char* ws; int ph_lo, ph_hi; };

struct Frame {
    LAS unsigned char* lds;
    int tid, lane, wave;
    int vcu, G;
};

__device__ __forceinline__ float wave_sum(float v) {
#pragma unroll
    for (int o = 1; o < 64; o <<= 1) v += __shfl_xor(v, o);
    return v;
}

__device__ __forceinline__ void conv_item(const float* W, int ldw, int srccol0, bf16* WT, int K, int dstrow0, int k0, LAS float* scr, int lane, const float* kscale  , int kslo = 0, int kshi = 1 << 30) {
    {
        const int lr = lane >> 3, lc = (lane & 7) * 4; f32x4 v[8];
#pragma unroll
        for (int i = 0; i < 8; ++i) { const float* p = W + (size_t)(k0 + 8 * i + lr) * ldw + srccol0 + lc;
            if ((((size_t)p) & 15) == 0) v[i] = *(const f32x4*)p; else { v[i][0] = p[0]; v[i][1] = p[1]; v[i][2] = p[2]; v[i][3] = p[3]; } }
#pragma unroll
        for (int i = 0; i < 8; ++i) { LAS float* d = scr + (8 * i + lr) * 33 + lc; d[0] = v[i][0]; d[1] = v[i][1]; d[2] = v[i][2]; d[3] = v[i][3]; }
    }
    const int c = lane & 7;
    f32x4 ks0 = (f32x4){1.f, 1.f, 1.f, 1.f}, ks1 = ks0;
    if (kscale && k0 >= kslo && k0 < kshi) { ks0 = *(const f32x4*)(kscale + k0 - kslo + 8 * c); ks1 = *(const f32x4*)(kscale + k0 - kslo + 8 * c + 4); }
    LDS_WAIT(); asm volatile("" ::: "memory");
#pragma unroll
    for (int j = 0; j < 4; ++j) { const int n = (lane >> 3) + 8 * j; const LAS float* s = scr + (8 * c) * 33 + n;
        v4u o; o.x = pk2(s[0 * 33] * ks0[0], s[1 * 33] * ks0[1]); o.y = pk2(s[2 * 33] * ks0[2], s[3 * 33] * ks0[3]); o.z = pk2(s[4 * 33] * ks1[0], s[5 * 33] * ks1[1]); o.w = pk2(s[6 * 33] * ks1[2], s[7 * 33] * ks1[3]);
        *(GAS v4u*)(WT + (size_t)(dstrow0 + n) * K + k0 + 8 * c) = o; }
    LDS_WAIT(); asm volatile("" ::: "memory");
}
__device__ __forceinline__ int in_src_col(int n0) {
    const int tile = n0 >> 8, p = n0 & 255; int dest;
    if (tile < 2 || tile == 8 || tile == 9) { const int bj = p >> 7, wc = (p >> 5) & 3; dest = (tile << 8) + 64 * wc + 32 * bj; } else dest = n0;
    if (dest < PC_Z) return SC_Q + dest;
    if (dest < PC_MO) return SC_Z + dest - PC_Z;
    if (dest < PC_K) return SC_MO + dest - PC_MO;
    if (dest < PC_V) return SC_K + dest - PC_K;
    if (dest < PC_XBC) return SC_V + dest - PC_V;
    if (dest < PC_MQK) return SC_XBC + dest - PC_XBC;
    if (dest < PC_MV) return SC_MQK + dest - PC_MQK;
    return SC_MV + dest - PC_MV;
}
__device__ __forceinline__ void conv_w_in(Frame& F, const float* w_in, const float* nw, bf16* wt, LAS float* scr) {
    const int gw = F.vcu * NWAVES + F.wave, NGW = F.G * NWAVES;
    for (int it = gw; it < (DM / 64) * (PLD / 32); it += NGW) { const int nblk = PLD / 32, kb = it / nblk, nb = it % nblk; conv_item(w_in, P_IN, in_src_col(32 * nb), wt, DM, 32 * nb, 64 * kb, scr, F.lane, nw); }
}
__device__ __forceinline__ void conv_plain(Frame& F, const float* W, int K, int N, const float* kscale, bf16* wt, LAS float* scr, int kslo = 0, int kshi = 1 << 30) {
    const int gw = F.vcu * NWAVES + F.wave, NGW = F.G * NWAVES; const int nblk = N / 32;
    for (int it = gw; it < (K / 64) * nblk; it += NGW) { const int kb = it / nblk, nb = it % nblk; conv_item(W, N, 32 * nb, wt, K, 32 * nb, 64 * kb, scr, F.lane, kscale, kslo, kshi); }
}
__device__ __forceinline__ void conv_small(Frame& F, const float* w_in, const float* nw, bf16* wst) {
    const int gt = F.vcu * (NWAVES * 64) + F.tid, NT = F.G * NWAVES * 64;
    for (int i = gt; i < 32 * DM; i += NT) { const int c = i >> 10, k = i & (DM - 1);
        float v = 0.f; if (c < 24) v = w_in[(size_t)k * P_IN + (c < 16 ? SC_DT + c : SC_MI + (c - 16))] * nw[k];
        wst[i] = (bf16)(pk2(v, 0.f) & 0xffffu); }
}
__device__ __forceinline__ void row_pass0(Frame& F, const float* x, bf16* xb, float* rs) {
    const int gw = F.vcu * NWAVES + F.wave, NGW = F.G * NWAVES;
    for (int m = gw; m < M; m += 2 * NGW) {
        const int m2 = m + NGW; const bool two = m2 < M;
        const GAS f32x4* xr = (const GAS f32x4*)(x + (size_t)m * DM) + F.lane; const GAS f32x4* xr2 = (const GAS f32x4*)(x + (size_t)(two ? m2 : m) * DM) + F.lane;
        f32x4 v[4], u[4]; float s_ = 0.f, t_ = 0.f;
#pragma unroll
        for (int j = 0; j < 4; ++j) { v[j] = xr[64 * j]; u[j] = xr2[64 * j]; }
#pragma unroll
        for (int j = 0; j < 4; ++j) { s_ += (v[j].x * v[j].x + v[j].y * v[j].y) + (v[j].z * v[j].z + v[j].w * v[j].w); t_ += (u[j].x * u[j].x + u[j].y * u[j].y) + (u[j].z * u[j].z + u[j].w * u[j].w); }
        s_ = wave_sum(s_); t_ = wave_sum(t_);
        GAS unsigned long long* o8 = (GAS unsigned long long*)(xb + (size_t)m * DM) + F.lane;
#pragma unroll
        for (int j = 0; j < 4; ++j) o8[64 * j] = (unsigned long long)pk2(v[j].x, v[j].y) | ((unsigned long long)pk2(v[j].z, v[j].w) << 32);
        if (F.lane == 0) rs[m] = s_;
        if (two) { GAS unsigned long long* p8 = (GAS unsigned long long*)(xb + (size_t)m2 * DM) + F.lane;
#pragma unroll
            for (int j = 0; j < 4; ++j) p8[64 * j] = (unsigned long long)pk2(u[j].x, u[j].y) | ((unsigned long long)pk2(u[j].z, u[j].w) << 32);
            if (F.lane == 0) rs[m2] = t_; }
    }
}
typedef short bf16x8s __attribute__((ext_vector_type(8)));
__device__ __forceinline__ void small_proj(Frame& F, const bf16* xb, const bf16* wst, const float* rs, float* smallp) {
    constexpr int SP = 1040;
    LAS unsigned char* As = F.lds; LAS unsigned char* Bs = F.lds + 64 * SP;
    const int lane = F.lane, w = F.wave, mt = w & 3, nt = w >> 2, r16 = lane & 15, kq = lane >> 4;
    for (int rb = F.vcu * 64; rb < M; rb += F.G * 64) {
        f32x4 acc = (f32x4){0.f, 0.f, 0.f, 0.f};
#pragma unroll 1
        for (int kh = 0; kh < 2; ++kh) {
            v4u av[8], bv[4];
#pragma unroll
            for (int i = 0; i < 8; ++i) { const int it = F.tid + 512 * i, row = it >> 6, c = it & 63; av[i] = *(const v4u*)(xb + (size_t)(rb + row) * DM + kh * 512 + c * 8); }
#pragma unroll
            for (int i = 0; i < 4; ++i) { const int it = F.tid + 512 * i, row = it >> 6, c = it & 63; bv[i] = *(const v4u*)(wst + (size_t)row * DM + kh * 512 + c * 8); }
            __syncthreads();
#pragma unroll
            for (int i = 0; i < 8; ++i) { const int it = F.tid + 512 * i, row = it >> 6, c = it & 63; *(LAS v4u*)(As + row * SP + c * 16) = av[i]; }
#pragma unroll
            for (int i = 0; i < 4; ++i) { const int it = F.tid + 512 * i, row = it >> 6, c = it & 63; *(LAS v4u*)(Bs + row * SP + c * 16) = bv[i]; }
            __syncthreads();
            bf16x8s a[16], b[16];
#pragma unroll
            for (int ks = 0; ks < 16; ++ks) { a[ks] = *(const LAS bf16x8s*)(As + (16 * mt + r16) * SP + (32 * ks + 8 * kq) * 2); b[ks] = *(const LAS bf16x8s*)(Bs + (16 * nt + r16) * SP + (32 * ks + 8 * kq) * 2); }
#pragma unroll
            for (int ks = 0; ks < 16; ++ks) acc = __builtin_amdgcn_mfma_f32_16x16x32_bf16(a[ks], b[ks], acc, 0, 0, 0);
        }
        const int n = 16 * nt + r16;
        if (n < 24) {
#pragma unroll
            for (int i = 0; i < 4; ++i) { const int row = rb + 16 * mt + 4 * kq + i; smallp[(size_t)row * 24 + n] = acc[i] * (1.0f / sqrtf(rs[row] * (1.0f / DM) + EPS)); } }
    }
    __syncthreads();
}
__device__ __forceinline__ unsigned cvtpk(float lo, float hi) { return pk2(lo, hi); }
__device__ __forceinline__ float bflo(unsigned w) { return __uint_as_float(w << 16); }
__device__ __forceinline__ float bfhi(unsigned w) { return __uint_as_float(w & 0xffff0000u); }
typedef float f32x2 __attribute__((ext_vector_type(2)));
__device__ __forceinline__ f32x2 gelu_pk(f32x2 v) {
    const f32x2 av = __builtin_elementwise_abs(v), d = av * 0.2316418882f + 1.0f;
    f32x2 t; t.x = __builtin_amdgcn_rcpf(d.x); t.y = __builtin_amdgcn_rcpf(d.y);
    f32x2 q = t * 0.5307027145f + (-0.7265760135f); q = q * t + 0.7107068705f; q = q * t + (-0.142248368f); q = q * t + 0.127414796f; q = q * t;
    const f32x2 s = (v * v) * (-0.72134752044f);
    f32x2 e; e.x = __builtin_amdgcn_exp2f(s.x); e.y = __builtin_amdgcn_exp2f(s.y);
    const f32x2 m = v * (q * e), r = v - m;
    f32x2 o; o.x = v.x < 0.f ? m.x : r.x; o.y = v.y < 0.f ? m.y : r.y; return o;
}

__device__ __forceinline__ void ffn_fix(Frame& F, bf16* H, const bf16* sideA, const bf16* sideB, const float* cw, const float* cb, int pm) {
    constexpr int CPR = FFN / 8;
    for (int it = F.tid; it < 4 * 2 * CPR; it += NWAVES * 64) {
        const int c0 = (it % CPR) * 8, rr_ = (it / CPR) & 1, grp = 4 * pm + it / (2 * CPR); const bool first = (grp & 31) == 0;
        const v4u z = (v4u){0, 0, 0, 0};
        const bf16* sb = sideB + ((size_t)grp * 2 + rr_) * 2 * FFN + c0;
        const v4u g2 = *(const v4u*)sb, vv = *(const v4u*)(sb + FFN);
        const v4u a1 = first ? z : *(const v4u*)(sideA + ((size_t)(grp - 1) * 2 + 1) * FFN + c0), a0 = first ? z : *(const v4u*)(sideA + ((size_t)(grp - 1) * 2) * FFN + c0);
        const v4u g1 = rr_ ? *(const v4u*)(sideB + ((size_t)grp * 2) * 2 * FFN + c0) : a1, g0 = rr_ ? a1 : a0;
        f32x4 w0[2], w1[2], w2[2], bb[2];
#pragma unroll
        for (int k = 0; k < 2; ++k) { w0[k] = *(const f32x4*)(cw + c0 + 4 * k); w1[k] = *(const f32x4*)(cw + FFN + c0 + 4 * k); w2[k] = *(const f32x4*)(cw + 2 * FFN + c0 + 4 * k); bb[k] = *(const f32x4*)(cb + c0 + 4 * k); }
        v4u ov;
#pragma unroll
        for (int i = 0; i < 4; ++i) { const int k = i >> 1, e = (i & 1) * 2; f32x2 x;
            x.x = bb[k][e] + w0[k][e] * bflo(g0[i]) + w1[k][e] * bflo(g1[i]) + w2[k][e] * bflo(g2[i]);
            x.y = bb[k][e + 1] + w0[k][e + 1] * bfhi(g0[i]) + w1[k][e + 1] * bfhi(g1[i]) + w2[k][e + 1] * bfhi(g2[i]);
            const f32x2 ge = gelu_pk(x); ov[i] = cvtpk(ge.x * bflo(vv[i]), ge.y * bfhi(vv[i])); }
        *(v4u*)(H + (size_t)(grp * 64 + rr_) * FFN + c0) = ov;
    }
}
__device__ __forceinline__ float silu_f(float x) { return x * __builtin_amdgcn_rcpf(1.0f + __builtin_amdgcn_exp2f(-1.4426950408889634f * x)); }
__device__ __forceinline__ float sigm_f(float x) { return __builtin_amdgcn_rcpf(1.0f + __builtin_amdgcn_exp2f(-1.4426950408889634f * x)); }

__device__ __forceinline__ float shx(float v, int m, int lane) { return __int_as_float(__builtin_amdgcn_ds_bpermute((lane ^ m) << 2, __float_as_int(v))); }
__device__ __forceinline__ float shup(float v, int o, int lane) { return __int_as_float(__builtin_amdgcn_ds_bpermute((lane - o) << 2, __float_as_int(v))); }
__device__ __forceinline__ float shl_(float v, int src, int lane) { (void)lane; return __int_as_float(__builtin_amdgcn_ds_bpermute(src << 2, __float_as_int(v))); }
__device__ __forceinline__ float softplus_f(float x) { return fmaxf(x, 0.f) + 0.6931471805599453f * __builtin_amdgcn_logf(1.0f + __builtin_amdgcn_exp2f(-1.4426950408889634f * fabsf(x))); }
__device__ __forceinline__ float logsig_f(float x) { return fminf(x, 0.f) - 0.6931471805599453f * __builtin_amdgcn_logf(1.0f + __builtin_amdgcn_exp2f(-1.4426950408889634f * fabsf(x))); }
typedef short bf16x8v __attribute__((ext_vector_type(8)));
typedef float f32x16 __attribute__((ext_vector_type(16)));
typedef short v4i16_t __attribute__((ext_vector_type(4)));
__device__ __forceinline__ bf16x8v frag_row(LAS const unsigned char* base, int pitch, int row, int kel) { return *(const LAS bf16x8v*)(base + row * pitch + kel * 2); }
__device__ __forceinline__ bf16x8v frag_tr(LAS const unsigned char* base, int pitch, int krow, int col) {
    LAS const unsigned char* p = base + krow * pitch + col * 2;
    const v4i16_t lo = __builtin_amdgcn_ds_read_tr16_b64_v4i16((LAS v4i16_t*)p);
    const v4i16_t hi = __builtin_amdgcn_ds_read_tr16_b64_v4i16((LAS v4i16_t*)(p + 4 * pitch));
    return (bf16x8v){lo[0], lo[1], lo[2], lo[3], hi[0], hi[1], hi[2], hi[3]};
}
#define MFMA32(a, b, c) __builtin_amdgcn_mfma_f32_32x32x16_bf16((a), (b), (c), 0, 0, 0)

__device__ __forceinline__ void ssd_unit(int tid, bf16* proj, const float* smallp, float* ssq, const float* dt_bias, const float* a_log, const float* dskip, int b, int h, LAS unsigned char* lds) {
    constexpr int PB = 272, PX = 144;
    asm volatile("" : "+v"(tid));
    LAS unsigned char* CG = lds;
    LAS unsigned char* BB = lds + 34816;
    LAS unsigned char* XX = lds + 69632;
    LAS unsigned char* XW = lds + 88064;
    LAS unsigned char* ST = lds + 106496;
    LAS float* ldv = (LAS float*)(lds + 123904);
    LAS float* dtv = ldv + 2048;
    const int lane0 = tid & 63, w = __builtin_amdgcn_readfirstlane(tid >> 6);
    const int g = h >> 3, pt = w & 1, lt = w >> 1;
    const float a = -__expf(a_log[h]), dsk = dskip[h], dtb = dt_bias[h];
    const size_t rowb = (size_t)b * SEQ;
    const int xrow = tid >> 2, xq = tid & 3, brow = tid >> 4, bc = tid & 15;
    const bf16* xsrc = proj + (rowb + xrow) * PLD + PC_XBC + h * 64 + xq * 16;
    bf16* zptr = proj + (rowb + xrow) * PLD + PC_Z + h * 64 + xq * 16;
    const bf16* bsrc = proj + (rowb + brow) * PLD + PC_XBC + 1024 + g * 128 + bc * 8;
    const bf16* csrc = bsrc + 256;
    const float* dsrc = smallp + (rowb + lane0) * 24 + h;
    v4u xr[2], br[4], cr[4];
#pragma unroll
    for (int k = 0; k < 2; ++k) xr[k] = *(const v4u*)(xsrc + 8 * k);
#pragma unroll
    for (int k = 0; k < 4; ++k) { br[k] = *(const v4u*)(bsrc + (size_t)32 * k * PLD); cr[k] = *(const v4u*)(csrc + (size_t)32 * k * PLD); }
#pragma unroll
    for (int cc = 0; cc < 2; ++cc) { const int ch_ = 2 * w + cc; const float* dp_ = dsrc + (size_t)ch_ * 128 * 24;
        float v0 = dp_[0] + dtb, v1 = dp_[64 * 24] + dtb;
        v0 = softplus_f(v0); v1 = softplus_f(v1);
        float s0 = v0 * a, s1 = v1 * a;
#pragma unroll
        for (int o = 1; o < 64; o <<= 1) { const float t0 = shup(s0, o, lane0), t1 = shup(s1, o, lane0); if (lane0 >= o) { s0 += t0; s1 += t1; } }
        s1 += shl_(s0, 63, lane0);
        ldv[ch_ * 128 + lane0] = s0; ldv[ch_ * 128 + 64 + lane0] = s1; dtv[ch_ * 128 + lane0] = v0; dtv[ch_ * 128 + 64 + lane0] = v1; }
    f32x16 sacc;
#pragma unroll
    for (int i = 0; i < 16; ++i) sacc[i] = 0.f;
    for (int i = tid; i < 17408 / 4; i += 512) ((LAS unsigned*)ST)[i] = 0u;
    for (int c = 0; c < 16; ++c) {
        const size_t row0 = rowb + c * 128;
        int lane = lane0; asm volatile("" : "+v"(lane));
        const int r = lane & 31, hh = lane >> 5, trq = (lane & 15) >> 2, trc = 16 * ((lane >> 4) & 1) + 4 * (lane & 3);
        LAS const float* ldc = ldv + c * 128; LAS const float* dtc = dtv + c * 128;
        __syncthreads();
        {
            const float wl = dtc[xrow] * __expf(ldc[127] - ldc[xrow]);
#pragma unroll
            for (int k = 0; k < 2; ++k) { *(LAS v4u*)(XX + xrow * PX + xq * 32 + k * 16) = xr[k]; v4u o;
#pragma unroll
                for (int i = 0; i < 4; ++i) o[i] = pk2(bf2f(xr[k][i] & 0xffff) * wl, bf2f(xr[k][i] >> 16) * wl);
                *(LAS v4u*)(XW + xrow * PX + xq * 32 + k * 16) = o; }
#pragma unroll
            for (int k = 0; k < 4; ++k) { *(LAS v4u*)(BB + (brow + 32 * k) * PB + bc * 16) = br[k]; *(LAS v4u*)(CG + (brow + 32 * k) * PB + bc * 16) = cr[k]; }
        }
        v4u zr[2];
#pragma unroll
        for (int k = 0; k < 2; ++k) zr[k] = *(const v4u*)(zptr + (size_t)c * 128 * PLD + 8 * k);
        if (c < 15) {
#pragma unroll
            for (int k = 0; k < 2; ++k) xr[k] = *(const v4u*)(xsrc + (size_t)(c + 1) * 128 * PLD + 8 * k);
#pragma unroll
            for (int k = 0; k < 4; ++k) { br[k] = *(const v4u*)(bsrc + (size_t)((c + 1) * 128 + 32 * k) * PLD); cr[k] = *(const v4u*)(csrc + (size_t)((c + 1) * 128 + 32 * k) * PLD); }
        }
        __syncthreads();
        f32x16 yacc;
#pragma unroll
        for (int i = 0; i < 16; ++i) yacc[i] = 0.f;
        {   bf16x8v fa[8], fb[8];
#pragma unroll
            for (int ks = 0; ks < 8; ++ks) { fa[ks] = frag_row(ST, PB, 32 * pt + r, 16 * ks + 8 * hh); fb[ks] = frag_row(CG, PB, 32 * lt + r, 16 * ks + 8 * hh); }
            __builtin_amdgcn_sched_barrier(0);
#pragma unroll
            for (int ks = 0; ks < 8; ++ks) yacc = MFMA32(fa[ks], fb[ks], yacc); }
        { const float e = __expf(ldc[32 * lt + r]);
#pragma unroll
          for (int i = 0; i < 16; ++i) yacc[i] *= e; }
        f32x16 tA, tB;
        const int ltA = (w >= 6) ? 3 : (w >= 3) ? 2 : (w >= 1) ? 1 : 0, stA = w - ltA * (ltA + 1) / 2;
        const int ltB = 3, stB = w + 2;
#pragma unroll
        for (int i = 0; i < 16; ++i) { tA[i] = 0.f; tB[i] = 0.f; }
        {   bf16x8v fa[8], fb[8];
#pragma unroll
            for (int ks = 0; ks < 8; ++ks) { fa[ks] = frag_row(BB, PB, 32 * stA + r, 16 * ks + 8 * hh); fb[ks] = frag_row(CG, PB, 32 * ltA + r, 16 * ks + 8 * hh); }
            __builtin_amdgcn_sched_barrier(0);
#pragma unroll
            for (int ks = 0; ks < 8; ++ks) tA = MFMA32(fa[ks], fb[ks], tA); }
        if (w < 2) { bf16x8v fa[8], fb[8];
#pragma unroll
            for (int ks = 0; ks < 8; ++ks) { fa[ks] = frag_row(BB, PB, 32 * stB + r, 16 * ks + 8 * hh); fb[ks] = frag_row(CG, PB, 32 * ltB + r, 16 * ks + 8 * hh); }
            __builtin_amdgcn_sched_barrier(0);
#pragma unroll
            for (int ks = 0; ks < 8; ++ks) tB = MFMA32(fa[ks], fb[ks], tB); }
        __syncthreads();
#define SSD_GWRITE(T_, st_, lt_) do { const int l = 32 * (lt_) + r; const float ldl = ldc[l]; \
          _Pragma("unroll") for (int g4 = 0; g4 < 4; ++g4) { const int s0 = 32 * (st_) + 8 * g4 + 4 * hh; \
              const f32x4 lds4 = *(LAS const f32x4*)(ldc + s0), dts4 = *(LAS const f32x4*)(dtc + s0); float v[4]; \
              _Pragma("unroll") for (int j = 0; j < 4; ++j) { const float e_ = __expf(fminf(ldl - lds4[j], 0.f)) * dts4[j] * T_[4 * g4 + j]; v[j] = (s0 + j <= l) ? e_ : 0.f; } \
              *(LAS unsigned long long*)(CG + l * PB + s0 * 2) = (unsigned long long)pk2(v[0], v[1]) | ((unsigned long long)pk2(v[2], v[3]) << 32); } } while (0)
        SSD_GWRITE(tA, stA, ltA);
        if (w < 2) SSD_GWRITE(tB, stB, ltB);
#undef SSD_GWRITE
        __syncthreads();
        for (int kb = 0; kb <= lt; ++kb) { bf16x8v fa[2], fb[2];
#pragma unroll
            for (int k2 = 0; k2 < 2; ++k2) { const int ks = 2 * kb + k2; fa[k2] = frag_tr(XX, PX, 16 * ks + 8 * hh + trq, 32 * pt + trc); fb[k2] = frag_row(CG, PB, 32 * lt + r, 16 * ks + 8 * hh); }
            __builtin_amdgcn_sched_barrier(0);
#pragma unroll
            for (int k2 = 0; k2 < 2; ++k2) yacc = MFMA32(fa[k2], fb[k2], yacc); }
        { const float e = __expf(ldc[127]);
#pragma unroll
          for (int i = 0; i < 16; ++i) sacc[i] *= e; }
        {   bf16x8v fa[8], fb[8];
#pragma unroll
            for (int ks = 0; ks < 8; ++ks) { fa[ks] = frag_tr(BB, PB, 16 * ks + 8 * hh + trq, 32 * lt + trc); fb[ks] = frag_tr(XW, PX, 16 * ks + 8 * hh + trq, 32 * pt + trc); }
            __builtin_amdgcn_sched_barrier(0);
#pragma unroll
            for (int ks = 0; ks < 8; ++ks) sacc = MFMA32(fa[ks], fb[ks], sacc); }
        __syncthreads();
        {
            const int p = 32 * pt + r, l = 32 * lt + r;
#pragma unroll
            for (int g4 = 0; g4 < 4; ++g4) { const int n0 = 32 * lt + 8 * g4 + 4 * hh;
                *(LAS unsigned long long*)(ST + p * PB + n0 * 2) = (unsigned long long)pk2(sacc[4 * g4], sacc[4 * g4 + 1]) | ((unsigned long long)pk2(sacc[4 * g4 + 2], sacc[4 * g4 + 3]) << 32);
                const int p0 = 32 * pt + 8 * g4 + 4 * hh;
                *(LAS f32x4*)(CG + l * 272 + p0 * 4) = (f32x4){yacc[4 * g4], yacc[4 * g4 + 1], yacc[4 * g4 + 2], yacc[4 * g4 + 3]}; }
        }
        __syncthreads();
        {
            float o[16]; float ss = 0.f;
#pragma unroll
            for (int k = 0; k < 2; ++k) { const v4u zv = zr[k]; const v4u xv = *(const LAS v4u*)(XX + xrow * PX + xq * 32 + k * 16);
                const f32x4 y0 = *(const LAS f32x4*)(CG + xrow * 272 + (xq * 16 + 8 * k) * 4), y1 = *(const LAS f32x4*)(CG + xrow * 272 + (xq * 16 + 8 * k + 4) * 4);
#pragma unroll
                for (int i = 0; i < 4; ++i) { const float ya = (i < 2 ? y0[2 * i] : y1[2 * i - 4]), yb = (i < 2 ? y0[2 * i + 1] : y1[2 * i - 3]);
                    const float oa = (ya + dsk * bf2f(xv[i] & 0xffff)) * silu_f(bf2f(zv[i] & 0xffff)), ob = (yb + dsk * bf2f(xv[i] >> 16)) * silu_f(bf2f(zv[i] >> 16));
                    o[8 * k + 2 * i] = oa; o[8 * k + 2 * i + 1] = ob; ss += oa * oa + ob * ob; } }
            ss += shx(ss, 1, lane); ss += shx(ss, 2, lane);
            bf16* zp = zptr + (size_t)c * 128 * PLD;
#pragma unroll
            for (int k = 0; k < 2; ++k) { v4u ov; ov.x = pk2(o[8 * k], o[8 * k + 1]); ov.y = pk2(o[8 * k + 2], o[8 * k + 3]); ov.z = pk2(o[8 * k + 4], o[8 * k + 5]); ov.w = pk2(o[8 * k + 6], o[8 * k + 7]); *(v4u*)(zp + 8 * k) = ov; }
            if (xq == 0) ssq[(row0 + xrow) * 16 + h] = ss;
        }
    }
    __syncthreads();
}

__device__ __forceinline__ void mlstm_unit(int tid, bf16* proj, const float* smallp, const float* i_bias, const float* f_bias, const float* norm_w, int b, int hd, LAS unsigned char* lds, float* gsc  , unsigned long long* pts) {
    constexpr int PB = 272, GS = 656;
    asm volatile("" : "+v"(tid));
    LAS unsigned char* QP = lds;
    LAS unsigned char* KK = lds + 34816;
    LAS unsigned char* VV = lds + 69632;
    LAS unsigned char* CS = lds + 104448;
    LAS float* uu = (LAS float*)(lds + 139264);
    LAS float* mmv = uu + 128;
    LAS float* wint = mmv + 128;
    LAS float* dnv = wint + 128;
    LAS float* wlv = dnv + 128;
    LAS float* scal = wlv + 128;
    LAS float* nwl = scal + 16;
    LAS float* ptot = nwl + 128;
    LAS float* pmlo = ptot + 16;
    LAS unsigned short* nstb = (LAS unsigned short*)(pmlo + 16);
    const int lane0 = tid & 63, w = __builtin_amdgcn_readfirstlane(tid >> 6);
    const int tt = w >> 1, dp = w & 1;
    const float ib = i_bias[hd], fb = f_bias[hd];
    const size_t rowb = (size_t)b * SEQ;
    const int srow = tid >> 4, sc = tid & 15, et = tid >> 2, eq = tid & 3;
    const bf16* qsrc = proj + (rowb + srow) * PLD + PC_MQK + hd * 128 + sc * 8;
    const bf16* ksrc = qsrc + 512;
    const bf16* vsrc = proj + (rowb + srow) * PLD + PC_MV + hd * 128 + sc * 8;
    bf16* optr = proj + (rowb + et) * PLD + PC_MO + hd * 128 + eq * 32;
    v4u qr[4], kr[4]; float wlr[4];
#pragma unroll
    for (int k = 0; k < 4; ++k) { qr[k] = *(const v4u*)(qsrc + (size_t)32 * k * PLD); kr[k] = *(const v4u*)(ksrc + (size_t)32 * k * PLD); }
    {
        float pc0[2], pc1[2], pu0[2], pu1[2], pp0[2], pp1[2];
#pragma unroll
        for (int cc = 0; cc < 2; ++cc) { const float* gp = smallp + (rowb + (size_t)(2 * w + cc) * 128 + lane0) * 24 + 16 + hd;
            const float li0 = gp[0] + ib, li1 = gp[64 * 24] + ib, f0 = gp[4] + fb, f1 = gp[64 * 24 + 4] + fb;
            float c0 = logsig_f(f0), c1 = logsig_f(f1);
#pragma unroll
            for (int o = 1; o < 64; o <<= 1) { const float t0 = shup(c0, o, lane0), t1 = shup(c1, o, lane0); if (lane0 >= o) { c0 += t0; c1 += t1; } }
            c1 += shl_(c0, 63, lane0);
            const float totf = shl_(c1, 63, lane0);
            const float u0 = li0 - c0, u1 = li1 - c1;
            float p0 = u0, p1 = u1;
#pragma unroll
            for (int o = 1; o < 64; o <<= 1) { const float t0 = shup(p0, o, lane0), t1 = shup(p1, o, lane0); if (lane0 >= o) { p0 = fmaxf(p0, t0); p1 = fmaxf(p1, t1); } }
            p1 = fmaxf(p1, shl_(p0, 63, lane0));
            pc0[cc] = c0; pc1[cc] = c1; pu0[cc] = u0; pu1[cc] = u1; pp0[cc] = p0; pp1[cc] = p1;
            const float pall = shl_(p1, 63, lane0);
            if (lane0 == 0) { ptot[2 * w + cc] = totf; pmlo[2 * w + cc] = totf + pall; }
        }
        if (tid < 128) nwl[tid] = norm_w[hd * 128 + tid];
        if (tid < 64) ((LAS unsigned*)nstb)[tid] = 0u;
        for (int i = tid; i < 34816 / 4; i += 512) ((LAS unsigned*)CS)[i] = 0u;
        __syncthreads();
        float mst = 0.f, mst_mine[2] = {0.f, 0.f}, mnew_mine[2] = {0.f, 0.f};
#pragma unroll
        for (int c = 0; c < 16; ++c) { const float tf = ptot[c], ml = pmlo[c]; const float mn = fmaxf(tf + mst, ml);
            if (tid == 0) scal[c] = __expf(tf + mst - mn);
            if (c == 2 * w) { mst_mine[0] = mst; mnew_mine[0] = mn; }
            if (c == 2 * w + 1) { mst_mine[1] = mst; mnew_mine[1] = mn; }
            mst = mn; }
#pragma unroll
        for (int cc = 0; cc < 2; ++cc) { float* go_ = gsc + (size_t)(2 * w + cc) * GS; const float ms = mst_mine[cc], mn = mnew_mine[cc], tf = ptot[2 * w + cc];
            const float m0 = fmaxf(pp0[cc], ms), m1 = fmaxf(pp1[cc], ms);
            go_[lane0] = __expf(mn - tf - m0); go_[64 + lane0] = __expf(mn - tf - m1); go_[128 + lane0] = m0; go_[192 + lane0] = m1;
            go_[256 + lane0] = __expf(ms - m0); go_[320 + lane0] = __expf(ms - m1);
            go_[384 + lane0] = __expf(-(pc0[cc] + m0)); go_[448 + lane0] = __expf(-(pc1[cc] + m1));
            go_[512 + lane0] = __expf(tf + pu0[cc] - mn); go_[576 + lane0] = __expf(tf + pu1[cc] - mn); }
        asm volatile("s_waitcnt vmcnt(0)" ::: "memory");
        __syncthreads();
    }
    float gr[5] = {0.f, 0.f, 0.f, 0.f, 0.f};
    if (tid < 128) {
#pragma unroll
        for (int k = 0; k < 5; ++k) gr[k] = __hip_atomic_load(gsc + k * 128 + tid, __ATOMIC_RELAXED, __HIP_MEMORY_SCOPE_AGENT); }
#pragma unroll
    for (int k = 0; k < 4; ++k) wlr[k] = __hip_atomic_load(gsc + 512 + srow + 32 * k, __ATOMIC_RELAXED, __HIP_MEMORY_SCOPE_AGENT);
    f32x16 cacc0, cacc1, nacc;
#pragma unroll
    for (int i = 0; i < 16; ++i) { cacc0[i] = 0.f; cacc1[i] = 0.f; nacc[i] = 0.f; }
    const bf16x8v ones = (bf16x8v){0x3F80, 0x3F80, 0x3F80, 0x3F80, 0x3F80, 0x3F80, 0x3F80, 0x3F80};
#if PROBE_PHASE != -1 && defined(PROBE_STAGES)
    unsigned long long tacc = 0; unsigned long long tprev = __builtin_amdgcn_s_memrealtime();
#define STAMP(k) do { const unsigned long long tn_ = __builtin_amdgcn_s_memrealtime(); if ((k) == PROBE_STAGES) tacc += tn_ - tprev; tprev = tn_; } while (0)
#else
#define STAMP(k) do {} while (0)
#endif
    for (int c = 0; c < 16; ++c) {
        int lane = lane0; asm volatile("" : "+v"(lane));
        const int r = lane & 31, hh = lane >> 5, trq = (lane & 15) >> 2, trc = 16 * ((lane >> 4) & 1) + 4 * (lane & 3);
        __syncthreads();
        STAMP(0);
#pragma unroll
        for (int k = 0; k < 4; ++k) { *(LAS v4u*)(QP + (srow + 32 * k) * PB + sc * 16) = qr[k]; v4u kw_;
#pragma unroll
            for (int i = 0; i < 4; ++i) kw_[i] = pk2(bflo(kr[k][i]) * wlr[k], bfhi(kr[k][i]) * wlr[k]);
            *(LAS v4u*)(KK + (srow + 32 * k) * PB + sc * 16) = kw_; }
        if (tid < 128) { uu[tid] = gr[0]; mmv[tid] = gr[1]; wint[tid] = gr[2]; dnv[tid] = gr[3]; wlv[tid] = gr[4]; }
        v4u vr[4];
#pragma unroll
        for (int k = 0; k < 4; ++k) vr[k] = *(const v4u*)(vsrc + (size_t)(c * 128 + 32 * k) * PLD);
        if (c < 15) {
#pragma unroll
            for (int k = 0; k < 4; ++k) { const size_t ro = (size_t)((c + 1) * 128 + 32 * k) * PLD; qr[k] = *(const v4u*)(qsrc + ro); kr[k] = *(const v4u*)(ksrc + ro); }
#pragma unroll
            for (int k = 0; k < 4; ++k) wlr[k] = __hip_atomic_load(gsc + (size_t)(c + 1) * GS + 512 + srow + 32 * k, __ATOMIC_RELAXED, __HIP_MEMORY_SCOPE_AGENT);
            if (tid < 128) {
#pragma unroll
                for (int k = 0; k < 5; ++k) gr[k] = __hip_atomic_load(gsc + (size_t)(c + 1) * GS + k * 128 + tid, __ATOMIC_RELAXED, __HIP_MEMORY_SCOPE_AGENT); }
        }
        __syncthreads();
        STAMP(1);
        f32x16 na0, na1, dacc;
#pragma unroll
        for (int i = 0; i < 16; ++i) { na0[i] = 0.f; na1[i] = 0.f; dacc[i] = 0.f; }
#pragma unroll
        for (int kh = 0; kh < 2; ++kh) { bf16x8v fq[4], f0[4], f1[4], fn[4];
#pragma unroll
            for (int k4 = 0; k4 < 4; ++k4) { const int ks = 4 * kh + k4; fq[k4] = frag_row(QP, PB, 32 * tt + r, 16 * ks + 8 * hh); f0[k4] = frag_row(CS, PB, 32 * (2 * dp) + r, 16 * ks + 8 * hh); f1[k4] = frag_row(CS, PB, 32 * (2 * dp + 1) + r, 16 * ks + 8 * hh);
                fn[k4] = *(const LAS bf16x8v*)((LAS const unsigned char*)nstb + (16 * ks + 8 * hh) * 2); }
            __builtin_amdgcn_sched_barrier(0);
#pragma unroll
            for (int k4 = 0; k4 < 4; ++k4) { na0 = MFMA32(f0[k4], fq[k4], na0); na1 = MFMA32(f1[k4], fq[k4], na1); dacc = MFMA32(fn[k4], fq[k4], dacc); } }
        { const float e = wint[32 * tt + r];
#pragma unroll
          for (int i = 0; i < 16; ++i) { na0[i] *= e; na1[i] *= e; dacc[i] *= e; } }
        f32x16 tA, tB;
        const int ttA = (w >= 6) ? 3 : (w >= 3) ? 2 : (w >= 1) ? 1 : 0, stA = w - ttA * (ttA + 1) / 2;
        const int ttB = 3, stB = w + 2;
#pragma unroll
        for (int i = 0; i < 16; ++i) { tA[i] = 0.f; tB[i] = 0.f; }
#pragma unroll
        for (int kh = 0; kh < 2; ++kh) { bf16x8v fa[4], fb_[4];
#pragma unroll
            for (int k4 = 0; k4 < 4; ++k4) { const int ks = 4 * kh + k4; fa[k4] = frag_row(KK, PB, 32 * stA + r, 16 * ks + 8 * hh); fb_[k4] = frag_row(QP, PB, 32 * ttA + r, 16 * ks + 8 * hh); }
            __builtin_amdgcn_sched_barrier(0);
#pragma unroll
            for (int k4 = 0; k4 < 4; ++k4) tA = MFMA32(fa[k4], fb_[k4], tA); }
        if (w < 2) {
#pragma unroll
            for (int kh = 0; kh < 2; ++kh) { bf16x8v fa[4], fb_[4];
#pragma unroll
                for (int k4 = 0; k4 < 4; ++k4) { const int ks = 4 * kh + k4; fa[k4] = frag_row(KK, PB, 32 * stB + r, 16 * ks + 8 * hh); fb_[k4] = frag_row(QP, PB, 32 * ttB + r, 16 * ks + 8 * hh); }
                __builtin_amdgcn_sched_barrier(0);
#pragma unroll
                for (int k4 = 0; k4 < 4; ++k4) tB = MFMA32(fa[k4], fb_[k4], tB); } }
        __syncthreads();
        STAMP(2);
#define ML_PWRITE(T_, st_, tt_) do { const int t = 32 * (tt_) + r; const float rh = uu[t]; \
          _Pragma("unroll") for (int g4 = 0; g4 < 4; ++g4) { const int s0 = 32 * (st_) + 8 * g4 + 4 * hh; float v[4]; \
              _Pragma("unroll") for (int j = 0; j < 4; ++j) v[j] = (s0 + j <= t) ? T_[4 * g4 + j] * rh : 0.f; \
              *(LAS unsigned long long*)(QP + t * PB + s0 * 2) = (unsigned long long)pk2(v[0], v[1]) | ((unsigned long long)pk2(v[2], v[3]) << 32); } } while (0)
        ML_PWRITE(tA, stA, ttA);
        if (w < 2) ML_PWRITE(tB, stB, ttB);
#undef ML_PWRITE
#pragma unroll
        for (int k = 0; k < 4; ++k) *(LAS v4u*)(VV + (srow + 32 * k) * PB + sc * 16) = vr[k];
        v4u og[4];
#pragma unroll
        for (int k = 0; k < 4; ++k) og[k] = *(const v4u*)(optr + (size_t)c * 128 * PLD + 8 * k);
        __syncthreads();
        STAMP(3);
        for (int kb = 0; kb <= tt; ++kb) { bf16x8v fp[2], f0[2], f1[2];
#pragma unroll
            for (int k2 = 0; k2 < 2; ++k2) { const int ks = 2 * kb + k2; fp[k2] = frag_row(QP, PB, 32 * tt + r, 16 * ks + 8 * hh);
                f0[k2] = frag_tr(VV, PB, 16 * ks + 8 * hh + trq, 32 * (2 * dp) + trc); f1[k2] = frag_tr(VV, PB, 16 * ks + 8 * hh + trq, 32 * (2 * dp + 1) + trc); }
            __builtin_amdgcn_sched_barrier(0);
#pragma unroll
            for (int k2 = 0; k2 < 2; ++k2) { na0 = MFMA32(f0[k2], fp[k2], na0); na1 = MFMA32(f1[k2], fp[k2], na1); dacc = MFMA32(ones, fp[k2], dacc); } }
        { const float e = scal[c];
#pragma unroll
          for (int i = 0; i < 16; ++i) { cacc0[i] *= e; cacc1[i] *= e; nacc[i] *= e; } }
#pragma unroll
        for (int kh = 0; kh < 2; ++kh) { bf16x8v fk[4], f0[4], f1[4];
#pragma unroll
            for (int k4 = 0; k4 < 4; ++k4) { const int ks = 4 * kh + k4; fk[k4] = frag_tr(KK, PB, 16 * ks + 8 * hh + trq, 32 * tt + trc);
                f0[k4] = frag_tr(VV, PB, 16 * ks + 8 * hh + trq, 32 * (2 * dp) + trc); f1[k4] = frag_tr(VV, PB, 16 * ks + 8 * hh + trq, 32 * (2 * dp + 1) + trc); }
            __builtin_amdgcn_sched_barrier(0);
#pragma unroll
            for (int k4 = 0; k4 < 4; ++k4) { cacc0 = MFMA32(fk[k4], f0[k4], cacc0); cacc1 = MFMA32(fk[k4], f1[k4], cacc1); nacc = MFMA32(fk[k4], ones, nacc); } }
        __syncthreads();
        STAMP(4);
        {
            const int t = 32 * tt + r; const float dv = __builtin_amdgcn_rcpf(fmaxf(fabsf(dacc[0]), dnv[t]));
#pragma unroll
            for (int g4 = 0; g4 < 4; ++g4) {
                const int e0 = 32 * tt + 8 * g4 + 4 * hh, d0 = 32 * (2 * dp) + r, d1 = 32 * (2 * dp + 1) + r;
                *(LAS unsigned long long*)(CS + d0 * PB + e0 * 2) = (unsigned long long)pk2(cacc0[4 * g4], cacc0[4 * g4 + 1]) | ((unsigned long long)pk2(cacc0[4 * g4 + 2], cacc0[4 * g4 + 3]) << 32);
                *(LAS unsigned long long*)(CS + d1 * PB + e0 * 2) = (unsigned long long)pk2(cacc1[4 * g4], cacc1[4 * g4 + 1]) | ((unsigned long long)pk2(cacc1[4 * g4 + 2], cacc1[4 * g4 + 3]) << 32);
                const int dd0 = 32 * (2 * dp) + 8 * g4 + 4 * hh, dd1 = dd0 + 32;
                *(LAS unsigned long long*)(QP + t * PB + dd0 * 2) = (unsigned long long)pk2(na0[4 * g4] * dv, na0[4 * g4 + 1] * dv) | ((unsigned long long)pk2(na0[4 * g4 + 2] * dv, na0[4 * g4 + 3] * dv) << 32);
                *(LAS unsigned long long*)(QP + t * PB + dd1 * 2) = (unsigned long long)pk2(na1[4 * g4] * dv, na1[4 * g4 + 1] * dv) | ((unsigned long long)pk2(na1[4 * g4 + 2] * dv, na1[4 * g4 + 3] * dv) << 32);
                if (dp == 0 && r == 0) *(LAS unsigned long long*)((LAS unsigned char*)nstb + e0 * 2) = (unsigned long long)pk2(nacc[4 * g4], nacc[4 * g4 + 1]) | ((unsigned long long)pk2(nacc[4 * g4 + 2], nacc[4 * g4 + 3]) << 32);
            }
        }
        __syncthreads();
        STAMP(5);
        {
            float hv[32]; float ss = 0.f;
#pragma unroll
            for (int k = 0; k < 4; ++k) { const v4u x = *(const LAS v4u*)(QP + et * PB + eq * 64 + k * 16);
#pragma unroll
                for (int i = 0; i < 4; ++i) { hv[8 * k + 2 * i] = bflo(x[i]); hv[8 * k + 2 * i + 1] = bfhi(x[i]); ss += hv[8 * k + 2 * i] * hv[8 * k + 2 * i] + hv[8 * k + 2 * i + 1] * hv[8 * k + 2 * i + 1]; } }
            ss += shx(ss, 1, lane); ss += shx(ss, 2, lane);
            const float rr = __builtin_amdgcn_rsqf(ss * (1.0f / 128.0f) + EPS);
            bf16* op = optr + (size_t)c * 128 * PLD;
            LAS const float* nw = nwl + eq * 32;
#pragma unroll
            for (int k = 0; k < 4; ++k) { v4u o; const f32x4 w0 = *(LAS const f32x4*)(nw + 8 * k), w1 = *(LAS const f32x4*)(nw + 8 * k + 4);
#pragma unroll
                for (int i = 0; i < 4; ++i) { const float g0 = sigm_f(bflo(og[k][i])), g1 = sigm_f(bfhi(og[k][i]));
                    const float wa = (i < 2) ? w0[2 * i] : w1[2 * i - 4], wb = (i < 2) ? w0[2 * i + 1] : w1[2 * i - 3];
                    o[i] = pk2(hv[8 * k + 2 * i] * rr * wa * g0, hv[8 * k + 2 * i + 1] * rr * wb * g1); }
                *(v4u*)(op + 8 * k) = o; }
        }
    }
#if PROBE_PHASE != -1 && defined(PROBE_STAGES)
    STAMP(6);
    if (tid == 0 && pts) pts[PROBE_STAGES] = tacc;
#endif
#undef STAMP
    __syncthreads();
}

__device__ __forceinline__ void conv_fix(Frame& F, bf16* proj, const bf16* halo, const float* scw, const float* scb, const float* mcw, const float* mcb) {
    const int gt = F.vcu * (NWAVES * 64) + F.tid, NT = F.G * NWAVES * 64;
    for (int it = gt; it < 256 * 320; it += NT) {
        const int strip = it % 320, rg = it / 320, hch = strip * 8;
        const float* wp; const float* bp; int wst; float post = 1.0f;
        if (hch < 1536) { wp = scw + hch; bp = scb + hch; wst = 1536; }
        else { const int c2 = hch - 1536; wp = mcw + c2; bp = mcb + c2; wst = 1024; post = (c2 >= 512) ? 0.08838834764831845f : 1.0f; }
        bf16* base = proj + (size_t)rg * 64 * PLD + PC_XBC + hch;
        v4u r0 = (v4u){0, 0, 0, 0}, r1 = r0, r2 = r0;
        if ((rg & 31) != 0) { const bf16* hp = halo + ((size_t)(rg - 1) * 3) * 2560 + hch; r0 = *(const v4u*)hp; r1 = *(const v4u*)(hp + 2560); r2 = *(const v4u*)(hp + 5120); }
        v4u cur[3];
#pragma unroll
        for (int j = 0; j < 3; ++j) cur[j] = *(const v4u*)(base + (size_t)j * PLD);
        float cw[4][8], cb[8];
#pragma unroll
        for (int j = 0; j < 4; ++j) { const f32x4 a0 = *(const f32x4*)(wp + j * wst), a1 = *(const f32x4*)(wp + j * wst + 4);
#pragma unroll
            for (int i = 0; i < 4; ++i) { cw[j][i] = a0[i]; cw[j][4 + i] = a1[i]; } }
        { const f32x4 a0 = *(const f32x4*)bp, a1 = *(const f32x4*)(bp + 4);
#pragma unroll
          for (int i = 0; i < 4; ++i) { cb[i] = a0[i]; cb[4 + i] = a1[i]; } }
#pragma unroll
        for (int j = 0; j < 3; ++j) { v4u o;
#pragma unroll
            for (int i = 0; i < 4; ++i) {
                const float a0 = cb[2 * i] + cw[0][2 * i] * bflo(r0[i]) + cw[1][2 * i] * bflo(r1[i]) + cw[2][2 * i] * bflo(r2[i]) + cw[3][2 * i] * bflo(cur[j][i]);
                const float a1 = cb[2 * i + 1] + cw[0][2 * i + 1] * bfhi(r0[i]) + cw[1][2 * i + 1] * bfhi(r1[i]) + cw[2][2 * i + 1] * bfhi(r2[i]) + cw[3][2 * i + 1] * bfhi(cur[j][i]);
                o[i] = pk2(silu_f(a0) * post, silu_f(a1) * post); }
            *(v4u*)(base + (size_t)j * PLD) = o; r0 = r1; r1 = r2; r2 = cur[j]; }
    }
}

__device__ __forceinline__ void ksum_pass(Frame& F, const bf16* proj, float* ksum) {
    const int gt = F.vcu * (NWAVES * 64) + F.tid, NT = F.G * NWAVES * 64;
    for (int it = gt; it < 64 * 16 * 64; it += NT) {
        const int ch = it & 63, sl = (it >> 6) & 15, tile = it >> 10;
        const bf16* base = proj + ((size_t)tile * 256 + sl * 16) * PLD + PC_K + ch * 8;
        float a[8];
#pragma unroll
        for (int i = 0; i < 8; ++i) a[i] = 0.f;
        v4u v[16];
#pragma unroll
        for (int j = 0; j < 16; ++j) v[j] = *(const v4u*)(base + (size_t)j * PLD);
#pragma unroll
        for (int j = 0; j < 16; ++j)
#pragma unroll
            for (int i = 0; i < 4; ++i) { a[2 * i] += bflo(v[j][i]); a[2 * i + 1] += bfhi(v[j][i]); }
        float* kd = ksum + (size_t)tile * 512 + ch * 8;
#pragma unroll
        for (int i = 0; i < 8; ++i) atomicAdd(kd + i, a[i]);
    }
}

namespace attn_body {
using bf16=__hip_bfloat16;
using bf16x8=__attribute__((ext_vector_type(8)))short;
using s16x4=__attribute__((ext_vector_type(4)))short;
using f32x16=__attribute__((ext_vector_type(16)))float;
using u32x4=__attribute__((ext_vector_type(4)))unsigned;
constexpr int BATCH=8,NHEAD=8,SEQ=2048,D=64,DM=6144;
constexpr int NW=8,QBLK=32,QB=QBLK*NW,KVBLK=64,NQB=SEQ/QB;
constexpr int ATTN_PITCH=DM, ATTN_UNIT_ROWS=QB;
__device__ __forceinline__ int crow(int r,int hi){return (r&3)+8*(r>>2)+4*hi;}
#define SBAR() __builtin_amdgcn_sched_barrier(0)
__device__ __forceinline__ void cmask(f32x16&p0,f32x16&p1,int jb,int qrel,int hi){
  const float NEG=-INFINITY; int kb=64*jb+4*hi;
  #pragma unroll
  for(int r=0;r<16;++r){int kv=kb+(r&3)+8*(r>>2); if(kv>qrel)p0[r]=NEG; if(kv+32>qrel)p1[r]=NEG;}
}

typedef float f32x4_t __attribute__((ext_vector_type(4)));
__device__ __forceinline__ float bfu(short v){return __uint_as_float(((unsigned)(unsigned short)v)<<16);}
constexpr int NSLOT=3, SLOTB=8192;
constexpr int LDS_K=0, LDS_V=NSLOT*SLOTB, LDS_WS=2*NSLOT*SLOTB, LDS_OST=LDS_WS+NW*64*4, LDS_BYTES=LDS_OST+NW*4096;
constexpr float C2=0.125f*1.4426950408889634f;
__device__ __forceinline__ void glds16(const void*gsrc,unsigned lds_dst){unsigned keep;
  asm volatile("s_mov_b32 %0, m0\n\ts_mov_b32 m0, %2\n\ts_nop 0\n\tglobal_load_lds_dwordx4 %1, off\n\ts_mov_b32 m0, %0":"=&s"(keep):"v"(gsrc),"s"(lds_dst):"memory");}
__device__ __forceinline__ float max3f(float a,float b,float c){float r;asm("v_max3_f32 %0, %1, %2, %3":"=v"(r):"v"(a),"v"(b),"v"(c));return r;}
__device__ __forceinline__ float max2f(float a,float b){float r;asm("v_max_f32_e32 %0, %1, %2":"=v"(r):"v"(a),"v"(b));return r;}
__device__ __forceinline__ float fadd_s(float a,float b){float r;asm("v_add_f32_e32 %0, %1, %2":"=v"(r):"v"(a),"v"(b));return r;}
__device__ __forceinline__ float fsub_s(float a,float b){float r;asm("v_sub_f32_e32 %0, %1, %2":"=v"(r):"v"(a),"v"(b));return r;}
typedef float f32x2_t __attribute__((ext_vector_type(2))); typedef __bf16 bf16x2_t __attribute__((ext_vector_type(2)));
__device__ __forceinline__ unsigned cvtpk_s(float lo,float hi){f32x2_t v={lo,hi};bf16x2_t b=__builtin_convertvector(v,bf16x2_t);return __builtin_bit_cast(unsigned,b);}
#define WAIT_BAR(N) asm volatile("s_waitcnt vmcnt(" #N ") lgkmcnt(0)\n\ts_barrier":::"memory")

__device__ __forceinline__ void qkt(f32x16&p0,f32x16&p1,const char*Kslot,const bf16x8*qr,const f32x16&negm,int r32,int hi){
  const char*kb=Kslot+hi*1024+r32*16;
  #pragma unroll
  for(int d0=0;d0<4;++d0){
    const bf16x8 b0=*reinterpret_cast<const bf16x8*>(kb+d0*2048);
    const bf16x8 b1=*reinterpret_cast<const bf16x8*>(kb+d0*2048+512);
    if(d0==0){p0=__builtin_amdgcn_mfma_f32_32x32x16_bf16(b0,qr[0],negm,0,0,0);p1=__builtin_amdgcn_mfma_f32_32x32x16_bf16(b1,qr[0],negm,0,0,0);}
    else{p0=__builtin_amdgcn_mfma_f32_32x32x16_bf16(b0,qr[d0],p0,0,0,0);p1=__builtin_amdgcn_mfma_f32_32x32x16_bf16(b1,qr[d0],p1,0,0,0);}}
}
typedef __attribute__((address_space(3))) const char* lds_cptr;
typedef short v4i16_t __attribute__((ext_vector_type(4)));
__device__ __forceinline__ void kload8(bf16x8*kf,lds_cptr kp){
  kf[0]=*(const __attribute__((address_space(3))) bf16x8*)(kp);      kf[1]=*(const __attribute__((address_space(3))) bf16x8*)(kp+512);
  kf[2]=*(const __attribute__((address_space(3))) bf16x8*)(kp+2048); kf[3]=*(const __attribute__((address_space(3))) bf16x8*)(kp+2560);
  kf[4]=*(const __attribute__((address_space(3))) bf16x8*)(kp+4096); kf[5]=*(const __attribute__((address_space(3))) bf16x8*)(kp+4608);
  kf[6]=*(const __attribute__((address_space(3))) bf16x8*)(kp+6144); kf[7]=*(const __attribute__((address_space(3))) bf16x8*)(kp+6656);
}
__device__ __forceinline__ void kload2(bf16x8*kf,lds_cptr kp,int j){ kf[2*j]=*(const __attribute__((address_space(3))) bf16x8*)(kp+j*2048); kf[2*j+1]=*(const __attribute__((address_space(3))) bf16x8*)(kp+j*2048+512); }
__device__ __forceinline__ s16x4 vtr(lds_cptr p){ return __builtin_bit_cast(s16x4,__builtin_amdgcn_ds_read_tr16_b64_v4i16((__attribute__((address_space(3))) v4i16_t*)p)); }
__device__ __forceinline__ float rowmax(const f32x16&p0,const f32x16&p1){
  float a=max3f(p0[0],p0[1],p1[0]),b=max3f(p0[2],p0[3],p1[1]);a=max3f(a,p1[2],p1[3]);
  #pragma unroll
  for(int r=4;r<16;r+=4){a=max3f(a,p0[r],p0[r+1]);b=max3f(b,p0[r+2],p0[r+3]);a=max3f(a,p1[r],p1[r+1]);b=max3f(b,p1[r+2],p1[r+3]);}
  const float m=max2f(a,b);
  auto rr=__builtin_amdgcn_permlane32_swap(__float_as_uint(m),__float_as_uint(m),false,false);
  return max2f(__uint_as_float(rr[0]),__uint_as_float(rr[1]));
}
__device__ __forceinline__ void pv(f32x16*o,int vb,bf16x8 pa0,bf16x8 pa1,bf16x8 pa2,bf16x8 pa3){
  #pragma unroll
  for(int d0=0;d0<2;++d0){s16x4 lo[4],hi[4];
    #pragma unroll
    for(int ks=0;ks<4;++ks){
      asm volatile("ds_read_b64_tr_b16 %0,%1 offset:%c2":"=&v"(lo[ks]):"v"(vb),"i"(d0*4096+ks*1024):"memory");
      asm volatile("ds_read_b64_tr_b16 %0,%1 offset:%c2":"=&v"(hi[ks]):"v"(vb),"i"(d0*4096+ks*1024+512):"memory");}
    asm volatile("s_waitcnt lgkmcnt(0)":::"memory");SBAR();
    #define PK(k) (bf16x8){lo[k][0],lo[k][1],lo[k][2],lo[k][3],hi[k][0],hi[k][1],hi[k][2],hi[k][3]}
    o[d0]=__builtin_amdgcn_mfma_f32_32x32x16_bf16(pa0,PK(0),o[d0],0,0,0);
    o[d0]=__builtin_amdgcn_mfma_f32_32x32x16_bf16(pa1,PK(1),o[d0],0,0,0);
    o[d0]=__builtin_amdgcn_mfma_f32_32x32x16_bf16(pa2,PK(2),o[d0],0,0,0);
    o[d0]=__builtin_amdgcn_mfma_f32_32x32x16_bf16(pa3,PK(3),o[d0],0,0,0);
    #undef PK
  }
}

#ifndef ATTN_STORE16
#define ATTN_STORE16(p,v) (*(u32x4*)(p)=(v))
#endif
template<int THRL> __device__ __forceinline__ void attn_unit(int tid,int b,int h,int qb,const bf16*Q,const bf16*__restrict__ K,const bf16*__restrict__ V,bf16*O,const float*__restrict__ ksum,char*shm){
  asm volatile("":"+v"(tid));
  const int lane=tid&63,r32=lane&31,hi=lane>>5; const int wid=__builtin_amdgcn_readfirstlane(tid>>6);
  const long rowbase=(long)b*SEQ; const int q0=qb*QB;
  const bf16*Qw=Q+(rowbase+q0+wid*QBLK)*DM+h*D;
  const bf16*Kh=K+rowbase*DM+h*D,*Vh=V+rowbase*DM+h*D;
  const unsigned lds0=(unsigned)(uintptr_t)shm;
  float*wsf=(float*)(shm+LDS_WS)+wid*64;
  const bf16*ksrc=Kh+(long)lane*DM+wid*8;
  const bf16*vsrc=Vh+(long)(16*(wid&3)+(lane>>2))*DM+(wid>>2)*32+(lane&3)*8;
  const unsigned kdst=lds0+LDS_K+wid*1024, vdst=lds0+LDS_V+wid*1024;
  #define DMA_K(t,slot) glds16(ksrc+(long)(t)*KVBLK*DM,(unsigned)__builtin_amdgcn_readfirstlane(kdst+(slot)))
  #define DMA_V(t,slot) glds16(vsrc+(long)(t)*KVBLK*DM,(unsigned)__builtin_amdgcn_readfirstlane(vdst+(slot)))
  const int vb0=(int)(lds0+LDS_V)+((lane>>4)&1)*32+(lane&3)*8+(4*hi+((lane&15)>>2))*64;
  const char*Kbase=shm+LDS_K; bf16x8 kf[8];
  const lds_cptr shm3=(lds_cptr)shm; const lds_cptr kp0=shm3+LDS_K+hi*1024+r32*16; const lds_cptr vp0=shm3+LDS_V+((lane>>4)&1)*32+(lane&3)*8+(4*hi+((lane&15)>>2))*64;
  const int NT=(q0+QB)/KVBLK;
  DMA_K(0,0);DMA_V(0,0);DMA_K(1,SLOTB);
  bf16x8 qr[4];
  #pragma unroll
  for(int d0=0;d0<4;++d0)qr[d0]=*reinterpret_cast<const bf16x8*>(&Qw[(long)r32*DM+d0*16+hi*8]);
  unsigned sel=(1u<<qb)-1u;
  if(qb>=4){
    float g[8];
    #pragma unroll
    for(int n=0;n<8;++n){ g[n]=0.f;
      { const float*kp=ksum+(((long)(b*8+n)*NHEAD+h)*64)+hi*8; float a=0.f;
        #pragma unroll
        for(int d0=0;d0<4;++d0){ const f32x4_t k0=*(const f32x4_t*)(kp+d0*16),k1=*(const f32x4_t*)(kp+d0*16+4);
          #pragma unroll
          for(int j=0;j<4;++j){ a+=bfu(qr[d0][j])*k0[j]; a+=bfu(qr[d0][4+j])*k1[j]; } }
        a+=shx(a,32,lane); g[n]=a; } }
    sel=0u;
    #pragma unroll
    for(int k=0;k<3;++k){ int best=-1; float bv=0.f;
      #pragma unroll
      for(int n=0;n<8;++n) if(n<qb&&!((sel>>n)&1u)){ if(best<0||g[n]>bv){best=n;bv=g[n];} }
      sel|=1u<<best; }
  }
  const f32x16 ninf={-INFINITY,-INFINITY,-INFINITY,-INFINITY,-INFINITY,-INFINITY,-INFINITY,-INFINITY,-INFINITY,-INFINITY,-INFINITY,-INFINITY,-INFINITY,-INFINITY,-INFINITY,-INFINITY};
  #define CINIT(t) ({ const bool mk_=((t)<NT-4)&&!((sel>>((t)>>2))&1u); f32x16 c_; _Pragma("unroll") for(int r_=0;r_<16;++r_)c_[r_]=mk_?ninf[r_]:negm[r_]; c_; })
  float mhat=0.f,l_reg=0.f;f32x16 o[2];o[0]=f32x16{};o[1]=f32x16{};f32x16 negm=f32x16{};asm volatile("":"+v"(negm));
  const int qrel=wid*QBLK+r32;
  #define CMASK(P0,P1,t) do{int jb_=(t)-(NT-4); if(jb_>=0)cmask(P0,P1,jb_,qrel,hi);}while(0)
  bool resc=false;
  #define START(P0,P1) do{ const float rm=rowmax(P0,P1); resc=false; \
    { const float dl=max2f(rm,-64.f); mhat=fadd_s(mhat,dl); \
      _Pragma("unroll") for(int r=0;r<16;++r){P0[r]=fsub_s(P0[r],dl);P1[r]=fsub_s(P1[r],dl);} \
      _Pragma("unroll") for(int r=0;r<16;++r)negm[r]=-mhat; asm volatile("":"+v"(negm)); } \
    _Pragma("unroll") for(int r=0;r<16;++r)P0[r]=__builtin_amdgcn_exp2f(P0[r]); }while(0)
  #define RESC() do{ if(resc){ asm volatile("s_waitcnt lgkmcnt(0)":::"memory"); \
      _Pragma("unroll") for(int d_=0;d_<2;++d_) _Pragma("unroll") for(int r=0;r<16;++r)o[d_][r]*=wsf[crow(r,hi)]; } }while(0)
  f32x16 pA0,pA1,pB0,pB1;
  int sl_prev=0,sl_cur=0,sl_next=SLOTB;
  #define ROT() do{sl_prev=sl_cur;sl_cur=sl_next;sl_next=(sl_next==(NSLOT-1)*SLOTB)?0:sl_next+SLOTB;}while(0)
  DMA_K(2,2*SLOTB);
  WAIT_BAR(3);
  { const f32x16 c0_=CINIT(0); qkt(pA0,pA1,Kbase,qr,c0_,r32,hi); }asm volatile("s_nop 15\n\ts_nop 7":"+v"(pA0),"+v"(pA1));CMASK(pA0,pA1,0);
  START(pA0,pA1);
  _Pragma("unroll") for(int r=0;r<16;++r)pA1[r]=__builtin_amdgcn_exp2f(pA1[r]);
  WAIT_BAR(0);
  DMA_K(3,0);DMA_V(1,SLOTB);
  ROT();
  kload8(kf,kp0+sl_cur);
  WAIT_BAR(2);
  s16x4 vlo[8],vhi[8]; u32x4 pw0,pw1,pw2,pw3;
  #define PKW(P,B) cvtpk_s(P[B],P[B+1])
  #define PAF(k) __builtin_bit_cast(bf16x8,pw##k)
  #define VFR(i) (bf16x8){vlo[i][0],vlo[i][1],vlo[i][2],vlo[i][3],vhi[i][0],vhi[i][1],vhi[i][2],vhi[i][3]}
  #define PIN(x) asm volatile("":"+v"(x))
  #define MX3(a,b,c) __builtin_fmaxf(__builtin_fmaxf((a),(b)),(c))
  #define GAPA(MF,A0,A1,A2,A3,W0,W1,PW) do{ MF; sacc+=A0; sacc+=A1; sacc+=A2; sacc+=A3; PIN(sacc); W0; W1; PIN(PW); SBAR(); }while(0)
  #define EX(v) __builtin_amdgcn_exp2f(v)
  #define GAPB(MF,X,B) do{ MF; X[B]=EX(X[B]); X[B+1]=EX(X[B+1]); X[B+2]=EX(X[B+2]); X[B+3]=EX(X[B+3]); PIN(X); SBAR(); }while(0)
  #define VRD(i) do{ vlo[i]=vtr(vp_+(((i)>>2)*4096+((i)&3)*1024)); vhi[i]=vtr(vp_+(((i)>>2)*4096+((i)&3)*1024+512)); }while(0)
  #define KRD(G,j) do{ if(G){ kload2(kf,kp0+sl_next,j); SBAR(); } }while(0)
  #define STEP(C0,C1,P0,P1,t,GK,GV,GL) do{ SBAR(); \
    const lds_cptr vp_=vp0+sl_prev; const f32x16 cin_=CINIT(t); \
    VRD(0); SBAR(); float sacc=(P0[0]+P0[1]); \
    GAPA(C0=__builtin_amdgcn_mfma_f32_32x32x16_bf16(kf[0],qr[0],cin_,0,0,0), P0[2],P0[3],P0[4],P0[5],     pw0[0]=PKW(P0,0), pw0[1]=PKW(P0,2), pw0); \
    VRD(4); SBAR(); GAPA(C1=__builtin_amdgcn_mfma_f32_32x32x16_bf16(kf[1],qr[0],cin_,0,0,0), P0[6],P0[7],P0[8],P0[9],     pw0[2]=PKW(P0,4), pw0[3]=PKW(P0,6), pw0); \
    VRD(1); SBAR(); GAPA(C0=__builtin_amdgcn_mfma_f32_32x32x16_bf16(kf[2],qr[1],C0,0,0,0),   P0[10],P0[11],P0[12],P0[13], pw1[0]=PKW(P0,8), pw1[1]=PKW(P0,10), pw1); \
    VRD(5); SBAR(); GAPA(C1=__builtin_amdgcn_mfma_f32_32x32x16_bf16(kf[3],qr[1],C1,0,0,0),   P0[14],P0[15],P1[0],P1[1],   pw1[2]=PKW(P0,12),pw1[3]=PKW(P0,14), pw1); \
    VRD(2); SBAR(); GAPA(C0=__builtin_amdgcn_mfma_f32_32x32x16_bf16(kf[4],qr[2],C0,0,0,0),   P1[2],P1[3],P1[4],P1[5],     pw2[0]=PKW(P1,0), pw2[1]=PKW(P1,2), pw2); \
    VRD(6); SBAR(); GAPA(C1=__builtin_amdgcn_mfma_f32_32x32x16_bf16(kf[5],qr[2],C1,0,0,0),   P1[6],P1[7],P1[8],P1[9],     pw2[2]=PKW(P1,4), pw2[3]=PKW(P1,6), pw2); \
    VRD(3); SBAR(); GAPA(C0=__builtin_amdgcn_mfma_f32_32x32x16_bf16(kf[6],qr[3],C0,0,0,0),   P1[10],P1[11],P1[12],P1[13], pw3[0]=PKW(P1,8), pw3[1]=PKW(P1,10), pw3); \
    VRD(7); SBAR(); GAPA(C1=__builtin_amdgcn_mfma_f32_32x32x16_bf16(kf[7],qr[3],C1,0,0,0),   P1[14],P1[15],0.f,0.f,       pw3[2]=PKW(P1,12),pw3[3]=PKW(P1,14), pw3); \
    l_reg+=sacc; \
    if(GK){DMA_K((t)+3,sl_cur);} if(GV){DMA_V((t)+1,sl_next);} \
    CMASK(C0,C1,t); \
    { float a=MX3(C0[0],C0[1],C1[0]),b=MX3(C0[2],C0[3],C1[1]); a=MX3(a,C1[2],C1[3]); \
      _Pragma("unroll") for(int r=4;r<16;r+=4){a=MX3(a,C0[r],C0[r+1]);b=MX3(b,C0[r+2],C0[r+3]);a=MX3(a,C1[r],C1[r+1]);b=MX3(b,C1[r+2],C1[r+3]);} \
      float rm=__builtin_fmaxf(a,b); { auto rr=__builtin_amdgcn_permlane32_swap(__float_as_uint(rm),__float_as_uint(rm),false,false); rm=__builtin_fmaxf(__uint_as_float(rr[0]),__uint_as_float(rr[1])); } \
      resc=false; \
      if(__builtin_expect(__any(rm>(float)THRL),0)){ const float dl=__builtin_fmaxf(rm,0.f); mhat+=dl; \
        _Pragma("unroll") for(int r=0;r<16;++r){C0[r]-=dl;C1[r]-=dl;} \
        _Pragma("unroll") for(int r=0;r<16;++r)negm[r]=-mhat; asm volatile("":"+v"(negm)); \
        const float f=__builtin_amdgcn_exp2f(-dl); l_reg*=f; if(hi==0)wsf[r32]=f; resc=true; } } \
    SBAR(); \
    GAPB(o[0]=__builtin_amdgcn_mfma_f32_32x32x16_bf16(PAF(0),VFR(0),o[0],0,0,0), C0,0); \
    GAPB(o[1]=__builtin_amdgcn_mfma_f32_32x32x16_bf16(PAF(0),VFR(4),o[1],0,0,0), C0,4); \
    KRD(GL,0); GAPB(o[0]=__builtin_amdgcn_mfma_f32_32x32x16_bf16(PAF(1),VFR(1),o[0],0,0,0), C0,8); \
    KRD(GL,1); GAPB(o[1]=__builtin_amdgcn_mfma_f32_32x32x16_bf16(PAF(1),VFR(5),o[1],0,0,0), C0,12); \
    KRD(GL,2); GAPB(o[0]=__builtin_amdgcn_mfma_f32_32x32x16_bf16(PAF(2),VFR(2),o[0],0,0,0), C1,0); \
    KRD(GL,3); GAPB(o[1]=__builtin_amdgcn_mfma_f32_32x32x16_bf16(PAF(2),VFR(6),o[1],0,0,0), C1,4); \
    GAPB(o[0]=__builtin_amdgcn_mfma_f32_32x32x16_bf16(PAF(3),VFR(3),o[0],0,0,0), C1,8); \
    GAPB(o[1]=__builtin_amdgcn_mfma_f32_32x32x16_bf16(PAF(3),VFR(7),o[1],0,0,0), C1,12); \
    }while(0)
  int t=1;
  #undef CMASK
  #define CMASK(P0,P1,t) do{}while(0)
  for(;t+5<NT;t+=2){
    STEP(pB0,pB1,pA0,pA1,t,true,true,true);     WAIT_BAR(2); RESC(); ROT();
    STEP(pA0,pA1,pB0,pB1,t+1,true,true,true);   WAIT_BAR(2); RESC(); ROT();
  }
  #undef CMASK
  #define CMASK(P0,P1,t) do{int jb_=(t)-(NT-4); if(jb_>=0)cmask(P0,P1,jb_,qrel,hi);}while(0)
  #define ENDW(tt) do{ if((tt)+3<NT){WAIT_BAR(2);} else if((tt)+2<NT){WAIT_BAR(1);} else {WAIT_BAR(0);} }while(0)
  for(;t+1<NT;t+=2){
    STEP(pB0,pB1,pA0,pA1,t,(t+3<NT),(t+1<NT),(t+1<NT));       ENDW(t);   RESC(); ROT();
    STEP(pA0,pA1,pB0,pB1,t+1,(t+4<NT),(t+2<NT),(t+2<NT));     ENDW(t+1); RESC(); ROT();
  }
  STEP(pB0,pB1,pA0,pA1,NT-1,false,false,false); RESC();
  { float sacc=pB0[0]+pB0[1]; _Pragma("unroll") for(int r=2;r<16;++r)sacc+=pB0[r]; _Pragma("unroll") for(int r=0;r<16;++r)sacc+=pB1[r]; l_reg+=sacc;
    pw0=(u32x4){PKW(pB0,0),PKW(pB0,2),PKW(pB0,4),PKW(pB0,6)};pw1=(u32x4){PKW(pB0,8),PKW(pB0,10),PKW(pB0,12),PKW(pB0,14)};pw2=(u32x4){PKW(pB1,0),PKW(pB1,2),PKW(pB1,4),PKW(pB1,6)};pw3=(u32x4){PKW(pB1,8),PKW(pB1,10),PKW(pB1,12),PKW(pB1,14)};
    SBAR(); pv(o,vb0+sl_cur,PAF(0),PAF(1),PAF(2),PAF(3)); }
  #undef PKW
  #undef PAF
  #undef VFR
  #undef PIN
  #undef MX3
  #undef GAPA
  #undef GAPB
  #undef EX
  #undef VRD
  #undef KRD
  #undef STEP
  #undef ENDW
  {auto rr=__builtin_amdgcn_permlane32_swap(__float_as_uint(l_reg),__float_as_uint(l_reg),false,false);l_reg=__uint_as_float(rr[0])+__uint_as_float(rr[1]);}
  if(hi==0)wsf[32+r32]=l_reg;asm volatile("s_waitcnt lgkmcnt(0)":::"memory");
  float rli[16];
  #pragma unroll
  for(int r=0;r<16;++r)rli[r]=__builtin_amdgcn_rcpf(wsf[32+crow(r,hi)]);
  bf16*Ow=O+(rowbase+q0+wid*QBLK)*DM+h*D;
  { bf16*stg=(bf16*)(shm+LDS_OST)+wid*2048;
    #pragma unroll
    for(int r=0;r<16;++r){const int orow=crow(r,hi);
      #pragma unroll
      for(int d0=0;d0<2;++d0)stg[orow*64+d0*32+r32]=__float2bfloat16(o[d0][r]*rli[r]);}
    asm volatile("s_waitcnt lgkmcnt(0)":::"memory");
    #pragma unroll
    for(int i=0;i<4;++i){const int row=i*8+(lane>>3),ch=lane&7; const u32x4 v=*(const u32x4*)(stg+row*64+ch*8); ATTN_STORE16(Ow+(long)row*DM+ch*8,v);} }
  asm volatile("s_waitcnt lgkmcnt(0)\n\ts_barrier":::"memory");
  #undef CINIT
  #undef DMA_K
  #undef DMA_V
  #undef CMASK
  #undef START
  #undef RESC
  #undef ROT
}
constexpr int ATTN_LDS_BYTES=LDS_BYTES;
#undef SBAR
#undef WAIT_BAR
}

constexpr int PH_PER_LAYER = 10, N_PHASES = PH_PER_LAYER * DEPTH;

constexpr int CONV_UNIT_ITEMS = 16, N_CONV_UNITS = (1024 + 2816) / CONV_UNIT_ITEMS;
__device__ __forceinline__ void conv_unit(int wave, int lane, int idx, const float* w_out, const float* ssm_nw, const float* w_up, const float* n2w, bf16* bufa, bf16* bufb, LAS float* scr) {
    for (int it = CONV_UNIT_ITEMS * idx + wave; it < CONV_UNIT_ITEMS * idx + CONV_UNIT_ITEMS; it += NWAVES) {
        if (it < 1024) { const int kb = it >> 5, nb = it & 31; conv_item(w_out, DM, 32 * nb, bufb, DMIX, 32 * nb, 64 * kb, scr, lane, ssm_nw, 512, 1536); }
        else { const int i2 = it - 1024, kb = i2 / (ULD / 32), nb = i2 % (ULD / 32); const int src = ((nb >> 2) & 1) * FFN + 128 * (nb >> 3) + (nb & 3) * 32;
            conv_item(w_up, ULD, src, bufa, DM, 32 * nb, 64 * kb, scr, lane, n2w); }
    }
}

template <int L, int P>
__device__ __forceinline__ void run_phase(Frame& F, const int wave0, const int ph_lo, const int ph_hi) {
    constexpr int l = L, p = P, ph = L * PH_PER_LAYER + P;
    if constexpr ((L > 0 && P == 0) || P == 4 || P == 6 || P == 8) return;
    if (!(ph_lo <= ph && ph < ph_hi)) return;
    {
        const __attribute__((address_space(4))) Args* ap = (const __attribute__((address_space(4))) Args*)__builtin_amdgcn_kernarg_segment_ptr();
        asm volatile("" : "+s"(ap));
        { int t_ = wave0 * 64 + fresh_lane(); asm volatile("" : "+v"(t_)); F.tid = t_; F.lane = t_ & 63; F.wave = __builtin_amdgcn_readfirstlane(t_ >> 6); }
        F.G = gridDim.x; { const int bx = blockIdx.x; F.vcu = (F.G % 8 == 0) ? (bx % 8) * (F.G / 8) + bx / 8 : bx; }
        unsigned char* ws = ap->ws; float* out = ap->out;
        bf16* bufa = (bf16*)(ws + WS_BUFA); bf16* bufb = (bf16*)(ws + WS_BUFB); bf16* xb = (bf16*)(ws + WS_XB); bf16* proj = (bf16*)(ws + WS_PROJ);
        float* smallp = (float*)(ws + WS_SMALLP); float* ssq = (float*)(ws + WS_SSQ);
        switch (p) {
        case 0: {
            LAS float* scr = (LAS float*)(F.lds + F.wave * 16384);
            conv_w_in(F, ap->in[2], ap->in[1], bufa, scr);
            conv_small(F, ap->in[2], ap->in[1], (bf16*)(ws + WS_WSM));
            row_pass0(F, ap->in[0], xb, (float*)(ws + WS_RS));
        } break;
        case 1: {
            const float* rs = (const float*)(ws + WS_RS) + (size_t)(2 * l) * M;
            pg8::Gemm g{xb, bufa, M, PLD, DM, DM}; pg8::StaticOrder S; S.init(M, PLD, F.G, (int)blockIdx.x);
            pg8::EpiProj E{ws, (const float* const __attribute__((address_space(4)))*)ap->in, l};
            pg8::gemm_phase<pg8::EpiProj>(F.lds + RING_OFF, g, S, E, F.tid);
            small_proj(F, xb, (const bf16*)(ws + WS_WSM) + (size_t)(l & 1) * 32 * DM, rs, smallp);
        } break;
        case 2: {
            ksum_pass(F, proj, (float*)(ws + WS_KSUM + (size_t)l * 131072));
            conv_fix(F, proj, (const bf16*)(ws + WS_HALO), ap->in[5] + (size_t)l * 4 * 1536, ap->in[6] + l * 1536, ap->in[11] + (size_t)l * 4 * 1024, ap->in[12] + l * 1024);
        } break;
        case 3: {
            gu32* qhead = (gu32*)(ws + WS_QUEUE) + l * 64;
            volatile LAS unsigned* MISC = (volatile LAS unsigned*)(F.lds + MISC_OFF);
            const attn_body::bf16* pq = (const attn_body::bf16*)proj; const float* ks = (const float*)(ws + WS_KSUM + (size_t)l * 131072);
            for (;;) {
                const int tq = wave0 * 64 + fresh_lane();
                __syncthreads();
                if (tq == 0) MISC[0] = __hip_atomic_fetch_add(qhead, 1u, RLX_AGENT);
                __syncthreads();
                const int u = (int)MISC[0];
                if (u >= 672 + N_CONV_UNITS) break;
#if PROBE_PHASE != -1
                const unsigned long long tu0 = __builtin_amdgcn_s_memrealtime();
#endif
                if (u < 32) mlstm_unit(tq, proj, smallp, ap->in[13] + l * 4, ap->in[14] + l * 4, ap->in[15] + l * 512, u >> 2, u & 3, F.lds, (float*)(ws + WS_GSC) + (size_t)u * 16 * 656, (l == 0 && u == 0) ? (unsigned long long*)(ws + WS_TS) + 1024 : nullptr);
                else if (u < 160) ssd_unit(tq, proj, smallp, ssq, ap->in[7] + l * 16, ap->in[8] + l * 16, ap->in[9] + l * 16, (u - 32) >> 4, (u - 32) & 15, F.lds);
                else if (u < 672) { const int idx = u - 160, bh = idx & 63, qb = 7 - (idx >> 6);
                    attn_body::attn_unit<8>(tq, bh >> 3, bh & 7, qb, pq + PC_Q, pq + PC_K, pq + PC_V, (attn_body::bf16*)proj + PC_Q, ks, (char*)F.lds); }
                else conv_unit(wave0, tq & 63, u - 672, ap->in[16] + (size_t)l * DMIX * DM, ap->in[10] + l * 1024, ap->in[18] + (size_t)l * DM * ULD, ap->in[17] + l * DM, bufa, bufb, (LAS float*)(F.lds + wave0 * 16384));
#if PROBE_PHASE != -1
                if (l == 0 && wave0 == 0 && fresh_lane() == 0) __hip_atomic_store((unsigned long long*)(ws + WS_TS) + 128 + u, (unsigned long long)(__builtin_amdgcn_s_memrealtime() - tu0), __ATOMIC_RELAXED, __HIP_MEMORY_SCOPE_AGENT);
#endif
            }
        } break;
        case 4: break;
        case 5: {
            pg8::Gemm g{proj, bufb, M, DM, DMIX, PLD}; pg8::StaticOrder S; S.init(M, DM, F.G, (int)blockIdx.x);
            LAS float* ftab = (LAS float*)(F.lds + RING_BYTES);
            { pg8::Unit u0; if (S.next(0, u0)) { const int row = F.tid >> 1; const float* sq = ssq + (size_t)(u0.pm * 256 + row) * 16;
                const f32x4 a0 = *(const f32x4*)sq, a1 = *(const f32x4*)(sq + 4), a2 = *(const f32x4*)(sq + 8), a3 = *(const f32x4*)(sq + 12);
                const float s0 = ((a0[0] + a0[1]) + (a0[2] + a0[3])) + ((a1[0] + a1[1]) + (a1[2] + a1[3])), s1 = ((a2[0] + a2[1]) + (a2[2] + a2[3])) + ((a3[0] + a3[1]) + (a3[2] + a3[3]));
                const float r0 = 1.0f / sqrtf(s0 * (1.0f / 512.0f) + EPS), r1 = 1.0f / sqrtf(s1 * (1.0f / 512.0f) + EPS);
                ftab[F.tid] = (F.tid & 1) ? r1 : r0 / r1; } }
            LDS_WAIT(); __syncthreads();
            pg8::EpiRes E{xb, nullptr, (float*)(ws + WS_RS) + (size_t)(2 * l + 1) * M};
            pg8::gemm_phase<pg8::EpiRes, 1>(F.lds + RING_OFF, g, S, E, F.tid, (const LAS float*)ftab);
        } break;
        case 6: break;
        case 7: {
            pg8::Gemm g{xb, bufa, M, ULD, DM, DM}; pg8::StaticOrder S; S.init(M, ULD, F.G, (int)blockIdx.x);
            pg8::EpiFfn E{proj, (const float*)(ws + WS_RS) + (size_t)(2 * l + 1) * M, ap->in[19] + (size_t)l * 3 * FFN, ap->in[20] + l * FFN, (bf16*)(ws + WS_SIDEA), (bf16*)(ws + WS_SIDEB)};
            pg8::gemm_phase<pg8::EpiFfn>(F.lds + RING_OFF, g, S, E, F.tid);
            {
                const bool half = (F.G == 256); if (!half || blockIdx.x >= 128) { Frame F2 = F; if (half) { F2.vcu = (int)blockIdx.x - 128; F2.G = 128; }
                    conv_plain(F2, ap->in[21] + (size_t)l * FFN * DM, FFN, DM, nullptr, bufb, (LAS float*)(F.lds + F.wave * 16384));
                    if (l + 1 < DEPTH) conv_small(F2, ap->in[2] + (size_t)(l + 1) * DM * P_IN, ap->in[1] + (l + 1) * DM, (bf16*)(ws + WS_WSM) + (size_t)((l + 1) & 1) * 32 * DM); } }
        } break;
        case 8: break;
        case 9: {
            pg8::Gemm g{proj, bufb, M, DM, FFN, FFN}; pg8::StaticOrder S; S.init(M, DM, F.G, (int)blockIdx.x);
            { pg8::Unit u0; for (int i = 0; S.next(i, u0); ++i) ffn_fix(F, proj, (const bf16*)(ws + WS_SIDEA), (const bf16*)(ws + WS_SIDEB), ap->in[19] + (size_t)l * 3 * FFN, ap->in[20] + l * FFN, u0.pm); }
            VM_WAIT(); __syncthreads();
            pg8::EpiRes E{xb, (l + 1 < DEPTH) ? nullptr : out, (float*)(ws + WS_RS) + (size_t)(2 * l + 2) * M};
            pg8::gemm_phase<pg8::EpiRes>(F.lds + RING_OFF, g, S, E, F.tid);
            if (l + 1 < DEPTH) conv_w_in(F, ap->in[2] + (size_t)(l + 1) * DM * P_IN, ap->in[1] + (l + 1) * DM, bufa, (LAS float*)(F.lds + F.wave * 16384));
        } break;
        }
        if (ph + 1 < ph_hi || PROBE_PHASE != -1) { XcdBarrier bar; bar.bar = (unsigned*)(ap->ws + WS_CTL) + CW_BAR; bar.x = xb_xcc_id(); bar.st = (volatile LAS unsigned*)(F.lds + MISC_OFF) + 8; xcd_barrier(bar, wave0 * 64 + fresh_lane()); }
#if PROBE_PHASE != -1
        if (blockIdx.x == 0 && wave0 == 0 && fresh_lane() == 0) { const unsigned long long tnow = __builtin_amdgcn_s_memrealtime();
            __hip_atomic_store((unsigned long long*)(ap->ws + WS_TS) + 1 + ph, tnow, __ATOMIC_RELAXED, __HIP_MEMORY_SCOPE_AGENT);
            if (P == 3 || P == 5 || P == 7 || P == 9) __hip_atomic_store((unsigned long long*)(ap->ws + WS_TS) + 2 + ph, tnow, __ATOMIC_RELAXED, __HIP_MEMORY_SCOPE_AGENT); }
#endif
    }
}

__global__ void __launch_bounds__(NWAVES * 64, 2) fwd(Args args) {
    extern __shared__ __attribute__((aligned(16))) unsigned char lds[];
    Frame F;
    F.lds = (LAS unsigned char*)lds;
    F.tid = threadIdx.x; F.lane = F.tid & 63; F.wave = __builtin_amdgcn_readfirstlane(F.tid >> 6);
    const int wave0 = F.wave;
    for (int u = F.tid; u < (LDS_BYTES - LDSCTL_OFF) / 4; u += NWAVES * 64) ((LAS unsigned*)(F.lds + LDSCTL_OFF))[u] = 0u;
    __syncthreads();
    const int ph_lo = args.ph_lo, ph_hi = args.ph_hi;
#if PROBE_PHASE != -1
    if (blockIdx.x == 0 && F.tid == 0) __hip_atomic_store((unsigned long long*)(args.ws + WS_TS), (unsigned long long)__builtin_amdgcn_s_memrealtime(), __ATOMIC_RELAXED, __HIP_MEMORY_SCOPE_AGENT);
#endif
    if (ph_hi - ph_lo > 1) (void)xcd_barrier_post((unsigned*)(args.ws + WS_CTL) + CW_BAR, (volatile LAS unsigned*)(F.lds + MISC_OFF) + 8);

    run_phase<0, 0>(F, wave0, ph_lo, ph_hi);
    run_phase<0, 1>(F, wave0, ph_lo, ph_hi);
    run_phase<0, 2>(F, wave0, ph_lo, ph_hi);
    run_phase<0, 3>(F, wave0, ph_lo, ph_hi);
    run_phase<0, 4>(F, wave0, ph_lo, ph_hi);
    run_phase<0, 5>(F, wave0, ph_lo, ph_hi);
    run_phase<0, 6>(F, wave0, ph_lo, ph_hi);
    run_phase<0, 7>(F, wave0, ph_lo, ph_hi);
    run_phase<0, 8>(F, wave0, ph_lo, ph_hi);
    run_phase<0, 9>(F, wave0, ph_lo, ph_hi);
    run_phase<1, 0>(F, wave0, ph_lo, ph_hi);
    run_phase<1, 1>(F, wave0, ph_lo, ph_hi);
    run_phase<1, 2>(F, wave0, ph_lo, ph_hi);
    run_phase<1, 3>(F, wave0, ph_lo, ph_hi);
    run_phase<1, 4>(F, wave0, ph_lo, ph_hi);
    run_phase<1, 5>(F, wave0, ph_lo, ph_hi);
    run_phase<1, 6>(F, wave0, ph_lo, ph_hi);
    run_phase<1, 7>(F, wave0, ph_lo, ph_hi);
    run_phase<1, 8>(F, wave0, ph_lo, ph_hi);
    run_phase<1, 9>(F, wave0, ph_lo, ph_hi);
#if PROBE_PHASE != -1
    {
        const __attribute__((address_space(4))) Args* ap = (const __attribute__((address_space(4))) Args*)__builtin_amdgcn_kernarg_segment_ptr();
        const unsigned long long* ts = (const unsigned long long*)(ap->ws + WS_TS);
        float us = 500.f;
#ifdef PROBE_UNIT
        if (true) { us = 0.01f * (float)__hip_atomic_load(ts + PROBE_UNIT, __ATOMIC_RELAXED, __HIP_MEMORY_SCOPE_AGENT); } else
#endif
        if (PROBE_PHASE >= 0) { us = 0.f;
            for (int l = 0; l < DEPTH; ++l) { const int ph = l * PH_PER_LAYER + PROBE_PHASE; if (ph < N_PHASES - 1) us += 0.01f * (float)(__hip_atomic_load(ts + 1 + ph, __ATOMIC_RELAXED, __HIP_MEMORY_SCOPE_AGENT) - __hip_atomic_load(ts + ph, __ATOMIC_RELAXED, __HIP_MEMORY_SCOPE_AGENT)); } }
        const float dl = sqrtf(PROBE_GAIN * us);
        float* o = ap->out;
        for (size_t i = (size_t)blockIdx.x * 512 + wave0 * 64 + fresh_lane(); i < (size_t)M * DM; i += (size_t)gridDim.x * 512) o[i] += (i & 1) ? dl : -dl;
    }
#endif
}

extern "C" void kernel_launch(void* const* d_in, const int* in_sizes, int n_in, void* d_out, int out_size, void* d_ws, size_t ws_size, hipStream_t stream) {
    static int grid = 0;
    if (grid == 0) {
        if (n_in != 22 || in_sizes[0] != M * DM || out_size != M * DM || ws_size < WS_END) { fprintf(stderr, "kernel_launch: unexpected shapes (n_in %d, in0 %d, out %d, ws %zu); nothing launched\n", n_in, n_in > 0 ? in_sizes[0] : -1, out_size, ws_size); grid = -1; return; }
        int dev = 0, cus = 0, per_cu = 0;
        if (hipGetDevice(&dev) != hipSuccess || hipDeviceGetAttribute(&cus, hipDeviceAttributeMultiprocessorCount, dev) != hipSuccess) { grid = -1; return; }
        if (hipFuncSetAttribute((const void*)fwd, hipFuncAttributeMaxDynamicSharedMemorySize, LDS_BYTES) != hipSuccess) { fprintf(stderr, "kernel_launch: hipFuncSetAttribute failed\n"); grid = -1; return; }
        if (hipOccupancyMaxActiveBlocksPerMultiprocessor(&per_cu, (const void*)fwd, NWAVES * 64, LDS_BYTES) != hipSuccess || per_cu < 1) { fprintf(stderr, "kernel_launch: occupancy query reports %d blocks per CU\n", per_cu); per_cu = 1; }
        (void)hipGetLastError();
        grid = cus;
    }
    if (grid < 0) return;
    (void)hipMemsetAsync((char*)d_ws + WS_CTL, 0, CTL_ZERO_BYTES, stream);
    Args a{};
    for (int i = 0; i < 22; ++i) a.in[i] = (const float*)d_in[i];
    a.out = (float*)d_out; a.ws = (unsigned char*)d_ws;
#if MK_MULTI
    for (int ph = 0; ph < N_PHASES; ++ph) {
        a.ph_lo = ph; a.ph_hi = ph + 1;
        hipLaunchKernelGGL(fwd, dim3(grid), dim3(NWAVES * 64), LDS_BYTES, stream, a);
    }
#else
    a.ph_lo = 0; a.ph_hi = N_PHASES;
    hipLaunchKernelGGL(fwd, dim3(grid), dim3(NWAVES * 64), LDS_BYTES, stream, a);
#endif
}
```

```cpp
#include <hip/hip_runtime.h>
#include <hip/hip_bf16.h>
#include <cstdio>
#include <cstdint>
#include <cmath>

#ifndef PROBE_PHASE
#define PROBE_PHASE -1
#endif
#ifndef PROBE_GAIN
#define PROBE_GAIN 1e-6f
#endif
#ifndef MK_MULTI
#define MK_MULTI 0
#endif

constexpr int BATCH = 8, SEQ = 2048, DM = 1024, DEPTH = 2;
constexpr int M = BATCH * SEQ;
constexpr int P_IN = 6168;
constexpr int PLD = 6144;
constexpr int PC_Q = 0, PC_Z = 512, PC_MO = 1536, PC_K = 2048, PC_V = 2560, PC_XBC = 3072, PC_MQK = 4608, PC_MV = 5632;
constexpr int SC_Q = 0, SC_K = 512, SC_V = 1024, SC_Z = 1536, SC_XBC = 2560, SC_DT = 4096, SC_MQK = 4112, SC_MV = 5136, SC_MO = 5648, SC_MI = 6160, SC_MF = 6164;
constexpr int FFN = 2816, ULD = 5632;
constexpr int DMIX = 2048;
constexpr float EPS = 1e-6f;
constexpr float C2 = 0.125f * 1.4426950408889634f;

constexpr size_t MiB = 1u << 20;
constexpr size_t WS_CTL = 0, CTL_ZERO_BYTES = 1 * MiB;
constexpr size_t WS_KSUM = 256 * 1024;
constexpr size_t WS_TS = 800 * 1024;
constexpr size_t WS_RS = 512 * 1024;
constexpr size_t WS_QUEUE = 768 * 1024;
constexpr size_t WS_SMALLP = 1 * MiB;
constexpr size_t WS_SSQ = 3 * MiB - 512 * 1024;
constexpr size_t WS_WSM = 3 * MiB + 512 * 1024;
constexpr size_t WS_BUFA = 4 * MiB;
constexpr size_t WS_BUFB = 16 * MiB;
constexpr size_t WS_XB = 22 * MiB;
constexpr size_t WS_HALO = 54 * MiB;
constexpr size_t WS_GSC = 58 * MiB;
constexpr size_t WS_SIDEA = 54 * MiB;
constexpr size_t WS_SIDEB = 57 * MiB;
static_assert(true, "EpiProj hard-codes WS_PROJ = 64 MiB, WS_HALO = 54 MiB, WS_KSUM = 256 KiB, WS_RS = 512 KiB");
constexpr size_t WS_PROJ = 64 * MiB;
constexpr size_t WS_END = 256 * MiB;

namespace pg8 {
#define PG8_LAS __attribute__((address_space(3)))
typedef unsigned short bf16_t;
typedef short bf16x8 __attribute__((ext_vector_type(8)));
typedef float f32x4 __attribute__((ext_vector_type(4)));
typedef unsigned u32x4 __attribute__((ext_vector_type(4)));
constexpr int BM = 256, BK = 64, HALF = 128, HTB = HALF * BK * 2, STAGE_BYTES = 8 * HTB, NXCD = 8, WGM = 8;

__host__ __device__ __forceinline__ int lds_byte(int r, int c) { const int st = (r >> 4) * 2 + (c >> 5), rr = r & 15, cc = c & 31, ob = rr * 64 + cc * 2; return st * 1024 + (ob ^ (((ob >> 9) & 1) << 5)); }
__host__ __device__ __forceinline__ void stage_rc(int b, int& R, int& C) { const int st = b / 1024, sb = b % 1024, swz = sb ^ (((sb >> 9) & 1) << 5); R = (st >> 1) * 16 + swz / 64; C = (st & 1) * 32 + (swz % 64) / 2; }
__host__ __device__ __forceinline__ int perm32(int rho) { const int n = rho >> 4, i = rho & 15; return 8 * (i >> 2) + 4 * n + (i & 3); }

struct Unit { int pm, pn; };
struct Gemm { const bf16_t* A; const bf16_t* Bt; int M, N, K, lda; };

struct StaticOrder {
    int nM, nN, nwg, G, c;
    __host__ __device__ void init(int M_, int N_, int G_, int c_) { nM = M_ / BM; nN = N_ / BM; nwg = nM * nN; G = G_; c = c_; }
    __host__ __device__ bool next(int i, Unit& u) const {
        const long L = (long)i * G + c; if (L >= nwg) return false;
        int wgid = (int)L; { const int q = nwg / NXCD, r = nwg % NXCD, xcd = wgid % NXCD, off = wgid / NXCD; wgid = (xcd < r ? xcd * (q + 1) : r * (q + 1) + (xcd - r) * q) + off; }
        const int nig = WGM * nN, gid = wgid / nig, fm = gid * WGM, gsz = (nM - fm) < WGM ? (nM - fm) : WGM;
        u.pm = fm + ((wgid % nig) % gsz); u.pn = (wgid % nig) / gsz; return true;
    }
};

typedef float f32x2p __attribute__((ext_vector_type(2))); typedef __bf16 bf16x2p __attribute__((ext_vector_type(2)));
__device__ __forceinline__ unsigned cvt_pk_bf16(float lo, float hi) { const f32x2p v = {lo, hi}; return __builtin_bit_cast(unsigned, __builtin_convertvector(v, bf16x2p)); }

struct EpiBf16 {
    static constexpr bool PERM = true;
    bf16_t* O; int ldc;
    __device__ __forceinline__ void operator()(const f32x4 (&acc)[2][2][4][2], const Unit& u, int wr, int wc, int fr, int fq) const {
        const int row0 = u.pm * BM + wr * 64 + fr; const int col0 = u.pn * BM + wc * 32 + 8 * fq;
#pragma unroll
        for (int ai = 0; ai < 2; ++ai)
#pragma unroll
            for (int m = 0; m < 4; ++m) { bf16_t* rowp = O + (size_t)(row0 + ai * HALF + m * 16) * ldc + col0;
#pragma unroll
                for (int bj = 0; bj < 2; ++bj) { const f32x4 v0 = acc[ai][bj][m][0], v1 = acc[ai][bj][m][1];
                    u32x4 w; w.x = cvt_pk_bf16(v0[0], v0[1]); w.y = cvt_pk_bf16(v0[2], v0[3]); w.z = cvt_pk_bf16(v1[0], v1[1]); w.w = cvt_pk_bf16(v1[2], v1[3]);
                    *(u32x4*)(rowp + bj * HALF) = w; } }
    }
};
__device__ __forceinline__ float row_prev(float prevblk, float cur, int n  ) {
    const int pb = __float_as_int(prevblk), cu = __float_as_int(cur);
    const int o = (n == 1) ? __builtin_amdgcn_update_dpp(0, pb, 0x121, 0xf, 0xf, false) : (n == 2) ? __builtin_amdgcn_update_dpp(0, pb, 0x122, 0xf, 0xf, false) : __builtin_amdgcn_update_dpp(0, pb, 0x123, 0xf, 0xf, false);
    return __int_as_float((n == 1) ? __builtin_amdgcn_update_dpp(o, cu, 0x111, 0xf, 0xf, false) : (n == 2) ? __builtin_amdgcn_update_dpp(o, cu, 0x112, 0xf, 0xf, false) : __builtin_amdgcn_update_dpp(o, cu, 0x113, 0xf, 0xf, false));
}
struct EpiProj {
    static constexpr bool PERM = true;
    unsigned char* ws; const float* const __attribute__((address_space(4)))* in; int l;
    __device__ __forceinline__ void operator()(const f32x4 (&acc)[2][2][4][2], const Unit& u, int wr, int wc, int fr, int fq) const {
        bf16_t* P = (bf16_t*)(ws + (size_t)64 * 1048576); bf16_t* halo = (bf16_t*)(ws + (size_t)54 * 1048576);
        const float* rs = (const float*)(ws + 524288) + (size_t)(2 * l) * 16384;
        const float* qw = in[3] + l * 64; const float* kw = in[4] + l * 64;
        const float* scw = in[5] + (size_t)l * 4 * 1536; const float* scb = in[6] + l * 1536; const float* mcw = in[11] + (size_t)l * 4 * 1024; const float* mcb = in[12] + l * 1024;
        const int pn = u.pn; const bool isq = pn < 2, isk = (pn == 8 || pn == 9);
        const int row0 = u.pm * BM + wr * 64 + fr;
        float rr[2][4];
#pragma unroll
        for (int ai = 0; ai < 2; ++ai)
#pragma unroll
            for (int m = 0; m < 4; ++m) rr[ai][m] = rs[row0 + ai * HALF + m * 16];
#pragma unroll
        for (int ai = 0; ai < 2; ++ai)
#pragma unroll
            for (int m = 0; m < 4; ++m) rr[ai][m] = 1.0f / sqrtf(rr[ai][m] * (1.0f / 1024.0f) + EPS);
        if (pn >= 12 && pn < 22) {
            const int col0 = pn * BM + wc * 32 + 8 * fq;
            const bool ssm = pn < 18; const float post = (pn >= 20) ? 0.08838834764831845f : 1.0f; const int wst = ssm ? 1536 : 1024;
#pragma unroll
            for (int bj = 0; bj < 2; ++bj) {
                const int hch = col0 + bj * HALF - PC_XBC; const float* wp = ssm ? (scw + hch) : (mcw + (hch - 1536)); const float* bp = ssm ? (scb + hch) : (mcb + (hch - 1536));
                f32x4 cwv[4][2], cbv[2];
#pragma unroll
                for (int j = 0; j < 4; ++j) { cwv[j][0] = *(const f32x4*)(wp + j * wst); cwv[j][1] = *(const f32x4*)(wp + j * wst + 4); }
                cbv[0] = *(const f32x4*)bp; cbv[1] = *(const f32x4*)(bp + 4);
#pragma unroll
                for (int ai = 0; ai < 2; ++ai) {
                    f32x4 gp[2] = {(f32x4){0.f, 0.f, 0.f, 0.f}, (f32x4){0.f, 0.f, 0.f, 0.f}};
#pragma unroll
                    for (int m = 0; m < 4; ++m) { const int row = row0 + ai * HALF + m * 16;
                        f32x4 g[2]; g[0] = acc[ai][bj][m][0] * rr[ai][m]; g[1] = acc[ai][bj][m][1] * rr[ai][m];
                        u32x4 raw, cv;
#pragma unroll
                        for (int n = 0; n < 2; ++n)
#pragma unroll
                            for (int i2 = 0; i2 < 2; ++i2) { float y[2];
#pragma unroll
                                for (int e = 0; e < 2; ++e) { const int i = 2 * i2 + e; const float x1 = row_prev(gp[n][i], g[n][i], 1), x2 = row_prev(gp[n][i], g[n][i], 2), x3 = row_prev(gp[n][i], g[n][i], 3);
                                    const float a = cbv[n][i] + cwv[0][n][i] * x3 + cwv[1][n][i] * x2 + cwv[2][n][i] * x1 + cwv[3][n][i] * g[n][i];
                                    y[e] = a * __builtin_amdgcn_rcpf(1.0f + __builtin_amdgcn_exp2f(-1.4426950408889634f * a)) * post; }
                                cv[2 * n + i2] = cvt_pk_bf16(y[0], y[1]); raw[2 * n + i2] = cvt_pk_bf16(g[n][2 * i2], g[n][2 * i2 + 1]); }
                        *(u32x4*)(P + (size_t)row * PLD + col0 + bj * HALF) = (m == 0 && fr < 3) ? raw : cv;
                        if (m == 3 && fr >= 13) *(u32x4*)(halo + ((size_t)((row >> 6) * 3 + fr - 13) * 2560 + hch)) = raw;
                        gp[0] = g[0]; gp[1] = g[1]; }
                }
            }
        } else if (!(isq || isk)) {
            const int col0 = pn * BM + wc * 32 + 8 * fq;
#pragma unroll
            for (int ai = 0; ai < 2; ++ai)
#pragma unroll
                for (int m = 0; m < 4; ++m) { bf16_t* rowp = P + (size_t)(row0 + ai * HALF + m * 16) * PLD + col0;
#pragma unroll
                    for (int bj = 0; bj < 2; ++bj) { const f32x4 v0 = acc[ai][bj][m][0] * rr[ai][m], v1 = acc[ai][bj][m][1] * rr[ai][m];
                        u32x4 w; w.x = cvt_pk_bf16(v0[0], v0[1]); w.y = cvt_pk_bf16(v0[2], v0[3]); w.z = cvt_pk_bf16(v1[0], v1[1]); w.w = cvt_pk_bf16(v1[2], v1[3]);
                        *(u32x4*)(rowp + bj * HALF) = w;
                    } }
        } else {
            const float* w = isq ? qw : kw; const float post = isq ? C2 : 1.0f;
            const int colb = pn * BM + 64 * wc + 8 * fq;
#pragma unroll
            for (int ai = 0; ai < 2; ++ai)
#pragma unroll
                for (int m = 0; m < 4; ++m) {
                    float ss = 0.f;
#pragma unroll
                    for (int bj = 0; bj < 2; ++bj)
#pragma unroll
                        for (int n = 0; n < 2; ++n) { const f32x4 x = acc[ai][bj][m][n] * rr[ai][m]; ss += (x[0] * x[0] + x[1] * x[1]) + (x[2] * x[2] + x[3] * x[3]); }
                    ss += __shfl_xor(ss, 16); ss += __shfl_xor(ss, 32);
                    const float r = (1.0f / sqrtf(ss * (1.0f / 64.0f) + EPS)) * post * rr[ai][m];
                    bf16_t* rowp = P + (size_t)(row0 + ai * HALF + m * 16) * PLD + colb;
#pragma unroll
                    for (int bj = 0; bj < 2; ++bj) { const f32x4 w0 = *(const f32x4*)(w + 32 * bj + 8 * fq), w1 = *(const f32x4*)(w + 32 * bj + 8 * fq + 4);
                        const f32x4 v0 = acc[ai][bj][m][0] * r * w0, v1 = acc[ai][bj][m][1] * r * w1;
                        u32x4 o; o.x = cvt_pk_bf16(v0[0], v0[1]); o.y = cvt_pk_bf16(v0[2], v0[3]); o.z = cvt_pk_bf16(v1[0], v1[1]); o.w = cvt_pk_bf16(v1[2], v1[3]);
                        *(u32x4*)(rowp + 32 * bj) = o; }
                    asm volatile("" ::: "memory");
                }
        }
    }
};
struct EpiRes {
    static constexpr bool PERM = true;
    bf16_t* xb; float* out; float* rs;
    __device__ __forceinline__ void operator()(const f32x4 (&acc)[2][2][4][2], const Unit& u, int wr, int wc, int fr, int fq) const {
        const int row0 = u.pm * BM + wr * 64 + fr, col0 = u.pn * BM + wc * 32 + 8 * fq;
#pragma unroll
        for (int ai = 0; ai < 2; ++ai)
#pragma unroll
            for (int m = 0; m < 4; ++m) { const int row = row0 + ai * HALF + m * 16; const size_t off = (size_t)row * 1024 + col0; float ss = 0.f;
#pragma unroll
                for (int bj = 0; bj < 2; ++bj) { const u32x4 bw = *(const u32x4*)(xb + off + bj * HALF);
                    f32x4 v0 = acc[ai][bj][m][0], v1 = acc[ai][bj][m][1];
                    v0[0] += __uint_as_float(bw.x << 16); v0[1] += __uint_as_float(bw.x & 0xffff0000u); v0[2] += __uint_as_float(bw.y << 16); v0[3] += __uint_as_float(bw.y & 0xffff0000u);
                    v1[0] += __uint_as_float(bw.z << 16); v1[1] += __uint_as_float(bw.z & 0xffff0000u); v1[2] += __uint_as_float(bw.w << 16); v1[3] += __uint_as_float(bw.w & 0xffff0000u);
                    if (out) { *(f32x4*)(out + off + bj * HALF) = v0; *(f32x4*)(out + off + bj * HALF + 4) = v1; }
                    else { ss += ((v0[0] * v0[0] + v0[1] * v0[1]) + (v0[2] * v0[2] + v0[3] * v0[3])) + ((v1[0] * v1[0] + v1[1] * v1[1]) + (v1[2] * v1[2] + v1[3] * v1[3]));
                        u32x4 w; w.x = cvt_pk_bf16(v0[0], v0[1]); w.y = cvt_pk_bf16(v0[2], v0[3]); w.z = cvt_pk_bf16(v1[0], v1[1]); w.w = cvt_pk_bf16(v1[2], v1[3]);
                        *(u32x4*)(xb + off + bj * HALF) = w; } }
                if (!out) { ss += __shfl_xor(ss, 16); ss += __shfl_xor(ss, 32); if (fq == 0) atomicAdd(rs + row, ss); }
                asm volatile("" ::: "memory"); }
    }
};
struct EpiScaleBf16 {
    static constexpr bool PERM = true;
    bf16_t* O; int ldc; const float* rs;
    __device__ __forceinline__ void operator()(const f32x4 (&acc)[2][2][4][2], const Unit& u, int wr, int wc, int fr, int fq) const {
        const int row0 = u.pm * BM + wr * 64 + fr; const int col0 = u.pn * BM + wc * 32 + 8 * fq;
        float rr[2][4];
#pragma unroll
        for (int ai = 0; ai < 2; ++ai)
#pragma unroll
            for (int m = 0; m < 4; ++m) rr[ai][m] = rs[row0 + ai * HALF + m * 16];
#pragma unroll
        for (int ai = 0; ai < 2; ++ai)
#pragma unroll
            for (int m = 0; m < 4; ++m) { bf16_t* rowp = O + (size_t)(row0 + ai * HALF + m * 16) * ldc + col0; const float r = 1.0f / sqrtf(rr[ai][m] * (1.0f / 1024.0f) + EPS);
#pragma unroll
                for (int bj = 0; bj < 2; ++bj) { const f32x4 v0 = acc[ai][bj][m][0] * r, v1 = acc[ai][bj][m][1] * r;
                    u32x4 w; w.x = cvt_pk_bf16(v0[0], v0[1]); w.y = cvt_pk_bf16(v0[2], v0[3]); w.z = cvt_pk_bf16(v1[0], v1[1]); w.w = cvt_pk_bf16(v1[2], v1[3]);
                    *(u32x4*)(rowp + bj * HALF) = w; } }
    }
};

typedef float f32x2q __attribute__((ext_vector_type(2)));
__device__ __forceinline__ f32x2q gelu_pk2(f32x2q v) {
    const f32x2q av = __builtin_elementwise_abs(v), d = av * 0.2316418882f + 1.0f;
    f32x2q t; t.x = __builtin_amdgcn_rcpf(d.x); t.y = __builtin_amdgcn_rcpf(d.y);
    f32x2q q = t * 0.5307027145f + (-0.7265760135f); q = q * t + 0.7107068705f; q = q * t + (-0.142248368f); q = q * t + 0.127414796f; q = q * t;
    const f32x2q s = (v * v) * (-0.72134752044f);
    f32x2q e; e.x = __builtin_amdgcn_exp2f(s.x); e.y = __builtin_amdgcn_exp2f(s.y);
    const f32x2q m = v * (q * e), r = v - m;
    f32x2q o; o.x = v.x < 0.f ? m.x : r.x; o.y = v.y < 0.f ? m.y : r.y; return o;
}
struct EpiFfn {
    static constexpr bool PERM = true;
    bf16_t* H; const float* rs; const float* cw  ; const float* cb; bf16_t* sideA  ; bf16_t* sideB  ;
    __device__ __forceinline__ void operator()(const f32x4 (&acc)[2][2][4][2], const Unit& u, int wr, int wc, int fr, int fq) const {
        constexpr int FF = 2816;
        const int row0 = u.pm * BM + wr * 64 + fr, c0 = u.pn * 128 + wc * 32 + 8 * fq;
        float rr[2][4];
#pragma unroll
        for (int ai = 0; ai < 2; ++ai)
#pragma unroll
            for (int m = 0; m < 4; ++m) rr[ai][m] = rs[row0 + ai * HALF + m * 16];
        f32x4 w0[2], w1[2], w2[2], bb[2];
#pragma unroll
        for (int n = 0; n < 2; ++n) { w0[n] = *(const f32x4*)(cw + c0 + 4 * n); w1[n] = *(const f32x4*)(cw + FF + c0 + 4 * n); w2[n] = *(const f32x4*)(cw + 2 * FF + c0 + 4 * n); bb[n] = *(const f32x4*)(cb + c0 + 4 * n); }
#pragma unroll
        for (int ai = 0; ai < 2; ++ai) {
            f32x4 gp[2] = {(f32x4){0.f, 0.f, 0.f, 0.f}, (f32x4){0.f, 0.f, 0.f, 0.f}};
#pragma unroll
            for (int m = 0; m < 4; ++m) {
                const int row = row0 + ai * HALF + m * 16; const float r = 1.0f / sqrtf(rr[ai][m] * (1.0f / 1024.0f) + EPS);
                f32x4 g[2], v[2]; u32x4 hw, gw, vw;
#pragma unroll
                for (int n = 0; n < 2; ++n) { g[n] = acc[ai][0][m][n] * r; v[n] = acc[ai][1][m][n] * r; }
#pragma unroll
                for (int n = 0; n < 2; ++n)
#pragma unroll
                    for (int i2 = 0; i2 < 2; ++i2) { f32x2q x;
#pragma unroll
                        for (int e = 0; e < 2; ++e) { const int i = 2 * i2 + e; const float x1 = row_prev(gp[n][i], g[n][i], 1), x2 = row_prev(gp[n][i], g[n][i], 2);
                            x[e] = bb[n][i] + w0[n][i] * x2 + w1[n][i] * x1 + w2[n][i] * g[n][i]; }
                        const f32x2q ge = gelu_pk2(x);
                        hw[2 * n + i2] = cvt_pk_bf16(ge.x * v[n][2 * i2], ge.y * v[n][2 * i2 + 1]);
                        gw[2 * n + i2] = cvt_pk_bf16(g[n][2 * i2], g[n][2 * i2 + 1]); vw[2 * n + i2] = cvt_pk_bf16(v[n][2 * i2], v[n][2 * i2 + 1]); }
                *(u32x4*)(H + (size_t)row * FF + c0) = hw;
                if (m == 3 && fr >= 14) *(u32x4*)(sideA + ((size_t)(row >> 6) * 2 + (fr - 14)) * FF + c0) = gw;
                if (m == 0 && fr < 2) { bf16_t* sb = sideB + ((size_t)(row >> 6) * 2 + fr) * 2 * FF + c0; *(u32x4*)sb = gw; *(u32x4*)(sb + FF) = vw; }
                gp[0] = g[0]; gp[1] = g[1];
            }
        }
    }
};

#define PG8_KT(i) (KMODE ? ((i) < 16 ? (i) + 8 : ((i) < 24 ? (i) - 16 : (i))) : (i))
template <class Epi, int KMODE = 0>
__device__ __forceinline__ void gemm_phase(PG8_LAS unsigned char* lds, const Gemm g, const StaticOrder& S, const Epi& E, int tid_, const PG8_LAS float* ftab = nullptr) {
    asm volatile("" : "+v"(tid_));
    const int tid = tid_, wid = __builtin_amdgcn_readfirstlane(tid >> 6), lane = tid & 63, wr = wid >> 2, wc = wid & 3, fr = lane & 15, fq = lane >> 4;
    const int K = g.K, nt = K / BK, lda = g.lda;
    unsigned voffA[2], voffB[2];
#pragma unroll
    for (int i = 0; i < 2; ++i) { int R, C; stage_rc(tid * 16 + i * 8192, R, C); const int Rb = Epi::PERM ? ((R & ~31) + perm32(R & 31)) : R;
        voffA[i] = (unsigned)(R * lda + C) * 2u; voffB[i] = (unsigned)(Rb * K + C) * 2u; }
    const size_t kstep = (size_t)(BK * 2);
    const size_t hstepA = (size_t)HALF * lda * 2, hstepB = (size_t)HALF * K * 2;
    const size_t tstepA = 2 * hstepA, tstepB = 2 * hstepB;
    const unsigned ldsw = (unsigned)wid * 1024u;
    const int aoff = lds_byte(wr * 64 + fr, fq * 8), boff = lds_byte(wc * 32 + fr, fq * 8);
#define PG8_SA(b, h) (((b) * 2 + (h)) * HTB)
#define PG8_SB(b, h) ((4 + (b) * 2 + (h)) * HTB)
#define PG8_STAGE(bufoff, gbase, voff) do { _Pragma("unroll") for (int _i = 0; _i < 2; ++_i) \
        __builtin_amdgcn_global_load_lds((const unsigned*)((const char*)(gbase) + (voff)[_i]), (PG8_LAS unsigned*)(lds + (bufoff) + ldsw + _i * 8192), 16, 0, 0); } while (0)
#define PG8_LDA(dst, b, h) do { _Pragma("unroll") for (int m = 0; m < 4; ++m) _Pragma("unroll") for (int k = 0; k < 2; ++k) dst[m][k] = *(const PG8_LAS bf16x8*)(lds + PG8_SA(b, h) + aoff + m * 2048 + k * 1024); } while (0)
#define PG8_LDB(dst, b, h) do { _Pragma("unroll") for (int n = 0; n < 2; ++n) _Pragma("unroll") for (int k = 0; k < 2; ++k) dst[n][k] = *(const PG8_LAS bf16x8*)(lds + PG8_SB(b, h) + boff + n * 2048 + k * 1024); } while (0)
#define PG8_MMA(ai, bj, At, Bt) do { __builtin_amdgcn_s_setprio(1); _Pragma("unroll") for (int m = 0; m < 4; ++m) _Pragma("unroll") for (int n = 0; n < 2; ++n) _Pragma("unroll") for (int k = 0; k < 2; ++k) \
        acc[ai][bj][m][n] = __builtin_amdgcn_mfma_f32_16x16x32_bf16(Bt[n][k], At[m][k], acc[ai][bj][m][n], 0, 0, 0); __builtin_amdgcn_s_setprio(0); } while (0)
#define PG8_WAIT_V(n) asm volatile("s_waitcnt vmcnt(" #n ")" ::: "memory")
#define PG8_WAIT_L(n) asm volatile("s_waitcnt lgkmcnt(" #n ")" ::: "memory")
#define PG8_BAR __builtin_amdgcn_s_barrier()
#define PG8_SCHED __builtin_amdgcn_sched_barrier(0)
    Unit cur, nxt; int ui = 0;
    if (!S.next(0, cur)) return;
    f32x4 acc[2][2][4][2];
#pragma unroll
    for (int a = 0; a < 2; ++a)
#pragma unroll
        for (int b = 0; b < 2; ++b)
#pragma unroll
            for (int m = 0; m < 4; ++m)
#pragma unroll
                for (int n = 0; n < 2; ++n) acc[a][b][m][n] = (f32x4){0.f, 0.f, 0.f, 0.f};
    bf16x8 At[4][2], B0[2][2], B1[2][2];
    const char* cA = (const char*)g.A + (size_t)cur.pm * tstepA; const char* cB = (const char*)g.Bt + (size_t)cur.pn * tstepB;
    { const char* cA0 = cA + (size_t)PG8_KT(0) * kstep; const char* cB0 = cB + (size_t)PG8_KT(0) * kstep;
    PG8_STAGE(PG8_SB(0, 0), cB0, voffB); PG8_STAGE(PG8_SB(0, 1), cB0 + hstepB, voffB); PG8_STAGE(PG8_SA(0, 0), cA0, voffA); PG8_STAGE(PG8_SA(0, 1), cA0 + hstepA, voffA);
    if (wr == 1) PG8_BAR;
    PG8_WAIT_V(2); PG8_BAR;
    PG8_STAGE(PG8_SB(1, 0), cB0 + kstep, voffB); PG8_STAGE(PG8_SA(1, 0), cA0 + kstep, voffA); PG8_STAGE(PG8_SB(1, 1), cB0 + hstepB + kstep, voffB);
    PG8_WAIT_V(6); PG8_BAR; }
    for (;;) {
        const bool has_next = S.next(ui + 1, nxt);
        const char* nA = has_next ? (const char*)g.A + (size_t)nxt.pm * tstepA : cA; const char* nB = has_next ? (const char*)g.Bt + (size_t)nxt.pn * tstepB : cB;
        for (int t = 0; t < nt; t += 2) {
            const bool last = (t == nt - 2);
            const char* a1 = cA + (size_t)PG8_KT(t + 1) * kstep;
            const char* a2 = last ? nA + (size_t)PG8_KT(0) * kstep : cA + (size_t)PG8_KT(t + 2) * kstep; const char* b2 = last ? nB + (size_t)PG8_KT(0) * kstep : cB + (size_t)PG8_KT(t + 2) * kstep;
            const char* a3 = a2 + kstep; const char* b3 = b2 + kstep;
            PG8_LDB(B0, 0, 0); PG8_LDB(B1, 0, 1); PG8_SCHED; PG8_LDA(At, 0, 0); PG8_STAGE(PG8_SA(1, 1), a1 + hstepA, voffA);
            PG8_WAIT_V(8); PG8_WAIT_L(0); PG8_BAR; PG8_MMA(0, 0, At, B0); PG8_MMA(0, 1, At, B1); PG8_BAR; PG8_SCHED;
            PG8_LDA(At, 0, 1); PG8_STAGE(PG8_SB(0, 0), b2, voffB); PG8_STAGE(PG8_SB(0, 1), b2 + hstepB, voffB); PG8_STAGE(PG8_SA(0, 0), a2, voffA);
            PG8_WAIT_V(8); PG8_WAIT_L(0); PG8_BAR; PG8_MMA(1, 0, At, B0); PG8_MMA(1, 1, At, B1); PG8_BAR; PG8_SCHED;
            PG8_LDB(B0, 1, 0); PG8_LDB(B1, 1, 1); PG8_SCHED; PG8_LDA(At, 1, 0); PG8_STAGE(PG8_SA(0, 1), a2 + hstepA, voffA);
            PG8_WAIT_V(8); PG8_WAIT_L(0); PG8_BAR; PG8_MMA(0, 0, At, B0); PG8_MMA(0, 1, At, B1); PG8_BAR; PG8_SCHED;
            PG8_LDA(At, 1, 1); PG8_STAGE(PG8_SB(1, 0), b3, voffB); PG8_STAGE(PG8_SB(1, 1), b3 + hstepB, voffB); PG8_STAGE(PG8_SA(1, 0), a3, voffA);
            PG8_WAIT_V(8); PG8_WAIT_L(0); PG8_BAR; PG8_MMA(1, 0, At, B0); PG8_MMA(1, 1, At, B1); PG8_BAR; PG8_SCHED;
            if (KMODE == 1 && (t == 6 || t == 14)) {
                const int wh = (t == 14) ? 1 : 0;
#pragma unroll
                for (int ai = 0; ai < 2; ++ai)
#pragma unroll
                    for (int m = 0; m < 4; ++m) { const float f = ftab[(ai * HALF + wr * 64 + m * 16 + fr) * 2 + wh];
#pragma unroll
                        for (int bj = 0; bj < 2; ++bj)
#pragma unroll
                            for (int n = 0; n < 2; ++n) acc[ai][bj][m][n] *= f; }
                PG8_SCHED;
            }
        }
        if (wr == 0) PG8_BAR;
        E(acc, cur, wr, wc, fr, fq);
        if (!has_next) break;
#pragma unroll
        for (int a = 0; a < 2; ++a)
#pragma unroll
            for (int b = 0; b < 2; ++b)
#pragma unroll
                for (int m = 0; m < 4; ++m)
#pragma unroll
                    for (int n = 0; n < 2; ++n) acc[a][b][m][n] = (f32x4){0.f, 0.f, 0.f, 0.f};
        cur = nxt; cA = nA; cB = nB; ++ui;
        if (wr == 1) PG8_BAR;
    }
    PG8_WAIT_V(0);
    PG8_BAR;
#undef PG8_SA
#undef PG8_SB
#undef PG8_STAGE
#undef PG8_LDA
#undef PG8_LDB
#undef PG8_MMA
#undef PG8_WAIT_V
#undef PG8_WAIT_L
#undef PG8_BAR
#undef PG8_SCHED
}
}

constexpr int NWAVES = 8;
constexpr int RING_OFF = 0, RING_BYTES = 131072;
constexpr int LDS_BYTES = 147456;
constexpr int LDSCTL_OFF = LDS_BYTES - 512, MISC_OFF = LDSCTL_OFF + 320;
constexpr int CW_BAR = 4096;

#define GAS __attribute__((address_space(1)))
#define LAS __attribute__((address_space(3)))
typedef unsigned short bf16;
typedef unsigned v4u __attribute__((ext_vector_type(4)));
typedef float f32x4 __attribute__((ext_vector_type(4)));
typedef GAS unsigned gu32;
#define RLX_AGENT __ATOMIC_RELAXED, __HIP_MEMORY_SCOPE_AGENT
#define LDS_WAIT() asm volatile("s_waitcnt lgkmcnt(0)" ::: "memory")
#define VM_WAIT() asm volatile("s_waitcnt vmcnt(0)" ::: "memory")
__device__ __forceinline__ unsigned f2bf(float f) { unsigned u = __builtin_bit_cast(unsigned, f); return (u + 0x7fffu + ((u >> 16) & 1u)) >> 16; }
typedef float f32x2_ __attribute__((ext_vector_type(2))); typedef __bf16 bf16x2_ __attribute__((ext_vector_type(2)));
__device__ __forceinline__ unsigned pk2(float lo, float hi) { const f32x2_ v = {lo, hi}; return __builtin_bit_cast(unsigned, __builtin_convertvector(v, bf16x2_)); }
__device__ __forceinline__ float bf2f(unsigned short b) { return __uint_as_float(((unsigned)b) << 16); }

#define XB_TMO      128
#define XB_XCNT(j)  (256  + 64 * (j))
#define XB_XSUB(j)  (1280 + 64 * (j))
#define XB_XGEN(j)  (2304 + 64 * (j))
#define XB_TOP      3328
#define XB_TOPGEN   3392
#define XCD_BAR_WORDS 3456
#define XB_SPIN_CAP (1u << 18)
__device__ __forceinline__ unsigned xb_ld(unsigned* p)              { return __hip_atomic_load(p, __ATOMIC_RELAXED, __HIP_MEMORY_SCOPE_AGENT); }
__device__ __forceinline__ unsigned xb_add(unsigned* p, unsigned v) { return __hip_atomic_fetch_add(p, v, __ATOMIC_RELAXED, __HIP_MEMORY_SCOPE_AGENT); }
__device__ __forceinline__ unsigned xb_xcc_id() { return (unsigned)__builtin_amdgcn_s_getreg((3 << 11) | 20) & 0xFu; }
#define XB_SPIN(cond, bar) do { unsigned _sp = 0; while (cond) { __builtin_amdgcn_s_sleep(1); \
    if ((++_sp & 255u) == 0u) { if (xb_ld(&(bar)[XB_TMO])) break; if (_sp > XB_SPIN_CAP) { atomicAdd(&(bar)[XB_TMO], 1u); break; } } } } while (0)
struct XcdBarrier { unsigned* bar; unsigned x; volatile LAS unsigned* st; };
__device__ __forceinline__ XcdBarrier xcd_barrier_post(unsigned* bar, volatile LAS unsigned* st) {
    XcdBarrier b; b.bar = bar; b.x = xb_xcc_id(); b.st = st;
    if (threadIdx.x == 0) (void)xb_add(&bar[XB_XCNT(b.x)], 1u);
    return b;
}
__device__ __forceinline__ void xcd_barrier_complete(unsigned* bar, unsigned x, unsigned& nloc, unsigned& nx) {
    const unsigned G = gridDim.x * gridDim.y * gridDim.z;
    unsigned sum, cnt, mine, sp = 0u;
    for (;;) {
        sum = 0u; cnt = 0u; mine = 0u;
#pragma unroll
        for (unsigned j = 0; j < 16; ++j) { const unsigned c = xb_ld(&bar[XB_XCNT(j)]); sum += c; cnt += (c > 0u) ? 1u : 0u; mine = (j == x) ? c : mine; }
        if (sum == G) break;
        __builtin_amdgcn_s_sleep(1);
        if ((++sp & 255u) == 0u) { if (xb_ld(&bar[XB_TMO])) break; if (sp > XB_SPIN_CAP) { atomicAdd(&bar[XB_TMO], 1u); break; } }
    }
    nloc = mine > 0u ? mine : 1u; nx = cnt > 0u ? cnt : 1u;
}
__device__ __forceinline__ void xcd_barrier(const XcdBarrier& b, int tid) {
    asm volatile("s_waitcnt vmcnt(0)" ::: "memory");
    __syncthreads();
    if (tid == 0) {
        unsigned* bar = b.bar;
        __builtin_amdgcn_s_waitcnt(0);
        unsigned nloc = b.st[0], nx = b.st[1];
        if (nloc == 0u) { xcd_barrier_complete(bar, b.x, nloc, nx); b.st[0] = nloc; b.st[1] = nx; }
        const unsigned old = xb_add(&bar[XB_XSUB(b.x)], 1u);
        const unsigned gen = old / nloc;
        if (old + 1u == (gen + 1u) * nloc) {
            __builtin_amdgcn_fence(__ATOMIC_RELEASE, "agent");
            asm volatile("s_waitcnt vmcnt(0)" ::: "memory");
            const unsigned og = xb_add(&bar[XB_TOP], 1u);
            const unsigned tg = og / nx;
            if (og + 1u == (tg + 1u) * nx) xb_add(&bar[XB_TOPGEN], 1u);
            else XB_SPIN(xb_ld(&bar[XB_TOPGEN]) == tg, bar);
            __builtin_amdgcn_fence(__ATOMIC_ACQUIRE, "agent");
            xb_add(&bar[XB_XGEN(b.x)], 1u);
            asm volatile("s_waitcnt vmcnt(0)" ::: "memory");
        } else {
            XB_SPIN(xb_ld(&bar[XB_XGEN(b.x)]) == gen, bar);
            __builtin_amdgcn_fence(__ATOMIC_ACQUIRE, "agent");
            asm volatile("s_waitcnt vmcnt(0)" ::: "memory");
        }
    }
    __syncthreads();
}

__device__ __forceinline__ int fresh_lane() { int l; asm volatile("v_mbcnt_lo_u32_b32 %0, -1, 0\n\tv_mbcnt_hi_u32_b32 %0, -1, %0" : "=v"(l)); return l; }
struct Args { const float* in[22]; float* out; unsigned char* ws; int ph_lo, ph_hi; };

struct Frame {
    LAS unsigned char* lds;
    int tid, lane, wave;
    int vcu, G;
};

__device__ __forceinline__ float wave_sum(float v) {
#pragma unroll
    for (int o = 1; o < 64; o <<= 1) v += __shfl_xor(v, o);
    return v;
}

__device__ __forceinline__ void conv_item(const float* W, int ldw, int srccol0, bf16* WT, int K, int dstrow0, int k0, LAS float* scr, int lane, const float* kscale  , int kslo = 0, int kshi = 1 << 30) {
    {
        const int lr = lane >> 3, lc = (lane & 7) * 4; f32x4 v[8];
#pragma unroll
        for (int i = 0; i < 8; ++i) { const float* p = W + (size_t)(k0 + 8 * i + lr) * ldw + srccol0 + lc;
            if ((((size_t)p) & 15) == 0) v[i] = *(const f32x4*)p; else { v[i][0] = p[0]; v[i][1] = p[1]; v[i][2] = p[2]; v[i][3] = p[3]; } }
#pragma unroll
        for (int i = 0; i < 8; ++i) { LAS float* d = scr + (8 * i + lr) * 33 + lc; d[0] = v[i][0]; d[1] = v[i][1]; d[2] = v[i][2]; d[3] = v[i][3]; }
    }
    const int c = lane & 7;
    f32x4 ks0 = (f32x4){1.f, 1.f, 1.f, 1.f}, ks1 = ks0;
    if (kscale && k0 >= kslo && k0 < kshi) { ks0 = *(const f32x4*)(kscale + k0 - kslo + 8 * c); ks1 = *(const f32x4*)(kscale + k0 - kslo + 8 * c + 4); }
    LDS_WAIT(); asm volatile("" ::: "memory");
#pragma unroll
    for (int j = 0; j < 4; ++j) { const int n = (lane >> 3) + 8 * j; const LAS float* s = scr + (8 * c) * 33 + n;
        v4u o; o.x = pk2(s[0 * 33] * ks0[0], s[1 * 33] * ks0[1]); o.y = pk2(s[2 * 33] * ks0[2], s[3 * 33] * ks0[3]); o.z = pk2(s[4 * 33] * ks1[0], s[5 * 33] * ks1[1]); o.w = pk2(s[6 * 33] * ks1[2], s[7 * 33] * ks1[3]);
        *(GAS v4u*)(WT + (size_t)(dstrow0 + n) * K + k0 + 8 * c) = o; }
    LDS_WAIT(); asm volatile("" ::: "memory");
}
__device__ __forceinline__ int in_src_col(int n0) {
    const int tile = n0 >> 8, p = n0 & 255; int dest;
    if (tile < 2 || tile == 8 || tile == 9) { const int bj = p >> 7, wc = (p >> 5) & 3; dest = (tile << 8) + 64 * wc + 32 * bj; } else dest = n0;
    if (dest < PC_Z) return SC_Q + dest;
    if (dest < PC_MO) return SC_Z + dest - PC_Z;
    if (dest < PC_K) return SC_MO + dest - PC_MO;
    if (dest < PC_V) return SC_K + dest - PC_K;
    if (dest < PC_XBC) return SC_V + dest - PC_V;
    if (dest < PC_MQK) return SC_XBC + dest - PC_XBC;
    if (dest < PC_MV) return SC_MQK + dest - PC_MQK;
    return SC_MV + dest - PC_MV;
}
__device__ __forceinline__ void conv_w_in(Frame& F, const float* w_in, const float* nw, bf16* wt, LAS float* scr) {
    const int gw = F.vcu * NWAVES + F.wave, NGW = F.G * NWAVES;
    for (int it = gw; it < (DM / 64) * (PLD / 32); it += NGW) { const int nblk = PLD / 32, kb = it / nblk, nb = it % nblk; conv_item(w_in, P_IN, in_src_col(32 * nb), wt, DM, 32 * nb, 64 * kb, scr, F.lane, nw); }
}
__device__ __forceinline__ void conv_plain(Frame& F, const float* W, int K, int N, const float* kscale, bf16* wt, LAS float* scr, int kslo = 0, int kshi = 1 << 30) {
    const int gw = F.vcu * NWAVES + F.wave, NGW = F.G * NWAVES; const int nblk = N / 32;
    for (int it = gw; it < (K / 64) * nblk; it += NGW) { const int kb = it / nblk, nb = it % nblk; conv_item(W, N, 32 * nb, wt, K, 32 * nb, 64 * kb, scr, F.lane, kscale, kslo, kshi); }
}
__device__ __forceinline__ void conv_small(Frame& F, const float* w_in, const float* nw, bf16* wst) {
    const int gt = F.vcu * (NWAVES * 64) + F.tid, NT = F.G * NWAVES * 64;
    for (int i = gt; i < 32 * DM; i += NT) { const int c = i >> 10, k = i & (DM - 1);
        float v = 0.f; if (c < 24) v = w_in[(size_t)k * P_IN + (c < 16 ? SC_DT + c : SC_MI + (c - 16))] * nw[k];
        wst[i] = (bf16)(pk2(v, 0.f) & 0xffffu); }
}
__device__ __forceinline__ void row_pass0(Frame& F, const float* x, bf16* xb, float* rs) {
    const int gw = F.vcu * NWAVES + F.wave, NGW = F.G * NWAVES;
    for (int m = gw; m < M; m += 2 * NGW) {
        const int m2 = m + NGW; const bool two = m2 < M;
        const GAS f32x4* xr = (const GAS f32x4*)(x + (size_t)m * DM) + F.lane; const GAS f32x4* xr2 = (const GAS f32x4*)(x + (size_t)(two ? m2 : m) * DM) + F.lane;
        f32x4 v[4], u[4]; float s_ = 0.f, t_ = 0.f;
#pragma unroll
        for (int j = 0; j < 4; ++j) { v[j] = xr[64 * j]; u[j] = xr2[64 * j]; }
#pragma unroll
        for (int j = 0; j < 4; ++j) { s_ += (v[j].x * v[j].x + v[j].y * v[j].y) + (v[j].z * v[j].z + v[j].w * v[j].w); t_ += (u[j].x * u[j].x + u[j].y * u[j].y) + (u[j].z * u[j].z + u[j].w * u[j].w); }
        s_ = wave_sum(s_); t_ = wave_sum(t_);
        GAS unsigned long long* o8 = (GAS unsigned long long*)(xb + (size_t)m * DM) + F.lane;
#pragma unroll
        for (int j = 0; j < 4; ++j) o8[64 * j] = (unsigned long long)pk2(v[j].x, v[j].y) | ((unsigned long long)pk2(v[j].z, v[j].w) << 32);
        if (F.lane == 0) rs[m] = s_;
        if (two) { GAS unsigned long long* p8 = (GAS unsigned long long*)(xb + (size_t)m2 * DM) + F.lane;
#pragma unroll
            for (int j = 0; j < 4; ++j) p8[64 * j] = (unsigned long long)pk2(u[j].x, u[j].y) | ((unsigned long long)pk2(u[j].z, u[j].w) << 32);
            if (F.lane == 0) rs[m2] = t_; }
    }
}
typedef short bf16x8s __attribute__((ext_vector_type(8)));
__device__ __forceinline__ void small_proj(Frame& F, const bf16* xb, const bf16* wst, const float* rs, float* smallp) {
    constexpr int SP = 1040;
    LAS unsigned char* As = F.lds; LAS unsigned char* Bs = F.lds + 64 * SP;
    const int lane = F.lane, w = F.wave, mt = w & 3, nt = w >> 2, r16 = lane & 15, kq = lane >> 4;
    for (int rb = F.vcu * 64; rb < M; rb += F.G * 64) {
        f32x4 acc = (f32x4){0.f, 0.f, 0.f, 0.f};
#pragma unroll 1
        for (int kh = 0; kh < 2; ++kh) {
            v4u av[8], bv[4];
#pragma unroll
            for (int i = 0; i < 8; ++i) { const int it = F.tid + 512 * i, row = it >> 6, c = it & 63; av[i] = *(const v4u*)(xb + (size_t)(rb + row) * DM + kh * 512 + c * 8); }
#pragma unroll
            for (int i = 0; i < 4; ++i) { const int it = F.tid + 512 * i, row = it >> 6, c = it & 63; bv[i] = *(const v4u*)(wst + (size_t)row * DM + kh * 512 + c * 8); }
            __syncthreads();
#pragma unroll
            for (int i = 0; i < 8; ++i) { const int it = F.tid + 512 * i, row = it >> 6, c = it & 63; *(LAS v4u*)(As + row * SP + c * 16) = av[i]; }
#pragma unroll
            for (int i = 0; i < 4; ++i) { const int it = F.tid + 512 * i, row = it >> 6, c = it & 63; *(LAS v4u*)(Bs + row * SP + c * 16) = bv[i]; }
            __syncthreads();
            bf16x8s a[16], b[16];
#pragma unroll
            for (int ks = 0; ks < 16; ++ks) { a[ks] = *(const LAS bf16x8s*)(As + (16 * mt + r16) * SP + (32 * ks + 8 * kq) * 2); b[ks] = *(const LAS bf16x8s*)(Bs + (16 * nt + r16) * SP + (32 * ks + 8 * kq) * 2); }
#pragma unroll
            for (int ks = 0; ks < 16; ++ks) acc = __builtin_amdgcn_mfma_f32_16x16x32_bf16(a[ks], b[ks], acc, 0, 0, 0);
        }
        const int n = 16 * nt + r16;
        if (n < 24) {
#pragma unroll
            for (int i = 0; i < 4; ++i) { const int row = rb + 16 * mt + 4 * kq + i; smallp[(size_t)row * 24 + n] = acc[i] * (1.0f / sqrtf(rs[row] * (1.0f / DM) + EPS)); } }
    }
    __syncthreads();
}
__device__ __forceinline__ unsigned cvtpk(float lo, float hi) { return pk2(lo, hi); }
__device__ __forceinline__ float bflo(unsigned w) { return __uint_as_float(w << 16); }
__device__ __forceinline__ float bfhi(unsigned w) { return __uint_as_float(w & 0xffff0000u); }
typedef float f32x2 __attribute__((ext_vector_type(2)));
__device__ __forceinline__ f32x2 gelu_pk(f32x2 v) {
    const f32x2 av = __builtin_elementwise_abs(v), d = av * 0.2316418882f + 1.0f;
    f32x2 t; t.x = __builtin_amdgcn_rcpf(d.x); t.y = __builtin_amdgcn_rcpf(d.y);
    f32x2 q = t * 0.5307027145f + (-0.7265760135f); q = q * t + 0.7107068705f; q = q * t + (-0.142248368f); q = q * t + 0.127414796f; q = q * t;
    const f32x2 s = (v * v) * (-0.72134752044f);
    f32x2 e; e.x = __builtin_amdgcn_exp2f(s.x); e.y = __builtin_amdgcn_exp2f(s.y);
    const f32x2 m = v * (q * e), r = v - m;
    f32x2 o; o.x = v.x < 0.f ? m.x : r.x; o.y = v.y < 0.f ? m.y : r.y; return o;
}

__device__ __forceinline__ void ffn_fix(Frame& F, bf16* H, const bf16* sideA, const bf16* sideB, const float* cw, const float* cb, int pm) {
    constexpr int CPR = FFN / 8;
    for (int it = F.tid; it < 4 * 2 * CPR; it += NWAVES * 64) {
        const int c0 = (it % CPR) * 8, rr_ = (it / CPR) & 1, grp = 4 * pm + it / (2 * CPR); const bool first = (grp & 31) == 0;
        const v4u z = (v4u){0, 0, 0, 0};
        const bf16* sb = sideB + ((size_t)grp * 2 + rr_) * 2 * FFN + c0;
        const v4u g2 = *(const v4u*)sb, vv = *(const v4u*)(sb + FFN);
        const v4u a1 = first ? z : *(const v4u*)(sideA + ((size_t)(grp - 1) * 2 + 1) * FFN + c0), a0 = first ? z : *(const v4u*)(sideA + ((size_t)(grp - 1) * 2) * FFN + c0);
        const v4u g1 = rr_ ? *(const v4u*)(sideB + ((size_t)grp * 2) * 2 * FFN + c0) : a1, g0 = rr_ ? a1 : a0;
        f32x4 w0[2], w1[2], w2[2], bb[2];
#pragma unroll
        for (int k = 0; k < 2; ++k) { w0[k] = *(const f32x4*)(cw + c0 + 4 * k); w1[k] = *(const f32x4*)(cw + FFN + c0 + 4 * k); w2[k] = *(const f32x4*)(cw + 2 * FFN + c0 + 4 * k); bb[k] = *(const f32x4*)(cb + c0 + 4 * k); }
        v4u ov;
#pragma unroll
        for (int i = 0; i < 4; ++i) { const int k = i >> 1, e = (i & 1) * 2; f32x2 x;
            x.x = bb[k][e] + w0[k][e] * bflo(g0[i]) + w1[k][e] * bflo(g1[i]) + w2[k][e] * bflo(g2[i]);
            x.y = bb[k][e + 1] + w0[k][e + 1] * bfhi(g0[i]) + w1[k][e + 1] * bfhi(g1[i]) + w2[k][e + 1] * bfhi(g2[i]);
            const f32x2 ge = gelu_pk(x); ov[i] = cvtpk(ge.x * bflo(vv[i]), ge.y * bfhi(vv[i])); }
        *(v4u*)(H + (size_t)(grp * 64 + rr_) * FFN + c0) = ov;
    }
}
__device__ __forceinline__ float silu_f(float x) { return x * __builtin_amdgcn_rcpf(1.0f + __builtin_amdgcn_exp2f(-1.4426950408889634f * x)); }
__device__ __forceinline__ float sigm_f(float x) { return __builtin_amdgcn_rcpf(1.0f + __builtin_amdgcn_exp2f(-1.4426950408889634f * x)); }

__device__ __forceinline__ float shx(float v, int m, int lane) { return __int_as_float(__builtin_amdgcn_ds_bpermute((lane ^ m) << 2, __float_as_int(v))); }
__device__ __forceinline__ float shup(float v, int o, int lane) { return __int_as_float(__builtin_amdgcn_ds_bpermute((lane - o) << 2, __float_as_int(v))); }
__device__ __forceinline__ float shl_(float v, int src, int lane) { (void)lane; return __int_as_float(__builtin_amdgcn_ds_bpermute(src << 2, __float_as_int(v))); }
__device__ __forceinline__ float softplus_f(float x) { return fmaxf(x, 0.f) + 0.6931471805599453f * __builtin_amdgcn_logf(1.0f + __builtin_amdgcn_exp2f(-1.4426950408889634f * fabsf(x))); }
__device__ __forceinline__ float logsig_f(float x) { return fminf(x, 0.f) - 0.6931471805599453f * __builtin_amdgcn_logf(1.0f + __builtin_amdgcn_exp2f(-1.4426950408889634f * fabsf(x))); }
typedef short bf16x8v __attribute__((ext_vector_type(8)));
typedef float f32x16 __attribute__((ext_vector_type(16)));
typedef short v4i16_t __attribute__((ext_vector_type(4)));
__device__ __forceinline__ bf16x8v frag_row(LAS const unsigned char* base, int pitch, int row, int kel) { return *(const LAS bf16x8v*)(base + row * pitch + kel * 2); }
__device__ __forceinline__ bf16x8v frag_tr(LAS const unsigned char* base, int pitch, int krow, int col) {
    LAS const unsigned char* p = base + krow * pitch + col * 2;
    const v4i16_t lo = __builtin_amdgcn_ds_read_tr16_b64_v4i16((LAS v4i16_t*)p);
    const v4i16_t hi = __builtin_amdgcn_ds_read_tr16_b64_v4i16((LAS v4i16_t*)(p + 4 * pitch));
    return (bf16x8v){lo[0], lo[1], lo[2], lo[3], hi[0], hi[1], hi[2], hi[3]};
}
#define MFMA32(a, b, c) __builtin_amdgcn_mfma_f32_32x32x16_bf16((a), (b), (c), 0, 0, 0)

__device__ __forceinline__ void ssd_unit(int tid, bf16* proj, const float* smallp, float* ssq, const float* dt_bias, const float* a_log, const float* dskip, int b, int h, LAS unsigned char* lds) {
    constexpr int PB = 272, PX = 144;
    asm volatile("" : "+v"(tid));
    LAS unsigned char* CG = lds;
    LAS unsigned char* BB = lds + 34816;
    LAS unsigned char* XX = lds + 69632;
    LAS unsigned char* XW = lds + 88064;
    LAS unsigned char* ST = lds + 106496;
    LAS float* ldv = (LAS float*)(lds + 123904);
    LAS float* dtv = ldv + 2048;
    const int lane0 = tid & 63, w = __builtin_amdgcn_readfirstlane(tid >> 6);
    const int g = h >> 3, pt = w & 1, lt = w >> 1;
    const float a = -__expf(a_log[h]), dsk = dskip[h], dtb = dt_bias[h];
    const size_t rowb = (size_t)b * SEQ;
    const int xrow = tid >> 2, xq = tid & 3, brow = tid >> 4, bc = tid & 15;
    const bf16* xsrc = proj + (rowb + xrow) * PLD + PC_XBC + h * 64 + xq * 16;
    bf16* zptr = proj + (rowb + xrow) * PLD + PC_Z + h * 64 + xq * 16;
    const bf16* bsrc = proj + (rowb + brow) * PLD + PC_XBC + 1024 + g * 128 + bc * 8;
    const bf16* csrc = bsrc + 256;
    const float* dsrc = smallp + (rowb + lane0) * 24 + h;
    v4u xr[2], br[4], cr[4];
#pragma unroll
    for (int k = 0; k < 2; ++k) xr[k] = *(const v4u*)(xsrc + 8 * k);
#pragma unroll
    for (int k = 0; k < 4; ++k) { br[k] = *(const v4u*)(bsrc + (size_t)32 * k * PLD); cr[k] = *(const v4u*)(csrc + (size_t)32 * k * PLD); }
#pragma unroll
    for (int cc = 0; cc < 2; ++cc) { const int ch_ = 2 * w + cc; const float* dp_ = dsrc + (size_t)ch_ * 128 * 24;
        float v0 = dp_[0] + dtb, v1 = dp_[64 * 24] + dtb;
        v0 = softplus_f(v0); v1 = softplus_f(v1);
        float s0 = v0 * a, s1 = v1 * a;
#pragma unroll
        for (int o = 1; o < 64; o <<= 1) { const float t0 = shup(s0, o, lane0), t1 = shup(s1, o, lane0); if (lane0 >= o) { s0 += t0; s1 += t1; } }
        s1 += shl_(s0, 63, lane0);
        ldv[ch_ * 128 + lane0] = s0; ldv[ch_ * 128 + 64 + lane0] = s1; dtv[ch_ * 128 + lane0] = v0; dtv[ch_ * 128 + 64 + lane0] = v1; }
    f32x16 sacc;
#pragma unroll
    for (int i = 0; i < 16; ++i) sacc[i] = 0.f;
    for (int i = tid; i < 17408 / 4; i += 512) ((LAS unsigned*)ST)[i] = 0u;
    for (int c = 0; c < 16; ++c) {
        const size_t row0 = rowb + c * 128;
        int lane = lane0; asm volatile("" : "+v"(lane));
        const int r = lane & 31, hh = lane >> 5, trq = (lane & 15) >> 2, trc = 16 * ((lane >> 4) & 1) + 4 * (lane & 3);
        LAS const float* ldc = ldv + c * 128; LAS const float* dtc = dtv + c * 128;
        __syncthreads();
        {
            const float wl = dtc[xrow] * __expf(ldc[127] - ldc[xrow]);
#pragma unroll
            for (int k = 0; k < 2; ++k) { *(LAS v4u*)(XX + xrow * PX + xq * 32 + k * 16) = xr[k]; v4u o;
#pragma unroll
                for (int i = 0; i < 4; ++i) o[i] = pk2(bf2f(xr[k][i] & 0xffff) * wl, bf2f(xr[k][i] >> 16) * wl);
                *(LAS v4u*)(XW + xrow * PX + xq * 32 + k * 16) = o; }
#pragma unroll
            for (int k = 0; k < 4; ++k) { *(LAS v4u*)(BB + (brow + 32 * k) * PB + bc * 16) = br[k]; *(LAS v4u*)(CG + (brow + 32 * k) * PB + bc * 16) = cr[k]; }
        }
        v4u zr[2];
#pragma unroll
        for (int k = 0; k < 2; ++k) zr[k] = *(const v4u*)(zptr + (size_t)c * 128 * PLD + 8 * k);
        if (c < 15) {
#pragma unroll
            for (int k = 0; k < 2; ++k) xr[k] = *(const v4u*)(xsrc + (size_t)(c + 1) * 128 * PLD + 8 * k);
#pragma unroll
            for (int k = 0; k < 4; ++k) { br[k] = *(const v4u*)(bsrc + (size_t)((c + 1) * 128 + 32 * k) * PLD); cr[k] = *(const v4u*)(csrc + (size_t)((c + 1) * 128 + 32 * k) * PLD); }
        }
        __syncthreads();
        f32x16 yacc;
#pragma unroll
        for (int i = 0; i < 16; ++i) yacc[i] = 0.f;
        {   bf16x8v fa[8], fb[8];
#pragma unroll
            for (int ks = 0; ks < 8; ++ks) { fa[ks] = frag_row(ST, PB, 32 * pt + r, 16 * ks + 8 * hh); fb[ks] = frag_row(CG, PB, 32 * lt + r, 16 * ks + 8 * hh); }
            __builtin_amdgcn_sched_barrier(0);
#pragma unroll
            for (int ks = 0; ks < 8; ++ks) yacc = MFMA32(fa[ks], fb[ks], yacc); }
        { const float e = __expf(ldc[32 * lt + r]);
#pragma unroll
          for (int i = 0; i < 16; ++i) yacc[i] *= e; }
        f32x16 tA, tB;
        const int ltA = (w >= 6) ? 3 : (w >= 3) ? 2 : (w >= 1) ? 1 : 0, stA = w - ltA * (ltA + 1) / 2;
        const int ltB = 3, stB = w + 2;
#pragma unroll
        for (int i = 0; i < 16; ++i) { tA[i] = 0.f; tB[i] = 0.f; }
        {   bf16x8v fa[8], fb[8];
#pragma unroll
            for (int ks = 0; ks < 8; ++ks) { fa[ks] = frag_row(BB, PB, 32 * stA + r, 16 * ks + 8 * hh); fb[ks] = frag_row(CG, PB, 32 * ltA + r, 16 * ks + 8 * hh); }
            __builtin_amdgcn_sched_barrier(0);
#pragma unroll
            for (int ks = 0; ks < 8; ++ks) tA = MFMA32(fa[ks], fb[ks], tA); }
        if (w < 2) { bf16x8v fa[8], fb[8];
#pragma unroll
            for (int ks = 0; ks < 8; ++ks) { fa[ks] = frag_row(BB, PB, 32 * stB + r, 16 * ks + 8 * hh); fb[ks] = frag_row(CG, PB, 32 * ltB + r, 16 * ks + 8 * hh); }
            __builtin_amdgcn_sched_barrier(0);
#pragma unroll
            for (int ks = 0; ks < 8; ++ks) tB = MFMA32(fa[ks], fb[ks], tB); }
        __syncthreads();
#define SSD_GWRITE(T_, st_, lt_) do { const int l = 32 * (lt_) + r; const float ldl = ldc[l]; \
          _Pragma("unroll") for (int g4 = 0; g4 < 4; ++g4) { const int s0 = 32 * (st_) + 8 * g4 + 4 * hh; \
              const f32x4 lds4 = *(LAS const f32x4*)(ldc + s0), dts4 = *(LAS const f32x4*)(dtc + s0); float v[4]; \
              _Pragma("unroll") for (int j = 0; j < 4; ++j) { const float e_ = __expf(fminf(ldl - lds4[j], 0.f)) * dts4[j] * T_[4 * g4 + j]; v[j] = (s0 + j <= l) ? e_ : 0.f; } \
              *(LAS unsigned long long*)(CG + l * PB + s0 * 2) = (unsigned long long)pk2(v[0], v[1]) | ((unsigned long long)pk2(v[2], v[3]) << 32); } } while (0)
        SSD_GWRITE(tA, stA, ltA);
        if (w < 2) SSD_GWRITE(tB, stB, ltB);
#undef SSD_GWRITE
        __syncthreads();
        for (int kb = 0; kb <= lt; ++kb) { bf16x8v fa[2], fb[2];
#pragma unroll
            for (int k2 = 0; k2 < 2; ++k2) { const int ks = 2 * kb + k2; fa[k2] = frag_tr(XX, PX, 16 * ks + 8 * hh + trq, 32 * pt + trc); fb[k2] = frag_row(CG, PB, 32 * lt + r, 16 * ks + 8 * hh); }
            __builtin_amdgcn_sched_barrier(0);
#pragma unroll
            for (int k2 = 0; k2 < 2; ++k2) yacc = MFMA32(fa[k2], fb[k2], yacc); }
        { const float e = __expf(ldc[127]);
#pragma unroll
          for (int i = 0; i < 16; ++i) sacc[i] *= e; }
        {   bf16x8v fa[8], fb[8];
#pragma unroll
            for (int ks = 0; ks < 8; ++ks) { fa[ks] = frag_tr(BB, PB, 16 * ks + 8 * hh + trq, 32 * lt + trc); fb[ks] = frag_tr(XW, PX, 16 * ks + 8 * hh + trq, 32 * pt + trc); }
            __builtin_amdgcn_sched_barrier(0);
#pragma unroll
            for (int ks = 0; ks < 8; ++ks) sacc = MFMA32(fa[ks], fb[ks], sacc); }
        __syncthreads();
        {
            const int p = 32 * pt + r, l = 32 * lt + r;
#pragma unroll
            for (int g4 = 0; g4 < 4; ++g4) { const int n0 = 32 * lt + 8 * g4 + 4 * hh;
                *(LAS unsigned long long*)(ST + p * PB + n0 * 2) = (unsigned long long)pk2(sacc[4 * g4], sacc[4 * g4 + 1]) | ((unsigned long long)pk2(sacc[4 * g4 + 2], sacc[4 * g4 + 3]) << 32);
                const int p0 = 32 * pt + 8 * g4 + 4 * hh;
                *(LAS f32x4*)(CG + l * 272 + p0 * 4) = (f32x4){yacc[4 * g4], yacc[4 * g4 + 1], yacc[4 * g4 + 2], yacc[4 * g4 + 3]}; }
        }
        __syncthreads();
        {
            float o[16]; float ss = 0.f;
#pragma unroll
            for (int k = 0; k < 2; ++k) { const v4u zv = zr[k]; const v4u xv = *(const LAS v4u*)(XX + xrow * PX + xq * 32 + k * 16);
                const f32x4 y0 = *(const LAS f32x4*)(CG + xrow * 272 + (xq * 16 + 8 * k) * 4), y1 = *(const LAS f32x4*)(CG + xrow * 272 + (xq * 16 + 8 * k + 4) * 4);
#pragma unroll
                for (int i = 0; i < 4; ++i) { const float ya = (i < 2 ? y0[2 * i] : y1[2 * i - 4]), yb = (i < 2 ? y0[2 * i + 1] : y1[2 * i - 3]);
                    const float oa = (ya + dsk * bf2f(xv[i] & 0xffff)) * silu_f(bf2f(zv[i] & 0xffff)), ob = (yb + dsk * bf2f(xv[i] >> 16)) * silu_f(bf2f(zv[i] >> 16));
                    o[8 * k + 2 * i] = oa; o[8 * k + 2 * i + 1] = ob; ss += oa * oa + ob * ob; } }
            ss += shx(ss, 1, lane); ss += shx(ss, 2, lane);
            bf16* zp = zptr + (size_t)c * 128 * PLD;
#pragma unroll
            for (int k = 0; k < 2; ++k) { v4u ov; ov.x = pk2(o[8 * k], o[8 * k + 1]); ov.y = pk2(o[8 * k + 2], o[8 * k + 3]); ov.z = pk2(o[8 * k + 4], o[8 * k + 5]); ov.w = pk2(o[8 * k + 6], o[8 * k + 7]); *(v4u*)(zp + 8 * k) = ov; }
            if (xq == 0) ssq[(row0 + xrow) * 16 + h] = ss;
        }
    }
    __syncthreads();
}

__device__ __forceinline__ void mlstm_unit(int tid, bf16* proj, const float* smallp, const float* i_bias, const float* f_bias, const float* norm_w, int b, int hd, LAS unsigned char* lds, float* gsc  , unsigned long long* pts) {
    constexpr int PB = 272, GS = 656;
    asm volatile("" : "+v"(tid));
    LAS unsigned char* QP = lds;
    LAS unsigned char* KK = lds + 34816;
    LAS unsigned char* VV = lds + 69632;
    LAS unsigned char* CS = lds + 104448;
    LAS float* uu = (LAS float*)(lds + 139264);
    LAS float* mmv = uu + 128;
    LAS float* wint = mmv + 128;
    LAS float* dnv = wint + 128;
    LAS float* wlv = dnv + 128;
    LAS float* scal = wlv + 128;
    LAS float* nwl = scal + 16;
    LAS float* ptot = nwl + 128;
    LAS float* pmlo = ptot + 16;
    LAS unsigned short* nstb = (LAS unsigned short*)(pmlo + 16);
    const int lane0 = tid & 63, w = __builtin_amdgcn_readfirstlane(tid >> 6);
    const int tt = w >> 1, dp = w & 1;
    const float ib = i_bias[hd], fb = f_bias[hd];
    const size_t rowb = (size_t)b * SEQ;
    const int srow = tid >> 4, sc = tid & 15, et = tid >> 2, eq = tid & 3;
    const bf16* qsrc = proj + (rowb + srow) * PLD + PC_MQK + hd * 128 + sc * 8;
    const bf16* ksrc = qsrc + 512;
    const bf16* vsrc = proj + (rowb + srow) * PLD + PC_MV + hd * 128 + sc * 8;
    bf16* optr = proj + (rowb + et) * PLD + PC_MO + hd * 128 + eq * 32;
    v4u qr[4], kr[4]; float wlr[4];
#pragma unroll
    for (int k = 0; k < 4; ++k) { qr[k] = *(const v4u*)(qsrc + (size_t)32 * k * PLD); kr[k] = *(const v4u*)(ksrc + (size_t)32 * k * PLD); }
    {
        float pc0[2], pc1[2], pu0[2], pu1[2], pp0[2], pp1[2];
#pragma unroll
        for (int cc = 0; cc < 2; ++cc) { const float* gp = smallp + (rowb + (size_t)(2 * w + cc) * 128 + lane0) * 24 + 16 + hd;
            const float li0 = gp[0] + ib, li1 = gp[64 * 24] + ib, f0 = gp[4] + fb, f1 = gp[64 * 24 + 4] + fb;
            float c0 = logsig_f(f0), c1 = logsig_f(f1);
#pragma unroll
            for (int o = 1; o < 64; o <<= 1) { const float t0 = shup(c0, o, lane0), t1 = shup(c1, o, lane0); if (lane0 >= o) { c0 += t0; c1 += t1; } }
            c1 += shl_(c0, 63, lane0);
            const float totf = shl_(c1, 63, lane0);
            const float u0 = li0 - c0, u1 = li1 - c1;
            float p0 = u0, p1 = u1;
#pragma unroll
            for (int o = 1; o < 64; o <<= 1) { const float t0 = shup(p0, o, lane0), t1 = shup(p1, o, lane0); if (lane0 >= o) { p0 = fmaxf(p0, t0); p1 = fmaxf(p1, t1); } }
            p1 = fmaxf(p1, shl_(p0, 63, lane0));
            pc0[cc] = c0; pc1[cc] = c1; pu0[cc] = u0; pu1[cc] = u1; pp0[cc] = p0; pp1[cc] = p1;
            const float pall = shl_(p1, 63, lane0);
            if (lane0 == 0) { ptot[2 * w + cc] = totf; pmlo[2 * w + cc] = totf + pall; }
        }
        if (tid < 128) nwl[tid] = norm_w[hd * 128 + tid];
        if (tid < 64) ((LAS unsigned*)nstb)[tid] = 0u;
        for (int i = tid; i < 34816 / 4; i += 512) ((LAS unsigned*)CS)[i] = 0u;
        __syncthreads();
        float mst = 0.f, mst_mine[2] = {0.f, 0.f}, mnew_mine[2] = {0.f, 0.f};
#pragma unroll
        for (int c = 0; c < 16; ++c) { const float tf = ptot[c], ml = pmlo[c]; const float mn = fmaxf(tf + mst, ml);
            if (tid == 0) scal[c] = __expf(tf + mst - mn);
            if (c == 2 * w) { mst_mine[0] = mst; mnew_mine[0] = mn; }
            if (c == 2 * w + 1) { mst_mine[1] = mst; mnew_mine[1] = mn; }
            mst = mn; }
#pragma unroll
        for (int cc = 0; cc < 2; ++cc) { float* go_ = gsc + (size_t)(2 * w + cc) * GS; const float ms = mst_mine[cc], mn = mnew_mine[cc], tf = ptot[2 * w + cc];
            const float m0 = fmaxf(pp0[cc], ms), m1 = fmaxf(pp1[cc], ms);
            go_[lane0] = __expf(mn - tf - m0); go_[64 + lane0] = __expf(mn - tf - m1); go_[128 + lane0] = m0; go_[192 + lane0] = m1;
            go_[256 + lane0] = __expf(ms - m0); go_[320 + lane0] = __expf(ms - m1);
            go_[384 + lane0] = __expf(-(pc0[cc] + m0)); go_[448 + lane0] = __expf(-(pc1[cc] + m1));
            go_[512 + lane0] = __expf(tf + pu0[cc] - mn); go_[576 + lane0] = __expf(tf + pu1[cc] - mn); }
        asm volatile("s_waitcnt vmcnt(0)" ::: "memory");
        __syncthreads();
    }
    float gr[5] = {0.f, 0.f, 0.f, 0.f, 0.f};
    if (tid < 128) {
#pragma unroll
        for (int k = 0; k < 5; ++k) gr[k] = __hip_atomic_load(gsc + k * 128 + tid, __ATOMIC_RELAXED, __HIP_MEMORY_SCOPE_AGENT); }
#pragma unroll
    for (int k = 0; k < 4; ++k) wlr[k] = __hip_atomic_load(gsc + 512 + srow + 32 * k, __ATOMIC_RELAXED, __HIP_MEMORY_SCOPE_AGENT);
    f32x16 cacc0, cacc1, nacc;
#pragma unroll
    for (int i = 0; i < 16; ++i) { cacc0[i] = 0.f; cacc1[i] = 0.f; nacc[i] = 0.f; }
    const bf16x8v ones = (bf16x8v){0x3F80, 0x3F80, 0x3F80, 0x3F80, 0x3F80, 0x3F80, 0x3F80, 0x3F80};
#if PROBE_PHASE != -1 && defined(PROBE_STAGES)
    unsigned long long tacc = 0; unsigned long long tprev = __builtin_amdgcn_s_memrealtime();
#define STAMP(k) do { const unsigned long long tn_ = __builtin_amdgcn_s_memrealtime(); if ((k) == PROBE_STAGES) tacc += tn_ - tprev; tprev = tn_; } while (0)
#else
#define STAMP(k) do {} while (0)
#endif
    for (int c = 0; c < 16; ++c) {
        int lane = lane0; asm volatile("" : "+v"(lane));
        const int r = lane & 31, hh = lane >> 5, trq = (lane & 15) >> 2, trc = 16 * ((lane >> 4) & 1) + 4 * (lane & 3);
        __syncthreads();
        STAMP(0);
#pragma unroll
        for (int k = 0; k < 4; ++k) { *(LAS v4u*)(QP + (srow + 32 * k) * PB + sc * 16) = qr[k]; v4u kw_;
#pragma unroll
            for (int i = 0; i < 4; ++i) kw_[i] = pk2(bflo(kr[k][i]) * wlr[k], bfhi(kr[k][i]) * wlr[k]);
            *(LAS v4u*)(KK + (srow + 32 * k) * PB + sc * 16) = kw_; }
        if (tid < 128) { uu[tid] = gr[0]; mmv[tid] = gr[1]; wint[tid] = gr[2]; dnv[tid] = gr[3]; wlv[tid] = gr[4]; }
        v4u vr[4];
#pragma unroll
        for (int k = 0; k < 4; ++k) vr[k] = *(const v4u*)(vsrc + (size_t)(c * 128 + 32 * k) * PLD);
        if (c < 15) {
#pragma unroll
            for (int k = 0; k < 4; ++k) { const size_t ro = (size_t)((c + 1) * 128 + 32 * k) * PLD; qr[k] = *(const v4u*)(qsrc + ro); kr[k] = *(const v4u*)(ksrc + ro); }
#pragma unroll
            for (int k = 0; k < 4; ++k) wlr[k] = __hip_atomic_load(gsc + (size_t)(c + 1) * GS + 512 + srow + 32 * k, __ATOMIC_RELAXED, __HIP_MEMORY_SCOPE_AGENT);
            if (tid < 128) {
#pragma unroll
                for (int k = 0; k < 5; ++k) gr[k] = __hip_atomic_load(gsc + (size_t)(c + 1) * GS + k * 128 + tid, __ATOMIC_RELAXED, __HIP_MEMORY_SCOPE_AGENT); }
        }
        __syncthreads();
        STAMP(1);
        f32x16 na0, na1, dacc;
#pragma unroll
        for (int i = 0; i < 16; ++i) { na0[i] = 0.f; na1[i] = 0.f; dacc[i] = 0.f; }
#pragma unroll
        for (int kh = 0; kh < 2; ++kh) { bf16x8v fq[4], f0[4], f1[4], fn[4];
#pragma unroll
            for (int k4 = 0; k4 < 4; ++k4) { const int ks = 4 * kh + k4; fq[k4] = frag_row(QP, PB, 32 * tt + r, 16 * ks + 8 * hh); f0[k4] = frag_row(CS, PB, 32 * (2 * dp) + r, 16 * ks + 8 * hh); f1[k4] = frag_row(CS, PB, 32 * (2 * dp + 1) + r, 16 * ks + 8 * hh);
                fn[k4] = *(const LAS bf16x8v*)((LAS const unsigned char*)nstb + (16 * ks + 8 * hh) * 2); }
            __builtin_amdgcn_sched_barrier(0);
#pragma unroll
            for (int k4 = 0; k4 < 4; ++k4) { na0 = MFMA32(f0[k4], fq[k4], na0); na1 = MFMA32(f1[k4], fq[k4], na1); dacc = MFMA32(fn[k4], fq[k4], dacc); } }
        { const float e = wint[32 * tt + r];
#pragma unroll
          for (int i = 0; i < 16; ++i) { na0[i] *= e; na1[i] *= e; dacc[i] *= e; } }
        f32x16 tA, tB;
        const int ttA = (w >= 6) ? 3 : (w >= 3) ? 2 : (w >= 1) ? 1 : 0, stA = w - ttA * (ttA + 1) / 2;
        const int ttB = 3, stB = w + 2;
#pragma unroll
        for (int i = 0; i < 16; ++i) { tA[i] = 0.f; tB[i] = 0.f; }
#pragma unroll
        for (int kh = 0; kh < 2; ++kh) { bf16x8v fa[4], fb_[4];
#pragma unroll
            for (int k4 = 0; k4 < 4; ++k4) { const int ks = 4 * kh + k4; fa[k4] = frag_row(KK, PB, 32 * stA + r, 16 * ks + 8 * hh); fb_[k4] = frag_row(QP, PB, 32 * ttA + r, 16 * ks + 8 * hh); }
            __builtin_amdgcn_sched_barrier(0);
#pragma unroll
            for (int k4 = 0; k4 < 4; ++k4) tA = MFMA32(fa[k4], fb_[k4], tA); }
        if (w < 2) {
#pragma unroll
            for (int kh = 0; kh < 2; ++kh) { bf16x8v fa[4], fb_[4];
#pragma unroll
                for (int k4 = 0; k4 < 4; ++k4) { const int ks = 4 * kh + k4; fa[k4] = frag_row(KK, PB, 32 * stB + r, 16 * ks + 8 * hh); fb_[k4] = frag_row(QP, PB, 32 * ttB + r, 16 * ks + 8 * hh); }
                __builtin_amdgcn_sched_barrier(0);
#pragma unroll
                for (int k4 = 0; k4 < 4; ++k4) tB = MFMA32(fa[k4], fb_[k4], tB); } }
        __syncthreads();
        STAMP(2);
#define ML_PWRITE(T_, st_, tt_) do { const int t = 32 * (tt_) + r; const float rh = uu[t]; \
          _Pragma("unroll") for (int g4 = 0; g4 < 4; ++g4) { const int s0 = 32 * (st_) + 8 * g4 + 4 * hh; float v[4]; \
              _Pragma("unroll") for (int j = 0; j < 4; ++j) v[j] = (s0 + j <= t) ? T_[4 * g4 + j] * rh : 0.f; \
              *(LAS unsigned long long*)(QP + t * PB + s0 * 2) = (unsigned long long)pk2(v[0], v[1]) | ((unsigned long long)pk2(v[2], v[3]) << 32); } } while (0)
        ML_PWRITE(tA, stA, ttA);
        if (w < 2) ML_PWRITE(tB, stB, ttB);
#undef ML_PWRITE
#pragma unroll
        for (int k = 0; k < 4; ++k) *(LAS v4u*)(VV + (srow + 32 * k) * PB + sc * 16) = vr[k];
        v4u og[4];
#pragma unroll
        for (int k = 0; k < 4; ++k) og[k] = *(const v4u*)(optr + (size_t)c * 128 * PLD + 8 * k);
        __syncthreads();
        STAMP(3);
        { const float e = scal[c];
#pragma unroll
          for (int i = 0; i < 16; ++i) { cacc0[i] *= e; cacc1[i] *= e; nacc[i] *= e; } }
#pragma unroll
        for (int kb = 0; kb < 4; ++kb) { bf16x8v fk[2], f0[2], f1[2], fp[2];
            const bool m3 = kb <= tt;
#pragma unroll
            for (int k2 = 0; k2 < 2; ++k2) { const int ks = 2 * kb + k2; fk[k2] = frag_tr(KK, PB, 16 * ks + 8 * hh + trq, 32 * tt + trc);
                f0[k2] = frag_tr(VV, PB, 16 * ks + 8 * hh + trq, 32 * (2 * dp) + trc); f1[k2] = frag_tr(VV, PB, 16 * ks + 8 * hh + trq, 32 * (2 * dp + 1) + trc);
                fp[k2] = frag_row(QP, PB, 32 * tt + r, 16 * ks + 8 * hh); }
            __builtin_amdgcn_sched_barrier(0);
#pragma unroll
            for (int k2 = 0; k2 < 2; ++k2) { cacc0 = MFMA32(fk[k2], f0[k2], cacc0); cacc1 = MFMA32(fk[k2], f1[k2], cacc1); nacc = MFMA32(fk[k2], ones, nacc);
                if (m3) { na0 = MFMA32(f0[k2], fp[k2], na0); na1 = MFMA32(f1[k2], fp[k2], na1); dacc = MFMA32(ones, fp[k2], dacc); } } }
        __syncthreads();
        STAMP(4);
        {
            const int t = 32 * tt + r; const float dv = __builtin_amdgcn_rcpf(fmaxf(fabsf(dacc[0]), dnv[t]));
#pragma unroll
            for (int g4 = 0; g4 < 4; ++g4) {
                const int e0 = 32 * tt + 8 * g4 + 4 * hh, d0 = 32 * (2 * dp) + r, d1 = 32 * (2 * dp + 1) + r;
                *(LAS unsigned long long*)(CS + d0 * PB + e0 * 2) = (unsigned long long)pk2(cacc0[4 * g4], cacc0[4 * g4 + 1]) | ((unsigned long long)pk2(cacc0[4 * g4 + 2], cacc0[4 * g4 + 3]) << 32);
                *(LAS unsigned long long*)(CS + d1 * PB + e0 * 2) = (unsigned long long)pk2(cacc1[4 * g4], cacc1[4 * g4 + 1]) | ((unsigned long long)pk2(cacc1[4 * g4 + 2], cacc1[4 * g4 + 3]) << 32);
                const int dd0 = 32 * (2 * dp) + 8 * g4 + 4 * hh, dd1 = dd0 + 32;
                *(LAS unsigned long long*)(QP + t * PB + dd0 * 2) = (unsigned long long)pk2(na0[4 * g4] * dv, na0[4 * g4 + 1] * dv) | ((unsigned long long)pk2(na0[4 * g4 + 2] * dv, na0[4 * g4 + 3] * dv) << 32);
                *(LAS unsigned long long*)(QP + t * PB + dd1 * 2) = (unsigned long long)pk2(na1[4 * g4] * dv, na1[4 * g4 + 1] * dv) | ((unsigned long long)pk2(na1[4 * g4 + 2] * dv, na1[4 * g4 + 3] * dv) << 32);
                if (dp == 0 && r == 0) *(LAS unsigned long long*)((LAS unsigned char*)nstb + e0 * 2) = (unsigned long long)pk2(nacc[4 * g4], nacc[4 * g4 + 1]) | ((unsigned long long)pk2(nacc[4 * g4 + 2], nacc[4 * g4 + 3]) << 32);
            }
        }
        __syncthreads();
        STAMP(5);
        {
            float hv[32]; float ss = 0.f;
#pragma unroll
            for (int k = 0; k < 4; ++k) { const v4u x = *(const LAS v4u*)(QP + et * PB + eq * 64 + k * 16);
#pragma unroll
                for (int i = 0; i < 4; ++i) { hv[8 * k + 2 * i] = bflo(x[i]); hv[8 * k + 2 * i + 1] = bfhi(x[i]); ss += hv[8 * k + 2 * i] * hv[8 * k + 2 * i] + hv[8 * k + 2 * i + 1] * hv[8 * k + 2 * i + 1]; } }
            ss += shx(ss, 1, lane); ss += shx(ss, 2, lane);
            const float rr = __builtin_amdgcn_rsqf(ss * (1.0f / 128.0f) + EPS);
            bf16* op = optr + (size_t)c * 128 * PLD;
            LAS const float* nw = nwl + eq * 32;
#pragma unroll
            for (int k = 0; k < 4; ++k) { v4u o; const f32x4 w0 = *(LAS const f32x4*)(nw + 8 * k), w1 = *(LAS const f32x4*)(nw + 8 * k + 4);
#pragma unroll
                for (int i = 0; i < 4; ++i) { const float g0 = sigm_f(bflo(og[k][i])), g1 = sigm_f(bfhi(og[k][i]));
                    const float wa = (i < 2) ? w0[2 * i] : w1[2 * i - 4], wb = (i < 2) ? w0[2 * i + 1] : w1[2 * i - 3];
                    o[i] = pk2(hv[8 * k + 2 * i] * rr * wa * g0, hv[8 * k + 2 * i + 1] * rr * wb * g1); }
                *(v4u*)(op + 8 * k) = o; }
        }
    }
#if PROBE_PHASE != -1 && defined(PROBE_STAGES)
    STAMP(6);
    if (tid == 0 && pts) pts[PROBE_STAGES] = tacc;
#endif
#undef STAMP
    __syncthreads();
}

__device__ __forceinline__ void conv_fix(Frame& F, bf16* proj, const bf16* halo, const float* scw, const float* scb, const float* mcw, const float* mcb) {
    const int gt = F.vcu * (NWAVES * 64) + F.tid, NT = F.G * NWAVES * 64;
    for (int it = gt; it < 256 * 320; it += NT) {
        const int strip = it % 320, rg = it / 320, hch = strip * 8;
        const float* wp; const float* bp; int wst; float post = 1.0f;
        if (hch < 1536) { wp = scw + hch; bp = scb + hch; wst = 1536; }
        else { const int c2 = hch - 1536; wp = mcw + c2; bp = mcb + c2; wst = 1024; post = (c2 >= 512) ? 0.08838834764831845f : 1.0f; }
        bf16* base = proj + (size_t)rg * 64 * PLD + PC_XBC + hch;
        v4u r0 = (v4u){0, 0, 0, 0}, r1 = r0, r2 = r0;
        if ((rg & 31) != 0) { const bf16* hp = halo + ((size_t)(rg - 1) * 3) * 2560 + hch; r0 = *(const v4u*)hp; r1 = *(const v4u*)(hp + 2560); r2 = *(const v4u*)(hp + 5120); }
        v4u cur[3];
#pragma unroll
        for (int j = 0; j < 3; ++j) cur[j] = *(const v4u*)(base + (size_t)j * PLD);
        float cw[4][8], cb[8];
#pragma unroll
        for (int j = 0; j < 4; ++j) { const f32x4 a0 = *(const f32x4*)(wp + j * wst), a1 = *(const f32x4*)(wp + j * wst + 4);
#pragma unroll
            for (int i = 0; i < 4; ++i) { cw[j][i] = a0[i]; cw[j][4 + i] = a1[i]; } }
        { const f32x4 a0 = *(const f32x4*)bp, a1 = *(const f32x4*)(bp + 4);
#pragma unroll
          for (int i = 0; i < 4; ++i) { cb[i] = a0[i]; cb[4 + i] = a1[i]; } }
#pragma unroll
        for (int j = 0; j < 3; ++j) { v4u o;
#pragma unroll
            for (int i = 0; i < 4; ++i) {
                const float a0 = cb[2 * i] + cw[0][2 * i] * bflo(r0[i]) + cw[1][2 * i] * bflo(r1[i]) + cw[2][2 * i] * bflo(r2[i]) + cw[3][2 * i] * bflo(cur[j][i]);
                const float a1 = cb[2 * i + 1] + cw[0][2 * i + 1] * bfhi(r0[i]) + cw[1][2 * i + 1] * bfhi(r1[i]) + cw[2][2 * i + 1] * bfhi(r2[i]) + cw[3][2 * i + 1] * bfhi(cur[j][i]);
                o[i] = pk2(silu_f(a0) * post, silu_f(a1) * post); }
            *(v4u*)(base + (size_t)j * PLD) = o; r0 = r1; r1 = r2; r2 = cur[j]; }
    }
}

__device__ __forceinline__ void ksum_pass(Frame& F, const bf16* proj, float* ksum) {
    const int gt = F.vcu * (NWAVES * 64) + F.tid, NT = F.G * NWAVES * 64;
    for (int it = gt; it < 64 * 16 * 64; it += NT) {
        const int ch = it & 63, sl = (it >> 6) & 15, tile = it >> 10;
        const bf16* base = proj + ((size_t)tile * 256 + sl * 16) * PLD + PC_K + ch * 8;
        float a[8];
#pragma unroll
        for (int i = 0; i < 8; ++i) a[i] = 0.f;
        v4u v[16];
#pragma unroll
        for (int j = 0; j < 16; ++j) v[j] = *(const v4u*)(base + (size_t)j * PLD);
#pragma unroll
        for (int j = 0; j < 16; ++j)
#pragma unroll
            for (int i = 0; i < 4; ++i) { a[2 * i] += bflo(v[j][i]); a[2 * i + 1] += bfhi(v[j][i]); }
        float* kd = ksum + (size_t)tile * 512 + ch * 8;
#pragma unroll
        for (int i = 0; i < 8; ++i) atomicAdd(kd + i, a[i]);
    }
}

namespace attn_body {
using bf16=__hip_bfloat16;
using bf16x8=__attribute__((ext_vector_type(8)))short;
using s16x4=__attribute__((ext_vector_type(4)))short;
using f32x16=__attribute__((ext_vector_type(16)))float;
using u32x4=__attribute__((ext_vector_type(4)))unsigned;
constexpr int BATCH=8,NHEAD=8,SEQ=2048,D=64,DM=6144;
constexpr int NW=8,QBLK=32,QB=QBLK*NW,KVBLK=64,NQB=SEQ/QB;
constexpr int ATTN_PITCH=DM, ATTN_UNIT_ROWS=QB;
__device__ __forceinline__ int crow(int r,int hi){return (r&3)+8*(r>>2)+4*hi;}
#define SBAR() __builtin_amdgcn_sched_barrier(0)
__device__ __forceinline__ void cmask(f32x16&p0,f32x16&p1,int jb,int qrel,int hi){
  const float NEG=-INFINITY; int kb=64*jb+4*hi;
  #pragma unroll
  for(int r=0;r<16;++r){int kv=kb+(r&3)+8*(r>>2); if(kv>qrel)p0[r]=NEG; if(kv+32>qrel)p1[r]=NEG;}
}

typedef float f32x4_t __attribute__((ext_vector_type(4)));
__device__ __forceinline__ float bfu(short v){return __uint_as_float(((unsigned)(unsigned short)v)<<16);}
constexpr int NSLOT=3, SLOTB=8192;
constexpr int LDS_K=0, LDS_V=NSLOT*SLOTB, LDS_WS=2*NSLOT*SLOTB, LDS_OST=LDS_WS+NW*64*4, LDS_BYTES=LDS_OST+NW*4096;
constexpr float C2=0.125f*1.4426950408889634f;
__device__ __forceinline__ void glds16(const void*gsrc,unsigned lds_dst){unsigned keep;
  asm volatile("s_mov_b32 %0, m0\n\ts_mov_b32 m0, %2\n\ts_nop 0\n\tglobal_load_lds_dwordx4 %1, off\n\ts_mov_b32 m0, %0":"=&s"(keep):"v"(gsrc),"s"(lds_dst):"memory");}
__device__ __forceinline__ float max3f(float a,float b,float c){float r;asm("v_max3_f32 %0, %1, %2, %3":"=v"(r):"v"(a),"v"(b),"v"(c));return r;}
__device__ __forceinline__ float max2f(float a,float b){float r;asm("v_max_f32_e32 %0, %1, %2":"=v"(r):"v"(a),"v"(b));return r;}
__device__ __forceinline__ float fadd_s(float a,float b){float r;asm("v_add_f32_e32 %0, %1, %2":"=v"(r):"v"(a),"v"(b));return r;}
__device__ __forceinline__ float fsub_s(float a,float b){float r;asm("v_sub_f32_e32 %0, %1, %2":"=v"(r):"v"(a),"v"(b));return r;}
typedef float f32x2_t __attribute__((ext_vector_type(2))); typedef __bf16 bf16x2_t __attribute__((ext_vector_type(2)));
__device__ __forceinline__ unsigned cvtpk_s(float lo,float hi){f32x2_t v={lo,hi};bf16x2_t b=__builtin_convertvector(v,bf16x2_t);return __builtin_bit_cast(unsigned,b);}
#define WAIT_BAR(N) asm volatile("s_waitcnt vmcnt(" #N ") lgkmcnt(0)\n\ts_barrier":::"memory")

__device__ __forceinline__ void qkt(f32x16&p0,f32x16&p1,const char*Kslot,const bf16x8*qr,const f32x16&negm,int r32,int hi){
  const char*kb=Kslot+hi*1024+r32*16;
  #pragma unroll
  for(int d0=0;d0<4;++d0){
    const bf16x8 b0=*reinterpret_cast<const bf16x8*>(kb+d0*2048);
    const bf16x8 b1=*reinterpret_cast<const bf16x8*>(kb+d0*2048+512);
    if(d0==0){p0=__builtin_amdgcn_mfma_f32_32x32x16_bf16(b0,qr[0],negm,0,0,0);p1=__builtin_amdgcn_mfma_f32_32x32x16_bf16(b1,qr[0],negm,0,0,0);}
    else{p0=__builtin_amdgcn_mfma_f32_32x32x16_bf16(b0,qr[d0],p0,0,0,0);p1=__builtin_amdgcn_mfma_f32_32x32x16_bf16(b1,qr[d0],p1,0,0,0);}}
}
typedef __attribute__((address_space(3))) const char* lds_cptr;
typedef short v4i16_t __attribute__((ext_vector_type(4)));
__device__ __forceinline__ void kload8(bf16x8*kf,lds_cptr kp){
  kf[0]=*(const __attribute__((address_space(3))) bf16x8*)(kp);      kf[1]=*(const __attribute__((address_space(3))) bf16x8*)(kp+512);
  kf[2]=*(const __attribute__((address_space(3))) bf16x8*)(kp+2048); kf[3]=*(const __attribute__((address_space(3))) bf16x8*)(kp+2560);
  kf[4]=*(const __attribute__((address_space(3))) bf16x8*)(kp+4096); kf[5]=*(const __attribute__((address_space(3))) bf16x8*)(kp+4608);
  kf[6]=*(const __attribute__((address_space(3))) bf16x8*)(kp+6144); kf[7]=*(const __attribute__((address_space(3))) bf16x8*)(kp+6656);
}
__device__ __forceinline__ void kload2(bf16x8*kf,lds_cptr kp,int j){ kf[2*j]=*(const __attribute__((address_space(3))) bf16x8*)(kp+j*2048); kf[2*j+1]=*(const __attribute__((address_space(3))) bf16x8*)(kp+j*2048+512); }
__device__ __forceinline__ s16x4 vtr(lds_cptr p){ return __builtin_bit_cast(s16x4,__builtin_amdgcn_ds_read_tr16_b64_v4i16((__attribute__((address_space(3))) v4i16_t*)p)); }
__device__ __forceinline__ float rowmax(const f32x16&p0,const f32x16&p1){
  float a=max3f(p0[0],p0[1],p1[0]),b=max3f(p0[2],p0[3],p1[1]);a=max3f(a,p1[2],p1[3]);
  #pragma unroll
  for(int r=4;r<16;r+=4){a=max3f(a,p0[r],p0[r+1]);b=max3f(b,p0[r+2],p0[r+3]);a=max3f(a,p1[r],p1[r+1]);b=max3f(b,p1[r+2],p1[r+3]);}
  const float m=max2f(a,b);
  auto rr=__builtin_amdgcn_permlane32_swap(__float_as_uint(m),__float_as_uint(m),false,false);
  return max2f(__uint_as_float(rr[0]),__uint_as_float(rr[1]));
}
__device__ __forceinline__ void pv(f32x16*o,int vb,bf16x8 pa0,bf16x8 pa1,bf16x8 pa2,bf16x8 pa3){
  #pragma unroll
  for(int d0=0;d0<2;++d0){s16x4 lo[4],hi[4];
    #pragma unroll
    for(int ks=0;ks<4;++ks){
      asm volatile("ds_read_b64_tr_b16 %0,%1 offset:%c2":"=&v"(lo[ks]):"v"(vb),"i"(d0*4096+ks*1024):"memory");
      asm volatile("ds_read_b64_tr_b16 %0,%1 offset:%c2":"=&v"(hi[ks]):"v"(vb),"i"(d0*4096+ks*1024+512):"memory");}
    asm volatile("s_waitcnt lgkmcnt(0)":::"memory");SBAR();
    #define PK(k) (bf16x8){lo[k][0],lo[k][1],lo[k][2],lo[k][3],hi[k][0],hi[k][1],hi[k][2],hi[k][3]}
    o[d0]=__builtin_amdgcn_mfma_f32_32x32x16_bf16(pa0,PK(0),o[d0],0,0,0);
    o[d0]=__builtin_amdgcn_mfma_f32_32x32x16_bf16(pa1,PK(1),o[d0],0,0,0);
    o[d0]=__builtin_amdgcn_mfma_f32_32x32x16_bf16(pa2,PK(2),o[d0],0,0,0);
    o[d0]=__builtin_amdgcn_mfma_f32_32x32x16_bf16(pa3,PK(3),o[d0],0,0,0);
    #undef PK
  }
}

#ifndef ATTN_STORE16
#define ATTN_STORE16(p,v) (*(u32x4*)(p)=(v))
#endif
template<int THRL> __device__ __forceinline__ void attn_unit(int tid,int b,int h,int qb,const bf16*Q,const bf16*__restrict__ K,const bf16*__restrict__ V,bf16*O,const float*__restrict__ ksum,char*shm){
  asm volatile("":"+v"(tid));
  const int lane=tid&63,r32=lane&31,hi=lane>>5; const int wid=__builtin_amdgcn_readfirstlane(tid>>6);
  const long rowbase=(long)b*SEQ; const int q0=qb*QB;
  const bf16*Qw=Q+(rowbase+q0+wid*QBLK)*DM+h*D;
  const bf16*Kh=K+rowbase*DM+h*D,*Vh=V+rowbase*DM+h*D;
  const unsigned lds0=(unsigned)(uintptr_t)shm;
  float*wsf=(float*)(shm+LDS_WS)+wid*64;
  const bf16*ksrc=Kh+(long)lane*DM+wid*8;
  const bf16*vsrc=Vh+(long)(16*(wid&3)+(lane>>2))*DM+(wid>>2)*32+(lane&3)*8;
  const unsigned kdst=lds0+LDS_K+wid*1024, vdst=lds0+LDS_V+wid*1024;
  #define DMA_K(t,slot) glds16(ksrc+(long)(t)*KVBLK*DM,(unsigned)__builtin_amdgcn_readfirstlane(kdst+(slot)))
  #define DMA_V(t,slot) glds16(vsrc+(long)(t)*KVBLK*DM,(unsigned)__builtin_amdgcn_readfirstlane(vdst+(slot)))
  const int vb0=(int)(lds0+LDS_V)+((lane>>4)&1)*32+(lane&3)*8+(4*hi+((lane&15)>>2))*64;
  const char*Kbase=shm+LDS_K; bf16x8 kf[8];
  const lds_cptr shm3=(lds_cptr)shm; const lds_cptr kp0=shm3+LDS_K+hi*1024+r32*16; const lds_cptr vp0=shm3+LDS_V+((lane>>4)&1)*32+(lane&3)*8+(4*hi+((lane&15)>>2))*64;
  const int NT=(q0+QB)/KVBLK;
  DMA_K(0,0);DMA_V(0,0);DMA_K(1,SLOTB);
  bf16x8 qr[4];
  #pragma unroll
  for(int d0=0;d0<4;++d0)qr[d0]=*reinterpret_cast<const bf16x8*>(&Qw[(long)r32*DM+d0*16+hi*8]);
  unsigned sel=(1u<<qb)-1u;
  if(qb>=4){
    float g[8];
    #pragma unroll
    for(int n=0;n<8;++n){ g[n]=0.f;
      { const float*kp=ksum+(((long)(b*8+n)*NHEAD+h)*64)+hi*8; float a=0.f;
        #pragma unroll
        for(int d0=0;d0<4;++d0){ const f32x4_t k0=*(const f32x4_t*)(kp+d0*16),k1=*(const f32x4_t*)(kp+d0*16+4);
          #pragma unroll
          for(int j=0;j<4;++j){ a+=bfu(qr[d0][j])*k0[j]; a+=bfu(qr[d0][4+j])*k1[j]; } }
        a+=shx(a,32,lane); g[n]=a; } }
    sel=0u;
    #pragma unroll
    for(int k=0;k<3;++k){ int best=-1; float bv=0.f;
      #pragma unroll
      for(int n=0;n<8;++n) if(n<qb&&!((sel>>n)&1u)){ if(best<0||g[n]>bv){best=n;bv=g[n];} }
      sel|=1u<<best; }
  }
  #define KEEP(t) (((t)>=NT-4)||((sel>>((t)>>2))&1u))
  float mhat=0.f,l_reg=0.f;f32x16 o[2];o[0]=f32x16{};o[1]=f32x16{};f32x16 negm=f32x16{};asm volatile("":"+v"(negm));
  const int qrel=wid*QBLK+r32;
  #define CMASK(P0,P1,t) do{int jb_=(t)-(NT-4); if(jb_>=0)cmask(P0,P1,jb_,qrel,hi);}while(0)
  bool resc=false;
  #define START(P0,P1) do{ const float rm=KEEP(0)?rowmax(P0,P1):-INFINITY; resc=false; \
    { const float dl=max2f(rm,-64.f); mhat=fadd_s(mhat,dl); \
      _Pragma("unroll") for(int r=0;r<16;++r){P0[r]=fsub_s(P0[r],dl);P1[r]=fsub_s(P1[r],dl);} \
      _Pragma("unroll") for(int r=0;r<16;++r)negm[r]=-mhat; asm volatile("":"+v"(negm)); } \
    _Pragma("unroll") for(int r=0;r<16;++r)P0[r]=__builtin_amdgcn_exp2f(P0[r]); }while(0)
  #define RESC() do{ if(resc){ asm volatile("s_waitcnt lgkmcnt(0)":::"memory"); \
      _Pragma("unroll") for(int d_=0;d_<2;++d_) _Pragma("unroll") for(int r=0;r<16;++r)o[d_][r]*=wsf[crow(r,hi)]; } }while(0)
  f32x16 pA0,pA1,pB0,pB1;
  int sl_prev=0,sl_cur=0,sl_next=SLOTB;
  #define ROT() do{sl_prev=sl_cur;sl_cur=sl_next;sl_next=(sl_next==(NSLOT-1)*SLOTB)?0:sl_next+SLOTB;}while(0)
  DMA_K(2,2*SLOTB);
  WAIT_BAR(3);
  qkt(pA0,pA1,Kbase,qr,negm,r32,hi);asm volatile("s_nop 15\n\ts_nop 7":"+v"(pA0),"+v"(pA1));CMASK(pA0,pA1,0);
  START(pA0,pA1);
  _Pragma("unroll") for(int r=0;r<16;++r)pA1[r]=__builtin_amdgcn_exp2f(pA1[r]);
  WAIT_BAR(0);
  DMA_K(3,0);DMA_V(1,SLOTB);
  ROT();
  kload8(kf,kp0+sl_cur);
  WAIT_BAR(2);
  s16x4 vlo[8],vhi[8]; u32x4 pw0,pw1,pw2,pw3;
  #define PKW(P,B) (cvtpk_s(P[B],P[B+1])&kmp_)
  #define PAF(k) __builtin_bit_cast(bf16x8,pw##k)
  #define VFR(i) (bf16x8){vlo[i][0],vlo[i][1],vlo[i][2],vlo[i][3],vhi[i][0],vhi[i][1],vhi[i][2],vhi[i][3]}
  #define PIN(x) asm volatile("":"+v"(x))
  #define MX3(a,b,c) __builtin_fmaxf(__builtin_fmaxf((a),(b)),(c))
  #define GAPA(MF,A0,A1,A2,A3,W0,W1,PW) do{ MF; sacc+=A0; sacc+=A1; sacc+=A2; sacc+=A3; PIN(sacc); W0; W1; PIN(PW); SBAR(); }while(0)
  #define EX(v) __builtin_amdgcn_exp2f(v)
  #define GAPB(MF,X,B) do{ MF; X[B]=EX(X[B]); X[B+1]=EX(X[B+1]); X[B+2]=EX(X[B+2]); X[B+3]=EX(X[B+3]); PIN(X); SBAR(); }while(0)
  #define VRD(i) do{ vlo[i]=vtr(vp_+(((i)>>2)*4096+((i)&3)*1024)); vhi[i]=vtr(vp_+(((i)>>2)*4096+((i)&3)*1024+512)); }while(0)
  #define KRD(G,j) do{ if(G){ kload2(kf,kp0+sl_next,j); SBAR(); } }while(0)
  #define STEP(C0,C1,P0,P1,t,GK,GV,GL) do{ SBAR(); \
    const lds_cptr vp_=vp0+sl_prev; const bool kp_=KEEP((t)-1); const unsigned kmp_=kp_?0xffffffffu:0u; const float kfp_=kp_?1.f:0.f; \
    VRD(0); SBAR(); float sacc=(P0[0]+P0[1]); \
    GAPA(C0=__builtin_amdgcn_mfma_f32_32x32x16_bf16(kf[0],qr[0],negm,0,0,0), P0[2],P0[3],P0[4],P0[5],     pw0[0]=PKW(P0,0), pw0[1]=PKW(P0,2), pw0); \
    VRD(4); SBAR(); GAPA(C1=__builtin_amdgcn_mfma_f32_32x32x16_bf16(kf[1],qr[0],negm,0,0,0), P0[6],P0[7],P0[8],P0[9],     pw0[2]=PKW(P0,4), pw0[3]=PKW(P0,6), pw0); \
    VRD(1); SBAR(); GAPA(C0=__builtin_amdgcn_mfma_f32_32x32x16_bf16(kf[2],qr[1],C0,0,0,0),   P0[10],P0[11],P0[12],P0[13], pw1[0]=PKW(P0,8), pw1[1]=PKW(P0,10), pw1); \
    VRD(5); SBAR(); GAPA(C1=__builtin_amdgcn_mfma_f32_32x32x16_bf16(kf[3],qr[1],C1,0,0,0),   P0[14],P0[15],P1[0],P1[1],   pw1[2]=PKW(P0,12),pw1[3]=PKW(P0,14), pw1); \
    VRD(2); SBAR(); GAPA(C0=__builtin_amdgcn_mfma_f32_32x32x16_bf16(kf[4],qr[2],C0,0,0,0),   P1[2],P1[3],P1[4],P1[5],     pw2[0]=PKW(P1,0), pw2[1]=PKW(P1,2), pw2); \
    VRD(6); SBAR(); GAPA(C1=__builtin_amdgcn_mfma_f32_32x32x16_bf16(kf[5],qr[2],C1,0,0,0),   P1[6],P1[7],P1[8],P1[9],     pw2[2]=PKW(P1,4), pw2[3]=PKW(P1,6), pw2); \
    VRD(3); SBAR(); GAPA(C0=__builtin_amdgcn_mfma_f32_32x32x16_bf16(kf[6],qr[3],C0,0,0,0),   P1[10],P1[11],P1[12],P1[13], pw3[0]=PKW(P1,8), pw3[1]=PKW(P1,10), pw3); \
    VRD(7); SBAR(); GAPA(C1=__builtin_amdgcn_mfma_f32_32x32x16_bf16(kf[7],qr[3],C1,0,0,0),   P1[14],P1[15],0.f,0.f,       pw3[2]=PKW(P1,12),pw3[3]=PKW(P1,14), pw3); \
    l_reg=__builtin_fmaf(sacc,kfp_,l_reg); \
    if(GK){DMA_K((t)+3,sl_cur);} if(GV){DMA_V((t)+1,sl_next);} \
    CMASK(C0,C1,t); \
    { float a=MX3(C0[0],C0[1],C1[0]),b=MX3(C0[2],C0[3],C1[1]); a=MX3(a,C1[2],C1[3]); \
      _Pragma("unroll") for(int r=4;r<16;r+=4){a=MX3(a,C0[r],C0[r+1]);b=MX3(b,C0[r+2],C0[r+3]);a=MX3(a,C1[r],C1[r+1]);b=MX3(b,C1[r+2],C1[r+3]);} \
      float rm=__builtin_fmaxf(a,b); { auto rr=__builtin_amdgcn_permlane32_swap(__float_as_uint(rm),__float_as_uint(rm),false,false); rm=__builtin_fmaxf(__uint_as_float(rr[0]),__uint_as_float(rr[1])); } \
      rm=KEEP(t)?rm:-INFINITY; \
      resc=false; \
      if(__builtin_expect(__any(rm>(float)THRL),0)){ const float dl=__builtin_fmaxf(rm,0.f); mhat+=dl; \
        _Pragma("unroll") for(int r=0;r<16;++r){C0[r]-=dl;C1[r]-=dl;} \
        _Pragma("unroll") for(int r=0;r<16;++r)negm[r]=-mhat; asm volatile("":"+v"(negm)); \
        const float f=__builtin_amdgcn_exp2f(-dl); l_reg*=f; if(hi==0)wsf[r32]=f; resc=true; } } \
    SBAR(); \
    GAPB(o[0]=__builtin_amdgcn_mfma_f32_32x32x16_bf16(PAF(0),VFR(0),o[0],0,0,0), C0,0); \
    GAPB(o[1]=__builtin_amdgcn_mfma_f32_32x32x16_bf16(PAF(0),VFR(4),o[1],0,0,0), C0,4); \
    KRD(GL,0); GAPB(o[0]=__builtin_amdgcn_mfma_f32_32x32x16_bf16(PAF(1),VFR(1),o[0],0,0,0), C0,8); \
    KRD(GL,1); GAPB(o[1]=__builtin_amdgcn_mfma_f32_32x32x16_bf16(PAF(1),VFR(5),o[1],0,0,0), C0,12); \
    KRD(GL,2); GAPB(o[0]=__builtin_amdgcn_mfma_f32_32x32x16_bf16(PAF(2),VFR(2),o[0],0,0,0), C1,0); \
    KRD(GL,3); GAPB(o[1]=__builtin_amdgcn_mfma_f32_32x32x16_bf16(PAF(2),VFR(6),o[1],0,0,0), C1,4); \
    GAPB(o[0]=__builtin_amdgcn_mfma_f32_32x32x16_bf16(PAF(3),VFR(3),o[0],0,0,0), C1,8); \
    GAPB(o[1]=__builtin_amdgcn_mfma_f32_32x32x16_bf16(PAF(3),VFR(7),o[1],0,0,0), C1,12); \
    }while(0)
  int t=1;
  #undef CMASK
  #define CMASK(P0,P1,t) do{}while(0)
  for(;t+5<NT;t+=2){
    STEP(pB0,pB1,pA0,pA1,t,true,true,true);     WAIT_BAR(2); RESC(); ROT();
    STEP(pA0,pA1,pB0,pB1,t+1,true,true,true);   WAIT_BAR(2); RESC(); ROT();
  }
  #undef CMASK
  #define CMASK(P0,P1,t) do{int jb_=(t)-(NT-4); if(jb_>=0)cmask(P0,P1,jb_,qrel,hi);}while(0)
  #define ENDW(tt) do{ if((tt)+3<NT){WAIT_BAR(2);} else if((tt)+2<NT){WAIT_BAR(1);} else {WAIT_BAR(0);} }while(0)
  for(;t+1<NT;t+=2){
    STEP(pB0,pB1,pA0,pA1,t,(t+3<NT),(t+1<NT),(t+1<NT));       ENDW(t);   RESC(); ROT();
    STEP(pA0,pA1,pB0,pB1,t+1,(t+4<NT),(t+2<NT),(t+2<NT));     ENDW(t+1); RESC(); ROT();
  }
  STEP(pB0,pB1,pA0,pA1,NT-1,false,false,false); RESC();
  { const unsigned kmp_=0xffffffffu; float sacc=pB0[0]+pB0[1]; _Pragma("unroll") for(int r=2;r<16;++r)sacc+=pB0[r]; _Pragma("unroll") for(int r=0;r<16;++r)sacc+=pB1[r]; l_reg+=sacc;
    pw0=(u32x4){PKW(pB0,0),PKW(pB0,2),PKW(pB0,4),PKW(pB0,6)};pw1=(u32x4){PKW(pB0,8),PKW(pB0,10),PKW(pB0,12),PKW(pB0,14)};pw2=(u32x4){PKW(pB1,0),PKW(pB1,2),PKW(pB1,4),PKW(pB1,6)};pw3=(u32x4){PKW(pB1,8),PKW(pB1,10),PKW(pB1,12),PKW(pB1,14)};
    SBAR(); pv(o,vb0+sl_cur,PAF(0),PAF(1),PAF(2),PAF(3)); }
  #undef PKW
  #undef PAF
  #undef VFR
  #undef PIN
  #undef MX3
  #undef GAPA
  #undef GAPB
  #undef EX
  #undef VRD
  #undef KRD
  #undef STEP
  #undef ENDW
  {auto rr=__builtin_amdgcn_permlane32_swap(__float_as_uint(l_reg),__float_as_uint(l_reg),false,false);l_reg=__uint_as_float(rr[0])+__uint_as_float(rr[1]);}
  if(hi==0)wsf[32+r32]=l_reg;asm volatile("s_waitcnt lgkmcnt(0)":::"memory");
  float rli[16];
  #pragma unroll
  for(int r=0;r<16;++r)rli[r]=__builtin_amdgcn_rcpf(wsf[32+crow(r,hi)]);
  bf16*Ow=O+(rowbase+q0+wid*QBLK)*DM+h*D;
  { bf16*stg=(bf16*)(shm+LDS_OST)+wid*2048;
    #pragma unroll
    for(int r=0;r<16;++r){const int orow=crow(r,hi);
      #pragma unroll
      for(int d0=0;d0<2;++d0)stg[orow*64+d0*32+r32]=__float2bfloat16(o[d0][r]*rli[r]);}
    asm volatile("s_waitcnt lgkmcnt(0)":::"memory");
    #pragma unroll
    for(int i=0;i<4;++i){const int row=i*8+(lane>>3),ch=lane&7; const u32x4 v=*(const u32x4*)(stg+row*64+ch*8); ATTN_STORE16(Ow+(long)row*DM+ch*8,v);} }
  asm volatile("s_waitcnt lgkmcnt(0)\n\ts_barrier":::"memory");
  #undef KEEP
  #undef DMA_K
  #undef DMA_V
  #undef CMASK
  #undef START
  #undef RESC
  #undef ROT
}
constexpr int ATTN_LDS_BYTES=LDS_BYTES;
#undef SBAR
#undef WAIT_BAR
}

constexpr int PH_PER_LAYER = 10, N_PHASES = PH_PER_LAYER * DEPTH;

constexpr int CONV_UNIT_ITEMS = 16, N_CONV_UNITS = (1024 + 2816) / CONV_UNIT_ITEMS;
__device__ __forceinline__ void conv_unit(int wave, int lane, int idx, const float* w_out, const float* ssm_nw, const float* w_up, const float* n2w, bf16* bufa, bf16* bufb, LAS float* scr) {
    for (int it = CONV_UNIT_ITEMS * idx + wave; it < CONV_UNIT_ITEMS * idx + CONV_UNIT_ITEMS; it += NWAVES) {
        if (it < 1024) { const int kb = it >> 5, nb = it & 31; conv_item(w_out, DM, 32 * nb, bufb, DMIX, 32 * nb, 64 * kb, scr, lane, ssm_nw, 512, 1536); }
        else { const int i2 = it - 1024, kb = i2 / (ULD / 32), nb = i2 % (ULD / 32); const int src = ((nb >> 2) & 1) * FFN + 128 * (nb >> 3) + (nb & 3) * 32;
            conv_item(w_up, ULD, src, bufa, DM, 32 * nb, 64 * kb, scr, lane, n2w); }
    }
}

template <int L, int P>
__device__ __forceinline__ void run_phase(Frame& F, const int wave0, const int ph_lo, const int ph_hi) {
    constexpr int l = L, p = P, ph = L * PH_PER_LAYER + P;
    if constexpr ((L > 0 && P == 0) || P == 4 || P == 6 || P == 8) return;
    if (!(ph_lo <= ph && ph < ph_hi)) return;
    {
        const __attribute__((address_space(4))) Args* ap = (const __attribute__((address_space(4))) Args*)__builtin_amdgcn_kernarg_segment_ptr();
        asm volatile("" : "+s"(ap));
        { int t_ = wave0 * 64 + fresh_lane(); asm volatile("" : "+v"(t_)); F.tid = t_; F.lane = t_ & 63; F.wave = __builtin_amdgcn_readfirstlane(t_ >> 6); }
        F.G = gridDim.x; { const int bx = blockIdx.x; F.vcu = (F.G % 8 == 0) ? (bx % 8) * (F.G / 8) + bx / 8 : bx; }
        unsigned char* ws = ap->ws; float* out = ap->out;
        bf16* bufa = (bf16*)(ws + WS_BUFA); bf16* bufb = (bf16*)(ws + WS_BUFB); bf16* xb = (bf16*)(ws + WS_XB); bf16* proj = (bf16*)(ws + WS_PROJ);
        float* smallp = (float*)(ws + WS_SMALLP); float* ssq = (float*)(ws + WS_SSQ);
        switch (p) {
        case 0: {
            LAS float* scr = (LAS float*)(F.lds + F.wave * 16384);
            conv_w_in(F, ap->in[2], ap->in[1], bufa, scr);
            conv_small(F, ap->in[2], ap->in[1], (bf16*)(ws + WS_WSM));
            row_pass0(F, ap->in[0], xb, (float*)(ws + WS_RS));
        } break;
        case 1: {
            const float* rs = (const float*)(ws + WS_RS) + (size_t)(2 * l) * M;
            pg8::Gemm g{xb, bufa, M, PLD, DM, DM}; pg8::StaticOrder S; S.init(M, PLD, F.G, (int)blockIdx.x);
            pg8::EpiProj E{ws, (const float* const __attribute__((address_space(4)))*)ap->in, l};
            pg8::gemm_phase<pg8::EpiProj>(F.lds + RING_OFF, g, S, E, F.tid);
            small_proj(F, xb, (const bf16*)(ws + WS_WSM) + (size_t)(l & 1) * 32 * DM, rs, smallp);
        } break;
        case 2: {
            ksum_pass(F, proj, (float*)(ws + WS_KSUM + (size_t)l * 131072));
            conv_fix(F, proj, (const bf16*)(ws + WS_HALO), ap->in[5] + (size_t)l * 4 * 1536, ap->in[6] + l * 1536, ap->in[11] + (size_t)l * 4 * 1024, ap->in[12] + l * 1024);
        } break;
        case 3: {
            constexpr int QN = 4 + 16 + 64 + N_CONV_UNITS / 8;
            gu32* qheads = (gu32*)(ws + WS_QUEUE) + l * 8 * 64;
            volatile LAS unsigned* MISC = (volatile LAS unsigned*)(F.lds + MISC_OFF);
            const attn_body::bf16* pq = (const attn_body::bf16*)proj; const float* ks = (const float*)(ws + WS_KSUM + (size_t)l * 131072);
            const int x0 = (int)(xb_xcc_id() & 7u);
            for (int hop = 0; hop < 8;) {
                const int x = (x0 + hop) & 7;
                const int tq = wave0 * 64 + fresh_lane();
                __syncthreads();
                if (tq == 0) MISC[0] = __hip_atomic_fetch_add(qheads + x * 64, 1u, RLX_AGENT);
                __syncthreads();
                const int j = (int)MISC[0];
                if (j >= QN) { ++hop; continue; }
#if PROBE_PHASE != -1
                const unsigned long long tu0 = __builtin_amdgcn_s_memrealtime();
                const int u = (j < 4) ? (x * 4 + j) : (j < 20) ? (32 + x * 16 + j - 4) : 160 + x * 64 + j - 20;
#endif
                if (j < 4) mlstm_unit(tq, proj, smallp, ap->in[13] + l * 4, ap->in[14] + l * 4, ap->in[15] + l * 512, x, j, F.lds, (float*)(ws + WS_GSC) + (size_t)(x * 4 + j) * 16 * 656, (l == 0 && x == 0 && j == 0) ? (unsigned long long*)(ws + WS_TS) + 1024 : nullptr);
                else if (j < 20) ssd_unit(tq, proj, smallp, ssq, ap->in[7] + l * 16, ap->in[8] + l * 16, ap->in[9] + l * 16, x, j - 4, F.lds);
                else if (j < 84) { const int idx = j - 20, h = idx & 7, qb = 7 - (idx >> 3);
                    attn_body::attn_unit<8>(tq, x, h, qb, pq + PC_Q, pq + PC_K, pq + PC_V, (attn_body::bf16*)proj + PC_Q, ks, (char*)F.lds); }
                else conv_unit(wave0, tq & 63, x * (N_CONV_UNITS / 8) + j - 84, ap->in[16] + (size_t)l * DMIX * DM, ap->in[10] + l * 1024, ap->in[18] + (size_t)l * DM * ULD, ap->in[17] + l * DM, bufa, bufb, (LAS float*)(F.lds + wave0 * 16384));
#if PROBE_PHASE != -1
                if (l == 0 && wave0 == 0 && fresh_lane() == 0) __hip_atomic_store((unsigned long long*)(ws + WS_TS) + 128 + u, (unsigned long long)(__builtin_amdgcn_s_memrealtime() - tu0), __ATOMIC_RELAXED, __HIP_MEMORY_SCOPE_AGENT);
#endif
            }
        } break;
        case 4: break;
        case 5: {
            pg8::Gemm g{proj, bufb, M, DM, DMIX, PLD}; pg8::StaticOrder S; S.init(M, DM, F.G, (int)blockIdx.x);
            LAS float* ftab = (LAS float*)(F.lds + RING_BYTES);
            { pg8::Unit u0; if (S.next(0, u0)) { const int row = F.tid >> 1; const float* sq = ssq + (size_t)(u0.pm * 256 + row) * 16;
                const f32x4 a0 = *(const f32x4*)sq, a1 = *(const f32x4*)(sq + 4), a2 = *(const f32x4*)(sq + 8), a3 = *(const f32x4*)(sq + 12);
                const float s0 = ((a0[0] + a0[1]) + (a0[2] + a0[3])) + ((a1[0] + a1[1]) + (a1[2] + a1[3])), s1 = ((a2[0] + a2[1]) + (a2[2] + a2[3])) + ((a3[0] + a3[1]) + (a3[2] + a3[3]));
                const float r0 = 1.0f / sqrtf(s0 * (1.0f / 512.0f) + EPS), r1 = 1.0f / sqrtf(s1 * (1.0f / 512.0f) + EPS);
                ftab[F.tid] = (F.tid & 1) ? r1 : r0 / r1; } }
            LDS_WAIT(); __syncthreads();
            pg8::EpiRes E{xb, nullptr, (float*)(ws + WS_RS) + (size_t)(2 * l + 1) * M};
            pg8::gemm_phase<pg8::EpiRes, 1>(F.lds + RING_OFF, g, S, E, F.tid, (const LAS float*)ftab);
        } break;
        case 6: break;
        case 7: {
            pg8::Gemm g{xb, bufa, M, ULD, DM, DM}; pg8::StaticOrder S; S.init(M, ULD, F.G, (int)blockIdx.x);
            pg8::EpiFfn E{proj, (const float*)(ws + WS_RS) + (size_t)(2 * l + 1) * M, ap->in[19] + (size_t)l * 3 * FFN, ap->in[20] + l * FFN, (bf16*)(ws + WS_SIDEA), (bf16*)(ws + WS_SIDEB)};
            pg8::gemm_phase<pg8::EpiFfn>(F.lds + RING_OFF, g, S, E, F.tid);
            {
                const bool half = (F.G == 256); if (!half || blockIdx.x >= 128) { Frame F2 = F; if (half) { F2.vcu = (int)blockIdx.x - 128; F2.G = 128; }
                    conv_plain(F2, ap->in[21] + (size_t)l * FFN * DM, FFN, DM, nullptr, bufb, (LAS float*)(F.lds + F.wave * 16384));
                    if (l + 1 < DEPTH) conv_small(F2, ap->in[2] + (size_t)(l + 1) * DM * P_IN, ap->in[1] + (l + 1) * DM, (bf16*)(ws + WS_WSM) + (size_t)((l + 1) & 1) * 32 * DM); } }
        } break;
        case 8: break;
        case 9: {
            pg8::Gemm g{proj, bufb, M, DM, FFN, FFN}; pg8::StaticOrder S; S.init(M, DM, F.G, (int)blockIdx.x);
            { pg8::Unit u0; for (int i = 0; S.next(i, u0); ++i) ffn_fix(F, proj, (const bf16*)(ws + WS_SIDEA), (const bf16*)(ws + WS_SIDEB), ap->in[19] + (size_t)l * 3 * FFN, ap->in[20] + l * FFN, u0.pm); }
            VM_WAIT(); __syncthreads();
            pg8::EpiRes E{xb, (l + 1 < DEPTH) ? nullptr : out, (float*)(ws + WS_RS) + (size_t)(2 * l + 2) * M};
            pg8::gemm_phase<pg8::EpiRes>(F.lds + RING_OFF, g, S, E, F.tid);
            if (l + 1 < DEPTH) conv_w_in(F, ap->in[2] + (size_t)(l + 1) * DM * P_IN, ap->in[1] + (l + 1) * DM, bufa, (LAS float*)(F.lds + F.wave * 16384));
        } break;
        }
        if (ph + 1 < ph_hi || PROBE_PHASE != -1) { XcdBarrier bar; bar.bar = (unsigned*)(ap->ws + WS_CTL) + CW_BAR; bar.x = xb_xcc_id(); bar.st = (volatile LAS unsigned*)(F.lds + MISC_OFF) + 8; xcd_barrier(bar, wave0 * 64 + fresh_lane()); }
#if PROBE_PHASE != -1
        if (blockIdx.x == 0 && wave0 == 0 && fresh_lane() == 0) { const unsigned long long tnow = __builtin_amdgcn_s_memrealtime();
            __hip_atomic_store((unsigned long long*)(ap->ws + WS_TS) + 1 + ph, tnow, __ATOMIC_RELAXED, __HIP_MEMORY_SCOPE_AGENT);
            if (P == 3 || P == 5 || P == 7 || P == 9) __hip_atomic_store((unsigned long long*)(ap->ws + WS_TS) + 2 + ph, tnow, __ATOMIC_RELAXED, __HIP_MEMORY_SCOPE_AGENT); }
#endif
    }
}

__global__ void __launch_bounds__(NWAVES * 64, 2) fwd(Args args) {
    extern __shared__ __attribute__((aligned(16))) unsigned char lds[];
    Frame F;
    F.lds = (LAS unsigned char*)lds;
    F.tid = threadIdx.x; F.lane = F.tid & 63; F.wave = __builtin_amdgcn_readfirstlane(F.tid >> 6);
    const int wave0 = F.wave;
    for (int u = F.tid; u < (LDS_BYTES - LDSCTL_OFF) / 4; u += NWAVES * 64) ((LAS unsigned*)(F.lds + LDSCTL_OFF))[u] = 0u;
    __syncthreads();
    const int ph_lo = args.ph_lo, ph_hi = args.ph_hi;
#if PROBE_PHASE != -1
    if (blockIdx.x == 0 && F.tid == 0) __hip_atomic_store((unsigned long long*)(args.ws + WS_TS), (unsigned long long)__builtin_amdgcn_s_memrealtime(), __ATOMIC_RELAXED, __HIP_MEMORY_SCOPE_AGENT);
#endif
    if (ph_hi - ph_lo > 1) (void)xcd_barrier_post((unsigned*)(args.ws + WS_CTL) + CW_BAR, (volatile LAS unsigned*)(F.lds + MISC_OFF) + 8);

    run_phase<0, 0>(F, wave0, ph_lo, ph_hi);
    run_phase<0, 1>(F, wave0, ph_lo, ph_hi);
    run_phase<0, 2>(F, wave0, ph_lo, ph_hi);
    run_phase<0, 3>(F, wave0, ph_lo, ph_hi);
    run_phase<0, 4>(F, wave0, ph_lo, ph_hi);
    run_phase<0, 5>(F, wave0, ph_lo, ph_hi);
    run_phase<0, 6>(F, wave0, ph_lo, ph_hi);
    run_phase<0, 7>(F, wave0, ph_lo, ph_hi);
    run_phase<0, 8>(F, wave0, ph_lo, ph_hi);
    run_phase<0, 9>(F, wave0, ph_lo, ph_hi);
    run_phase<1, 0>(F, wave0, ph_lo, ph_hi);
    run_phase<1, 1>(F, wave0, ph_lo, ph_hi);
    run_phase<1, 2>(F, wave0, ph_lo, ph_hi);
    run_phase<1, 3>(F, wave0, ph_lo, ph_hi);
    run_phase<1, 4>(F, wave0, ph_lo, ph_hi);
    run_phase<1, 5>(F, wave0, ph_lo, ph_hi);
    run_phase<1, 6>(F, wave0, ph_lo, ph_hi);
    run_phase<1, 7>(F, wave0, ph_lo, ph_hi);
    run_phase<1, 8>(F, wave0, ph_lo, ph_hi);
    run_phase<1, 9>(F, wave0, ph_lo, ph_hi);
#if PROBE_PHASE != -1
    {
        const __attribute__((address_space(4))) Args* ap = (const __attribute__((address_space(4))) Args*)__builtin_amdgcn_kernarg_segment_ptr();
        const unsigned long long* ts = (const unsigned long long*)(ap->ws + WS_TS);
        float us = 500.f;
#ifdef PROBE_UNIT
        if (true) { us = 0.01f * (float)__hip_atomic_load(ts + PROBE_UNIT, __ATOMIC_RELAXED, __HIP_MEMORY_SCOPE_AGENT); } else
#endif
        if (PROBE_PHASE >= 0) { us = 0.f;
            for (int l = 0; l < DEPTH; ++l) { const int ph = l * PH_PER_LAYER + PROBE_PHASE; if (ph < N_PHASES - 1) us += 0.01f * (float)(__hip_atomic_load(ts + 1 + ph, __ATOMIC_RELAXED, __HIP_MEMORY_SCOPE_AGENT) - __hip_atomic_load(ts + ph, __ATOMIC_RELAXED, __HIP_MEMORY_SCOPE_AGENT)); } }
        const float dl = sqrtf(PROBE_GAIN * us);
        float* o = ap->out;
        for (size_t i = (size_t)blockIdx.x * 512 + wave0 * 64 + fresh_lane(); i < (size_t)M * DM; i += (size_t)gridDim.x * 512) o[i] += (i & 1) ? dl : -dl;
    }
#endif
}

extern "C" void kernel_launch(void* const* d_in, const int* in_sizes, int n_in, void* d_out, int out_size, void* d_ws, size_t ws_size, hipStream_t stream) {
    static int grid = 0;
    if (grid == 0) {
        if (n_in != 22 || in_sizes[0] != M * DM || out_size != M * DM || ws_size < WS_END) { fprintf(stderr, "kernel_launch: unexpected shapes (n_in %d, in0 %d, out %d, ws %zu); nothing launched\n", n_in, n_in > 0 ? in_sizes[0] : -1, out_size, ws_size); grid = -1; return; }
        int dev = 0, cus = 0, per_cu = 0;
        if (hipGetDevice(&dev) != hipSuccess || hipDeviceGetAttribute(&cus, hipDeviceAttributeMultiprocessorCount, dev) != hipSuccess) { grid = -1; return; }
        if (hipFuncSetAttribute((const void*)fwd, hipFuncAttributeMaxDynamicSharedMemorySize, LDS_BYTES) != hipSuccess) { fprintf(stderr, "kernel_launch: hipFuncSetAttribute failed\n"); grid = -1; return; }
        if (hipOccupancyMaxActiveBlocksPerMultiprocessor(&per_cu, (const void*)fwd, NWAVES * 64, LDS_BYTES) != hipSuccess || per_cu < 1) { fprintf(stderr, "kernel_launch: occupancy query reports %d blocks per CU\n", per_cu); per_cu = 1; }
        (void)hipGetLastError();
        grid = cus;
    }
    if (grid < 0) return;
    (void)hipMemsetAsync((char*)d_ws + WS_CTL, 0, CTL_ZERO_BYTES, stream);
    Args a{};
    for (int i = 0; i < 22; ++i) a.in[i] = (const float*)d_in[i];
    a.out = (float*)d_out; a.ws = (unsigned char*)d_ws;
#if MK_MULTI
    for (int ph = 0; ph < N_PHASES; ++ph) {
        a.ph_lo = ph; a.ph_hi = ph + 1;
        hipLaunchKernelGGL(fwd, dim3(grid), dim3(NWAVES * 64), LDS_BYTES, stream, a);
    }
#else
    a.ph_lo = 0; a.ph_hi = N_PHASES;
    hipLaunchKernelGGL(fwd, dim3(grid), dim3(NWAVES * 64), LDS_BYTES, stream, a);
#endif
}
```

```cpp
#include <hip/hip_runtime.h>
#include <hip/hip_bf16.h>
#include <cstdio>
#include <cstdint>
#include <cmath>

#ifndef PROBE_PHASE
#define PROBE_PHASE -1
#endif
#ifndef PROBE_GAIN
#define PROBE_GAIN 1e-6f
#endif
#ifndef MK_MULTI
#define MK_MULTI 0
#endif

constexpr int BATCH = 8, SEQ = 2048, DM = 1024, DEPTH = 2;
constexpr int M = BATCH * SEQ;
constexpr int P_IN = 6168;
constexpr int PLD = 6144;
constexpr int PC_Q = 0, PC_Z = 512, PC_MO = 1536, PC_K = 2048, PC_V = 2560, PC_XBC = 3072, PC_MQK = 4608, PC_MV = 5632;
constexpr int SC_Q = 0, SC_K = 512, SC_V = 1024, SC_Z = 1536, SC_XBC = 2560, SC_DT = 4096, SC_MQK = 4112, SC_MV = 5136, SC_MO = 5648, SC_MI = 6160, SC_MF = 6164;
constexpr int FFN = 2816, ULD = 5632;
constexpr int DMIX = 2048;
constexpr float EPS = 1e-6f;
constexpr float C2 = 0.125f * 1.4426950408889634f;

constexpr size_t MiB = 1u << 20;
constexpr size_t WS_CTL = 0, CTL_ZERO_BYTES = 1 * MiB;
constexpr size_t WS_KSUM = 256 * 1024;
constexpr size_t WS_TS = 800 * 1024;
constexpr size_t WS_RS = 512 * 1024;
constexpr size_t WS_QUEUE = 768 * 1024;
constexpr size_t WS_SMALLP = 1 * MiB;
constexpr size_t WS_SSQ = 3 * MiB - 512 * 1024;
constexpr size_t WS_WSM = 3 * MiB + 512 * 1024;
constexpr size_t WS_BUFA = 4 * MiB;
constexpr size_t WS_BUFB = 16 * MiB;
constexpr size_t WS_XB = 22 * MiB;
constexpr size_t WS_HALO = 54 * MiB;
constexpr size_t WS_GSC = 58 * MiB;
constexpr size_t WS_SIDEA = 54 * MiB;
constexpr size_t WS_SIDEB = 57 * MiB;
static_assert(true, "EpiProj hard-codes WS_PROJ = 64 MiB, WS_HALO = 54 MiB, WS_KSUM = 256 KiB, WS_RS = 512 KiB");
constexpr size_t WS_PROJ = 64 * MiB;
constexpr size_t WS_END = 256 * MiB;

namespace pg8 {
#define PG8_LAS __attribute__((address_space(3)))
typedef unsigned short bf16_t;
typedef short bf16x8 __attribute__((ext_vector_type(8)));
typedef float f32x4 __attribute__((ext_vector_type(4)));
typedef unsigned u32x4 __attribute__((ext_vector_type(4)));
constexpr int BM = 256, BK = 64, HALF = 128, HTB = HALF * BK * 2, STAGE_BYTES = 8 * HTB, NXCD = 8, WGM = 8;

__host__ __device__ __forceinline__ int lds_byte(int r, int c) { const int st = (r >> 4) * 2 + (c >> 5), rr = r & 15, cc = c & 31, ob = rr * 64 + cc * 2; return st * 1024 + (ob ^ (((ob >> 9) & 1) << 5)); }
__host__ __device__ __forceinline__ void stage_rc(int b, int& R, int& C) { const int st = b / 1024, sb = b % 1024, swz = sb ^ (((sb >> 9) & 1) << 5); R = (st >> 1) * 16 + swz / 64; C = (st & 1) * 32 + (swz % 64) / 2; }
__host__ __device__ __forceinline__ int perm32(int rho) { const int n = rho >> 4, i = rho & 15; return 8 * (i >> 2) + 4 * n + (i & 3); }

struct Unit { int pm, pn; };
struct Gemm { const bf16_t* A; const bf16_t* Bt; int M, N, K, lda; };

struct StaticOrder {
    int nM, nN, nwg, G, c;
    __host__ __device__ void init(int M_, int N_, int G_, int c_) { nM = M_ / BM; nN = N_ / BM; nwg = nM * nN; G = G_; c = c_; }
    __host__ __device__ bool next(int i, Unit& u) const {
        const long L = (long)i * G + c; if (L >= nwg) return false;
        int wgid = (int)L; { const int q = nwg / NXCD, r = nwg % NXCD, xcd = wgid % NXCD, off = wgid / NXCD; wgid = (xcd < r ? xcd * (q + 1) : r * (q + 1) + (xcd - r) * q) + off; }
        const int nig = WGM * nN, gid = wgid / nig, fm = gid * WGM, gsz = (nM - fm) < WGM ? (nM - fm) : WGM;
        u.pm = fm + ((wgid % nig) % gsz); u.pn = (wgid % nig) / gsz; return true;
    }
};

typedef float f32x2p __attribute__((ext_vector_type(2))); typedef __bf16 bf16x2p __attribute__((ext_vector_type(2)));
__device__ __forceinline__ unsigned cvt_pk_bf16(float lo, float hi) { const f32x2p v = {lo, hi}; return __builtin_bit_cast(unsigned, __builtin_convertvector(v, bf16x2p)); }

struct EpiBf16 {
    static constexpr bool PERM = true; static constexpr bool ROWPERM = false;
    bf16_t* O; int ldc;
    __device__ __forceinline__ void operator()(const f32x4 (&acc)[2][2][4][2], const Unit& u, int wr, int wc, int fr, int fq) const {
        const int row0 = u.pm * BM + wr * 64 + fr; const int col0 = u.pn * BM + wc * 32 + 8 * fq;
#pragma unroll
        for (int ai = 0; ai < 2; ++ai)
#pragma unroll
            for (int m = 0; m < 4; ++m) { bf16_t* rowp = O + (size_t)(row0 + ai * HALF + m * 16) * ldc + col0;
#pragma unroll
                for (int bj = 0; bj < 2; ++bj) { const f32x4 v0 = acc[ai][bj][m][0], v1 = acc[ai][bj][m][1];
                    u32x4 w; w.x = cvt_pk_bf16(v0[0], v0[1]); w.y = cvt_pk_bf16(v0[2], v0[3]); w.z = cvt_pk_bf16(v1[0], v1[1]); w.w = cvt_pk_bf16(v1[2], v1[3]);
                    *(u32x4*)(rowp + bj * HALF) = w; } }
    }
};
__device__ __forceinline__ float row_prev(float prevblk, float cur, int n  ) {
    const int pb = __float_as_int(prevblk), cu = __float_as_int(cur);
    const int o = (n == 1) ? __builtin_amdgcn_update_dpp(0, pb, 0x121, 0xf, 0xf, false) : (n == 2) ? __builtin_amdgcn_update_dpp(0, pb, 0x122, 0xf, 0xf, false) : __builtin_amdgcn_update_dpp(0, pb, 0x123, 0xf, 0xf, false);
    return __int_as_float((n == 1) ? __builtin_amdgcn_update_dpp(o, cu, 0x111, 0xf, 0xf, false) : (n == 2) ? __builtin_amdgcn_update_dpp(o, cu, 0x112, 0xf, 0xf, false) : __builtin_amdgcn_update_dpp(o, cu, 0x113, 0xf, 0xf, false));
}
struct EpiProj {
    static constexpr bool PERM = true; static constexpr bool ROWPERM = true;
    unsigned char* ws; const float* const __attribute__((address_space(4)))* in; int l;
    __device__ __forceinline__ void operator()(const f32x4 (&acc)[2][2][4][2], const Unit& u, int wr, int wc, int fr, int fq) const {
        bf16_t* P = (bf16_t*)(ws + (size_t)64 * 1048576); bf16_t* halo = (bf16_t*)(ws + (size_t)54 * 1048576);
        const float* rs = (const float*)(ws + 524288) + (size_t)(2 * l) * 16384;
        const float* qw = in[3] + l * 64; const float* kw = in[4] + l * 64;
        const float* scw = in[5] + (size_t)l * 4 * 1536; const float* scb = in[6] + l * 1536; const float* mcw = in[11] + (size_t)l * 4 * 1024; const float* mcb = in[12] + l * 1024;
        const int pn = u.pn; const bool isq = pn < 2, isk = (pn == 8 || pn == 9);
        const int row0 = u.pm * BM + wr * 64 + 4 * fr;
        float rr[2][4];
#pragma unroll
        for (int ai = 0; ai < 2; ++ai) { const f32x4 t = *(const f32x4*)(rs + row0 + ai * HALF);
#pragma unroll
            for (int m = 0; m < 4; ++m) rr[ai][m] = 1.0f / sqrtf(t[m] * (1.0f / 1024.0f) + EPS); }
        if (pn >= 12 && pn < 22) {
            const int col0 = pn * BM + wc * 32 + 8 * fq;
            const bool ssm = pn < 18; const float post = (pn >= 20) ? 0.08838834764831845f : 1.0f; const int wst = ssm ? 1536 : 1024;
#pragma unroll
            for (int bj = 0; bj < 2; ++bj) {
                const int hch = col0 + bj * HALF - PC_XBC; const float* wp = ssm ? (scw + hch) : (mcw + (hch - 1536)); const float* bp = ssm ? (scb + hch) : (mcb + (hch - 1536));
                f32x4 cwv[4][2], cbv[2];
#pragma unroll
                for (int j = 0; j < 4; ++j) { cwv[j][0] = *(const f32x4*)(wp + j * wst); cwv[j][1] = *(const f32x4*)(wp + j * wst + 4); }
                cbv[0] = *(const f32x4*)bp; cbv[1] = *(const f32x4*)(bp + 4);
#pragma unroll
                for (int ai = 0; ai < 2; ++ai) {
                    u32x4 cv[4], raw[4];
#pragma unroll
                    for (int n = 0; n < 2; ++n)
#pragma unroll
                        for (int i2 = 0; i2 < 2; ++i2) { float y[4][2], g[4][2];
#pragma unroll
                            for (int e = 0; e < 2; ++e) { const int i = 2 * i2 + e;
#pragma unroll
                                for (int m = 0; m < 4; ++m) g[m][e] = acc[ai][bj][m][n][i] * rr[ai][m];
                                const float p1 = __int_as_float(__builtin_amdgcn_update_dpp(0, __float_as_int(g[3][e]), 0x111, 0xf, 0xf, true)), p2 = __int_as_float(__builtin_amdgcn_update_dpp(0, __float_as_int(g[2][e]), 0x111, 0xf, 0xf, true)),
                                            p3 = __int_as_float(__builtin_amdgcn_update_dpp(0, __float_as_int(g[1][e]), 0x111, 0xf, 0xf, true));
                                const float c0_ = cwv[0][n][i], c1_ = cwv[1][n][i], c2_ = cwv[2][n][i], c3_ = cwv[3][n][i], cb_ = cbv[n][i];
                                y[0][e] = cb_ + c0_ * p3 + c1_ * p2 + c2_ * p1 + c3_ * g[0][e];
                                y[1][e] = cb_ + c0_ * p2 + c1_ * p1 + c2_ * g[0][e] + c3_ * g[1][e];
                                y[2][e] = cb_ + c0_ * p1 + c1_ * g[0][e] + c2_ * g[1][e] + c3_ * g[2][e];
                                y[3][e] = cb_ + c0_ * g[0][e] + c1_ * g[1][e] + c2_ * g[2][e] + c3_ * g[3][e];
#pragma unroll
                                for (int m = 0; m < 4; ++m) y[m][e] = y[m][e] * __builtin_amdgcn_rcpf(1.0f + __builtin_amdgcn_exp2f(-1.4426950408889634f * y[m][e])) * post; }
#pragma unroll
                            for (int m = 0; m < 4; ++m) { cv[m][2 * n + i2] = cvt_pk_bf16(y[m][0], y[m][1]); raw[m][2 * n + i2] = cvt_pk_bf16(g[m][0], g[m][1]); } }
#pragma unroll
                    for (int m = 0; m < 4; ++m) { const int row = row0 + ai * HALF + m;
                        *(u32x4*)(P + (size_t)row * PLD + col0 + bj * HALF) = (m < 3 && fr == 0) ? raw[m] : cv[m];
                        if (m >= 1 && fr == 15) *(u32x4*)(halo + ((size_t)((row >> 6) * 3 + m - 1) * 2560 + hch)) = raw[m]; }
                }
            }
        } else if (!(isq || isk)) {
            const int col0 = pn * BM + wc * 32 + 8 * fq;
#pragma unroll
            for (int ai = 0; ai < 2; ++ai)
#pragma unroll
                for (int m = 0; m < 4; ++m) { bf16_t* rowp = P + (size_t)(row0 + ai * HALF + m) * PLD + col0;
#pragma unroll
                    for (int bj = 0; bj < 2; ++bj) { const f32x4 v0 = acc[ai][bj][m][0] * rr[ai][m], v1 = acc[ai][bj][m][1] * rr[ai][m];
                        u32x4 w; w.x = cvt_pk_bf16(v0[0], v0[1]); w.y = cvt_pk_bf16(v0[2], v0[3]); w.z = cvt_pk_bf16(v1[0], v1[1]); w.w = cvt_pk_bf16(v1[2], v1[3]);
                        *(u32x4*)(rowp + bj * HALF) = w;
                    } }
        } else {
            const float* w = isq ? qw : kw; const float post = isq ? C2 : 1.0f;
            const int colb = pn * BM + 64 * wc + 8 * fq;
#pragma unroll
            for (int ai = 0; ai < 2; ++ai)
#pragma unroll
                for (int m = 0; m < 4; ++m) {
                    float ss = 0.f;
#pragma unroll
                    for (int bj = 0; bj < 2; ++bj)
#pragma unroll
                        for (int n = 0; n < 2; ++n) { const f32x4 x = acc[ai][bj][m][n] * rr[ai][m]; ss += (x[0] * x[0] + x[1] * x[1]) + (x[2] * x[2] + x[3] * x[3]); }
                    ss += __shfl_xor(ss, 16); ss += __shfl_xor(ss, 32);
                    const float r = (1.0f / sqrtf(ss * (1.0f / 64.0f) + EPS)) * post * rr[ai][m];
                    bf16_t* rowp = P + (size_t)(row0 + ai * HALF + m) * PLD + colb;
#pragma unroll
                    for (int bj = 0; bj < 2; ++bj) { const f32x4 w0 = *(const f32x4*)(w + 32 * bj + 8 * fq), w1 = *(const f32x4*)(w + 32 * bj + 8 * fq + 4);
                        const f32x4 v0 = acc[ai][bj][m][0] * r * w0, v1 = acc[ai][bj][m][1] * r * w1;
                        u32x4 o; o.x = cvt_pk_bf16(v0[0], v0[1]); o.y = cvt_pk_bf16(v0[2], v0[3]); o.z = cvt_pk_bf16(v1[0], v1[1]); o.w = cvt_pk_bf16(v1[2], v1[3]);
                        *(u32x4*)(rowp + 32 * bj) = o; }
                    asm volatile("" ::: "memory");
                }
        }
    }
};
struct EpiRes {
    static constexpr bool PERM = true; static constexpr bool ROWPERM = false;
    bf16_t* xb; float* out; float* rs;
    __device__ __forceinline__ void operator()(const f32x4 (&acc)[2][2][4][2], const Unit& u, int wr, int wc, int fr, int fq) const {
        const int row0 = u.pm * BM + wr * 64 + fr, col0 = u.pn * BM + wc * 32 + 8 * fq;
#pragma unroll
        for (int ai = 0; ai < 2; ++ai)
#pragma unroll
            for (int m = 0; m < 4; ++m) { const int row = row0 + ai * HALF + m * 16; const size_t off = (size_t)row * 1024 + col0; float ss = 0.f;
#pragma unroll
                for (int bj = 0; bj < 2; ++bj) { const u32x4 bw = *(const u32x4*)(xb + off + bj * HALF);
                    f32x4 v0 = acc[ai][bj][m][0], v1 = acc[ai][bj][m][1];
                    v0[0] += __uint_as_float(bw.x << 16); v0[1] += __uint_as_float(bw.x & 0xffff0000u); v0[2] += __uint_as_float(bw.y << 16); v0[3] += __uint_as_float(bw.y & 0xffff0000u);
                    v1[0] += __uint_as_float(bw.z << 16); v1[1] += __uint_as_float(bw.z & 0xffff0000u); v1[2] += __uint_as_float(bw.w << 16); v1[3] += __uint_as_float(bw.w & 0xffff0000u);
                    if (out) { *(f32x4*)(out + off + bj * HALF) = v0; *(f32x4*)(out + off + bj * HALF + 4) = v1; }
                    else { ss += ((v0[0] * v0[0] + v0[1] * v0[1]) + (v0[2] * v0[2] + v0[3] * v0[3])) + ((v1[0] * v1[0] + v1[1] * v1[1]) + (v1[2] * v1[2] + v1[3] * v1[3]));
                        u32x4 w; w.x = cvt_pk_bf16(v0[0], v0[1]); w.y = cvt_pk_bf16(v0[2], v0[3]); w.z = cvt_pk_bf16(v1[0], v1[1]); w.w = cvt_pk_bf16(v1[2], v1[3]);
                        *(u32x4*)(xb + off + bj * HALF) = w; } }
                if (!out) { ss += __shfl_xor(ss, 16); ss += __shfl_xor(ss, 32); if (fq == 0) atomicAdd(rs + row, ss); }
                asm volatile("" ::: "memory"); }
    }
};
struct EpiScaleBf16 {
    static constexpr bool PERM = true; static constexpr bool ROWPERM = false;
    bf16_t* O; int ldc; const float* rs;
    __device__ __forceinline__ void operator()(const f32x4 (&acc)[2][2][4][2], const Unit& u, int wr, int wc, int fr, int fq) const {
        const int row0 = u.pm * BM + wr * 64 + fr; const int col0 = u.pn * BM + wc * 32 + 8 * fq;
        float rr[2][4];
#pragma unroll
        for (int ai = 0; ai < 2; ++ai)
#pragma unroll
            for (int m = 0; m < 4; ++m) rr[ai][m] = rs[row0 + ai * HALF + m * 16];
#pragma unroll
        for (int ai = 0; ai < 2; ++ai)
#pragma unroll
            for (int m = 0; m < 4; ++m) { bf16_t* rowp = O + (size_t)(row0 + ai * HALF + m * 16) * ldc + col0; const float r = 1.0f / sqrtf(rr[ai][m] * (1.0f / 1024.0f) + EPS);
#pragma unroll
                for (int bj = 0; bj < 2; ++bj) { const f32x4 v0 = acc[ai][bj][m][0] * r, v1 = acc[ai][bj][m][1] * r;
                    u32x4 w; w.x = cvt_pk_bf16(v0[0], v0[1]); w.y = cvt_pk_bf16(v0[2], v0[3]); w.z = cvt_pk_bf16(v1[0], v1[1]); w.w = cvt_pk_bf16(v1[2], v1[3]);
                    *(u32x4*)(rowp + bj * HALF) = w; } }
    }
};

typedef float f32x2q __attribute__((ext_vector_type(2)));
__device__ __forceinline__ f32x2q gelu_pk2(f32x2q v) {
    const f32x2q av = __builtin_elementwise_abs(v), d = av * 0.2316418882f + 1.0f;
    f32x2q t; t.x = __builtin_amdgcn_rcpf(d.x); t.y = __builtin_amdgcn_rcpf(d.y);
    f32x2q q = t * 0.5307027145f + (-0.7265760135f); q = q * t + 0.7107068705f; q = q * t + (-0.142248368f); q = q * t + 0.127414796f; q = q * t;
    const f32x2q s = (v * v) * (-0.72134752044f);
    f32x2q e; e.x = __builtin_amdgcn_exp2f(s.x); e.y = __builtin_amdgcn_exp2f(s.y);
    const f32x2q m = v * (q * e), r = v - m;
    f32x2q o; o.x = v.x < 0.f ? m.x : r.x; o.y = v.y < 0.f ? m.y : r.y; return o;
}
struct EpiFfn {
    static constexpr bool PERM = true; static constexpr bool ROWPERM = true;
    bf16_t* H; const float* rs; const float* cw  ; const float* cb; bf16_t* sideA  ; bf16_t* sideB  ;
    __device__ __forceinline__ void operator()(const f32x4 (&acc)[2][2][4][2], const Unit& u, int wr, int wc, int fr, int fq) const {
        constexpr int FF = 2816;
        const int row0 = u.pm * BM + wr * 64 + 4 * fr, c0 = u.pn * 128 + wc * 32 + 8 * fq;
        float rr[2][4];
#pragma unroll
        for (int ai = 0; ai < 2; ++ai) { const f32x4 t = *(const f32x4*)(rs + row0 + ai * HALF);
#pragma unroll
            for (int m = 0; m < 4; ++m) rr[ai][m] = 1.0f / sqrtf(t[m] * (1.0f / 1024.0f) + EPS); }
        f32x4 w0[2], w1[2], w2[2], bb[2];
#pragma unroll
        for (int n = 0; n < 2; ++n) { w0[n] = *(const f32x4*)(cw + c0 + 4 * n); w1[n] = *(const f32x4*)(cw + FF + c0 + 4 * n); w2[n] = *(const f32x4*)(cw + 2 * FF + c0 + 4 * n); bb[n] = *(const f32x4*)(cb + c0 + 4 * n); }
#pragma unroll
        for (int ai = 0; ai < 2; ++ai) {
            u32x4 hw[4], gw[4], vw[2];
#pragma unroll
            for (int n = 0; n < 2; ++n)
#pragma unroll
                for (int i2 = 0; i2 < 2; ++i2) { f32x2q x[4]; float g[4][2], v[4][2];
#pragma unroll
                    for (int e = 0; e < 2; ++e) { const int i = 2 * i2 + e;
#pragma unroll
                        for (int m = 0; m < 4; ++m) { g[m][e] = acc[ai][0][m][n][i] * rr[ai][m]; v[m][e] = acc[ai][1][m][n][i] * rr[ai][m]; }
                        const float p1 = __int_as_float(__builtin_amdgcn_update_dpp(0, __float_as_int(g[3][e]), 0x111, 0xf, 0xf, true)), p2 = __int_as_float(__builtin_amdgcn_update_dpp(0, __float_as_int(g[2][e]), 0x111, 0xf, 0xf, true));
                        const float a0 = w0[n][i], a1 = w1[n][i], a2 = w2[n][i], b_ = bb[n][i];
                        x[0][e] = b_ + a0 * p2 + a1 * p1 + a2 * g[0][e];
                        x[1][e] = b_ + a0 * p1 + a1 * g[0][e] + a2 * g[1][e];
                        x[2][e] = b_ + a0 * g[0][e] + a1 * g[1][e] + a2 * g[2][e];
                        x[3][e] = b_ + a0 * g[1][e] + a1 * g[2][e] + a2 * g[3][e]; }
#pragma unroll
                    for (int m = 0; m < 4; ++m) { const f32x2q ge = gelu_pk2(x[m]);
                        hw[m][2 * n + i2] = cvt_pk_bf16(ge.x * v[m][0], ge.y * v[m][1]); gw[m][2 * n + i2] = cvt_pk_bf16(g[m][0], g[m][1]);
                        if (m < 2) vw[m][2 * n + i2] = cvt_pk_bf16(v[m][0], v[m][1]); } }
#pragma unroll
            for (int m = 0; m < 4; ++m) { const int row = row0 + ai * HALF + m;
                *(u32x4*)(H + (size_t)row * FF + c0) = hw[m];
                if (m >= 2 && fr == 15) *(u32x4*)(sideA + ((size_t)(row >> 6) * 2 + (m - 2)) * FF + c0) = gw[m];
                if (m < 2 && fr == 0) { bf16_t* sb = sideB + ((size_t)(row >> 6) * 2 + m) * 2 * FF + c0; *(u32x4*)sb = gw[m]; *(u32x4*)(sb + FF) = vw[m]; } }
        }
    }
};

#define PG8_KT(i) (KMODE ? ((i) < 16 ? (i) + 8 : ((i) < 24 ? (i) - 16 : (i))) : (i))
template <class Epi, int KMODE = 0>
__device__ __forceinline__ void gemm_phase(PG8_LAS unsigned char* lds, const Gemm g, const StaticOrder& S, const Epi& E, int tid_, const PG8_LAS float* ftab = nullptr) {
    asm volatile("" : "+v"(tid_));
    const int tid = tid_, wid = __builtin_amdgcn_readfirstlane(tid >> 6), lane = tid & 63, wr = wid >> 2, wc = wid & 3, fr = lane & 15, fq = lane >> 4;
    const int K = g.K, nt = K / BK, lda = g.lda;
    unsigned voffA[2], voffB[2];
#pragma unroll
    for (int i = 0; i < 2; ++i) { int R, C; stage_rc(tid * 16 + i * 8192, R, C); const int Rb = Epi::PERM ? ((R & ~31) + perm32(R & 31)) : R;
        const int Ra = Epi::ROWPERM ? ((R & ~63) + 4 * (R & 15) + ((R >> 4) & 3)) : R;
        voffA[i] = (unsigned)(Ra * lda + C) * 2u; voffB[i] = (unsigned)(Rb * K + C) * 2u; }
    const size_t kstep = (size_t)(BK * 2);
    const size_t hstepA = (size_t)HALF * lda * 2, hstepB = (size_t)HALF * K * 2;
    const size_t tstepA = 2 * hstepA, tstepB = 2 * hstepB;
    const unsigned ldsw = (unsigned)wid * 1024u;
    const int aoff = lds_byte(wr * 64 + fr, fq * 8), boff = lds_byte(wc * 32 + fr, fq * 8);
#define PG8_SA(b, h) (((b) * 2 + (h)) * HTB)
#define PG8_SB(b, h) ((4 + (b) * 2 + (h)) * HTB)
#define PG8_STAGE(bufoff, gbase, voff) do { _Pragma("unroll") for (int _i = 0; _i < 2; ++_i) \
        __builtin_amdgcn_global_load_lds((const unsigned*)((const char*)(gbase) + (voff)[_i]), (PG8_LAS unsigned*)(lds + (bufoff) + ldsw + _i * 8192), 16, 0, 0); } while (0)
#define PG8_LDA(dst, b, h) do { _Pragma("unroll") for (int m = 0; m < 4; ++m) _Pragma("unroll") for (int k = 0; k < 2; ++k) dst[m][k] = *(const PG8_LAS bf16x8*)(lds + PG8_SA(b, h) + aoff + m * 2048 + k * 1024); } while (0)
#define PG8_LDB(dst, b, h) do { _Pragma("unroll") for (int n = 0; n < 2; ++n) _Pragma("unroll") for (int k = 0; k < 2; ++k) dst[n][k] = *(const PG8_LAS bf16x8*)(lds + PG8_SB(b, h) + boff + n * 2048 + k * 1024); } while (0)
#define PG8_MMA(ai, bj, At, Bt) do { __builtin_amdgcn_s_setprio(1); _Pragma("unroll") for (int m = 0; m < 4; ++m) _Pragma("unroll") for (int n = 0; n < 2; ++n) _Pragma("unroll") for (int k = 0; k < 2; ++k) \
        acc[ai][bj][m][n] = __builtin_amdgcn_mfma_f32_16x16x32_bf16(Bt[n][k], At[m][k], acc[ai][bj][m][n], 0, 0, 0); __builtin_amdgcn_s_setprio(0); } while (0)
#define PG8_WAIT_V(n) asm volatile("s_waitcnt vmcnt(" #n ")" ::: "memory")
#define PG8_WAIT_L(n) asm volatile("s_waitcnt lgkmcnt(" #n ")" ::: "memory")
#define PG8_BAR __builtin_amdgcn_s_barrier()
#define PG8_SCHED __builtin_amdgcn_sched_barrier(0)
    Unit cur, nxt; int ui = 0;
    if (!S.next(0, cur)) return;
    f32x4 acc[2][2][4][2];
#pragma unroll
    for (int a = 0; a < 2; ++a)
#pragma unroll
        for (int b = 0; b < 2; ++b)
#pragma unroll
            for (int m = 0; m < 4; ++m)
#pragma unroll
                for (int n = 0; n < 2; ++n) acc[a][b][m][n] = (f32x4){0.f, 0.f, 0.f, 0.f};
    bf16x8 At[4][2], B0[2][2], B1[2][2];
    const char* cA = (const char*)g.A + (size_t)cur.pm * tstepA; const char* cB = (const char*)g.Bt + (size_t)cur.pn * tstepB;
    { const char* cA0 = cA + (size_t)PG8_KT(0) * kstep; const char* cB0 = cB + (size_t)PG8_KT(0) * kstep;
    PG8_STAGE(PG8_SB(0, 0), cB0, voffB); PG8_STAGE(PG8_SB(0, 1), cB0 + hstepB, voffB); PG8_STAGE(PG8_SA(0, 0), cA0, voffA); PG8_STAGE(PG8_SA(0, 1), cA0 + hstepA, voffA);
    if (wr == 1) PG8_BAR;
    PG8_WAIT_V(2); PG8_BAR;
    PG8_STAGE(PG8_SB(1, 0), cB0 + kstep, voffB); PG8_STAGE(PG8_SA(1, 0), cA0 + kstep, voffA); PG8_STAGE(PG8_SB(1, 1), cB0 + hstepB + kstep, voffB);
    PG8_WAIT_V(6); PG8_BAR; }
    for (;;) {
        const bool has_next = S.next(ui + 1, nxt);
        const char* nA = has_next ? (const char*)g.A + (size_t)nxt.pm * tstepA : cA; const char* nB = has_next ? (const char*)g.Bt + (size_t)nxt.pn * tstepB : cB;
        for (int t = 0; t < nt; t += 2) {
            const bool last = (t == nt - 2);
            const char* a1 = cA + (size_t)PG8_KT(t + 1) * kstep;
            const char* a2 = last ? nA + (size_t)PG8_KT(0) * kstep : cA + (size_t)PG8_KT(t + 2) * kstep; const char* b2 = last ? nB + (size_t)PG8_KT(0) * kstep : cB + (size_t)PG8_KT(t + 2) * kstep;
            const char* a3 = a2 + kstep; const char* b3 = b2 + kstep;
            PG8_LDB(B0, 0, 0); PG8_LDB(B1, 0, 1); PG8_SCHED; PG8_LDA(At, 0, 0); PG8_STAGE(PG8_SA(1, 1), a1 + hstepA, voffA);
            PG8_WAIT_V(8); PG8_WAIT_L(0); PG8_BAR; PG8_MMA(0, 0, At, B0); PG8_MMA(0, 1, At, B1); PG8_BAR; PG8_SCHED;
            PG8_LDA(At, 0, 1); PG8_STAGE(PG8_SB(0, 0), b2, voffB); PG8_STAGE(PG8_SB(0, 1), b2 + hstepB, voffB); PG8_STAGE(PG8_SA(0, 0), a2, voffA);
            PG8_WAIT_V(8); PG8_WAIT_L(0); PG8_BAR; PG8_MMA(1, 0, At, B0); PG8_MMA(1, 1, At, B1); PG8_BAR; PG8_SCHED;
            PG8_LDB(B0, 1, 0); PG8_LDB(B1, 1, 1); PG8_SCHED; PG8_LDA(At, 1, 0); PG8_STAGE(PG8_SA(0, 1), a2 + hstepA, voffA);
            PG8_WAIT_V(8); PG8_WAIT_L(0); PG8_BAR; PG8_MMA(0, 0, At, B0); PG8_MMA(0, 1, At, B1); PG8_BAR; PG8_SCHED;
            PG8_LDA(At, 1, 1); PG8_STAGE(PG8_SB(1, 0), b3, voffB); PG8_STAGE(PG8_SB(1, 1), b3 + hstepB, voffB); PG8_STAGE(PG8_SA(1, 0), a3, voffA);
            PG8_WAIT_V(8); PG8_WAIT_L(0); PG8_BAR; PG8_MMA(1, 0, At, B0); PG8_MMA(1, 1, At, B1); PG8_BAR; PG8_SCHED;
            if (KMODE == 1 && (t == 6 || t == 14)) {
                const int wh = (t == 14) ? 1 : 0;
#pragma unroll
                for (int ai = 0; ai < 2; ++ai)
#pragma unroll
                    for (int m = 0; m < 4; ++m) { const float f = ftab[(ai * HALF + wr * 64 + m * 16 + fr) * 2 + wh];
#pragma unroll
                        for (int bj = 0; bj < 2; ++bj)
#pragma unroll
                            for (int n = 0; n < 2; ++n) acc[ai][bj][m][n] *= f; }
                PG8_SCHED;
            }
        }
        if (wr == 0) PG8_BAR;
        E(acc, cur, wr, wc, fr, fq);
        if (!has_next) break;
#pragma unroll
        for (int a = 0; a < 2; ++a)
#pragma unroll
            for (int b = 0; b < 2; ++b)
#pragma unroll
                for (int m = 0; m < 4; ++m)
#pragma unroll
                    for (int n = 0; n < 2; ++n) acc[a][b][m][n] = (f32x4){0.f, 0.f, 0.f, 0.f};
        cur = nxt; cA = nA; cB = nB; ++ui;
        if (wr == 1) PG8_BAR;
    }
    PG8_WAIT_V(0);
    PG8_BAR;
#undef PG8_SA
#undef PG8_SB
#undef PG8_STAGE
#undef PG8_LDA
#undef PG8_LDB
#undef PG8_MMA
#undef PG8_WAIT_V
#undef PG8_WAIT_L
#undef PG8_BAR
#undef PG8_SCHED
}
}

constexpr int NWAVES = 8;
constexpr int RING_OFF = 0, RING_BYTES = 131072;
constexpr int LDS_BYTES = 147456;
constexpr int LDSCTL_OFF = LDS_BYTES - 512, MISC_OFF = LDSCTL_OFF + 320;
constexpr int CW_BAR = 4096;

#define GAS __attribute__((address_space(1)))
#define LAS __attribute__((address_space(3)))
typedef unsigned short bf16;
typedef unsigned v4u __attribute__((ext_vector_type(4)));
typedef float f32x4 __attribute__((ext_vector_type(4)));
typedef GAS unsigned gu32;
#define RLX_AGENT __ATOMIC_RELAXED, __HIP_MEMORY_SCOPE_AGENT
#define LDS_WAIT() asm volatile("s_waitcnt lgkmcnt(0)" ::: "memory")
#define VM_WAIT() asm volatile("s_waitcnt vmcnt(0)" ::: "memory")
__device__ __forceinline__ unsigned f2bf(float f) { unsigned u = __builtin_bit_cast(unsigned, f); return (u + 0x7fffu + ((u >> 16) & 1u)) >> 16; }
typedef float f32x2_ __attribute__((ext_vector_type(2))); typedef __bf16 bf16x2_ __attribute__((ext_vector_type(2)));
__device__ __forceinline__ unsigned pk2(float lo, float hi) { const f32x2_ v = {lo, hi}; return __builtin_bit_cast(unsigned, __builtin_convertvector(v, bf16x2_)); }
__device__ __forceinline__ float bf2f(unsigned short b) { return __uint_as_float(((unsigned)b) << 16); }

#define XB_TMO      128
#define XB_XCNT(j)  (256  + 64 * (j))
#define XB_XSUB(j)  (1280 + 64 * (j))
#define XB_XGEN(j)  (2304 + 64 * (j))
#define XB_TOP      3328
#define XB_TOPGEN   3392
#define XCD_BAR_WORDS 3456
#define XB_SPIN_CAP (1u << 18)
__device__ __forceinline__ unsigned xb_ld(unsigned* p)              { return __hip_atomic_load(p, __ATOMIC_RELAXED, __HIP_MEMORY_SCOPE_AGENT); }
__device__ __forceinline__ unsigned xb_add(unsigned* p, unsigned v) { return __hip_atomic_fetch_add(p, v, __ATOMIC_RELAXED, __HIP_MEMORY_SCOPE_AGENT); }
__device__ __forceinline__ unsigned xb_xcc_id() { return (unsigned)__builtin_amdgcn_s_getreg((3 << 11) | 20) & 0xFu; }
#define XB_SPIN(cond, bar) do { unsigned _sp = 0; while (cond) { __builtin_amdgcn_s_sleep(1); \
    if ((++_sp & 255u) == 0u) { if (xb_ld(&(bar)[XB_TMO])) break; if (_sp > XB_SPIN_CAP) { atomicAdd(&(bar)[XB_TMO], 1u); break; } } } } while (0)
struct XcdBarrier { unsigned* bar; unsigned x; volatile LAS unsigned* st; };
__device__ __forceinline__ XcdBarrier xcd_barrier_post(unsigned* bar, volatile LAS unsigned* st) {
    XcdBarrier b; b.bar = bar; b.x = xb_xcc_id(); b.st = st;
    if (threadIdx.x == 0) (void)xb_add(&bar[XB_XCNT(b.x)], 1u);
    return b;
}
__device__ __forceinline__ void xcd_barrier_complete(unsigned* bar, unsigned x, unsigned& nloc, unsigned& nx) {
    const unsigned G = gridDim.x * gridDim.y * gridDim.z;
    unsigned sum, cnt, mine, sp = 0u;
    for (;;) {
        sum = 0u; cnt = 0u; mine = 0u;
#pragma unroll
        for (unsigned j = 0; j < 16; ++j) { const unsigned c = xb_ld(&bar[XB_XCNT(j)]); sum += c; cnt += (c > 0u) ? 1u : 0u; mine = (j == x) ? c : mine; }
        if (sum == G) break;
        __builtin_amdgcn_s_sleep(1);
        if ((++sp & 255u) == 0u) { if (xb_ld(&bar[XB_TMO])) break; if (sp > XB_SPIN_CAP) { atomicAdd(&bar[XB_TMO], 1u); break; } }
    }
    nloc = mine > 0u ? mine : 1u; nx = cnt > 0u ? cnt : 1u;
}
__device__ __forceinline__ void xcd_barrier(const XcdBarrier& b, int tid) {
    asm volatile("s_waitcnt vmcnt(0)" ::: "memory");
    __syncthreads();
    if (tid == 0) {
        unsigned* bar = b.bar;
        __builtin_amdgcn_s_waitcnt(0);
        unsigned nloc = b.st[0], nx = b.st[1];
        if (nloc == 0u) { xcd_barrier_complete(bar, b.x, nloc, nx); b.st[0] = nloc; b.st[1] = nx; }
        const unsigned old = xb_add(&bar[XB_XSUB(b.x)], 1u);
        const unsigned gen = old / nloc;
        if (old + 1u == (gen + 1u) * nloc) {
            __builtin_amdgcn_fence(__ATOMIC_RELEASE, "agent");
            asm volatile("s_waitcnt vmcnt(0)" ::: "memory");
            const unsigned og = xb_add(&bar[XB_TOP], 1u);
            const unsigned tg = og / nx;
            if (og + 1u == (tg + 1u) * nx) xb_add(&bar[XB_TOPGEN], 1u);
            else XB_SPIN(xb_ld(&bar[XB_TOPGEN]) == tg, bar);
            __builtin_amdgcn_fence(__ATOMIC_ACQUIRE, "agent");
            xb_add(&bar[XB_XGEN(b.x)], 1u);
            asm volatile("s_waitcnt vmcnt(0)" ::: "memory");
        } else {
            XB_SPIN(xb_ld(&bar[XB_XGEN(b.x)]) == gen, bar);
            __builtin_amdgcn_fence(__ATOMIC_ACQUIRE, "agent");
            asm volatile("s_waitcnt vmcnt(0)" ::: "memory");
        }
    }
    __syncthreads();
}

__device__ __forceinline__ int fresh_lane() { int l; asm volatile("v_mbcnt_lo_u32_b32 %0, -1, 0\n\tv_mbcnt_hi_u32_b32 %0, -1, %0" : "=v"(l)); return l; }
struct Args { const float* in[22]; float* out; unsigned char* ws; int ph_lo, ph_hi; };

struct Frame {
    LAS unsigned char* lds;
    int tid, lane, wave;
    int vcu, G;
};

__device__ __forceinline__ float wave_sum(float v) {
#pragma unroll
    for (int o = 1; o < 64; o <<= 1) v += __shfl_xor(v, o);
    return v;
}

__device__ __forceinline__ void conv_item(const float* W, int ldw, int srccol0, bf16* WT, int K, int dstrow0, int k0, LAS float* scr, int lane, const float* kscale  , int kslo = 0, int kshi = 1 << 30) {
    {
        const int lr = lane >> 3, lc = (lane & 7) * 4; f32x4 v[8];
#pragma unroll
        for (int i = 0; i < 8; ++i) { const float* p = W + (size_t)(k0 + 8 * i + lr) * ldw + srccol0 + lc;
            if ((((size_t)p) & 15) == 0) v[i] = *(const f32x4*)p; else { v[i][0] = p[0]; v[i][1] = p[1]; v[i][2] = p[2]; v[i][3] = p[3]; } }
#pragma unroll
        for (int i = 0; i < 8; ++i) { LAS float* d = scr + (8 * i + lr) * 33 + lc; d[0] = v[i][0]; d[1] = v[i][1]; d[2] = v[i][2]; d[3] = v[i][3]; }
    }
    const int c = lane & 7;
    f32x4 ks0 = (f32x4){1.f, 1.f, 1.f, 1.f}, ks1 = ks0;
    if (kscale && k0 >= kslo && k0 < kshi) { ks0 = *(const f32x4*)(kscale + k0 - kslo + 8 * c); ks1 = *(const f32x4*)(kscale + k0 - kslo + 8 * c + 4); }
    LDS_WAIT(); asm volatile("" ::: "memory");
#pragma unroll
    for (int j = 0; j < 4; ++j) { const int n = (lane >> 3) + 8 * j; const LAS float* s = scr + (8 * c) * 33 + n;
        v4u o; o.x = pk2(s[0 * 33] * ks0[0], s[1 * 33] * ks0[1]); o.y = pk2(s[2 * 33] * ks0[2], s[3 * 33] * ks0[3]); o.z = pk2(s[4 * 33] * ks1[0], s[5 * 33] * ks1[1]); o.w = pk2(s[6 * 33] * ks1[2], s[7 * 33] * ks1[3]);
        *(GAS v4u*)(WT + (size_t)(dstrow0 + n) * K + k0 + 8 * c) = o; }
    LDS_WAIT(); asm volatile("" ::: "memory");
}
__device__ __forceinline__ int in_src_col(int n0) {
    const int tile = n0 >> 8, p = n0 & 255; int dest;
    if (tile < 2 || tile == 8 || tile == 9) { const int bj = p >> 7, wc = (p >> 5) & 3; dest = (tile << 8) + 64 * wc + 32 * bj; } else dest = n0;
    if (dest < PC_Z) return SC_Q + dest;
    if (dest < PC_MO) return SC_Z + dest - PC_Z;
    if (dest < PC_K) return SC_MO + dest - PC_MO;
    if (dest < PC_V) return SC_K + dest - PC_K;
    if (dest < PC_XBC) return SC_V + dest - PC_V;
    if (dest < PC_MQK) return SC_XBC + dest - PC_XBC;
    if (dest < PC_MV) return SC_MQK + dest - PC_MQK;
    return SC_MV + dest - PC_MV;
}
__device__ __forceinline__ void conv_w_in(Frame& F, const float* w_in, const float* nw, bf16* wt, LAS float* scr) {
    const int gw = F.vcu * NWAVES + F.wave, NGW = F.G * NWAVES;
    for (int it = gw; it < (DM / 64) * (PLD / 32); it += NGW) { const int nblk = PLD / 32, kb = it / nblk, nb = it % nblk; conv_item(w_in, P_IN, in_src_col(32 * nb), wt, DM, 32 * nb, 64 * kb, scr, F.lane, nw); }
}
__device__ __forceinline__ void conv_plain(Frame& F, const float* W, int K, int N, const float* kscale, bf16* wt, LAS float* scr, int kslo = 0, int kshi = 1 << 30) {
    const int gw = F.vcu * NWAVES + F.wave, NGW = F.G * NWAVES; const int nblk = N / 32;
    for (int it = gw; it < (K / 64) * nblk; it += NGW) { const int kb = it / nblk, nb = it % nblk; conv_item(W, N, 32 * nb, wt, K, 32 * nb, 64 * kb, scr, F.lane, kscale, kslo, kshi); }
}
__device__ __forceinline__ void conv_small(Frame& F, const float* w_in, const float* nw, bf16* wst) {
    const int gt = F.vcu * (NWAVES * 64) + F.tid, NT = F.G * NWAVES * 64;
    for (int i = gt; i < 32 * DM; i += NT) { const int c = i >> 10, k = i & (DM - 1);
        float v = 0.f; if (c < 24) v = w_in[(size_t)k * P_IN + (c < 16 ? SC_DT + c : SC_MI + (c - 16))] * nw[k];
        wst[i] = (bf16)(pk2(v, 0.f) & 0xffffu); }
}
__device__ __forceinline__ void row_pass0(Frame& F, const float* x, bf16* xb, float* rs) {
    const int gw = F.vcu * NWAVES + F.wave, NGW = F.G * NWAVES;
    for (int m = gw; m < M; m += 2 * NGW) {
        const int m2 = m + NGW; const bool two = m2 < M;
        const GAS f32x4* xr = (const GAS f32x4*)(x + (size_t)m * DM) + F.lane; const GAS f32x4* xr2 = (const GAS f32x4*)(x + (size_t)(two ? m2 : m) * DM) + F.lane;
        f32x4 v[4], u[4]; float s_ = 0.f, t_ = 0.f;
#pragma unroll
        for (int j = 0; j < 4; ++j) { v[j] = xr[64 * j]; u[j] = xr2[64 * j]; }
#pragma unroll
        for (int j = 0; j < 4; ++j) { s_ += (v[j].x * v[j].x + v[j].y * v[j].y) + (v[j].z * v[j].z + v[j].w * v[j].w); t_ += (u[j].x * u[j].x + u[j].y * u[j].y) + (u[j].z * u[j].z + u[j].w * u[j].w); }
        s_ = wave_sum(s_); t_ = wave_sum(t_);
        GAS unsigned long long* o8 = (GAS unsigned long long*)(xb + (size_t)m * DM) + F.lane;
#pragma unroll
        for (int j = 0; j < 4; ++j) o8[64 * j] = (unsigned long long)pk2(v[j].x, v[j].y) | ((unsigned long long)pk2(v[j].z, v[j].w) << 32);
        if (F.lane == 0) rs[m] = s_;
        if (two) { GAS unsigned long long* p8 = (GAS unsigned long long*)(xb + (size_t)m2 * DM) + F.lane;
#pragma unroll
            for (int j = 0; j < 4; ++j) p8[64 * j] = (unsigned long long)pk2(u[j].x, u[j].y) | ((unsigned long long)pk2(u[j].z, u[j].w) << 32);
            if (F.lane == 0) rs[m2] = t_; }
    }
}
typedef short bf16x8s __attribute__((ext_vector_type(8)));
__device__ __forceinline__ void small_proj(Frame& F, const bf16* xb, const bf16* wst, const float* rs, float* smallp) {
    constexpr int SP = 1040;
    LAS unsigned char* As = F.lds; LAS unsigned char* Bs = F.lds + 64 * SP;
    const int lane = F.lane, w = F.wave, mt = w & 3, nt = w >> 2, r16 = lane & 15, kq = lane >> 4;
    for (int rb = F.vcu * 64; rb < M; rb += F.G * 64) {
        f32x4 acc = (f32x4){0.f, 0.f, 0.f, 0.f};
#pragma unroll 1
        for (int kh = 0; kh < 2; ++kh) {
            v4u av[8], bv[4];
#pragma unroll
            for (int i = 0; i < 8; ++i) { const int it = F.tid + 512 * i, row = it >> 6, c = it & 63; av[i] = *(const v4u*)(xb + (size_t)(rb + row) * DM + kh * 512 + c * 8); }
#pragma unroll
            for (int i = 0; i < 4; ++i) { const int it = F.tid + 512 * i, row = it >> 6, c = it & 63; bv[i] = *(const v4u*)(wst + (size_t)row * DM + kh * 512 + c * 8); }
            __syncthreads();
#pragma unroll
            for (int i = 0; i < 8; ++i) { const int it = F.tid + 512 * i, row = it >> 6, c = it & 63; *(LAS v4u*)(As + row * SP + c * 16) = av[i]; }
#pragma unroll
            for (int i = 0; i < 4; ++i) { const int it = F.tid + 512 * i, row = it >> 6, c = it & 63; *(LAS v4u*)(Bs + row * SP + c * 16) = bv[i]; }
            __syncthreads();
            bf16x8s a[16], b[16];
#pragma unroll
            for (int ks = 0; ks < 16; ++ks) { a[ks] = *(const LAS bf16x8s*)(As + (16 * mt + r16) * SP + (32 * ks + 8 * kq) * 2); b[ks] = *(const LAS bf16x8s*)(Bs + (16 * nt + r16) * SP + (32 * ks + 8 * kq) * 2); }
#pragma unroll
            for (int ks = 0; ks < 16; ++ks) acc = __builtin_amdgcn_mfma_f32_16x16x32_bf16(a[ks], b[ks], acc, 0, 0, 0);
        }
        const int n = 16 * nt + r16;
        if (n < 24) {
#pragma unroll
            for (int i = 0; i < 4; ++i) { const int row = rb + 16 * mt + 4 * kq + i; smallp[(size_t)row * 24 + n] = acc[i] * (1.0f / sqrtf(rs[row] * (1.0f / DM) + EPS)); } }
    }
    __syncthreads();
}
__device__ __forceinline__ unsigned cvtpk(float lo, float hi) { return pk2(lo, hi); }
__device__ __forceinline__ float bflo(unsigned w) { return __uint_as_float(w << 16); }
__device__ __forceinline__ float bfhi(unsigned w) { return __uint_as_float(w & 0xffff0000u); }
typedef float f32x2 __attribute__((ext_vector_type(2)));
__device__ __forceinline__ f32x2 gelu_pk(f32x2 v) {
    const f32x2 av = __builtin_elementwise_abs(v), d = av * 0.2316418882f + 1.0f;
    f32x2 t; t.x = __builtin_amdgcn_rcpf(d.x); t.y = __builtin_amdgcn_rcpf(d.y);
    f32x2 q = t * 0.5307027145f + (-0.7265760135f); q = q * t + 0.7107068705f; q = q * t + (-0.142248368f); q = q * t + 0.127414796f; q = q * t;
    const f32x2 s = (v * v) * (-0.72134752044f);
    f32x2 e; e.x = __builtin_amdgcn_exp2f(s.x); e.y = __builtin_amdgcn_exp2f(s.y);
    const f32x2 m = v * (q * e), r = v - m;
    f32x2 o; o.x = v.x < 0.f ? m.x : r.x; o.y = v.y < 0.f ? m.y : r.y; return o;
}

__device__ __forceinline__ void ffn_fix(Frame& F, bf16* H, const bf16* sideA, const bf16* sideB, const float* cw, const float* cb, int pm) {
    constexpr int CPR = FFN / 8;
    for (int it = F.tid; it < 4 * 2 * CPR; it += NWAVES * 64) {
        const int c0 = (it % CPR) * 8, rr_ = (it / CPR) & 1, grp = 4 * pm + it / (2 * CPR); const bool first = (grp & 31) == 0;
        const v4u z = (v4u){0, 0, 0, 0};
        const bf16* sb = sideB + ((size_t)grp * 2 + rr_) * 2 * FFN + c0;
        const v4u g2 = *(const v4u*)sb, vv = *(const v4u*)(sb + FFN);
        const v4u a1 = first ? z : *(const v4u*)(sideA + ((size_t)(grp - 1) * 2 + 1) * FFN + c0), a0 = first ? z : *(const v4u*)(sideA + ((size_t)(grp - 1) * 2) * FFN + c0);
        const v4u g1 = rr_ ? *(const v4u*)(sideB + ((size_t)grp * 2) * 2 * FFN + c0) : a1, g0 = rr_ ? a1 : a0;
        f32x4 w0[2], w1[2], w2[2], bb[2];
#pragma unroll
        for (int k = 0; k < 2; ++k) { w0[k] = *(const f32x4*)(cw + c0 + 4 * k); w1[k] = *(const f32x4*)(cw + FFN + c0 + 4 * k); w2[k] = *(const f32x4*)(cw + 2 * FFN + c0 + 4 * k); bb[k] = *(const f32x4*)(cb + c0 + 4 * k); }
        v4u ov;
#pragma unroll
        for (int i = 0; i < 4; ++i) { const int k = i >> 1, e = (i & 1) * 2; f32x2 x;
            x.x = bb[k][e] + w0[k][e] * bflo(g0[i]) + w1[k][e] * bflo(g1[i]) + w2[k][e] * bflo(g2[i]);
            x.y = bb[k][e + 1] + w0[k][e + 1] * bfhi(g0[i]) + w1[k][e + 1] * bfhi(g1[i]) + w2[k][e + 1] * bfhi(g2[i]);
            const f32x2 ge = gelu_pk(x); ov[i] = cvtpk(ge.x * bflo(vv[i]), ge.y * bfhi(vv[i])); }
        *(v4u*)(H + (size_t)(grp * 64 + rr_) * FFN + c0) = ov;
    }
}
__device__ __forceinline__ float silu_f(float x) { return x * __builtin_amdgcn_rcpf(1.0f + __builtin_amdgcn_exp2f(-1.4426950408889634f * x)); }
__device__ __forceinline__ float sigm_f(float x) { return __builtin_amdgcn_rcpf(1.0f + __builtin_amdgcn_exp2f(-1.4426950408889634f * x)); }

__device__ __forceinline__ float shx(float v, int m, int lane) { return __int_as_float(__builtin_amdgcn_ds_bpermute((lane ^ m) << 2, __float_as_int(v))); }
__device__ __forceinline__ float shup(float v, int o, int lane) { return __int_as_float(__builtin_amdgcn_ds_bpermute((lane - o) << 2, __float_as_int(v))); }
__device__ __forceinline__ float shl_(float v, int src, int lane) { (void)lane; return __int_as_float(__builtin_amdgcn_ds_bpermute(src << 2, __float_as_int(v))); }
__device__ __forceinline__ float softplus_f(float x) { return fmaxf(x, 0.f) + 0.6931471805599453f * __builtin_amdgcn_logf(1.0f + __builtin_amdgcn_exp2f(-1.4426950408889634f * fabsf(x))); }
__device__ __forceinline__ float logsig_f(float x) { return fminf(x, 0.f) - 0.6931471805599453f * __builtin_amdgcn_logf(1.0f + __builtin_amdgcn_exp2f(-1.4426950408889634f * fabsf(x))); }
typedef short bf16x8v __attribute__((ext_vector_type(8)));
typedef float f32x16 __attribute__((ext_vector_type(16)));
typedef short v4i16_t __attribute__((ext_vector_type(4)));
__device__ __forceinline__ bf16x8v frag_row(LAS const unsigned char* base, int pitch, int row, int kel) { return *(const LAS bf16x8v*)(base + row * pitch + kel * 2); }
__device__ __forceinline__ bf16x8v frag_tr(LAS const unsigned char* base, int pitch, int krow, int col) {
    LAS const unsigned char* p = base + krow * pitch + col * 2;
    const v4i16_t lo = __builtin_amdgcn_ds_read_tr16_b64_v4i16((LAS v4i16_t*)p);
    const v4i16_t hi = __builtin_amdgcn_ds_read_tr16_b64_v4i16((LAS v4i16_t*)(p + 4 * pitch));
    return (bf16x8v){lo[0], lo[1], lo[2], lo[3], hi[0], hi[1], hi[2], hi[3]};
}
#define MFMA32(a, b, c) __builtin_amdgcn_mfma_f32_32x32x16_bf16((a), (b), (c), 0, 0, 0)

__device__ __forceinline__ void ssd_unit(int tid, bf16* proj, const float* smallp, float* ssq, const float* dt_bias, const float* a_log, const float* dskip, int b, int h, LAS unsigned char* lds) {
    constexpr int PB = 272, PX = 144;
    asm volatile("" : "+v"(tid));
    LAS unsigned char* CG = lds;
    LAS unsigned char* BB = lds + 34816;
    LAS unsigned char* XX = lds + 69632;
    LAS unsigned char* XW = lds + 88064;
    LAS unsigned char* ST = lds + 106496;
    LAS float* ldv = (LAS float*)(lds + 123904);
    LAS float* dtv = ldv + 2048;
    const int lane0 = tid & 63, w = __builtin_amdgcn_readfirstlane(tid >> 6);
    const int g = h >> 3, pt = w & 1, lt = w >> 1;
    const float a = -__expf(a_log[h]), dsk = dskip[h], dtb = dt_bias[h];
    const size_t rowb = (size_t)b * SEQ;
    const int xrow = tid >> 2, xq = tid & 3, brow = tid >> 4, bc = tid & 15;
    const bf16* xsrc = proj + (rowb + xrow) * PLD + PC_XBC + h * 64 + xq * 16;
    bf16* zptr = proj + (rowb + xrow) * PLD + PC_Z + h * 64 + xq * 16;
    const bf16* bsrc = proj + (rowb + brow) * PLD + PC_XBC + 1024 + g * 128 + bc * 8;
    const bf16* csrc = bsrc + 256;
    const float* dsrc = smallp + (rowb + lane0) * 24 + h;
    v4u xr[2], br[4], cr[4];
#pragma unroll
    for (int k = 0; k < 2; ++k) xr[k] = *(const v4u*)(xsrc + 8 * k);
#pragma unroll
    for (int k = 0; k < 4; ++k) { br[k] = *(const v4u*)(bsrc + (size_t)32 * k * PLD); cr[k] = *(const v4u*)(csrc + (size_t)32 * k * PLD); }
#pragma unroll
    for (int cc = 0; cc < 2; ++cc) { const int ch_ = 2 * w + cc; const float* dp_ = dsrc + (size_t)ch_ * 128 * 24;
        float v0 = dp_[0] + dtb, v1 = dp_[64 * 24] + dtb;
        v0 = softplus_f(v0); v1 = softplus_f(v1);
        float s0 = v0 * a, s1 = v1 * a;
#pragma unroll
        for (int o = 1; o < 64; o <<= 1) { const float t0 = shup(s0, o, lane0), t1 = shup(s1, o, lane0); if (lane0 >= o) { s0 += t0; s1 += t1; } }
        s1 += shl_(s0, 63, lane0);
        ldv[ch_ * 128 + lane0] = s0; ldv[ch_ * 128 + 64 + lane0] = s1; dtv[ch_ * 128 + lane0] = v0; dtv[ch_ * 128 + 64 + lane0] = v1; }
    f32x16 sacc;
#pragma unroll
    for (int i = 0; i < 16; ++i) sacc[i] = 0.f;
    for (int i = tid; i < 17408 / 4; i += 512) ((LAS unsigned*)ST)[i] = 0u;
    for (int c = 0; c < 16; ++c) {
        const size_t row0 = rowb + c * 128;
        int lane = lane0; asm volatile("" : "+v"(lane));
        const int r = lane & 31, hh = lane >> 5, trq = (lane & 15) >> 2, trc = 16 * ((lane >> 4) & 1) + 4 * (lane & 3);
        LAS const float* ldc = ldv + c * 128; LAS const float* dtc = dtv + c * 128;
        __syncthreads();
        {
            const float wl = dtc[xrow] * __expf(ldc[127] - ldc[xrow]);
#pragma unroll
            for (int k = 0; k < 2; ++k) { *(LAS v4u*)(XX + xrow * PX + xq * 32 + k * 16) = xr[k]; v4u o;
#pragma unroll
                for (int i = 0; i < 4; ++i) o[i] = pk2(bf2f(xr[k][i] & 0xffff) * wl, bf2f(xr[k][i] >> 16) * wl);
                *(LAS v4u*)(XW + xrow * PX + xq * 32 + k * 16) = o; }
#pragma unroll
            for (int k = 0; k < 4; ++k) { *(LAS v4u*)(BB + (brow + 32 * k) * PB + bc * 16) = br[k]; *(LAS v4u*)(CG + (brow + 32 * k) * PB + bc * 16) = cr[k]; }
        }
        v4u zr[2];
#pragma unroll
        for (int k = 0; k < 2; ++k) zr[k] = *(const v4u*)(zptr + (size_t)c * 128 * PLD + 8 * k);
        if (c < 15) {
#pragma unroll
            for (int k = 0; k < 2; ++k) xr[k] = *(const v4u*)(xsrc + (size_t)(c + 1) * 128 * PLD + 8 * k);
#pragma unroll
            for (int k = 0; k < 4; ++k) { br[k] = *(const v4u*)(bsrc + (size_t)((c + 1) * 128 + 32 * k) * PLD); cr[k] = *(const v4u*)(csrc + (size_t)((c + 1) * 128 + 32 * k) * PLD); }
        }
        __syncthreads();
        f32x16 yacc;
#pragma unroll
        for (int i = 0; i < 16; ++i) yacc[i] = 0.f;
        {   bf16x8v fa[8], fb[8];
#pragma unroll
            for (int ks = 0; ks < 8; ++ks) { fa[ks] = frag_row(ST, PB, 32 * pt + r, 16 * ks + 8 * hh); fb[ks] = frag_row(CG, PB, 32 * lt + r, 16 * ks + 8 * hh); }
            __builtin_amdgcn_sched_barrier(0);
#pragma unroll
            for (int ks = 0; ks < 8; ++ks) yacc = MFMA32(fa[ks], fb[ks], yacc); }
        { const float e = __expf(ldc[32 * lt + r]);
#pragma unroll
          for (int i = 0; i < 16; ++i) yacc[i] *= e; }
        f32x16 tA, tB;
        const int ltA = (w >= 6) ? 3 : (w >= 3) ? 2 : (w >= 1) ? 1 : 0, stA = w - ltA * (ltA + 1) / 2;
        const int ltB = 3, stB = w + 2;
#pragma unroll
        for (int i = 0; i < 16; ++i) { tA[i] = 0.f; tB[i] = 0.f; }
        {   bf16x8v fa[8], fb[8];
#pragma unroll
            for (int ks = 0; ks < 8; ++ks) { fa[ks] = frag_row(BB, PB, 32 * stA + r, 16 * ks + 8 * hh); fb[ks] = frag_row(CG, PB, 32 * ltA + r, 16 * ks + 8 * hh); }
            __builtin_amdgcn_sched_barrier(0);
#pragma unroll
            for (int ks = 0; ks < 8; ++ks) tA = MFMA32(fa[ks], fb[ks], tA); }
        if (w < 2) { bf16x8v fa[8], fb[8];
#pragma unroll
            for (int ks = 0; ks < 8; ++ks) { fa[ks] = frag_row(BB, PB, 32 * stB + r, 16 * ks + 8 * hh); fb[ks] = frag_row(CG, PB, 32 * ltB + r, 16 * ks + 8 * hh); }
            __builtin_amdgcn_sched_barrier(0);
#pragma unroll
            for (int ks = 0; ks < 8; ++ks) tB = MFMA32(fa[ks], fb[ks], tB); }
        __syncthreads();
#define SSD_GWRITE(T_, st_, lt_) do { const int l = 32 * (lt_) + r; const float ldl = ldc[l]; \
          _Pragma("unroll") for (int g4 = 0; g4 < 4; ++g4) { const int s0 = 32 * (st_) + 8 * g4 + 4 * hh; \
              const f32x4 lds4 = *(LAS const f32x4*)(ldc + s0), dts4 = *(LAS const f32x4*)(dtc + s0); float v[4]; \
              _Pragma("unroll") for (int j = 0; j < 4; ++j) { const float e_ = __expf(fminf(ldl - lds4[j], 0.f)) * dts4[j] * T_[4 * g4 + j]; v[j] = (s0 + j <= l) ? e_ : 0.f; } \
              *(LAS unsigned long long*)(CG + l * PB + s0 * 2) = (unsigned long long)pk2(v[0], v[1]) | ((unsigned long long)pk2(v[2], v[3]) << 32); } } while (0)
        SSD_GWRITE(tA, stA, ltA);
        if (w < 2) SSD_GWRITE(tB, stB, ltB);
#undef SSD_GWRITE
        __syncthreads();
        for (int kb = 0; kb <= lt; ++kb) { bf16x8v fa[2], fb[2];
#pragma unroll
            for (int k2 = 0; k2 < 2; ++k2) { const int ks = 2 * kb + k2; fa[k2] = frag_tr(XX, PX, 16 * ks + 8 * hh + trq, 32 * pt + trc); fb[k2] = frag_row(CG, PB, 32 * lt + r, 16 * ks + 8 * hh); }
            __builtin_amdgcn_sched_barrier(0);
#pragma unroll
            for (int k2 = 0; k2 < 2; ++k2) yacc = MFMA32(fa[k2], fb[k2], yacc); }
        { const float e = __expf(ldc[127]);
#pragma unroll
          for (int i = 0; i < 16; ++i) sacc[i] *= e; }
        {   bf16x8v fa[8], fb[8];
#pragma unroll
            for (int ks = 0; ks < 8; ++ks) { fa[ks] = frag_tr(BB, PB, 16 * ks + 8 * hh + trq, 32 * lt + trc); fb[ks] = frag_tr(XW, PX, 16 * ks + 8 * hh + trq, 32 * pt + trc); }
            __builtin_amdgcn_sched_barrier(0);
#pragma unroll
            for (int ks = 0; ks < 8; ++ks) sacc = MFMA32(fa[ks], fb[ks], sacc); }
        __syncthreads();
        {
            const int p = 32 * pt + r, l = 32 * lt + r;
#pragma unroll
            for (int g4 = 0; g4 < 4; ++g4) { const int n0 = 32 * lt + 8 * g4 + 4 * hh;
                *(LAS unsigned long long*)(ST + p * PB + n0 * 2) = (unsigned long long)pk2(sacc[4 * g4], sacc[4 * g4 + 1]) | ((unsigned long long)pk2(sacc[4 * g4 + 2], sacc[4 * g4 + 3]) << 32);
                const int p0 = 32 * pt + 8 * g4 + 4 * hh;
                *(LAS f32x4*)(CG + l * 272 + p0 * 4) = (f32x4){yacc[4 * g4], yacc[4 * g4 + 1], yacc[4 * g4 + 2], yacc[4 * g4 + 3]}; }
        }
        __syncthreads();
        {
            float o[16]; float ss = 0.f;
#pragma unroll
            for (int k = 0; k < 2; ++k) { const v4u zv = zr[k]; const v4u xv = *(const LAS v4u*)(XX + xrow * PX + xq * 32 + k * 16);
                const f32x4 y0 = *(const LAS f32x4*)(CG + xrow * 272 + (xq * 16 + 8 * k) * 4), y1 = *(const LAS f32x4*)(CG + xrow * 272 + (xq * 16 + 8 * k + 4) * 4);
#pragma unroll
                for (int i = 0; i < 4; ++i) { const float ya = (i < 2 ? y0[2 * i] : y1[2 * i - 4]), yb = (i < 2 ? y0[2 * i + 1] : y1[2 * i - 3]);
                    const float oa = (ya + dsk * bf2f(xv[i] & 0xffff)) * silu_f(bf2f(zv[i] & 0xffff)), ob = (yb + dsk * bf2f(xv[i] >> 16)) * silu_f(bf2f(zv[i] >> 16));
                    o[8 * k + 2 * i] = oa; o[8 * k + 2 * i + 1] = ob; ss += oa * oa + ob * ob; } }
            ss += shx(ss, 1, lane); ss += shx(ss, 2, lane);
            bf16* zp = zptr + (size_t)c * 128 * PLD;
#pragma unroll
            for (int k = 0; k < 2; ++k) { v4u ov; ov.x = pk2(o[8 * k], o[8 * k + 1]); ov.y = pk2(o[8 * k + 2], o[8 * k + 3]); ov.z = pk2(o[8 * k + 4], o[8 * k + 5]); ov.w = pk2(o[8 * k + 6], o[8 * k + 7]); *(v4u*)(zp + 8 * k) = ov; }
            if (xq == 0) ssq[(row0 + xrow) * 16 + h] = ss;
        }
    }
    __syncthreads();
}

__device__ __forceinline__ void mlstm_unit(int tid, bf16* proj, const float* smallp, const float* i_bias, const float* f_bias, const float* norm_w, int b, int hd, LAS unsigned char* lds, float* gsc  , unsigned long long* pts) {
    constexpr int PB = 272, GS = 656;
    asm volatile("" : "+v"(tid));
    LAS unsigned char* QP = lds;
    LAS unsigned char* KK = lds + 34816;
    LAS unsigned char* VV = lds + 69632;
    LAS unsigned char* CS = lds + 104448;
    LAS float* uu = (LAS float*)(lds + 139264);
    LAS float* mmv = uu + 128;
    LAS float* wint = mmv + 128;
    LAS float* dnv = wint + 128;
    LAS float* wlv = dnv + 128;
    LAS float* scal = wlv + 128;
    LAS float* nwl = scal + 16;
    LAS float* ptot = nwl + 128;
    LAS float* pmlo = ptot + 16;
    LAS unsigned short* nstb = (LAS unsigned short*)(pmlo + 16);
    const int lane0 = tid & 63, w = __builtin_amdgcn_readfirstlane(tid >> 6);
    const int tt = w >> 1, dp = w & 1;
    const float ib = i_bias[hd], fb = f_bias[hd];
    const size_t rowb = (size_t)b * SEQ;
    const int srow = tid >> 4, sc = tid & 15, et = tid >> 2, eq = tid & 3;
    const bf16* qsrc = proj + (rowb + srow) * PLD + PC_MQK + hd * 128 + sc * 8;
    const bf16* ksrc = qsrc + 512;
    const bf16* vsrc = proj + (rowb + srow) * PLD + PC_MV + hd * 128 + sc * 8;
    bf16* optr = proj + (rowb + et) * PLD + PC_MO + hd * 128 + eq * 32;
    v4u qr[4], kr[4]; float wlr[4];
#pragma unroll
    for (int k = 0; k < 4; ++k) { qr[k] = *(const v4u*)(qsrc + (size_t)32 * k * PLD); kr[k] = *(const v4u*)(ksrc + (size_t)32 * k * PLD); }
    {
        float pc0[2], pc1[2], pu0[2], pu1[2], pp0[2], pp1[2];
#pragma unroll
        for (int cc = 0; cc < 2; ++cc) { const float* gp = smallp + (rowb + (size_t)(2 * w + cc) * 128 + lane0) * 24 + 16 + hd;
            const float li0 = gp[0] + ib, li1 = gp[64 * 24] + ib, f0 = gp[4] + fb, f1 = gp[64 * 24 + 4] + fb;
            float c0 = logsig_f(f0), c1 = logsig_f(f1);
#pragma unroll
            for (int o = 1; o < 64; o <<= 1) { const float t0 = shup(c0, o, lane0), t1 = shup(c1, o, lane0); if (lane0 >= o) { c0 += t0; c1 += t1; } }
            c1 += shl_(c0, 63, lane0);
            const float totf = shl_(c1, 63, lane0);
            const float u0 = li0 - c0, u1 = li1 - c1;
            float p0 = u0, p1 = u1;
#pragma unroll
            for (int o = 1; o < 64; o <<= 1) { const float t0 = shup(p0, o, lane0), t1 = shup(p1, o, lane0); if (lane0 >= o) { p0 = fmaxf(p0, t0); p1 = fmaxf(p1, t1); } }
            p1 = fmaxf(p1, shl_(p0, 63, lane0));
            pc0[cc] = c0; pc1[cc] = c1; pu0[cc] = u0; pu1[cc] = u1; pp0[cc] = p0; pp1[cc] = p1;
            const float pall = shl_(p1, 63, lane0);
            if (lane0 == 0) { ptot[2 * w + cc] = totf; pmlo[2 * w + cc] = totf + pall; }
        }
        if (tid < 128) nwl[tid] = norm_w[hd * 128 + tid];
        if (tid < 64) ((LAS unsigned*)nstb)[tid] = 0u;
        for (int i = tid; i < 34816 / 4; i += 512) ((LAS unsigned*)CS)[i] = 0u;
        __syncthreads();
        float mst = 0.f, mst_mine[2] = {0.f, 0.f}, mnew_mine[2] = {0.f, 0.f};
#pragma unroll
        for (int c = 0; c < 16; ++c) { const float tf = ptot[c], ml = pmlo[c]; const float mn = fmaxf(tf + mst, ml);
            if (tid == 0) scal[c] = __expf(tf + mst - mn);
            if (c == 2 * w) { mst_mine[0] = mst; mnew_mine[0] = mn; }
            if (c == 2 * w + 1) { mst_mine[1] = mst; mnew_mine[1] = mn; }
            mst = mn; }
#pragma unroll
        for (int cc = 0; cc < 2; ++cc) { float* go_ = gsc + (size_t)(2 * w + cc) * GS; const float ms = mst_mine[cc], mn = mnew_mine[cc], tf = ptot[2 * w + cc];
            const float m0 = fmaxf(pp0[cc], ms), m1 = fmaxf(pp1[cc], ms);
            go_[lane0] = __expf(mn - tf - m0); go_[64 + lane0] = __expf(mn - tf - m1); go_[128 + lane0] = m0; go_[192 + lane0] = m1;
            go_[256 + lane0] = __expf(ms - m0); go_[320 + lane0] = __expf(ms - m1);
            go_[384 + lane0] = __expf(-(pc0[cc] + m0)); go_[448 + lane0] = __expf(-(pc1[cc] + m1));
            go_[512 + lane0] = __expf(tf + pu0[cc] - mn); go_[576 + lane0] = __expf(tf + pu1[cc] - mn); }
        asm volatile("s_waitcnt vmcnt(0)" ::: "memory");
        __syncthreads();
    }
    float gr[5] = {0.f, 0.f, 0.f, 0.f, 0.f};
    if (tid < 128) {
#pragma unroll
        for (int k = 0; k < 5; ++k) gr[k] = __hip_atomic_load(gsc + k * 128 + tid, __ATOMIC_RELAXED, __HIP_MEMORY_SCOPE_AGENT); }
#pragma unroll
    for (int k = 0; k < 4; ++k) wlr[k] = __hip_atomic_load(gsc + 512 + srow + 32 * k, __ATOMIC_RELAXED, __HIP_MEMORY_SCOPE_AGENT);
    f32x16 cacc0, cacc1, nacc;
#pragma unroll
    for (int i = 0; i < 16; ++i) { cacc0[i] = 0.f; cacc1[i] = 0.f; nacc[i] = 0.f; }
    const bf16x8v ones = (bf16x8v){0x3F80, 0x3F80, 0x3F80, 0x3F80, 0x3F80, 0x3F80, 0x3F80, 0x3F80};
#if PROBE_PHASE != -1 && defined(PROBE_STAGES)
    unsigned long long tacc = 0; unsigned long long tprev = __builtin_amdgcn_s_memrealtime();
#define STAMP(k) do { const unsigned long long tn_ = __builtin_amdgcn_s_memrealtime(); if ((k) == PROBE_STAGES) tacc += tn_ - tprev; tprev = tn_; } while (0)
#else
#define STAMP(k) do {} while (0)
#endif
    for (int c = 0; c < 16; ++c) {
        int lane = lane0; asm volatile("" : "+v"(lane));
        const int r = lane & 31, hh = lane >> 5, trq = (lane & 15) >> 2, trc = 16 * ((lane >> 4) & 1) + 4 * (lane & 3);
        __syncthreads();
        STAMP(0);
#pragma unroll
        for (int k = 0; k < 4; ++k) { *(LAS v4u*)(QP + (srow + 32 * k) * PB + sc * 16) = qr[k]; v4u kw_;
#pragma unroll
            for (int i = 0; i < 4; ++i) kw_[i] = pk2(bflo(kr[k][i]) * wlr[k], bfhi(kr[k][i]) * wlr[k]);
            *(LAS v4u*)(KK + (srow + 32 * k) * PB + sc * 16) = kw_; }
        if (tid < 128) { uu[tid] = gr[0]; mmv[tid] = gr[1]; wint[tid] = gr[2]; dnv[tid] = gr[3]; wlv[tid] = gr[4]; }
        v4u vr[4];
#pragma unroll
        for (int k = 0; k < 4; ++k) vr[k] = *(const v4u*)(vsrc + (size_t)(c * 128 + 32 * k) * PLD);
        if (c < 15) {
#pragma unroll
            for (int k = 0; k < 4; ++k) { const size_t ro = (size_t)((c + 1) * 128 + 32 * k) * PLD; qr[k] = *(const v4u*)(qsrc + ro); kr[k] = *(const v4u*)(ksrc + ro); }
#pragma unroll
            for (int k = 0; k < 4; ++k) wlr[k] = __hip_atomic_load(gsc + (size_t)(c + 1) * GS + 512 + srow + 32 * k, __ATOMIC_RELAXED, __HIP_MEMORY_SCOPE_AGENT);
            if (tid < 128) {
#pragma unroll
                for (int k = 0; k < 5; ++k) gr[k] = __hip_atomic_load(gsc + (size_t)(c + 1) * GS + k * 128 + tid, __ATOMIC_RELAXED, __HIP_MEMORY_SCOPE_AGENT); }
        }
        __syncthreads();
        STAMP(1);
        f32x16 na0, na1, dacc;
#pragma unroll
        for (int i = 0; i < 16; ++i) { na0[i] = 0.f; na1[i] = 0.f; dacc[i] = 0.f; }
#pragma unroll
        for (int kh = 0; kh < 2; ++kh) { bf16x8v fq[4], f0[4], f1[4], fn[4];
#pragma unroll
            for (int k4 = 0; k4 < 4; ++k4) { const int ks = 4 * kh + k4; fq[k4] = frag_row(QP, PB, 32 * tt + r, 16 * ks + 8 * hh); f0[k4] = frag_row(CS, PB, 32 * (2 * dp) + r, 16 * ks + 8 * hh); f1[k4] = frag_row(CS, PB, 32 * (2 * dp + 1) + r, 16 * ks + 8 * hh);
                fn[k4] = *(const LAS bf16x8v*)((LAS const unsigned char*)nstb + (16 * ks + 8 * hh) * 2); }
            __builtin_amdgcn_sched_barrier(0);
#pragma unroll
            for (int k4 = 0; k4 < 4; ++k4) { na0 = MFMA32(f0[k4], fq[k4], na0); na1 = MFMA32(f1[k4], fq[k4], na1); dacc = MFMA32(fn[k4], fq[k4], dacc); } }
        { const float e = wint[32 * tt + r];
#pragma unroll
          for (int i = 0; i < 16; ++i) { na0[i] *= e; na1[i] *= e; dacc[i] *= e; } }
        f32x16 tA, tB;
        const int ttA = (w >= 6) ? 3 : (w >= 3) ? 2 : (w >= 1) ? 1 : 0, stA = w - ttA * (ttA + 1) / 2;
        const int ttB = 3, stB = w + 2;
#pragma unroll
        for (int i = 0; i < 16; ++i) { tA[i] = 0.f; tB[i] = 0.f; }
#pragma unroll
        for (int kh = 0; kh < 2; ++kh) { bf16x8v fa[4], fb_[4];
#pragma unroll
            for (int k4 = 0; k4 < 4; ++k4) { const int ks = 4 * kh + k4; fa[k4] = frag_row(KK, PB, 32 * stA + r, 16 * ks + 8 * hh); fb_[k4] = frag_row(QP, PB, 32 * ttA + r, 16 * ks + 8 * hh); }
            __builtin_amdgcn_sched_barrier(0);
#pragma unroll
            for (int k4 = 0; k4 < 4; ++k4) tA = MFMA32(fa[k4], fb_[k4], tA); }
        if (w < 2) {
#pragma unroll
            for (int kh = 0; kh < 2; ++kh) { bf16x8v fa[4], fb_[4];
#pragma unroll
                for (int k4 = 0; k4 < 4; ++k4) { const int ks = 4 * kh + k4; fa[k4] = frag_row(KK, PB, 32 * stB + r, 16 * ks + 8 * hh); fb_[k4] = frag_row(QP, PB, 32 * ttB + r, 16 * ks + 8 * hh); }
                __builtin_amdgcn_sched_barrier(0);
#pragma unroll
                for (int k4 = 0; k4 < 4; ++k4) tB = MFMA32(fa[k4], fb_[k4], tB); } }
        __syncthreads();
        STAMP(2);
#define ML_PWRITE(T_, st_, tt_) do { const int t = 32 * (tt_) + r; const float rh = uu[t]; \
          _Pragma("unroll") for (int g4 = 0; g4 < 4; ++g4) { const int s0 = 32 * (st_) + 8 * g4 + 4 * hh; float v[4]; \
              _Pragma("unroll") for (int j = 0; j < 4; ++j) v[j] = (s0 + j <= t) ? T_[4 * g4 + j] * rh : 0.f; \
              *(LAS unsigned long long*)(QP + t * PB + s0 * 2) = (unsigned long long)pk2(v[0], v[1]) | ((unsigned long long)pk2(v[2], v[3]) << 32); } } while (0)
        ML_PWRITE(tA, stA, ttA);
        if (w < 2) ML_PWRITE(tB, stB, ttB);
#undef ML_PWRITE
#pragma unroll
        for (int k = 0; k < 4; ++k) *(LAS v4u*)(VV + (srow + 32 * k) * PB + sc * 16) = vr[k];
        v4u og[4];
#pragma unroll
        for (int k = 0; k < 4; ++k) og[k] = *(const v4u*)(optr + (size_t)c * 128 * PLD + 8 * k);
        __syncthreads();
        STAMP(3);
        { const float e = scal[c];
#pragma unroll
          for (int i = 0; i < 16; ++i) { cacc0[i] *= e; cacc1[i] *= e; nacc[i] *= e; } }
#pragma unroll
        for (int kb = 0; kb < 4; ++kb) { bf16x8v fk[2], f0[2], f1[2], fp[2];
            const bool m3 = kb <= tt;
#pragma unroll
            for (int k2 = 0; k2 < 2; ++k2) { const int ks = 2 * kb + k2; fk[k2] = frag_tr(KK, PB, 16 * ks + 8 * hh + trq, 32 * tt + trc);
                f0[k2] = frag_tr(VV, PB, 16 * ks + 8 * hh + trq, 32 * (2 * dp) + trc); f1[k2] = frag_tr(VV, PB, 16 * ks + 8 * hh + trq, 32 * (2 * dp + 1) + trc);
                fp[k2] = frag_row(QP, PB, 32 * tt + r, 16 * ks + 8 * hh); }
            __builtin_amdgcn_sched_barrier(0);
#pragma unroll
            for (int k2 = 0; k2 < 2; ++k2) { cacc0 = MFMA32(fk[k2], f0[k2], cacc0); cacc1 = MFMA32(fk[k2], f1[k2], cacc1); nacc = MFMA32(fk[k2], ones, nacc);
                if (m3) { na0 = MFMA32(f0[k2], fp[k2], na0); na1 = MFMA32(f1[k2], fp[k2], na1); dacc = MFMA32(ones, fp[k2], dacc); } } }
        __syncthreads();
        STAMP(4);
        {
            const int t = 32 * tt + r; const float dv = __builtin_amdgcn_rcpf(fmaxf(fabsf(dacc[0]), dnv[t]));
#pragma unroll
            for (int g4 = 0; g4 < 4; ++g4) {
                const int e0 = 32 * tt + 8 * g4 + 4 * hh, d0 = 32 * (2 * dp) + r, d1 = 32 * (2 * dp + 1) + r;
                *(LAS unsigned long long*)(CS + d0 * PB + e0 * 2) = (unsigned long long)pk2(cacc0[4 * g4], cacc0[4 * g4 + 1]) | ((unsigned long long)pk2(cacc0[4 * g4 + 2], cacc0[4 * g4 + 3]) << 32);
                *(LAS unsigned long long*)(CS + d1 * PB + e0 * 2) = (unsigned long long)pk2(cacc1[4 * g4], cacc1[4 * g4 + 1]) | ((unsigned long long)pk2(cacc1[4 * g4 + 2], cacc1[4 * g4 + 3]) << 32);
                const int dd0 = 32 * (2 * dp) + 8 * g4 + 4 * hh, dd1 = dd0 + 32;
                *(LAS unsigned long long*)(QP + t * PB + dd0 * 2) = (unsigned long long)pk2(na0[4 * g4] * dv, na0[4 * g4 + 1] * dv) | ((unsigned long long)pk2(na0[4 * g4 + 2] * dv, na0[4 * g4 + 3] * dv) << 32);
                *(LAS unsigned long long*)(QP + t * PB + dd1 * 2) = (unsigned long long)pk2(na1[4 * g4] * dv, na1[4 * g4 + 1] * dv) | ((unsigned long long)pk2(na1[4 * g4 + 2] * dv, na1[4 * g4 + 3] * dv) << 32);
                if (dp == 0 && r == 0) *(LAS unsigned long long*)((LAS unsigned char*)nstb + e0 * 2) = (unsigned long long)pk2(nacc[4 * g4], nacc[4 * g4 + 1]) | ((unsigned long long)pk2(nacc[4 * g4 + 2], nacc[4 * g4 + 3]) << 32);
            }
        }
        __syncthreads();
        STAMP(5);
        {
            float hv[32]; float ss = 0.f;
#pragma unroll
            for (int k = 0; k < 4; ++k) { const v4u x = *(const LAS v4u*)(QP + et * PB + eq * 64 + k * 16);
#pragma unroll
                for (int i = 0; i < 4; ++i) { hv[8 * k + 2 * i] = bflo(x[i]); hv[8 * k + 2 * i + 1] = bfhi(x[i]); ss += hv[8 * k + 2 * i] * hv[8 * k + 2 * i] + hv[8 * k + 2 * i + 1] * hv[8 * k + 2 * i + 1]; } }
            ss += shx(ss, 1, lane); ss += shx(ss, 2, lane);
            const float rr = __builtin_amdgcn_rsqf(ss * (1.0f / 128.0f) + EPS);
            bf16* op = optr + (size_t)c * 128 * PLD;
            LAS const float* nw = nwl + eq * 32;
#pragma unroll
            for (int k = 0; k < 4; ++k) { v4u o; const f32x4 w0 = *(LAS const f32x4*)(nw + 8 * k), w1 = *(LAS const f32x4*)(nw + 8 * k + 4);
#pragma unroll
                for (int i = 0; i < 4; ++i) { const float g0 = sigm_f(bflo(og[k][i])), g1 = sigm_f(bfhi(og[k][i]));
                    const float wa = (i < 2) ? w0[2 * i] : w1[2 * i - 4], wb = (i < 2) ? w0[2 * i + 1] : w1[2 * i - 3];
                    o[i] = pk2(hv[8 * k + 2 * i] * rr * wa * g0, hv[8 * k + 2 * i + 1] * rr * wb * g1); }
                *(v4u*)(op + 8 * k) = o; }
        }
    }
#if PROBE_PHASE != -1 && defined(PROBE_STAGES)
    STAMP(6);
    if (tid == 0 && pts) pts[PROBE_STAGES] = tacc;
#endif
#undef STAMP
    __syncthreads();
}

__device__ __forceinline__ void conv_fix(Frame& F, bf16* proj, const bf16* halo, const float* scw, const float* scb, const float* mcw, const float* mcb) {
    const int gt = F.vcu * (NWAVES * 64) + F.tid, NT = F.G * NWAVES * 64;
    for (int it = gt; it < 256 * 320; it += NT) {
        const int strip = it % 320, rg = it / 320, hch = strip * 8;
        const float* wp; const float* bp; int wst; float post = 1.0f;
        if (hch < 1536) { wp = scw + hch; bp = scb + hch; wst = 1536; }
        else { const int c2 = hch - 1536; wp = mcw + c2; bp = mcb + c2; wst = 1024; post = (c2 >= 512) ? 0.08838834764831845f : 1.0f; }
        bf16* base = proj + (size_t)rg * 64 * PLD + PC_XBC + hch;
        v4u r0 = (v4u){0, 0, 0, 0}, r1 = r0, r2 = r0;
        if ((rg & 31) != 0) { const bf16* hp = halo + ((size_t)(rg - 1) * 3) * 2560 + hch; r0 = *(const v4u*)hp; r1 = *(const v4u*)(hp + 2560); r2 = *(const v4u*)(hp + 5120); }
        v4u cur[3];
#pragma unroll
        for (int j = 0; j < 3; ++j) cur[j] = *(const v4u*)(base + (size_t)j * PLD);
        float cw[4][8], cb[8];
#pragma unroll
        for (int j = 0; j < 4; ++j) { const f32x4 a0 = *(const f32x4*)(wp + j * wst), a1 = *(const f32x4*)(wp + j * wst + 4);
#pragma unroll
            for (int i = 0; i < 4; ++i) { cw[j][i] = a0[i]; cw[j][4 + i] = a1[i]; } }
        { const f32x4 a0 = *(const f32x4*)bp, a1 = *(const f32x4*)(bp + 4);
#pragma unroll
          for (int i = 0; i < 4; ++i) { cb[i] = a0[i]; cb[4 + i] = a1[i]; } }
#pragma unroll
        for (int j = 0; j < 3; ++j) { v4u o;
#pragma unroll
            for (int i = 0; i < 4; ++i) {
                const float a0 = cb[2 * i] + cw[0][2 * i] * bflo(r0[i]) + cw[1][2 * i] * bflo(r1[i]) + cw[2][2 * i] * bflo(r2[i]) + cw[3][2 * i] * bflo(cur[j][i]);
                const float a1 = cb[2 * i + 1] + cw[0][2 * i + 1] * bfhi(r0[i]) + cw[1][2 * i + 1] * bfhi(r1[i]) + cw[2][2 * i + 1] * bfhi(r2[i]) + cw[3][2 * i + 1] * bfhi(cur[j][i]);
                o[i] = pk2(silu_f(a0) * post, silu_f(a1) * post); }
            *(v4u*)(base + (size_t)j * PLD) = o; r0 = r1; r1 = r2; r2 = cur[j]; }
    }
}

__device__ __forceinline__ void ksum_pass(Frame& F, const bf16* proj, float* ksum) {
    const int gt = F.vcu * (NWAVES * 64) + F.tid, NT = F.G * NWAVES * 64;
    for (int it = gt; it < 64 * 16 * 64; it += NT) {
        const int ch = it & 63, sl = (it >> 6) & 15, tile = it >> 10;
        const bf16* base = proj + ((size_t)tile * 256 + sl * 16) * PLD + PC_K + ch * 8;
        float a[8];
#pragma unroll
        for (int i = 0; i < 8; ++i) a[i] = 0.f;
        v4u v[16];
#pragma unroll
        for (int j = 0; j < 16; ++j) v[j] = *(const v4u*)(base + (size_t)j * PLD);
#pragma unroll
        for (int j = 0; j < 16; ++j)
#pragma unroll
            for (int i = 0; i < 4; ++i) { a[2 * i] += bflo(v[j][i]); a[2 * i + 1] += bfhi(v[j][i]); }
        float* kd = ksum + (size_t)tile * 512 + ch * 8;
#pragma unroll
        for (int i = 0; i < 8; ++i) atomicAdd(kd + i, a[i]);
    }
}

namespace attn_body {
using bf16=__hip_bfloat16;
using bf16x8=__attribute__((ext_vector_type(8)))short;
using s16x4=__attribute__((ext_vector_type(4)))short;
using f32x16=__attribute__((ext_vector_type(16)))float;
using u32x4=__attribute__((ext_vector_type(4)))unsigned;
constexpr int BATCH=8,NHEAD=8,SEQ=2048,D=64,DM=6144;
constexpr int NW=8,QBLK=32,QB=QBLK*NW,KVBLK=64,NQB=SEQ/QB;
constexpr int ATTN_PITCH=DM, ATTN_UNIT_ROWS=QB;
__device__ __forceinline__ int crow(int r,int hi){return (r&3)+8*(r>>2)+4*hi;}
#define SBAR() __builtin_amdgcn_sched_barrier(0)
__device__ __forceinline__ void cmask(f32x16&p0,f32x16&p1,int jb,int qrel,int hi){
  const float NEG=-INFINITY; int kb=64*jb+4*hi;
  #pragma unroll
  for(int r=0;r<16;++r){int kv=kb+(r&3)+8*(r>>2); if(kv>qrel)p0[r]=NEG; if(kv+32>qrel)p1[r]=NEG;}
}

typedef float f32x4_t __attribute__((ext_vector_type(4)));
__device__ __forceinline__ float bfu(short v){return __uint_as_float(((unsigned)(unsigned short)v)<<16);}
constexpr int NSLOT=3, SLOTB=8192;
constexpr int LDS_K=0, LDS_V=NSLOT*SLOTB, LDS_WS=2*NSLOT*SLOTB, LDS_OST=LDS_WS+NW*64*4, LDS_BYTES=LDS_OST+NW*4096;
constexpr float C2=0.125f*1.4426950408889634f;
__device__ __forceinline__ void glds16(const void*gsrc,unsigned lds_dst){unsigned keep;
  asm volatile("s_mov_b32 %0, m0\n\ts_mov_b32 m0, %2\n\ts_nop 0\n\tglobal_load_lds_dwordx4 %1, off\n\ts_mov_b32 m0, %0":"=&s"(keep):"v"(gsrc),"s"(lds_dst):"memory");}
__device__ __forceinline__ float max3f(float a,float b,float c){float r;asm("v_max3_f32 %0, %1, %2, %3":"=v"(r):"v"(a),"v"(b),"v"(c));return r;}
__device__ __forceinline__ float max2f(float a,float b){float r;asm("v_max_f32_e32 %0, %1, %2":"=v"(r):"v"(a),"v"(b));return r;}
__device__ __forceinline__ float fadd_s(float a,float b){float r;asm("v_add_f32_e32 %0, %1, %2":"=v"(r):"v"(a),"v"(b));return r;}
__device__ __forceinline__ float fsub_s(float a,float b){float r;asm("v_sub_f32_e32 %0, %1, %2":"=v"(r):"v"(a),"v"(b));return r;}
typedef float f32x2_t __attribute__((ext_vector_type(2))); typedef __bf16 bf16x2_t __attribute__((ext_vector_type(2)));
__device__ __forceinline__ unsigned cvtpk_s(float lo,float hi){f32x2_t v={lo,hi};bf16x2_t b=__builtin_convertvector(v,bf16x2_t);return __builtin_bit_cast(unsigned,b);}
#define WAIT_BAR(N) asm volatile("s_waitcnt vmcnt(" #N ") lgkmcnt(0)\n\ts_barrier":::"memory")

__device__ __forceinline__ void qkt(f32x16&p0,f32x16&p1,const char*Kslot,const bf16x8*qr,const f32x16&negm,int r32,int hi){
  const char*kb=Kslot+hi*1024+r32*16;
  #pragma unroll
  for(int d0=0;d0<4;++d0){
    const bf16x8 b0=*reinterpret_cast<const bf16x8*>(kb+d0*2048);
    const bf16x8 b1=*reinterpret_cast<const bf16x8*>(kb+d0*2048+512);
    if(d0==0){p0=__builtin_amdgcn_mfma_f32_32x32x16_bf16(b0,qr[0],negm,0,0,0);p1=__builtin_amdgcn_mfma_f32_32x32x16_bf16(b1,qr[0],negm,0,0,0);}
    else{p0=__builtin_amdgcn_mfma_f32_32x32x16_bf16(b0,qr[d0],p0,0,0,0);p1=__builtin_amdgcn_mfma_f32_32x32x16_bf16(b1,qr[d0],p1,0,0,0);}}
}
typedef __attribute__((address_space(3))) const char* lds_cptr;
typedef short v4i16_t __attribute__((ext_vector_type(4)));
__device__ __forceinline__ void kload8(bf16x8*kf,lds_cptr kp){
  kf[0]=*(const __attribute__((address_space(3))) bf16x8*)(kp);      kf[1]=*(const __attribute__((address_space(3))) bf16x8*)(kp+512);
  kf[2]=*(const __attribute__((address_space(3))) bf16x8*)(kp+2048); kf[3]=*(const __attribute__((address_space(3))) bf16x8*)(kp+2560);
  kf[4]=*(const __attribute__((address_space(3))) bf16x8*)(kp+4096); kf[5]=*(const __attribute__((address_space(3))) bf16x8*)(kp+4608);
  kf[6]=*(const __attribute__((address_space(3))) bf16x8*)(kp+6144); kf[7]=*(const __attribute__((address_space(3))) bf16x8*)(kp+6656);
}
__device__ __forceinline__ void kload2(bf16x8*kf,lds_cptr kp,int j){ kf[2*j]=*(const __attribute__((address_space(3))) bf16x8*)(kp+j*2048); kf[2*j+1]=*(const __attribute__((address_space(3))) bf16x8*)(kp+j*2048+512); }
__device__ __forceinline__ s16x4 vtr(lds_cptr p){ return __builtin_bit_cast(s16x4,__builtin_amdgcn_ds_read_tr16_b64_v4i16((__attribute__((address_space(3))) v4i16_t*)p)); }
__device__ __forceinline__ float rowmax(const f32x16&p0,const f32x16&p1){
  float a=max3f(p0[0],p0[1],p1[0]),b=max3f(p0[2],p0[3],p1[1]);a=max3f(a,p1[2],p1[3]);
  #pragma unroll
  for(int r=4;r<16;r+=4){a=max3f(a,p0[r],p0[r+1]);b=max3f(b,p0[r+2],p0[r+3]);a=max3f(a,p1[r],p1[r+1]);b=max3f(b,p1[r+2],p1[r+3]);}
  const float m=max2f(a,b);
  auto rr=__builtin_amdgcn_permlane32_swap(__float_as_uint(m),__float_as_uint(m),false,false);
  return max2f(__uint_as_float(rr[0]),__uint_as_float(rr[1]));
}
__device__ __forceinline__ void pv(f32x16*o,int vb,bf16x8 pa0,bf16x8 pa1,bf16x8 pa2,bf16x8 pa3){
  #pragma unroll
  for(int d0=0;d0<2;++d0){s16x4 lo[4],hi[4];
    #pragma unroll
    for(int ks=0;ks<4;++ks){
      asm volatile("ds_read_b64_tr_b16 %0,%1 offset:%c2":"=&v"(lo[ks]):"v"(vb),"i"(d0*4096+ks*1024):"memory");
      asm volatile("ds_read_b64_tr_b16 %0,%1 offset:%c2":"=&v"(hi[ks]):"v"(vb),"i"(d0*4096+ks*1024+512):"memory");}
    asm volatile("s_waitcnt lgkmcnt(0)":::"memory");SBAR();
    #define PK(k) (bf16x8){lo[k][0],lo[k][1],lo[k][2],lo[k][3],hi[k][0],hi[k][1],hi[k][2],hi[k][3]}
    o[d0]=__builtin_amdgcn_mfma_f32_32x32x16_bf16(pa0,PK(0),o[d0],0,0,0);
    o[d0]=__builtin_amdgcn_mfma_f32_32x32x16_bf16(pa1,PK(1),o[d0],0,0,0);
    o[d0]=__builtin_amdgcn_mfma_f32_32x32x16_bf16(pa2,PK(2),o[d0],0,0,0);
    o[d0]=__builtin_amdgcn_mfma_f32_32x32x16_bf16(pa3,PK(3),o[d0],0,0,0);
    #undef PK
  }
}

#ifndef ATTN_STORE16
#define ATTN_STORE16(p,v) (*(u32x4*)(p)=(v))
#endif
template<int THRL> __device__ __forceinline__ void attn_unit(int tid,int b,int h,int qb,const bf16*Q,const bf16*__restrict__ K,const bf16*__restrict__ V,bf16*O,const float*__restrict__ ksum,char*shm){
  asm volatile("":"+v"(tid));
  const int lane=tid&63,r32=lane&31,hi=lane>>5; const int wid=__builtin_amdgcn_readfirstlane(tid>>6);
  const long rowbase=(long)b*SEQ; const int q0=qb*QB;
  const bf16*Qw=Q+(rowbase+q0+wid*QBLK)*DM+h*D;
  const bf16*Kh=K+rowbase*DM+h*D,*Vh=V+rowbase*DM+h*D;
  const unsigned lds0=(unsigned)(uintptr_t)shm;
  float*wsf=(float*)(shm+LDS_WS)+wid*64;
  const bf16*ksrc=Kh+(long)lane*DM+wid*8;
  const bf16*vsrc=Vh+(long)(16*(wid&3)+(lane>>2))*DM+(wid>>2)*32+(lane&3)*8;
  const unsigned kdst=lds0+LDS_K+wid*1024, vdst=lds0+LDS_V+wid*1024;
  #define DMA_K(t,slot) glds16(ksrc+(long)(t)*KVBLK*DM,(unsigned)__builtin_amdgcn_readfirstlane(kdst+(slot)))
  #define DMA_V(t,slot) glds16(vsrc+(long)(t)*KVBLK*DM,(unsigned)__builtin_amdgcn_readfirstlane(vdst+(slot)))
  const int vb0=(int)(lds0+LDS_V)+((lane>>4)&1)*32+(lane&3)*8+(4*hi+((lane&15)>>2))*64;
  const char*Kbase=shm+LDS_K; bf16x8 kf[8];
  const lds_cptr shm3=(lds_cptr)shm; const lds_cptr kp0=shm3+LDS_K+hi*1024+r32*16; const lds_cptr vp0=shm3+LDS_V+((lane>>4)&1)*32+(lane&3)*8+(4*hi+((lane&15)>>2))*64;
  const int NT=(q0+QB)/KVBLK;
  DMA_K(0,0);DMA_V(0,0);DMA_K(1,SLOTB);
  bf16x8 qr[4];
  #pragma unroll
  for(int d0=0;d0<4;++d0)qr[d0]=*reinterpret_cast<const bf16x8*>(&Qw[(long)r32*DM+d0*16+hi*8]);
  unsigned sel=(1u<<qb)-1u;
  if(qb>=4){
    float g[8];
    #pragma unroll
    for(int n=0;n<8;++n){ g[n]=0.f;
      { const float*kp=ksum+(((long)(b*8+n)*NHEAD+h)*64)+hi*8; float a=0.f;
        #pragma unroll
        for(int d0=0;d0<4;++d0){ const f32x4_t k0=*(const f32x4_t*)(kp+d0*16),k1=*(const f32x4_t*)(kp+d0*16+4);
          #pragma unroll
          for(int j=0;j<4;++j){ a+=bfu(qr[d0][j])*k0[j]; a+=bfu(qr[d0][4+j])*k1[j]; } }
        a+=shx(a,32,lane); g[n]=a; } }
    sel=0u;
    #pragma unroll
    for(int k=0;k<3;++k){ int best=-1; float bv=0.f;
      #pragma unroll
      for(int n=0;n<8;++n) if(n<qb&&!((sel>>n)&1u)){ if(best<0||g[n]>bv){best=n;bv=g[n];} }
      sel|=1u<<best; }
  }
  #define KEEP(t) (((t)>=NT-4)||((sel>>((t)>>2))&1u))
  float mhat=0.f,l_reg=0.f;f32x16 o[2];o[0]=f32x16{};o[1]=f32x16{};f32x16 negm=f32x16{};asm volatile("":"+v"(negm));
  const int qrel=wid*QBLK+r32;
  #define CMASK(P0,P1,t) do{int jb_=(t)-(NT-4); if(jb_>=0)cmask(P0,P1,jb_,qrel,hi);}while(0)
  bool resc=false;
  #define START(P0,P1) do{ const float rm=KEEP(0)?rowmax(P0,P1):-INFINITY; resc=false; \
    { const float dl=max2f(rm,-64.f); mhat=fadd_s(mhat,dl); \
      _Pragma("unroll") for(int r=0;r<16;++r){P0[r]=fsub_s(P0[r],dl);P1[r]=fsub_s(P1[r],dl);} \
      _Pragma("unroll") for(int r=0;r<16;++r)negm[r]=-mhat; asm volatile("":"+v"(negm)); } \
    _Pragma("unroll") for(int r=0;r<16;++r)P0[r]=__builtin_amdgcn_exp2f(P0[r]); }while(0)
  #define RESC() do{ if(resc){ asm volatile("s_waitcnt lgkmcnt(0)":::"memory"); \
      _Pragma("unroll") for(int d_=0;d_<2;++d_) _Pragma("unroll") for(int r=0;r<16;++r)o[d_][r]*=wsf[crow(r,hi)]; } }while(0)
  f32x16 pA0,pA1,pB0,pB1;
  int sl_prev=0,sl_cur=0,sl_next=SLOTB;
  #define ROT() do{sl_prev=sl_cur;sl_cur=sl_next;sl_next=(sl_next==(NSLOT-1)*SLOTB)?0:sl_next+SLOTB;}while(0)
  DMA_K(2,2*SLOTB);
  WAIT_BAR(3);
  qkt(pA0,pA1,Kbase,qr,negm,r32,hi);asm volatile("s_nop 15\n\ts_nop 7":"+v"(pA0),"+v"(pA1));CMASK(pA0,pA1,0);
  START(pA0,pA1);
  _Pragma("unroll") for(int r=0;r<16;++r)pA1[r]=__builtin_amdgcn_exp2f(pA1[r]);
  WAIT_BAR(0);
  DMA_K(3,0);DMA_V(1,SLOTB);
  ROT();
  kload8(kf,kp0+sl_cur);
  WAIT_BAR(2);
  s16x4 vlo[8],vhi[8]; u32x4 pw0,pw1,pw2,pw3;
  #define PKW(P,B) (cvtpk_s(P[B],P[B+1])&kmp_)
  #define PAF(k) __builtin_bit_cast(bf16x8,pw##k)
  #define VFR(i) (bf16x8){vlo[i][0],vlo[i][1],vlo[i][2],vlo[i][3],vhi[i][0],vhi[i][1],vhi[i][2],vhi[i][3]}
  #define PIN(x) asm volatile("":"+v"(x))
  #define MX3(a,b,c) __builtin_fmaxf(__builtin_fmaxf((a),(b)),(c))
  #define GAPA(MF,A0,A1,A2,A3,W0,W1,PW) do{ MF; sacc+=A0; sacc+=A1; sacc+=A2; sacc+=A3; PIN(sacc); W0; W1; PIN(PW); SBAR(); }while(0)
  #define EX(v) __builtin_amdgcn_exp2f(v)
  #define GAPB(MF,X,B) do{ MF; X[B]=EX(X[B]); X[B+1]=EX(X[B+1]); X[B+2]=EX(X[B+2]); X[B+3]=EX(X[B+3]); PIN(X); SBAR(); }while(0)
  #define VRD(i) do{ vlo[i]=vtr(vp_+(((i)>>2)*4096+((i)&3)*1024)); vhi[i]=vtr(vp_+(((i)>>2)*4096+((i)&3)*1024+512)); }while(0)
  #define KRD(G,j) do{ if(G){ kload2(kf,kp0+sl_next,j); SBAR(); } }while(0)
  #define STEP(C0,C1,P0,P1,t,GK,GV,GL) do{ SBAR(); \
    const lds_cptr vp_=vp0+sl_prev; const bool kp_=KEEP((t)-1); const unsigned kmp_=kp_?0xffffffffu:0u; const float kfp_=kp_?1.f:0.f; \
    VRD(0); SBAR(); float sacc=(P0[0]+P0[1]); \
    GAPA(C0=__builtin_amdgcn_mfma_f32_32x32x16_bf16(kf[0],qr[0],negm,0,0,0), P0[2],P0[3],P0[4],P0[5],     pw0[0]=PKW(P0,0), pw0[1]=PKW(P0,2), pw0); \
    VRD(4); SBAR(); GAPA(C1=__builtin_amdgcn_mfma_f32_32x32x16_bf16(kf[1],qr[0],negm,0,0,0), P0[6],P0[7],P0[8],P0[9],     pw0[2]=PKW(P0,4), pw0[3]=PKW(P0,6), pw0); \
    VRD(1); SBAR(); GAPA(C0=__builtin_amdgcn_mfma_f32_32x32x16_bf16(kf[2],qr[1],C0,0,0,0),   P0[10],P0[11],P0[12],P0[13], pw1[0]=PKW(P0,8), pw1[1]=PKW(P0,10), pw1); \
    VRD(5); SBAR(); GAPA(C1=__builtin_amdgcn_mfma_f32_32x32x16_bf16(kf[3],qr[1],C1,0,0,0),   P0[14],P0[15],P1[0],P1[1],   pw1[2]=PKW(P0,12),pw1[3]=PKW(P0,14), pw1); \
    VRD(2); SBAR(); GAPA(C0=__builtin_amdgcn_mfma_f32_32x32x16_bf16(kf[4],qr[2],C0,0,0,0),   P1[2],P1[3],P1[4],P1[5],     pw2[0]=PKW(P1,0), pw2[1]=PKW(P1,2), pw2); \
    VRD(6); SBAR(); GAPA(C1=__builtin_amdgcn_mfma_f32_32x32x16_bf16(kf[5],qr[2],C1,0,0,0),   P1[6],P1[7],P1[8],P1[9],     pw2[2]=PKW(P1,4), pw2[3]=PKW(P1,6), pw2); \
    VRD(3); SBAR(); GAPA(C0=__builtin_amdgcn_mfma_f32_32x32x16_bf16(kf[6],qr[3],C0,0,0,0),   P1[10],P1[11],P1[12],P1[13], pw3[0]=PKW(P1,8), pw3[1]=PKW(P1,10), pw3); \
    VRD(7); SBAR(); GAPA(C1=__builtin_amdgcn_mfma_f32_32x32x16_bf16(kf[7],qr[3],C1,0,0,0),   P1[14],P1[15],0.f,0.f,       pw3[2]=PKW(P1,12),pw3[3]=PKW(P1,14), pw3); \
    l_reg=__builtin_fmaf(sacc,kfp_,l_reg); \
    if(GK){DMA_K((t)+3,sl_cur);} if(GV){DMA_V((t)+1,sl_next);} \
    CMASK(C0,C1,t); \
    { float a=MX3(C0[0],C0[1],C1[0]),b=MX3(C0[2],C0[3],C1[1]); a=MX3(a,C1[2],C1[3]); \
      _Pragma("unroll") for(int r=4;r<16;r+=4){a=MX3(a,C0[r],C0[r+1]);b=MX3(b,C0[r+2],C0[r+3]);a=MX3(a,C1[r],C1[r+1]);b=MX3(b,C1[r+2],C1[r+3]);} \
      float rm=__builtin_fmaxf(a,b); { auto rr=__builtin_amdgcn_permlane32_swap(__float_as_uint(rm),__float_as_uint(rm),false,false); rm=__builtin_fmaxf(__uint_as_float(rr[0]),__uint_as_float(rr[1])); } \
      rm=KEEP(t)?rm:-INFINITY; \
      resc=false; \
      if(__builtin_expect(__any(rm>(float)THRL),0)){ const float dl=__builtin_fmaxf(rm,0.f); mhat+=dl; \
        _Pragma("unroll") for(int r=0;r<16;++r){C0[r]-=dl;C1[r]-=dl;} \
        _Pragma("unroll") for(int r=0;r<16;++r)negm[r]=-mhat; asm volatile("":"+v"(negm)); \
        const float f=__builtin_amdgcn_exp2f(-dl); l_reg*=f; if(hi==0)wsf[r32]=f; resc=true; } } \
    SBAR(); \
    GAPB(o[0]=__builtin_amdgcn_mfma_f32_32x32x16_bf16(PAF(0),VFR(0),o[0],0,0,0), C0,0); \
    GAPB(o[1]=__builtin_amdgcn_mfma_f32_32x32x16_bf16(PAF(0),VFR(4),o[1],0,0,0), C0,4); \
    KRD(GL,0); GAPB(o[0]=__builtin_amdgcn_mfma_f32_32x32x16_bf16(PAF(1),VFR(1),o[0],0,0,0), C0,8); \
    KRD(GL,1); GAPB(o[1]=__builtin_amdgcn_mfma_f32_32x32x16_bf16(PAF(1),VFR(5),o[1],0,0,0), C0,12); \
    KRD(GL,2); GAPB(o[0]=__builtin_amdgcn_mfma_f32_32x32x16_bf16(PAF(2),VFR(2),o[0],0,0,0), C1,0); \
    KRD(GL,3); GAPB(o[1]=__builtin_amdgcn_mfma_f32_32x32x16_bf16(PAF(2),VFR(6),o[1],0,0,0), C1,4); \
    GAPB(o[0]=__builtin_amdgcn_mfma_f32_32x32x16_bf16(PAF(3),VFR(3),o[0],0,0,0), C1,8); \
    GAPB(o[1]=__builtin_amdgcn_mfma_f32_32x32x16_bf16(PAF(3),VFR(7),o[1],0,0,0), C1,12); \
    }while(0)
  int t=1;
  #undef CMASK
  #define CMASK(P0,P1,t) do{}while(0)
  for(;t+5<NT;t+=2){
    STEP(pB0,pB1,pA0,pA1,t,true,true,true);     WAIT_BAR(2); RESC(); ROT();
    STEP(pA0,pA1,pB0,pB1,t+1,true,true,true);   WAIT_BAR(2); RESC(); ROT();
  }
  #undef CMASK
  #define CMASK(P0,P1,t) do{int jb_=(t)-(NT-4); if(jb_>=0)cmask(P0,P1,jb_,qrel,hi);}while(0)
  #define ENDW(tt) do{ if((tt)+3<NT){WAIT_BAR(2);} else if((tt)+2<NT){WAIT_BAR(1);} else {WAIT_BAR(0);} }while(0)
  for(;t+1<NT;t+=2){
    STEP(pB0,pB1,pA0,pA1,t,(t+3<NT),(t+1<NT),(t+1<NT));       ENDW(t);   RESC(); ROT();
    STEP(pA0,pA1,pB0,pB1,t+1,(t+4<NT),(t+2<NT),(t+2<NT));     ENDW(t+1); RESC(); ROT();
  }
  STEP(pB0,pB1,pA0,pA1,NT-1,false,false,false); RESC();
  { const unsigned kmp_=0xffffffffu; float sacc=pB0[0]+pB0[1]; _Pragma("unroll") for(int r=2;r<16;++r)sacc+=pB0[r]; _Pragma("unroll") for(int r=0;r<16;++r)sacc+=pB1[r]; l_reg+=sacc;
    pw0=(u32x4){PKW(pB0,0),PKW(pB0,2),PKW(pB0,4),PKW(pB0,6)};pw1=(u32x4){PKW(pB0,8),PKW(pB0,10),PKW(pB0,12),PKW(pB0,14)};pw2=(u32x4){PKW(pB1,0),PKW(pB1,2),PKW(pB1,4),PKW(pB1,6)};pw3=(u32x4){PKW(pB1,8),PKW(pB1,10),PKW(pB1,12),PKW(pB1,14)};
    SBAR(); pv(o,vb0+sl_cur,PAF(0),PAF(1),PAF(2),PAF(3)); }
  #undef PKW
  #undef PAF
  #undef VFR
  #undef PIN
  #undef MX3
  #undef GAPA
  #undef GAPB
  #undef EX
  #undef VRD
  #undef KRD
  #undef STEP
  #undef ENDW
  {auto rr=__builtin_amdgcn_permlane32_swap(__float_as_uint(l_reg),__float_as_uint(l_reg),false,false);l_reg=__uint_as_float(rr[0])+__uint_as_float(rr[1]);}
  if(hi==0)wsf[32+r32]=l_reg;asm volatile("s_waitcnt lgkmcnt(0)":::"memory");
  float rli[16];
  #pragma unroll
  for(int r=0;r<16;++r)rli[r]=__builtin_amdgcn_rcpf(wsf[32+crow(r,hi)]);
  bf16*Ow=O+(rowbase+q0+wid*QBLK)*DM+h*D;
  { bf16*stg=(bf16*)(shm+LDS_OST)+wid*2048;
    #pragma unroll
    for(int r=0;r<16;++r){const int orow=crow(r,hi);
      #pragma unroll
      for(int d0=0;d0<2;++d0)stg[orow*64+d0*32+r32]=__float2bfloat16(o[d0][r]*rli[r]);}
    asm volatile("s_waitcnt lgkmcnt(0)":::"memory");
    #pragma unroll
    for(int i=0;i<4;++i){const int row=i*8+(lane>>3),ch=lane&7; const u32x4 v=*(const u32x4*)(stg+row*64+ch*8); ATTN_STORE16(Ow+(long)row*DM+ch*8,v);} }
  asm volatile("s_waitcnt lgkmcnt(0)\n\ts_barrier":::"memory");
  #undef KEEP
  #undef DMA_K
  #undef DMA_V
  #undef CMASK
  #undef START
  #undef RESC
  #undef ROT
}
constexpr int ATTN_LDS_BYTES=LDS_BYTES;
#undef SBAR
#undef WAIT_BAR
}

constexpr int PH_PER_LAYER = 10, N_PHASES = PH_PER_LAYER * DEPTH;

constexpr int CONV_UNIT_ITEMS = 16, N_CONV_UNITS = (1024 + 2816) / CONV_UNIT_ITEMS;
__device__ __forceinline__ void conv_unit(int wave, int lane, int idx, const float* w_out, const float* ssm_nw, const float* w_up, const float* n2w, bf16* bufa, bf16* bufb, LAS float* scr) {
    for (int it = CONV_UNIT_ITEMS * idx + wave; it < CONV_UNIT_ITEMS * idx + CONV_UNIT_ITEMS; it += NWAVES) {
        if (it < 1024) { const int kb = it >> 5, nb = it & 31; conv_item(w_out, DM, 32 * nb, bufb, DMIX, 32 * nb, 64 * kb, scr, lane, ssm_nw, 512, 1536); }
        else { const int i2 = it - 1024, kb = i2 / (ULD / 32), nb = i2 % (ULD / 32); const int src = ((nb >> 2) & 1) * FFN + 128 * (nb >> 3) + (nb & 3) * 32;
            conv_item(w_up, ULD, src, bufa, DM, 32 * nb, 64 * kb, scr, lane, n2w); }
    }
}

template <int L, int P>
__device__ __forceinline__ void run_phase(Frame& F, const int wave0, const int ph_lo, const int ph_hi) {
    constexpr int l = L, p = P, ph = L * PH_PER_LAYER + P;
    if constexpr ((L > 0 && P == 0) || P == 4 || P == 6 || P == 8) return;
    if (!(ph_lo <= ph && ph < ph_hi)) return;
    {
        const __attribute__((address_space(4))) Args* ap = (const __attribute__((address_space(4))) Args*)__builtin_amdgcn_kernarg_segment_ptr();
        asm volatile("" : "+s"(ap));
        { int t_ = wave0 * 64 + fresh_lane(); asm volatile("" : "+v"(t_)); F.tid = t_; F.lane = t_ & 63; F.wave = __builtin_amdgcn_readfirstlane(t_ >> 6); }
        F.G = gridDim.x; { const int bx = blockIdx.x; F.vcu = (F.G % 8 == 0) ? (bx % 8) * (F.G / 8) + bx / 8 : bx; }
        unsigned char* ws = ap->ws; float* out = ap->out;
        bf16* bufa = (bf16*)(ws + WS_BUFA); bf16* bufb = (bf16*)(ws + WS_BUFB); bf16* xb = (bf16*)(ws + WS_XB); bf16* proj = (bf16*)(ws + WS_PROJ);
        float* smallp = (float*)(ws + WS_SMALLP); float* ssq = (float*)(ws + WS_SSQ);
        switch (p) {
        case 0: {
            LAS float* scr = (LAS float*)(F.lds + F.wave * 16384);
            conv_w_in(F, ap->in[2], ap->in[1], bufa, scr);
            conv_small(F, ap->in[2], ap->in[1], (bf16*)(ws + WS_WSM));
            row_pass0(F, ap->in[0], xb, (float*)(ws + WS_RS));
        } break;
        case 1: {
            const float* rs = (const float*)(ws + WS_RS) + (size_t)(2 * l) * M;
            pg8::Gemm g{xb, bufa, M, PLD, DM, DM}; pg8::StaticOrder S; S.init(M, PLD, F.G, (int)blockIdx.x);
            pg8::EpiProj E{ws, (const float* const __attribute__((address_space(4)))*)ap->in, l};
            pg8::gemm_phase<pg8::EpiProj>(F.lds + RING_OFF, g, S, E, F.tid);
            small_proj(F, xb, (const bf16*)(ws + WS_WSM) + (size_t)(l & 1) * 32 * DM, rs, smallp);
        } break;
        case 2: {
            ksum_pass(F, proj, (float*)(ws + WS_KSUM + (size_t)l * 131072));
            conv_fix(F, proj, (const bf16*)(ws + WS_HALO), ap->in[5] + (size_t)l * 4 * 1536, ap->in[6] + l * 1536, ap->in[11] + (size_t)l * 4 * 1024, ap->in[12] + l * 1024);
        } break;
        case 3: {
            constexpr int QN = 4 + 16 + 64 + N_CONV_UNITS / 8;
            gu32* qheads = (gu32*)(ws + WS_QUEUE) + l * 8 * 64;
            volatile LAS unsigned* MISC = (volatile LAS unsigned*)(F.lds + MISC_OFF);
            const attn_body::bf16* pq = (const attn_body::bf16*)proj; const float* ks = (const float*)(ws + WS_KSUM + (size_t)l * 131072);
            const int x0 = (int)(xb_xcc_id() & 7u);
            for (int hop = 0; hop < 8;) {
                const int x = (x0 + hop) & 7;
                const int tq = wave0 * 64 + fresh_lane();
                __syncthreads();
                if (tq == 0) MISC[0] = __hip_atomic_fetch_add(qheads + x * 64, 1u, RLX_AGENT);
                __syncthreads();
                const int j = (int)MISC[0];
                if (j >= QN) { ++hop; continue; }
#if PROBE_PHASE != -1
                const unsigned long long tu0 = __builtin_amdgcn_s_memrealtime();
                const int u = (j < 4) ? (x * 4 + j) : (j < 20) ? (32 + x * 16 + j - 4) : 160 + x * 64 + j - 20;
#endif
                if (j < 4) mlstm_unit(tq, proj, smallp, ap->in[13] + l * 4, ap->in[14] + l * 4, ap->in[15] + l * 512, x, j, F.lds, (float*)(ws + WS_GSC) + (size_t)(x * 4 + j) * 16 * 656, (l == 0 && x == 0 && j == 0) ? (unsigned long long*)(ws + WS_TS) + 1024 : nullptr);
                else if (j < 20) ssd_unit(tq, proj, smallp, ssq, ap->in[7] + l * 16, ap->in[8] + l * 16, ap->in[9] + l * 16, x, j - 4, F.lds);
                else if (j < 84) { const int idx = j - 20, h = idx & 7, qb = 7 - (idx >> 3);
                    attn_body::attn_unit<8>(tq, x, h, qb, pq + PC_Q, pq + PC_K, pq + PC_V, (attn_body::bf16*)proj + PC_Q, ks, (char*)F.lds); }
                else conv_unit(wave0, tq & 63, x * (N_CONV_UNITS / 8) + j - 84, ap->in[16] + (size_t)l * DMIX * DM, ap->in[10] + l * 1024, ap->in[18] + (size_t)l * DM * ULD, ap->in[17] + l * DM, bufa, bufb, (LAS float*)(F.lds + wave0 * 16384));
#if PROBE_PHASE != -1
                if (l == 0 && wave0 == 0 && fresh_lane() == 0) __hip_atomic_store((unsigned long long*)(ws + WS_TS) + 128 + u, (unsigned long long)(__builtin_amdgcn_s_memrealtime() - tu0), __ATOMIC_RELAXED, __HIP_MEMORY_SCOPE_AGENT);
#endif
            }
        } break;
        case 4: break;
        case 5: {
            pg8::Gemm g{proj, bufb, M, DM, DMIX, PLD}; pg8::StaticOrder S; S.init(M, DM, F.G, (int)blockIdx.x);
            LAS float* ftab = (LAS float*)(F.lds + RING_BYTES);
            { pg8::Unit u0; if (S.next(0, u0)) { const int row = F.tid >> 1; const float* sq = ssq + (size_t)(u0.pm * 256 + row) * 16;
                const f32x4 a0 = *(const f32x4*)sq, a1 = *(const f32x4*)(sq + 4), a2 = *(const f32x4*)(sq + 8), a3 = *(const f32x4*)(sq + 12);
                const float s0 = ((a0[0] + a0[1]) + (a0[2] + a0[3])) + ((a1[0] + a1[1]) + (a1[2] + a1[3])), s1 = ((a2[0] + a2[1]) + (a2[2] + a2[3])) + ((a3[0] + a3[1]) + (a3[2] + a3[3]));
                const float r0 = 1.0f / sqrtf(s0 * (1.0f / 512.0f) + EPS), r1 = 1.0f / sqrtf(s1 * (1.0f / 512.0f) + EPS);
                ftab[F.tid] = (F.tid & 1) ? r1 : r0 / r1; } }
            LDS_WAIT(); __syncthreads();
            pg8::EpiRes E{xb, nullptr, (float*)(ws + WS_RS) + (size_t)(2 * l + 1) * M};
            pg8::gemm_phase<pg8::EpiRes, 1>(F.lds + RING_OFF, g, S, E, F.tid, (const LAS float*)ftab);
        } break;
        case 6: break;
        case 7: {
            pg8::Gemm g{xb, bufa, M, ULD, DM, DM}; pg8::StaticOrder S; S.init(M, ULD, F.G, (int)blockIdx.x);
            pg8::EpiFfn E{proj, (const float*)(ws + WS_RS) + (size_t)(2 * l + 1) * M, ap->in[19] + (size_t)l * 3 * FFN, ap->in[20] + l * FFN, (bf16*)(ws + WS_SIDEA), (bf16*)(ws + WS_SIDEB)};
            pg8::gemm_phase<pg8::EpiFfn>(F.lds + RING_OFF, g, S, E, F.tid);
            {
                const bool half = (F.G == 256); if (!half || blockIdx.x >= 128) { Frame F2 = F; if (half) { F2.vcu = (int)blockIdx.x - 128; F2.G = 128; }
                    conv_plain(F2, ap->in[21] + (size_t)l * FFN * DM, FFN, DM, nullptr, bufb, (LAS float*)(F.lds + F.wave * 16384));
                    if (l + 1 < DEPTH) conv_small(F2, ap->in[2] + (size_t)(l + 1) * DM * P_IN, ap->in[1] + (l + 1) * DM, (bf16*)(ws + WS_WSM) + (size_t)((l + 1) & 1) * 32 * DM); } }
        } break;
        case 8: break;
        case 9: {
            pg8::Gemm g{proj, bufb, M, DM, FFN, FFN}; pg8::StaticOrder S; S.init(M, DM, F.G, (int)blockIdx.x);
            { pg8::Unit u0; for (int i = 0; S.next(i, u0); ++i) ffn_fix(F, proj, (const bf16*)(ws + WS_SIDEA), (const bf16*)(ws + WS_SIDEB), ap->in[19] + (size_t)l * 3 * FFN, ap->in[20] + l * FFN, u0.pm); }
            VM_WAIT(); __syncthreads();
            pg8::EpiRes E{xb, (l + 1 < DEPTH) ? nullptr : out, (float*)(ws + WS_RS) + (size_t)(2 * l + 2) * M};
            pg8::gemm_phase<pg8::EpiRes>(F.lds + RING_OFF, g, S, E, F.tid);
            if (l + 1 < DEPTH) conv_w_in(F, ap->in[2] + (size_t)(l + 1) * DM * P_IN, ap->in[1] + (l + 1) * DM, bufa, (LAS float*)(F.lds + F.wave * 16384));
        } break;
        }
        if (ph + 1 < ph_hi || PROBE_PHASE != -1) { XcdBarrier bar; bar.bar = (unsigned*)(ap->ws + WS_CTL) + CW_BAR; bar.x = xb_xcc_id(); bar.st = (volatile LAS unsigned*)(F.lds + MISC_OFF) + 8; xcd_barrier(bar, wave0 * 64 + fresh_lane()); }
#if PROBE_PHASE != -1
        if (blockIdx.x == 0 && wave0 == 0 && fresh_lane() == 0) { const unsigned long long tnow = __builtin_amdgcn_s_memrealtime();
            __hip_atomic_store((unsigned long long*)(ap->ws + WS_TS) + 1 + ph, tnow, __ATOMIC_RELAXED, __HIP_MEMORY_SCOPE_AGENT);
            if (P == 3 || P == 5 || P == 7 || P == 9) __hip_atomic_store((unsigned long long*)(ap->ws + WS_TS) + 2 + ph, tnow, __ATOMIC_RELAXED, __HIP_MEMORY_SCOPE_AGENT); }
#endif
    }
}

__global__ void __launch_bounds__(NWAVES * 64, 2) fwd(Args args) {
    extern __shared__ __attribute__((aligned(16))) unsigned char lds[];
    Frame F;
    F.lds = (LAS unsigned char*)lds;
    F.tid = threadIdx.x; F.lane = F.tid & 63; F.wave = __builtin_amdgcn_readfirstlane(F.tid >> 6);
    const int wave0 = F.wave;
    for (int u = F.tid; u < (LDS_BYTES - LDSCTL_OFF) / 4; u += NWAVES * 64) ((LAS unsigned*)(F.lds + LDSCTL_OFF))[u] = 0u;
    __syncthreads();
    const int ph_lo = args.ph_lo, ph_hi = args.ph_hi;
#if PROBE_PHASE != -1
    if (blockIdx.x == 0 && F.tid == 0) __hip_atomic_store((unsigned long long*)(args.ws + WS_TS), (unsigned long long)__builtin_amdgcn_s_memrealtime(), __ATOMIC_RELAXED, __HIP_MEMORY_SCOPE_AGENT);
#endif
    if (ph_hi - ph_lo > 1) (void)xcd_barrier_post((unsigned*)(args.ws + WS_CTL) + CW_BAR, (volatile LAS unsigned*)(F.lds + MISC_OFF) + 8);

    run_phase<0, 0>(F, wave0, ph_lo, ph_hi);
    run_phase<0, 1>(F, wave0, ph_lo, ph_hi);
    run_phase<0, 2>(F, wave0, ph_lo, ph_hi);
    run_phase<0, 3>(F, wave0, ph_lo, ph_hi);
    run_phase<0, 4>(F, wave0, ph_lo, ph_hi);
    run_phase<0, 5>(F, wave0, ph_lo, ph_hi);
    run_phase<0, 6>(F, wave0, ph_lo, ph_hi);
    run_phase<0, 7>(F, wave0, ph_lo, ph_hi);
    run_phase<0, 8>(F, wave0, ph_lo, ph_hi);
    run_phase<0, 9>(F, wave0, ph_lo, ph_hi);
    run_phase<1, 0>(F, wave0, ph_lo, ph_hi);
    run_phase<1, 1>(F, wave0, ph_lo, ph_hi);
    run_phase<1, 2>(F, wave0, ph_lo, ph_hi);
    run_phase<1, 3>(F, wave0, ph_lo, ph_hi);
    run_phase<1, 4>(F, wave0, ph_lo, ph_hi);
    run_phase<1, 5>(F, wave0, ph_lo, ph_hi);
    run_phase<1, 6>(F, wave0, ph_lo, ph_hi);
    run_phase<1, 7>(F, wave0, ph_lo, ph_hi);
    run_phase<1, 8>(F, wave0, ph_lo, ph_hi);
    run_phase<1, 9>(F, wave0, ph_lo, ph_hi);
#if PROBE_PHASE != -1
    {
        const __attribute__((address_space(4))) Args* ap = (const __attribute__((address_space(4))) Args*)__builtin_amdgcn_kernarg_segment_ptr();
        const unsigned long long* ts = (const unsigned long long*)(ap->ws + WS_TS);
        float us = 500.f;
#ifdef PROBE_UNIT
        if (true) { us = 0.01f * (float)__hip_atomic_load(ts + PROBE_UNIT, __ATOMIC_RELAXED, __HIP_MEMORY_SCOPE_AGENT); } else
#endif
        if (PROBE_PHASE >= 0) { us = 0.f;
            for (int l = 0; l < DEPTH; ++l) { const int ph = l * PH_PER_LAYER + PROBE_PHASE; if (ph < N_PHASES - 1) us += 0.01f * (float)(__hip_atomic_load(ts + 1 + ph, __ATOMIC_RELAXED, __HIP_MEMORY_SCOPE_AGENT) - __hip_atomic_load(ts + ph, __ATOMIC_RELAXED, __HIP_MEMORY_SCOPE_AGENT)); } }
        const float dl = sqrtf(PROBE_GAIN * us);
        float* o = ap->out;
        for (size_t i = (size_t)blockIdx.x * 512 + wave0 * 64 + fresh_lane(); i < (size_t)M * DM; i += (size_t)gridDim.x * 512) o[i] += (i & 1) ? dl : -dl;
    }
#endif
}

extern "C" void kernel_launch(void* const* d_in, const int* in_sizes, int n_in, void* d_out, int out_size, void* d_ws, size_t ws_size, hipStream_t stream) {
    static int grid = 0;
    if (grid == 0) {
        if (n_in != 22 || in_sizes[0] != M * DM || out_size != M * DM || ws_size < WS_END) { fprintf(stderr, "kernel_launch: unexpected shapes (n_in %d, in0 %d, out %d, ws %zu); nothing launched\n", n_in, n_in > 0 ? in_sizes[0] : -1, out_size, ws_size); grid = -1; return; }
        int dev = 0, cus = 0, per_cu = 0;
        if (hipGetDevice(&dev) != hipSuccess || hipDeviceGetAttribute(&cus, hipDeviceAttributeMultiprocessorCount, dev) != hipSuccess) { grid = -1; return; }
        if (hipFuncSetAttribute((const void*)fwd, hipFuncAttributeMaxDynamicSharedMemorySize, LDS_BYTES) != hipSuccess) { fprintf(stderr, "kernel_launch: hipFuncSetAttribute failed\n"); grid = -1; return; }
        if (hipOccupancyMaxActiveBlocksPerMultiprocessor(&per_cu, (const void*)fwd, NWAVES * 64, LDS_BYTES) != hipSuccess || per_cu < 1) { fprintf(stderr, "kernel_launch: occupancy query reports %d blocks per CU\n", per_cu); per_cu = 1; }
        (void)hipGetLastError();
        grid = cus;
    }
    if (grid < 0) return;
    (void)hipMemsetAsync((char*)d_ws + WS_CTL, 0, CTL_ZERO_BYTES, stream);
    Args a{};
    for (int i = 0; i < 22; ++i) a.in[i] = (const float*)d_in[i];
    a.out = (float*)d_out; a.ws = (unsigned char*)d_ws;
#if MK_MULTI
    for (int ph = 0; ph < N_PHASES; ++ph) {
        a.ph_lo = ph; a.ph_hi = ph + 1;
        hipLaunchKernelGGL(fwd, dim3(grid), dim3(NWAVES * 64), LDS_BYTES, stream, a);
    }
#else
    a.ph_lo = 0; a.ph_hi = N_PHASES;
    hipLaunchKernelGGL(fwd, dim3(grid), dim3(NWAVES * 64), LDS_BYTES, stream, a);
#endif
}
```

```cpp
#include <hip/hip_runtime.h>
#include <hip/hip_bf16.h>
#include <cstdio>
#include <cstdint>
#include <cmath>

#ifndef PROBE_PHASE
#define PROBE_PHASE -1
#endif
#ifndef PROBE_GAIN
#define PROBE_GAIN 1e-6f
#endif
#ifndef MK_MULTI
#define MK_MULTI 0
#endif

constexpr int BATCH = 8, SEQ = 2048, DM = 1024, DEPTH = 2;
constexpr int M = BATCH * SEQ;
constexpr int P_IN = 6168;
constexpr int PLD = 6144;
constexpr int PC_Q = 0, PC_Z = 512, PC_MO = 1536, PC_K = 2048, PC_V = 2560, PC_XBC = 3072, PC_MQK = 4608, PC_MV = 5632;
constexpr int SC_Q = 0, SC_K = 512, SC_V = 1024, SC_Z = 1536, SC_XBC = 2560, SC_DT = 4096, SC_MQK = 4112, SC_MV = 5136, SC_MO = 5648, SC_MI = 6160, SC_MF = 6164;
constexpr int FFN = 2816, ULD = 5632;
constexpr int DMIX = 2048;
constexpr float EPS = 1e-6f;
constexpr float C2 = 0.125f * 1.4426950408889634f;

constexpr size_t MiB = 1u << 20;
constexpr size_t WS_CTL = 0, CTL_ZERO_BYTES = 1 * MiB;
constexpr size_t WS_KSUM = 256 * 1024;
constexpr size_t WS_TS = 800 * 1024;
constexpr size_t WS_RS = 512 * 1024;
constexpr size_t WS_QUEUE = 768 * 1024;
constexpr size_t WS_SMALLP = 1 * MiB;
constexpr size_t WS_SSQ = 3 * MiB - 512 * 1024;
constexpr size_t WS_WSM = 3 * MiB + 512 * 1024;
constexpr size_t WS_BUFA = 4 * MiB;
constexpr size_t WS_BUFB = 16 * MiB;
constexpr size_t WS_XB = 22 * MiB;
constexpr size_t WS_HALO = 54 * MiB;
constexpr size_t WS_GSC = 58 * MiB;
constexpr size_t WS_SIDEA = 54 * MiB;
constexpr size_t WS_SIDEB = 57 * MiB;
static_assert(true, "EpiProj hard-codes WS_PROJ = 64 MiB, WS_HALO = 54 MiB, WS_KSUM = 256 KiB, WS_RS = 512 KiB");
constexpr size_t WS_PROJ = 64 * MiB;
constexpr size_t WS_END = 256 * MiB;

namespace pg8 {
#define PG8_LAS __attribute__((address_space(3)))
typedef unsigned short bf16_t;
typedef short bf16x8 __attribute__((ext_vector_type(8)));
typedef float f32x4 __attribute__((ext_vector_type(4)));
typedef unsigned u32x4 __attribute__((ext_vector_type(4)));
constexpr int BM = 256, BK = 64, HALF = 128, HTB = HALF * BK * 2, STAGE_BYTES = 8 * HTB, NXCD = 8, WGM = 8;

__host__ __device__ __forceinline__ int lds_byte(int r, int c) { const int st = (r >> 4) * 2 + (c >> 5), rr = r & 15, cc = c & 31, ob = rr * 64 + cc * 2; return st * 1024 + (ob ^ (((ob >> 9) & 1) << 5)); }
__host__ __device__ __forceinline__ void stage_rc(int b, int& R, int& C) { const int st = b / 1024, sb = b % 1024, swz = sb ^ (((sb >> 9) & 1) << 5); R = (st >> 1) * 16 + swz / 64; C = (st & 1) * 32 + (swz % 64) / 2; }
__host__ __device__ __forceinline__ int perm32(int rho) { const int n = rho >> 4, i = rho & 15; return 8 * (i >> 2) + 4 * n + (i & 3); }

struct Unit { int pm, pn; };
struct Gemm { const bf16_t* A; const bf16_t* Bt; int M, N, K, lda; };

struct StaticOrder {
    int nM, nN, nwg, G, c;
    __host__ __device__ void init(int M_, int N_, int G_, int c_) { nM = M_ / BM; nN = N_ / BM; nwg = nM * nN; G = G_; c = c_; }
    __host__ __device__ bool next(int i, Unit& u) const {
        const long L = (long)i * G + c; if (L >= nwg) return false;
        int wgid = (int)L; { const int q = nwg / NXCD, r = nwg % NXCD, xcd = wgid % NXCD, off = wgid / NXCD; wgid = (xcd < r ? xcd * (q + 1) : r * (q + 1) + (xcd - r) * q) + off; }
        const int nig = WGM * nN, gid = wgid / nig, fm = gid * WGM, gsz = (nM - fm) < WGM ? (nM - fm) : WGM;
        u.pm = fm + ((wgid % nig) % gsz); u.pn = (wgid % nig) / gsz; return true;
    }
};

typedef float f32x2p __attribute__((ext_vector_type(2))); typedef __bf16 bf16x2p __attribute__((ext_vector_type(2)));
__device__ __forceinline__ unsigned cvt_pk_bf16(float lo, float hi) { const f32x2p v = {lo, hi}; return __builtin_bit_cast(unsigned, __builtin_convertvector(v, bf16x2p)); }

struct EpiBf16 {
    static constexpr bool PERM = true; static constexpr bool ROWPERM = false;
    bf16_t* O; int ldc;
    __device__ __forceinline__ void operator()(const f32x4 (&acc)[2][2][4][2], const Unit& u, int wr, int wc, int fr, int fq) const {
        const int row0 = u.pm * BM + wr * 64 + fr; const int col0 = u.pn * BM + wc * 32 + 8 * fq;
#pragma unroll
        for (int ai = 0; ai < 2; ++ai)
#pragma unroll
            for (int m = 0; m < 4; ++m) { bf16_t* rowp = O + (size_t)(row0 + ai * HALF + m * 16) * ldc + col0;
#pragma unroll
                for (int bj = 0; bj < 2; ++bj) { const f32x4 v0 = acc[ai][bj][m][0], v1 = acc[ai][bj][m][1];
                    u32x4 w; w.x = cvt_pk_bf16(v0[0], v0[1]); w.y = cvt_pk_bf16(v0[2], v0[3]); w.z = cvt_pk_bf16(v1[0], v1[1]); w.w = cvt_pk_bf16(v1[2], v1[3]);
                    *(u32x4*)(rowp + bj * HALF) = w; } }
    }
};
__device__ __forceinline__ float row_prev(float prevblk, float cur, int n  ) {
    const int pb = __float_as_int(prevblk), cu = __float_as_int(cur);
    const int o = (n == 1) ? __builtin_amdgcn_update_dpp(0, pb, 0x121, 0xf, 0xf, false) : (n == 2) ? __builtin_amdgcn_update_dpp(0, pb, 0x122, 0xf, 0xf, false) : __builtin_amdgcn_update_dpp(0, pb, 0x123, 0xf, 0xf, false);
    return __int_as_float((n == 1) ? __builtin_amdgcn_update_dpp(o, cu, 0x111, 0xf, 0xf, false) : (n == 2) ? __builtin_amdgcn_update_dpp(o, cu, 0x112, 0xf, 0xf, false) : __builtin_amdgcn_update_dpp(o, cu, 0x113, 0xf, 0xf, false));
}
struct EpiProj {
    static constexpr bool PERM = true; static constexpr bool ROWPERM = true;
    unsigned char* ws; const float* const __attribute__((address_space(4)))* in; int l;
    __device__ __forceinline__ void operator()(const f32x4 (&acc)[2][2][4][2], const Unit& u, int wr, int wc, int fr, int fq) const {
        bf16_t* P = (bf16_t*)(ws + (size_t)64 * 1048576); bf16_t* halo = (bf16_t*)(ws + (size_t)54 * 1048576);
        const float* rs = (const float*)(ws + 524288) + (size_t)(2 * l) * 16384;
        const float* qw = in[3] + l * 64; const float* kw = in[4] + l * 64;
        const float* scw = in[5] + (size_t)l * 4 * 1536; const float* scb = in[6] + l * 1536; const float* mcw = in[11] + (size_t)l * 4 * 1024; const float* mcb = in[12] + l * 1024;
        const int pn = u.pn; const bool isq = pn < 2, isk = (pn == 8 || pn == 9);
        const int row0 = u.pm * BM + wr * 64 + 4 * fr;
        float rr[2][4];
#pragma unroll
        for (int ai = 0; ai < 2; ++ai) { const f32x4 t = *(const f32x4*)(rs + row0 + ai * HALF);
#pragma unroll
            for (int m = 0; m < 4; ++m) rr[ai][m] = 1.0f / sqrtf(t[m] * (1.0f / 1024.0f) + EPS); }
        if (pn >= 12 && pn < 22) {
            const int col0 = pn * BM + wc * 32 + 8 * fq;
            const bool ssm = pn < 18; const float post = (pn >= 20) ? 0.08838834764831845f : 1.0f; const int wst = ssm ? 1536 : 1024;
#pragma unroll
            for (int bj = 0; bj < 2; ++bj) {
                const int hch = col0 + bj * HALF - PC_XBC; const float* wp = ssm ? (scw + hch) : (mcw + (hch - 1536)); const float* bp = ssm ? (scb + hch) : (mcb + (hch - 1536));
                f32x4 cwv[4][2], cbv[2];
#pragma unroll
                for (int j = 0; j < 4; ++j) { cwv[j][0] = *(const f32x4*)(wp + j * wst); cwv[j][1] = *(const f32x4*)(wp + j * wst + 4); }
                cbv[0] = *(const f32x4*)bp; cbv[1] = *(const f32x4*)(bp + 4);
#pragma unroll
                for (int ai = 0; ai < 2; ++ai) {
                    u32x4 cv[4], raw[4];
#pragma unroll
                    for (int n = 0; n < 2; ++n)
#pragma unroll
                        for (int i2 = 0; i2 < 2; ++i2) { float y[4][2], g[4][2];
#pragma unroll
                            for (int e = 0; e < 2; ++e) { const int i = 2 * i2 + e;
#pragma unroll
                                for (int m = 0; m < 4; ++m) g[m][e] = acc[ai][bj][m][n][i] * rr[ai][m];
                                const float p1 = __int_as_float(__builtin_amdgcn_update_dpp(0, __float_as_int(g[3][e]), 0x111, 0xf, 0xf, true)), p2 = __int_as_float(__builtin_amdgcn_update_dpp(0, __float_as_int(g[2][e]), 0x111, 0xf, 0xf, true)),
                                            p3 = __int_as_float(__builtin_amdgcn_update_dpp(0, __float_as_int(g[1][e]), 0x111, 0xf, 0xf, true));
                                const float c0_ = cwv[0][n][i], c1_ = cwv[1][n][i], c2_ = cwv[2][n][i], c3_ = cwv[3][n][i], cb_ = cbv[n][i];
                                y[0][e] = cb_ + c0_ * p3 + c1_ * p2 + c2_ * p1 + c3_ * g[0][e];
                                y[1][e] = cb_ + c0_ * p2 + c1_ * p1 + c2_ * g[0][e] + c3_ * g[1][e];
                                y[2][e] = cb_ + c0_ * p1 + c1_ * g[0][e] + c2_ * g[1][e] + c3_ * g[2][e];
                                y[3][e] = cb_ + c0_ * g[0][e] + c1_ * g[1][e] + c2_ * g[2][e] + c3_ * g[3][e];
#pragma unroll
                                for (int m = 0; m < 4; ++m) y[m][e] = y[m][e] * __builtin_amdgcn_rcpf(1.0f + __builtin_amdgcn_exp2f(-1.4426950408889634f * y[m][e])) * post; }
#pragma unroll
                            for (int m = 0; m < 4; ++m) { cv[m][2 * n + i2] = cvt_pk_bf16(y[m][0], y[m][1]); raw[m][2 * n + i2] = cvt_pk_bf16(g[m][0], g[m][1]); } }
#pragma unroll
                    for (int m = 0; m < 4; ++m) { const int row = row0 + ai * HALF + m;
                        *(u32x4*)(P + (size_t)row * PLD + col0 + bj * HALF) = (m < 3 && fr == 0) ? raw[m] : cv[m];
                        if (m >= 1 && fr == 15) *(u32x4*)(halo + ((size_t)((row >> 6) * 3 + m - 1) * 2560 + hch)) = raw[m]; }
                }
            }
        } else if (!(isq || isk)) {
            const int col0 = pn * BM + wc * 32 + 8 * fq;
#pragma unroll
            for (int ai = 0; ai < 2; ++ai)
#pragma unroll
                for (int m = 0; m < 4; ++m) { bf16_t* rowp = P + (size_t)(row0 + ai * HALF + m) * PLD + col0;
#pragma unroll
                    for (int bj = 0; bj < 2; ++bj) { const f32x4 v0 = acc[ai][bj][m][0] * rr[ai][m], v1 = acc[ai][bj][m][1] * rr[ai][m];
                        u32x4 w; w.x = cvt_pk_bf16(v0[0], v0[1]); w.y = cvt_pk_bf16(v0[2], v0[3]); w.z = cvt_pk_bf16(v1[0], v1[1]); w.w = cvt_pk_bf16(v1[2], v1[3]);
                        *(u32x4*)(rowp + bj * HALF) = w;
                    } }
        } else {
            const float* w = isq ? qw : kw; const float post = isq ? C2 : 1.0f;
            const int colb = pn * BM + 64 * wc + 8 * fq;
#pragma unroll
            for (int ai = 0; ai < 2; ++ai)
#pragma unroll
                for (int m = 0; m < 4; ++m) {
                    float ss = 0.f;
#pragma unroll
                    for (int bj = 0; bj < 2; ++bj)
#pragma unroll
                        for (int n = 0; n < 2; ++n) { const f32x4 x = acc[ai][bj][m][n] * rr[ai][m]; ss += (x[0] * x[0] + x[1] * x[1]) + (x[2] * x[2] + x[3] * x[3]); }
                    ss += __shfl_xor(ss, 16); ss += __shfl_xor(ss, 32);
                    const float r = (1.0f / sqrtf(ss * (1.0f / 64.0f) + EPS)) * post * rr[ai][m];
                    bf16_t* rowp = P + (size_t)(row0 + ai * HALF + m) * PLD + colb;
#pragma unroll
                    for (int bj = 0; bj < 2; ++bj) { const f32x4 w0 = *(const f32x4*)(w + 32 * bj + 8 * fq), w1 = *(const f32x4*)(w + 32 * bj + 8 * fq + 4);
                        const f32x4 v0 = acc[ai][bj][m][0] * r * w0, v1 = acc[ai][bj][m][1] * r * w1;
                        u32x4 o; o.x = cvt_pk_bf16(v0[0], v0[1]); o.y = cvt_pk_bf16(v0[2], v0[3]); o.z = cvt_pk_bf16(v1[0], v1[1]); o.w = cvt_pk_bf16(v1[2], v1[3]);
                        *(u32x4*)(rowp + 32 * bj) = o; }
                    asm volatile("" ::: "memory");
                }
        }
    }
};
struct EpiRes {
    static constexpr bool PERM = true; static constexpr bool ROWPERM = false;
    bf16_t* xb; float* out; float* rs;
    __device__ __forceinline__ void operator()(const f32x4 (&acc)[2][2][4][2], const Unit& u, int wr, int wc, int fr, int fq) const {
        const int row0 = u.pm * BM + wr * 64 + fr, col0 = u.pn * BM + wc * 32 + 8 * fq;
#pragma unroll
        for (int ai = 0; ai < 2; ++ai)
#pragma unroll
            for (int m = 0; m < 4; ++m) { const int row = row0 + ai * HALF + m * 16; const size_t off = (size_t)row * 1024 + col0; float ss = 0.f;
#pragma unroll
                for (int bj = 0; bj < 2; ++bj) { const u32x4 bw = *(const u32x4*)(xb + off + bj * HALF);
                    f32x4 v0 = acc[ai][bj][m][0], v1 = acc[ai][bj][m][1];
                    v0[0] += __uint_as_float(bw.x << 16); v0[1] += __uint_as_float(bw.x & 0xffff0000u); v0[2] += __uint_as_float(bw.y << 16); v0[3] += __uint_as_float(bw.y & 0xffff0000u);
                    v1[0] += __uint_as_float(bw.z << 16); v1[1] += __uint_as_float(bw.z & 0xffff0000u); v1[2] += __uint_as_float(bw.w << 16); v1[3] += __uint_as_float(bw.w & 0xffff0000u);
                    if (out) { *(f32x4*)(out + off + bj * HALF) = v0; *(f32x4*)(out + off + bj * HALF + 4) = v1; }
                    else { ss += ((v0[0] * v0[0] + v0[1] * v0[1]) + (v0[2] * v0[2] + v0[3] * v0[3])) + ((v1[0] * v1[0] + v1[1] * v1[1]) + (v1[2] * v1[2] + v1[3] * v1[3]));
                        u32x4 w; w.x = cvt_pk_bf16(v0[0], v0[1]); w.y = cvt_pk_bf16(v0[2], v0[3]); w.z = cvt_pk_bf16(v1[0], v1[1]); w.w = cvt_pk_bf16(v1[2], v1[3]);
                        *(u32x4*)(xb + off + bj * HALF) = w; } }
                if (!out) { ss += __shfl_xor(ss, 16); ss += __shfl_xor(ss, 32); if (fq == 0) atomicAdd(rs + row, ss); }
                asm volatile("" ::: "memory"); }
    }
};
struct EpiScaleBf16 {
    static constexpr bool PERM = true; static constexpr bool ROWPERM = false;
    bf16_t* O; int ldc; const float* rs;
    __device__ __forceinline__ void operator()(const f32x4 (&acc)[2][2][4][2], const Unit& u, int wr, int wc, int fr, int fq) const {
        const int row0 = u.pm * BM + wr * 64 + fr; const int col0 = u.pn * BM + wc * 32 + 8 * fq;
        float rr[2][4];
#pragma unroll
        for (int ai = 0; ai < 2; ++ai)
#pragma unroll
            for (int m = 0; m < 4; ++m) rr[ai][m] = rs[row0 + ai * HALF + m * 16];
#pragma unroll
        for (int ai = 0; ai < 2; ++ai)
#pragma unroll
            for (int m = 0; m < 4; ++m) { bf16_t* rowp = O + (size_t)(row0 + ai * HALF + m * 16) * ldc + col0; const float r = 1.0f / sqrtf(rr[ai][m] * (1.0f / 1024.0f) + EPS);
#pragma unroll
                for (int bj = 0; bj < 2; ++bj) { const f32x4 v0 = acc[ai][bj][m][0] * r, v1 = acc[ai][bj][m][1] * r;
                    u32x4 w; w.x = cvt_pk_bf16(v0[0], v0[1]); w.y = cvt_pk_bf16(v0[2], v0[3]); w.z = cvt_pk_bf16(v1[0], v1[1]); w.w = cvt_pk_bf16(v1[2], v1[3]);
                    *(u32x4*)(rowp + bj * HALF) = w; } }
    }
};

typedef float f32x2q __attribute__((ext_vector_type(2)));
__device__ __forceinline__ f32x2q gelu_pk2(f32x2q v) {
    const f32x2q av = __builtin_elementwise_abs(v), d = av * 0.2316418882f + 1.0f;
    f32x2q t; t.x = __builtin_amdgcn_rcpf(d.x); t.y = __builtin_amdgcn_rcpf(d.y);
    f32x2q q = t * 0.5307027145f + (-0.7265760135f); q = q * t + 0.7107068705f; q = q * t + (-0.142248368f); q = q * t + 0.127414796f; q = q * t;
    const f32x2q s = (v * v) * (-0.72134752044f);
    f32x2q e; e.x = __builtin_amdgcn_exp2f(s.x); e.y = __builtin_amdgcn_exp2f(s.y);
    const f32x2q m = v * (q * e), r = v - m;
    f32x2q o; o.x = v.x < 0.f ? m.x : r.x; o.y = v.y < 0.f ? m.y : r.y; return o;
}
struct EpiFfn {
    static constexpr bool PERM = true; static constexpr bool ROWPERM = true;
    bf16_t* H; const float* rs; const float* cw  ; const float* cb; bf16_t* sideA  ; bf16_t* sideB  ;
    __device__ __forceinline__ void operator()(const f32x4 (&acc)[2][2][4][2], const Unit& u, int wr, int wc, int fr, int fq) const {
        constexpr int FF = 2816;
        const int row0 = u.pm * BM + wr * 64 + 4 * fr, c0 = u.pn * 128 + wc * 32 + 8 * fq;
        float rr[2][4];
#pragma unroll
        for (int ai = 0; ai < 2; ++ai) { const f32x4 t = *(const f32x4*)(rs + row0 + ai * HALF);
#pragma unroll
            for (int m = 0; m < 4; ++m) rr[ai][m] = 1.0f / sqrtf(t[m] * (1.0f / 1024.0f) + EPS); }
        f32x4 w0[2], w1[2], w2[2], bb[2];
#pragma unroll
        for (int n = 0; n < 2; ++n) { w0[n] = *(const f32x4*)(cw + c0 + 4 * n); w1[n] = *(const f32x4*)(cw + FF + c0 + 4 * n); w2[n] = *(const f32x4*)(cw + 2 * FF + c0 + 4 * n); bb[n] = *(const f32x4*)(cb + c0 + 4 * n); }
#pragma unroll
        for (int ai = 0; ai < 2; ++ai) {
            u32x4 hw[4], gw[4], vw[2];
#pragma unroll
            for (int n = 0; n < 2; ++n)
#pragma unroll
                for (int i2 = 0; i2 < 2; ++i2) { f32x2q x[4]; float g[4][2], v[4][2];
#pragma unroll
                    for (int e = 0; e < 2; ++e) { const int i = 2 * i2 + e;
#pragma unroll
                        for (int m = 0; m < 4; ++m) { g[m][e] = acc[ai][0][m][n][i] * rr[ai][m]; v[m][e] = acc[ai][1][m][n][i] * rr[ai][m]; }
                        const float p1 = __int_as_float(__builtin_amdgcn_update_dpp(0, __float_as_int(g[3][e]), 0x111, 0xf, 0xf, true)), p2 = __int_as_float(__builtin_amdgcn_update_dpp(0, __float_as_int(g[2][e]), 0x111, 0xf, 0xf, true));
                        const float a0 = w0[n][i], a1 = w1[n][i], a2 = w2[n][i], b_ = bb[n][i];
                        x[0][e] = b_ + a0 * p2 + a1 * p1 + a2 * g[0][e];
                        x[1][e] = b_ + a0 * p1 + a1 * g[0][e] + a2 * g[1][e];
                        x[2][e] = b_ + a0 * g[0][e] + a1 * g[1][e] + a2 * g[2][e];
                        x[3][e] = b_ + a0 * g[1][e] + a1 * g[2][e] + a2 * g[3][e]; }
#pragma unroll
                    for (int m = 0; m < 4; ++m) { const f32x2q ge = gelu_pk2(x[m]);
                        hw[m][2 * n + i2] = cvt_pk_bf16(ge.x * v[m][0], ge.y * v[m][1]); gw[m][2 * n + i2] = cvt_pk_bf16(g[m][0], g[m][1]);
                        if (m < 2) vw[m][2 * n + i2] = cvt_pk_bf16(v[m][0], v[m][1]); } }
#pragma unroll
            for (int m = 0; m < 4; ++m) { const int row = row0 + ai * HALF + m;
                *(u32x4*)(H + (size_t)row * FF + c0) = hw[m];
                if (m >= 2 && fr == 15) *(u32x4*)(sideA + ((size_t)(row >> 6) * 2 + (m - 2)) * FF + c0) = gw[m];
                if (m < 2 && fr == 0) { bf16_t* sb = sideB + ((size_t)(row >> 6) * 2 + m) * 2 * FF + c0; *(u32x4*)sb = gw[m]; *(u32x4*)(sb + FF) = vw[m]; } }
        }
    }
};

#define PG8_KT(i) (KMODE ? ((i) < 16 ? (i) + 8 : ((i) < 24 ? (i) - 16 : (i))) : (i))
template <class Epi, int KMODE = 0>
__device__ __forceinline__ void gemm_phase(PG8_LAS unsigned char* lds, const Gemm g, const StaticOrder& S, const Epi& E, int tid_, const PG8_LAS float* ftab = nullptr) {
    asm volatile("" : "+v"(tid_));
    const int tid = tid_, wid = __builtin_amdgcn_readfirstlane(tid >> 6), lane = tid & 63, wr = wid >> 2, wc = wid & 3, fr = lane & 15, fq = lane >> 4;
    const int K = g.K, nt = K / BK, lda = g.lda;
    unsigned voffA[2], voffB[2];
#pragma unroll
    for (int i = 0; i < 2; ++i) { int R, C; stage_rc(tid * 16 + i * 8192, R, C); const int Rb = Epi::PERM ? ((R & ~31) + perm32(R & 31)) : R;
        const int Ra = Epi::ROWPERM ? ((R & ~63) + 4 * (R & 15) + ((R >> 4) & 3)) : R;
        voffA[i] = (unsigned)(Ra * lda + C) * 2u; voffB[i] = (unsigned)(Rb * K + C) * 2u; }
    const size_t kstep = (size_t)(BK * 2);
    const size_t hstepA = (size_t)HALF * lda * 2, hstepB = (size_t)HALF * K * 2;
    const size_t tstepA = 2 * hstepA, tstepB = 2 * hstepB;
    const unsigned ldsw = (unsigned)wid * 1024u;
    const int aoff = lds_byte(wr * 64 + fr, fq * 8), boff = lds_byte(wc * 32 + fr, fq * 8);
#define PG8_SA(b, h) (((b) * 2 + (h)) * HTB)
#define PG8_SB(b, h) ((4 + (b) * 2 + (h)) * HTB)
#define PG8_STAGE(bufoff, gbase, voff) do { _Pragma("unroll") for (int _i = 0; _i < 2; ++_i) \
        __builtin_amdgcn_global_load_lds((const unsigned*)((const char*)(gbase) + (voff)[_i]), (PG8_LAS unsigned*)(lds + (bufoff) + ldsw + _i * 8192), 16, 0, 0); } while (0)
#define PG8_LDA(dst, b, h) do { _Pragma("unroll") for (int m = 0; m < 4; ++m) _Pragma("unroll") for (int k = 0; k < 2; ++k) dst[m][k] = *(const PG8_LAS bf16x8*)(lds + PG8_SA(b, h) + aoff + m * 2048 + k * 1024); } while (0)
#define PG8_LDB(dst, b, h) do { _Pragma("unroll") for (int n = 0; n < 2; ++n) _Pragma("unroll") for (int k = 0; k < 2; ++k) dst[n][k] = *(const PG8_LAS bf16x8*)(lds + PG8_SB(b, h) + boff + n * 2048 + k * 1024); } while (0)
#define PG8_MMA(ai, bj, At, Bt) do { __builtin_amdgcn_s_setprio(1); _Pragma("unroll") for (int m = 0; m < 4; ++m) _Pragma("unroll") for (int n = 0; n < 2; ++n) _Pragma("unroll") for (int k = 0; k < 2; ++k) \
        acc[ai][bj][m][n] = __builtin_amdgcn_mfma_f32_16x16x32_bf16(Bt[n][k], At[m][k], acc[ai][bj][m][n], 0, 0, 0); __builtin_amdgcn_s_setprio(0); } while (0)
#define PG8_WAIT_V(n) asm volatile("s_waitcnt vmcnt(" #n ")" ::: "memory")
#define PG8_WAIT_L(n) asm volatile("s_waitcnt lgkmcnt(" #n ")" ::: "memory")
#define PG8_BAR __builtin_amdgcn_s_barrier()
#define PG8_SCHED __builtin_amdgcn_sched_barrier(0)
    Unit cur, nxt; int ui = 0;
    if (!S.next(0, cur)) return;
    f32x4 acc[2][2][4][2];
#pragma unroll
    for (int a = 0; a < 2; ++a)
#pragma unroll
        for (int b = 0; b < 2; ++b)
#pragma unroll
            for (int m = 0; m < 4; ++m)
#pragma unroll
                for (int n = 0; n < 2; ++n) acc[a][b][m][n] = (f32x4){0.f, 0.f, 0.f, 0.f};
    bf16x8 At[4][2], B0[2][2], B1[2][2];
    const char* cA = (const char*)g.A + (size_t)cur.pm * tstepA; const char* cB = (const char*)g.Bt + (size_t)cur.pn * tstepB;
    { const char* cA0 = cA + (size_t)PG8_KT(0) * kstep; const char* cB0 = cB + (size_t)PG8_KT(0) * kstep;
    PG8_STAGE(PG8_SB(0, 0), cB0, voffB); PG8_STAGE(PG8_SB(0, 1), cB0 + hstepB, voffB); PG8_STAGE(PG8_SA(0, 0), cA0, voffA); PG8_STAGE(PG8_SA(0, 1), cA0 + hstepA, voffA);
    if (wr == 1) PG8_BAR;
    PG8_WAIT_V(2); PG8_BAR;
    PG8_STAGE(PG8_SB(1, 0), cB0 + kstep, voffB); PG8_STAGE(PG8_SA(1, 0), cA0 + kstep, voffA); PG8_STAGE(PG8_SB(1, 1), cB0 + hstepB + kstep, voffB);
    PG8_WAIT_V(6); PG8_BAR; }
    for (;;) {
        const bool has_next = S.next(ui + 1, nxt);
        const char* nA = has_next ? (const char*)g.A + (size_t)nxt.pm * tstepA : cA; const char* nB = has_next ? (const char*)g.Bt + (size_t)nxt.pn * tstepB : cB;
        for (int t = 0; t < nt; t += 2) {
            const bool last = (t == nt - 2);
            const char* a1 = cA + (size_t)PG8_KT(t + 1) * kstep;
            const char* a2 = last ? nA + (size_t)PG8_KT(0) * kstep : cA + (size_t)PG8_KT(t + 2) * kstep; const char* b2 = last ? nB + (size_t)PG8_KT(0) * kstep : cB + (size_t)PG8_KT(t + 2) * kstep;
            const char* a3 = a2 + kstep; const char* b3 = b2 + kstep;
            PG8_LDB(B0, 0, 0); PG8_LDB(B1, 0, 1); PG8_SCHED; PG8_LDA(At, 0, 0); PG8_STAGE(PG8_SA(1, 1), a1 + hstepA, voffA);
            PG8_WAIT_V(8); PG8_WAIT_L(0); PG8_BAR; PG8_MMA(0, 0, At, B0); PG8_MMA(0, 1, At, B1); PG8_BAR; PG8_SCHED;
            PG8_LDA(At, 0, 1); PG8_STAGE(PG8_SB(0, 0), b2, voffB); PG8_STAGE(PG8_SB(0, 1), b2 + hstepB, voffB); PG8_STAGE(PG8_SA(0, 0), a2, voffA);
            PG8_WAIT_V(8); PG8_WAIT_L(0); PG8_BAR; PG8_MMA(1, 0, At, B0); PG8_MMA(1, 1, At, B1); PG8_BAR; PG8_SCHED;
            PG8_LDB(B0, 1, 0); PG8_LDB(B1, 1, 1); PG8_SCHED; PG8_LDA(At, 1, 0); PG8_STAGE(PG8_SA(0, 1), a2 + hstepA, voffA);
            PG8_WAIT_V(8); PG8_WAIT_L(0); PG8_BAR; PG8_MMA(0, 0, At, B0); PG8_MMA(0, 1, At, B1); PG8_BAR; PG8_SCHED;
            PG8_LDA(At, 1, 1); PG8_STAGE(PG8_SB(1, 0), b3, voffB); PG8_STAGE(PG8_SB(1, 1), b3 + hstepB, voffB); PG8_STAGE(PG8_SA(1, 0), a3, voffA);
            PG8_WAIT_V(8); PG8_WAIT_L(0); PG8_BAR; PG8_MMA(1, 0, At, B0); PG8_MMA(1, 1, At, B1); PG8_BAR; PG8_SCHED;
            if (KMODE == 1 && (t == 6 || t == 14)) {
                const int wh = (t == 14) ? 1 : 0;
#pragma unroll
                for (int ai = 0; ai < 2; ++ai)
#pragma unroll
                    for (int m = 0; m < 4; ++m) { const float f = ftab[(ai * HALF + wr * 64 + m * 16 + fr) * 2 + wh];
#pragma unroll
                        for (int bj = 0; bj < 2; ++bj)
#pragma unroll
                            for (int n = 0; n < 2; ++n) acc[ai][bj][m][n] *= f; }
                PG8_SCHED;
            }
        }
        if (wr == 0) PG8_BAR;
        E(acc, cur, wr, wc, fr, fq);
        if (!has_next) break;
#pragma unroll
        for (int a = 0; a < 2; ++a)
#pragma unroll
            for (int b = 0; b < 2; ++b)
#pragma unroll
                for (int m = 0; m < 4; ++m)
#pragma unroll
                    for (int n = 0; n < 2; ++n) acc[a][b][m][n] = (f32x4){0.f, 0.f, 0.f, 0.f};
        cur = nxt; cA = nA; cB = nB; ++ui;
        if (wr == 1) PG8_BAR;
    }
    PG8_WAIT_V(0);
    PG8_BAR;
#undef PG8_SA
#undef PG8_SB
#undef PG8_STAGE
#undef PG8_LDA
#undef PG8_LDB
#undef PG8_MMA
#undef PG8_WAIT_V
#undef PG8_WAIT_L
#undef PG8_BAR
#undef PG8_SCHED
}
}

constexpr int NWAVES = 8;
constexpr int RING_OFF = 0, RING_BYTES = 131072;
constexpr int LDS_BYTES = 147456;
constexpr int LDSCTL_OFF = LDS_BYTES - 512, MISC_OFF = LDSCTL_OFF + 320;
constexpr int CW_BAR = 4096;

#define GAS __attribute__((address_space(1)))
#define LAS __attribute__((address_space(3)))
typedef unsigned short bf16;
typedef unsigned v4u __attribute__((ext_vector_type(4)));
typedef float f32x4 __attribute__((ext_vector_type(4)));
typedef GAS unsigned gu32;
#define RLX_AGENT __ATOMIC_RELAXED, __HIP_MEMORY_SCOPE_AGENT
#define LDS_WAIT() asm volatile("s_waitcnt lgkmcnt(0)" ::: "memory")
#define VM_WAIT() asm volatile("s_waitcnt vmcnt(0)" ::: "memory")
__device__ __forceinline__ unsigned f2bf(float f) { unsigned u = __builtin_bit_cast(unsigned, f); return (u + 0x7fffu + ((u >> 16) & 1u)) >> 16; }
typedef float f32x2_ __attribute__((ext_vector_type(2))); typedef __bf16 bf16x2_ __attribute__((ext_vector_type(2)));
__device__ __forceinline__ unsigned pk2(float lo, float hi) { const f32x2_ v = {lo, hi}; return __builtin_bit_cast(unsigned, __builtin_convertvector(v, bf16x2_)); }
__device__ __forceinline__ float bf2f(unsigned short b) { return __uint_as_float(((unsigned)b) << 16); }

#define XB_TMO      128
#define XB_XCNT(j)  (256  + 64 * (j))
#define XB_XSUB(j)  (1280 + 64 * (j))
#define XB_XGEN(j)  (2304 + 64 * (j))
#define XB_TOP      3328
#define XB_TOPGEN   3392
#define XCD_BAR_WORDS 3456
#define XB_SPIN_CAP (1u << 18)
__device__ __forceinline__ unsigned xb_ld(unsigned* p)              { return __hip_atomic_load(p, __ATOMIC_RELAXED, __HIP_MEMORY_SCOPE_AGENT); }
__device__ __forceinline__ unsigned xb_add(unsigned* p, unsigned v) { return __hip_atomic_fetch_add(p, v, __ATOMIC_RELAXED, __HIP_MEMORY_SCOPE_AGENT); }
__device__ __forceinline__ unsigned xb_xcc_id() { return (unsigned)__builtin_amdgcn_s_getreg((3 << 11) | 20) & 0xFu; }
#define XB_SPIN(cond, bar) do { unsigned _sp = 0; while (cond) { __builtin_amdgcn_s_sleep(1); \
    if ((++_sp & 255u) == 0u) { if (xb_ld(&(bar)[XB_TMO])) break; if (_sp > XB_SPIN_CAP) { atomicAdd(&(bar)[XB_TMO], 1u); break; } } } } while (0)
struct XcdBarrier { unsigned* bar; unsigned x; volatile LAS unsigned* st; };
__device__ __forceinline__ XcdBarrier xcd_barrier_post(unsigned* bar, volatile LAS unsigned* st) {
    XcdBarrier b; b.bar = bar; b.x = xb_xcc_id(); b.st = st;
    if (threadIdx.x == 0) (void)xb_add(&bar[XB_XCNT(b.x)], 1u);
    return b;
}
__device__ __forceinline__ void xcd_barrier_complete(unsigned* bar, unsigned x, unsigned& nloc, unsigned& nx) {
    const unsigned G = gridDim.x * gridDim.y * gridDim.z;
    unsigned sum, cnt, mine, sp = 0u;
    for (;;) {
        sum = 0u; cnt = 0u; mine = 0u;
#pragma unroll
        for (unsigned j = 0; j < 16; ++j) { const unsigned c = xb_ld(&bar[XB_XCNT(j)]); sum += c; cnt += (c > 0u) ? 1u : 0u; mine = (j == x) ? c : mine; }
        if (sum == G) break;
        __builtin_amdgcn_s_sleep(1);
        if ((++sp & 255u) == 0u) { if (xb_ld(&bar[XB_TMO])) break; if (sp > XB_SPIN_CAP) { atomicAdd(&bar[XB_TMO], 1u); break; } }
    }
    nloc = mine > 0u ? mine : 1u; nx = cnt > 0u ? cnt : 1u;
}
__device__ __forceinline__ void xcd_barrier(const XcdBarrier& b, int tid) {
    asm volatile("s_waitcnt vmcnt(0)" ::: "memory");
    __syncthreads();
    if (tid == 0) {
        unsigned* bar = b.bar;
        __builtin_amdgcn_s_waitcnt(0);
        unsigned nloc = b.st[0], nx = b.st[1];
        if (nloc == 0u) { xcd_barrier_complete(bar, b.x, nloc, nx); b.st[0] = nloc; b.st[1] = nx; }
        const unsigned tg = b.st[2];
        const unsigned old = xb_add(&bar[XB_XSUB(b.x)], 1u);
        if (old + 1u == (old / nloc + 1u) * nloc) {
            __builtin_amdgcn_fence(__ATOMIC_RELEASE, "agent");
            asm volatile("s_waitcnt vmcnt(0)" ::: "memory");
            const unsigned og = xb_add(&bar[XB_TOP], 1u);
            if (og + 1u == (og / nx + 1u) * nx) xb_add(&bar[XB_TOPGEN], 1u);
        }
        XB_SPIN(xb_ld(&bar[XB_TOPGEN]) == tg, bar);
        b.st[2] = tg + 1u;
        __builtin_amdgcn_fence(__ATOMIC_ACQUIRE, "agent");
        asm volatile("s_waitcnt vmcnt(0)" ::: "memory");
    }
    __syncthreads();
}

__device__ __forceinline__ int fresh_lane() { int l; asm volatile("v_mbcnt_lo_u32_b32 %0, -1, 0\n\tv_mbcnt_hi_u32_b32 %0, -1, %0" : "=v"(l)); return l; }
struct Args { const float* in[22]; float* out; unsigned char* ws; int ph_lo, ph_hi; };

struct Frame {
    LAS unsigned char* lds;
    int tid, lane, wave;
    int vcu, G;
};

__device__ __forceinline__ float wave_sum(float v) {
#pragma unroll
    for (int o = 1; o < 64; o <<= 1) v += __shfl_xor(v, o);
    return v;
}

__device__ __forceinline__ void conv_item(const float* W, int ldw, int srccol0, bf16* WT, int K, int dstrow0, int k0, LAS float* scr, int lane, const float* kscale  , int kslo = 0, int kshi = 1 << 30) {
    {
        const int lr = lane >> 3, lc = (lane & 7) * 4; f32x4 v[8];
#pragma unroll
        for (int i = 0; i < 8; ++i) { const float* p = W + (size_t)(k0 + 8 * i + lr) * ldw + srccol0 + lc;
            if ((((size_t)p) & 15) == 0) v[i] = *(const f32x4*)p; else { v[i][0] = p[0]; v[i][1] = p[1]; v[i][2] = p[2]; v[i][3] = p[3]; } }
#pragma unroll
        for (int i = 0; i < 8; ++i) { LAS float* d = scr + (8 * i + lr) * 33 + lc; d[0] = v[i][0]; d[1] = v[i][1]; d[2] = v[i][2]; d[3] = v[i][3]; }
    }
    const int c = lane & 7;
    f32x4 ks0 = (f32x4){1.f, 1.f, 1.f, 1.f}, ks1 = ks0;
    if (kscale && k0 >= kslo && k0 < kshi) { ks0 = *(const f32x4*)(kscale + k0 - kslo + 8 * c); ks1 = *(const f32x4*)(kscale + k0 - kslo + 8 * c + 4); }
    LDS_WAIT(); asm volatile("" ::: "memory");
#pragma unroll
    for (int j = 0; j < 4; ++j) { const int n = (lane >> 3) + 8 * j; const LAS float* s = scr + (8 * c) * 33 + n;
        v4u o; o.x = pk2(s[0 * 33] * ks0[0], s[1 * 33] * ks0[1]); o.y = pk2(s[2 * 33] * ks0[2], s[3 * 33] * ks0[3]); o.z = pk2(s[4 * 33] * ks1[0], s[5 * 33] * ks1[1]); o.w = pk2(s[6 * 33] * ks1[2], s[7 * 33] * ks1[3]);
        *(GAS v4u*)(WT + (size_t)(dstrow0 + n) * K + k0 + 8 * c) = o; }
    LDS_WAIT(); asm volatile("" ::: "memory");
}
__device__ __forceinline__ int in_src_col(int n0) {
    const int tile = n0 >> 8, p = n0 & 255; int dest;
    if (tile < 2 || tile == 8 || tile == 9) { const int bj = p >> 7, wc = (p >> 5) & 3; dest = (tile << 8) + 64 * wc + 32 * bj; } else dest = n0;
    if (dest < PC_Z) return SC_Q + dest;
    if (dest < PC_MO) return SC_Z + dest - PC_Z;
    if (dest < PC_K) return SC_MO + dest - PC_MO;
    if (dest < PC_V) return SC_K + dest - PC_K;
    if (dest < PC_XBC) return SC_V + dest - PC_V;
    if (dest < PC_MQK) return SC_XBC + dest - PC_XBC;
    if (dest < PC_MV) return SC_MQK + dest - PC_MQK;
    return SC_MV + dest - PC_MV;
}
__device__ __forceinline__ void conv_w_in(Frame& F, const float* w_in, const float* nw, bf16* wt, LAS float* scr) {
    const int gw = F.vcu * NWAVES + F.wave, NGW = F.G * NWAVES;
    for (int it = gw; it < (DM / 64) * (PLD / 32); it += NGW) { const int nblk = PLD / 32, kb = it / nblk, nb = it % nblk; conv_item(w_in, P_IN, in_src_col(32 * nb), wt, DM, 32 * nb, 64 * kb, scr, F.lane, nw); }
}
__device__ __forceinline__ void conv_plain(Frame& F, const float* W, int K, int N, const float* kscale, bf16* wt, LAS float* scr, int kslo = 0, int kshi = 1 << 30) {
    const int gw = F.vcu * NWAVES + F.wave, NGW = F.G * NWAVES; const int nblk = N / 32;
    for (int it = gw; it < (K / 64) * nblk; it += NGW) { const int kb = it / nblk, nb = it % nblk; conv_item(W, N, 32 * nb, wt, K, 32 * nb, 64 * kb, scr, F.lane, kscale, kslo, kshi); }
}
__device__ __forceinline__ void conv_small(Frame& F, const float* w_in, const float* nw, bf16* wst) {
    const int gt = F.vcu * (NWAVES * 64) + F.tid, NT = F.G * NWAVES * 64;
    for (int i = gt; i < 32 * DM; i += NT) { const int c = i >> 10, k = i & (DM - 1);
        float v = 0.f; if (c < 24) v = w_in[(size_t)k * P_IN + (c < 16 ? SC_DT + c : SC_MI + (c - 16))] * nw[k];
        wst[i] = (bf16)(pk2(v, 0.f) & 0xffffu); }
}
__device__ __forceinline__ void row_pass0(Frame& F, const float* x, bf16* xb, float* rs) {
    const int gw = F.vcu * NWAVES + F.wave, NGW = F.G * NWAVES;
    for (int m = gw; m < M; m += 2 * NGW) {
        const int m2 = m + NGW; const bool two = m2 < M;
        const GAS f32x4* xr = (const GAS f32x4*)(x + (size_t)m * DM) + F.lane; const GAS f32x4* xr2 = (const GAS f32x4*)(x + (size_t)(two ? m2 : m) * DM) + F.lane;
        f32x4 v[4], u[4]; float s_ = 0.f, t_ = 0.f;
#pragma unroll
        for (int j = 0; j < 4; ++j) { v[j] = xr[64 * j]; u[j] = xr2[64 * j]; }
#pragma unroll
        for (int j = 0; j < 4; ++j) { s_ += (v[j].x * v[j].x + v[j].y * v[j].y) + (v[j].z * v[j].z + v[j].w * v[j].w); t_ += (u[j].x * u[j].x + u[j].y * u[j].y) + (u[j].z * u[j].z + u[j].w * u[j].w); }
        s_ = wave_sum(s_); t_ = wave_sum(t_);
        GAS unsigned long long* o8 = (GAS unsigned long long*)(xb + (size_t)m * DM) + F.lane;
#pragma unroll
        for (int j = 0; j < 4; ++j) o8[64 * j] = (unsigned long long)pk2(v[j].x, v[j].y) | ((unsigned long long)pk2(v[j].z, v[j].w) << 32);
        if (F.lane == 0) rs[m] = s_;
        if (two) { GAS unsigned long long* p8 = (GAS unsigned long long*)(xb + (size_t)m2 * DM) + F.lane;
#pragma unroll
            for (int j = 0; j < 4; ++j) p8[64 * j] = (unsigned long long)pk2(u[j].x, u[j].y) | ((unsigned long long)pk2(u[j].z, u[j].w) << 32);
            if (F.lane == 0) rs[m2] = t_; }
    }
}
typedef short bf16x8s __attribute__((ext_vector_type(8)));
__device__ __forceinline__ void small_proj(Frame& F, const bf16* xb, const bf16* wst, const float* rs, float* smallp) {
    constexpr int SP = 1040;
    LAS unsigned char* As = F.lds; LAS unsigned char* Bs = F.lds + 64 * SP;
    const int lane = F.lane, w = F.wave, mt = w & 3, nt = w >> 2, r16 = lane & 15, kq = lane >> 4;
    for (int rb = F.vcu * 64; rb < M; rb += F.G * 64) {
        f32x4 acc = (f32x4){0.f, 0.f, 0.f, 0.f};
#pragma unroll 1
        for (int kh = 0; kh < 2; ++kh) {
            v4u av[8], bv[4];
#pragma unroll
            for (int i = 0; i < 8; ++i) { const int it = F.tid + 512 * i, row = it >> 6, c = it & 63; av[i] = *(const v4u*)(xb + (size_t)(rb + row) * DM + kh * 512 + c * 8); }
#pragma unroll
            for (int i = 0; i < 4; ++i) { const int it = F.tid + 512 * i, row = it >> 6, c = it & 63; bv[i] = *(const v4u*)(wst + (size_t)row * DM + kh * 512 + c * 8); }
            __syncthreads();
#pragma unroll
            for (int i = 0; i < 8; ++i) { const int it = F.tid + 512 * i, row = it >> 6, c = it & 63; *(LAS v4u*)(As + row * SP + c * 16) = av[i]; }
#pragma unroll
            for (int i = 0; i < 4; ++i) { const int it = F.tid + 512 * i, row = it >> 6, c = it & 63; *(LAS v4u*)(Bs + row * SP + c * 16) = bv[i]; }
            __syncthreads();
            bf16x8s a[16], b[16];
#pragma unroll
            for (int ks = 0; ks < 16; ++ks) { a[ks] = *(const LAS bf16x8s*)(As + (16 * mt + r16) * SP + (32 * ks + 8 * kq) * 2); b[ks] = *(const LAS bf16x8s*)(Bs + (16 * nt + r16) * SP + (32 * ks + 8 * kq) * 2); }
#pragma unroll
            for (int ks = 0; ks < 16; ++ks) acc = __builtin_amdgcn_mfma_f32_16x16x32_bf16(a[ks], b[ks], acc, 0, 0, 0);
        }
        const int n = 16 * nt + r16;
        if (n < 24) {
#pragma unroll
            for (int i = 0; i < 4; ++i) { const int row = rb + 16 * mt + 4 * kq + i; smallp[(size_t)row * 24 + n] = acc[i] * (1.0f / sqrtf(rs[row] * (1.0f / DM) + EPS)); } }
    }
    __syncthreads();
}
__device__ __forceinline__ unsigned cvtpk(float lo, float hi) { return pk2(lo, hi); }
__device__ __forceinline__ float bflo(unsigned w) { return __uint_as_float(w << 16); }
__device__ __forceinline__ float bfhi(unsigned w) { return __uint_as_float(w & 0xffff0000u); }
typedef float f32x2 __attribute__((ext_vector_type(2)));
__device__ __forceinline__ f32x2 gelu_pk(f32x2 v) {
    const f32x2 av = __builtin_elementwise_abs(v), d = av * 0.2316418882f + 1.0f;
    f32x2 t; t.x = __builtin_amdgcn_rcpf(d.x); t.y = __builtin_amdgcn_rcpf(d.y);
    f32x2 q = t * 0.5307027145f + (-0.7265760135f); q = q * t + 0.7107068705f; q = q * t + (-0.142248368f); q = q * t + 0.127414796f; q = q * t;
    const f32x2 s = (v * v) * (-0.72134752044f);
    f32x2 e; e.x = __builtin_amdgcn_exp2f(s.x); e.y = __builtin_amdgcn_exp2f(s.y);
    const f32x2 m = v * (q * e), r = v - m;
    f32x2 o; o.x = v.x < 0.f ? m.x : r.x; o.y = v.y < 0.f ? m.y : r.y; return o;
}

__device__ __forceinline__ void ffn_fix(Frame& F, bf16* H, const bf16* sideA, const bf16* sideB, const float* cw, const float* cb, int pm) {
    constexpr int CPR = FFN / 8;
    for (int it = F.tid; it < 4 * 2 * CPR; it += NWAVES * 64) {
        const int c0 = (it % CPR) * 8, rr_ = (it / CPR) & 1, grp = 4 * pm + it / (2 * CPR); const bool first = (grp & 31) == 0;
        const v4u z = (v4u){0, 0, 0, 0};
        const bf16* sb = sideB + ((size_t)grp * 2 + rr_) * 2 * FFN + c0;
        const v4u g2 = *(const v4u*)sb, vv = *(const v4u*)(sb + FFN);
        const v4u a1 = first ? z : *(const v4u*)(sideA + ((size_t)(grp - 1) * 2 + 1) * FFN + c0), a0 = first ? z : *(const v4u*)(sideA + ((size_t)(grp - 1) * 2) * FFN + c0);
        const v4u g1 = rr_ ? *(const v4u*)(sideB + ((size_t)grp * 2) * 2 * FFN + c0) : a1, g0 = rr_ ? a1 : a0;
        f32x4 w0[2], w1[2], w2[2], bb[2];
#pragma unroll
        for (int k = 0; k < 2; ++k) { w0[k] = *(const f32x4*)(cw + c0 + 4 * k); w1[k] = *(const f32x4*)(cw + FFN + c0 + 4 * k); w2[k] = *(const f32x4*)(cw + 2 * FFN + c0 + 4 * k); bb[k] = *(const f32x4*)(cb + c0 + 4 * k); }
        v4u ov;
#pragma unroll
        for (int i = 0; i < 4; ++i) { const int k = i >> 1, e = (i & 1) * 2; f32x2 x;
            x.x = bb[k][e] + w0[k][e] * bflo(g0[i]) + w1[k][e] * bflo(g1[i]) + w2[k][e] * bflo(g2[i]);
            x.y = bb[k][e + 1] + w0[k][e + 1] * bfhi(g0[i]) + w1[k][e + 1] * bfhi(g1[i]) + w2[k][e + 1] * bfhi(g2[i]);
            const f32x2 ge = gelu_pk(x); ov[i] = cvtpk(ge.x * bflo(vv[i]), ge.y * bfhi(vv[i])); }
        *(v4u*)(H + (size_t)(grp * 64 + rr_) * FFN + c0) = ov;
    }
}
__device__ __forceinline__ float silu_f(float x) { return x * __builtin_amdgcn_rcpf(1.0f + __builtin_amdgcn_exp2f(-1.4426950408889634f * x)); }
__device__ __forceinline__ float sigm_f(float x) { return __builtin_amdgcn_rcpf(1.0f + __builtin_amdgcn_exp2f(-1.4426950408889634f * x)); }

__device__ __forceinline__ float shx(float v, int m, int lane) { return __int_as_float(__builtin_amdgcn_ds_bpermute((lane ^ m) << 2, __float_as_int(v))); }
__device__ __forceinline__ float shup(float v, int o, int lane) { return __int_as_float(__builtin_amdgcn_ds_bpermute((lane - o) << 2, __float_as_int(v))); }
__device__ __forceinline__ float shl_(float v, int src, int lane) { (void)lane; return __int_as_float(__builtin_amdgcn_ds_bpermute(src << 2, __float_as_int(v))); }
__device__ __forceinline__ float softplus_f(float x) { return fmaxf(x, 0.f) + 0.6931471805599453f * __builtin_amdgcn_logf(1.0f + __builtin_amdgcn_exp2f(-1.4426950408889634f * fabsf(x))); }
__device__ __forceinline__ float logsig_f(float x) { return fminf(x, 0.f) - 0.6931471805599453f * __builtin_amdgcn_logf(1.0f + __builtin_amdgcn_exp2f(-1.4426950408889634f * fabsf(x))); }
typedef short bf16x8v __attribute__((ext_vector_type(8)));
typedef float f32x16 __attribute__((ext_vector_type(16)));
typedef short v4i16_t __attribute__((ext_vector_type(4)));
__device__ __forceinline__ bf16x8v frag_row(LAS const unsigned char* base, int pitch, int row, int kel) { return *(const LAS bf16x8v*)(base + row * pitch + kel * 2); }
__device__ __forceinline__ bf16x8v frag_tr(LAS const unsigned char* base, int pitch, int krow, int col) {
    LAS const unsigned char* p = base + krow * pitch + col * 2;
    const v4i16_t lo = __builtin_amdgcn_ds_read_tr16_b64_v4i16((LAS v4i16_t*)p);
    const v4i16_t hi = __builtin_amdgcn_ds_read_tr16_b64_v4i16((LAS v4i16_t*)(p + 4 * pitch));
    return (bf16x8v){lo[0], lo[1], lo[2], lo[3], hi[0], hi[1], hi[2], hi[3]};
}
#define MFMA32(a, b, c) __builtin_amdgcn_mfma_f32_32x32x16_bf16((a), (b), (c), 0, 0, 0)

__device__ __forceinline__ void ssd_unit(int tid, bf16* proj, const float* smallp, float* ssq, const float* dt_bias, const float* a_log, const float* dskip, int b, int h, LAS unsigned char* lds) {
    constexpr int PB = 272, PX = 144;
    asm volatile("" : "+v"(tid));
    LAS unsigned char* CG = lds;
    LAS unsigned char* BB = lds + 34816;
    LAS unsigned char* XX = lds + 69632;
    LAS unsigned char* XW = lds + 88064;
    LAS unsigned char* ST = lds + 106496;
    LAS float* ldv = (LAS float*)(lds + 123904);
    LAS float* dtv = ldv + 2048;
    const int lane0 = tid & 63, w = __builtin_amdgcn_readfirstlane(tid >> 6);
    const int g = h >> 3, pt = w & 1, lt = w >> 1;
    const float a = -__expf(a_log[h]), dsk = dskip[h], dtb = dt_bias[h];
    const size_t rowb = (size_t)b * SEQ;
    const int xrow = tid >> 2, xq = tid & 3, brow = tid >> 4, bc = tid & 15;
    const bf16* xsrc = proj + (rowb + xrow) * PLD + PC_XBC + h * 64 + xq * 16;
    bf16* zptr = proj + (rowb + xrow) * PLD + PC_Z + h * 64 + xq * 16;
    const bf16* bsrc = proj + (rowb + brow) * PLD + PC_XBC + 1024 + g * 128 + bc * 8;
    const bf16* csrc = bsrc + 256;
    const float* dsrc = smallp + (rowb + lane0) * 24 + h;
    v4u xr[2], br[4], cr[4];
#pragma unroll
    for (int k = 0; k < 2; ++k) xr[k] = *(const v4u*)(xsrc + 8 * k);
#pragma unroll
    for (int k = 0; k < 4; ++k) { br[k] = *(const v4u*)(bsrc + (size_t)32 * k * PLD); cr[k] = *(const v4u*)(csrc + (size_t)32 * k * PLD); }
#pragma unroll
    for (int cc = 0; cc < 2; ++cc) { const int ch_ = 2 * w + cc; const float* dp_ = dsrc + (size_t)ch_ * 128 * 24;
        float v0 = dp_[0] + dtb, v1 = dp_[64 * 24] + dtb;
        v0 = softplus_f(v0); v1 = softplus_f(v1);
        float s0 = v0 * a, s1 = v1 * a;
#pragma unroll
        for (int o = 1; o < 64; o <<= 1) { const float t0 = shup(s0, o, lane0), t1 = shup(s1, o, lane0); if (lane0 >= o) { s0 += t0; s1 += t1; } }
        s1 += shl_(s0, 63, lane0);
        ldv[ch_ * 128 + lane0] = s0; ldv[ch_ * 128 + 64 + lane0] = s1; dtv[ch_ * 128 + lane0] = v0; dtv[ch_ * 128 + 64 + lane0] = v1; }
    f32x16 sacc;
#pragma unroll
    for (int i = 0; i < 16; ++i) sacc[i] = 0.f;
    for (int i = tid; i < 17408 / 4; i += 512) ((LAS unsigned*)ST)[i] = 0u;
    for (int c = 0; c < 16; ++c) {
        const size_t row0 = rowb + c * 128;
        int lane = lane0; asm volatile("" : "+v"(lane));
        const int r = lane & 31, hh = lane >> 5, trq = (lane & 15) >> 2, trc = 16 * ((lane >> 4) & 1) + 4 * (lane & 3);
        LAS const float* ldc = ldv + c * 128; LAS const float* dtc = dtv + c * 128;
        __syncthreads();
        {
            const float wl = dtc[xrow] * __expf(ldc[127] - ldc[xrow]);
#pragma unroll
            for (int k = 0; k < 2; ++k) { *(LAS v4u*)(XX + xrow * PX + xq * 32 + k * 16) = xr[k]; v4u o;
#pragma unroll
                for (int i = 0; i < 4; ++i) o[i] = pk2(bf2f(xr[k][i] & 0xffff) * wl, bf2f(xr[k][i] >> 16) * wl);
                *(LAS v4u*)(XW + xrow * PX + xq * 32 + k * 16) = o; }
#pragma unroll
            for (int k = 0; k < 4; ++k) { *(LAS v4u*)(BB + (brow + 32 * k) * PB + bc * 16) = br[k]; *(LAS v4u*)(CG + (brow + 32 * k) * PB + bc * 16) = cr[k]; }
        }
        v4u zr[2];
#pragma unroll
        for (int k = 0; k < 2; ++k) zr[k] = *(const v4u*)(zptr + (size_t)c * 128 * PLD + 8 * k);
        if (c < 15) {
#pragma unroll
            for (int k = 0; k < 2; ++k) xr[k] = *(const v4u*)(xsrc + (size_t)(c + 1) * 128 * PLD + 8 * k);
#pragma unroll
            for (int k = 0; k < 4; ++k) { br[k] = *(const v4u*)(bsrc + (size_t)((c + 1) * 128 + 32 * k) * PLD); cr[k] = *(const v4u*)(csrc + (size_t)((c + 1) * 128 + 32 * k) * PLD); }
        }
        __syncthreads();
        f32x16 yacc;
#pragma unroll
        for (int i = 0; i < 16; ++i) yacc[i] = 0.f;
        {   bf16x8v fa[8], fb[8];
#pragma unroll
            for (int ks = 0; ks < 8; ++ks) { fa[ks] = frag_row(ST, PB, 32 * pt + r, 16 * ks + 8 * hh); fb[ks] = frag_row(CG, PB, 32 * lt + r, 16 * ks + 8 * hh); }
            __builtin_amdgcn_sched_barrier(0);
#pragma unroll
            for (int ks = 0; ks < 8; ++ks) yacc = MFMA32(fa[ks], fb[ks], yacc); }
        { const float e = __expf(ldc[32 * lt + r]);
#pragma unroll
          for (int i = 0; i < 16; ++i) yacc[i] *= e; }
        f32x16 tA, tB;
        const int ltA = (w >= 6) ? 3 : (w >= 3) ? 2 : (w >= 1) ? 1 : 0, stA = w - ltA * (ltA + 1) / 2;
        const int ltB = 3, stB = w + 2;
#pragma unroll
        for (int i = 0; i < 16; ++i) { tA[i] = 0.f; tB[i] = 0.f; }
        {   bf16x8v fa[8], fb[8];
#pragma unroll
            for (int ks = 0; ks < 8; ++ks) { fa[ks] = frag_row(BB, PB, 32 * stA + r, 16 * ks + 8 * hh); fb[ks] = frag_row(CG, PB, 32 * ltA + r, 16 * ks + 8 * hh); }
            __builtin_amdgcn_sched_barrier(0);
#pragma unroll
            for (int ks = 0; ks < 8; ++ks) tA = MFMA32(fa[ks], fb[ks], tA); }
        if (w < 2) { bf16x8v fa[8], fb[8];
#pragma unroll
            for (int ks = 0; ks < 8; ++ks) { fa[ks] = frag_row(BB, PB, 32 * stB + r, 16 * ks + 8 * hh); fb[ks] = frag_row(CG, PB, 32 * ltB + r, 16 * ks + 8 * hh); }
            __builtin_amdgcn_sched_barrier(0);
#pragma unroll
            for (int ks = 0; ks < 8; ++ks) tB = MFMA32(fa[ks], fb[ks], tB); }
        __syncthreads();
#define SSD_GWRITE(T_, st_, lt_) do { const int l = 32 * (lt_) + r; const float ldl = ldc[l]; \
          _Pragma("unroll") for (int g4 = 0; g4 < 4; ++g4) { const int s0 = 32 * (st_) + 8 * g4 + 4 * hh; \
              const f32x4 lds4 = *(LAS const f32x4*)(ldc + s0), dts4 = *(LAS const f32x4*)(dtc + s0); float v[4]; \
              _Pragma("unroll") for (int j = 0; j < 4; ++j) { const float e_ = __expf(fminf(ldl - lds4[j], 0.f)) * dts4[j] * T_[4 * g4 + j]; v[j] = (s0 + j <= l) ? e_ : 0.f; } \
              *(LAS unsigned long long*)(CG + l * PB + s0 * 2) = (unsigned long long)pk2(v[0], v[1]) | ((unsigned long long)pk2(v[2], v[3]) << 32); } } while (0)
        SSD_GWRITE(tA, stA, ltA);
        if (w < 2) SSD_GWRITE(tB, stB, ltB);
#undef SSD_GWRITE
        __syncthreads();
        for (int kb = 0; kb <= lt; ++kb) { bf16x8v fa[2], fb[2];
#pragma unroll
            for (int k2 = 0; k2 < 2; ++k2) { const int ks = 2 * kb + k2; fa[k2] = frag_tr(XX, PX, 16 * ks + 8 * hh + trq, 32 * pt + trc); fb[k2] = frag_row(CG, PB, 32 * lt + r, 16 * ks + 8 * hh); }
            __builtin_amdgcn_sched_barrier(0);
#pragma unroll
            for (int k2 = 0; k2 < 2; ++k2) yacc = MFMA32(fa[k2], fb[k2], yacc); }
        { const float e = __expf(ldc[127]);
#pragma unroll
          for (int i = 0; i < 16; ++i) sacc[i] *= e; }
        {   bf16x8v fa[8], fb[8];
#pragma unroll
            for (int ks = 0; ks < 8; ++ks) { fa[ks] = frag_tr(BB, PB, 16 * ks + 8 * hh + trq, 32 * lt + trc); fb[ks] = frag_tr(XW, PX, 16 * ks + 8 * hh + trq, 32 * pt + trc); }
            __builtin_amdgcn_sched_barrier(0);
#pragma unroll
            for (int ks = 0; ks < 8; ++ks) sacc = MFMA32(fa[ks], fb[ks], sacc); }
        __syncthreads();
        {
            const int p = 32 * pt + r, l = 32 * lt + r;
#pragma unroll
            for (int g4 = 0; g4 < 4; ++g4) { const int n0 = 32 * lt + 8 * g4 + 4 * hh;
                *(LAS unsigned long long*)(ST + p * PB + n0 * 2) = (unsigned long long)pk2(sacc[4 * g4], sacc[4 * g4 + 1]) | ((unsigned long long)pk2(sacc[4 * g4 + 2], sacc[4 * g4 + 3]) << 32);
                const int p0 = 32 * pt + 8 * g4 + 4 * hh;
                *(LAS f32x4*)(CG + l * 272 + p0 * 4) = (f32x4){yacc[4 * g4], yacc[4 * g4 + 1], yacc[4 * g4 + 2], yacc[4 * g4 + 3]}; }
        }
        __syncthreads();
        {
            float o[16]; float ss = 0.f;
#pragma unroll
            for (int k = 0; k < 2; ++k) { const v4u zv = zr[k]; const v4u xv = *(const LAS v4u*)(XX + xrow * PX + xq * 32 + k * 16);
                const f32x4 y0 = *(const LAS f32x4*)(CG + xrow * 272 + (xq * 16 + 8 * k) * 4), y1 = *(const LAS f32x4*)(CG + xrow * 272 + (xq * 16 + 8 * k + 4) * 4);
#pragma unroll
                for (int i = 0; i < 4; ++i) { const float ya = (i < 2 ? y0[2 * i] : y1[2 * i - 4]), yb = (i < 2 ? y0[2 * i + 1] : y1[2 * i - 3]);
                    const float oa = (ya + dsk * bf2f(xv[i] & 0xffff)) * silu_f(bf2f(zv[i] & 0xffff)), ob = (yb + dsk * bf2f(xv[i] >> 16)) * silu_f(bf2f(zv[i] >> 16));
                    o[8 * k + 2 * i] = oa; o[8 * k + 2 * i + 1] = ob; ss += oa * oa + ob * ob; } }
            ss += shx(ss, 1, lane); ss += shx(ss, 2, lane);
            bf16* zp = zptr + (size_t)c * 128 * PLD;
#pragma unroll
            for (int k = 0; k < 2; ++k) { v4u ov; ov.x = pk2(o[8 * k], o[8 * k + 1]); ov.y = pk2(o[8 * k + 2], o[8 * k + 3]); ov.z = pk2(o[8 * k + 4], o[8 * k + 5]); ov.w = pk2(o[8 * k + 6], o[8 * k + 7]); *(v4u*)(zp + 8 * k) = ov; }
            if (xq == 0) ssq[(row0 + xrow) * 16 + h] = ss;
        }
    }
    __syncthreads();
}

__device__ __forceinline__ void mlstm_unit(int tid, bf16* proj, const float* smallp, const float* i_bias, const float* f_bias, const float* norm_w, int b, int hd, LAS unsigned char* lds, float* gsc  , unsigned long long* pts) {
    constexpr int PB = 272, GS = 656;
    asm volatile("" : "+v"(tid));
    LAS unsigned char* QP = lds;
    LAS unsigned char* KK = lds + 34816;
    LAS unsigned char* VV = lds + 69632;
    LAS unsigned char* CS = lds + 104448;
    LAS float* uu = (LAS float*)(lds + 139264);
    LAS float* mmv = uu + 128;
    LAS float* wint = mmv + 128;
    LAS float* dnv = wint + 128;
    LAS float* wlv = dnv + 128;
    LAS float* scal = wlv + 128;
    LAS float* nwl = scal + 16;
    LAS float* ptot = nwl + 128;
    LAS float* pmlo = ptot + 16;
    LAS unsigned short* nstb = (LAS unsigned short*)(pmlo + 16);
    const int lane0 = tid & 63, w = __builtin_amdgcn_readfirstlane(tid >> 6);
    const int tt = w >> 1, dp = w & 1;
    const float ib = i_bias[hd], fb = f_bias[hd];
    const size_t rowb = (size_t)b * SEQ;
    const int srow = tid >> 4, sc = tid & 15, et = tid >> 2, eq = tid & 3;
    const bf16* qsrc = proj + (rowb + srow) * PLD + PC_MQK + hd * 128 + sc * 8;
    const bf16* ksrc = qsrc + 512;
    const bf16* vsrc = proj + (rowb + srow) * PLD + PC_MV + hd * 128 + sc * 8;
    bf16* optr = proj + (rowb + et) * PLD + PC_MO + hd * 128 + eq * 32;
    v4u qr[4], kr[4]; float wlr[4];
#pragma unroll
    for (int k = 0; k < 4; ++k) { qr[k] = *(const v4u*)(qsrc + (size_t)32 * k * PLD); kr[k] = *(const v4u*)(ksrc + (size_t)32 * k * PLD); }
    {
        float pc0[2], pc1[2], pu0[2], pu1[2], pp0[2], pp1[2];
#pragma unroll
        for (int cc = 0; cc < 2; ++cc) { const float* gp = smallp + (rowb + (size_t)(2 * w + cc) * 128 + lane0) * 24 + 16 + hd;
            const float li0 = gp[0] + ib, li1 = gp[64 * 24] + ib, f0 = gp[4] + fb, f1 = gp[64 * 24 + 4] + fb;
            float c0 = logsig_f(f0), c1 = logsig_f(f1);
#pragma unroll
            for (int o = 1; o < 64; o <<= 1) { const float t0 = shup(c0, o, lane0), t1 = shup(c1, o, lane0); if (lane0 >= o) { c0 += t0; c1 += t1; } }
            c1 += shl_(c0, 63, lane0);
            const float totf = shl_(c1, 63, lane0);
            const float u0 = li0 - c0, u1 = li1 - c1;
            float p0 = u0, p1 = u1;
#pragma unroll
            for (int o = 1; o < 64; o <<= 1) { const float t0 = shup(p0, o, lane0), t1 = shup(p1, o, lane0); if (lane0 >= o) { p0 = fmaxf(p0, t0); p1 = fmaxf(p1, t1); } }
            p1 = fmaxf(p1, shl_(p0, 63, lane0));
            pc0[cc] = c0; pc1[cc] = c1; pu0[cc] = u0; pu1[cc] = u1; pp0[cc] = p0; pp1[cc] = p1;
            const float pall = shl_(p1, 63, lane0);
            if (lane0 == 0) { ptot[2 * w + cc] = totf; pmlo[2 * w + cc] = totf + pall; }
        }
        if (tid < 128) nwl[tid] = norm_w[hd * 128 + tid];
        if (tid < 64) ((LAS unsigned*)nstb)[tid] = 0u;
        for (int i = tid; i < 34816 / 4; i += 512) ((LAS unsigned*)CS)[i] = 0u;
        __syncthreads();
        float mst = 0.f, mst_mine[2] = {0.f, 0.f}, mnew_mine[2] = {0.f, 0.f};
#pragma unroll
        for (int c = 0; c < 16; ++c) { const float tf = ptot[c], ml = pmlo[c]; const float mn = fmaxf(tf + mst, ml);
            if (tid == 0) scal[c] = __expf(tf + mst - mn);
            if (c == 2 * w) { mst_mine[0] = mst; mnew_mine[0] = mn; }
            if (c == 2 * w + 1) { mst_mine[1] = mst; mnew_mine[1] = mn; }
            mst = mn; }
#pragma unroll
        for (int cc = 0; cc < 2; ++cc) { float* go_ = gsc + (size_t)(2 * w + cc) * GS; const float ms = mst_mine[cc], mn = mnew_mine[cc], tf = ptot[2 * w + cc];
            const float m0 = fmaxf(pp0[cc], ms), m1 = fmaxf(pp1[cc], ms);
            go_[lane0] = __expf(mn - tf - m0); go_[64 + lane0] = __expf(mn - tf - m1); go_[128 + lane0] = m0; go_[192 + lane0] = m1;
            go_[256 + lane0] = __expf(ms - m0); go_[320 + lane0] = __expf(ms - m1);
            go_[384 + lane0] = __expf(-(pc0[cc] + m0)); go_[448 + lane0] = __expf(-(pc1[cc] + m1));
            go_[512 + lane0] = __expf(tf + pu0[cc] - mn); go_[576 + lane0] = __expf(tf + pu1[cc] - mn); }
        asm volatile("s_waitcnt vmcnt(0)" ::: "memory");
        __syncthreads();
    }
    float gr[5] = {0.f, 0.f, 0.f, 0.f, 0.f};
    if (tid < 128) {
#pragma unroll
        for (int k = 0; k < 5; ++k) gr[k] = __hip_atomic_load(gsc + k * 128 + tid, __ATOMIC_RELAXED, __HIP_MEMORY_SCOPE_AGENT); }
#pragma unroll
    for (int k = 0; k < 4; ++k) wlr[k] = __hip_atomic_load(gsc + 512 + srow + 32 * k, __ATOMIC_RELAXED, __HIP_MEMORY_SCOPE_AGENT);
    f32x16 cacc0, cacc1, nacc;
#pragma unroll
    for (int i = 0; i < 16; ++i) { cacc0[i] = 0.f; cacc1[i] = 0.f; nacc[i] = 0.f; }
    const bf16x8v ones = (bf16x8v){0x3F80, 0x3F80, 0x3F80, 0x3F80, 0x3F80, 0x3F80, 0x3F80, 0x3F80};
#if PROBE_PHASE != -1 && defined(PROBE_STAGES)
    unsigned long long tacc = 0; unsigned long long tprev = __builtin_amdgcn_s_memrealtime();
#define STAMP(k) do { const unsigned long long tn_ = __builtin_amdgcn_s_memrealtime(); if ((k) == PROBE_STAGES) tacc += tn_ - tprev; tprev = tn_; } while (0)
#else
#define STAMP(k) do {} while (0)
#endif
    for (int c = 0; c < 16; ++c) {
        int lane = lane0; asm volatile("" : "+v"(lane));
        const int r = lane & 31, hh = lane >> 5, trq = (lane & 15) >> 2, trc = 16 * ((lane >> 4) & 1) + 4 * (lane & 3);
        __syncthreads();
        STAMP(0);
#pragma unroll
        for (int k = 0; k < 4; ++k) { *(LAS v4u*)(QP + (srow + 32 * k) * PB + sc * 16) = qr[k]; v4u kw_;
#pragma unroll
            for (int i = 0; i < 4; ++i) kw_[i] = pk2(bflo(kr[k][i]) * wlr[k], bfhi(kr[k][i]) * wlr[k]);
            *(LAS v4u*)(KK + (srow + 32 * k) * PB + sc * 16) = kw_; }
        if (tid < 128) { uu[tid] = gr[0]; mmv[tid] = gr[1]; wint[tid] = gr[2]; dnv[tid] = gr[3]; wlv[tid] = gr[4]; }
        v4u vr[4];
#pragma unroll
        for (int k = 0; k < 4; ++k) vr[k] = *(const v4u*)(vsrc + (size_t)(c * 128 + 32 * k) * PLD);
        if (c < 15) {
#pragma unroll
            for (int k = 0; k < 4; ++k) { const size_t ro = (size_t)((c + 1) * 128 + 32 * k) * PLD; qr[k] = *(const v4u*)(qsrc + ro); kr[k] = *(const v4u*)(ksrc + ro); }
#pragma unroll
            for (int k = 0; k < 4; ++k) wlr[k] = __hip_atomic_load(gsc + (size_t)(c + 1) * GS + 512 + srow + 32 * k, __ATOMIC_RELAXED, __HIP_MEMORY_SCOPE_AGENT);
            if (tid < 128) {
#pragma unroll
                for (int k = 0; k < 5; ++k) gr[k] = __hip_atomic_load(gsc + (size_t)(c + 1) * GS + k * 128 + tid, __ATOMIC_RELAXED, __HIP_MEMORY_SCOPE_AGENT); }
        }
        __syncthreads();
        STAMP(1);
        f32x16 na0, na1, dacc;
#pragma unroll
        for (int i = 0; i < 16; ++i) { na0[i] = 0.f; na1[i] = 0.f; dacc[i] = 0.f; }
#pragma unroll
        for (int kh = 0; kh < 2; ++kh) { bf16x8v fq[4], f0[4], f1[4], fn[4];
#pragma unroll
            for (int k4 = 0; k4 < 4; ++k4) { const int ks = 4 * kh + k4; fq[k4] = frag_row(QP, PB, 32 * tt + r, 16 * ks + 8 * hh); f0[k4] = frag_row(CS, PB, 32 * (2 * dp) + r, 16 * ks + 8 * hh); f1[k4] = frag_row(CS, PB, 32 * (2 * dp + 1) + r, 16 * ks + 8 * hh);
                fn[k4] = *(const LAS bf16x8v*)((LAS const unsigned char*)nstb + (16 * ks + 8 * hh) * 2); }
            __builtin_amdgcn_sched_barrier(0);
#pragma unroll
            for (int k4 = 0; k4 < 4; ++k4) { na0 = MFMA32(f0[k4], fq[k4], na0); na1 = MFMA32(f1[k4], fq[k4], na1); dacc = MFMA32(fn[k4], fq[k4], dacc); } }
        { const float e = wint[32 * tt + r];
#pragma unroll
          for (int i = 0; i < 16; ++i) { na0[i] *= e; na1[i] *= e; dacc[i] *= e; } }
        f32x16 tA, tB;
        const int ttA = (w >= 6) ? 3 : (w >= 3) ? 2 : (w >= 1) ? 1 : 0, stA = w - ttA * (ttA + 1) / 2;
        const int ttB = 3, stB = w + 2;
#pragma unroll
        for (int i = 0; i < 16; ++i) { tA[i] = 0.f; tB[i] = 0.f; }
#pragma unroll
        for (int kh = 0; kh < 2; ++kh) { bf16x8v fa[4], fb_[4];
#pragma unroll
            for (int k4 = 0; k4 < 4; ++k4) { const int ks = 4 * kh + k4; fa[k4] = frag_row(KK, PB, 32 * stA + r, 16 * ks + 8 * hh); fb_[k4] = frag_row(QP, PB, 32 * ttA + r, 16 * ks + 8 * hh); }
            __builtin_amdgcn_sched_barrier(0);
#pragma unroll
            for (int k4 = 0; k4 < 4; ++k4) tA = MFMA32(fa[k4], fb_[k4], tA); }
        if (w < 2) {
#pragma unroll
            for (int kh = 0; kh < 2; ++kh) { bf16x8v fa[4], fb_[4];
#pragma unroll
                for (int k4 = 0; k4 < 4; ++k4) { const int ks = 4 * kh + k4; fa[k4] = frag_row(KK, PB, 32 * stB + r, 16 * ks + 8 * hh); fb_[k4] = frag_row(QP, PB, 32 * ttB + r, 16 * ks + 8 * hh); }
                __builtin_amdgcn_sched_barrier(0);
#pragma unroll
                for (int k4 = 0; k4 < 4; ++k4) tB = MFMA32(fa[k4], fb_[k4], tB); } }
        __syncthreads();
        STAMP(2);
#define ML_PWRITE(T_, st_, tt_) do { const int t = 32 * (tt_) + r; const float rh = uu[t]; \
          _Pragma("unroll") for (int g4 = 0; g4 < 4; ++g4) { const int s0 = 32 * (st_) + 8 * g4 + 4 * hh; float v[4]; \
              _Pragma("unroll") for (int j = 0; j < 4; ++j) v[j] = (s0 + j <= t) ? T_[4 * g4 + j] * rh : 0.f; \
              *(LAS unsigned long long*)(QP + t * PB + s0 * 2) = (unsigned long long)pk2(v[0], v[1]) | ((unsigned long long)pk2(v[2], v[3]) << 32); } } while (0)
        ML_PWRITE(tA, stA, ttA);
        if (w < 2) ML_PWRITE(tB, stB, ttB);
#undef ML_PWRITE
#pragma unroll
        for (int k = 0; k < 4; ++k) *(LAS v4u*)(VV + (srow + 32 * k) * PB + sc * 16) = vr[k];
        v4u og[4];
#pragma unroll
        for (int k = 0; k < 4; ++k) og[k] = *(const v4u*)(optr + (size_t)c * 128 * PLD + 8 * k);
        __syncthreads();
        STAMP(3);
        { const float e = scal[c];
#pragma unroll
          for (int i = 0; i < 16; ++i) { cacc0[i] *= e; cacc1[i] *= e; nacc[i] *= e; } }
#pragma unroll
        for (int kb = 0; kb < 4; ++kb) { bf16x8v fk[2], f0[2], f1[2], fp[2];
            const bool m3 = kb <= tt;
#pragma unroll
            for (int k2 = 0; k2 < 2; ++k2) { const int ks = 2 * kb + k2; fk[k2] = frag_tr(KK, PB, 16 * ks + 8 * hh + trq, 32 * tt + trc);
                f0[k2] = frag_tr(VV, PB, 16 * ks + 8 * hh + trq, 32 * (2 * dp) + trc); f1[k2] = frag_tr(VV, PB, 16 * ks + 8 * hh + trq, 32 * (2 * dp + 1) + trc);
                fp[k2] = frag_row(QP, PB, 32 * tt + r, 16 * ks + 8 * hh); }
            __builtin_amdgcn_sched_barrier(0);
#pragma unroll
            for (int k2 = 0; k2 < 2; ++k2) { cacc0 = MFMA32(fk[k2], f0[k2], cacc0); cacc1 = MFMA32(fk[k2], f1[k2], cacc1); nacc = MFMA32(fk[k2], ones, nacc);
                if (m3) { na0 = MFMA32(f0[k2], fp[k2], na0); na1 = MFMA32(f1[k2], fp[k2], na1); dacc = MFMA32(ones, fp[k2], dacc); } } }
        __syncthreads();
        STAMP(4);
        {
            const int t = 32 * tt + r; const float dv = __builtin_amdgcn_rcpf(fmaxf(fabsf(dacc[0]), dnv[t]));
#pragma unroll
            for (int g4 = 0; g4 < 4; ++g4) {
                const int e0 = 32 * tt + 8 * g4 + 4 * hh, d0 = 32 * (2 * dp) + r, d1 = 32 * (2 * dp + 1) + r;
                *(LAS unsigned long long*)(CS + d0 * PB + e0 * 2) = (unsigned long long)pk2(cacc0[4 * g4], cacc0[4 * g4 + 1]) | ((unsigned long long)pk2(cacc0[4 * g4 + 2], cacc0[4 * g4 + 3]) << 32);
                *(LAS unsigned long long*)(CS + d1 * PB + e0 * 2) = (unsigned long long)pk2(cacc1[4 * g4], cacc1[4 * g4 + 1]) | ((unsigned long long)pk2(cacc1[4 * g4 + 2], cacc1[4 * g4 + 3]) << 32);
                const int dd0 = 32 * (2 * dp) + 8 * g4 + 4 * hh, dd1 = dd0 + 32;
                *(LAS unsigned long long*)(QP + t * PB + dd0 * 2) = (unsigned long long)pk2(na0[4 * g4] * dv, na0[4 * g4 + 1] * dv) | ((unsigned long long)pk2(na0[4 * g4 + 2] * dv, na0[4 * g4 + 3] * dv) << 32);
                *(LAS unsigned long long*)(QP + t * PB + dd1 * 2) = (unsigned long long)pk2(na1[4 * g4] * dv, na1[4 * g4 + 1] * dv) | ((unsigned long long)pk2(na1[4 * g4 + 2] * dv, na1[4 * g4 + 3] * dv) << 32);
                if (dp == 0 && r == 0) *(LAS unsigned long long*)((LAS unsigned char*)nstb + e0 * 2) = (unsigned long long)pk2(nacc[4 * g4], nacc[4 * g4 + 1]) | ((unsigned long long)pk2(nacc[4 * g4 + 2], nacc[4 * g4 + 3]) << 32);
            }
        }
        __syncthreads();
        STAMP(5);
        {
            float hv[32]; float ss = 0.f;
#pragma unroll
            for (int k = 0; k < 4; ++k) { const v4u x = *(const LAS v4u*)(QP + et * PB + eq * 64 + k * 16);
#pragma unroll
                for (int i = 0; i < 4; ++i) { hv[8 * k + 2 * i] = bflo(x[i]); hv[8 * k + 2 * i + 1] = bfhi(x[i]); ss += hv[8 * k + 2 * i] * hv[8 * k + 2 * i] + hv[8 * k + 2 * i + 1] * hv[8 * k + 2 * i + 1]; } }
            ss += shx(ss, 1, lane); ss += shx(ss, 2, lane);
            const float rr = __builtin_amdgcn_rsqf(ss * (1.0f / 128.0f) + EPS);
            bf16* op = optr + (size_t)c * 128 * PLD;
            LAS const float* nw = nwl + eq * 32;
#pragma unroll
            for (int k = 0; k < 4; ++k) { v4u o; const f32x4 w0 = *(LAS const f32x4*)(nw + 8 * k), w1 = *(LAS const f32x4*)(nw + 8 * k + 4);
#pragma unroll
                for (int i = 0; i < 4; ++i) { const float g0 = sigm_f(bflo(og[k][i])), g1 = sigm_f(bfhi(og[k][i]));
                    const float wa = (i < 2) ? w0[2 * i] : w1[2 * i - 4], wb = (i < 2) ? w0[2 * i + 1] : w1[2 * i - 3];
                    o[i] = pk2(hv[8 * k + 2 * i] * rr * wa * g0, hv[8 * k + 2 * i + 1] * rr * wb * g1); }
                *(v4u*)(op + 8 * k) = o; }
        }
    }
#if PROBE_PHASE != -1 && defined(PROBE_STAGES)
    STAMP(6);
    if (tid == 0 && pts) pts[PROBE_STAGES] = tacc;
#endif
#undef STAMP
    __syncthreads();
}

__device__ __forceinline__ void conv_fix(Frame& F, bf16* proj, const bf16* halo, const float* scw, const float* scb, const float* mcw, const float* mcb) {
    const int gt = F.vcu * (NWAVES * 64) + F.tid, NT = F.G * NWAVES * 64;
    for (int it = gt; it < 256 * 320; it += NT) {
        const int strip = it % 320, rg = it / 320, hch = strip * 8;
        const float* wp; const float* bp; int wst; float post = 1.0f;
        if (hch < 1536) { wp = scw + hch; bp = scb + hch; wst = 1536; }
        else { const int c2 = hch - 1536; wp = mcw + c2; bp = mcb + c2; wst = 1024; post = (c2 >= 512) ? 0.08838834764831845f : 1.0f; }
        bf16* base = proj + (size_t)rg * 64 * PLD + PC_XBC + hch;
        v4u r0 = (v4u){0, 0, 0, 0}, r1 = r0, r2 = r0;
        if ((rg & 31) != 0) { const bf16* hp = halo + ((size_t)(rg - 1) * 3) * 2560 + hch; r0 = *(const v4u*)hp; r1 = *(const v4u*)(hp + 2560); r2 = *(const v4u*)(hp + 5120); }
        v4u cur[3];
#pragma unroll
        for (int j = 0; j < 3; ++j) cur[j] = *(const v4u*)(base + (size_t)j * PLD);
        float cw[4][8], cb[8];
#pragma unroll
        for (int j = 0; j < 4; ++j) { const f32x4 a0 = *(const f32x4*)(wp + j * wst), a1 = *(const f32x4*)(wp + j * wst + 4);
#pragma unroll
            for (int i = 0; i < 4; ++i) { cw[j][i] = a0[i]; cw[j][4 + i] = a1[i]; } }
        { const f32x4 a0 = *(const f32x4*)bp, a1 = *(const f32x4*)(bp + 4);
#pragma unroll
          for (int i = 0; i < 4; ++i) { cb[i] = a0[i]; cb[4 + i] = a1[i]; } }
#pragma unroll
        for (int j = 0; j < 3; ++j) { v4u o;
#pragma unroll
            for (int i = 0; i < 4; ++i) {
                const float a0 = cb[2 * i] + cw[0][2 * i] * bflo(r0[i]) + cw[1][2 * i] * bflo(r1[i]) + cw[2][2 * i] * bflo(r2[i]) + cw[3][2 * i] * bflo(cur[j][i]);
                const float a1 = cb[2 * i + 1] + cw[0][2 * i + 1] * bfhi(r0[i]) + cw[1][2 * i + 1] * bfhi(r1[i]) + cw[2][2 * i + 1] * bfhi(r2[i]) + cw[3][2 * i + 1] * bfhi(cur[j][i]);
                o[i] = pk2(silu_f(a0) * post, silu_f(a1) * post); }
            *(v4u*)(base + (size_t)j * PLD) = o; r0 = r1; r1 = r2; r2 = cur[j]; }
    }
}

__device__ __forceinline__ void ksum_pass(Frame& F, const bf16* proj, float* ksum) {
    const int gt = F.vcu * (NWAVES * 64) + F.tid, NT = F.G * NWAVES * 64;
    for (int it = gt; it < 64 * 16 * 64; it += NT) {
        const int ch = it & 63, sl = (it >> 6) & 15, tile = it >> 10;
        const bf16* base = proj + ((size_t)tile * 256 + sl * 16) * PLD + PC_K + ch * 8;
        float a[8];
#pragma unroll
        for (int i = 0; i < 8; ++i) a[i] = 0.f;
        v4u v[16];
#pragma unroll
        for (int j = 0; j < 16; ++j) v[j] = *(const v4u*)(base + (size_t)j * PLD);
#pragma unroll
        for (int j = 0; j < 16; ++j)
#pragma unroll
            for (int i = 0; i < 4; ++i) { a[2 * i] += bflo(v[j][i]); a[2 * i + 1] += bfhi(v[j][i]); }
        float* kd = ksum + (size_t)tile * 512 + ch * 8;
#pragma unroll
        for (int i = 0; i < 8; ++i) atomicAdd(kd + i, a[i]);
    }
}

namespace attn_body {
using bf16=__hip_bfloat16;
using bf16x8=__attribute__((ext_vector_type(8)))short;
using s16x4=__attribute__((ext_vector_type(4)))short;
using f32x16=__attribute__((ext_vector_type(16)))float;
using u32x4=__attribute__((ext_vector_type(4)))unsigned;
constexpr int BATCH=8,NHEAD=8,SEQ=2048,D=64,DM=6144;
constexpr int NW=8,QBLK=32,QB=QBLK*NW,KVBLK=64,NQB=SEQ/QB;
constexpr int ATTN_PITCH=DM, ATTN_UNIT_ROWS=QB;
__device__ __forceinline__ int crow(int r,int hi){return (r&3)+8*(r>>2)+4*hi;}
#define SBAR() __builtin_amdgcn_sched_barrier(0)
__device__ __forceinline__ void cmask(f32x16&p0,f32x16&p1,int jb,int qrel,int hi){
  const float NEG=-INFINITY; int kb=64*jb+4*hi;
  #pragma unroll
  for(int r=0;r<16;++r){int kv=kb+(r&3)+8*(r>>2); if(kv>qrel)p0[r]=NEG; if(kv+32>qrel)p1[r]=NEG;}
}

typedef float f32x4_t __attribute__((ext_vector_type(4)));
__device__ __forceinline__ float bfu(short v){return __uint_as_float(((unsigned)(unsigned short)v)<<16);}
constexpr int NSLOT=3, SLOTB=8192;
constexpr int LDS_K=0, LDS_V=NSLOT*SLOTB, LDS_WS=2*NSLOT*SLOTB, LDS_OST=LDS_WS+NW*64*4, LDS_BYTES=LDS_OST+NW*4096;
constexpr float C2=0.125f*1.4426950408889634f;
__device__ __forceinline__ void glds16(const void*gsrc,unsigned lds_dst){unsigned keep;
  asm volatile("s_mov_b32 %0, m0\n\ts_mov_b32 m0, %2\n\ts_nop 0\n\tglobal_load_lds_dwordx4 %1, off\n\ts_mov_b32 m0, %0":"=&s"(keep):"v"(gsrc),"s"(lds_dst):"memory");}
__device__ __forceinline__ float max3f(float a,float b,float c){float r;asm("v_max3_f32 %0, %1, %2, %3":"=v"(r):"v"(a),"v"(b),"v"(c));return r;}
__device__ __forceinline__ float max2f(float a,float b){float r;asm("v_max_f32_e32 %0, %1, %2":"=v"(r):"v"(a),"v"(b));return r;}
__device__ __forceinline__ float fadd_s(float a,float b){float r;asm("v_add_f32_e32 %0, %1, %2":"=v"(r):"v"(a),"v"(b));return r;}
__device__ __forceinline__ float fsub_s(float a,float b){float r;asm("v_sub_f32_e32 %0, %1, %2":"=v"(r):"v"(a),"v"(b));return r;}
typedef float f32x2_t __attribute__((ext_vector_type(2))); typedef __bf16 bf16x2_t __attribute__((ext_vector_type(2)));
__device__ __forceinline__ unsigned cvtpk_s(float lo,float hi){f32x2_t v={lo,hi};bf16x2_t b=__builtin_convertvector(v,bf16x2_t);return __builtin_bit_cast(unsigned,b);}
#define WAIT_BAR(N) asm volatile("s_waitcnt vmcnt(" #N ") lgkmcnt(0)\n\ts_barrier":::"memory")

__device__ __forceinline__ void qkt(f32x16&p0,f32x16&p1,const char*Kslot,const bf16x8*qr,const f32x16&negm,int r32,int hi){
  const char*kb=Kslot+hi*1024+r32*16;
  #pragma unroll
  for(int d0=0;d0<4;++d0){
    const bf16x8 b0=*reinterpret_cast<const bf16x8*>(kb+d0*2048);
    const bf16x8 b1=*reinterpret_cast<const bf16x8*>(kb+d0*2048+512);
    if(d0==0){p0=__builtin_amdgcn_mfma_f32_32x32x16_bf16(b0,qr[0],negm,0,0,0);p1=__builtin_amdgcn_mfma_f32_32x32x16_bf16(b1,qr[0],negm,0,0,0);}
    else{p0=__builtin_amdgcn_mfma_f32_32x32x16_bf16(b0,qr[d0],p0,0,0,0);p1=__builtin_amdgcn_mfma_f32_32x32x16_bf16(b1,qr[d0],p1,0,0,0);}}
}
typedef __attribute__((address_space(3))) const char* lds_cptr;
typedef short v4i16_t __attribute__((ext_vector_type(4)));
__device__ __forceinline__ void kload8(bf16x8*kf,lds_cptr kp){
  kf[0]=*(const __attribute__((address_space(3))) bf16x8*)(kp);      kf[1]=*(const __attribute__((address_space(3))) bf16x8*)(kp+512);
  kf[2]=*(const __attribute__((address_space(3))) bf16x8*)(kp+2048); kf[3]=*(const __attribute__((address_space(3))) bf16x8*)(kp+2560);
  kf[4]=*(const __attribute__((address_space(3))) bf16x8*)(kp+4096); kf[5]=*(const __attribute__((address_space(3))) bf16x8*)(kp+4608);
  kf[6]=*(const __attribute__((address_space(3))) bf16x8*)(kp+6144); kf[7]=*(const __attribute__((address_space(3))) bf16x8*)(kp+6656);
}
__device__ __forceinline__ void kload2(bf16x8*kf,lds_cptr kp,int j){ kf[2*j]=*(const __attribute__((address_space(3))) bf16x8*)(kp+j*2048); kf[2*j+1]=*(const __attribute__((address_space(3))) bf16x8*)(kp+j*2048+512); }
__device__ __forceinline__ s16x4 vtr(lds_cptr p){ return __builtin_bit_cast(s16x4,__builtin_amdgcn_ds_read_tr16_b64_v4i16((__attribute__((address_space(3))) v4i16_t*)p)); }
__device__ __forceinline__ float rowmax(const f32x16&p0,const f32x16&p1){
  float a=max3f(p0[0],p0[1],p1[0]),b=max3f(p0[2],p0[3],p1[1]);a=max3f(a,p1[2],p1[3]);
  #pragma unroll
  for(int r=4;r<16;r+=4){a=max3f(a,p0[r],p0[r+1]);b=max3f(b,p0[r+2],p0[r+3]);a=max3f(a,p1[r],p1[r+1]);b=max3f(b,p1[r+2],p1[r+3]);}
  const float m=max2f(a,b);
  auto rr=__builtin_amdgcn_permlane32_swap(__float_as_uint(m),__float_as_uint(m),false,false);
  return max2f(__uint_as_float(rr[0]),__uint_as_float(rr[1]));
}
__device__ __forceinline__ void pv(f32x16*o,int vb,bf16x8 pa0,bf16x8 pa1,bf16x8 pa2,bf16x8 pa3){
  #pragma unroll
  for(int d0=0;d0<2;++d0){s16x4 lo[4],hi[4];
    #pragma unroll
    for(int ks=0;ks<4;++ks){
      asm volatile("ds_read_b64_tr_b16 %0,%1 offset:%c2":"=&v"(lo[ks]):"v"(vb),"i"(d0*4096+ks*1024):"memory");
      asm volatile("ds_read_b64_tr_b16 %0,%1 offset:%c2":"=&v"(hi[ks]):"v"(vb),"i"(d0*4096+ks*1024+512):"memory");}
    asm volatile("s_waitcnt lgkmcnt(0)":::"memory");SBAR();
    #define PK(k) (bf16x8){lo[k][0],lo[k][1],lo[k][2],lo[k][3],hi[k][0],hi[k][1],hi[k][2],hi[k][3]}
    o[d0]=__builtin_amdgcn_mfma_f32_32x32x16_bf16(pa0,PK(0),o[d0],0,0,0);
    o[d0]=__builtin_amdgcn_mfma_f32_32x32x16_bf16(pa1,PK(1),o[d0],0,0,0);
    o[d0]=__builtin_amdgcn_mfma_f32_32x32x16_bf16(pa2,PK(2),o[d0],0,0,0);
    o[d0]=__builtin_amdgcn_mfma_f32_32x32x16_bf16(pa3,PK(3),o[d0],0,0,0);
    #undef PK
  }
}

#ifndef ATTN_STORE16
#define ATTN_STORE16(p,v) (*(u32x4*)(p)=(v))
#endif
template<int THRL> __device__ __forceinline__ void attn_unit(int tid,int b,int h,int qb,const bf16*Q,const bf16*__restrict__ K,const bf16*__restrict__ V,bf16*O,const float*__restrict__ ksum,char*shm){
  asm volatile("":"+v"(tid));
  const int lane=tid&63,r32=lane&31,hi=lane>>5; const int wid=__builtin_amdgcn_readfirstlane(tid>>6);
  const long rowbase=(long)b*SEQ; const int q0=qb*QB;
  const bf16*Qw=Q+(rowbase+q0+wid*QBLK)*DM+h*D;
  const bf16*Kh=K+rowbase*DM+h*D,*Vh=V+rowbase*DM+h*D;
  const unsigned lds0=(unsigned)(uintptr_t)shm;
  float*wsf=(float*)(shm+LDS_WS)+wid*64;
  const bf16*ksrc=Kh+(long)lane*DM+wid*8;
  const bf16*vsrc=Vh+(long)(16*(wid&3)+(lane>>2))*DM+(wid>>2)*32+(lane&3)*8;
  const unsigned kdst=lds0+LDS_K+wid*1024, vdst=lds0+LDS_V+wid*1024;
  #define DMA_K(t,slot) glds16(ksrc+(long)(t)*KVBLK*DM,(unsigned)__builtin_amdgcn_readfirstlane(kdst+(slot)))
  #define DMA_V(t,slot) glds16(vsrc+(long)(t)*KVBLK*DM,(unsigned)__builtin_amdgcn_readfirstlane(vdst+(slot)))
  const int vb0=(int)(lds0+LDS_V)+((lane>>4)&1)*32+(lane&3)*8+(4*hi+((lane&15)>>2))*64;
  const char*Kbase=shm+LDS_K; bf16x8 kf[8];
  const lds_cptr shm3=(lds_cptr)shm; const lds_cptr kp0=shm3+LDS_K+hi*1024+r32*16; const lds_cptr vp0=shm3+LDS_V+((lane>>4)&1)*32+(lane&3)*8+(4*hi+((lane&15)>>2))*64;
  const int NT=(q0+QB)/KVBLK;
  DMA_K(0,0);DMA_V(0,0);DMA_K(1,SLOTB);
  bf16x8 qr[4];
  #pragma unroll
  for(int d0=0;d0<4;++d0)qr[d0]=*reinterpret_cast<const bf16x8*>(&Qw[(long)r32*DM+d0*16+hi*8]);
  unsigned sel=(1u<<qb)-1u;
  if(qb>=4){
    float g[8];
    #pragma unroll
    for(int n=0;n<8;++n){ g[n]=0.f;
      { const float*kp=ksum+(((long)(b*8+n)*NHEAD+h)*64)+hi*8; float a=0.f;
        #pragma unroll
        for(int d0=0;d0<4;++d0){ const f32x4_t k0=*(const f32x4_t*)(kp+d0*16),k1=*(const f32x4_t*)(kp+d0*16+4);
          #pragma unroll
          for(int j=0;j<4;++j){ a+=bfu(qr[d0][j])*k0[j]; a+=bfu(qr[d0][4+j])*k1[j]; } }
        a+=shx(a,32,lane); g[n]=a; } }
    sel=0u;
    #pragma unroll
    for(int k=0;k<3;++k){ int best=-1; float bv=0.f;
      #pragma unroll
      for(int n=0;n<8;++n) if(n<qb&&!((sel>>n)&1u)){ if(best<0||g[n]>bv){best=n;bv=g[n];} }
      sel|=1u<<best; }
  }
  #define KEEP(t) (((t)>=NT-4)||((sel>>((t)>>2))&1u))
  float mhat=0.f,l_reg=0.f;f32x16 o[2];o[0]=f32x16{};o[1]=f32x16{};f32x16 negm=f32x16{};asm volatile("":"+v"(negm));
  const int qrel=wid*QBLK+r32;
  #define CMASK(P0,P1,t) do{int jb_=(t)-(NT-4); if(jb_>=0)cmask(P0,P1,jb_,qrel,hi);}while(0)
  bool resc=false;
  #define START(P0,P1) do{ const float rm=KEEP(0)?rowmax(P0,P1):-INFINITY; resc=false; \
    { const float dl=max2f(rm,-64.f); mhat=fadd_s(mhat,dl); \
      _Pragma("unroll") for(int r=0;r<16;++r){P0[r]=fsub_s(P0[r],dl);P1[r]=fsub_s(P1[r],dl);} \
      _Pragma("unroll") for(int r=0;r<16;++r)negm[r]=-mhat; asm volatile("":"+v"(negm)); } \
    _Pragma("unroll") for(int r=0;r<16;++r)P0[r]=__builtin_amdgcn_exp2f(P0[r]); }while(0)
  #define RESC() do{ if(resc){ asm volatile("s_waitcnt lgkmcnt(0)":::"memory"); \
      _Pragma("unroll") for(int d_=0;d_<2;++d_) _Pragma("unroll") for(int r=0;r<16;++r)o[d_][r]*=wsf[crow(r,hi)]; } }while(0)
  f32x16 pA0,pA1,pB0,pB1;
  int sl_prev=0,sl_cur=0,sl_next=SLOTB;
  #define ROT() do{sl_prev=sl_cur;sl_cur=sl_next;sl_next=(sl_next==(NSLOT-1)*SLOTB)?0:sl_next+SLOTB;}while(0)
  DMA_K(2,2*SLOTB);
  WAIT_BAR(3);
  qkt(pA0,pA1,Kbase,qr,negm,r32,hi);asm volatile("s_nop 15\n\ts_nop 7":"+v"(pA0),"+v"(pA1));CMASK(pA0,pA1,0);
  START(pA0,pA1);
  _Pragma("unroll") for(int r=0;r<16;++r)pA1[r]=__builtin_amdgcn_exp2f(pA1[r]);
  WAIT_BAR(0);
  DMA_K(3,0);DMA_V(1,SLOTB);
  ROT();
  kload8(kf,kp0+sl_cur);
  WAIT_BAR(2);
  s16x4 vlo[8],vhi[8]; u32x4 pw0,pw1,pw2,pw3;
  #define PKW(P,B) (cvtpk_s(P[B],P[B+1])&kmp_)
  #define PAF(k) __builtin_bit_cast(bf16x8,pw##k)
  #define VFR(i) (bf16x8){vlo[i][0],vlo[i][1],vlo[i][2],vlo[i][3],vhi[i][0],vhi[i][1],vhi[i][2],vhi[i][3]}
  #define PIN(x) asm volatile("":"+v"(x))
  #define MX3(a,b,c) __builtin_fmaxf(__builtin_fmaxf((a),(b)),(c))
  #define GAPA(MF,A0,A1,A2,A3,W0,W1,PW) do{ MF; sacc+=A0; sacc+=A1; sacc+=A2; sacc+=A3; PIN(sacc); W0; W1; PIN(PW); SBAR(); }while(0)
  #define EX(v) __builtin_amdgcn_exp2f(v)
  #define GAPB(MF,X,B) do{ MF; X[B]=EX(X[B]); X[B+1]=EX(X[B+1]); X[B+2]=EX(X[B+2]); X[B+3]=EX(X[B+3]); PIN(X); SBAR(); }while(0)
  #define VRD(i) do{ vlo[i]=vtr(vp_+(((i)>>2)*4096+((i)&3)*1024)); vhi[i]=vtr(vp_+(((i)>>2)*4096+((i)&3)*1024+512)); }while(0)
  #define KRD(G,j) do{ if(G){ kload2(kf,kp0+sl_next,j); SBAR(); } }while(0)
  #define STEP(C0,C1,P0,P1,t,GK,GV,GL) do{ SBAR(); \
    const lds_cptr vp_=vp0+sl_prev; const bool kp_=KEEP((t)-1); const unsigned kmp_=kp_?0xffffffffu:0u; const float kfp_=kp_?1.f:0.f; \
    VRD(0); SBAR(); float sacc=(P0[0]+P0[1]); \
    GAPA(C0=__builtin_amdgcn_mfma_f32_32x32x16_bf16(kf[0],qr[0],negm,0,0,0), P0[2],P0[3],P0[4],P0[5],     pw0[0]=PKW(P0,0), pw0[1]=PKW(P0,2), pw0); \
    VRD(4); SBAR(); GAPA(C1=__builtin_amdgcn_mfma_f32_32x32x16_bf16(kf[1],qr[0],negm,0,0,0), P0[6],P0[7],P0[8],P0[9],     pw0[2]=PKW(P0,4), pw0[3]=PKW(P0,6), pw0); \
    VRD(1); SBAR(); GAPA(C0=__builtin_amdgcn_mfma_f32_32x32x16_bf16(kf[2],qr[1],C0,0,0,0),   P0[10],P0[11],P0[12],P0[13], pw1[0]=PKW(P0,8), pw1[1]=PKW(P0,10), pw1); \
    VRD(5); SBAR(); GAPA(C1=__builtin_amdgcn_mfma_f32_32x32x16_bf16(kf[3],qr[1],C1,0,0,0),   P0[14],P0[15],P1[0],P1[1],   pw1[2]=PKW(P0,12),pw1[3]=PKW(P0,14), pw1); \
    VRD(2); SBAR(); GAPA(C0=__builtin_amdgcn_mfma_f32_32x32x16_bf16(kf[4],qr[2],C0,0,0,0),   P1[2],P1[3],P1[4],P1[5],     pw2[0]=PKW(P1,0), pw2[1]=PKW(P1,2), pw2); \
    VRD(6); SBAR(); GAPA(C1=__builtin_amdgcn_mfma_f32_32x32x16_bf16(kf[5],qr[2],C1,0,0,0),   P1[6],P1[7],P1[8],P1[9],     pw2[2]=PKW(P1,4), pw2[3]=PKW(P1,6), pw2); \
    VRD(3); SBAR(); GAPA(C0=__builtin_amdgcn_mfma_f32_32x32x16_bf16(kf[6],qr[3],C0,0,0,0),   P1[10],P1[11],P1[12],P1[13], pw3[0]=PKW(P1,8), pw3[1]=PKW(P1,10), pw3); \
    VRD(7); SBAR(); GAPA(C1=__builtin_amdgcn_mfma_f32_32x32x16_bf16(kf[7],qr[3],C1,0,0,0),   P1[14],P1[15],0.f,0.f,       pw3[2]=PKW(P1,12),pw3[3]=PKW(P1,14), pw3); \
    l_reg=__builtin_fmaf(sacc,kfp_,l_reg); \
    if(GK){DMA_K((t)+3,sl_cur);} if(GV){DMA_V((t)+1,sl_next);} \
    CMASK(C0,C1,t); \
    { float a=MX3(C0[0],C0[1],C1[0]),b=MX3(C0[2],C0[3],C1[1]); a=MX3(a,C1[2],C1[3]); \
      _Pragma("unroll") for(int r=4;r<16;r+=4){a=MX3(a,C0[r],C0[r+1]);b=MX3(b,C0[r+2],C0[r+3]);a=MX3(a,C1[r],C1[r+1]);b=MX3(b,C1[r+2],C1[r+3]);} \
      float rm=__builtin_fmaxf(a,b); { auto rr=__builtin_amdgcn_permlane32_swap(__float_as_uint(rm),__float_as_uint(rm),false,false); rm=__builtin_fmaxf(__uint_as_float(rr[0]),__uint_as_float(rr[1])); } \
      rm=KEEP(t)?rm:-INFINITY; \
      resc=false; \
      if(__builtin_expect(__any(rm>(float)THRL),0)){ const float dl=__builtin_fmaxf(rm,0.f); mhat+=dl; \
        _Pragma("unroll") for(int r=0;r<16;++r){C0[r]-=dl;C1[r]-=dl;} \
        _Pragma("unroll") for(int r=0;r<16;++r)negm[r]=-mhat; asm volatile("":"+v"(negm)); \
        const float f=__builtin_amdgcn_exp2f(-dl); l_reg*=f; if(hi==0)wsf[r32]=f; resc=true; } } \
    SBAR(); \
    GAPB(o[0]=__builtin_amdgcn_mfma_f32_32x32x16_bf16(PAF(0),VFR(0),o[0],0,0,0), C0,0); \
    GAPB(o[1]=__builtin_amdgcn_mfma_f32_32x32x16_bf16(PAF(0),VFR(4),o[1],0,0,0), C0,4); \
    KRD(GL,0); GAPB(o[0]=__builtin_amdgcn_mfma_f32_32x32x16_bf16(PAF(1),VFR(1),o[0],0,0,0), C0,8); \
    KRD(GL,1); GAPB(o[1]=__builtin_amdgcn_mfma_f32_32x32x16_bf16(PAF(1),VFR(5),o[1],0,0,0), C0,12); \
    KRD(GL,2); GAPB(o[0]=__builtin_amdgcn_mfma_f32_32x32x16_bf16(PAF(2),VFR(2),o[0],0,0,0), C1,0); \
    KRD(GL,3); GAPB(o[1]=__builtin_amdgcn_mfma_f32_32x32x16_bf16(PAF(2),VFR(6),o[1],0,0,0), C1,4); \
    GAPB(o[0]=__builtin_amdgcn_mfma_f32_32x32x16_bf16(PAF(3),VFR(3),o[0],0,0,0), C1,8); \
    GAPB(o[1]=__builtin_amdgcn_mfma_f32_32x32x16_bf16(PAF(3),VFR(7),o[1],0,0,0), C1,12); \
    }while(0)
  int t=1;
  #undef CMASK
  #define CMASK(P0,P1,t) do{}while(0)
  for(;t+5<NT;t+=2){
    STEP(pB0,pB1,pA0,pA1,t,true,true,true);     WAIT_BAR(2); RESC(); ROT();
    STEP(pA0,pA1,pB0,pB1,t+1,true,true,true);   WAIT_BAR(2); RESC(); ROT();
  }
  #undef CMASK
  #define CMASK(P0,P1,t) do{int jb_=(t)-(NT-4); if(jb_>=0)cmask(P0,P1,jb_,qrel,hi);}while(0)
  #define ENDW(tt) do{ if((tt)+3<NT){WAIT_BAR(2);} else if((tt)+2<NT){WAIT_BAR(1);} else {WAIT_BAR(0);} }while(0)
  for(;t+1<NT;t+=2){
    STEP(pB0,pB1,pA0,pA1,t,(t+3<NT),(t+1<NT),(t+1<NT));       ENDW(t);   RESC(); ROT();
    STEP(pA0,pA1,pB0,pB1,t+1,(t+4<NT),(t+2<NT),(t+2<NT));     ENDW(t+1); RESC(); ROT();
  }
  STEP(pB0,pB1,pA0,pA1,NT-1,false,false,false); RESC();
  { const unsigned kmp_=0xffffffffu; float sacc=pB0[0]+pB0[1]; _Pragma("unroll") for(int r=2;r<16;++r)sacc+=pB0[r]; _Pragma("unroll") for(int r=0;r<16;++r)sacc+=pB1[r]; l_reg+=sacc;
    pw0=(u32x4){PKW(pB0,0),PKW(pB0,2),PKW(pB0,4),PKW(pB0,6)};pw1=(u32x4){PKW(pB0,8),PKW(pB0,10),PKW(pB0,12),PKW(pB0,14)};pw2=(u32x4){PKW(pB1,0),PKW(pB1,2),PKW(pB1,4),PKW(pB1,6)};pw3=(u32x4){PKW(pB1,8),PKW(pB1,10),PKW(pB1,12),PKW(pB1,14)};
    SBAR(); pv(o,vb0+sl_cur,PAF(0),PAF(1),PAF(2),PAF(3)); }
  #undef PKW
  #undef PAF
  #undef VFR
  #undef PIN
  #undef MX3
  #undef GAPA
  #undef GAPB
  #undef EX
  #undef VRD
  #undef KRD
  #undef STEP
  #undef ENDW
  {auto rr=__builtin_amdgcn_permlane32_swap(__float_as_uint(l_reg),__float_as_uint(l_reg),false,false);l_reg=__uint_as_float(rr[0])+__uint_as_float(rr[1]);}
  if(hi==0)wsf[32+r32]=l_reg;asm volatile("s_waitcnt lgkmcnt(0)":::"memory");
  float rli[16];
  #pragma unroll
  for(int r=0;r<16;++r)rli[r]=__builtin_amdgcn_rcpf(wsf[32+crow(r,hi)]);
  bf16*Ow=O+(rowbase+q0+wid*QBLK)*DM+h*D;
  { bf16*stg=(bf16*)(shm+LDS_OST)+wid*2048;
    #pragma unroll
    for(int r=0;r<16;++r){const int orow=crow(r,hi);
      #pragma unroll
      for(int d0=0;d0<2;++d0)stg[orow*64+d0*32+r32]=__float2bfloat16(o[d0][r]*rli[r]);}
    asm volatile("s_waitcnt lgkmcnt(0)":::"memory");
    #pragma unroll
    for(int i=0;i<4;++i){const int row=i*8+(lane>>3),ch=lane&7; const u32x4 v=*(const u32x4*)(stg+row*64+ch*8); ATTN_STORE16(Ow+(long)row*DM+ch*8,v);} }
  asm volatile("s_waitcnt lgkmcnt(0)\n\ts_barrier":::"memory");
  #undef KEEP
  #undef DMA_K
  #undef DMA_V
  #undef CMASK
  #undef START
  #undef RESC
  #undef ROT
}
constexpr int ATTN_LDS_BYTES=LDS_BYTES;
#undef SBAR
#undef WAIT_BAR
}

constexpr int PH_PER_LAYER = 10, N_PHASES = PH_PER_LAYER * DEPTH;

constexpr int CONV_UNIT_ITEMS = 16, N_CONV_UNITS = (1024 + 2816) / CONV_UNIT_ITEMS;
__device__ __forceinline__ void conv_unit(int wave, int lane, int idx, const float* w_out, const float* ssm_nw, const float* w_up, const float* n2w, bf16* bufa, bf16* bufb, LAS float* scr) {
    for (int it = CONV_UNIT_ITEMS * idx + wave; it < CONV_UNIT_ITEMS * idx + CONV_UNIT_ITEMS; it += NWAVES) {
        if (it < 1024) { const int kb = it >> 5, nb = it & 31; conv_item(w_out, DM, 32 * nb, bufb, DMIX, 32 * nb, 64 * kb, scr, lane, ssm_nw, 512, 1536); }
        else { const int i2 = it - 1024, kb = i2 / (ULD / 32), nb = i2 % (ULD / 32); const int src = ((nb >> 2) & 1) * FFN + 128 * (nb >> 3) + (nb & 3) * 32;
            conv_item(w_up, ULD, src, bufa, DM, 32 * nb, 64 * kb, scr, lane, n2w); }
    }
}

template <int L, int P>
__device__ __forceinline__ void run_phase(Frame& F, const int wave0, const int ph_lo, const int ph_hi) {
    constexpr int l = L, p = P, ph = L * PH_PER_LAYER + P;
    if constexpr ((L > 0 && P == 0) || P == 4 || P == 6 || P == 8) return;
    if (!(ph_lo <= ph && ph < ph_hi)) return;
    {
        const __attribute__((address_space(4))) Args* ap = (const __attribute__((address_space(4))) Args*)__builtin_amdgcn_kernarg_segment_ptr();
        asm volatile("" : "+s"(ap));
        { int t_ = wave0 * 64 + fresh_lane(); asm volatile("" : "+v"(t_)); F.tid = t_; F.lane = t_ & 63; F.wave = __builtin_amdgcn_readfirstlane(t_ >> 6); }
        F.G = gridDim.x; { const int bx = blockIdx.x; F.vcu = (F.G % 8 == 0) ? (bx % 8) * (F.G / 8) + bx / 8 : bx; }
        unsigned char* ws = ap->ws; float* out = ap->out;
        bf16* bufa = (bf16*)(ws + WS_BUFA); bf16* bufb = (bf16*)(ws + WS_BUFB); bf16* xb = (bf16*)(ws + WS_XB); bf16* proj = (bf16*)(ws + WS_PROJ);
        float* smallp = (float*)(ws + WS_SMALLP); float* ssq = (float*)(ws + WS_SSQ);
        switch (p) {
        case 0: {
            LAS float* scr = (LAS float*)(F.lds + F.wave * 16384);
            conv_w_in(F, ap->in[2], ap->in[1], bufa, scr);
            conv_small(F, ap->in[2], ap->in[1], (bf16*)(ws + WS_WSM));
            row_pass0(F, ap->in[0], xb, (float*)(ws + WS_RS));
        } break;
        case 1: {
            const float* rs = (const float*)(ws + WS_RS) + (size_t)(2 * l) * M;
            pg8::Gemm g{xb, bufa, M, PLD, DM, DM}; pg8::StaticOrder S; S.init(M, PLD, F.G, (int)blockIdx.x);
            pg8::EpiProj E{ws, (const float* const __attribute__((address_space(4)))*)ap->in, l};
            pg8::gemm_phase<pg8::EpiProj>(F.lds + RING_OFF, g, S, E, F.tid);
            small_proj(F, xb, (const bf16*)(ws + WS_WSM) + (size_t)(l & 1) * 32 * DM, rs, smallp);
        } break;
        case 2: {
            ksum_pass(F, proj, (float*)(ws + WS_KSUM + (size_t)l * 131072));
            conv_fix(F, proj, (const bf16*)(ws + WS_HALO), ap->in[5] + (size_t)l * 4 * 1536, ap->in[6] + l * 1536, ap->in[11] + (size_t)l * 4 * 1024, ap->in[12] + l * 1024);
        } break;
        case 3: {
            constexpr int QN = 4 + 16 + 64 + N_CONV_UNITS / 8;
            gu32* qheads = (gu32*)(ws + WS_QUEUE) + l * 8 * 64;
            volatile LAS unsigned* MISC = (volatile LAS unsigned*)(F.lds + MISC_OFF);
            const attn_body::bf16* pq = (const attn_body::bf16*)proj; const float* ks = (const float*)(ws + WS_KSUM + (size_t)l * 131072);
            const int x0 = (int)(xb_xcc_id() & 7u);
            for (int hop = 0; hop < 8;) {
                const int x = (x0 + hop) & 7;
                const int tq = wave0 * 64 + fresh_lane();
                __syncthreads();
                if (tq == 0) MISC[0] = __hip_atomic_fetch_add(qheads + x * 64, 1u, RLX_AGENT);
                __syncthreads();
                const int j = (int)MISC[0];
                if (j >= QN) { ++hop; continue; }
#if PROBE_PHASE != -1
                const unsigned long long tu0 = __builtin_amdgcn_s_memrealtime();
                const int u = (j < 4) ? (x * 4 + j) : (j < 20) ? (32 + x * 16 + j - 4) : 160 + x * 64 + j - 20;
#endif
                if (j < 4) mlstm_unit(tq, proj, smallp, ap->in[13] + l * 4, ap->in[14] + l * 4, ap->in[15] + l * 512, x, j, F.lds, (float*)(ws + WS_GSC) + (size_t)(x * 4 + j) * 16 * 656, (l == 0 && x == 0 && j == 0) ? (unsigned long long*)(ws + WS_TS) + 1024 : nullptr);
                else if (j < 20) ssd_unit(tq, proj, smallp, ssq, ap->in[7] + l * 16, ap->in[8] + l * 16, ap->in[9] + l * 16, x, j - 4, F.lds);
                else if (j < 84) { const int idx = j - 20, h = idx & 7, qb = 7 - (idx >> 3);
                    attn_body::attn_unit<8>(tq, x, h, qb, pq + PC_Q, pq + PC_K, pq + PC_V, (attn_body::bf16*)proj + PC_Q, ks, (char*)F.lds); }
                else conv_unit(wave0, tq & 63, x * (N_CONV_UNITS / 8) + j - 84, ap->in[16] + (size_t)l * DMIX * DM, ap->in[10] + l * 1024, ap->in[18] + (size_t)l * DM * ULD, ap->in[17] + l * DM, bufa, bufb, (LAS float*)(F.lds + wave0 * 16384));
#if PROBE_PHASE != -1
                if (l == 0 && wave0 == 0 && fresh_lane() == 0) __hip_atomic_store((unsigned long long*)(ws + WS_TS) + 128 + u, (unsigned long long)(__builtin_amdgcn_s_memrealtime() - tu0), __ATOMIC_RELAXED, __HIP_MEMORY_SCOPE_AGENT);
#endif
            }
        } break;
        case 4: break;
        case 5: {
            pg8::Gemm g{proj, bufb, M, DM, DMIX, PLD}; pg8::StaticOrder S; S.init(M, DM, F.G, (int)blockIdx.x);
            LAS float* ftab = (LAS float*)(F.lds + RING_BYTES);
            { pg8::Unit u0; if (S.next(0, u0)) { const int row = F.tid >> 1; const float* sq = ssq + (size_t)(u0.pm * 256 + row) * 16;
                const f32x4 a0 = *(const f32x4*)sq, a1 = *(const f32x4*)(sq + 4), a2 = *(const f32x4*)(sq + 8), a3 = *(const f32x4*)(sq + 12);
                const float s0 = ((a0[0] + a0[1]) + (a0[2] + a0[3])) + ((a1[0] + a1[1]) + (a1[2] + a1[3])), s1 = ((a2[0] + a2[1]) + (a2[2] + a2[3])) + ((a3[0] + a3[1]) + (a3[2] + a3[3]));
                const float r0 = 1.0f / sqrtf(s0 * (1.0f / 512.0f) + EPS), r1 = 1.0f / sqrtf(s1 * (1.0f / 512.0f) + EPS);
                ftab[F.tid] = (F.tid & 1) ? r1 : r0 / r1; } }
            LDS_WAIT(); __syncthreads();
            pg8::EpiRes E{xb, nullptr, (float*)(ws + WS_RS) + (size_t)(2 * l + 1) * M};
            pg8::gemm_phase<pg8::EpiRes, 1>(F.lds + RING_OFF, g, S, E, F.tid, (const LAS float*)ftab);
        } break;
        case 6: break;
        case 7: {
            pg8::Gemm g{xb, bufa, M, ULD, DM, DM}; pg8::StaticOrder S; S.init(M, ULD, F.G, (int)blockIdx.x);
            pg8::EpiFfn E{proj, (const float*)(ws + WS_RS) + (size_t)(2 * l + 1) * M, ap->in[19] + (size_t)l * 3 * FFN, ap->in[20] + l * FFN, (bf16*)(ws + WS_SIDEA), (bf16*)(ws + WS_SIDEB)};
            pg8::gemm_phase<pg8::EpiFfn>(F.lds + RING_OFF, g, S, E, F.tid);
            {
                const bool half = (F.G == 256); if (!half || blockIdx.x >= 128) { Frame F2 = F; if (half) { F2.vcu = (int)blockIdx.x - 128; F2.G = 128; }
                    conv_plain(F2, ap->in[21] + (size_t)l * FFN * DM, FFN, DM, nullptr, bufb, (LAS float*)(F.lds + F.wave * 16384));
                    if (l + 1 < DEPTH) conv_small(F2, ap->in[2] + (size_t)(l + 1) * DM * P_IN, ap->in[1] + (l + 1) * DM, (bf16*)(ws + WS_WSM) + (size_t)((l + 1) & 1) * 32 * DM); } }
        } break;
        case 8: break;
        case 9: {
            pg8::Gemm g{proj, bufb, M, DM, FFN, FFN}; pg8::StaticOrder S; S.init(M, DM, F.G, (int)blockIdx.x);
            { pg8::Unit u0; for (int i = 0; S.next(i, u0); ++i) ffn_fix(F, proj, (const bf16*)(ws + WS_SIDEA), (const bf16*)(ws + WS_SIDEB), ap->in[19] + (size_t)l * 3 * FFN, ap->in[20] + l * FFN, u0.pm); }
            VM_WAIT(); __syncthreads();
            pg8::EpiRes E{xb, (l + 1 < DEPTH) ? nullptr : out, (float*)(ws + WS_RS) + (size_t)(2 * l + 2) * M};
            pg8::gemm_phase<pg8::EpiRes>(F.lds + RING_OFF, g, S, E, F.tid);
            if (l + 1 < DEPTH) conv_w_in(F, ap->in[2] + (size_t)(l + 1) * DM * P_IN, ap->in[1] + (l + 1) * DM, bufa, (LAS float*)(F.lds + F.wave * 16384));
        } break;
        }
        if (ph + 1 < ph_hi || PROBE_PHASE != -1) { XcdBarrier bar; bar.bar = (unsigned*)(ap->ws + WS_CTL) + CW_BAR; bar.x = xb_xcc_id(); bar.st = (volatile LAS unsigned*)(F.lds + MISC_OFF) + 8; xcd_barrier(bar, wave0 * 64 + fresh_lane()); }
#if PROBE_PHASE != -1
        if (blockIdx.x == 0 && wave0 == 0 && fresh_lane() == 0) { const unsigned long long tnow = __builtin_amdgcn_s_memrealtime();
            __hip_atomic_store((unsigned long long*)(ap->ws + WS_TS) + 1 + ph, tnow, __ATOMIC_RELAXED, __HIP_MEMORY_SCOPE_AGENT);
            if (P == 3 || P == 5 || P == 7 || P == 9) __hip_atomic_store((unsigned long long*)(ap->ws + WS_TS) + 2 + ph, tnow, __ATOMIC_RELAXED, __HIP_MEMORY_SCOPE_AGENT); }
#endif
    }
}

__global__ void __launch_bounds__(NWAVES * 64, 2) fwd(Args args) {
    extern __shared__ __attribute__((aligned(16))) unsigned char lds[];
    Frame F;
    F.lds = (LAS unsigned char*)lds;
    F.tid = threadIdx.x; F.lane = F.tid & 63; F.wave = __builtin_amdgcn_readfirstlane(F.tid >> 6);
    const int wave0 = F.wave;
    for (int u = F.tid; u < (LDS_BYTES - LDSCTL_OFF) / 4; u += NWAVES * 64) ((LAS unsigned*)(F.lds + LDSCTL_OFF))[u] = 0u;
    __syncthreads();
    const int ph_lo = args.ph_lo, ph_hi = args.ph_hi;
#if PROBE_PHASE != -1
    if (blockIdx.x == 0 && F.tid == 0) __hip_atomic_store((unsigned long long*)(args.ws + WS_TS), (unsigned long long)__builtin_amdgcn_s_memrealtime(), __ATOMIC_RELAXED, __HIP_MEMORY_SCOPE_AGENT);
#endif
    if (ph_hi - ph_lo > 1) (void)xcd_barrier_post((unsigned*)(args.ws + WS_CTL) + CW_BAR, (volatile LAS unsigned*)(F.lds + MISC_OFF) + 8);

    run_phase<0, 0>(F, wave0, ph_lo, ph_hi);
    run_phase<0, 1>(F, wave0, ph_lo, ph_hi);
    run_phase<0, 2>(F, wave0, ph_lo, ph_hi);
    run_phase<0, 3>(F, wave0, ph_lo, ph_hi);
    run_phase<0, 4>(F, wave0, ph_lo, ph_hi);
    run_phase<0, 5>(F, wave0, ph_lo, ph_hi);
    run_phase<0, 6>(F, wave0, ph_lo, ph_hi);
    run_phase<0, 7>(F, wave0, ph_lo, ph_hi);
    run_phase<0, 8>(F, wave0, ph_lo, ph_hi);
    run_phase<0, 9>(F, wave0, ph_lo, ph_hi);
    run_phase<1, 0>(F, wave0, ph_lo, ph_hi);
    run_phase<1, 1>(F, wave0, ph_lo, ph_hi);
    run_phase<1, 2>(F, wave0, ph_lo, ph_hi);
    run_phase<1, 3>(F, wave0, ph_lo, ph_hi);
    run_phase<1, 4>(F, wave0, ph_lo, ph_hi);
    run_phase<1, 5>(F, wave0, ph_lo, ph_hi);
    run_phase<1, 6>(F, wave0, ph_lo, ph_hi);
    run_phase<1, 7>(F, wave0, ph_lo, ph_hi);
    run_phase<1, 8>(F, wave0, ph_lo, ph_hi);
    run_phase<1, 9>(F, wave0, ph_lo, ph_hi);
#if PROBE_PHASE != -1
    {
        const __attribute__((address_space(4))) Args* ap = (const __attribute__((address_space(4))) Args*)__builtin_amdgcn_kernarg_segment_ptr();
        const unsigned long long* ts = (const unsigned long long*)(ap->ws + WS_TS);
        float us = 500.f;
#ifdef PROBE_UNIT
        if (true) { us = 0.01f * (float)__hip_atomic_load(ts + PROBE_UNIT, __ATOMIC_RELAXED, __HIP_MEMORY_SCOPE_AGENT); } else
#endif
        if (PROBE_PHASE >= 0) { us = 0.f;
            for (int l = 0; l < DEPTH; ++l) { const int ph = l * PH_PER_LAYER + PROBE_PHASE; if (ph < N_PHASES - 1) us += 0.01f * (float)(__hip_atomic_load(ts + 1 + ph, __ATOMIC_RELAXED, __HIP_MEMORY_SCOPE_AGENT) - __hip_atomic_load(ts + ph, __ATOMIC_RELAXED, __HIP_MEMORY_SCOPE_AGENT)); } }
        const float dl = sqrtf(PROBE_GAIN * us);
        float* o = ap->out;
        for (size_t i = (size_t)blockIdx.x * 512 + wave0 * 64 + fresh_lane(); i < (size_t)M * DM; i += (size_t)gridDim.x * 512) o[i] += (i & 1) ? dl : -dl;
    }
#endif
}

extern "C" void kernel_launch(void* const* d_in, const int* in_sizes, int n_in, void* d_out, int out_size, void* d_ws, size_t ws_size, hipStream_t stream) {
    static int grid = 0;
    if (grid == 0) {
        if (n_in != 22 || in_sizes[0] != M * DM || out_size != M * DM || ws_size < WS_END) { fprintf(stderr, "kernel_launch: unexpected shapes (n_in %d, in0 %d, out %d, ws %zu); nothing launched\n", n_in, n_in > 0 ? in_sizes[0] : -1, out_size, ws_size); grid = -1; return; }
        int dev = 0, cus = 0, per_cu = 0;
        if (hipGetDevice(&dev) != hipSuccess || hipDeviceGetAttribute(&cus, hipDeviceAttributeMultiprocessorCount, dev) != hipSuccess) { grid = -1; return; }
        if (hipFuncSetAttribute((const void*)fwd, hipFuncAttributeMaxDynamicSharedMemorySize, LDS_BYTES) != hipSuccess) { fprintf(stderr, "kernel_launch: hipFuncSetAttribute failed\n"); grid = -1; return; }
        if (hipOccupancyMaxActiveBlocksPerMultiprocessor(&per_cu, (const void*)fwd, NWAVES * 64, LDS_BYTES) != hipSuccess || per_cu < 1) { fprintf(stderr, "kernel_launch: occupancy query reports %d blocks per CU\n", per_cu); per_cu = 1; }
        (void)hipGetLastError();
        grid = cus;
    }
    if (grid < 0) return;
    (void)hipMemsetAsync((char*)d_ws + WS_CTL, 0, CTL_ZERO_BYTES, stream);
    Args a{};
    for (int i = 0; i < 22; ++i) a.in[i] = (const float*)d_in[i];
    a.out = (float*)d_out; a.ws = (unsigned char*)d_ws;
#if MK_MULTI
    for (int ph = 0; ph < N_PHASES; ++ph) {
        a.ph_lo = ph; a.ph_hi = ph + 1;
        hipLaunchKernelGGL(fwd, dim3(grid), dim3(NWAVES * 64), LDS_BYTES, stream, a);
    }
#else
    a.ph_lo = 0; a.ph_hi = N_PHASES;
    hipLaunchKernelGGL(fwd, dim3(grid), dim3(NWAVES * 64), LDS_BYTES, stream, a);
#endif
}
```

```cpp
#include <hip/hip_runtime.h>
#include <hip/hip_bf16.h>
#include <cstdio>
#include <cstdint>
#include <cmath>

#ifndef PROBE_PHASE
#define PROBE_PHASE -1
#endif
#ifndef PROBE_GAIN
#define PROBE_GAIN 1e-6f
#endif
#ifndef MK_MULTI
#define MK_MULTI 0
#endif

constexpr int BATCH = 8, SEQ = 2048, DM = 1024, DEPTH = 2;
constexpr int M = BATCH * SEQ;
constexpr int P_IN = 6168;
constexpr int PLD = 6144;
constexpr int PC_Q = 0, PC_Z = 512, PC_MO = 1536, PC_K = 2048, PC_V = 2560, PC_XBC = 3072, PC_MQK = 4608, PC_MV = 5632;
constexpr int SC_Q = 0, SC_K = 512, SC_V = 1024, SC_Z = 1536, SC_XBC = 2560, SC_DT = 4096, SC_MQK = 4112, SC_MV = 5136, SC_MO = 5648, SC_MI = 6160, SC_MF = 6164;
constexpr int FFN = 2816, ULD = 5632;
constexpr int DMIX = 2048;
constexpr float EPS = 1e-6f;
constexpr float C2 = 0.125f * 1.4426950408889634f;

constexpr size_t MiB = 1u << 20;
constexpr size_t WS_CTL = 0, CTL_ZERO_BYTES = 1 * MiB;
constexpr size_t WS_KSUM = 256 * 1024;
constexpr size_t WS_TS = 800 * 1024;
constexpr size_t WS_RS = 512 * 1024;
constexpr size_t WS_QUEUE = 768 * 1024;
constexpr size_t WS_SMALLP = 1 * MiB;
constexpr size_t WS_SSQ = 3 * MiB - 512 * 1024;
constexpr size_t WS_WSM = 3 * MiB + 512 * 1024;
constexpr size_t WS_BUFA = 4 * MiB;
constexpr size_t WS_BUFB = 16 * MiB;
constexpr size_t WS_XB = 22 * MiB;
constexpr size_t WS_HALO = 54 * MiB;
constexpr size_t WS_GSC = 58 * MiB;
constexpr size_t WS_SIDEA = 54 * MiB;
constexpr size_t WS_SIDEB = 57 * MiB;
static_assert(true, "EpiProj hard-codes WS_PROJ = 64 MiB, WS_HALO = 54 MiB, WS_KSUM = 256 KiB, WS_RS = 512 KiB");
constexpr size_t WS_PROJ = 64 * MiB;
constexpr size_t WS_END = 256 * MiB;

namespace pg8 {
#define PG8_LAS __attribute__((address_space(3)))
typedef unsigned short bf16_t;
typedef short bf16x8 __attribute__((ext_vector_type(8)));
typedef float f32x4 __attribute__((ext_vector_type(4)));
typedef unsigned u32x4 __attribute__((ext_vector_type(4)));
constexpr int BM = 256, BK = 64, HALF = 128, HTB = HALF * BK * 2, STAGE_BYTES = 8 * HTB, NXCD = 8, WGM = 8;

__host__ __device__ __forceinline__ int lds_byte(int r, int c) { const int st = (r >> 4) * 2 + (c >> 5), rr = r & 15, cc = c & 31, ob = rr * 64 + cc * 2; return st * 1024 + (ob ^ (((ob >> 9) & 1) << 5)); }
__host__ __device__ __forceinline__ void stage_rc(int b, int& R, int& C) { const int st = b / 1024, sb = b % 1024, swz = sb ^ (((sb >> 9) & 1) << 5); R = (st >> 1) * 16 + swz / 64; C = (st & 1) * 32 + (swz % 64) / 2; }
__host__ __device__ __forceinline__ int perm32(int rho) { const int n = rho >> 4, i = rho & 15; return 8 * (i >> 2) + 4 * n + (i & 3); }

struct Unit { int pm, pn; };
struct Gemm { const bf16_t* A; const bf16_t* Bt; int M, N, K, lda; };

struct StaticOrder {
    int nM, nN, nwg, G, c, pnmap;
    __host__ __device__ void init(int M_, int N_, int G_, int c_, int pnmap_ = 0) { nM = M_ / BM; nN = N_ / BM; nwg = nM * nN; G = G_; c = c_; pnmap = pnmap_; }
    __host__ __device__ bool next(int i, Unit& u) const {
        const long L = (long)i * G + c; if (L >= nwg) return false;
        int wgid = (int)L; { const int q = nwg / NXCD, r = nwg % NXCD, xcd = wgid % NXCD, off = wgid / NXCD; wgid = (xcd < r ? xcd * (q + 1) : r * (q + 1) + (xcd - r) * q) + off; }
        const int nig = WGM * nN, gid = wgid / nig, fm = gid * WGM, gsz = (nM - fm) < WGM ? (nM - fm) : WGM;
        u.pm = fm + ((wgid % nig) % gsz); u.pn = (wgid % nig) / gsz;
        if (pnmap) { const unsigned long long t = (u.pn < 12) ? 0x4022eace0da49ecull : 0xb2ae439963484a2ull; u.pn = (int)((t >> (5 * (u.pn < 12 ? u.pn : u.pn - 12))) & 31ull); }
        return true;
    }
};

typedef float f32x2p __attribute__((ext_vector_type(2))); typedef __bf16 bf16x2p __attribute__((ext_vector_type(2)));
__device__ __forceinline__ unsigned cvt_pk_bf16(float lo, float hi) { const f32x2p v = {lo, hi}; return __builtin_bit_cast(unsigned, __builtin_convertvector(v, bf16x2p)); }

struct EpiBf16 {
    static constexpr bool PERM = true; static constexpr bool ROWPERM = false;
    bf16_t* O; int ldc;
    __device__ __forceinline__ void operator()(const f32x4 (&acc)[2][2][4][2], const Unit& u, int wr, int wc, int fr, int fq) const {
        const int row0 = u.pm * BM + wr * 64 + fr; const int col0 = u.pn * BM + wc * 32 + 8 * fq;
#pragma unroll
        for (int ai = 0; ai < 2; ++ai)
#pragma unroll
            for (int m = 0; m < 4; ++m) { bf16_t* rowp = O + (size_t)(row0 + ai * HALF + m * 16) * ldc + col0;
#pragma unroll
                for (int bj = 0; bj < 2; ++bj) { const f32x4 v0 = acc[ai][bj][m][0], v1 = acc[ai][bj][m][1];
                    u32x4 w; w.x = cvt_pk_bf16(v0[0], v0[1]); w.y = cvt_pk_bf16(v0[2], v0[3]); w.z = cvt_pk_bf16(v1[0], v1[1]); w.w = cvt_pk_bf16(v1[2], v1[3]);
                    *(u32x4*)(rowp + bj * HALF) = w; } }
    }
};
__device__ __forceinline__ float row_prev(float prevblk, float cur, int n  ) {
    const int pb = __float_as_int(prevblk), cu = __float_as_int(cur);
    const int o = (n == 1) ? __builtin_amdgcn_update_dpp(0, pb, 0x121, 0xf, 0xf, false) : (n == 2) ? __builtin_amdgcn_update_dpp(0, pb, 0x122, 0xf, 0xf, false) : __builtin_amdgcn_update_dpp(0, pb, 0x123, 0xf, 0xf, false);
    return __int_as_float((n == 1) ? __builtin_amdgcn_update_dpp(o, cu, 0x111, 0xf, 0xf, false) : (n == 2) ? __builtin_amdgcn_update_dpp(o, cu, 0x112, 0xf, 0xf, false) : __builtin_amdgcn_update_dpp(o, cu, 0x113, 0xf, 0xf, false));
}
struct EpiProj {
    static constexpr bool PERM = true; static constexpr bool ROWPERM = true;
    unsigned char* ws; const float* const __attribute__((address_space(4)))* in; int l;
    __device__ __forceinline__ void operator()(const f32x4 (&acc)[2][2][4][2], const Unit& u, int wr, int wc, int fr, int fq) const {
        bf16_t* P = (bf16_t*)(ws + (size_t)64 * 1048576); bf16_t* halo = (bf16_t*)(ws + (size_t)54 * 1048576);
        const float* rs = (const float*)(ws + 524288) + (size_t)(2 * l) * 16384;
        const float* qw = in[3] + l * 64; const float* kw = in[4] + l * 64;
        const float* scw = in[5] + (size_t)l * 4 * 1536; const float* scb = in[6] + l * 1536; const float* mcw = in[11] + (size_t)l * 4 * 1024; const float* mcb = in[12] + l * 1024;
        const int pn = u.pn; const bool isq = pn < 2, isk = (pn == 8 || pn == 9);
        const int row0 = u.pm * BM + wr * 64 + 4 * fr;
        float rr[2][4];
#pragma unroll
        for (int ai = 0; ai < 2; ++ai) { const f32x4 t = *(const f32x4*)(rs + row0 + ai * HALF);
#pragma unroll
            for (int m = 0; m < 4; ++m) rr[ai][m] = 1.0f / sqrtf(t[m] * (1.0f / 1024.0f) + EPS); }
        if (pn >= 12 && pn < 22) {
            const int col0 = pn * BM + wc * 32 + 8 * fq;
            const bool ssm = pn < 18; const float post = (pn >= 20) ? 0.08838834764831845f : 1.0f; const int wst = ssm ? 1536 : 1024;
#pragma unroll
            for (int bj = 0; bj < 2; ++bj) {
                const int hch = col0 + bj * HALF - PC_XBC; const float* wp = ssm ? (scw + hch) : (mcw + (hch - 1536)); const float* bp = ssm ? (scb + hch) : (mcb + (hch - 1536));
                f32x4 cwv[4][2], cbv[2];
#pragma unroll
                for (int j = 0; j < 4; ++j) { cwv[j][0] = *(const f32x4*)(wp + j * wst); cwv[j][1] = *(const f32x4*)(wp + j * wst + 4); }
                cbv[0] = *(const f32x4*)bp; cbv[1] = *(const f32x4*)(bp + 4);
#pragma unroll
                for (int ai = 0; ai < 2; ++ai) {
                    u32x4 cv[4], raw[4];
#pragma unroll
                    for (int n = 0; n < 2; ++n)
#pragma unroll
                        for (int i2 = 0; i2 < 2; ++i2) { float y[4][2], g[4][2];
#pragma unroll
                            for (int e = 0; e < 2; ++e) { const int i = 2 * i2 + e;
#pragma unroll
                                for (int m = 0; m < 4; ++m) g[m][e] = acc[ai][bj][m][n][i] * rr[ai][m];
                                const float p1 = __int_as_float(__builtin_amdgcn_update_dpp(0, __float_as_int(g[3][e]), 0x111, 0xf, 0xf, true)), p2 = __int_as_float(__builtin_amdgcn_update_dpp(0, __float_as_int(g[2][e]), 0x111, 0xf, 0xf, true)),
                                            p3 = __int_as_float(__builtin_amdgcn_update_dpp(0, __float_as_int(g[1][e]), 0x111, 0xf, 0xf, true));
                                const float c0_ = cwv[0][n][i], c1_ = cwv[1][n][i], c2_ = cwv[2][n][i], c3_ = cwv[3][n][i], cb_ = cbv[n][i];
                                y[0][e] = cb_ + c0_ * p3 + c1_ * p2 + c2_ * p1 + c3_ * g[0][e];
                                y[1][e] = cb_ + c0_ * p2 + c1_ * p1 + c2_ * g[0][e] + c3_ * g[1][e];
                                y[2][e] = cb_ + c0_ * p1 + c1_ * g[0][e] + c2_ * g[1][e] + c3_ * g[2][e];
                                y[3][e] = cb_ + c0_ * g[0][e] + c1_ * g[1][e] + c2_ * g[2][e] + c3_ * g[3][e];
#pragma unroll
                                for (int m = 0; m < 4; ++m) y[m][e] = y[m][e] * __builtin_amdgcn_rcpf(1.0f + __builtin_amdgcn_exp2f(-1.4426950408889634f * y[m][e])) * post; }
#pragma unroll
                            for (int m = 0; m < 4; ++m) { cv[m][2 * n + i2] = cvt_pk_bf16(y[m][0], y[m][1]); raw[m][2 * n + i2] = cvt_pk_bf16(g[m][0], g[m][1]); } }
#pragma unroll
                    for (int m = 0; m < 4; ++m) { const int row = row0 + ai * HALF + m;
                        *(u32x4*)(P + (size_t)row * PLD + col0 + bj * HALF) = (m < 3 && fr == 0) ? raw[m] : cv[m];
                        if (m >= 1 && fr == 15) *(u32x4*)(halo + ((size_t)((row >> 6) * 3 + m - 1) * 2560 + hch)) = raw[m]; }
                }
            }
        } else if (!(isq || isk)) {
            const int col0 = pn * BM + wc * 32 + 8 * fq; const bool sig = (pn == PC_MO / BM || pn == PC_MO / BM + 1);
#pragma unroll
            for (int ai = 0; ai < 2; ++ai)
#pragma unroll
                for (int m = 0; m < 4; ++m) { bf16_t* rowp = P + (size_t)(row0 + ai * HALF + m) * PLD + col0;
#pragma unroll
                    for (int bj = 0; bj < 2; ++bj) { f32x4 v0 = acc[ai][bj][m][0] * rr[ai][m], v1 = acc[ai][bj][m][1] * rr[ai][m];
                        if (sig) {
#pragma unroll
                            for (int i = 0; i < 4; ++i) { v0[i] = __builtin_amdgcn_rcpf(1.0f + __builtin_amdgcn_exp2f(-1.4426950408889634f * v0[i])); v1[i] = __builtin_amdgcn_rcpf(1.0f + __builtin_amdgcn_exp2f(-1.4426950408889634f * v1[i])); } }
                        u32x4 w; w.x = cvt_pk_bf16(v0[0], v0[1]); w.y = cvt_pk_bf16(v0[2], v0[3]); w.z = cvt_pk_bf16(v1[0], v1[1]); w.w = cvt_pk_bf16(v1[2], v1[3]);
                        *(u32x4*)(rowp + bj * HALF) = w;
                    } }
        } else {
            const float* w = isq ? qw : kw; const float post = isq ? C2 : 1.0f;
            const int colb = pn * BM + 64 * wc + 8 * fq;
#pragma unroll
            for (int ai = 0; ai < 2; ++ai)
#pragma unroll
                for (int m = 0; m < 4; ++m) {
                    float ss = 0.f;
#pragma unroll
                    for (int bj = 0; bj < 2; ++bj)
#pragma unroll
                        for (int n = 0; n < 2; ++n) { const f32x4 x = acc[ai][bj][m][n] * rr[ai][m]; ss += (x[0] * x[0] + x[1] * x[1]) + (x[2] * x[2] + x[3] * x[3]); }
                    ss += __shfl_xor(ss, 16); ss += __shfl_xor(ss, 32);
                    const float r = (1.0f / sqrtf(ss * (1.0f / 64.0f) + EPS)) * post * rr[ai][m];
                    bf16_t* rowp = P + (size_t)(row0 + ai * HALF + m) * PLD + colb;
#pragma unroll
                    for (int bj = 0; bj < 2; ++bj) { const f32x4 w0 = *(const f32x4*)(w + 32 * bj + 8 * fq), w1 = *(const f32x4*)(w + 32 * bj + 8 * fq + 4);
                        const f32x4 v0 = acc[ai][bj][m][0] * r * w0, v1 = acc[ai][bj][m][1] * r * w1;
                        u32x4 o; o.x = cvt_pk_bf16(v0[0], v0[1]); o.y = cvt_pk_bf16(v0[2], v0[3]); o.z = cvt_pk_bf16(v1[0], v1[1]); o.w = cvt_pk_bf16(v1[2], v1[3]);
                        *(u32x4*)(rowp + 32 * bj) = o; }
                    asm volatile("" ::: "memory");
                }
        }
    }
};
struct EpiRes {
    static constexpr bool PERM = true; static constexpr bool ROWPERM = false;
    bf16_t* xb; float* out; float* rs;
    __device__ __forceinline__ void operator()(const f32x4 (&acc)[2][2][4][2], const Unit& u, int wr, int wc, int fr, int fq) const {
        const int row0 = u.pm * BM + wr * 64 + fr, col0 = u.pn * BM + wc * 32 + 8 * fq;
#pragma unroll
        for (int ai = 0; ai < 2; ++ai)
#pragma unroll
            for (int m = 0; m < 4; ++m) { const int row = row0 + ai * HALF + m * 16; const size_t off = (size_t)row * 1024 + col0; float ss = 0.f;
#pragma unroll
                for (int bj = 0; bj < 2; ++bj) { const u32x4 bw = *(const u32x4*)(xb + off + bj * HALF);
                    f32x4 v0 = acc[ai][bj][m][0], v1 = acc[ai][bj][m][1];
                    v0[0] += __uint_as_float(bw.x << 16); v0[1] += __uint_as_float(bw.x & 0xffff0000u); v0[2] += __uint_as_float(bw.y << 16); v0[3] += __uint_as_float(bw.y & 0xffff0000u);
                    v1[0] += __uint_as_float(bw.z << 16); v1[1] += __uint_as_float(bw.z & 0xffff0000u); v1[2] += __uint_as_float(bw.w << 16); v1[3] += __uint_as_float(bw.w & 0xffff0000u);
                    if (out) { *(f32x4*)(out + off + bj * HALF) = v0; *(f32x4*)(out + off + bj * HALF + 4) = v1; }
                    else { ss += ((v0[0] * v0[0] + v0[1] * v0[1]) + (v0[2] * v0[2] + v0[3] * v0[3])) + ((v1[0] * v1[0] + v1[1] * v1[1]) + (v1[2] * v1[2] + v1[3] * v1[3]));
                        u32x4 w; w.x = cvt_pk_bf16(v0[0], v0[1]); w.y = cvt_pk_bf16(v0[2], v0[3]); w.z = cvt_pk_bf16(v1[0], v1[1]); w.w = cvt_pk_bf16(v1[2], v1[3]);
                        *(u32x4*)(xb + off + bj * HALF) = w; } }
                if (!out) { ss += __shfl_xor(ss, 16); ss += __shfl_xor(ss, 32); if (fq == 0) atomicAdd(rs + row, ss); }
                asm volatile("" ::: "memory"); }
    }
};
struct EpiScaleBf16 {
    static constexpr bool PERM = true; static constexpr bool ROWPERM = false;
    bf16_t* O; int ldc; const float* rs;
    __device__ __forceinline__ void operator()(const f32x4 (&acc)[2][2][4][2], const Unit& u, int wr, int wc, int fr, int fq) const {
        const int row0 = u.pm * BM + wr * 64 + fr; const int col0 = u.pn * BM + wc * 32 + 8 * fq;
        float rr[2][4];
#pragma unroll
        for (int ai = 0; ai < 2; ++ai)
#pragma unroll
            for (int m = 0; m < 4; ++m) rr[ai][m] = rs[row0 + ai * HALF + m * 16];
#pragma unroll
        for (int ai = 0; ai < 2; ++ai)
#pragma unroll
            for (int m = 0; m < 4; ++m) { bf16_t* rowp = O + (size_t)(row0 + ai * HALF + m * 16) * ldc + col0; const float r = 1.0f / sqrtf(rr[ai][m] * (1.0f / 1024.0f) + EPS);
#pragma unroll
                for (int bj = 0; bj < 2; ++bj) { const f32x4 v0 = acc[ai][bj][m][0] * r, v1 = acc[ai][bj][m][1] * r;
                    u32x4 w; w.x = cvt_pk_bf16(v0[0], v0[1]); w.y = cvt_pk_bf16(v0[2], v0[3]); w.z = cvt_pk_bf16(v1[0], v1[1]); w.w = cvt_pk_bf16(v1[2], v1[3]);
                    *(u32x4*)(rowp + bj * HALF) = w; } }
    }
};

typedef float f32x2q __attribute__((ext_vector_type(2)));
__device__ __forceinline__ f32x2q gelu_pk2(f32x2q v) {
    const f32x2q av = __builtin_elementwise_abs(v), d = av * 0.2316418882f + 1.0f;
    f32x2q t; t.x = __builtin_amdgcn_rcpf(d.x); t.y = __builtin_amdgcn_rcpf(d.y);
    f32x2q q = t * 0.5307027145f + (-0.7265760135f); q = q * t + 0.7107068705f; q = q * t + (-0.142248368f); q = q * t + 0.127414796f; q = q * t;
    const f32x2q s = (v * v) * (-0.72134752044f);
    f32x2q e; e.x = __builtin_amdgcn_exp2f(s.x); e.y = __builtin_amdgcn_exp2f(s.y);
    const f32x2q m = v * (q * e), r = v - m;
    f32x2q o; o.x = v.x < 0.f ? m.x : r.x; o.y = v.y < 0.f ? m.y : r.y; return o;
}
struct EpiFfn {
    static constexpr bool PERM = true; static constexpr bool ROWPERM = true;
    bf16_t* H; const float* rs; const float* cw  ; const float* cb; bf16_t* sideA  ; bf16_t* sideB  ;
    __device__ __forceinline__ void operator()(const f32x4 (&acc)[2][2][4][2], const Unit& u, int wr, int wc, int fr, int fq) const {
        constexpr int FF = 2816;
        const int row0 = u.pm * BM + wr * 64 + 4 * fr, c0 = u.pn * 128 + wc * 32 + 8 * fq;
        float rr[2][4];
#pragma unroll
        for (int ai = 0; ai < 2; ++ai) { const f32x4 t = *(const f32x4*)(rs + row0 + ai * HALF);
#pragma unroll
            for (int m = 0; m < 4; ++m) rr[ai][m] = 1.0f / sqrtf(t[m] * (1.0f / 1024.0f) + EPS); }
        f32x4 w0[2], w1[2], w2[2], bb[2];
#pragma unroll
        for (int n = 0; n < 2; ++n) { w0[n] = *(const f32x4*)(cw + c0 + 4 * n); w1[n] = *(const f32x4*)(cw + FF + c0 + 4 * n); w2[n] = *(const f32x4*)(cw + 2 * FF + c0 + 4 * n); bb[n] = *(const f32x4*)(cb + c0 + 4 * n); }
#pragma unroll
        for (int ai = 0; ai < 2; ++ai) {
            u32x4 hw[4], gw[4], vw[2];
#pragma unroll
            for (int n = 0; n < 2; ++n)
#pragma unroll
                for (int i2 = 0; i2 < 2; ++i2) { f32x2q x[4]; float g[4][2], v[4][2];
#pragma unroll
                    for (int e = 0; e < 2; ++e) { const int i = 2 * i2 + e;
#pragma unroll
                        for (int m = 0; m < 4; ++m) { g[m][e] = acc[ai][0][m][n][i] * rr[ai][m]; v[m][e] = acc[ai][1][m][n][i] * rr[ai][m]; }
                        const float p1 = __int_as_float(__builtin_amdgcn_update_dpp(0, __float_as_int(g[3][e]), 0x111, 0xf, 0xf, true)), p2 = __int_as_float(__builtin_amdgcn_update_dpp(0, __float_as_int(g[2][e]), 0x111, 0xf, 0xf, true));
                        const float a0 = w0[n][i], a1 = w1[n][i], a2 = w2[n][i], b_ = bb[n][i];
                        x[0][e] = b_ + a0 * p2 + a1 * p1 + a2 * g[0][e];
                        x[1][e] = b_ + a0 * p1 + a1 * g[0][e] + a2 * g[1][e];
                        x[2][e] = b_ + a0 * g[0][e] + a1 * g[1][e] + a2 * g[2][e];
                        x[3][e] = b_ + a0 * g[1][e] + a1 * g[2][e] + a2 * g[3][e]; }
#pragma unroll
                    for (int m = 0; m < 4; ++m) { const f32x2q ge = gelu_pk2(x[m]);
                        hw[m][2 * n + i2] = cvt_pk_bf16(ge.x * v[m][0], ge.y * v[m][1]); gw[m][2 * n + i2] = cvt_pk_bf16(g[m][0], g[m][1]);
                        if (m < 2) vw[m][2 * n + i2] = cvt_pk_bf16(v[m][0], v[m][1]); } }
#pragma unroll
            for (int m = 0; m < 4; ++m) { const int row = row0 + ai * HALF + m;
                *(u32x4*)(H + (size_t)row * FF + c0) = hw[m];
                if (m >= 2 && fr == 15) *(u32x4*)(sideA + ((size_t)(row >> 6) * 2 + (m - 2)) * FF + c0) = gw[m];
                if (m < 2 && fr == 0) { bf16_t* sb = sideB + ((size_t)(row >> 6) * 2 + m) * 2 * FF + c0; *(u32x4*)sb = gw[m]; *(u32x4*)(sb + FF) = vw[m]; } }
        }
    }
};

#define PG8_KT(i) (KMODE ? ((i) < 16 ? (i) + 8 : ((i) < 24 ? (i) - 16 : (i))) : (i))
template <class Epi, int KMODE = 0>
__device__ __forceinline__ void gemm_phase(PG8_LAS unsigned char* lds, const Gemm g, const StaticOrder& S, const Epi& E, int tid_, const PG8_LAS float* ftab = nullptr) {
    asm volatile("" : "+v"(tid_));
    const int tid = tid_, wid = __builtin_amdgcn_readfirstlane(tid >> 6), lane = tid & 63, wr = wid >> 2, wc = wid & 3, fr = lane & 15, fq = lane >> 4;
    const int K = g.K, nt = K / BK, lda = g.lda;
    unsigned voffA[2], voffB[2];
#pragma unroll
    for (int i = 0; i < 2; ++i) { int R, C; stage_rc(tid * 16 + i * 8192, R, C); const int Rb = Epi::PERM ? ((R & ~31) + perm32(R & 31)) : R;
        const int Ra = Epi::ROWPERM ? ((R & ~63) + 4 * (R & 15) + ((R >> 4) & 3)) : R;
        voffA[i] = (unsigned)(Ra * lda + C) * 2u; voffB[i] = (unsigned)(Rb * K + C) * 2u; }
    const size_t kstep = (size_t)(BK * 2);
    const size_t hstepA = (size_t)HALF * lda * 2, hstepB = (size_t)HALF * K * 2;
    const size_t tstepA = 2 * hstepA, tstepB = 2 * hstepB;
    const unsigned ldsw = (unsigned)wid * 1024u;
    const int aoff = lds_byte(wr * 64 + fr, fq * 8), boff = lds_byte(wc * 32 + fr, fq * 8);
#define PG8_SA(b, h) (((b) * 2 + (h)) * HTB)
#define PG8_SB(b, h) ((4 + (b) * 2 + (h)) * HTB)
#define PG8_STAGE(bufoff, gbase, voff) do { _Pragma("unroll") for (int _i = 0; _i < 2; ++_i) \
        __builtin_amdgcn_global_load_lds((const unsigned*)((const char*)(gbase) + (voff)[_i]), (PG8_LAS unsigned*)(lds + (bufoff) + ldsw + _i * 8192), 16, 0, 0); } while (0)
#define PG8_LDA(dst, b, h) do { _Pragma("unroll") for (int m = 0; m < 4; ++m) _Pragma("unroll") for (int k = 0; k < 2; ++k) dst[m][k] = *(const PG8_LAS bf16x8*)(lds + PG8_SA(b, h) + aoff + m * 2048 + k * 1024); } while (0)
#define PG8_LDB(dst, b, h) do { _Pragma("unroll") for (int n = 0; n < 2; ++n) _Pragma("unroll") for (int k = 0; k < 2; ++k) dst[n][k] = *(const PG8_LAS bf16x8*)(lds + PG8_SB(b, h) + boff + n * 2048 + k * 1024); } while (0)
#define PG8_MMA(ai, bj, At, Bt) do { __builtin_amdgcn_s_setprio(1); _Pragma("unroll") for (int m = 0; m < 4; ++m) _Pragma("unroll") for (int n = 0; n < 2; ++n) _Pragma("unroll") for (int k = 0; k < 2; ++k) \
        acc[ai][bj][m][n] = __builtin_amdgcn_mfma_f32_16x16x32_bf16(Bt[n][k], At[m][k], acc[ai][bj][m][n], 0, 0, 0); __builtin_amdgcn_s_setprio(0); } while (0)
#define PG8_WAIT_V(n) asm volatile("s_waitcnt vmcnt(" #n ")" ::: "memory")
#define PG8_WAIT_L(n) asm volatile("s_waitcnt lgkmcnt(" #n ")" ::: "memory")
#define PG8_BAR __builtin_amdgcn_s_barrier()
#define PG8_SCHED __builtin_amdgcn_sched_barrier(0)
    Unit cur, nxt; int ui = 0;
    if (!S.next(0, cur)) return;
    f32x4 acc[2][2][4][2];
#pragma unroll
    for (int a = 0; a < 2; ++a)
#pragma unroll
        for (int b = 0; b < 2; ++b)
#pragma unroll
            for (int m = 0; m < 4; ++m)
#pragma unroll
                for (int n = 0; n < 2; ++n) acc[a][b][m][n] = (f32x4){0.f, 0.f, 0.f, 0.f};
    bf16x8 At[4][2], B0[2][2], B1[2][2];
    const char* cA = (const char*)g.A + (size_t)cur.pm * tstepA; const char* cB = (const char*)g.Bt + (size_t)cur.pn * tstepB;
    { const char* cA0 = cA + (size_t)PG8_KT(0) * kstep; const char* cB0 = cB + (size_t)PG8_KT(0) * kstep;
    PG8_STAGE(PG8_SB(0, 0), cB0, voffB); PG8_STAGE(PG8_SB(0, 1), cB0 + hstepB, voffB); PG8_STAGE(PG8_SA(0, 0), cA0, voffA); PG8_STAGE(PG8_SA(0, 1), cA0 + hstepA, voffA);
    if (wr == 1) PG8_BAR;
    PG8_WAIT_V(2); PG8_BAR;
    PG8_STAGE(PG8_SB(1, 0), cB0 + kstep, voffB); PG8_STAGE(PG8_SA(1, 0), cA0 + kstep, voffA); PG8_STAGE(PG8_SB(1, 1), cB0 + hstepB + kstep, voffB);
    PG8_WAIT_V(6); PG8_BAR; }
    for (;;) {
        const bool has_next = S.next(ui + 1, nxt);
        const char* nA = has_next ? (const char*)g.A + (size_t)nxt.pm * tstepA : cA; const char* nB = has_next ? (const char*)g.Bt + (size_t)nxt.pn * tstepB : cB;
        for (int t = 0; t < nt; t += 2) {
            const bool last = (t == nt - 2);
            const char* a1 = cA + (size_t)PG8_KT(t + 1) * kstep;
            const char* a2 = last ? nA + (size_t)PG8_KT(0) * kstep : cA + (size_t)PG8_KT(t + 2) * kstep; const char* b2 = last ? nB + (size_t)PG8_KT(0) * kstep : cB + (size_t)PG8_KT(t + 2) * kstep;
            const char* a3 = a2 + kstep; const char* b3 = b2 + kstep;
            PG8_LDB(B0, 0, 0); PG8_LDB(B1, 0, 1); PG8_SCHED; PG8_LDA(At, 0, 0); PG8_STAGE(PG8_SA(1, 1), a1 + hstepA, voffA);
            PG8_WAIT_V(8); PG8_WAIT_L(0); PG8_BAR; PG8_MMA(0, 0, At, B0); PG8_MMA(0, 1, At, B1); PG8_BAR; PG8_SCHED;
            PG8_LDA(At, 0, 1); PG8_STAGE(PG8_SB(0, 0), b2, voffB); PG8_STAGE(PG8_SB(0, 1), b2 + hstepB, voffB); PG8_STAGE(PG8_SA(0, 0), a2, voffA);
            PG8_WAIT_V(8); PG8_WAIT_L(0); PG8_BAR; PG8_MMA(1, 0, At, B0); PG8_MMA(1, 1, At, B1); PG8_BAR; PG8_SCHED;
            PG8_LDB(B0, 1, 0); PG8_LDB(B1, 1, 1); PG8_SCHED; PG8_LDA(At, 1, 0); PG8_STAGE(PG8_SA(0, 1), a2 + hstepA, voffA);
            PG8_WAIT_V(8); PG8_WAIT_L(0); PG8_BAR; PG8_MMA(0, 0, At, B0); PG8_MMA(0, 1, At, B1); PG8_BAR; PG8_SCHED;
            PG8_LDA(At, 1, 1); PG8_STAGE(PG8_SB(1, 0), b3, voffB); PG8_STAGE(PG8_SB(1, 1), b3 + hstepB, voffB); PG8_STAGE(PG8_SA(1, 0), a3, voffA);
            PG8_WAIT_V(8); PG8_WAIT_L(0); PG8_BAR; PG8_MMA(1, 0, At, B0); PG8_MMA(1, 1, At, B1); PG8_BAR; PG8_SCHED;
            if (KMODE == 1 && (t == 6 || t == 14)) {
                const int wh = (t == 14) ? 1 : 0;
#pragma unroll
                for (int ai = 0; ai < 2; ++ai)
#pragma unroll
                    for (int m = 0; m < 4; ++m) { const float f = ftab[(ai * HALF + wr * 64 + m * 16 + fr) * 2 + wh];
#pragma unroll
                        for (int bj = 0; bj < 2; ++bj)
#pragma unroll
                            for (int n = 0; n < 2; ++n) acc[ai][bj][m][n] *= f; }
                PG8_SCHED;
            }
        }
        if (wr == 0) PG8_BAR;
        E(acc, cur, wr, wc, fr, fq);
        if (!has_next) break;
#pragma unroll
        for (int a = 0; a < 2; ++a)
#pragma unroll
            for (int b = 0; b < 2; ++b)
#pragma unroll
                for (int m = 0; m < 4; ++m)
#pragma unroll
                    for (int n = 0; n < 2; ++n) acc[a][b][m][n] = (f32x4){0.f, 0.f, 0.f, 0.f};
        cur = nxt; cA = nA; cB = nB; ++ui;
        if (wr == 1) PG8_BAR;
    }
    PG8_WAIT_V(0);
    PG8_BAR;
#undef PG8_SA
#undef PG8_SB
#undef PG8_STAGE
#undef PG8_LDA
#undef PG8_LDB
#undef PG8_MMA
#undef PG8_WAIT_V
#undef PG8_WAIT_L
#undef PG8_BAR
#undef PG8_SCHED
}
}

constexpr int NWAVES = 8;
constexpr int RING_OFF = 0, RING_BYTES = 131072;
constexpr int LDS_BYTES = 147456;
constexpr int LDSCTL_OFF = LDS_BYTES - 512, MISC_OFF = LDSCTL_OFF + 320;
constexpr int CW_BAR = 4096;

#define GAS __attribute__((address_space(1)))
#define LAS __attribute__((address_space(3)))
typedef unsigned short bf16;
typedef unsigned v4u __attribute__((ext_vector_type(4)));
typedef float f32x4 __attribute__((ext_vector_type(4)));
typedef GAS unsigned gu32;
#define RLX_AGENT __ATOMIC_RELAXED, __HIP_MEMORY_SCOPE_AGENT
#define LDS_WAIT() asm volatile("s_waitcnt lgkmcnt(0)" ::: "memory")
#define VM_WAIT() asm volatile("s_waitcnt vmcnt(0)" ::: "memory")
__device__ __forceinline__ unsigned f2bf(float f) { unsigned u = __builtin_bit_cast(unsigned, f); return (u + 0x7fffu + ((u >> 16) & 1u)) >> 16; }
typedef float f32x2_ __attribute__((ext_vector_type(2))); typedef __bf16 bf16x2_ __attribute__((ext_vector_type(2)));
__device__ __forceinline__ unsigned pk2(float lo, float hi) { const f32x2_ v = {lo, hi}; return __builtin_bit_cast(unsigned, __builtin_convertvector(v, bf16x2_)); }
__device__ __forceinline__ float bf2f(unsigned short b) { return __uint_as_float(((unsigned)b) << 16); }

#define XB_TMO      128
#define XB_XCNT(j)  (256  + 64 * (j))
#define XB_XSUB(j)  (1280 + 64 * (j))
#define XB_XGEN(j)  (2304 + 64 * (j))
#define XB_TOP      3328
#define XB_TOPGEN   3392
#define XCD_BAR_WORDS 3456
#define XB_SPIN_CAP (1u << 18)
__device__ __forceinline__ unsigned xb_ld(unsigned* p)              { return __hip_atomic_load(p, __ATOMIC_RELAXED, __HIP_MEMORY_SCOPE_AGENT); }
__device__ __forceinline__ unsigned xb_add(unsigned* p, unsigned v) { return __hip_atomic_fetch_add(p, v, __ATOMIC_RELAXED, __HIP_MEMORY_SCOPE_AGENT); }
__device__ __forceinline__ unsigned xb_xcc_id() { return (unsigned)__builtin_amdgcn_s_getreg((3 << 11) | 20) & 0xFu; }
#define XB_SPIN(cond, bar) do { unsigned _sp = 0; while (cond) { __builtin_amdgcn_s_sleep(1); \
    if ((++_sp & 255u) == 0u) { if (xb_ld(&(bar)[XB_TMO])) break; if (_sp > XB_SPIN_CAP) { atomicAdd(&(bar)[XB_TMO], 1u); break; } } } } while (0)
struct XcdBarrier { unsigned* bar; unsigned x; volatile LAS unsigned* st; };
__device__ __forceinline__ XcdBarrier xcd_barrier_post(unsigned* bar, volatile LAS unsigned* st) {
    XcdBarrier b; b.bar = bar; b.x = xb_xcc_id(); b.st = st;
    if (threadIdx.x == 0) (void)xb_add(&bar[XB_XCNT(b.x)], 1u);
    return b;
}
__device__ __forceinline__ void xcd_barrier_complete(unsigned* bar, unsigned x, unsigned& nloc, unsigned& nx) {
    const unsigned G = gridDim.x * gridDim.y * gridDim.z;
    unsigned sum, cnt, mine, sp = 0u;
    for (;;) {
        sum = 0u; cnt = 0u; mine = 0u;
#pragma unroll
        for (unsigned j = 0; j < 16; ++j) { const unsigned c = xb_ld(&bar[XB_XCNT(j)]); sum += c; cnt += (c > 0u) ? 1u : 0u; mine = (j == x) ? c : mine; }
        if (sum == G) break;
        __builtin_amdgcn_s_sleep(1);
        if ((++sp & 255u) == 0u) { if (xb_ld(&bar[XB_TMO])) break; if (sp > XB_SPIN_CAP) { atomicAdd(&bar[XB_TMO], 1u); break; } }
    }
    nloc = mine > 0u ? mine : 1u; nx = cnt > 0u ? cnt : 1u;
}
__device__ __forceinline__ void xcd_barrier(const XcdBarrier& b, int tid) {
    asm volatile("s_waitcnt vmcnt(0)" ::: "memory");
    __syncthreads();
    if (tid == 0) {
        unsigned* bar = b.bar;
        __builtin_amdgcn_s_waitcnt(0);
        unsigned nloc = b.st[0], nx = b.st[1];
        if (nloc == 0u) { xcd_barrier_complete(bar, b.x, nloc, nx); b.st[0] = nloc; b.st[1] = nx; }
        const unsigned tg = b.st[2];
        const unsigned old = xb_add(&bar[XB_XSUB(b.x)], 1u);
        if (old + 1u == (old / nloc + 1u) * nloc) {
            __builtin_amdgcn_fence(__ATOMIC_RELEASE, "agent");
            asm volatile("s_waitcnt vmcnt(0)" ::: "memory");
            const unsigned og = xb_add(&bar[XB_TOP], 1u);
            if (og + 1u == (og / nx + 1u) * nx) xb_add(&bar[XB_TOPGEN], 1u);
        }
        XB_SPIN(xb_ld(&bar[XB_TOPGEN]) == tg, bar);
        b.st[2] = tg + 1u;
        __builtin_amdgcn_fence(__ATOMIC_ACQUIRE, "agent");
        asm volatile("s_waitcnt vmcnt(0)" ::: "memory");
    }
    __syncthreads();
}

__device__ __forceinline__ int fresh_lane() { int l; asm volatile("v_mbcnt_lo_u32_b32 %0, -1, 0\n\tv_mbcnt_hi_u32_b32 %0, -1, %0" : "=v"(l)); return l; }
struct Args { const float* in[22]; float* out; unsigned char* ws; int ph_lo, ph_hi; };

struct Frame {
    LAS unsigned char* lds;
    int tid, lane, wave;
    int vcu, G;
};

__device__ __forceinline__ float wave_sum(float v) {
#pragma unroll
    for (int o = 1; o < 64; o <<= 1) v += __shfl_xor(v, o);
    return v;
}

__device__ __forceinline__ void conv_item(const float* W, int ldw, int srccol0, bf16* WT, int K, int dstrow0, int k0, LAS float* scr, int lane, const float* kscale  , int kslo = 0, int kshi = 1 << 30) {
    {
        const int lr = lane >> 3, lc = (lane & 7) * 4; f32x4 v[8];
#pragma unroll
        for (int i = 0; i < 8; ++i) { const float* p = W + (size_t)(k0 + 8 * i + lr) * ldw + srccol0 + lc;
            if ((((size_t)p) & 15) == 0) v[i] = *(const f32x4*)p; else { v[i][0] = p[0]; v[i][1] = p[1]; v[i][2] = p[2]; v[i][3] = p[3]; } }
#pragma unroll
        for (int i = 0; i < 8; ++i) { LAS float* d = scr + (8 * i + lr) * 33 + lc; d[0] = v[i][0]; d[1] = v[i][1]; d[2] = v[i][2]; d[3] = v[i][3]; }
    }
    const int c = lane & 7;
    f32x4 ks0 = (f32x4){1.f, 1.f, 1.f, 1.f}, ks1 = ks0;
    if (kscale && k0 >= kslo && k0 < kshi) { ks0 = *(const f32x4*)(kscale + k0 - kslo + 8 * c); ks1 = *(const f32x4*)(kscale + k0 - kslo + 8 * c + 4); }
    LDS_WAIT(); asm volatile("" ::: "memory");
#pragma unroll
    for (int j = 0; j < 4; ++j) { const int n = (lane >> 3) + 8 * j; const LAS float* s = scr + (8 * c) * 33 + n;
        v4u o; o.x = pk2(s[0 * 33] * ks0[0], s[1 * 33] * ks0[1]); o.y = pk2(s[2 * 33] * ks0[2], s[3 * 33] * ks0[3]); o.z = pk2(s[4 * 33] * ks1[0], s[5 * 33] * ks1[1]); o.w = pk2(s[6 * 33] * ks1[2], s[7 * 33] * ks1[3]);
        *(GAS v4u*)(WT + (size_t)(dstrow0 + n) * K + k0 + 8 * c) = o; }
    LDS_WAIT(); asm volatile("" ::: "memory");
}
__device__ __forceinline__ int in_src_col(int n0) {
    const int tile = n0 >> 8, p = n0 & 255; int dest;
    if (tile < 2 || tile == 8 || tile == 9) { const int bj = p >> 7, wc = (p >> 5) & 3; dest = (tile << 8) + 64 * wc + 32 * bj; } else dest = n0;
    if (dest < PC_Z) return SC_Q + dest;
    if (dest < PC_MO) return SC_Z + dest - PC_Z;
    if (dest < PC_K) return SC_MO + dest - PC_MO;
    if (dest < PC_V) return SC_K + dest - PC_K;
    if (dest < PC_XBC) return SC_V + dest - PC_V;
    if (dest < PC_MQK) return SC_XBC + dest - PC_XBC;
    if (dest < PC_MV) return SC_MQK + dest - PC_MQK;
    return SC_MV + dest - PC_MV;
}
__device__ __forceinline__ void conv_w_in(Frame& F, const float* w_in, const float* nw, bf16* wt, LAS float* scr) {
    const int gw = F.vcu * NWAVES + F.wave, NGW = F.G * NWAVES;
    for (int it = gw; it < (DM / 64) * (PLD / 32); it += NGW) { const int nblk = PLD / 32, kb = it / nblk, nb = it % nblk; conv_item(w_in, P_IN, in_src_col(32 * nb), wt, DM, 32 * nb, 64 * kb, scr, F.lane, nw); }
}
__device__ __forceinline__ void conv_plain(Frame& F, const float* W, int K, int N, const float* kscale, bf16* wt, LAS float* scr, int kslo = 0, int kshi = 1 << 30) {
    const int gw = F.vcu * NWAVES + F.wave, NGW = F.G * NWAVES; const int nblk = N / 32;
    for (int it = gw; it < (K / 64) * nblk; it += NGW) { const int kb = it / nblk, nb = it % nblk; conv_item(W, N, 32 * nb, wt, K, 32 * nb, 64 * kb, scr, F.lane, kscale, kslo, kshi); }
}
__device__ __forceinline__ void conv_small(Frame& F, const float* w_in, const float* nw, bf16* wst) {
    const int gt = F.vcu * (NWAVES * 64) + F.tid, NT = F.G * NWAVES * 64;
    for (int i = gt; i < 32 * DM; i += NT) { const int c = i >> 10, k = i & (DM - 1);
        float v = 0.f; if (c < 24) v = w_in[(size_t)k * P_IN + (c < 16 ? SC_DT + c : SC_MI + (c - 16))] * nw[k];
        wst[i] = (bf16)(pk2(v, 0.f) & 0xffffu); }
}
__device__ __forceinline__ void row_pass0(Frame& F, const float* x, bf16* xb, float* rs) {
    const int gw = F.vcu * NWAVES + F.wave, NGW = F.G * NWAVES;
    for (int m = gw; m < M; m += 2 * NGW) {
        const int m2 = m + NGW; const bool two = m2 < M;
        const GAS f32x4* xr = (const GAS f32x4*)(x + (size_t)m * DM) + F.lane; const GAS f32x4* xr2 = (const GAS f32x4*)(x + (size_t)(two ? m2 : m) * DM) + F.lane;
        f32x4 v[4], u[4]; float s_ = 0.f, t_ = 0.f;
#pragma unroll
        for (int j = 0; j < 4; ++j) { v[j] = xr[64 * j]; u[j] = xr2[64 * j]; }
#pragma unroll
        for (int j = 0; j < 4; ++j) { s_ += (v[j].x * v[j].x + v[j].y * v[j].y) + (v[j].z * v[j].z + v[j].w * v[j].w); t_ += (u[j].x * u[j].x + u[j].y * u[j].y) + (u[j].z * u[j].z + u[j].w * u[j].w); }
        s_ = wave_sum(s_); t_ = wave_sum(t_);
        GAS unsigned long long* o8 = (GAS unsigned long long*)(xb + (size_t)m * DM) + F.lane;
#pragma unroll
        for (int j = 0; j < 4; ++j) o8[64 * j] = (unsigned long long)pk2(v[j].x, v[j].y) | ((unsigned long long)pk2(v[j].z, v[j].w) << 32);
        if (F.lane == 0) rs[m] = s_;
        if (two) { GAS unsigned long long* p8 = (GAS unsigned long long*)(xb + (size_t)m2 * DM) + F.lane;
#pragma unroll
            for (int j = 0; j < 4; ++j) p8[64 * j] = (unsigned long long)pk2(u[j].x, u[j].y) | ((unsigned long long)pk2(u[j].z, u[j].w) << 32);
            if (F.lane == 0) rs[m2] = t_; }
    }
}
typedef short bf16x8s __attribute__((ext_vector_type(8)));
__device__ __forceinline__ void small_proj(Frame& F, const bf16* xb, const bf16* wst, const float* rs, float* smallp) {
    constexpr int SP = 1040;
    LAS unsigned char* As = F.lds; LAS unsigned char* Bs = F.lds + 64 * SP;
    const int lane = F.lane, w = F.wave, mt = w & 3, nt = w >> 2, r16 = lane & 15, kq = lane >> 4;
    for (int rb = F.vcu * 64; rb < M; rb += F.G * 64) {
        f32x4 acc = (f32x4){0.f, 0.f, 0.f, 0.f};
#pragma unroll 1
        for (int kh = 0; kh < 2; ++kh) {
            v4u av[8], bv[4];
#pragma unroll
            for (int i = 0; i < 8; ++i) { const int it = F.tid + 512 * i, row = it >> 6, c = it & 63; av[i] = *(const v4u*)(xb + (size_t)(rb + row) * DM + kh * 512 + c * 8); }
#pragma unroll
            for (int i = 0; i < 4; ++i) { const int it = F.tid + 512 * i, row = it >> 6, c = it & 63; bv[i] = *(const v4u*)(wst + (size_t)row * DM + kh * 512 + c * 8); }
            __syncthreads();
#pragma unroll
            for (int i = 0; i < 8; ++i) { const int it = F.tid + 512 * i, row = it >> 6, c = it & 63; *(LAS v4u*)(As + row * SP + c * 16) = av[i]; }
#pragma unroll
            for (int i = 0; i < 4; ++i) { const int it = F.tid + 512 * i, row = it >> 6, c = it & 63; *(LAS v4u*)(Bs + row * SP + c * 16) = bv[i]; }
            __syncthreads();
            bf16x8s a[16], b[16];
#pragma unroll
            for (int ks = 0; ks < 16; ++ks) { a[ks] = *(const LAS bf16x8s*)(As + (16 * mt + r16) * SP + (32 * ks + 8 * kq) * 2); b[ks] = *(const LAS bf16x8s*)(Bs + (16 * nt + r16) * SP + (32 * ks + 8 * kq) * 2); }
#pragma unroll
            for (int ks = 0; ks < 16; ++ks) acc = __builtin_amdgcn_mfma_f32_16x16x32_bf16(a[ks], b[ks], acc, 0, 0, 0);
        }
        const int n = 16 * nt + r16;
        if (n < 24) {
#pragma unroll
            for (int i = 0; i < 4; ++i) { const int row = rb + 16 * mt + 4 * kq + i; smallp[(size_t)row * 24 + n] = acc[i] * (1.0f / sqrtf(rs[row] * (1.0f / DM) + EPS)); } }
    }
    __syncthreads();
}
__device__ __forceinline__ unsigned cvtpk(float lo, float hi) { return pk2(lo, hi); }
__device__ __forceinline__ float bflo(unsigned w) { return __uint_as_float(w << 16); }
__device__ __forceinline__ float bfhi(unsigned w) { return __uint_as_float(w & 0xffff0000u); }
typedef float f32x2 __attribute__((ext_vector_type(2)));
__device__ __forceinline__ f32x2 gelu_pk(f32x2 v) {
    const f32x2 av = __builtin_elementwise_abs(v), d = av * 0.2316418882f + 1.0f;
    f32x2 t; t.x = __builtin_amdgcn_rcpf(d.x); t.y = __builtin_amdgcn_rcpf(d.y);
    f32x2 q = t * 0.5307027145f + (-0.7265760135f); q = q * t + 0.7107068705f; q = q * t + (-0.142248368f); q = q * t + 0.127414796f; q = q * t;
    const f32x2 s = (v * v) * (-0.72134752044f);
    f32x2 e; e.x = __builtin_amdgcn_exp2f(s.x); e.y = __builtin_amdgcn_exp2f(s.y);
    const f32x2 m = v * (q * e), r = v - m;
    f32x2 o; o.x = v.x < 0.f ? m.x : r.x; o.y = v.y < 0.f ? m.y : r.y; return o;
}

__device__ __forceinline__ void ffn_fix(Frame& F, bf16* H, const bf16* sideA, const bf16* sideB, const float* cw, const float* cb, int pm) {
    constexpr int CPR = FFN / 8;
    for (int it = F.tid; it < 4 * 2 * CPR; it += NWAVES * 64) {
        const int c0 = (it % CPR) * 8, rr_ = (it / CPR) & 1, grp = 4 * pm + it / (2 * CPR); const bool first = (grp & 31) == 0;
        const v4u z = (v4u){0, 0, 0, 0};
        const bf16* sb = sideB + ((size_t)grp * 2 + rr_) * 2 * FFN + c0;
        const v4u g2 = *(const v4u*)sb, vv = *(const v4u*)(sb + FFN);
        const v4u a1 = first ? z : *(const v4u*)(sideA + ((size_t)(grp - 1) * 2 + 1) * FFN + c0), a0 = first ? z : *(const v4u*)(sideA + ((size_t)(grp - 1) * 2) * FFN + c0);
        const v4u g1 = rr_ ? *(const v4u*)(sideB + ((size_t)grp * 2) * 2 * FFN + c0) : a1, g0 = rr_ ? a1 : a0;
        f32x4 w0[2], w1[2], w2[2], bb[2];
#pragma unroll
        for (int k = 0; k < 2; ++k) { w0[k] = *(const f32x4*)(cw + c0 + 4 * k); w1[k] = *(const f32x4*)(cw + FFN + c0 + 4 * k); w2[k] = *(const f32x4*)(cw + 2 * FFN + c0 + 4 * k); bb[k] = *(const f32x4*)(cb + c0 + 4 * k); }
        v4u ov;
#pragma unroll
        for (int i = 0; i < 4; ++i) { const int k = i >> 1, e = (i & 1) * 2; f32x2 x;
            x.x = bb[k][e] + w0[k][e] * bflo(g0[i]) + w1[k][e] * bflo(g1[i]) + w2[k][e] * bflo(g2[i]);
            x.y = bb[k][e + 1] + w0[k][e + 1] * bfhi(g0[i]) + w1[k][e + 1] * bfhi(g1[i]) + w2[k][e + 1] * bfhi(g2[i]);
            const f32x2 ge = gelu_pk(x); ov[i] = cvtpk(ge.x * bflo(vv[i]), ge.y * bfhi(vv[i])); }
        *(v4u*)(H + (size_t)(grp * 64 + rr_) * FFN + c0) = ov;
    }
}
__device__ __forceinline__ float silu_f(float x) { return x * __builtin_amdgcn_rcpf(1.0f + __builtin_amdgcn_exp2f(-1.4426950408889634f * x)); }
__device__ __forceinline__ float sigm_f(float x) { return __builtin_amdgcn_rcpf(1.0f + __builtin_amdgcn_exp2f(-1.4426950408889634f * x)); }

__device__ __forceinline__ float shx(float v, int m, int lane) { return __int_as_float(__builtin_amdgcn_ds_bpermute((lane ^ m) << 2, __float_as_int(v))); }
__device__ __forceinline__ float shup(float v, int o, int lane) { return __int_as_float(__builtin_amdgcn_ds_bpermute((lane - o) << 2, __float_as_int(v))); }
__device__ __forceinline__ float shl_(float v, int src, int lane) { (void)lane; return __int_as_float(__builtin_amdgcn_ds_bpermute(src << 2, __float_as_int(v))); }
__device__ __forceinline__ float softplus_f(float x) { return fmaxf(x, 0.f) + 0.6931471805599453f * __builtin_amdgcn_logf(1.0f + __builtin_amdgcn_exp2f(-1.4426950408889634f * fabsf(x))); }
__device__ __forceinline__ float logsig_f(float x) { return fminf(x, 0.f) - 0.6931471805599453f * __builtin_amdgcn_logf(1.0f + __builtin_amdgcn_exp2f(-1.4426950408889634f * fabsf(x))); }
typedef short bf16x8v __attribute__((ext_vector_type(8)));
typedef float f32x16 __attribute__((ext_vector_type(16)));
typedef short v4i16_t __attribute__((ext_vector_type(4)));
__device__ __forceinline__ bf16x8v frag_row(LAS const unsigned char* base, int pitch, int row, int kel) { return *(const LAS bf16x8v*)(base + row * pitch + kel * 2); }
__device__ __forceinline__ bf16x8v frag_tr(LAS const unsigned char* base, int pitch, int krow, int col) {
    LAS const unsigned char* p = base + krow * pitch + col * 2;
    const v4i16_t lo = __builtin_amdgcn_ds_read_tr16_b64_v4i16((LAS v4i16_t*)p);
    const v4i16_t hi = __builtin_amdgcn_ds_read_tr16_b64_v4i16((LAS v4i16_t*)(p + 4 * pitch));
    return (bf16x8v){lo[0], lo[1], lo[2], lo[3], hi[0], hi[1], hi[2], hi[3]};
}
#define MFMA32(a, b, c) __builtin_amdgcn_mfma_f32_32x32x16_bf16((a), (b), (c), 0, 0, 0)

__device__ __forceinline__ void ssd_unit(int tid, bf16* proj, const float* smallp, float* ssq, const float* dt_bias, const float* a_log, const float* dskip, int b, int h, LAS unsigned char* lds) {
    constexpr int PB = 272, PX = 144;
    asm volatile("" : "+v"(tid));
    LAS unsigned char* CG = lds;
    LAS unsigned char* BB = lds + 34816;
    LAS unsigned char* XX = lds + 69632;
    LAS unsigned char* XW = lds + 88064;
    LAS unsigned char* ST = lds + 106496;
    LAS float* ldv = (LAS float*)(lds + 123904);
    LAS float* dtv = ldv + 2048;
    const int lane0 = tid & 63, w = __builtin_amdgcn_readfirstlane(tid >> 6);
    const int g = h >> 3, pt = w & 1, lt = w >> 1;
    const float a = -__expf(a_log[h]), dsk = dskip[h], dtb = dt_bias[h];
    const size_t rowb = (size_t)b * SEQ;
    const int xrow = tid >> 2, xq = tid & 3, brow = tid >> 4, bc = tid & 15;
    const bf16* xsrc = proj + (rowb + xrow) * PLD + PC_XBC + h * 64 + xq * 16;
    bf16* zptr = proj + (rowb + xrow) * PLD + PC_Z + h * 64 + xq * 16;
    const bf16* bsrc = proj + (rowb + brow) * PLD + PC_XBC + 1024 + g * 128 + bc * 8;
    const bf16* csrc = bsrc + 256;
    const float* dsrc = smallp + (rowb + lane0) * 24 + h;
    v4u xr[2], br[4], cr[4];
#pragma unroll
    for (int k = 0; k < 2; ++k) xr[k] = *(const v4u*)(xsrc + 8 * k);
#pragma unroll
    for (int k = 0; k < 4; ++k) { br[k] = *(const v4u*)(bsrc + (size_t)32 * k * PLD); cr[k] = *(const v4u*)(csrc + (size_t)32 * k * PLD); }
#pragma unroll
    for (int cc = 0; cc < 2; ++cc) { const int ch_ = 2 * w + cc; const float* dp_ = dsrc + (size_t)ch_ * 128 * 24;
        float v0 = dp_[0] + dtb, v1 = dp_[64 * 24] + dtb;
        v0 = softplus_f(v0); v1 = softplus_f(v1);
        float s0 = v0 * a, s1 = v1 * a;
#pragma unroll
        for (int o = 1; o < 64; o <<= 1) { const float t0 = shup(s0, o, lane0), t1 = shup(s1, o, lane0); if (lane0 >= o) { s0 += t0; s1 += t1; } }
        s1 += shl_(s0, 63, lane0);
        ldv[ch_ * 128 + lane0] = s0; ldv[ch_ * 128 + 64 + lane0] = s1; dtv[ch_ * 128 + lane0] = v0; dtv[ch_ * 128 + 64 + lane0] = v1; }
    f32x16 sacc;
#pragma unroll
    for (int i = 0; i < 16; ++i) sacc[i] = 0.f;
    for (int i = tid; i < 17408 / 4; i += 512) ((LAS unsigned*)ST)[i] = 0u;
    for (int c = 0; c < 16; ++c) {
        const size_t row0 = rowb + c * 128;
        int lane = lane0; asm volatile("" : "+v"(lane));
        const int r = lane & 31, hh = lane >> 5, trq = (lane & 15) >> 2, trc = 16 * ((lane >> 4) & 1) + 4 * (lane & 3);
        LAS const float* ldc = ldv + c * 128; LAS const float* dtc = dtv + c * 128;
        __syncthreads();
        {
            const float wl = dtc[xrow] * __expf(ldc[127] - ldc[xrow]);
#pragma unroll
            for (int k = 0; k < 2; ++k) { *(LAS v4u*)(XX + xrow * PX + xq * 32 + k * 16) = xr[k]; v4u o;
#pragma unroll
                for (int i = 0; i < 4; ++i) o[i] = pk2(bf2f(xr[k][i] & 0xffff) * wl, bf2f(xr[k][i] >> 16) * wl);
                *(LAS v4u*)(XW + xrow * PX + xq * 32 + k * 16) = o; }
#pragma unroll
            for (int k = 0; k < 4; ++k) { *(LAS v4u*)(BB + (brow + 32 * k) * PB + bc * 16) = br[k]; *(LAS v4u*)(CG + (brow + 32 * k) * PB + bc * 16) = cr[k]; }
        }
        v4u zr[2];
#pragma unroll
        for (int k = 0; k < 2; ++k) zr[k] = *(const v4u*)(zptr + (size_t)c * 128 * PLD + 8 * k);
        if (c < 15) {
#pragma unroll
            for (int k = 0; k < 2; ++k) xr[k] = *(const v4u*)(xsrc + (size_t)(c + 1) * 128 * PLD + 8 * k);
#pragma unroll
            for (int k = 0; k < 4; ++k) { br[k] = *(const v4u*)(bsrc + (size_t)((c + 1) * 128 + 32 * k) * PLD); cr[k] = *(const v4u*)(csrc + (size_t)((c + 1) * 128 + 32 * k) * PLD); }
        }
        __syncthreads();
        f32x16 yacc;
#pragma unroll
        for (int i = 0; i < 16; ++i) yacc[i] = 0.f;
        {   bf16x8v fa[8], fb[8];
#pragma unroll
            for (int ks = 0; ks < 8; ++ks) { fa[ks] = frag_row(ST, PB, 32 * pt + r, 16 * ks + 8 * hh); fb[ks] = frag_row(CG, PB, 32 * lt + r, 16 * ks + 8 * hh); }
            __builtin_amdgcn_sched_barrier(0);
#pragma unroll
            for (int ks = 0; ks < 8; ++ks) yacc = MFMA32(fa[ks], fb[ks], yacc); }
        { const float e = __expf(ldc[32 * lt + r]);
#pragma unroll
          for (int i = 0; i < 16; ++i) yacc[i] *= e; }
        f32x16 tA, tB;
        const int ltA = (w >= 6) ? 3 : (w >= 3) ? 2 : (w >= 1) ? 1 : 0, stA = w - ltA * (ltA + 1) / 2;
        const int ltB = 3, stB = w + 2;
#pragma unroll
        for (int i = 0; i < 16; ++i) { tA[i] = 0.f; tB[i] = 0.f; }
        {   bf16x8v fa[8], fb[8];
#pragma unroll
            for (int ks = 0; ks < 8; ++ks) { fa[ks] = frag_row(BB, PB, 32 * stA + r, 16 * ks + 8 * hh); fb[ks] = frag_row(CG, PB, 32 * ltA + r, 16 * ks + 8 * hh); }
            __builtin_amdgcn_sched_barrier(0);
#pragma unroll
            for (int ks = 0; ks < 8; ++ks) tA = MFMA32(fa[ks], fb[ks], tA); }
        if (w < 2) { bf16x8v fa[8], fb[8];
#pragma unroll
            for (int ks = 0; ks < 8; ++ks) { fa[ks] = frag_row(BB, PB, 32 * stB + r, 16 * ks + 8 * hh); fb[ks] = frag_row(CG, PB, 32 * ltB + r, 16 * ks + 8 * hh); }
            __builtin_amdgcn_sched_barrier(0);
#pragma unroll
            for (int ks = 0; ks < 8; ++ks) tB = MFMA32(fa[ks], fb[ks], tB); }
        __syncthreads();
#define SSD_GWRITE(T_, st_, lt_) do { const int l = 32 * (lt_) + r; const float ldl = ldc[l]; \
          _Pragma("unroll") for (int g4 = 0; g4 < 4; ++g4) { const int s0 = 32 * (st_) + 8 * g4 + 4 * hh; \
              const f32x4 lds4 = *(LAS const f32x4*)(ldc + s0), dts4 = *(LAS const f32x4*)(dtc + s0); float v[4]; \
              _Pragma("unroll") for (int j = 0; j < 4; ++j) { const float e_ = __expf(fminf(ldl - lds4[j], 0.f)) * dts4[j] * T_[4 * g4 + j]; v[j] = (s0 + j <= l) ? e_ : 0.f; } \
              *(LAS unsigned long long*)(CG + l * PB + s0 * 2) = (unsigned long long)pk2(v[0], v[1]) | ((unsigned long long)pk2(v[2], v[3]) << 32); } } while (0)
        SSD_GWRITE(tA, stA, ltA);
        if (w < 2) SSD_GWRITE(tB, stB, ltB);
#undef SSD_GWRITE
        __syncthreads();
        for (int kb = 0; kb <= lt; ++kb) { bf16x8v fa[2], fb[2];
#pragma unroll
            for (int k2 = 0; k2 < 2; ++k2) { const int ks = 2 * kb + k2; fa[k2] = frag_tr(XX, PX, 16 * ks + 8 * hh + trq, 32 * pt + trc); fb[k2] = frag_row(CG, PB, 32 * lt + r, 16 * ks + 8 * hh); }
            __builtin_amdgcn_sched_barrier(0);
#pragma unroll
            for (int k2 = 0; k2 < 2; ++k2) yacc = MFMA32(fa[k2], fb[k2], yacc); }
        { const float e = __expf(ldc[127]);
#pragma unroll
          for (int i = 0; i < 16; ++i) sacc[i] *= e; }
        {   bf16x8v fa[8], fb[8];
#pragma unroll
            for (int ks = 0; ks < 8; ++ks) { fa[ks] = frag_tr(BB, PB, 16 * ks + 8 * hh + trq, 32 * lt + trc); fb[ks] = frag_tr(XW, PX, 16 * ks + 8 * hh + trq, 32 * pt + trc); }
            __builtin_amdgcn_sched_barrier(0);
#pragma unroll
            for (int ks = 0; ks < 8; ++ks) sacc = MFMA32(fa[ks], fb[ks], sacc); }
        __syncthreads();
        {
            const int p = 32 * pt + r, l = 32 * lt + r;
#pragma unroll
            for (int g4 = 0; g4 < 4; ++g4) { const int n0 = 32 * lt + 8 * g4 + 4 * hh;
                *(LAS unsigned long long*)(ST + p * PB + n0 * 2) = (unsigned long long)pk2(sacc[4 * g4], sacc[4 * g4 + 1]) | ((unsigned long long)pk2(sacc[4 * g4 + 2], sacc[4 * g4 + 3]) << 32);
                const int p0 = 32 * pt + 8 * g4 + 4 * hh;
                *(LAS f32x4*)(CG + l * 272 + p0 * 4) = (f32x4){yacc[4 * g4], yacc[4 * g4 + 1], yacc[4 * g4 + 2], yacc[4 * g4 + 3]}; }
        }
        __syncthreads();
        {
            float o[16]; float ss = 0.f;
#pragma unroll
            for (int k = 0; k < 2; ++k) { const v4u zv = zr[k]; const v4u xv = *(const LAS v4u*)(XX + xrow * PX + xq * 32 + k * 16);
                const f32x4 y0 = *(const LAS f32x4*)(CG + xrow * 272 + (xq * 16 + 8 * k) * 4), y1 = *(const LAS f32x4*)(CG + xrow * 272 + (xq * 16 + 8 * k + 4) * 4);
#pragma unroll
                for (int i = 0; i < 4; ++i) { const float ya = (i < 2 ? y0[2 * i] : y1[2 * i - 4]), yb = (i < 2 ? y0[2 * i + 1] : y1[2 * i - 3]);
                    const float oa = (ya + dsk * bf2f(xv[i] & 0xffff)) * silu_f(bf2f(zv[i] & 0xffff)), ob = (yb + dsk * bf2f(xv[i] >> 16)) * silu_f(bf2f(zv[i] >> 16));
                    o[8 * k + 2 * i] = oa; o[8 * k + 2 * i + 1] = ob; ss += oa * oa + ob * ob; } }
            ss += shx(ss, 1, lane); ss += shx(ss, 2, lane);
            bf16* zp = zptr + (size_t)c * 128 * PLD;
#pragma unroll
            for (int k = 0; k < 2; ++k) { v4u ov; ov.x = pk2(o[8 * k], o[8 * k + 1]); ov.y = pk2(o[8 * k + 2], o[8 * k + 3]); ov.z = pk2(o[8 * k + 4], o[8 * k + 5]); ov.w = pk2(o[8 * k + 6], o[8 * k + 7]); *(v4u*)(zp + 8 * k) = ov; }
            if (xq == 0) ssq[(row0 + xrow) * 16 + h] = ss;
        }
    }
    __syncthreads();
}

__device__ __forceinline__ void mlstm_unit(int tid, bf16* proj, const float* smallp, const float* i_bias, const float* f_bias, const float* norm_w, int b, int hd, LAS unsigned char* lds, float* gsc  , unsigned long long* pts) {
    constexpr int PB = 272, GS = 656;
    asm volatile("" : "+v"(tid));
    LAS unsigned char* QP = lds;
    LAS unsigned char* KK = lds + 34816;
    LAS unsigned char* VV = lds + 69632;
    LAS unsigned char* CS = lds + 104448;
    LAS float* uu = (LAS float*)(lds + 139264);
    LAS float* mmv = uu + 128;
    LAS float* wint = mmv + 128;
    LAS float* dnv = wint + 128;
    LAS float* wlv = dnv + 128;
    LAS float* scal = wlv + 128;
    LAS float* nwl = scal + 16;
    LAS float* ptot = nwl + 128;
    LAS float* pmlo = ptot + 16;
    LAS unsigned short* nstb = (LAS unsigned short*)(pmlo + 16);
    const int lane0 = tid & 63, w = __builtin_amdgcn_readfirstlane(tid >> 6);
    const int tt = w >> 1, dp = w & 1;
    const float ib = i_bias[hd], fb = f_bias[hd];
    const size_t rowb = (size_t)b * SEQ;
    const int srow = tid >> 4, sc = tid & 15, et = tid >> 2, eq = tid & 3;
    const bf16* qsrc = proj + (rowb + srow) * PLD + PC_MQK + hd * 128 + sc * 8;
    const bf16* ksrc = qsrc + 512;
    const bf16* vsrc = proj + (rowb + srow) * PLD + PC_MV + hd * 128 + sc * 8;
    bf16* optr = proj + (rowb + et) * PLD + PC_MO + hd * 128 + eq * 32;
    v4u qr[4], kr[4]; float wlr[4];
#pragma unroll
    for (int k = 0; k < 4; ++k) { qr[k] = *(const v4u*)(qsrc + (size_t)32 * k * PLD); kr[k] = *(const v4u*)(ksrc + (size_t)32 * k * PLD); }
    {
        float pc0[2], pc1[2], pu0[2], pu1[2], pp0[2], pp1[2];
#pragma unroll
        for (int cc = 0; cc < 2; ++cc) { const float* gp = smallp + (rowb + (size_t)(2 * w + cc) * 128 + lane0) * 24 + 16 + hd;
            const float li0 = gp[0] + ib, li1 = gp[64 * 24] + ib, f0 = gp[4] + fb, f1 = gp[64 * 24 + 4] + fb;
            float c0 = logsig_f(f0), c1 = logsig_f(f1);
#pragma unroll
            for (int o = 1; o < 64; o <<= 1) { const float t0 = shup(c0, o, lane0), t1 = shup(c1, o, lane0); if (lane0 >= o) { c0 += t0; c1 += t1; } }
            c1 += shl_(c0, 63, lane0);
            const float totf = shl_(c1, 63, lane0);
            const float u0 = li0 - c0, u1 = li1 - c1;
            float p0 = u0, p1 = u1;
#pragma unroll
            for (int o = 1; o < 64; o <<= 1) { const float t0 = shup(p0, o, lane0), t1 = shup(p1, o, lane0); if (lane0 >= o) { p0 = fmaxf(p0, t0); p1 = fmaxf(p1, t1); } }
            p1 = fmaxf(p1, shl_(p0, 63, lane0));
            pc0[cc] = c0; pc1[cc] = c1; pu0[cc] = u0; pu1[cc] = u1; pp0[cc] = p0; pp1[cc] = p1;
            const float pall = shl_(p1, 63, lane0);
            if (lane0 == 0) { ptot[2 * w + cc] = totf; pmlo[2 * w + cc] = totf + pall; }
        }
        if (tid < 128) nwl[tid] = norm_w[hd * 128 + tid];
        if (tid < 64) ((LAS unsigned*)nstb)[tid] = 0u;
        for (int i = tid; i < 34816 / 4; i += 512) ((LAS unsigned*)CS)[i] = 0u;
        __syncthreads();
        float mst = 0.f, mst_mine[2] = {0.f, 0.f}, mnew_mine[2] = {0.f, 0.f};
#pragma unroll
        for (int c = 0; c < 16; ++c) { const float tf = ptot[c], ml = pmlo[c]; const float mn = fmaxf(tf + mst, ml);
            if (tid == 0) scal[c] = __expf(tf + mst - mn);
            if (c == 2 * w) { mst_mine[0] = mst; mnew_mine[0] = mn; }
            if (c == 2 * w + 1) { mst_mine[1] = mst; mnew_mine[1] = mn; }
            mst = mn; }
#pragma unroll
        for (int cc = 0; cc < 2; ++cc) { float* go_ = gsc + (size_t)(2 * w + cc) * GS; const float ms = mst_mine[cc], mn = mnew_mine[cc], tf = ptot[2 * w + cc];
            const float m0 = fmaxf(pp0[cc], ms), m1 = fmaxf(pp1[cc], ms);
            go_[lane0] = __expf(mn - tf - m0); go_[64 + lane0] = __expf(mn - tf - m1); go_[128 + lane0] = m0; go_[192 + lane0] = m1;
            go_[256 + lane0] = __expf(ms - m0); go_[320 + lane0] = __expf(ms - m1);
            go_[384 + lane0] = __expf(-(pc0[cc] + m0)); go_[448 + lane0] = __expf(-(pc1[cc] + m1));
            go_[512 + lane0] = __expf(tf + pu0[cc] - mn); go_[576 + lane0] = __expf(tf + pu1[cc] - mn); }
        asm volatile("s_waitcnt vmcnt(0)" ::: "memory");
        __syncthreads();
    }
    float gr[5] = {0.f, 0.f, 0.f, 0.f, 0.f};
    if (tid < 128) {
#pragma unroll
        for (int k = 0; k < 5; ++k) gr[k] = __hip_atomic_load(gsc + k * 128 + tid, __ATOMIC_RELAXED, __HIP_MEMORY_SCOPE_AGENT); }
#pragma unroll
    for (int k = 0; k < 4; ++k) wlr[k] = __hip_atomic_load(gsc + 512 + srow + 32 * k, __ATOMIC_RELAXED, __HIP_MEMORY_SCOPE_AGENT);
    f32x16 cacc0, cacc1, nacc;
#pragma unroll
    for (int i = 0; i < 16; ++i) { cacc0[i] = 0.f; cacc1[i] = 0.f; nacc[i] = 0.f; }
    const bf16x8v ones = (bf16x8v){0x3F80, 0x3F80, 0x3F80, 0x3F80, 0x3F80, 0x3F80, 0x3F80, 0x3F80};
#if PROBE_PHASE != -1 && defined(PROBE_STAGES)
    unsigned long long tacc = 0; unsigned long long tprev = __builtin_amdgcn_s_memrealtime();
#define STAMP(k) do { const unsigned long long tn_ = __builtin_amdgcn_s_memrealtime(); if ((k) == PROBE_STAGES) tacc += tn_ - tprev; tprev = tn_; } while (0)
#else
#define STAMP(k) do {} while (0)
#endif
    for (int c = 0; c < 16; ++c) {
        int lane = lane0; asm volatile("" : "+v"(lane));
        const int r = lane & 31, hh = lane >> 5, trq = (lane & 15) >> 2, trc = 16 * ((lane >> 4) & 1) + 4 * (lane & 3);
        __syncthreads();
        STAMP(0);
#pragma unroll
        for (int k = 0; k < 4; ++k) { *(LAS v4u*)(QP + (srow + 32 * k) * PB + sc * 16) = qr[k]; v4u kw_;
#pragma unroll
            for (int i = 0; i < 4; ++i) kw_[i] = pk2(bflo(kr[k][i]) * wlr[k], bfhi(kr[k][i]) * wlr[k]);
            *(LAS v4u*)(KK + (srow + 32 * k) * PB + sc * 16) = kw_; }
        if (tid < 128) { uu[tid] = gr[0]; mmv[tid] = gr[1]; wint[tid] = gr[2]; dnv[tid] = gr[3]; wlv[tid] = gr[4]; }
        v4u vr[4];
#pragma unroll
        for (int k = 0; k < 4; ++k) vr[k] = *(const v4u*)(vsrc + (size_t)(c * 128 + 32 * k) * PLD);
        if (c < 15) {
#pragma unroll
            for (int k = 0; k < 4; ++k) { const size_t ro = (size_t)((c + 1) * 128 + 32 * k) * PLD; qr[k] = *(const v4u*)(qsrc + ro); kr[k] = *(const v4u*)(ksrc + ro); }
#pragma unroll
            for (int k = 0; k < 4; ++k) wlr[k] = __hip_atomic_load(gsc + (size_t)(c + 1) * GS + 512 + srow + 32 * k, __ATOMIC_RELAXED, __HIP_MEMORY_SCOPE_AGENT);
            if (tid < 128) {
#pragma unroll
                for (int k = 0; k < 5; ++k) gr[k] = __hip_atomic_load(gsc + (size_t)(c + 1) * GS + k * 128 + tid, __ATOMIC_RELAXED, __HIP_MEMORY_SCOPE_AGENT); }
        }
        __syncthreads();
        STAMP(1);
        f32x16 na0, na1, dacc;
#pragma unroll
        for (int i = 0; i < 16; ++i) { na0[i] = 0.f; na1[i] = 0.f; dacc[i] = 0.f; }
#pragma unroll
        for (int kh = 0; kh < 2; ++kh) { bf16x8v fq[4], f0[4], f1[4], fn[4];
#pragma unroll
            for (int k4 = 0; k4 < 4; ++k4) { const int ks = 4 * kh + k4; fq[k4] = frag_row(QP, PB, 32 * tt + r, 16 * ks + 8 * hh); f0[k4] = frag_row(CS, PB, 32 * (2 * dp) + r, 16 * ks + 8 * hh); f1[k4] = frag_row(CS, PB, 32 * (2 * dp + 1) + r, 16 * ks + 8 * hh);
                fn[k4] = *(const LAS bf16x8v*)((LAS const unsigned char*)nstb + (16 * ks + 8 * hh) * 2); }
            __builtin_amdgcn_sched_barrier(0);
#pragma unroll
            for (int k4 = 0; k4 < 4; ++k4) { na0 = MFMA32(f0[k4], fq[k4], na0); na1 = MFMA32(f1[k4], fq[k4], na1); dacc = MFMA32(fn[k4], fq[k4], dacc); } }
        { const float e = wint[32 * tt + r];
#pragma unroll
          for (int i = 0; i < 16; ++i) { na0[i] *= e; na1[i] *= e; dacc[i] *= e; } }
        f32x16 tA, tB;
        const int ttA = (w >= 6) ? 3 : (w >= 3) ? 2 : (w >= 1) ? 1 : 0, stA = w - ttA * (ttA + 1) / 2;
        const int ttB = 3, stB = w + 2;
#pragma unroll
        for (int i = 0; i < 16; ++i) { tA[i] = 0.f; tB[i] = 0.f; }
#pragma unroll
        for (int kh = 0; kh < 2; ++kh) { bf16x8v fa[4], fb_[4];
#pragma unroll
            for (int k4 = 0; k4 < 4; ++k4) { const int ks = 4 * kh + k4; fa[k4] = frag_row(KK, PB, 32 * stA + r, 16 * ks + 8 * hh); fb_[k4] = frag_row(QP, PB, 32 * ttA + r, 16 * ks + 8 * hh); }
            __builtin_amdgcn_sched_barrier(0);
#pragma unroll
            for (int k4 = 0; k4 < 4; ++k4) tA = MFMA32(fa[k4], fb_[k4], tA); }
        if (w < 2) {
#pragma unroll
            for (int kh = 0; kh < 2; ++kh) { bf16x8v fa[4], fb_[4];
#pragma unroll
                for (int k4 = 0; k4 < 4; ++k4) { const int ks = 4 * kh + k4; fa[k4] = frag_row(KK, PB, 32 * stB + r, 16 * ks + 8 * hh); fb_[k4] = frag_row(QP, PB, 32 * ttB + r, 16 * ks + 8 * hh); }
                __builtin_amdgcn_sched_barrier(0);
#pragma unroll
                for (int k4 = 0; k4 < 4; ++k4) tB = MFMA32(fa[k4], fb_[k4], tB); } }
        __syncthreads();
        STAMP(2);
#define ML_PWRITE(T_, st_, tt_) do { const int t = 32 * (tt_) + r; const float rh = uu[t]; \
          _Pragma("unroll") for (int g4 = 0; g4 < 4; ++g4) { const int s0 = 32 * (st_) + 8 * g4 + 4 * hh; float v[4]; \
              _Pragma("unroll") for (int j = 0; j < 4; ++j) v[j] = (s0 + j <= t) ? T_[4 * g4 + j] * rh : 0.f; \
              *(LAS unsigned long long*)(QP + t * PB + s0 * 2) = (unsigned long long)pk2(v[0], v[1]) | ((unsigned long long)pk2(v[2], v[3]) << 32); } } while (0)
        ML_PWRITE(tA, stA, ttA);
        if (w < 2) ML_PWRITE(tB, stB, ttB);
#undef ML_PWRITE
#pragma unroll
        for (int k = 0; k < 4; ++k) *(LAS v4u*)(VV + (srow + 32 * k) * PB + sc * 16) = vr[k];
        v4u og[4];
#pragma unroll
        for (int k = 0; k < 4; ++k) og[k] = *(const v4u*)(optr + (size_t)c * 128 * PLD + 8 * k);
        __syncthreads();
        STAMP(3);
        { const float e = scal[c];
#pragma unroll
          for (int i = 0; i < 16; ++i) { cacc0[i] *= e; cacc1[i] *= e; nacc[i] *= e; } }
#pragma unroll
        for (int kb = 0; kb < 4; ++kb) { bf16x8v fk[2], f0[2], f1[2], fp[2];
            const bool m3 = kb <= tt;
#pragma unroll
            for (int k2 = 0; k2 < 2; ++k2) { const int ks = 2 * kb + k2; fk[k2] = frag_tr(KK, PB, 16 * ks + 8 * hh + trq, 32 * tt + trc);
                f0[k2] = frag_tr(VV, PB, 16 * ks + 8 * hh + trq, 32 * (2 * dp) + trc); f1[k2] = frag_tr(VV, PB, 16 * ks + 8 * hh + trq, 32 * (2 * dp + 1) + trc);
                fp[k2] = frag_row(QP, PB, 32 * tt + r, 16 * ks + 8 * hh); }
            __builtin_amdgcn_sched_barrier(0);
#pragma unroll
            for (int k2 = 0; k2 < 2; ++k2) { cacc0 = MFMA32(fk[k2], f0[k2], cacc0); cacc1 = MFMA32(fk[k2], f1[k2], cacc1); nacc = MFMA32(fk[k2], ones, nacc);
                if (m3) { na0 = MFMA32(f0[k2], fp[k2], na0); na1 = MFMA32(f1[k2], fp[k2], na1); dacc = MFMA32(ones, fp[k2], dacc); } } }
        __syncthreads();
        STAMP(4);
        {
            const int t = 32 * tt + r; const float dv = __builtin_amdgcn_rcpf(fmaxf(fabsf(dacc[0]), dnv[t]));
#pragma unroll
            for (int g4 = 0; g4 < 4; ++g4) {
                const int e0 = 32 * tt + 8 * g4 + 4 * hh, d0 = 32 * (2 * dp) + r, d1 = 32 * (2 * dp + 1) + r;
                *(LAS unsigned long long*)(CS + d0 * PB + e0 * 2) = (unsigned long long)pk2(cacc0[4 * g4], cacc0[4 * g4 + 1]) | ((unsigned long long)pk2(cacc0[4 * g4 + 2], cacc0[4 * g4 + 3]) << 32);
                *(LAS unsigned long long*)(CS + d1 * PB + e0 * 2) = (unsigned long long)pk2(cacc1[4 * g4], cacc1[4 * g4 + 1]) | ((unsigned long long)pk2(cacc1[4 * g4 + 2], cacc1[4 * g4 + 3]) << 32);
                const int dd0 = 32 * (2 * dp) + 8 * g4 + 4 * hh, dd1 = dd0 + 32;
                *(LAS unsigned long long*)(QP + t * PB + dd0 * 2) = (unsigned long long)pk2(na0[4 * g4] * dv, na0[4 * g4 + 1] * dv) | ((unsigned long long)pk2(na0[4 * g4 + 2] * dv, na0[4 * g4 + 3] * dv) << 32);
                *(LAS unsigned long long*)(QP + t * PB + dd1 * 2) = (unsigned long long)pk2(na1[4 * g4] * dv, na1[4 * g4 + 1] * dv) | ((unsigned long long)pk2(na1[4 * g4 + 2] * dv, na1[4 * g4 + 3] * dv) << 32);
                if (dp == 0 && r == 0) *(LAS unsigned long long*)((LAS unsigned char*)nstb + e0 * 2) = (unsigned long long)pk2(nacc[4 * g4], nacc[4 * g4 + 1]) | ((unsigned long long)pk2(nacc[4 * g4 + 2], nacc[4 * g4 + 3]) << 32);
            }
        }
        __syncthreads();
        STAMP(5);
        {
            float hv[32]; float ss = 0.f;
#pragma unroll
            for (int k = 0; k < 4; ++k) { const v4u x = *(const LAS v4u*)(QP + et * PB + eq * 64 + k * 16);
#pragma unroll
                for (int i = 0; i < 4; ++i) { hv[8 * k + 2 * i] = bflo(x[i]); hv[8 * k + 2 * i + 1] = bfhi(x[i]); ss += hv[8 * k + 2 * i] * hv[8 * k + 2 * i] + hv[8 * k + 2 * i + 1] * hv[8 * k + 2 * i + 1]; } }
            ss += shx(ss, 1, lane); ss += shx(ss, 2, lane);
            const float rr = __builtin_amdgcn_rsqf(ss * (1.0f / 128.0f) + EPS);
            bf16* op = optr + (size_t)c * 128 * PLD;
            LAS const float* nw = nwl + eq * 32;
#pragma unroll
            for (int k = 0; k < 4; ++k) { v4u o; const f32x4 w0 = *(LAS const f32x4*)(nw + 8 * k), w1 = *(LAS const f32x4*)(nw + 8 * k + 4);
#pragma unroll
                for (int i = 0; i < 4; ++i) { const float g0 = bflo(og[k][i]), g1 = bfhi(og[k][i]);
                    const float wa = (i < 2) ? w0[2 * i] : w1[2 * i - 4], wb = (i < 2) ? w0[2 * i + 1] : w1[2 * i - 3];
                    o[i] = pk2(hv[8 * k + 2 * i] * rr * wa * g0, hv[8 * k + 2 * i + 1] * rr * wb * g1); }
                *(v4u*)(op + 8 * k) = o; }
        }
    }
#if PROBE_PHASE != -1 && defined(PROBE_STAGES)
    STAMP(6);
    if (tid == 0 && pts) pts[PROBE_STAGES] = tacc;
#endif
#undef STAMP
    __syncthreads();
}

__device__ __forceinline__ void conv_fix(Frame& F, bf16* proj, const bf16* halo, const float* scw, const float* scb, const float* mcw, const float* mcb) {
    const int gt = F.vcu * (NWAVES * 64) + F.tid, NT = F.G * NWAVES * 64;
    for (int it = gt; it < 256 * 320; it += NT) {
        const int strip = it % 320, rg = it / 320, hch = strip * 8;
        const float* wp; const float* bp; int wst; float post = 1.0f;
        if (hch < 1536) { wp = scw + hch; bp = scb + hch; wst = 1536; }
        else { const int c2 = hch - 1536; wp = mcw + c2; bp = mcb + c2; wst = 1024; post = (c2 >= 512) ? 0.08838834764831845f : 1.0f; }
        bf16* base = proj + (size_t)rg * 64 * PLD + PC_XBC + hch;
        v4u r0 = (v4u){0, 0, 0, 0}, r1 = r0, r2 = r0;
        if ((rg & 31) != 0) { const bf16* hp = halo + ((size_t)(rg - 1) * 3) * 2560 + hch; r0 = *(const v4u*)hp; r1 = *(const v4u*)(hp + 2560); r2 = *(const v4u*)(hp + 5120); }
        v4u cur[3];
#pragma unroll
        for (int j = 0; j < 3; ++j) cur[j] = *(const v4u*)(base + (size_t)j * PLD);
        float cw[4][8], cb[8];
#pragma unroll
        for (int j = 0; j < 4; ++j) { const f32x4 a0 = *(const f32x4*)(wp + j * wst), a1 = *(const f32x4*)(wp + j * wst + 4);
#pragma unroll
            for (int i = 0; i < 4; ++i) { cw[j][i] = a0[i]; cw[j][4 + i] = a1[i]; } }
        { const f32x4 a0 = *(const f32x4*)bp, a1 = *(const f32x4*)(bp + 4);
#pragma unroll
          for (int i = 0; i < 4; ++i) { cb[i] = a0[i]; cb[4 + i] = a1[i]; } }
#pragma unroll
        for (int j = 0; j < 3; ++j) { v4u o;
#pragma unroll
            for (int i = 0; i < 4; ++i) {
                const float a0 = cb[2 * i] + cw[0][2 * i] * bflo(r0[i]) + cw[1][2 * i] * bflo(r1[i]) + cw[2][2 * i] * bflo(r2[i]) + cw[3][2 * i] * bflo(cur[j][i]);
                const float a1 = cb[2 * i + 1] + cw[0][2 * i + 1] * bfhi(r0[i]) + cw[1][2 * i + 1] * bfhi(r1[i]) + cw[2][2 * i + 1] * bfhi(r2[i]) + cw[3][2 * i + 1] * bfhi(cur[j][i]);
                o[i] = pk2(silu_f(a0) * post, silu_f(a1) * post); }
            *(v4u*)(base + (size_t)j * PLD) = o; r0 = r1; r1 = r2; r2 = cur[j]; }
    }
}

__device__ __forceinline__ void ksum_pass(Frame& F, const bf16* proj, float* ksum) {
    const int gt = F.vcu * (NWAVES * 64) + F.tid, NT = F.G * NWAVES * 64;
    for (int it = gt; it < 64 * 16 * 64; it += NT) {
        const int ch = it & 63, sl = (it >> 6) & 15, tile = it >> 10;
        const bf16* base = proj + ((size_t)tile * 256 + sl * 16) * PLD + PC_K + ch * 8;
        float a[8];
#pragma unroll
        for (int i = 0; i < 8; ++i) a[i] = 0.f;
        v4u v[16];
#pragma unroll
        for (int j = 0; j < 16; ++j) v[j] = *(const v4u*)(base + (size_t)j * PLD);
#pragma unroll
        for (int j = 0; j < 16; ++j)
#pragma unroll
            for (int i = 0; i < 4; ++i) { a[2 * i] += bflo(v[j][i]); a[2 * i + 1] += bfhi(v[j][i]); }
        float* kd = ksum + (size_t)tile * 512 + ch * 8;
#pragma unroll
        for (int i = 0; i < 8; ++i) atomicAdd(kd + i, a[i]);
    }
}

namespace attn_body {
using bf16=__hip_bfloat16;
using bf16x8=__attribute__((ext_vector_type(8)))short;
using s16x4=__attribute__((ext_vector_type(4)))short;
using f32x16=__attribute__((ext_vector_type(16)))float;
using u32x4=__attribute__((ext_vector_type(4)))unsigned;
constexpr int BATCH=8,NHEAD=8,SEQ=2048,D=64,DM=6144;
constexpr int NW=8,QBLK=32,QB=QBLK*NW,KVBLK=64,NQB=SEQ/QB;
constexpr int ATTN_PITCH=DM, ATTN_UNIT_ROWS=QB;
__device__ __forceinline__ int crow(int r,int hi){return (r&3)+8*(r>>2)+4*hi;}
#define SBAR() __builtin_amdgcn_sched_barrier(0)
__device__ __forceinline__ void cmask(f32x16&p0,f32x16&p1,int jb,int qrel,int hi){
  const float NEG=-INFINITY; int kb=64*jb+4*hi;
  #pragma unroll
  for(int r=0;r<16;++r){int kv=kb+(r&3)+8*(r>>2); if(kv>qrel)p0[r]=NEG; if(kv+32>qrel)p1[r]=NEG;}
}

typedef float f32x4_t __attribute__((ext_vector_type(4)));
__device__ __forceinline__ float bfu(short v){return __uint_as_float(((unsigned)(unsigned short)v)<<16);}
constexpr int NSLOT=3, SLOTB=8192;
constexpr int LDS_K=0, LDS_V=NSLOT*SLOTB, LDS_WS=2*NSLOT*SLOTB, LDS_OST=LDS_WS+NW*64*4, LDS_BYTES=LDS_OST+NW*4096;
constexpr float C2=0.125f*1.4426950408889634f;
__device__ __forceinline__ void glds16(const void*gsrc,unsigned lds_dst){unsigned keep;
  asm volatile("s_mov_b32 %0, m0\n\ts_mov_b32 m0, %2\n\ts_nop 0\n\tglobal_load_lds_dwordx4 %1, off\n\ts_mov_b32 m0, %0":"=&s"(keep):"v"(gsrc),"s"(lds_dst):"memory");}
__device__ __forceinline__ float max3f(float a,float b,float c){float r;asm("v_max3_f32 %0, %1, %2, %3":"=v"(r):"v"(a),"v"(b),"v"(c));return r;}
__device__ __forceinline__ float max2f(float a,float b){float r;asm("v_max_f32_e32 %0, %1, %2":"=v"(r):"v"(a),"v"(b));return r;}
__device__ __forceinline__ float fadd_s(float a,float b){float r;asm("v_add_f32_e32 %0, %1, %2":"=v"(r):"v"(a),"v"(b));return r;}
__device__ __forceinline__ float fsub_s(float a,float b){float r;asm("v_sub_f32_e32 %0, %1, %2":"=v"(r):"v"(a),"v"(b));return r;}
typedef float f32x2_t __attribute__((ext_vector_type(2))); typedef __bf16 bf16x2_t __attribute__((ext_vector_type(2)));
__device__ __forceinline__ unsigned cvtpk_s(float lo,float hi){f32x2_t v={lo,hi};bf16x2_t b=__builtin_convertvector(v,bf16x2_t);return __builtin_bit_cast(unsigned,b);}
#define WAIT_BAR(N) asm volatile("s_waitcnt vmcnt(" #N ") lgkmcnt(0)\n\ts_barrier":::"memory")

__device__ __forceinline__ void qkt(f32x16&p0,f32x16&p1,const char*Kslot,const bf16x8*qr,const f32x16&negm,int r32,int hi){
  const char*kb=Kslot+hi*1024+r32*16;
  #pragma unroll
  for(int d0=0;d0<4;++d0){
    const bf16x8 b0=*reinterpret_cast<const bf16x8*>(kb+d0*2048);
    const bf16x8 b1=*reinterpret_cast<const bf16x8*>(kb+d0*2048+512);
    if(d0==0){p0=__builtin_amdgcn_mfma_f32_32x32x16_bf16(b0,qr[0],negm,0,0,0);p1=__builtin_amdgcn_mfma_f32_32x32x16_bf16(b1,qr[0],negm,0,0,0);}
    else{p0=__builtin_amdgcn_mfma_f32_32x32x16_bf16(b0,qr[d0],p0,0,0,0);p1=__builtin_amdgcn_mfma_f32_32x32x16_bf16(b1,qr[d0],p1,0,0,0);}}
}
typedef __attribute__((address_space(3))) const char* lds_cptr;
typedef short v4i16_t __attribute__((ext_vector_type(4)));
__device__ __forceinline__ void kload8(bf16x8*kf,lds_cptr kp){
  kf[0]=*(const __attribute__((address_space(3))) bf16x8*)(kp);      kf[1]=*(const __attribute__((address_space(3))) bf16x8*)(kp+512);
  kf[2]=*(const __attribute__((address_space(3))) bf16x8*)(kp+2048); kf[3]=*(const __attribute__((address_space(3))) bf16x8*)(kp+2560);
  kf[4]=*(const __attribute__((address_space(3))) bf16x8*)(kp+4096); kf[5]=*(const __attribute__((address_space(3))) bf16x8*)(kp+4608);
  kf[6]=*(const __attribute__((address_space(3))) bf16x8*)(kp+6144); kf[7]=*(const __attribute__((address_space(3))) bf16x8*)(kp+6656);
}
__device__ __forceinline__ void kload2(bf16x8*kf,lds_cptr kp,int j){ kf[2*j]=*(const __attribute__((address_space(3))) bf16x8*)(kp+j*2048); kf[2*j+1]=*(const __attribute__((address_space(3))) bf16x8*)(kp+j*2048+512); }
__device__ __forceinline__ s16x4 vtr(lds_cptr p){ return __builtin_bit_cast(s16x4,__builtin_amdgcn_ds_read_tr16_b64_v4i16((__attribute__((address_space(3))) v4i16_t*)p)); }
__device__ __forceinline__ float rowmax(const f32x16&p0,const f32x16&p1){
  float a=max3f(p0[0],p0[1],p1[0]),b=max3f(p0[2],p0[3],p1[1]);a=max3f(a,p1[2],p1[3]);
  #pragma unroll
  for(int r=4;r<16;r+=4){a=max3f(a,p0[r],p0[r+1]);b=max3f(b,p0[r+2],p0[r+3]);a=max3f(a,p1[r],p1[r+1]);b=max3f(b,p1[r+2],p1[r+3]);}
  const float m=max2f(a,b);
  auto rr=__builtin_amdgcn_permlane32_swap(__float_as_uint(m),__float_as_uint(m),false,false);
  return max2f(__uint_as_float(rr[0]),__uint_as_float(rr[1]));
}
__device__ __forceinline__ void pv(f32x16*o,int vb,bf16x8 pa0,bf16x8 pa1,bf16x8 pa2,bf16x8 pa3){
  #pragma unroll
  for(int d0=0;d0<2;++d0){s16x4 lo[4],hi[4];
    #pragma unroll
    for(int ks=0;ks<4;++ks){
      asm volatile("ds_read_b64_tr_b16 %0,%1 offset:%c2":"=&v"(lo[ks]):"v"(vb),"i"(d0*4096+ks*1024):"memory");
      asm volatile("ds_read_b64_tr_b16 %0,%1 offset:%c2":"=&v"(hi[ks]):"v"(vb),"i"(d0*4096+ks*1024+512):"memory");}
    asm volatile("s_waitcnt lgkmcnt(0)":::"memory");SBAR();
    #define PK(k) (bf16x8){lo[k][0],lo[k][1],lo[k][2],lo[k][3],hi[k][0],hi[k][1],hi[k][2],hi[k][3]}
    o[d0]=__builtin_amdgcn_mfma_f32_32x32x16_bf16(pa0,PK(0),o[d0],0,0,0);
    o[d0]=__builtin_amdgcn_mfma_f32_32x32x16_bf16(pa1,PK(1),o[d0],0,0,0);
    o[d0]=__builtin_amdgcn_mfma_f32_32x32x16_bf16(pa2,PK(2),o[d0],0,0,0);
    o[d0]=__builtin_amdgcn_mfma_f32_32x32x16_bf16(pa3,PK(3),o[d0],0,0,0);
    #undef PK
  }
}

#ifndef ATTN_STORE16
#define ATTN_STORE16(p,v) (*(u32x4*)(p)=(v))
#endif
template<int THRL> __device__ __forceinline__ void attn_unit(int tid,int b,int h,int qb,const bf16*Q,const bf16*__restrict__ K,const bf16*__restrict__ V,bf16*O,const float*__restrict__ ksum,char*shm){
  asm volatile("":"+v"(tid));
  const int lane=tid&63,r32=lane&31,hi=lane>>5; const int wid=__builtin_amdgcn_readfirstlane(tid>>6);
  const long rowbase=(long)b*SEQ; const int q0=qb*QB;
  const bf16*Qw=Q+(rowbase+q0+wid*QBLK)*DM+h*D;
  const bf16*Kh=K+rowbase*DM+h*D,*Vh=V+rowbase*DM+h*D;
  const unsigned lds0=(unsigned)(uintptr_t)shm;
  float*wsf=(float*)(shm+LDS_WS)+wid*64;
  const bf16*ksrc=Kh+(long)lane*DM+wid*8;
  const bf16*vsrc=Vh+(long)(16*(wid&3)+(lane>>2))*DM+(wid>>2)*32+(lane&3)*8;
  const unsigned kdst=lds0+LDS_K+wid*1024, vdst=lds0+LDS_V+wid*1024;
  #define DMA_K(t,slot) glds16(ksrc+(long)(t)*KVBLK*DM,(unsigned)__builtin_amdgcn_readfirstlane(kdst+(slot)))
  #define DMA_V(t,slot) glds16(vsrc+(long)(t)*KVBLK*DM,(unsigned)__builtin_amdgcn_readfirstlane(vdst+(slot)))
  const int vb0=(int)(lds0+LDS_V)+((lane>>4)&1)*32+(lane&3)*8+(4*hi+((lane&15)>>2))*64;
  const char*Kbase=shm+LDS_K; bf16x8 kf[8];
  const lds_cptr shm3=(lds_cptr)shm; const lds_cptr kp0=shm3+LDS_K+hi*1024+r32*16; const lds_cptr vp0=shm3+LDS_V+((lane>>4)&1)*32+(lane&3)*8+(4*hi+((lane&15)>>2))*64;
  const int NT=(q0+QB)/KVBLK;
  DMA_K(0,0);DMA_V(0,0);DMA_K(1,SLOTB);
  bf16x8 qr[4];
  #pragma unroll
  for(int d0=0;d0<4;++d0)qr[d0]=*reinterpret_cast<const bf16x8*>(&Qw[(long)r32*DM+d0*16+hi*8]);
  unsigned sel=(1u<<qb)-1u;
  if(qb>=4){
    float g[8];
    #pragma unroll
    for(int n=0;n<8;++n){ g[n]=0.f;
      { const float*kp=ksum+(((long)(b*8+n)*NHEAD+h)*64)+hi*8; float a=0.f;
        #pragma unroll
        for(int d0=0;d0<4;++d0){ const f32x4_t k0=*(const f32x4_t*)(kp+d0*16),k1=*(const f32x4_t*)(kp+d0*16+4);
          #pragma unroll
          for(int j=0;j<4;++j){ a+=bfu(qr[d0][j])*k0[j]; a+=bfu(qr[d0][4+j])*k1[j]; } }
        a+=shx(a,32,lane); g[n]=a; } }
    sel=0u;
    #pragma unroll
    for(int k=0;k<3;++k){ int best=-1; float bv=0.f;
      #pragma unroll
      for(int n=0;n<8;++n) if(n<qb&&!((sel>>n)&1u)){ if(best<0||g[n]>bv){best=n;bv=g[n];} }
      sel|=1u<<best; }
  }
  #define KEEP(t) (((t)>=NT-4)||((sel>>((t)>>2))&1u))
  float mhat=0.f,l_reg=0.f;f32x16 o[2];o[0]=f32x16{};o[1]=f32x16{};f32x16 negm=f32x16{};asm volatile("":"+v"(negm));
  const int qrel=wid*QBLK+r32;
  #define CMASK(P0,P1,t) do{int jb_=(t)-(NT-4); if(jb_>=0)cmask(P0,P1,jb_,qrel,hi);}while(0)
  bool resc=false;
  #define START(P0,P1) do{ const float rm=KEEP(0)?rowmax(P0,P1):-INFINITY; resc=false; \
    { const float dl=max2f(rm,-64.f); mhat=fadd_s(mhat,dl); \
      _Pragma("unroll") for(int r=0;r<16;++r){P0[r]=fsub_s(P0[r],dl);P1[r]=fsub_s(P1[r],dl);} \
      _Pragma("unroll") for(int r=0;r<16;++r)negm[r]=-mhat; asm volatile("":"+v"(negm)); } \
    _Pragma("unroll") for(int r=0;r<16;++r)P0[r]=__builtin_amdgcn_exp2f(P0[r]); }while(0)
  #define RESC() do{ if(resc){ asm volatile("s_waitcnt lgkmcnt(0)":::"memory"); \
      _Pragma("unroll") for(int d_=0;d_<2;++d_) _Pragma("unroll") for(int r=0;r<16;++r)o[d_][r]*=wsf[crow(r,hi)]; } }while(0)
  f32x16 pA0,pA1,pB0,pB1;
  int sl_prev=0,sl_cur=0,sl_next=SLOTB;
  #define ROT() do{sl_prev=sl_cur;sl_cur=sl_next;sl_next=(sl_next==(NSLOT-1)*SLOTB)?0:sl_next+SLOTB;}while(0)
  DMA_K(2,2*SLOTB);
  WAIT_BAR(3);
  qkt(pA0,pA1,Kbase,qr,negm,r32,hi);asm volatile("s_nop 15\n\ts_nop 7":"+v"(pA0),"+v"(pA1));CMASK(pA0,pA1,0);
  START(pA0,pA1);
  _Pragma("unroll") for(int r=0;r<16;++r)pA1[r]=__builtin_amdgcn_exp2f(pA1[r]);
  WAIT_BAR(0);
  DMA_K(3,0);DMA_V(1,SLOTB);
  ROT();
  kload8(kf,kp0+sl_cur);
  WAIT_BAR(2);
  s16x4 vlo[8],vhi[8]; u32x4 pw0,pw1,pw2,pw3;
  #define PKW(P,B) (cvtpk_s(P[B],P[B+1])&kmp_)
  #define PAF(k) __builtin_bit_cast(bf16x8,pw##k)
  #define VFR(i) (bf16x8){vlo[i][0],vlo[i][1],vlo[i][2],vlo[i][3],vhi[i][0],vhi[i][1],vhi[i][2],vhi[i][3]}
  #define PIN(x) asm volatile("":"+v"(x))
  #define MX3(a,b,c) __builtin_fmaxf(__builtin_fmaxf((a),(b)),(c))
  #define GAPA(MF,A0,A1,A2,A3,W0,W1,PW) do{ MF; sacc+=A0; sacc+=A1; sacc+=A2; sacc+=A3; PIN(sacc); W0; W1; PIN(PW); SBAR(); }while(0)
  #define EX(v) __builtin_amdgcn_exp2f(v)
  #define GAPB(MF,X,B) do{ MF; X[B]=EX(X[B]); X[B+1]=EX(X[B+1]); X[B+2]=EX(X[B+2]); X[B+3]=EX(X[B+3]); PIN(X); SBAR(); }while(0)
  #define VRD(i) do{ vlo[i]=vtr(vp_+(((i)>>2)*4096+((i)&3)*1024)); vhi[i]=vtr(vp_+(((i)>>2)*4096+((i)&3)*1024+512)); }while(0)
  #define KRD(G,j) do{ if(G){ kload2(kf,kp0+sl_next,j); SBAR(); } }while(0)
  #define STEP(C0,C1,P0,P1,t,GK,GV,GL) do{ SBAR(); \
    const lds_cptr vp_=vp0+sl_prev; const bool kp_=KEEP((t)-1); const unsigned kmp_=kp_?0xffffffffu:0u; const float kfp_=kp_?1.f:0.f; \
    VRD(0); SBAR(); float sacc=(P0[0]+P0[1]); \
    GAPA(C0=__builtin_amdgcn_mfma_f32_32x32x16_bf16(kf[0],qr[0],negm,0,0,0), P0[2],P0[3],P0[4],P0[5],     pw0[0]=PKW(P0,0), pw0[1]=PKW(P0,2), pw0); \
    VRD(4); SBAR(); GAPA(C1=__builtin_amdgcn_mfma_f32_32x32x16_bf16(kf[1],qr[0],negm,0,0,0), P0[6],P0[7],P0[8],P0[9],     pw0[2]=PKW(P0,4), pw0[3]=PKW(P0,6), pw0); \
    VRD(1); SBAR(); GAPA(C0=__builtin_amdgcn_mfma_f32_32x32x16_bf16(kf[2],qr[1],C0,0,0,0),   P0[10],P0[11],P0[12],P0[13], pw1[0]=PKW(P0,8), pw1[1]=PKW(P0,10), pw1); \
    VRD(5); SBAR(); GAPA(C1=__builtin_amdgcn_mfma_f32_32x32x16_bf16(kf[3],qr[1],C1,0,0,0),   P0[14],P0[15],P1[0],P1[1],   pw1[2]=PKW(P0,12),pw1[3]=PKW(P0,14), pw1); \
    VRD(2); SBAR(); GAPA(C0=__builtin_amdgcn_mfma_f32_32x32x16_bf16(kf[4],qr[2],C0,0,0,0),   P1[2],P1[3],P1[4],P1[5],     pw2[0]=PKW(P1,0), pw2[1]=PKW(P1,2), pw2); \
    VRD(6); SBAR(); GAPA(C1=__builtin_amdgcn_mfma_f32_32x32x16_bf16(kf[5],qr[2],C1,0,0,0),   P1[6],P1[7],P1[8],P1[9],     pw2[2]=PKW(P1,4), pw2[3]=PKW(P1,6), pw2); \
    VRD(3); SBAR(); GAPA(C0=__builtin_amdgcn_mfma_f32_32x32x16_bf16(kf[6],qr[3],C0,0,0,0),   P1[10],P1[11],P1[12],P1[13], pw3[0]=PKW(P1,8), pw3[1]=PKW(P1,10), pw3); \
    VRD(7); SBAR(); GAPA(C1=__builtin_amdgcn_mfma_f32_32x32x16_bf16(kf[7],qr[3],C1,0,0,0),   P1[14],P1[15],0.f,0.f,       pw3[2]=PKW(P1,12),pw3[3]=PKW(P1,14), pw3); \
    l_reg=__builtin_fmaf(sacc,kfp_,l_reg); \
    if(GK){DMA_K((t)+3,sl_cur);} if(GV){DMA_V((t)+1,sl_next);} \
    CMASK(C0,C1,t); \
    { float a=MX3(C0[0],C0[1],C1[0]),b=MX3(C0[2],C0[3],C1[1]); a=MX3(a,C1[2],C1[3]); \
      _Pragma("unroll") for(int r=4;r<16;r+=4){a=MX3(a,C0[r],C0[r+1]);b=MX3(b,C0[r+2],C0[r+3]);a=MX3(a,C1[r],C1[r+1]);b=MX3(b,C1[r+2],C1[r+3]);} \
      float rm=__builtin_fmaxf(a,b); { auto rr=__builtin_amdgcn_permlane32_swap(__float_as_uint(rm),__float_as_uint(rm),false,false); rm=__builtin_fmaxf(__uint_as_float(rr[0]),__uint_as_float(rr[1])); } \
      rm=KEEP(t)?rm:-INFINITY; \
      resc=false; \
      if(__builtin_expect(__any(rm>(float)THRL),0)){ const float dl=__builtin_fmaxf(rm,0.f); mhat+=dl; \
        _Pragma("unroll") for(int r=0;r<16;++r){C0[r]-=dl;C1[r]-=dl;} \
        _Pragma("unroll") for(int r=0;r<16;++r)negm[r]=-mhat; asm volatile("":"+v"(negm)); \
        const float f=__builtin_amdgcn_exp2f(-dl); l_reg*=f; if(hi==0)wsf[r32]=f; resc=true; } } \
    SBAR(); \
    GAPB(o[0]=__builtin_amdgcn_mfma_f32_32x32x16_bf16(PAF(0),VFR(0),o[0],0,0,0), C0,0); \
    GAPB(o[1]=__builtin_amdgcn_mfma_f32_32x32x16_bf16(PAF(0),VFR(4),o[1],0,0,0), C0,4); \
    KRD(GL,0); GAPB(o[0]=__builtin_amdgcn_mfma_f32_32x32x16_bf16(PAF(1),VFR(1),o[0],0,0,0), C0,8); \
    KRD(GL,1); GAPB(o[1]=__builtin_amdgcn_mfma_f32_32x32x16_bf16(PAF(1),VFR(5),o[1],0,0,0), C0,12); \
    KRD(GL,2); GAPB(o[0]=__builtin_amdgcn_mfma_f32_32x32x16_bf16(PAF(2),VFR(2),o[0],0,0,0), C1,0); \
    KRD(GL,3); GAPB(o[1]=__builtin_amdgcn_mfma_f32_32x32x16_bf16(PAF(2),VFR(6),o[1],0,0,0), C1,4); \
    GAPB(o[0]=__builtin_amdgcn_mfma_f32_32x32x16_bf16(PAF(3),VFR(3),o[0],0,0,0), C1,8); \
    GAPB(o[1]=__builtin_amdgcn_mfma_f32_32x32x16_bf16(PAF(3),VFR(7),o[1],0,0,0), C1,12); \
    }while(0)
  int t=1;
  #undef CMASK
  #define CMASK(P0,P1,t) do{}while(0)
  for(;t+5<NT;t+=2){
    STEP(pB0,pB1,pA0,pA1,t,true,true,true);     WAIT_BAR(2); RESC(); ROT();
    STEP(pA0,pA1,pB0,pB1,t+1,true,true,true);   WAIT_BAR(2); RESC(); ROT();
  }
  #undef CMASK
  #define CMASK(P0,P1,t) do{int jb_=(t)-(NT-4); if(jb_>=0)cmask(P0,P1,jb_,qrel,hi);}while(0)
  #define ENDW(tt) do{ if((tt)+3<NT){WAIT_BAR(2);} else if((tt)+2<NT){WAIT_BAR(1);} else {WAIT_BAR(0);} }while(0)
  for(;t+1<NT;t+=2){
    STEP(pB0,pB1,pA0,pA1,t,(t+3<NT),(t+1<NT),(t+1<NT));       ENDW(t);   RESC(); ROT();
    STEP(pA0,pA1,pB0,pB1,t+1,(t+4<NT),(t+2<NT),(t+2<NT));     ENDW(t+1); RESC(); ROT();
  }
  STEP(pB0,pB1,pA0,pA1,NT-1,false,false,false); RESC();
  { const unsigned kmp_=0xffffffffu; float sacc=pB0[0]+pB0[1]; _Pragma("unroll") for(int r=2;r<16;++r)sacc+=pB0[r]; _Pragma("unroll") for(int r=0;r<16;++r)sacc+=pB1[r]; l_reg+=sacc;
    pw0=(u32x4){PKW(pB0,0),PKW(pB0,2),PKW(pB0,4),PKW(pB0,6)};pw1=(u32x4){PKW(pB0,8),PKW(pB0,10),PKW(pB0,12),PKW(pB0,14)};pw2=(u32x4){PKW(pB1,0),PKW(pB1,2),PKW(pB1,4),PKW(pB1,6)};pw3=(u32x4){PKW(pB1,8),PKW(pB1,10),PKW(pB1,12),PKW(pB1,14)};
    SBAR(); pv(o,vb0+sl_cur,PAF(0),PAF(1),PAF(2),PAF(3)); }
  #undef PKW
  #undef PAF
  #undef VFR
  #undef PIN
  #undef MX3
  #undef GAPA
  #undef GAPB
  #undef EX
  #undef VRD
  #undef KRD
  #undef STEP
  #undef ENDW
  {auto rr=__builtin_amdgcn_permlane32_swap(__float_as_uint(l_reg),__float_as_uint(l_reg),false,false);l_reg=__uint_as_float(rr[0])+__uint_as_float(rr[1]);}
  if(hi==0)wsf[32+r32]=l_reg;asm volatile("s_waitcnt lgkmcnt(0)":::"memory");
  float rli[16];
  #pragma unroll
  for(int r=0;r<16;++r)rli[r]=__builtin_amdgcn_rcpf(wsf[32+crow(r,hi)]);
  bf16*Ow=O+(rowbase+q0+wid*QBLK)*DM+h*D;
  { bf16*stg=(bf16*)(shm+LDS_OST)+wid*2048;
    #pragma unroll
    for(int r=0;r<16;++r){const int orow=crow(r,hi);
      #pragma unroll
      for(int d0=0;d0<2;++d0)stg[orow*64+d0*32+r32]=__float2bfloat16(o[d0][r]*rli[r]);}
    asm volatile("s_waitcnt lgkmcnt(0)":::"memory");
    #pragma unroll
    for(int i=0;i<4;++i){const int row=i*8+(lane>>3),ch=lane&7; const u32x4 v=*(const u32x4*)(stg+row*64+ch*8); ATTN_STORE16(Ow+(long)row*DM+ch*8,v);} }
  asm volatile("s_waitcnt lgkmcnt(0)\n\ts_barrier":::"memory");
  #undef KEEP
  #undef DMA_K
  #undef DMA_V
  #undef CMASK
  #undef START
  #undef RESC
  #undef ROT
}
constexpr int ATTN_LDS_BYTES=LDS_BYTES;
#undef SBAR
#undef WAIT_BAR
}

constexpr int PH_PER_LAYER = 10, N_PHASES = PH_PER_LAYER * DEPTH;

constexpr int CONV_UNIT_ITEMS = 16, N_CONV_UNITS = (1024 + 2816) / CONV_UNIT_ITEMS;
__device__ __forceinline__ void conv_unit(int wave, int lane, int idx, const float* w_out, const float* ssm_nw, const float* w_up, const float* n2w, bf16* bufa, bf16* bufb, LAS float* scr) {
    for (int it = CONV_UNIT_ITEMS * idx + wave; it < CONV_UNIT_ITEMS * idx + CONV_UNIT_ITEMS; it += NWAVES) {
        if (it < 1024) { const int kb = it >> 5, nb = it & 31; conv_item(w_out, DM, 32 * nb, bufb, DMIX, 32 * nb, 64 * kb, scr, lane, ssm_nw, 512, 1536); }
        else { const int i2 = it - 1024, kb = i2 / (ULD / 32), nb = i2 % (ULD / 32); const int src = ((nb >> 2) & 1) * FFN + 128 * (nb >> 3) + (nb & 3) * 32;
            conv_item(w_up, ULD, src, bufa, DM, 32 * nb, 64 * kb, scr, lane, n2w); }
    }
}

template <int L, int P>
__device__ __forceinline__ void run_phase(Frame& F, const int wave0, const int ph_lo, const int ph_hi) {
    constexpr int l = L, p = P, ph = L * PH_PER_LAYER + P;
    if constexpr ((L > 0 && P == 0) || P == 4 || P == 6 || P == 8) return;
    if (!(ph_lo <= ph && ph < ph_hi)) return;
    {
        const __attribute__((address_space(4))) Args* ap = (const __attribute__((address_space(4))) Args*)__builtin_amdgcn_kernarg_segment_ptr();
        asm volatile("" : "+s"(ap));
        { int t_ = wave0 * 64 + fresh_lane(); asm volatile("" : "+v"(t_)); F.tid = t_; F.lane = t_ & 63; F.wave = __builtin_amdgcn_readfirstlane(t_ >> 6); }
        F.G = gridDim.x; { const int bx = blockIdx.x; F.vcu = (F.G % 8 == 0) ? (bx % 8) * (F.G / 8) + bx / 8 : bx; }
        unsigned char* ws = ap->ws; float* out = ap->out;
        bf16* bufa = (bf16*)(ws + WS_BUFA); bf16* bufb = (bf16*)(ws + WS_BUFB); bf16* xb = (bf16*)(ws + WS_XB); bf16* proj = (bf16*)(ws + WS_PROJ);
        float* smallp = (float*)(ws + WS_SMALLP); float* ssq = (float*)(ws + WS_SSQ);
        switch (p) {
        case 0: {
            LAS float* scr = (LAS float*)(F.lds + F.wave * 16384);
            conv_w_in(F, ap->in[2], ap->in[1], bufa, scr);
            conv_small(F, ap->in[2], ap->in[1], (bf16*)(ws + WS_WSM));
            row_pass0(F, ap->in[0], xb, (float*)(ws + WS_RS));
        } break;
        case 1: {
            const float* rs = (const float*)(ws + WS_RS) + (size_t)(2 * l) * M;
            pg8::Gemm g{xb, bufa, M, PLD, DM, DM}; pg8::StaticOrder S; S.init(M, PLD, F.G, (int)blockIdx.x, (F.G == 256) ? 1 : 0);
            pg8::EpiProj E{ws, (const float* const __attribute__((address_space(4)))*)ap->in, l};
            pg8::gemm_phase<pg8::EpiProj>(F.lds + RING_OFF, g, S, E, F.tid);
            small_proj(F, xb, (const bf16*)(ws + WS_WSM) + (size_t)(l & 1) * 32 * DM, rs, smallp);
        } break;
        case 2: {
            ksum_pass(F, proj, (float*)(ws + WS_KSUM + (size_t)l * 131072));
            conv_fix(F, proj, (const bf16*)(ws + WS_HALO), ap->in[5] + (size_t)l * 4 * 1536, ap->in[6] + l * 1536, ap->in[11] + (size_t)l * 4 * 1024, ap->in[12] + l * 1024);
        } break;
        case 3: {
            constexpr int QN = 4 + 16 + 64 + N_CONV_UNITS / 8;
            gu32* qheads = (gu32*)(ws + WS_QUEUE) + l * 8 * 64;
            volatile LAS unsigned* MISC = (volatile LAS unsigned*)(F.lds + MISC_OFF);
            const attn_body::bf16* pq = (const attn_body::bf16*)proj; const float* ks = (const float*)(ws + WS_KSUM + (size_t)l * 131072);
            const int x0 = (int)(xb_xcc_id() & 7u);
            for (int hop = 0; hop < 8;) {
                const int x = (x0 + hop) & 7;
                const int tq = wave0 * 64 + fresh_lane();
                __syncthreads();
                if (tq == 0) MISC[0] = __hip_atomic_fetch_add(qheads + x * 64, 1u, RLX_AGENT);
                __syncthreads();
                const int j = (int)MISC[0];
                if (j >= QN) { ++hop; continue; }
#if PROBE_PHASE != -1
                const unsigned long long tu0 = __builtin_amdgcn_s_memrealtime();
                const int u = (j < 4) ? (x * 4 + j) : (j < 20) ? (32 + x * 16 + j - 4) : 160 + x * 64 + j - 20;
#endif
                if (j < 4) mlstm_unit(tq, proj, smallp, ap->in[13] + l * 4, ap->in[14] + l * 4, ap->in[15] + l * 512, x, j, F.lds, (float*)(ws + WS_GSC) + (size_t)(x * 4 + j) * 16 * 656, (l == 0 && x == 0 && j == 0) ? (unsigned long long*)(ws + WS_TS) + 1024 : nullptr);
                else if (j < 20) ssd_unit(tq, proj, smallp, ssq, ap->in[7] + l * 16, ap->in[8] + l * 16, ap->in[9] + l * 16, x, j - 4, F.lds);
                else if (j < 84) { const int idx = j - 20, h = idx & 7, qb = 7 - (idx >> 3);
                    attn_body::attn_unit<8>(tq, x, h, qb, pq + PC_Q, pq + PC_K, pq + PC_V, (attn_body::bf16*)proj + PC_Q, ks, (char*)F.lds); }
                else conv_unit(wave0, tq & 63, x * (N_CONV_UNITS / 8) + j - 84, ap->in[16] + (size_t)l * DMIX * DM, ap->in[10] + l * 1024, ap->in[18] + (size_t)l * DM * ULD, ap->in[17] + l * DM, bufa, bufb, (LAS float*)(F.lds + wave0 * 16384));
#if PROBE_PHASE != -1
                if (l == 0 && wave0 == 0 && fresh_lane() == 0) __hip_atomic_store((unsigned long long*)(ws + WS_TS) + 128 + u, (unsigned long long)(__builtin_amdgcn_s_memrealtime() - tu0), __ATOMIC_RELAXED, __HIP_MEMORY_SCOPE_AGENT);
#endif
            }
        } break;
        case 4: break;
        case 5: {
            pg8::Gemm g{proj, bufb, M, DM, DMIX, PLD}; pg8::StaticOrder S; S.init(M, DM, F.G, (int)blockIdx.x);
            LAS float* ftab = (LAS float*)(F.lds + RING_BYTES);
            { pg8::Unit u0; if (S.next(0, u0)) { const int row = F.tid >> 1; const float* sq = ssq + (size_t)(u0.pm * 256 + row) * 16;
                const f32x4 a0 = *(const f32x4*)sq, a1 = *(const f32x4*)(sq + 4), a2 = *(const f32x4*)(sq + 8), a3 = *(const f32x4*)(sq + 12);
                const float s0 = ((a0[0] + a0[1]) + (a0[2] + a0[3])) + ((a1[0] + a1[1]) + (a1[2] + a1[3])), s1 = ((a2[0] + a2[1]) + (a2[2] + a2[3])) + ((a3[0] + a3[1]) + (a3[2] + a3[3]));
                const float r0 = 1.0f / sqrtf(s0 * (1.0f / 512.0f) + EPS), r1 = 1.0f / sqrtf(s1 * (1.0f / 512.0f) + EPS);
                ftab[F.tid] = (F.tid & 1) ? r1 : r0 / r1; } }
            LDS_WAIT(); __syncthreads();
            pg8::EpiRes E{xb, nullptr, (float*)(ws + WS_RS) + (size_t)(2 * l + 1) * M};
            pg8::gemm_phase<pg8::EpiRes, 1>(F.lds + RING_OFF, g, S, E, F.tid, (const LAS float*)ftab);
        } break;
        case 6: break;
        case 7: {
            pg8::Gemm g{xb, bufa, M, ULD, DM, DM}; pg8::StaticOrder S; S.init(M, ULD, F.G, (int)blockIdx.x);
            pg8::EpiFfn E{proj, (const float*)(ws + WS_RS) + (size_t)(2 * l + 1) * M, ap->in[19] + (size_t)l * 3 * FFN, ap->in[20] + l * FFN, (bf16*)(ws + WS_SIDEA), (bf16*)(ws + WS_SIDEB)};
            pg8::gemm_phase<pg8::EpiFfn>(F.lds + RING_OFF, g, S, E, F.tid);
            {
                const bool half = (F.G == 256); if (!half || blockIdx.x >= 128) { Frame F2 = F; if (half) { F2.vcu = (int)blockIdx.x - 128; F2.G = 128; }
                    conv_plain(F2, ap->in[21] + (size_t)l * FFN * DM, FFN, DM, nullptr, bufb, (LAS float*)(F.lds + F.wave * 16384));
                    if (l + 1 < DEPTH) conv_small(F2, ap->in[2] + (size_t)(l + 1) * DM * P_IN, ap->in[1] + (l + 1) * DM, (bf16*)(ws + WS_WSM) + (size_t)((l + 1) & 1) * 32 * DM); } }
        } break;
        case 8: break;
        case 9: {
            pg8::Gemm g{proj, bufb, M, DM, FFN, FFN}; pg8::StaticOrder S; S.init(M, DM, F.G, (int)blockIdx.x);
            { pg8::Unit u0; for (int i = 0; S.next(i, u0); ++i) ffn_fix(F, proj, (const bf16*)(ws + WS_SIDEA), (const bf16*)(ws + WS_SIDEB), ap->in[19] + (size_t)l * 3 * FFN, ap->in[20] + l * FFN, u0.pm); }
            VM_WAIT(); __syncthreads();
            pg8::EpiRes E{xb, (l + 1 < DEPTH) ? nullptr : out, (float*)(ws + WS_RS) + (size_t)(2 * l + 2) * M};
            pg8::gemm_phase<pg8::EpiRes>(F.lds + RING_OFF, g, S, E, F.tid);
            if (l + 1 < DEPTH) conv_w_in(F, ap->in[2] + (size_t)(l + 1) * DM * P_IN, ap->in[1] + (l + 1) * DM, bufa, (LAS float*)(F.lds + F.wave * 16384));
        } break;
        }
        if (ph + 1 < ph_hi || PROBE_PHASE != -1) { XcdBarrier bar; bar.bar = (unsigned*)(ap->ws + WS_CTL) + CW_BAR; bar.x = xb_xcc_id(); bar.st = (volatile LAS unsigned*)(F.lds + MISC_OFF) + 8; xcd_barrier(bar, wave0 * 64 + fresh_lane()); }
#if PROBE_PHASE != -1
        if (blockIdx.x == 0 && wave0 == 0 && fresh_lane() == 0) { const unsigned long long tnow = __builtin_amdgcn_s_memrealtime();
            __hip_atomic_store((unsigned long long*)(ap->ws + WS_TS) + 1 + ph, tnow, __ATOMIC_RELAXED, __HIP_MEMORY_SCOPE_AGENT);
            if (P == 3 || P == 5 || P == 7 || P == 9) __hip_atomic_store((unsigned long long*)(ap->ws + WS_TS) + 2 + ph, tnow, __ATOMIC_RELAXED, __HIP_MEMORY_SCOPE_AGENT); }
#endif
    }
}

__global__ void __launch_bounds__(NWAVES * 64, 2) fwd(Args args) {
    extern __shared__ __attribute__((aligned(16))) unsigned char lds[];
    Frame F;
    F.lds = (LAS unsigned char*)lds;
    F.tid = threadIdx.x; F.lane = F.tid & 63; F.wave = __builtin_amdgcn_readfirstlane(F.tid >> 6);
    const int wave0 = F.wave;
    for (int u = F.tid; u < (LDS_BYTES - LDSCTL_OFF) / 4; u += NWAVES * 64) ((LAS unsigned*)(F.lds + LDSCTL_OFF))[u] = 0u;
    __syncthreads();
    const int ph_lo = args.ph_lo, ph_hi = args.ph_hi;
#if PROBE_PHASE != -1
    if (blockIdx.x == 0 && F.tid == 0) __hip_atomic_store((unsigned long long*)(args.ws + WS_TS), (unsigned long long)__builtin_amdgcn_s_memrealtime(), __ATOMIC_RELAXED, __HIP_MEMORY_SCOPE_AGENT);
#endif
    if (ph_hi - ph_lo > 1) (void)xcd_barrier_post((unsigned*)(args.ws + WS_CTL) + CW_BAR, (volatile LAS unsigned*)(F.lds + MISC_OFF) + 8);

    run_phase<0, 0>(F, wave0, ph_lo, ph_hi);
    run_phase<0, 1>(F, wave0, ph_lo, ph_hi);
    run_phase<0, 2>(F, wave0, ph_lo, ph_hi);
    run_phase<0, 3>(F, wave0, ph_lo, ph_hi);
    run_phase<0, 4>(F, wave0, ph_lo, ph_hi);
    run_phase<0, 5>(F, wave0, ph_lo, ph_hi);
    run_phase<0, 6>(F, wave0, ph_lo, ph_hi);
    run_phase<0, 7>(F, wave0, ph_lo, ph_hi);
    run_phase<0, 8>(F, wave0, ph_lo, ph_hi);
    run_phase<0, 9>(F, wave0, ph_lo, ph_hi);
    run_phase<1, 0>(F, wave0, ph_lo, ph_hi);
    run_phase<1, 1>(F, wave0, ph_lo, ph_hi);
    run_phase<1, 2>(F, wave0, ph_lo, ph_hi);
    run_phase<1, 3>(F, wave0, ph_lo, ph_hi);
    run_phase<1, 4>(F, wave0, ph_lo, ph_hi);
    run_phase<1, 5>(F, wave0, ph_lo, ph_hi);
    run_phase<1, 6>(F, wave0, ph_lo, ph_hi);
    run_phase<1, 7>(F, wave0, ph_lo, ph_hi);
    run_phase<1, 8>(F, wave0, ph_lo, ph_hi);
    run_phase<1, 9>(F, wave0, ph_lo, ph_hi);
#if PROBE_PHASE != -1
    {
        const __attribute__((address_space(4))) Args* ap = (const __attribute__((address_space(4))) Args*)__builtin_amdgcn_kernarg_segment_ptr();
        const unsigned long long* ts = (const unsigned long long*)(ap->ws + WS_TS);
        float us = 500.f;
#ifdef PROBE_UNIT
        if (true) { us = 0.01f * (float)__hip_atomic_load(ts + PROBE_UNIT, __ATOMIC_RELAXED, __HIP_MEMORY_SCOPE_AGENT); } else
#endif
        if (PROBE_PHASE >= 0) { us = 0.f;
            for (int l = 0; l < DEPTH; ++l) { const int ph = l * PH_PER_LAYER + PROBE_PHASE; if (ph < N_PHASES - 1) us += 0.01f * (float)(__hip_atomic_load(ts + 1 + ph, __ATOMIC_RELAXED, __HIP_MEMORY_SCOPE_AGENT) - __hip_atomic_load(ts + ph, __ATOMIC_RELAXED, __HIP_MEMORY_SCOPE_AGENT)); } }
        const float dl = sqrtf(PROBE_GAIN * us);
        float* o = ap->out;
        for (size_t i = (size_t)blockIdx.x * 512 + wave0 * 64 + fresh_lane(); i < (size_t)M * DM; i += (size_t)gridDim.x * 512) o[i] += (i & 1) ? dl : -dl;
    }
#endif
}

extern "C" void kernel_launch(void* const* d_in, const int* in_sizes, int n_in, void* d_out, int out_size, void* d_ws, size_t ws_size, hipStream_t stream) {
    static int grid = 0;
    if (grid == 0) {
        if (n_in != 22 || in_sizes[0] != M * DM || out_size != M * DM || ws_size < WS_END) { fprintf(stderr, "kernel_launch: unexpected shapes (n_in %d, in0 %d, out %d, ws %zu); nothing launched\n", n_in, n_in > 0 ? in_sizes[0] : -1, out_size, ws_size); grid = -1; return; }
        int dev = 0, cus = 0, per_cu = 0;
        if (hipGetDevice(&dev) != hipSuccess || hipDeviceGetAttribute(&cus, hipDeviceAttributeMultiprocessorCount, dev) != hipSuccess) { grid = -1; return; }
        if (hipFuncSetAttribute((const void*)fwd, hipFuncAttributeMaxDynamicSharedMemorySize, LDS_BYTES) != hipSuccess) { fprintf(stderr, "kernel_launch: hipFuncSetAttribute failed\n"); grid = -1; return; }
        if (hipOccupancyMaxActiveBlocksPerMultiprocessor(&per_cu, (const void*)fwd, NWAVES * 64, LDS_BYTES) != hipSuccess || per_cu < 1) { fprintf(stderr, "kernel_launch: occupancy query reports %d blocks per CU\n", per_cu); per_cu = 1; }
        (void)hipGetLastError();
        grid = cus;
    }
    if (grid < 0) return;
    (void)hipMemsetAsync((char*)d_ws + WS_CTL, 0, CTL_ZERO_BYTES, stream);
    Args a{};
    for (int i = 0; i < 22; ++i) a.in[i] = (const float*)d_in[i];
    a.out = (float*)d_out; a.ws = (unsigned char*)d_ws;
#if MK_MULTI
    for (int ph = 0; ph < N_PHASES; ++ph) {
        a.ph_lo = ph; a.ph_hi = ph + 1;
        hipLaunchKernelGGL(fwd, dim3(grid), dim3(NWAVES * 64), LDS_BYTES, stream, a);
    }
#else
    a.ph_lo = 0; a.ph_hi = N_PHASES;
    hipLaunchKernelGGL(fwd, dim3(grid), dim3(NWAVES * 64), LDS_BYTES, stream, a);
#endif
}
```
